# Optimizing an MI355X kernel written in HIP

```python
import jax
import jax.numpy as jnp
from jax import lax
import numpy as np

D_MODEL = 2048
BATCH = 8
SEQ = 2048
DEPTH = 2

CHUNK = 64
EPS = 1e-6
NEG = -1e30
CONV_K = 4

HD_A = 128
W_A = D_MODEL // 2
H_A = W_A // HD_A
LOOKBACK = 8
BAND = (LOOKBACK + 1) * CHUNK
REL_MAX = 256
H_B = 4
W_B = D_MODEL // 2
HD_B = W_B // H_B
FORGET_BIAS = 3.0
W_C = D_MODEL // 2
N_BLK_C = 8
BLK_C = W_C // N_BLK_C
C_RG = 8.0
HD_D = 128
W_D = D_MODEL // 2
H_D = W_D // HD_D

EV_SIZES = (W_A, W_A, W_A, W_A, W_B, W_B, W_B, W_B, W_B, 2 * H_B)
OD_SIZES = (W_C, W_C, W_D, W_D, W_D, W_D, H_D, H_D)
EV_IN = sum(EV_SIZES)
OD_IN = sum(OD_SIZES)
W_EV = W_A + W_B
W_OD = W_C + W_D
N_EVEN = (DEPTH + 1) // 2
N_ODD = DEPTH // 2

kernel_name = "hybrid_chunkattn_mlstm_rglru_gdn"


def split_cols(t, sizes):
    offs = np.cumsum(sizes)[:-1].tolist()
    return jnp.split(t, offs, axis=-1)


def rmsnorm(x, g):
    xf = x.astype(jnp.float32)
    y = xf * lax.rsqrt(jnp.mean(xf * xf, axis=-1, keepdims=True) + EPS)
    return (y * g.astype(jnp.float32)).astype(x.dtype)


def l2norm(x):
    return x * lax.rsqrt(jnp.sum(x * x, axis=-1, keepdims=True) + EPS)


def causal_dwconv(x, w):
    s = x.shape[1]
    xp = jnp.pad(x, ((0, 0), (CONV_K - 1, 0), (0, 0)))
    return sum(xp[:, j:j + s] * w[j] for j in range(CONV_K))


def to_chunks(t):
    b, s, h = t.shape[:3]
    t = t.reshape(b, s // CHUNK, CHUNK, h, *t.shape[3:])
    return jnp.moveaxis(t, (1, 3), (0, 2))


def from_chunks(t):
    nc, b, h, l, d = t.shape
    return jnp.moveaxis(t, (0, 2), (1, 3)).reshape(b, nc * l, h * d)


def chunk_rel_attention(q, k, v, qn_g, kn_g, rel_bias):
    b, s, h, d = q.shape
    nc = s // CHUNK
    q = rmsnorm(q, qn_g).astype(jnp.float32) * (d ** -0.5)
    k = rmsnorm(k, kn_g).astype(jnp.float32)
    v = v.astype(jnp.float32)
    qc = q.reshape(b, nc, CHUNK, h, d)
    pad = ((0, 0), (LOOKBACK, 0), (0, 0), (0, 0), (0, 0))
    kp = jnp.pad(k.reshape(b, nc, CHUNK, h, d), pad)
    vp = jnp.pad(v.reshape(b, nc, CHUNK, h, d), pad)
    idx = jnp.arange(nc)[:, None] + jnp.arange(LOOKBACK + 1)[None, :]
    kb = kp[:, idx].reshape(b, nc, BAND, h, d)
    vb = vp[:, idx].reshape(b, nc, BAND, h, d)
    sc = jnp.einsum('bnqhd,bnkhd->bhnqk', qc, kb)
    qpos = LOOKBACK * CHUNK + jnp.arange(CHUNK)
    kpos = jnp.arange(BAND)
    rel = jnp.clip(qpos[:, None] - kpos[None, :], -REL_MAX, REL_MAX) + REL_MAX
    sc = sc + rel_bias.astype(jnp.float32)[:, rel][None, :, None]
    valid = (idx - LOOKBACK) >= 0
    valid = jnp.repeat(valid, CHUNK, axis=1)
    sc = jnp.where(valid[None, None, :, None, :], sc, NEG)
    p = jax.nn.softmax(sc, axis=-1)
    o = jnp.einsum('bhnqk,bnkhd->bnqhd', p, vb)
    return o.reshape(b, s, h * d)


def mlstm_chunkwise(q, k, v, li, lf):
    b, s, h, d = q.shape
    q = q * (d ** -0.5)
    qc, kc, vc = to_chunks(q), to_chunks(k), to_chunks(v)
    lic, lfc = to_chunks(li), to_chunks(lf)
    tril = jnp.tril(jnp.ones((CHUNK, CHUNK), dtype=bool))

    def step(carry, inp):
        cm, nm, m = carry
        qn, kn, vn, lin, lfn = inp
        bcum = jnp.cumsum(lfn, axis=-1)
        dmat = bcum[..., :, None] - bcum[..., None, :] + lin[..., None, :]
        dmat = jnp.where(tril, dmat, NEG)
        m_t = jnp.maximum(bcum + m[..., None], jnp.max(dmat, axis=-1))
        w_inter = jnp.exp(bcum + m[..., None] - m_t)
        p = jnp.exp(dmat - m_t[..., None]) * jnp.einsum('bhtd,bhsd->bhts', qn, kn)
        num = w_inter[..., None] * jnp.einsum('bhtk,bhkv->bhtv', qn, cm) + jnp.einsum('bhts,bhsv->bhtv', p, vn)
        den = w_inter * jnp.einsum('bhtk,bhk->bht', qn, nm) + jnp.sum(p, axis=-1)
        hout = num / jnp.maximum(jnp.abs(den), jnp.exp(-m_t))[..., None]
        b_last = bcum[..., -1]
        gs = b_last[..., None] - bcum + lin
        m_new = jnp.maximum(b_last + m, jnp.max(gs, axis=-1))
        w_c = jnp.exp(b_last + m - m_new)
        ws = jnp.exp(gs - m_new[..., None])
        cm = w_c[..., None, None] * cm + jnp.einsum('bhs,bhsk,bhsv->bhkv', ws, kn, vn)
        nm = w_c[..., None] * nm + jnp.einsum('bhs,bhsk->bhk', ws, kn)
        return (cm, nm, m_new), hout

    init = (jnp.zeros((b, h, d, d), jnp.float32), jnp.zeros((b, h, d), jnp.float32), jnp.zeros((b, h), jnp.float32))
    _, hs = lax.scan(step, init, (qc, kc, vc, lic, lfc))
    return from_chunks(hs)


def gated_delta_chunkwise(q, k, v, beta, g):
    b, s, h, d = q.shape
    qc = to_chunks(q) * (d ** -0.5)
    kc, vc = to_chunks(k), to_chunks(v)
    bc, gc = to_chunks(beta), to_chunks(g)
    tril = jnp.tril(jnp.ones((CHUNK, CHUNK), dtype=bool))
    strict = jnp.tril(jnp.ones((CHUNK, CHUNK), dtype=bool), k=-1)
    decay = jnp.cumsum(gc, axis=-1)
    gam = jnp.exp(jnp.where(tril, decay[..., :, None] - decay[..., None, :], NEG))
    kbeta = kc * bc[..., None]
    a_mat = jnp.where(strict, jnp.einsum('nbhtd,nbhsd->nbhts', kbeta, kc) * gam, 0.0)
    eye = jnp.eye(CHUNK, dtype=jnp.float32)
    t_inv = lax.linalg.triangular_solve(eye + a_mat, jnp.broadcast_to(eye, a_mat.shape), left_side=True, lower=True, unit_diagonal=True)
    u = jnp.einsum('nbhts,nbhsv->nbhtv', t_inv, vc * bc[..., None])
    w = jnp.einsum('nbhts,nbhsk->nbhtk', t_inv, kbeta * jnp.exp(decay)[..., None])
    qd = qc * jnp.exp(decay)[..., None]
    qk = jnp.einsum('nbhtd,nbhsd->nbhts', qc, kc) * gam
    kd = kc * jnp.exp(decay[..., -1:] - decay)[..., None]
    d_last = jnp.exp(decay[..., -1])

    def step(st, inp):
        un, wn, qdn, qkn, kdn, dln = inp
        v_new = un - jnp.einsum('bhtk,bhkv->bhtv', wn, st)
        o = jnp.einsum('bhtk,bhkv->bhtv', qdn, st) + jnp.einsum('bhts,bhsv->bhtv', qkn, v_new)
        st = dln[..., None, None] * st + jnp.einsum('bhsk,bhsv->bhkv', kdn, v_new)
        return st, o

    init = jnp.zeros((b, h, d, d), jnp.float32)
    _, os_ = lax.scan(step, init, (u, w, qd, qk, kd, d_last))
    return jnp.moveaxis(os_, (0, 2), (1, 3)).reshape(b, s, h, d)


def rg_lru(xconv, gate_w, gate_b, lam):
    b, s, _ = xconv.shape
    gates = jnp.einsum('bsnc,ncd->bsnd', xconv.reshape(b, s, N_BLK_C, BLK_C), gate_w.astype(jnp.float32))
    gb = gate_b.astype(jnp.float32)
    r = jax.nn.sigmoid(gates[..., :BLK_C].reshape(b, s, W_C) + gb[:W_C])
    i = jax.nn.sigmoid(gates[..., BLK_C:].reshape(b, s, W_C) + gb[W_C:])
    log_a = -C_RG * r * jax.nn.softplus(-lam.astype(jnp.float32))
    a = jnp.exp(log_a)
    inp = jnp.sqrt(-jnp.expm1(2.0 * log_a)) * (i * xconv)

    def combine(e1, e2):
        a1, b1 = e1
        a2, b2 = e2
        return a1 * a2, a2 * b1 + b2

    _, hs = lax.associative_scan(combine, (a, inp), axis=1)
    return hs


def even_layer(x, norm_g, w_in, if_bias, qn_g, kn_g, rel_bias, w_out):
    b, s, _ = x.shape
    proj = rmsnorm(x, norm_g) @ w_in
    qa, ka, va, za, qb, kb, vb, ob, zb, gif = split_cols(proj, EV_SIZES)
    ya = chunk_rel_attention(qa.reshape(b, s, H_A, HD_A), ka.reshape(b, s, H_A, HD_A), va.reshape(b, s, H_A, HD_A), qn_g, kn_g, rel_bias)
    ya = ya * jax.nn.silu(za.astype(jnp.float32))
    gif = gif.astype(jnp.float32) + if_bias.astype(jnp.float32)
    li = gif[..., :H_B]
    lf = jax.nn.log_sigmoid(gif[..., H_B:])
    f32 = jnp.float32
    hb = mlstm_chunkwise(qb.astype(f32).reshape(b, s, H_B, HD_B), kb.astype(f32).reshape(b, s, H_B, HD_B), vb.astype(f32).reshape(b, s, H_B, HD_B), li, lf)
    yb = jax.nn.sigmoid(ob.astype(f32)) * hb * jax.nn.silu(zb.astype(f32))
    y = jnp.concatenate([ya, yb], axis=-1).astype(x.dtype)
    return y @ w_out


def odd_layer(x, norm_g, w_in, conv_c_w, conv_c_b, gate_w, gate_b, lam, conv_d_w, a_log, dt_bias, onorm_g, w_out):
    b, s, _ = x.shape
    f32 = jnp.float32
    proj = rmsnorm(x, norm_g) @ w_in
    xc, zc, qd, kd, vd, zd, a_pre, b_pre = split_cols(proj, OD_SIZES)
    xconv = causal_dwconv(xc.astype(f32), conv_c_w.astype(f32)) + conv_c_b.astype(f32)
    yc = rg_lru(xconv, gate_w, gate_b, lam) * jax.nn.silu(zc.astype(f32))
    qkv = jax.nn.silu(causal_dwconv(jnp.concatenate([qd, kd, vd], axis=-1).astype(f32), conv_d_w.astype(f32)))
    q, k, v = jnp.split(qkv, 3, axis=-1)
    q = l2norm(q.reshape(b, s, H_D, HD_D))
    k = l2norm(k.reshape(b, s, H_D, HD_D))
    v = v.reshape(b, s, H_D, HD_D)
    beta = jax.nn.sigmoid(b_pre.astype(f32))
    g = -jnp.exp(a_log.astype(f32)) * jax.nn.softplus(a_pre.astype(f32) + dt_bias.astype(f32))
    od = gated_delta_chunkwise(q, k, v, beta, g)
    yd = rmsnorm(od, onorm_g).reshape(b, s, W_D) * jax.nn.silu(zd.astype(f32))
    y = jnp.concatenate([yc, yd], axis=-1).astype(x.dtype)
    return y @ w_out


def setup_inputs(seed: int = 0) -> dict:
    key = jax.random.key(seed)
    ks = jax.random.split(key, 24)
    f32 = jnp.float32
    ne, no = N_EVEN, N_ODD

    def nrm(k, shape, scale):
        return scale * jax.random.normal(k, shape, f32)

    x = nrm(ks[0], (BATCH, SEQ, D_MODEL), 1.0)
    ev_norm = 1.0 + nrm(ks[1], (ne, D_MODEL), 0.05)
    ev_w_in = nrm(ks[2], (ne, D_MODEL, EV_IN), D_MODEL ** -0.5)
    ev_if_bias = jnp.concatenate([nrm(ks[3], (ne, H_B), 0.1), FORGET_BIAS + nrm(ks[4], (ne, H_B), 0.5)], axis=-1)
    ev_qn_gain = 1.0 + nrm(ks[5], (ne, HD_A), 0.05)
    ev_kn_gain = 1.0 + nrm(ks[6], (ne, HD_A), 0.05)
    ev_rel_bias = nrm(ks[7], (ne, H_A, 2 * REL_MAX + 1), 0.2)
    ev_w_out = nrm(ks[8], (ne, W_EV, D_MODEL), W_EV ** -0.5)
    od_norm = 1.0 + nrm(ks[9], (no, D_MODEL), 0.05)
    od_w_in = nrm(ks[10], (no, D_MODEL, OD_IN), D_MODEL ** -0.5)
    od_conv_c_w = nrm(ks[11], (no, CONV_K, W_C), CONV_K ** -0.5)
    od_conv_c_b = nrm(ks[12], (no, W_C), 0.01)
    od_gate_w = nrm(ks[13], (no, N_BLK_C, BLK_C, 2 * BLK_C), BLK_C ** -0.5)
    od_gate_b = nrm(ks[14], (no, 2 * W_C), 0.1)
    a0 = jax.random.uniform(ks[15], (no, W_C), f32, minval=0.9, maxval=0.999)
    sig = a0 ** (1.0 / C_RG)
    od_lambda = jnp.log(sig) - jnp.log1p(-sig)
    od_conv_d_w = nrm(ks[16], (no, CONV_K, 3 * W_D), CONV_K ** -0.5)
    od_a_log = jnp.log(jax.random.uniform(ks[17], (no, H_D), f32, minval=1.0, maxval=16.0))
    u = jax.random.uniform(ks[18], (no, H_D), f32)
    dt = jnp.exp(np.log(0.001) + u * (np.log(0.1) - np.log(0.001)))
    od_dt_bias = dt + jnp.log(-jnp.expm1(-dt))
    od_onorm = 1.0 + nrm(ks[19], (no, HD_D), 0.05)
    od_w_out = nrm(ks[20], (no, W_OD, D_MODEL), W_OD ** -0.5)
    return {"x": x, "ev_norm": ev_norm, "ev_w_in": ev_w_in, "ev_if_bias": ev_if_bias, "ev_qn_gain": ev_qn_gain, "ev_kn_gain": ev_kn_gain, "ev_rel_bias": ev_rel_bias, "ev_w_out": ev_w_out, "od_norm": od_norm, "od_w_in": od_w_in, "od_conv_c_w": od_conv_c_w, "od_conv_c_b": od_conv_c_b, "od_gate_w": od_gate_w, "od_gate_b": od_gate_b, "od_lambda": od_lambda, "od_conv_d_w": od_conv_d_w, "od_a_log": od_a_log, "od_dt_bias": od_dt_bias, "od_onorm": od_onorm, "od_w_out": od_w_out}


def reference(x, ev_norm, ev_w_in, ev_if_bias, ev_qn_gain, ev_kn_gain, ev_rel_bias, ev_w_out, od_norm, od_w_in, od_conv_c_w, od_conv_c_b, od_gate_w, od_gate_b, od_lambda, od_conv_d_w, od_a_log, od_dt_bias, od_onorm, od_w_out):
    for layer in range(DEPTH):
        j = layer // 2
        if layer % 2 == 0:
            x = x + even_layer(x, ev_norm[j], ev_w_in[j], ev_if_bias[j], ev_qn_gain[j], ev_kn_gain[j], ev_rel_bias[j], ev_w_out[j])
        else:
            x = x + odd_layer(x, od_norm[j], od_w_in[j], od_conv_c_w[j], od_conv_c_b[j], od_gate_w[j], od_gate_b[j], od_lambda[j], od_conv_d_w[j], od_a_log[j], od_dt_bias[j], od_onorm[j], od_w_out[j])
    return x
```

```cpp
#include <hip/hip_runtime.h>
#include <cstdio>
#include <cstdint>
#include <cmath>

constexpr int D_MODEL = 2048, BATCH = 8, SEQ = 2048, M_TOK = BATCH * SEQ;
constexpr int CHUNK = 64, NCH = SEQ / CHUNK;
constexpr float EPS = 1e-6f;
constexpr int HD_A = 128, W_A = 1024, H_A = 8, LOOKBACK = 8, BAND = (LOOKBACK + 1) * CHUNK, REL_MAX = 256, NREL = 2 * REL_MAX + 1;
constexpr int H_B = 4, W_B = 1024, HD_B = 256;
constexpr int W_C = 1024, N_BLK_C = 8, BLK_C = 128;
constexpr int HD_D = 128, W_D = 1024, H_D = 8;
constexpr int EV_IN = 9224, EV_N = 9216;
constexpr int OD_IN = 6160, OD_N = 6144;
constexpr int EC_QA = 0, EC_KA = 1024, EC_VA = 2048, EC_ZA = 3072, EC_QB = 4096, EC_KB = 5120, EC_VB = 6144, EC_OB = 7168, EC_ZB = 8192;
constexpr int OC_XC = 0, OC_ZC = 1024, OC_QD = 2048, OC_KD = 3072, OC_VD = 4096, OC_ZD = 5120;

constexpr size_t MiB = 1u << 20;
constexpr size_t WS_CTL = 0, CTL_ZERO_BYTES = 1 * MiB;
constexpr size_t WS_R0 = 1 * MiB;
constexpr size_t WS_SS1 = WS_R0 + 64 * 1024;
constexpr size_t WS_GIF = WS_SS1 + 64 * 1024;
constexpr size_t WS_AB = WS_GIF + 512 * 1024;
constexpr size_t WS_W1T = 4 * MiB;
constexpr size_t WS_W2T = 40 * MiB;
constexpr size_t WS_W3T = 48 * MiB;
constexpr size_t WS_W4T = 73 * MiB;
constexpr size_t WS_XB = 81 * MiB;
constexpr size_t WS_Y = 145 * MiB;
constexpr size_t WS_PROJ = 209 * MiB;
constexpr size_t WS_END = 497 * MiB;
constexpr size_t WS_FREE1 = 401 * MiB;

typedef unsigned short bf16_t;
__device__ __forceinline__ float bf2f(unsigned short v) { return __builtin_bit_cast(float, (unsigned)v << 16); }
__device__ __forceinline__ unsigned f2bf(float f) { unsigned u = __builtin_bit_cast(unsigned, f); return (u + 0x7fffu + ((u >> 16) & 1u)) >> 16; }
__device__ __forceinline__ unsigned pk2(float lo, float hi) { return f2bf(lo) | (f2bf(hi) << 16); }
__device__ __forceinline__ float sigmoidf_(float x) { return 1.f / (1.f + expf(-x)); }
__device__ __forceinline__ float siluf_(float x) { return x / (1.f + expf(-x)); }
__device__ __forceinline__ float softplusf_(float x) { return fmaxf(x, 0.f) + log1pf(expf(-fabsf(x))); }
__device__ __forceinline__ float logsigmoidf_(float x) { return -softplusf_(-x); }

namespace pg8 {
#define PG8_LAS __attribute__((address_space(3)))
typedef unsigned short bf16_t;
typedef short bf16x8 __attribute__((ext_vector_type(8)));
typedef float f32x4 __attribute__((ext_vector_type(4)));
typedef unsigned u32x4 __attribute__((ext_vector_type(4)));
constexpr int BM = 256, BK = 64, HALF = 128, HTB = HALF * BK * 2  , STAGE_BYTES = 8 * HTB, NXCD = 8, WGM = 8;

__host__ __device__ __forceinline__ int lds_byte(int r, int c) { const int st = (r >> 4) * 2 + (c >> 5), rr = r & 15, cc = c & 31, ob = rr * 64 + cc * 2; return st * 1024 + (ob ^ (((ob >> 9) & 1) << 5)); }
__host__ __device__ __forceinline__ void stage_rc(int b, int& R, int& C) { const int st = b / 1024, sb = b % 1024, swz = sb ^ (((sb >> 9) & 1) << 5); R = (st >> 1) * 16 + swz / 64; C = (st & 1) * 32 + (swz % 64) / 2; }
__host__ __device__ __forceinline__ int perm32(int rho) { const int n = rho >> 4, i = rho & 15; return 8 * (i >> 2) + 4 * n + (i & 3); }

struct Unit { int pm, pn; };
struct Gemm { const bf16_t* A; const bf16_t* Bt; int M, N, K; };

struct StaticOrder {
    int nM, nN, nwg, G, c;
    __host__ __device__ void init(int M, int N, int G_, int c_) { nM = M / BM; nN = N / BM; nwg = nM * nN; G = G_; c = c_; }
    __host__ __device__ bool next(int i, Unit& u) const {
        const long L = (long)i * G + c; if (L >= nwg) return false;
        int wgid = (int)L; { const int q = nwg / NXCD, r = nwg % NXCD, xcd = wgid % NXCD, off = wgid / NXCD; wgid = (xcd < r ? xcd * (q + 1) : r * (q + 1) + (xcd - r) * q) + off; }
        const int nig = WGM * nN, gid = wgid / nig, fm = gid * WGM, gsz = (nM - fm) < WGM ? (nM - fm) : WGM;
        u.pm = fm + ((wgid % nig) % gsz); u.pn = (wgid % nig) / gsz; return true;
    }
    __device__ __forceinline__ void a_ready(const Unit&) const {}
    __device__ __forceinline__ void done(const Unit&) const {}
};

__device__ __forceinline__ unsigned cvt_pk_bf16(float lo, float hi) { unsigned r; asm volatile("v_cvt_pk_bf16_f32 %0, %1, %2" : "=v"(r) : "v"(lo), "v"(hi)); return r; }
struct EpiProj {
    static constexpr bool PERM = true, AFTER_DRAIN = false;
    bf16_t* O; int ldc; const float* rowv; int mode;
    __device__ __forceinline__ void operator()(const f32x4 (&acc)[2][2][4][2], const Unit& u, int wr, int wc, int fr, int fq) const {
        const int row0 = u.pm * BM + wr * 64 + fr; const int col0 = u.pn * BM + wc * 32 + 8 * fq;
#pragma unroll
        for (int ai = 0; ai < 2; ++ai)
#pragma unroll
            for (int m = 0; m < 4; ++m) { const int row = row0 + ai * HALF + m * 16; float sc = rowv[row]; if (mode) sc = 1.0f / sqrtf(sc * (1.0f / 2048.0f) + 1e-6f);
                bf16_t* rowp = O + (size_t)row * ldc + col0;
#pragma unroll
                for (int bj = 0; bj < 2; ++bj) { const f32x4 v0 = acc[ai][bj][m][0] * sc, v1 = acc[ai][bj][m][1] * sc;
                    u32x4 w; w.x = cvt_pk_bf16(v0[0], v0[1]); w.y = cvt_pk_bf16(v0[2], v0[3]); w.z = cvt_pk_bf16(v1[0], v1[1]); w.w = cvt_pk_bf16(v1[2], v1[3]);
                    *(u32x4*)(rowp + bj * HALF) = w; } }
    }
};
struct EpiRes {
    static constexpr bool PERM = false, AFTER_DRAIN = false;
    const float* base; float* out; bf16_t* xb; float* sumsq; int ldc;
    __device__ __forceinline__ void operator()(const f32x4 (&acc)[2][2][4][2], const Unit& u, int wr, int wc, int fr, int fq) const {
        typedef unsigned u32x2v __attribute__((ext_vector_type(2)));
        const int col0 = u.pn * BM + wc * 32 + 4 * fq;
#pragma unroll
        for (int ai = 0; ai < 2; ++ai)
#pragma unroll
            for (int m = 0; m < 4; ++m) { const int row = u.pm * BM + ai * HALF + wr * 64 + m * 16 + fr; const size_t off = (size_t)row * ldc + col0; float ss = 0.f;
#pragma unroll
                for (int bj = 0; bj < 2; ++bj)
#pragma unroll
                    for (int n = 0; n < 2; ++n) { const f32x4 o = *(const f32x4*)(base + off + bj * HALF + n * 16) + acc[ai][bj][m][n];
                        *(f32x4*)(out + off + bj * HALF + n * 16) = o;
                        if (xb) { u32x2v w; w.x = cvt_pk_bf16(o[0], o[1]); w.y = cvt_pk_bf16(o[2], o[3]); *(u32x2v*)(xb + off + bj * HALF + n * 16) = w; }
                        ss += (o[0] * o[0] + o[1] * o[1]) + (o[2] * o[2] + o[3] * o[3]); }
                if (sumsq) { ss += __shfl_xor(ss, 16); ss += __shfl_xor(ss, 32); if (fq == 0) atomicAdd(sumsq + row, ss); } }
    }
};

template <class Epi, class Sched, bool ALIGN_EPI = false, bool SP2 = false>
__device__ __forceinline__ void gemm_phase(PG8_LAS unsigned char* lds, const Gemm g, const Sched& S, const Epi& E) {
    const int tid = threadIdx.x, wid = __builtin_amdgcn_readfirstlane(tid >> 6), lane = tid & 63, wr = wid >> 2, wc = wid & 3, fr = lane & 15, fq = lane >> 4;
    const int K = g.K, nt = K / BK;
    unsigned voffA[2], voffB[2];
#pragma unroll
    for (int i = 0; i < 2; ++i) { int R, C; stage_rc(tid * 16 + i * 8192, R, C); const int Rb = Epi::PERM ? ((R & ~31) + perm32(R & 31)) : R;
        voffA[i] = (unsigned)(R * K + C) * 2u; voffB[i] = (unsigned)(Rb * K + C) * 2u; }
    const size_t kstep = (size_t)(BK * 2);
    const size_t hstep = (size_t)HALF * K * 2;
    const size_t tstep = 2 * hstep;
    const unsigned ldsw = (unsigned)wid * 1024u;
    const int aoff = lds_byte(wr * 64 + fr, fq * 8), boff = lds_byte(wc * 32 + fr, fq * 8);
#define PG8_SA(b, h) (((b) * 2 + (h)) * HTB)
#define PG8_SB(b, h) ((4 + (b) * 2 + (h)) * HTB)
#define PG8_STAGE(bufoff, gbase, voff) do { _Pragma("unroll") for (int _i = 0; _i < 2; ++_i) \
        __builtin_amdgcn_global_load_lds((const unsigned*)((const char*)(gbase) + (voff)[_i]), (PG8_LAS unsigned*)(lds + (bufoff) + ldsw + _i * 8192), 16, 0, 0); } while (0)
#define PG8_LDA(dst, b, h) do { _Pragma("unroll") for (int m = 0; m < 4; ++m) _Pragma("unroll") for (int k = 0; k < 2; ++k) dst[m][k] = *(const PG8_LAS bf16x8*)(lds + PG8_SA(b, h) + aoff + m * 2048 + k * 1024); } while (0)
#define PG8_LDB(dst, b, h) do { _Pragma("unroll") for (int n = 0; n < 2; ++n) _Pragma("unroll") for (int k = 0; k < 2; ++k) dst[n][k] = *(const PG8_LAS bf16x8*)(lds + PG8_SB(b, h) + boff + n * 2048 + k * 1024); } while (0)
#define PG8_MMA(ai, bj, At, Bt) do { __builtin_amdgcn_s_setprio(1); _Pragma("unroll") for (int m = 0; m < 4; ++m) _Pragma("unroll") for (int n = 0; n < 2; ++n) _Pragma("unroll") for (int k = 0; k < 2; ++k) \
        acc[ai][bj][m][n] = __builtin_amdgcn_mfma_f32_16x16x32_bf16(Bt[n][k], At[m][k], acc[ai][bj][m][n], 0, 0, 0); __builtin_amdgcn_s_setprio(0); } while (0)
#define PG8_WAIT_V(n) asm volatile("s_waitcnt vmcnt(" #n ")" ::: "memory")
#define PG8_WAIT_L(n) asm volatile("s_waitcnt lgkmcnt(" #n ")" ::: "memory")
#define PG8_BAR __builtin_amdgcn_s_barrier()
#define PG8_SCHED __builtin_amdgcn_sched_barrier(0)
    Unit cur, nxt; int ui = 0;
    if (!S.next(0, cur)) return;
    f32x4 acc[2][2][4][2];
#pragma unroll
    for (int a = 0; a < 2; ++a)
#pragma unroll
        for (int b = 0; b < 2; ++b)
#pragma unroll
            for (int m = 0; m < 4; ++m)
#pragma unroll
                for (int n = 0; n < 2; ++n) acc[a][b][m][n] = (f32x4){0.f, 0.f, 0.f, 0.f};
    bf16x8 At[4][2], B0[2][2], B1[2][2];
    const char* cA = (const char*)g.A + (size_t)cur.pm * tstep; const char* cB = (const char*)g.Bt + (size_t)cur.pn * tstep;
    S.a_ready(cur);
    if constexpr (SP2) {
        PG8_STAGE(PG8_SB(0, 0), cB, voffB); PG8_STAGE(PG8_SB(0, 1), cB + hstep, voffB); PG8_STAGE(PG8_SA(0, 0), cA, voffA); PG8_STAGE(PG8_SA(0, 1), cA + hstep, voffA);
        if (wr == 1) PG8_BAR;
        PG8_WAIT_V(2); PG8_BAR;
        PG8_STAGE(PG8_SB(1, 0), cB + kstep, voffB); PG8_STAGE(PG8_SA(1, 0), cA + kstep, voffA); PG8_STAGE(PG8_SB(1, 1), cB + hstep + kstep, voffB);
        PG8_WAIT_V(6); PG8_BAR;
    } else {
        PG8_STAGE(PG8_SB(0, 0), cB, voffB); PG8_STAGE(PG8_SA(0, 0), cA, voffA); PG8_STAGE(PG8_SB(0, 1), cB + hstep, voffB); PG8_STAGE(PG8_SA(0, 1), cA + hstep, voffA);
        if (wr == 1) PG8_BAR;
        PG8_WAIT_V(4); PG8_BAR;
        PG8_STAGE(PG8_SB(1, 0), cB + kstep, voffB); PG8_STAGE(PG8_SA(1, 0), cA + kstep, voffA); PG8_STAGE(PG8_SB(1, 1), cB + hstep + kstep, voffB);
        PG8_WAIT_V(6); PG8_BAR;
    }
    for (;;) {
        const bool has_next = S.next(ui + 1, nxt);
        const char* nA = has_next ? (const char*)g.A + (size_t)nxt.pm * tstep : cA; const char* nB = has_next ? (const char*)g.Bt + (size_t)nxt.pn * tstep : cB;
        for (int t = 0; t < nt; t += 2) {
            const bool last = (t == nt - 2);
            const char* a1 = cA + (size_t)(t + 1) * kstep;
            const char* a2 = last ? nA : cA + (size_t)(t + 2) * kstep; const char* b2 = last ? nB : cB + (size_t)(t + 2) * kstep;
            const char* a3 = a2 + kstep; const char* b3 = b2 + kstep;
            if (last && has_next) S.a_ready(nxt);
            if constexpr (SP2) {
            PG8_LDB(B0, 0, 0); PG8_LDB(B1, 0, 1); PG8_SCHED; PG8_LDA(At, 0, 0); PG8_STAGE(PG8_SA(1, 1), a1 + hstep, voffA);
            PG8_WAIT_V(8); PG8_WAIT_L(0); PG8_BAR; PG8_MMA(0, 0, At, B0); PG8_MMA(0, 1, At, B1); PG8_BAR; PG8_SCHED;
            PG8_LDA(At, 0, 1); PG8_STAGE(PG8_SB(0, 0), b2, voffB); PG8_STAGE(PG8_SB(0, 1), b2 + hstep, voffB); PG8_STAGE(PG8_SA(0, 0), a2, voffA);
            PG8_WAIT_V(8); PG8_WAIT_L(0); PG8_BAR; PG8_MMA(1, 0, At, B0); PG8_MMA(1, 1, At, B1); PG8_BAR; PG8_SCHED;
            PG8_LDB(B0, 1, 0); PG8_LDB(B1, 1, 1); PG8_SCHED; PG8_LDA(At, 1, 0); PG8_STAGE(PG8_SA(0, 1), a2 + hstep, voffA);
            PG8_WAIT_V(8); PG8_WAIT_L(0); PG8_BAR; PG8_MMA(0, 0, At, B0); PG8_MMA(0, 1, At, B1); PG8_BAR; PG8_SCHED;
            PG8_LDA(At, 1, 1); PG8_STAGE(PG8_SB(1, 0), b3, voffB); PG8_STAGE(PG8_SB(1, 1), b3 + hstep, voffB); PG8_STAGE(PG8_SA(1, 0), a3, voffA);
            PG8_WAIT_V(8); PG8_WAIT_L(0); PG8_BAR; PG8_MMA(1, 0, At, B0); PG8_MMA(1, 1, At, B1); PG8_BAR; PG8_SCHED;
            } else {
            PG8_LDB(B0, 0, 0); PG8_SCHED; PG8_LDA(At, 0, 0); PG8_STAGE(PG8_SA(1, 1), a1 + hstep, voffA);
            PG8_WAIT_L(8); PG8_BAR; PG8_WAIT_L(0); PG8_MMA(0, 0, At, B0); PG8_BAR; PG8_SCHED;
            PG8_LDB(B1, 0, 1); PG8_STAGE(PG8_SB(0, 0), b2, voffB);
            PG8_BAR; PG8_WAIT_L(0); PG8_MMA(0, 1, At, B1); PG8_BAR;
            PG8_LDA(At, 0, 1); PG8_STAGE(PG8_SA(0, 0), a2, voffA);
            PG8_BAR; PG8_WAIT_L(0); PG8_MMA(1, 0, At, B0); PG8_BAR; PG8_SCHED;
            PG8_STAGE(PG8_SB(0, 1), b2 + hstep, voffB);
            PG8_WAIT_V(6); PG8_BAR; PG8_MMA(1, 1, At, B1); PG8_BAR;
            PG8_LDB(B0, 1, 0); PG8_SCHED; PG8_LDA(At, 1, 0); PG8_STAGE(PG8_SA(0, 1), a2 + hstep, voffA);
            PG8_WAIT_L(8); PG8_BAR; PG8_WAIT_L(0); PG8_MMA(0, 0, At, B0); PG8_BAR; PG8_SCHED;
            PG8_LDB(B1, 1, 1); PG8_STAGE(PG8_SB(1, 0), b3, voffB);
            PG8_BAR; PG8_WAIT_L(0); PG8_MMA(0, 1, At, B1); PG8_BAR;
            PG8_LDA(At, 1, 1); PG8_STAGE(PG8_SA(1, 0), a3, voffA);
            PG8_BAR; PG8_WAIT_L(0); PG8_MMA(1, 0, At, B0); PG8_BAR; PG8_SCHED;
            PG8_STAGE(PG8_SB(1, 1), b3 + hstep, voffB);
            PG8_WAIT_V(6); PG8_BAR; PG8_MMA(1, 1, At, B1); PG8_BAR;
            }
        }
        if constexpr (ALIGN_EPI) { if (wr == 0) PG8_BAR; }
        if constexpr (!Epi::AFTER_DRAIN) { E(acc, cur, wr, wc, fr, fq); S.done(cur); }
        if (!has_next) break;
#pragma unroll
        for (int a = 0; a < 2; ++a)
#pragma unroll
            for (int b = 0; b < 2; ++b)
#pragma unroll
                for (int m = 0; m < 4; ++m)
#pragma unroll
                    for (int n = 0; n < 2; ++n) acc[a][b][m][n] = (f32x4){0.f, 0.f, 0.f, 0.f};
        cur = nxt; cA = nA; cB = nB; ++ui;
        if constexpr (ALIGN_EPI) { if (wr == 1) PG8_BAR; }
    }
    PG8_WAIT_V(0);
    if constexpr (!ALIGN_EPI) { if (wr == 0) PG8_BAR; }
    PG8_BAR;
    if constexpr (Epi::AFTER_DRAIN) { E.fused(acc, cur, wr, wc, fr, fq, lds, wid, lane); S.done(cur); }
#undef PG8_SA
#undef PG8_SB
#undef PG8_STAGE
#undef PG8_LDA
#undef PG8_LDB
#undef PG8_MMA
#undef PG8_WAIT_V
#undef PG8_WAIT_L
#undef PG8_BAR
#undef PG8_SCHED
}
}
#define GAS __attribute__((address_space(1)))
#define LAS __attribute__((address_space(3)))
typedef unsigned v4u __attribute__((ext_vector_type(4)));
typedef float f32x4 __attribute__((ext_vector_type(4)));
#define LDS_WAIT() asm volatile("s_waitcnt lgkmcnt(0)" ::: "memory")
constexpr int NWAVES = 8;
constexpr int GEMM_LDS = 131072;

struct Ptrs {
    const float* in[20]; float* out; unsigned char* ws;
};
#define IN_X 0
#define IN_EV_NORM 1
#define IN_EV_WIN 2
#define IN_EV_IFB 3
#define IN_EV_QNG 4
#define IN_EV_KNG 5
#define IN_EV_REL 6
#define IN_EV_WOUT 7
#define IN_OD_NORM 8
#define IN_OD_WIN 9
#define IN_OD_CCW 10
#define IN_OD_CCB 11
#define IN_OD_GW 12
#define IN_OD_GB 13
#define IN_OD_LAM 14
#define IN_OD_CDW 15
#define IN_OD_ALOG 16
#define IN_OD_DTB 17
#define IN_OD_ONORM 18
#define IN_OD_WOUT 19

__device__ __forceinline__ float wave_sum(float v) {
#pragma unroll
    for (int o = 1; o < 64; o <<= 1) v += __shfl_xor(v, o);
    return v;
}
__device__ __forceinline__ void p0_transpose_item(const float* W, int K, int ldw, int nblk, const float* gain, bf16_t* WT, LAS float* scr, int item, int lane) {
    const int kb = item / nblk, nb = item % nblk, k0 = 64 * kb, n0 = 32 * nb;
#pragma unroll 8
    for (int i = 0; i < 32; ++i) { const int kk = 2 * i + (lane >> 5); const float g = gain ? gain[k0 + kk] : 1.0f; scr[kk * 33 + (lane & 31)] = g * W[(size_t)(k0 + kk) * ldw + n0 + (lane & 31)]; }
    LDS_WAIT(); asm volatile("" ::: "memory");
    const int c = lane & 7;
#pragma unroll
    for (int j = 0; j < 4; ++j) { const int n = (lane >> 3) + 8 * j; const LAS float* s = scr + (8 * c) * 33 + n;
        v4u o; o.x = pk2(s[0 * 33], s[1 * 33]); o.y = pk2(s[2 * 33], s[3 * 33]); o.z = pk2(s[4 * 33], s[5 * 33]); o.w = pk2(s[6 * 33], s[7 * 33]);
        *(GAS v4u*)(WT + (size_t)(n0 + n) * K + k0 + 8 * c) = o; }
    LDS_WAIT(); asm volatile("" ::: "memory");
}
__device__ __forceinline__ void phase_prologue(const Ptrs& P, LAS unsigned char* lds, int wave, int lane, int gw, int NGW) {
    unsigned char* ws = P.ws;
    bf16_t* W1T = (bf16_t*)(ws + WS_W1T); bf16_t* W2T = (bf16_t*)(ws + WS_W2T); bf16_t* W3T = (bf16_t*)(ws + WS_W3T); bf16_t* W4T = (bf16_t*)(ws + WS_W4T);
    bf16_t* XB = (bf16_t*)(ws + WS_XB); float* R0 = (float*)(ws + WS_R0); float* SS1 = (float*)(ws + WS_SS1); float* GIF = (float*)(ws + WS_GIF);
    LAS float* scr = (LAS float*)(lds + wave * 16384);
    constexpr int I1 = (D_MODEL / 64) * (EV_N / 32), I2 = (D_MODEL / 64) * (D_MODEL / 32), I3 = (D_MODEL / 64) * (OD_N / 32), I4 = I2, NITEMS = I1 + I2 + I3 + I4;
    for (int it = gw; it < NITEMS; it += NGW) {
        int r = it;
        if (r < I1) { p0_transpose_item(P.in[IN_EV_WIN], D_MODEL, EV_IN, EV_N / 32, P.in[IN_EV_NORM], W1T, scr, r, lane); continue; } r -= I1;
        if (r < I2) { p0_transpose_item(P.in[IN_EV_WOUT], D_MODEL, D_MODEL, D_MODEL / 32, nullptr, W2T, scr, r, lane); continue; } r -= I2;
        if (r < I3) { p0_transpose_item(P.in[IN_OD_WIN], D_MODEL, OD_IN, OD_N / 32, P.in[IN_OD_NORM], W3T, scr, r, lane); continue; } r -= I3;
        p0_transpose_item(P.in[IN_OD_WOUT], D_MODEL, D_MODEL, D_MODEL / 32, nullptr, W4T, scr, r, lane);
    }
    { const int gt = gw * 64 + lane, NT = NGW * 64;
      for (int e = gt; e < 16 * D_MODEL; e += NT) { const int j = e / D_MODEL, k = e % D_MODEL; W3T[(size_t)(OD_N + j) * D_MODEL + k] = (bf16_t)f2bf(P.in[IN_OD_NORM][k] * P.in[IN_OD_WIN][(size_t)k * OD_IN + OD_N + j]); }
      for (int e = gt; e < M_TOK; e += NT) SS1[e] = 0.f; }
    __syncthreads();
    LAS float* G8 = (LAS float*)lds;
    for (int e = threadIdx.x; e < D_MODEL * 8; e += NWAVES * 64) { const int k = e >> 3, j = e & 7; G8[e] = P.in[IN_EV_NORM][k] * P.in[IN_EV_WIN][(size_t)k * EV_IN + EV_N + j]; }
    __syncthreads();
    const float* X = P.in[IN_X];
    for (int m = gw; m < M_TOK; m += NGW) {
        const GAS f32x4* xr = (const GAS f32x4*)(X + (size_t)m * D_MODEL) + lane;
        float s = 0.f;
        GAS unsigned long long* o8 = (GAS unsigned long long*)(XB + (size_t)m * D_MODEL) + lane;
#pragma unroll
        for (int j = 0; j < 8; ++j) { const f32x4 v = xr[64 * j]; s += (v.x * v.x + v.y * v.y) + (v.z * v.z + v.w * v.w);
            o8[64 * j] = (unsigned long long)pk2(v.x, v.y) | ((unsigned long long)pk2(v.z, v.w) << 32); }
        const float r0 = 1.0f / sqrtf(wave_sum(s) * (1.0f / D_MODEL) + EPS);
        float g[8];
#pragma unroll
        for (int i = 0; i < 8; ++i) g[i] = 0.f;
#pragma unroll 1
        for (int j = 0; j < 8; ++j) {
            const f32x4 v = xr[64 * j];
#pragma unroll
            for (int e = 0; e < 4; ++e) { const int k = 4 * lane + 256 * j + e; const f32x4 ga = *(const LAS f32x4*)(G8 + k * 8), gb = *(const LAS f32x4*)(G8 + k * 8 + 4); const float xv = v[e];
                g[0] += xv * ga.x; g[1] += xv * ga.y; g[2] += xv * ga.z; g[3] += xv * ga.w; g[4] += xv * gb.x; g[5] += xv * gb.y; g[6] += xv * gb.z; g[7] += xv * gb.w; }
        }
#pragma unroll
        for (int i = 0; i < 8; ++i) g[i] = wave_sum(g[i]);
        if (lane == 0) R0[m] = r0;
        if (lane < 8) { float gv = g[0];
#pragma unroll
            for (int i = 1; i < 8; ++i) gv = (lane == i) ? g[i] : gv;
            GIF[(size_t)m * 8 + lane] = r0 * gv + P.in[IN_EV_IFB][lane]; }
    }
}

__device__ __forceinline__ void ld8bf(const bf16_t* p, float (&v)[8]) {
    const v4u w = *(const v4u*)p;
    v[0] = __builtin_bit_cast(float, w.x << 16); v[1] = __builtin_bit_cast(float, w.x & 0xffff0000u);
    v[2] = __builtin_bit_cast(float, w.y << 16); v[3] = __builtin_bit_cast(float, w.y & 0xffff0000u);
    v[4] = __builtin_bit_cast(float, w.z << 16); v[5] = __builtin_bit_cast(float, w.z & 0xffff0000u);
    v[6] = __builtin_bit_cast(float, w.w << 16); v[7] = __builtin_bit_cast(float, w.w & 0xffff0000u);
}
__global__ void __launch_bounds__(256) k_attn_naive(const bf16_t* __restrict__ PROJ, const float* __restrict__ qn_g, const float* __restrict__ kn_g, const float* __restrict__ rel_bias, bf16_t* __restrict__ Y) {
    __shared__ float qs[16][128];
    __shared__ float S[16][577];
    const int bid = blockIdx.x, quarter = bid & 3, c = (bid >> 2) & 31, h = (bid >> 7) & 7, b = bid >> 10, t = threadIdx.x;
    { const int r = t >> 4, sub = t & 15; const int tok = b * SEQ + c * 64 + quarter * 16 + r;
      float v[8]; ld8bf(PROJ + (size_t)tok * EV_N + EC_QA + h * 128 + sub * 8, v);
      float ss = 0.f;
#pragma unroll
      for (int i = 0; i < 8; ++i) ss += v[i] * v[i];
      ss += __shfl_xor(ss, 1); ss += __shfl_xor(ss, 2); ss += __shfl_xor(ss, 4); ss += __shfl_xor(ss, 8);
      const float rs = 1.0f / sqrtf(ss * (1.0f / 128.0f) + EPS);
#pragma unroll
      for (int i = 0; i < 8; ++i) qs[r][sub * 8 + i] = v[i] * rs * qn_g[sub * 8 + i] * 0.08838834764831845f; }
    __syncthreads();
    for (int idx = t; idx < 16 * BAND; idx += 256) {
        const int r = idx / BAND, j = idx % BAND; const int kc = c - LOOKBACK + (j >> 6);
        float s;
        if (kc < 0) s = -1e30f;
        else { const bf16_t* kp = PROJ + (size_t)(b * SEQ + kc * 64 + (j & 63)) * EV_N + EC_KA + h * 128;
            float ss = 0.f, dot = 0.f;
            for (int d = 0; d < 128; d += 8) { float kv[8]; ld8bf(kp + d, kv);
#pragma unroll
                for (int i = 0; i < 8; ++i) { ss += kv[i] * kv[i]; dot += kv[i] * kn_g[d + i] * qs[r][d + i]; } }
            s = dot * (1.0f / sqrtf(ss * (1.0f / 128.0f) + EPS));
            const int qi = quarter * 16 + r; int rel = LOOKBACK * CHUNK + qi - j; rel = rel < -REL_MAX ? -REL_MAX : (rel > REL_MAX ? REL_MAX : rel); rel += REL_MAX;
            s += rel_bias[h * NREL + rel]; }
        S[r][j] = s;
    }
    __syncthreads();
    { const int r = t >> 4, sub = t & 15; float mx = -3.0e38f;
      for (int j = sub; j < BAND; j += 16) mx = fmaxf(mx, S[r][j]);
      mx = fmaxf(mx, __shfl_xor(mx, 1)); mx = fmaxf(mx, __shfl_xor(mx, 2)); mx = fmaxf(mx, __shfl_xor(mx, 4)); mx = fmaxf(mx, __shfl_xor(mx, 8));
      float sum = 0.f;
      for (int j = sub; j < BAND; j += 16) { const float e = expf(S[r][j] - mx); S[r][j] = e; sum += e; }
      sum += __shfl_xor(sum, 1); sum += __shfl_xor(sum, 2); sum += __shfl_xor(sum, 4); sum += __shfl_xor(sum, 8);
      const float inv = 1.0f / sum;
      for (int j = sub; j < BAND; j += 16) S[r][j] *= inv; }
    __syncthreads();
    { const int r = t >> 4, dg = t & 15; float acc[8];
#pragma unroll
      for (int i = 0; i < 8; ++i) acc[i] = 0.f;
      for (int j = 0; j < BAND; ++j) { const int kc = c - LOOKBACK + (j >> 6); if (kc < 0) continue;
          const float p = S[r][j]; float vv[8]; ld8bf(PROJ + (size_t)(b * SEQ + kc * 64 + (j & 63)) * EV_N + EC_VA + h * 128 + dg * 8, vv);
#pragma unroll
          for (int i = 0; i < 8; ++i) acc[i] += p * vv[i]; }
      const int tok = b * SEQ + c * 64 + quarter * 16 + r; float z[8]; ld8bf(PROJ + (size_t)tok * EV_N + EC_ZA + h * 128 + dg * 8, z);
      v4u o; o.x = pk2(acc[0] * siluf_(z[0]), acc[1] * siluf_(z[1])); o.y = pk2(acc[2] * siluf_(z[2]), acc[3] * siluf_(z[3]));
      o.z = pk2(acc[4] * siluf_(z[4]), acc[5] * siluf_(z[5])); o.w = pk2(acc[6] * siluf_(z[6]), acc[7] * siluf_(z[7]));
      *(v4u*)(Y + (size_t)tok * D_MODEL + h * 128 + dg * 8) = o; }
}
__global__ void __launch_bounds__(256) k_mlstm_naive(const bf16_t* __restrict__ PROJ, const float* __restrict__ GIF, bf16_t* __restrict__ Y) {
    __shared__ float ks[256], qs[256], part[4][64], dpart[4];
    const int bid = blockIdx.x, vs = bid & 3, h = (bid >> 2) & 3, b = bid >> 4, t = threadIdx.x, v = t & 63, kq = t >> 6;
    float C[64];
#pragma unroll
    for (int i = 0; i < 64; ++i) C[i] = 0.f;
    float nreg = 0.f;
    for (int s = 0; s < SEQ; ++s) {
        const size_t tok = (size_t)b * SEQ + s; const bf16_t* pr = PROJ + tok * EV_N;
        const float li = GIF[tok * 8 + h], fpre = GIF[tok * 8 + 4 + h];
        const float fw = sigmoidf_(fpre), iw = expf(li);
        const float kk = bf2f(pr[EC_KB + h * 256 + t]), qq = bf2f(pr[EC_QB + h * 256 + t]) * 0.0625f;
        const float vv = bf2f(pr[EC_VB + h * 256 + vs * 64 + v]);
        ks[t] = kk; qs[t] = qq;
        nreg = fw * nreg + iw * kk;
        float dp = nreg * qq; dp = wave_sum(dp);
        if ((t & 63) == 0) dpart[kq] = dp;
        __syncthreads();
        float np = 0.f; const float iv = iw * vv;
#pragma unroll
        for (int i = 0; i < 64; ++i) { C[i] = fw * C[i] + ks[kq * 64 + i] * iv; np += C[i] * qs[kq * 64 + i]; }
        part[kq][v] = np;
        __syncthreads();
        if (t < 64) { const float num = (part[0][t] + part[1][t]) + (part[2][t] + part[3][t]); const float den = (dpart[0] + dpart[1]) + (dpart[2] + dpart[3]);
            const float hh = num / fmaxf(fabsf(den), 1.0f);
            const float ob = bf2f(pr[EC_OB + h * 256 + vs * 64 + t]), zb = bf2f(pr[EC_ZB + h * 256 + vs * 64 + t]);
            Y[tok * D_MODEL + W_A + h * 256 + vs * 64 + t] = (bf16_t)f2bf(sigmoidf_(ob) * hh * siluf_(zb)); }
        __syncthreads();
    }
}
__global__ void __launch_bounds__(128) k_rglru_gates(const bf16_t* __restrict__ PROJ, const float* __restrict__ ccw, const float* __restrict__ ccb, const float* __restrict__ gw, const float* __restrict__ gb,
                                                     const float* __restrict__ lam, float* __restrict__ A, float* __restrict__ INP) {
    __shared__ float xs[8][128];
    const int blk = blockIdx.x & 7, tg = blockIdx.x >> 3, t = threadIdx.x, c = blk * 128 + t;
    float xc[8];
#pragma unroll
    for (int i = 0; i < 8; ++i) { const int tok = tg * 8 + i, s = tok % SEQ; float a = ccb[c];
#pragma unroll
        for (int j = 0; j < 4; ++j) { const int sj = s - 3 + j; if (sj >= 0) a += ccw[j * W_C + c] * bf2f(PROJ[(size_t)(tok - 3 + j) * OD_N + OC_XC + c]); }
        xc[i] = a; xs[i][t] = a; }
    __syncthreads();
    float rp[8], ip[8];
#pragma unroll
    for (int i = 0; i < 8; ++i) { rp[i] = 0.f; ip[i] = 0.f; }
    const float* g0 = gw + (size_t)blk * 128 * 256;
    for (int k = 0; k < 128; ++k) { const float wr_ = g0[k * 256 + t], wi_ = g0[k * 256 + 128 + t];
#pragma unroll
        for (int i = 0; i < 8; ++i) { const float xv = xs[i][k]; rp[i] += xv * wr_; ip[i] += xv * wi_; } }
    const float sp = softplusf_(-lam[c]); const float gbr = gb[c], gbi = gb[W_C + c];
#pragma unroll
    for (int i = 0; i < 8; ++i) { const int tok = tg * 8 + i; const float r = sigmoidf_(rp[i] + gbr), ig = sigmoidf_(ip[i] + gbi);
        const float la = -8.0f * r * sp; A[(size_t)tok * W_C + c] = expf(la); INP[(size_t)tok * W_C + c] = sqrtf(-expm1f(2.0f * la)) * (ig * xc[i]); }
}
__global__ void __launch_bounds__(256) k_rglru_scan(const bf16_t* __restrict__ PROJ, const float* __restrict__ A, const float* __restrict__ INP, bf16_t* __restrict__ Y) {
    const int gid = blockIdx.x * 256 + threadIdx.x, b = gid / W_C, c = gid % W_C; float h = 0.f;
    for (int s = 0; s < SEQ; ++s) { const size_t tok = (size_t)b * SEQ + s; h = A[tok * W_C + c] * h + INP[tok * W_C + c];
        Y[tok * D_MODEL + c] = (bf16_t)f2bf(h * siluf_(bf2f(PROJ[tok * OD_N + OC_ZC + c]))); }
}
__global__ void __launch_bounds__(256) k_gates_ab(const bf16_t* __restrict__ XB, const bf16_t* __restrict__ W3T, const float* __restrict__ SS1, float* __restrict__ AB) {
    const int t = threadIdx.x, row = blockIdx.x * 16 + (t >> 4), j = t & 15;
    const bf16_t* xp = XB + (size_t)row * D_MODEL; const bf16_t* wp = W3T + (size_t)(OD_N + j) * D_MODEL; float acc = 0.f;
    for (int k = 0; k < D_MODEL; k += 8) { float a[8], w[8]; ld8bf(xp + k, a); ld8bf(wp + k, w);
#pragma unroll
        for (int i = 0; i < 8; ++i) acc += a[i] * w[i]; }
    AB[(size_t)row * 16 + j] = acc * (1.0f / sqrtf(SS1[row] * (1.0f / D_MODEL) + EPS));
}
__global__ void __launch_bounds__(128) k_dn_prep(const bf16_t* __restrict__ PROJ, const float* __restrict__ cdw, float* __restrict__ Q2, float* __restrict__ K2, float* __restrict__ V2) {
    __shared__ float red[2][2];
    const int h = blockIdx.x & 7, tok = blockIdx.x >> 3, s = tok % SEQ, t = threadIdx.x; float o[3];
#pragma unroll
    for (int p = 0; p < 3; ++p) { const int col = p * W_D + h * 128 + t; float a = 0.f;
#pragma unroll
        for (int j = 0; j < 4; ++j) { const int sj = s - 3 + j; if (sj >= 0) a += cdw[j * 3 * W_D + col] * bf2f(PROJ[(size_t)(tok - 3 + j) * OD_N + OC_QD + col]); }
        o[p] = siluf_(a); }
    float sq = wave_sum(o[0] * o[0]), sk = wave_sum(o[1] * o[1]);
    if ((t & 63) == 0) { red[t >> 6][0] = sq; red[t >> 6][1] = sk; }
    __syncthreads();
    sq = red[0][0] + red[1][0]; sk = red[0][1] + red[1][1];
    const size_t o_ = (size_t)tok * W_D + h * 128 + t;
    Q2[o_] = o[0] * (1.0f / sqrtf(sq + EPS)); K2[o_] = o[1] * (1.0f / sqrtf(sk + EPS)); V2[o_] = o[2];
}
__global__ void __launch_bounds__(256) k_dn_scan(const bf16_t* __restrict__ PROJ, const float* __restrict__ Q2, const float* __restrict__ K2, const float* __restrict__ V2, const float* __restrict__ AB,
                                                 const float* __restrict__ a_log, const float* __restrict__ dt_bias, const float* __restrict__ onorm, bf16_t* __restrict__ Y) {
    __shared__ float ks[128], qs[128], part[2][128], red[2];
    const int h = blockIdx.x & 7, b = blockIdx.x >> 3, t = threadIdx.x, v = t & 127, kh = t >> 7;
    float S[64];
#pragma unroll
    for (int i = 0; i < 64; ++i) S[i] = 0.f;
    const float Aexp = expf(a_log[h]), dtb = dt_bias[h], og = onorm[v];
    for (int s = 0; s < SEQ; ++s) {
        const size_t tok = (size_t)b * SEQ + s; const size_t o_ = tok * W_D + h * 128;
        if (t < 128) ks[t] = K2[o_ + t]; else qs[t - 128] = Q2[o_ + t - 128] * 0.08838834764831845f;
        const float vv = V2[o_ + v];
        const float beta = sigmoidf_(AB[tok * 16 + 8 + h]); const float g = -Aexp * softplusf_(AB[tok * 16 + h] + dtb); const float al = expf(g);
        __syncthreads();
        float rp = 0.f;
#pragma unroll
        for (int i = 0; i < 64; ++i) rp += S[i] * ks[kh * 64 + i];
        part[kh][v] = rp;
        __syncthreads();
        const float r = part[0][v] + part[1][v];
        const float u = beta * (vv - al * r);
        float op = 0.f;
#pragma unroll
        for (int i = 0; i < 64; ++i) { S[i] = al * S[i] + ks[kh * 64 + i] * u; op += S[i] * qs[kh * 64 + i]; }
        __syncthreads();
        part[kh][v] = op;
        __syncthreads();
        const float o = part[0][v] + part[1][v];
        float sq = (t < 128) ? o * o : 0.f; sq = wave_sum(sq);
        if (t == 0) red[0] = sq; if (t == 64) red[1] = sq;
        __syncthreads();
        if (t < 128) { const float ms = (red[0] + red[1]) * (1.0f / 128.0f);
            const float zd = bf2f(PROJ[tok * OD_N + OC_ZD + h * 128 + t]);
            Y[tok * D_MODEL + W_C + h * 128 + t] = (bf16_t)f2bf(o * (1.0f / sqrtf(ms + EPS)) * og * siluf_(zd)); }
    }
}

__global__ void __launch_bounds__(512) k_prologue(Ptrs P) {
    extern __shared__ __attribute__((aligned(16))) unsigned char lds[];
    const int tid = threadIdx.x, lane = tid & 63, wave = __builtin_amdgcn_readfirstlane(tid >> 6);
    phase_prologue(P, (LAS unsigned char*)lds, wave, lane, blockIdx.x * NWAVES + wave, gridDim.x * NWAVES);
}
template <int WHICH> __device__ __forceinline__ void phase_gemm(const Ptrs& P, LAS unsigned char* lds, int G, int c) {
    unsigned char* ws = P.ws;
    bf16_t* W1T = (bf16_t*)(ws + WS_W1T); bf16_t* W2T = (bf16_t*)(ws + WS_W2T); bf16_t* W3T = (bf16_t*)(ws + WS_W3T); bf16_t* W4T = (bf16_t*)(ws + WS_W4T);
    bf16_t* XB = (bf16_t*)(ws + WS_XB); bf16_t* YB = (bf16_t*)(ws + WS_Y); bf16_t* PROJ = (bf16_t*)(ws + WS_PROJ);
    float* R0 = (float*)(ws + WS_R0); float* SS1 = (float*)(ws + WS_SS1);
    if constexpr (WHICH == 1) { pg8::Gemm g{XB, W1T, M_TOK, EV_N, D_MODEL}; pg8::EpiProj E{PROJ, EV_N, R0, 0}; pg8::StaticOrder S; S.init(g.M, g.N, G, c);
        pg8::gemm_phase<pg8::EpiProj, pg8::StaticOrder, true, true>(lds, g, S, E); }
    if constexpr (WHICH == 2) { pg8::Gemm g{YB, W2T, M_TOK, D_MODEL, D_MODEL}; pg8::EpiRes E{P.in[IN_X], P.out, XB, SS1, D_MODEL}; pg8::StaticOrder S; S.init(g.M, g.N, G, c);
        pg8::gemm_phase<pg8::EpiRes, pg8::StaticOrder, true, true>(lds, g, S, E); }
    if constexpr (WHICH == 3) { pg8::Gemm g{XB, W3T, M_TOK, OD_N, D_MODEL}; pg8::EpiProj E{PROJ, OD_N, SS1, 1}; pg8::StaticOrder S; S.init(g.M, g.N, G, c);
        pg8::gemm_phase<pg8::EpiProj, pg8::StaticOrder, true, true>(lds, g, S, E); }
    if constexpr (WHICH == 4) { pg8::Gemm g{YB, W4T, M_TOK, D_MODEL, D_MODEL}; pg8::EpiRes E{P.out, P.out, nullptr, nullptr, D_MODEL}; pg8::StaticOrder S; S.init(g.M, g.N, G, c);
        pg8::gemm_phase<pg8::EpiRes, pg8::StaticOrder, true, true>(lds, g, S, E); }
}
template <int WHICH> __global__ void __launch_bounds__(512, 2) k_gemm(Ptrs P) {
    extern __shared__ __attribute__((aligned(16))) unsigned char lds[];
    phase_gemm<WHICH>(P, (LAS unsigned char*)lds, gridDim.x, blockIdx.x);
}

extern "C" void kernel_launch(void* const* d_in, const int* in_sizes, int n_in, void* d_out, int out_size, void* d_ws, size_t ws_size, hipStream_t stream) {
    static int grid = 0;
    if (grid == 0) {
        if (n_in != 20 || in_sizes[0] != M_TOK * D_MODEL || out_size != M_TOK * D_MODEL || ws_size < WS_END) {
            fprintf(stderr, "kernel_launch: unexpected shapes: n_in %d in0 %d out %d ws %zu (need %zu)\n", n_in, n_in > 0 ? in_sizes[0] : -1, out_size, ws_size, (size_t)WS_END); grid = -1; return; }
        int dev = 0, cus = 0;
        if (hipGetDevice(&dev) != hipSuccess || hipDeviceGetAttribute(&cus, hipDeviceAttributeMultiprocessorCount, dev) != hipSuccess) { grid = -1; return; }
        (void)hipFuncSetAttribute((const void*)k_prologue, hipFuncAttributeMaxDynamicSharedMemorySize, GEMM_LDS);
        (void)hipFuncSetAttribute((const void*)k_gemm<1>, hipFuncAttributeMaxDynamicSharedMemorySize, GEMM_LDS);
        (void)hipFuncSetAttribute((const void*)k_gemm<2>, hipFuncAttributeMaxDynamicSharedMemorySize, GEMM_LDS);
        (void)hipFuncSetAttribute((const void*)k_gemm<3>, hipFuncAttributeMaxDynamicSharedMemorySize, GEMM_LDS);
        (void)hipFuncSetAttribute((const void*)k_gemm<4>, hipFuncAttributeMaxDynamicSharedMemorySize, GEMM_LDS);
        (void)hipGetLastError();
        grid = cus;
    }
    if (grid < 0) return;
    Ptrs P{};
    for (int i = 0; i < 20; ++i) P.in[i] = (const float*)d_in[i];
    P.out = (float*)d_out; P.ws = (unsigned char*)d_ws;
    unsigned char* ws = (unsigned char*)d_ws;
    bf16_t* W3T = (bf16_t*)(ws + WS_W3T);
    bf16_t* XB = (bf16_t*)(ws + WS_XB); bf16_t* YB = (bf16_t*)(ws + WS_Y); bf16_t* PROJ = (bf16_t*)(ws + WS_PROJ);
    float* SS1 = (float*)(ws + WS_SS1); float* GIF = (float*)(ws + WS_GIF); float* AB = (float*)(ws + WS_AB);
    const float* const* in = P.in;
    hipLaunchKernelGGL(k_prologue, dim3(grid), dim3(512), GEMM_LDS, stream, P);
    hipLaunchKernelGGL(k_gemm<1>, dim3(grid), dim3(512), GEMM_LDS, stream, P);
    hipLaunchKernelGGL(k_attn_naive, dim3(BATCH * H_A * NCH * 4), dim3(256), 0, stream, PROJ, in[IN_EV_QNG], in[IN_EV_KNG], in[IN_EV_REL], YB);
    hipLaunchKernelGGL(k_mlstm_naive, dim3(BATCH * H_B * 4), dim3(256), 0, stream, PROJ, GIF, YB);
    hipLaunchKernelGGL(k_gemm<2>, dim3(grid), dim3(512), GEMM_LDS, stream, P);
    hipLaunchKernelGGL(k_gemm<3>, dim3(grid), dim3(512), GEMM_LDS, stream, P);
    hipLaunchKernelGGL(k_gates_ab, dim3(M_TOK / 16), dim3(256), 0, stream, XB, W3T, SS1, AB);
    { float* A = (float*)(ws + WS_FREE1); float* INP = (float*)(ws + WS_XB);
      hipLaunchKernelGGL(k_rglru_gates, dim3(M_TOK / 8 * 8), dim3(128), 0, stream, PROJ, in[IN_OD_CCW], in[IN_OD_CCB], in[IN_OD_GW], in[IN_OD_GB], in[IN_OD_LAM], A, INP);
      hipLaunchKernelGGL(k_rglru_scan, dim3(BATCH * W_C / 256), dim3(256), 0, stream, PROJ, A, INP, YB);
      float* Q2 = (float*)(ws + WS_XB); float* K2 = (float*)(ws + WS_FREE1); float* V2 = (float*)(ws + WS_W1T);
      hipLaunchKernelGGL(k_dn_prep, dim3(M_TOK * H_D), dim3(128), 0, stream, PROJ, in[IN_OD_CDW], Q2, K2, V2);
      hipLaunchKernelGGL(k_dn_scan, dim3(BATCH * H_D), dim3(256), 0, stream, PROJ, Q2, K2, V2, AB, in[IN_OD_ALOG], in[IN_OD_DTB], in[IN_OD_ONORM], YB); }
    hipLaunchKernelGGL(k_gemm<4>, dim3(grid), dim3(512), GEMM_LDS, stream, P);
}
```

```cpp
#include <hip/hip_runtime.h>
#include <cstdio>
#include <cstdint>
#include <cmath>

constexpr int D_MODEL = 2048, BATCH = 8, SEQ = 2048, M_TOK = BATCH * SEQ;
constexpr int CHUNK = 64, NCH = SEQ / CHUNK;
constexpr float EPS = 1e-6f;
constexpr int HD_A = 128, W_A = 1024, H_A = 8, LOOKBACK = 8, BAND = (LOOKBACK + 1) * CHUNK, REL_MAX = 256, NREL = 2 * REL_MAX + 1;
constexpr int H_B = 4, W_B = 1024, HD_B = 256;
constexpr int W_C = 1024, N_BLK_C = 8, BLK_C = 128;
constexpr int HD_D = 128, W_D = 1024, H_D = 8;
constexpr int EV_IN = 9224, EV_N = 9216;
constexpr int OD_IN = 6160, OD_N = 6144;
constexpr int EC_QA = 0, EC_KA = 1024, EC_VA = 2048, EC_ZA = 3072, EC_QB = 4096, EC_KB = 5120, EC_VB = 6144, EC_OB = 7168, EC_ZB = 8192;
constexpr int OC_XC = 0, OC_ZC = 1024, OC_QD = 2048, OC_KD = 3072, OC_VD = 4096, OC_ZD = 5120;

constexpr size_t MiB = 1u << 20;
constexpr size_t WS_CTL = 0, CTL_ZERO_BYTES = 1 * MiB;
constexpr size_t WS_R0 = 1 * MiB;
constexpr size_t WS_SS1 = WS_R0 + 64 * 1024;
constexpr size_t WS_GIF = WS_SS1 + 64 * 1024;
constexpr size_t WS_AB = WS_GIF + 512 * 1024;
constexpr size_t WS_W1T = 4 * MiB;
constexpr size_t WS_W2T = 40 * MiB;
constexpr size_t WS_W3T = 48 * MiB;
constexpr size_t WS_W4T = 73 * MiB;
constexpr size_t WS_XB = 81 * MiB;
constexpr size_t WS_Y = 145 * MiB;
constexpr size_t WS_PROJ = 209 * MiB;
constexpr size_t WS_END = 497 * MiB;
constexpr size_t WS_FREE1 = 401 * MiB;

typedef unsigned short bf16_t;
__device__ __forceinline__ float bf2f(unsigned short v) { return __builtin_bit_cast(float, (unsigned)v << 16); }
__device__ __forceinline__ unsigned f2bf(float f) { unsigned u = __builtin_bit_cast(unsigned, f); return (u + 0x7fffu + ((u >> 16) & 1u)) >> 16; }
__device__ __forceinline__ unsigned pk2(float lo, float hi) { return f2bf(lo) | (f2bf(hi) << 16); }
__device__ __forceinline__ float sigmoidf_(float x) { return 1.f / (1.f + expf(-x)); }
__device__ __forceinline__ float siluf_(float x) { return x / (1.f + expf(-x)); }
__device__ __forceinline__ float softplusf_(float x) { return fmaxf(x, 0.f) + log1pf(expf(-fabsf(x))); }
__device__ __forceinline__ float logsigmoidf_(float x) { return -softplusf_(-x); }

namespace pg8 {
#define PG8_LAS __attribute__((address_space(3)))
typedef unsigned short bf16_t;
typedef short bf16x8 __attribute__((ext_vector_type(8)));
typedef float f32x4 __attribute__((ext_vector_type(4)));
typedef unsigned u32x4 __attribute__((ext_vector_type(4)));
constexpr int BM = 256, BK = 64, HALF = 128, HTB = HALF * BK * 2  , STAGE_BYTES = 8 * HTB, NXCD = 8, WGM = 8;

__host__ __device__ __forceinline__ int lds_byte(int r, int c) { const int st = (r >> 4) * 2 + (c >> 5), rr = r & 15, cc = c & 31, ob = rr * 64 + cc * 2; return st * 1024 + (ob ^ (((ob >> 9) & 1) << 5)); }
__host__ __device__ __forceinline__ void stage_rc(int b, int& R, int& C) { const int st = b / 1024, sb = b % 1024, swz = sb ^ (((sb >> 9) & 1) << 5); R = (st >> 1) * 16 + swz / 64; C = (st & 1) * 32 + (swz % 64) / 2; }
__host__ __device__ __forceinline__ int perm32(int rho) { const int n = rho >> 4, i = rho & 15; return 8 * (i >> 2) + 4 * n + (i & 3); }

struct Unit { int pm, pn; };
struct Gemm { const bf16_t* A; const bf16_t* Bt; int M, N, K; };

struct StaticOrder {
    int nM, nN, nwg, G, c;
    __host__ __device__ void init(int M, int N, int G_, int c_) { nM = M / BM; nN = N / BM; nwg = nM * nN; G = G_; c = c_; }
    __host__ __device__ bool next(int i, Unit& u) const {
        const long L = (long)i * G + c; if (L >= nwg) return false;
        int wgid = (int)L; { const int q = nwg / NXCD, r = nwg % NXCD, xcd = wgid % NXCD, off = wgid / NXCD; wgid = (xcd < r ? xcd * (q + 1) : r * (q + 1) + (xcd - r) * q) + off; }
        const int nig = WGM * nN, gid = wgid / nig, fm = gid * WGM, gsz = (nM - fm) < WGM ? (nM - fm) : WGM;
        u.pm = fm + ((wgid % nig) % gsz); u.pn = (wgid % nig) / gsz; return true;
    }
    __device__ __forceinline__ void a_ready(const Unit&) const {}
    __device__ __forceinline__ void done(const Unit&) const {}
};

__device__ __forceinline__ unsigned cvt_pk_bf16(float lo, float hi) { unsigned r; asm volatile("v_cvt_pk_bf16_f32 %0, %1, %2" : "=v"(r) : "v"(lo), "v"(hi)); return r; }
struct EpiProj {
    static constexpr bool PERM = true, AFTER_DRAIN = false;
    bf16_t* O; int ldc; const float* rowv; int mode;
    __device__ __forceinline__ void operator()(const f32x4 (&acc)[2][2][4][2], const Unit& u, int wr, int wc, int fr, int fq) const {
        const int row0 = u.pm * BM + wr * 64 + fr; const int col0 = u.pn * BM + wc * 32 + 8 * fq;
#pragma unroll
        for (int ai = 0; ai < 2; ++ai)
#pragma unroll
            for (int m = 0; m < 4; ++m) { const int row = row0 + ai * HALF + m * 16; float sc = rowv[row]; if (mode) sc = 1.0f / sqrtf(sc * (1.0f / 2048.0f) + 1e-6f);
                bf16_t* rowp = O + (size_t)row * ldc + col0;
#pragma unroll
                for (int bj = 0; bj < 2; ++bj) { const f32x4 v0 = acc[ai][bj][m][0] * sc, v1 = acc[ai][bj][m][1] * sc;
                    u32x4 w; w.x = cvt_pk_bf16(v0[0], v0[1]); w.y = cvt_pk_bf16(v0[2], v0[3]); w.z = cvt_pk_bf16(v1[0], v1[1]); w.w = cvt_pk_bf16(v1[2], v1[3]);
                    *(u32x4*)(rowp + bj * HALF) = w; } }
    }
};
struct EpiRes {
    static constexpr bool PERM = false, AFTER_DRAIN = false;
    const float* base; float* out; bf16_t* xb; float* sumsq; int ldc;
    __device__ __forceinline__ void operator()(const f32x4 (&acc)[2][2][4][2], const Unit& u, int wr, int wc, int fr, int fq) const {
        typedef unsigned u32x2v __attribute__((ext_vector_type(2)));
        const int col0 = u.pn * BM + wc * 32 + 4 * fq;
#pragma unroll
        for (int ai = 0; ai < 2; ++ai)
#pragma unroll
            for (int m = 0; m < 4; ++m) { const int row = u.pm * BM + ai * HALF + wr * 64 + m * 16 + fr; const size_t off = (size_t)row * ldc + col0; float ss = 0.f;
#pragma unroll
                for (int bj = 0; bj < 2; ++bj)
#pragma unroll
                    for (int n = 0; n < 2; ++n) { const f32x4 o = *(const f32x4*)(base + off + bj * HALF + n * 16) + acc[ai][bj][m][n];
                        *(f32x4*)(out + off + bj * HALF + n * 16) = o;
                        if (xb) { u32x2v w; w.x = cvt_pk_bf16(o[0], o[1]); w.y = cvt_pk_bf16(o[2], o[3]); *(u32x2v*)(xb + off + bj * HALF + n * 16) = w; }
                        ss += (o[0] * o[0] + o[1] * o[1]) + (o[2] * o[2] + o[3] * o[3]); }
                if (sumsq) { ss += __shfl_xor(ss, 16); ss += __shfl_xor(ss, 32); if (fq == 0) atomicAdd(sumsq + row, ss); } }
    }
};

template <class Epi, class Sched, bool ALIGN_EPI = false, bool SP2 = false>
__device__ __forceinline__ void gemm_phase(PG8_LAS unsigned char* lds, const Gemm g, const Sched& S, const Epi& E) {
    const int tid = threadIdx.x, wid = __builtin_amdgcn_readfirstlane(tid >> 6), lane = tid & 63, wr = wid >> 2, wc = wid & 3, fr = lane & 15, fq = lane >> 4;
    const int K = g.K, nt = K / BK;
    unsigned voffA[2], voffB[2];
#pragma unroll
    for (int i = 0; i < 2; ++i) { int R, C; stage_rc(tid * 16 + i * 8192, R, C); const int Rb = Epi::PERM ? ((R & ~31) + perm32(R & 31)) : R;
        voffA[i] = (unsigned)(R * K + C) * 2u; voffB[i] = (unsigned)(Rb * K + C) * 2u; }
    const size_t kstep = (size_t)(BK * 2);
    const size_t hstep = (size_t)HALF * K * 2;
    const size_t tstep = 2 * hstep;
    const unsigned ldsw = (unsigned)wid * 1024u;
    const int aoff = lds_byte(wr * 64 + fr, fq * 8), boff = lds_byte(wc * 32 + fr, fq * 8);
#define PG8_SA(b, h) (((b) * 2 + (h)) * HTB)
#define PG8_SB(b, h) ((4 + (b) * 2 + (h)) * HTB)
#define PG8_STAGE(bufoff, gbase, voff) do { _Pragma("unroll") for (int _i = 0; _i < 2; ++_i) \
        __builtin_amdgcn_global_load_lds((const unsigned*)((const char*)(gbase) + (voff)[_i]), (PG8_LAS unsigned*)(lds + (bufoff) + ldsw + _i * 8192), 16, 0, 0); } while (0)
#define PG8_LDA(dst, b, h) do { _Pragma("unroll") for (int m = 0; m < 4; ++m) _Pragma("unroll") for (int k = 0; k < 2; ++k) dst[m][k] = *(const PG8_LAS bf16x8*)(lds + PG8_SA(b, h) + aoff + m * 2048 + k * 1024); } while (0)
#define PG8_LDB(dst, b, h) do { _Pragma("unroll") for (int n = 0; n < 2; ++n) _Pragma("unroll") for (int k = 0; k < 2; ++k) dst[n][k] = *(const PG8_LAS bf16x8*)(lds + PG8_SB(b, h) + boff + n * 2048 + k * 1024); } while (0)
#define PG8_MMA(ai, bj, At, Bt) do { __builtin_amdgcn_s_setprio(1); _Pragma("unroll") for (int m = 0; m < 4; ++m) _Pragma("unroll") for (int n = 0; n < 2; ++n) _Pragma("unroll") for (int k = 0; k < 2; ++k) \
        acc[ai][bj][m][n] = __builtin_amdgcn_mfma_f32_16x16x32_bf16(Bt[n][k], At[m][k], acc[ai][bj][m][n], 0, 0, 0); __builtin_amdgcn_s_setprio(0); } while (0)
#define PG8_WAIT_V(n) asm volatile("s_waitcnt vmcnt(" #n ")" ::: "memory")
#define PG8_WAIT_L(n) asm volatile("s_waitcnt lgkmcnt(" #n ")" ::: "memory")
#define PG8_BAR __builtin_amdgcn_s_barrier()
#define PG8_SCHED __builtin_amdgcn_sched_barrier(0)
    Unit cur, nxt; int ui = 0;
    if (!S.next(0, cur)) return;
    f32x4 acc[2][2][4][2];
#pragma unroll
    for (int a = 0; a < 2; ++a)
#pragma unroll
        for (int b = 0; b < 2; ++b)
#pragma unroll
            for (int m = 0; m < 4; ++m)
#pragma unroll
                for (int n = 0; n < 2; ++n) acc[a][b][m][n] = (f32x4){0.f, 0.f, 0.f, 0.f};
    bf16x8 At[4][2], B0[2][2], B1[2][2];
    const char* cA = (const char*)g.A + (size_t)cur.pm * tstep; const char* cB = (const char*)g.Bt + (size_t)cur.pn * tstep;
    S.a_ready(cur);
    if constexpr (SP2) {
        PG8_STAGE(PG8_SB(0, 0), cB, voffB); PG8_STAGE(PG8_SB(0, 1), cB + hstep, voffB); PG8_STAGE(PG8_SA(0, 0), cA, voffA); PG8_STAGE(PG8_SA(0, 1), cA + hstep, voffA);
        if (wr == 1) PG8_BAR;
        PG8_WAIT_V(2); PG8_BAR;
        PG8_STAGE(PG8_SB(1, 0), cB + kstep, voffB); PG8_STAGE(PG8_SA(1, 0), cA + kstep, voffA); PG8_STAGE(PG8_SB(1, 1), cB + hstep + kstep, voffB);
        PG8_WAIT_V(6); PG8_BAR;
    } else {
        PG8_STAGE(PG8_SB(0, 0), cB, voffB); PG8_STAGE(PG8_SA(0, 0), cA, voffA); PG8_STAGE(PG8_SB(0, 1), cB + hstep, voffB); PG8_STAGE(PG8_SA(0, 1), cA + hstep, voffA);
        if (wr == 1) PG8_BAR;
        PG8_WAIT_V(4); PG8_BAR;
        PG8_STAGE(PG8_SB(1, 0), cB + kstep, voffB); PG8_STAGE(PG8_SA(1, 0), cA + kstep, voffA); PG8_STAGE(PG8_SB(1, 1), cB + hstep + kstep, voffB);
        PG8_WAIT_V(6); PG8_BAR;
    }
    for (;;) {
        const bool has_next = S.next(ui + 1, nxt);
        const char* nA = has_next ? (const char*)g.A + (size_t)nxt.pm * tstep : cA; const char* nB = has_next ? (const char*)g.Bt + (size_t)nxt.pn * tstep : cB;
        for (int t = 0; t < nt; t += 2) {
            const bool last = (t == nt - 2);
            const char* a1 = cA + (size_t)(t + 1) * kstep;
            const char* a2 = last ? nA : cA + (size_t)(t + 2) * kstep; const char* b2 = last ? nB : cB + (size_t)(t + 2) * kstep;
            const char* a3 = a2 + kstep; const char* b3 = b2 + kstep;
            if (last && has_next) S.a_ready(nxt);
            if constexpr (SP2) {
            PG8_LDB(B0, 0, 0); PG8_LDB(B1, 0, 1); PG8_SCHED; PG8_LDA(At, 0, 0); PG8_STAGE(PG8_SA(1, 1), a1 + hstep, voffA);
            PG8_WAIT_V(8); PG8_WAIT_L(0); PG8_BAR; PG8_MMA(0, 0, At, B0); PG8_MMA(0, 1, At, B1); PG8_BAR; PG8_SCHED;
            PG8_LDA(At, 0, 1); PG8_STAGE(PG8_SB(0, 0), b2, voffB); PG8_STAGE(PG8_SB(0, 1), b2 + hstep, voffB); PG8_STAGE(PG8_SA(0, 0), a2, voffA);
            PG8_WAIT_V(8); PG8_WAIT_L(0); PG8_BAR; PG8_MMA(1, 0, At, B0); PG8_MMA(1, 1, At, B1); PG8_BAR; PG8_SCHED;
            PG8_LDB(B0, 1, 0); PG8_LDB(B1, 1, 1); PG8_SCHED; PG8_LDA(At, 1, 0); PG8_STAGE(PG8_SA(0, 1), a2 + hstep, voffA);
            PG8_WAIT_V(8); PG8_WAIT_L(0); PG8_BAR; PG8_MMA(0, 0, At, B0); PG8_MMA(0, 1, At, B1); PG8_BAR; PG8_SCHED;
            PG8_LDA(At, 1, 1); PG8_STAGE(PG8_SB(1, 0), b3, voffB); PG8_STAGE(PG8_SB(1, 1), b3 + hstep, voffB); PG8_STAGE(PG8_SA(1, 0), a3, voffA);
            PG8_WAIT_V(8); PG8_WAIT_L(0); PG8_BAR; PG8_MMA(1, 0, At, B0); PG8_MMA(1, 1, At, B1); PG8_BAR; PG8_SCHED;
            } else {
            PG8_LDB(B0, 0, 0); PG8_SCHED; PG8_LDA(At, 0, 0); PG8_STAGE(PG8_SA(1, 1), a1 + hstep, voffA);
            PG8_WAIT_L(8); PG8_BAR; PG8_WAIT_L(0); PG8_MMA(0, 0, At, B0); PG8_BAR; PG8_SCHED;
            PG8_LDB(B1, 0, 1); PG8_STAGE(PG8_SB(0, 0), b2, voffB);
            PG8_BAR; PG8_WAIT_L(0); PG8_MMA(0, 1, At, B1); PG8_BAR;
            PG8_LDA(At, 0, 1); PG8_STAGE(PG8_SA(0, 0), a2, voffA);
            PG8_BAR; PG8_WAIT_L(0); PG8_MMA(1, 0, At, B0); PG8_BAR; PG8_SCHED;
            PG8_STAGE(PG8_SB(0, 1), b2 + hstep, voffB);
            PG8_WAIT_V(6); PG8_BAR; PG8_MMA(1, 1, At, B1); PG8_BAR;
            PG8_LDB(B0, 1, 0); PG8_SCHED; PG8_LDA(At, 1, 0); PG8_STAGE(PG8_SA(0, 1), a2 + hstep, voffA);
            PG8_WAIT_L(8); PG8_BAR; PG8_WAIT_L(0); PG8_MMA(0, 0, At, B0); PG8_BAR; PG8_SCHED;
            PG8_LDB(B1, 1, 1); PG8_STAGE(PG8_SB(1, 0), b3, voffB);
            PG8_BAR; PG8_WAIT_L(0); PG8_MMA(0, 1, At, B1); PG8_BAR;
            PG8_LDA(At, 1, 1); PG8_STAGE(PG8_SA(1, 0), a3, voffA);
            PG8_BAR; PG8_WAIT_L(0); PG8_MMA(1, 0, At, B0); PG8_BAR; PG8_SCHED;
            PG8_STAGE(PG8_SB(1, 1), b3 + hstep, voffB);
            PG8_WAIT_V(6); PG8_BAR; PG8_MMA(1, 1, At, B1); PG8_BAR;
            }
        }
        if constexpr (ALIGN_EPI) { if (wr == 0) PG8_BAR; }
        if constexpr (!Epi::AFTER_DRAIN) { E(acc, cur, wr, wc, fr, fq); S.done(cur); }
        if (!has_next) break;
#pragma unroll
        for (int a = 0; a < 2; ++a)
#pragma unroll
            for (int b = 0; b < 2; ++b)
#pragma unroll
                for (int m = 0; m < 4; ++m)
#pragma unroll
                    for (int n = 0; n < 2; ++n) acc[a][b][m][n] = (f32x4){0.f, 0.f, 0.f, 0.f};
        cur = nxt; cA = nA; cB = nB; ++ui;
        if constexpr (ALIGN_EPI) { if (wr == 1) PG8_BAR; }
    }
    PG8_WAIT_V(0);
    if constexpr (!ALIGN_EPI) { if (wr == 0) PG8_BAR; }
    PG8_BAR;
    if constexpr (Epi::AFTER_DRAIN) { E.fused(acc, cur, wr, wc, fr, fq, lds, wid, lane); S.done(cur); }
#undef PG8_SA
#undef PG8_SB
#undef PG8_STAGE
#undef PG8_LDA
#undef PG8_LDB
#undef PG8_MMA
#undef PG8_WAIT_V
#undef PG8_WAIT_L
#undef PG8_BAR
#undef PG8_SCHED
}
}
#define GAS __attribute__((address_space(1)))
#define LAS __attribute__((address_space(3)))
typedef unsigned v4u __attribute__((ext_vector_type(4)));
typedef float f32x4 __attribute__((ext_vector_type(4)));
#define LDS_WAIT() asm volatile("s_waitcnt lgkmcnt(0)" ::: "memory")
constexpr int NWAVES = 8;
constexpr int GEMM_LDS = 131072;

struct Ptrs {
    const float* in[20]; float* out; unsigned char* ws;
};
#define IN_X 0
#define IN_EV_NORM 1
#define IN_EV_WIN 2
#define IN_EV_IFB 3
#define IN_EV_QNG 4
#define IN_EV_KNG 5
#define IN_EV_REL 6
#define IN_EV_WOUT 7
#define IN_OD_NORM 8
#define IN_OD_WIN 9
#define IN_OD_CCW 10
#define IN_OD_CCB 11
#define IN_OD_GW 12
#define IN_OD_GB 13
#define IN_OD_LAM 14
#define IN_OD_CDW 15
#define IN_OD_ALOG 16
#define IN_OD_DTB 17
#define IN_OD_ONORM 18
#define IN_OD_WOUT 19

__device__ __forceinline__ float wave_sum(float v) {
#pragma unroll
    for (int o = 1; o < 64; o <<= 1) v += __shfl_xor(v, o);
    return v;
}
__device__ __forceinline__ void p0_transpose_item(const float* W, int K, int ldw, int nblk, const float* gain, bf16_t* WT, LAS float* scr, int item, int lane) {
    const int kb = item / nblk, nb = item % nblk, k0 = 64 * kb, n0 = 32 * nb;
#pragma unroll 8
    for (int i = 0; i < 32; ++i) { const int kk = 2 * i + (lane >> 5); const float g = gain ? gain[k0 + kk] : 1.0f; scr[kk * 33 + (lane & 31)] = g * W[(size_t)(k0 + kk) * ldw + n0 + (lane & 31)]; }
    LDS_WAIT(); asm volatile("" ::: "memory");
    const int c = lane & 7;
#pragma unroll
    for (int j = 0; j < 4; ++j) { const int n = (lane >> 3) + 8 * j; const LAS float* s = scr + (8 * c) * 33 + n;
        v4u o; o.x = pk2(s[0 * 33], s[1 * 33]); o.y = pk2(s[2 * 33], s[3 * 33]); o.z = pk2(s[4 * 33], s[5 * 33]); o.w = pk2(s[6 * 33], s[7 * 33]);
        *(GAS v4u*)(WT + (size_t)(n0 + n) * K + k0 + 8 * c) = o; }
    LDS_WAIT(); asm volatile("" ::: "memory");
}
__device__ __forceinline__ void phase_prologue(const Ptrs& P, LAS unsigned char* lds, int wave, int lane, int gw, int NGW) {
    unsigned char* ws = P.ws;
    bf16_t* W1T = (bf16_t*)(ws + WS_W1T); bf16_t* W2T = (bf16_t*)(ws + WS_W2T); bf16_t* W3T = (bf16_t*)(ws + WS_W3T); bf16_t* W4T = (bf16_t*)(ws + WS_W4T);
    bf16_t* XB = (bf16_t*)(ws + WS_XB); float* R0 = (float*)(ws + WS_R0); float* SS1 = (float*)(ws + WS_SS1); float* GIF = (float*)(ws + WS_GIF);
    LAS float* scr = (LAS float*)(lds + wave * 16384);
    constexpr int I1 = (D_MODEL / 64) * (EV_N / 32), I2 = (D_MODEL / 64) * (D_MODEL / 32), I3 = (D_MODEL / 64) * (OD_N / 32), I4 = I2, NITEMS = I1 + I2 + I3 + I4;
    for (int it = gw; it < NITEMS; it += NGW) {
        int r = it;
        if (r < I1) { p0_transpose_item(P.in[IN_EV_WIN], D_MODEL, EV_IN, EV_N / 32, P.in[IN_EV_NORM], W1T, scr, r, lane); continue; } r -= I1;
        if (r < I2) { p0_transpose_item(P.in[IN_EV_WOUT], D_MODEL, D_MODEL, D_MODEL / 32, nullptr, W2T, scr, r, lane); continue; } r -= I2;
        if (r < I3) { p0_transpose_item(P.in[IN_OD_WIN], D_MODEL, OD_IN, OD_N / 32, P.in[IN_OD_NORM], W3T, scr, r, lane); continue; } r -= I3;
        p0_transpose_item(P.in[IN_OD_WOUT], D_MODEL, D_MODEL, D_MODEL / 32, nullptr, W4T, scr, r, lane);
    }
    { const int gt = gw * 64 + lane, NT = NGW * 64;
      for (int e = gt; e < 16 * D_MODEL; e += NT) { const int j = e / D_MODEL, k = e % D_MODEL; W3T[(size_t)(OD_N + j) * D_MODEL + k] = (bf16_t)f2bf(P.in[IN_OD_NORM][k] * P.in[IN_OD_WIN][(size_t)k * OD_IN + OD_N + j]); }
      for (int e = gt; e < M_TOK; e += NT) SS1[e] = 0.f; }
    __syncthreads();
    LAS float* G8 = (LAS float*)lds;
    for (int e = threadIdx.x; e < D_MODEL * 8; e += NWAVES * 64) { const int k = e >> 3, j = e & 7; G8[e] = P.in[IN_EV_NORM][k] * P.in[IN_EV_WIN][(size_t)k * EV_IN + EV_N + j]; }
    __syncthreads();
    const float* X = P.in[IN_X];
    for (int m = gw; m < M_TOK; m += NGW) {
        const GAS f32x4* xr = (const GAS f32x4*)(X + (size_t)m * D_MODEL) + lane;
        float s = 0.f;
        GAS unsigned long long* o8 = (GAS unsigned long long*)(XB + (size_t)m * D_MODEL) + lane;
#pragma unroll
        for (int j = 0; j < 8; ++j) { const f32x4 v = xr[64 * j]; s += (v.x * v.x + v.y * v.y) + (v.z * v.z + v.w * v.w);
            o8[64 * j] = (unsigned long long)pk2(v.x, v.y) | ((unsigned long long)pk2(v.z, v.w) << 32); }
        const float r0 = 1.0f / sqrtf(wave_sum(s) * (1.0f / D_MODEL) + EPS);
        float g[8];
#pragma unroll
        for (int i = 0; i < 8; ++i) g[i] = 0.f;
#pragma unroll 1
        for (int j = 0; j < 8; ++j) {
            const f32x4 v = xr[64 * j];
#pragma unroll
            for (int e = 0; e < 4; ++e) { const int k = 4 * lane + 256 * j + e; const f32x4 ga = *(const LAS f32x4*)(G8 + k * 8), gb = *(const LAS f32x4*)(G8 + k * 8 + 4); const float xv = v[e];
                g[0] += xv * ga.x; g[1] += xv * ga.y; g[2] += xv * ga.z; g[3] += xv * ga.w; g[4] += xv * gb.x; g[5] += xv * gb.y; g[6] += xv * gb.z; g[7] += xv * gb.w; }
        }
#pragma unroll
        for (int i = 0; i < 8; ++i) g[i] = wave_sum(g[i]);
        if (lane == 0) R0[m] = r0;
        if (lane < 8) { float gv = g[0];
#pragma unroll
            for (int i = 1; i < 8; ++i) gv = (lane == i) ? g[i] : gv;
            GIF[(size_t)m * 8 + lane] = r0 * gv + P.in[IN_EV_IFB][lane]; }
    }
}

#define XB_TMO      128
#define XB_XCNT(j)  (256  + 64 * (j))
#define XB_XSUB(j)  (1280 + 64 * (j))
#define XB_XGEN(j)  (2304 + 64 * (j))
#define XB_TOP      3328
#define XB_TOPGEN   3392
#define XCD_BAR_WORDS 3456
#define XB_SPIN_CAP (1u << 18)

__device__ __forceinline__ unsigned xb_ld(unsigned* p)              { return __hip_atomic_load(p, __ATOMIC_RELAXED, __HIP_MEMORY_SCOPE_AGENT); }
__device__ __forceinline__ unsigned xb_add(unsigned* p, unsigned v) { return __hip_atomic_fetch_add(p, v, __ATOMIC_RELAXED, __HIP_MEMORY_SCOPE_AGENT); }
__device__ __forceinline__ unsigned xb_xcc_id() { return (unsigned)__builtin_amdgcn_s_getreg((3 << 11) | 20) & 0xFu; }
#define XB_SPIN(cond, bar) do { unsigned _sp = 0; while (cond) { __builtin_amdgcn_s_sleep(1); \
    if ((++_sp & 255u) == 0u) { if (xb_ld(&(bar)[XB_TMO])) break; if (_sp > XB_SPIN_CAP) { atomicAdd(&(bar)[XB_TMO], 1u); break; } } } } while (0)

struct XcdBarrier {
    unsigned* bar; unsigned x;
    volatile LAS unsigned* st;
};

__device__ __forceinline__ XcdBarrier xcd_barrier_post(unsigned* bar, volatile LAS unsigned* st) {
    XcdBarrier b; b.bar = bar; b.x = xb_xcc_id(); b.st = st;
    if (threadIdx.x == 0) (void)xb_add(&bar[XB_XCNT(b.x)], 1u);
    return b;
}
__device__ __forceinline__ void xcd_barrier_complete(unsigned* bar, unsigned x, unsigned& nloc, unsigned& nx) {
    const unsigned G = gridDim.x * gridDim.y * gridDim.z;
    unsigned sum, cnt, mine, sp = 0u;
    for (;;) {
        sum = 0u; cnt = 0u; mine = 0u;
#pragma unroll
        for (unsigned j = 0; j < 16; ++j) { const unsigned c = xb_ld(&bar[XB_XCNT(j)]); sum += c; cnt += (c > 0u) ? 1u : 0u; mine = (j == x) ? c : mine; }
        if (sum == G) break;
        __builtin_amdgcn_s_sleep(1);
        if ((++sp & 255u) == 0u) { if (xb_ld(&bar[XB_TMO])) break; if (sp > XB_SPIN_CAP) { atomicAdd(&bar[XB_TMO], 1u); break; } }
    }
    nloc = mine > 0u ? mine : 1u; nx = cnt > 0u ? cnt : 1u;
}

__device__ __forceinline__ void xcd_barrier(const XcdBarrier& b) {
    asm volatile("s_waitcnt vmcnt(0)" ::: "memory");
    __syncthreads();
    if (threadIdx.x == 0) {
        unsigned* bar = b.bar;
        __builtin_amdgcn_s_waitcnt(0);
        unsigned nloc = b.st[0], nx = b.st[1];
        if (nloc == 0u) { xcd_barrier_complete(bar, b.x, nloc, nx); b.st[0] = nloc; b.st[1] = nx; }
        const unsigned old = xb_add(&bar[XB_XSUB(b.x)], 1u);
        const unsigned gen = old / nloc;
        if (old + 1u == (gen + 1u) * nloc) {
            __builtin_amdgcn_fence(__ATOMIC_RELEASE, "agent");
            asm volatile("s_waitcnt vmcnt(0)" ::: "memory");
            const unsigned og = xb_add(&bar[XB_TOP], 1u);
            const unsigned tg = og / nx;
            if (og + 1u == (tg + 1u) * nx) xb_add(&bar[XB_TOPGEN], 1u);
            else XB_SPIN(xb_ld(&bar[XB_TOPGEN]) == tg, bar);
            __builtin_amdgcn_fence(__ATOMIC_ACQUIRE, "agent");
            xb_add(&bar[XB_XGEN(b.x)], 1u);
            asm volatile("s_waitcnt vmcnt(0)" ::: "memory");
        } else {
            XB_SPIN(xb_ld(&bar[XB_XGEN(b.x)]) == gen, bar);
            __builtin_amdgcn_fence(__ATOMIC_ACQUIRE, "agent");
            asm volatile("s_waitcnt vmcnt(0)" ::: "memory");
        }
    }
    __syncthreads();
}
__device__ __forceinline__ void ld8bf(const bf16_t* p, float (&v)[8]) {
    const v4u w = *(const v4u*)p;
    v[0] = __builtin_bit_cast(float, w.x << 16); v[1] = __builtin_bit_cast(float, w.x & 0xffff0000u);
    v[2] = __builtin_bit_cast(float, w.y << 16); v[3] = __builtin_bit_cast(float, w.y & 0xffff0000u);
    v[4] = __builtin_bit_cast(float, w.z << 16); v[5] = __builtin_bit_cast(float, w.z & 0xffff0000u);
    v[6] = __builtin_bit_cast(float, w.w << 16); v[7] = __builtin_bit_cast(float, w.w & 0xffff0000u);
}
__global__ void __launch_bounds__(256) k_attn_naive(const bf16_t* __restrict__ PROJ, const float* __restrict__ qn_g, const float* __restrict__ kn_g, const float* __restrict__ rel_bias, bf16_t* __restrict__ Y) {
    __shared__ float qs[16][128];
    __shared__ float S[16][577];
    const int bid = blockIdx.x, quarter = bid & 3, c = (bid >> 2) & 31, h = (bid >> 7) & 7, b = bid >> 10, t = threadIdx.x;
    { const int r = t >> 4, sub = t & 15; const int tok = b * SEQ + c * 64 + quarter * 16 + r;
      float v[8]; ld8bf(PROJ + (size_t)tok * EV_N + EC_QA + h * 128 + sub * 8, v);
      float ss = 0.f;
#pragma unroll
      for (int i = 0; i < 8; ++i) ss += v[i] * v[i];
      ss += __shfl_xor(ss, 1); ss += __shfl_xor(ss, 2); ss += __shfl_xor(ss, 4); ss += __shfl_xor(ss, 8);
      const float rs = 1.0f / sqrtf(ss * (1.0f / 128.0f) + EPS);
#pragma unroll
      for (int i = 0; i < 8; ++i) qs[r][sub * 8 + i] = v[i] * rs * qn_g[sub * 8 + i] * 0.08838834764831845f; }
    __syncthreads();
    for (int idx = t; idx < 16 * BAND; idx += 256) {
        const int r = idx / BAND, j = idx % BAND; const int kc = c - LOOKBACK + (j >> 6);
        float s;
        if (kc < 0) s = -1e30f;
        else { const bf16_t* kp = PROJ + (size_t)(b * SEQ + kc * 64 + (j & 63)) * EV_N + EC_KA + h * 128;
            float ss = 0.f, dot = 0.f;
            for (int d = 0; d < 128; d += 8) { float kv[8]; ld8bf(kp + d, kv);
#pragma unroll
                for (int i = 0; i < 8; ++i) { ss += kv[i] * kv[i]; dot += kv[i] * kn_g[d + i] * qs[r][d + i]; } }
            s = dot * (1.0f / sqrtf(ss * (1.0f / 128.0f) + EPS));
            const int qi = quarter * 16 + r; int rel = LOOKBACK * CHUNK + qi - j; rel = rel < -REL_MAX ? -REL_MAX : (rel > REL_MAX ? REL_MAX : rel); rel += REL_MAX;
            s += rel_bias[h * NREL + rel]; }
        S[r][j] = s;
    }
    __syncthreads();
    { const int r = t >> 4, sub = t & 15; float mx = -3.0e38f;
      for (int j = sub; j < BAND; j += 16) mx = fmaxf(mx, S[r][j]);
      mx = fmaxf(mx, __shfl_xor(mx, 1)); mx = fmaxf(mx, __shfl_xor(mx, 2)); mx = fmaxf(mx, __shfl_xor(mx, 4)); mx = fmaxf(mx, __shfl_xor(mx, 8));
      float sum = 0.f;
      for (int j = sub; j < BAND; j += 16) { const float e = expf(S[r][j] - mx); S[r][j] = e; sum += e; }
      sum += __shfl_xor(sum, 1); sum += __shfl_xor(sum, 2); sum += __shfl_xor(sum, 4); sum += __shfl_xor(sum, 8);
      const float inv = 1.0f / sum;
      for (int j = sub; j < BAND; j += 16) S[r][j] *= inv; }
    __syncthreads();
    { const int r = t >> 4, dg = t & 15; float acc[8];
#pragma unroll
      for (int i = 0; i < 8; ++i) acc[i] = 0.f;
      for (int j = 0; j < BAND; ++j) { const int kc = c - LOOKBACK + (j >> 6); if (kc < 0) continue;
          const float p = S[r][j]; float vv[8]; ld8bf(PROJ + (size_t)(b * SEQ + kc * 64 + (j & 63)) * EV_N + EC_VA + h * 128 + dg * 8, vv);
#pragma unroll
          for (int i = 0; i < 8; ++i) acc[i] += p * vv[i]; }
      const int tok = b * SEQ + c * 64 + quarter * 16 + r; float z[8]; ld8bf(PROJ + (size_t)tok * EV_N + EC_ZA + h * 128 + dg * 8, z);
      v4u o; o.x = pk2(acc[0] * siluf_(z[0]), acc[1] * siluf_(z[1])); o.y = pk2(acc[2] * siluf_(z[2]), acc[3] * siluf_(z[3]));
      o.z = pk2(acc[4] * siluf_(z[4]), acc[5] * siluf_(z[5])); o.w = pk2(acc[6] * siluf_(z[6]), acc[7] * siluf_(z[7]));
      *(v4u*)(Y + (size_t)tok * D_MODEL + h * 128 + dg * 8) = o; }
}
__global__ void __launch_bounds__(256) k_mlstm_naive(const bf16_t* __restrict__ PROJ, const float* __restrict__ GIF, bf16_t* __restrict__ Y) {
    __shared__ float ks[256], qs[256], part[4][64], dpart[4];
    const int bid = blockIdx.x, vs = bid & 3, h = (bid >> 2) & 3, b = bid >> 4, t = threadIdx.x, v = t & 63, kq = t >> 6;
    float C[64];
#pragma unroll
    for (int i = 0; i < 64; ++i) C[i] = 0.f;
    float nreg = 0.f;
    for (int s = 0; s < SEQ; ++s) {
        const size_t tok = (size_t)b * SEQ + s; const bf16_t* pr = PROJ + tok * EV_N;
        const float li = GIF[tok * 8 + h], fpre = GIF[tok * 8 + 4 + h];
        const float fw = sigmoidf_(fpre), iw = expf(li);
        const float kk = bf2f(pr[EC_KB + h * 256 + t]), qq = bf2f(pr[EC_QB + h * 256 + t]) * 0.0625f;
        const float vv = bf2f(pr[EC_VB + h * 256 + vs * 64 + v]);
        ks[t] = kk; qs[t] = qq;
        nreg = fw * nreg + iw * kk;
        float dp = nreg * qq; dp = wave_sum(dp);
        if ((t & 63) == 0) dpart[kq] = dp;
        __syncthreads();
        float np = 0.f; const float iv = iw * vv;
#pragma unroll
        for (int i = 0; i < 64; ++i) { C[i] = fw * C[i] + ks[kq * 64 + i] * iv; np += C[i] * qs[kq * 64 + i]; }
        part[kq][v] = np;
        __syncthreads();
        if (t < 64) { const float num = (part[0][t] + part[1][t]) + (part[2][t] + part[3][t]); const float den = (dpart[0] + dpart[1]) + (dpart[2] + dpart[3]);
            const float hh = num / fmaxf(fabsf(den), 1.0f);
            const float ob = bf2f(pr[EC_OB + h * 256 + vs * 64 + t]), zb = bf2f(pr[EC_ZB + h * 256 + vs * 64 + t]);
            Y[tok * D_MODEL + W_A + h * 256 + vs * 64 + t] = (bf16_t)f2bf(sigmoidf_(ob) * hh * siluf_(zb)); }
        __syncthreads();
    }
}
__global__ void __launch_bounds__(128) k_rglru_gates(const bf16_t* __restrict__ PROJ, const float* __restrict__ ccw, const float* __restrict__ ccb, const float* __restrict__ gw, const float* __restrict__ gb,
                                                     const float* __restrict__ lam, float* __restrict__ A, float* __restrict__ INP) {
    __shared__ float xs[8][128];
    const int blk = blockIdx.x & 7, tg = blockIdx.x >> 3, t = threadIdx.x, c = blk * 128 + t;
    float xc[8];
#pragma unroll
    for (int i = 0; i < 8; ++i) { const int tok = tg * 8 + i, s = tok % SEQ; float a = ccb[c];
#pragma unroll
        for (int j = 0; j < 4; ++j) { const int sj = s - 3 + j; if (sj >= 0) a += ccw[j * W_C + c] * bf2f(PROJ[(size_t)(tok - 3 + j) * OD_N + OC_XC + c]); }
        xc[i] = a; xs[i][t] = a; }
    __syncthreads();
    float rp[8], ip[8];
#pragma unroll
    for (int i = 0; i < 8; ++i) { rp[i] = 0.f; ip[i] = 0.f; }
    const float* g0 = gw + (size_t)blk * 128 * 256;
    for (int k = 0; k < 128; ++k) { const float wr_ = g0[k * 256 + t], wi_ = g0[k * 256 + 128 + t];
#pragma unroll
        for (int i = 0; i < 8; ++i) { const float xv = xs[i][k]; rp[i] += xv * wr_; ip[i] += xv * wi_; } }
    const float sp = softplusf_(-lam[c]); const float gbr = gb[c], gbi = gb[W_C + c];
#pragma unroll
    for (int i = 0; i < 8; ++i) { const int tok = tg * 8 + i; const float r = sigmoidf_(rp[i] + gbr), ig = sigmoidf_(ip[i] + gbi);
        const float la = -8.0f * r * sp; A[(size_t)tok * W_C + c] = expf(la); INP[(size_t)tok * W_C + c] = sqrtf(-expm1f(2.0f * la)) * (ig * xc[i]); }
}
__global__ void __launch_bounds__(256) k_rglru_scan(const bf16_t* __restrict__ PROJ, const float* __restrict__ A, const float* __restrict__ INP, bf16_t* __restrict__ Y) {
    const int gid = blockIdx.x * 256 + threadIdx.x, b = gid / W_C, c = gid % W_C; float h = 0.f;
    for (int s = 0; s < SEQ; ++s) { const size_t tok = (size_t)b * SEQ + s; h = A[tok * W_C + c] * h + INP[tok * W_C + c];
        Y[tok * D_MODEL + c] = (bf16_t)f2bf(h * siluf_(bf2f(PROJ[tok * OD_N + OC_ZC + c]))); }
}
__global__ void __launch_bounds__(256) k_gates_ab(const bf16_t* __restrict__ XB, const bf16_t* __restrict__ W3T, const float* __restrict__ SS1, float* __restrict__ AB) {
    const int t = threadIdx.x, row = blockIdx.x * 16 + (t >> 4), j = t & 15;
    const bf16_t* xp = XB + (size_t)row * D_MODEL; const bf16_t* wp = W3T + (size_t)(OD_N + j) * D_MODEL; float acc = 0.f;
    for (int k = 0; k < D_MODEL; k += 8) { float a[8], w[8]; ld8bf(xp + k, a); ld8bf(wp + k, w);
#pragma unroll
        for (int i = 0; i < 8; ++i) acc += a[i] * w[i]; }
    AB[(size_t)row * 16 + j] = acc * (1.0f / sqrtf(SS1[row] * (1.0f / D_MODEL) + EPS));
}
__global__ void __launch_bounds__(128) k_dn_prep(const bf16_t* __restrict__ PROJ, const float* __restrict__ cdw, float* __restrict__ Q2, float* __restrict__ K2, float* __restrict__ V2) {
    __shared__ float red[2][2];
    const int h = blockIdx.x & 7, tok = blockIdx.x >> 3, s = tok % SEQ, t = threadIdx.x; float o[3];
#pragma unroll
    for (int p = 0; p < 3; ++p) { const int col = p * W_D + h * 128 + t; float a = 0.f;
#pragma unroll
        for (int j = 0; j < 4; ++j) { const int sj = s - 3 + j; if (sj >= 0) a += cdw[j * 3 * W_D + col] * bf2f(PROJ[(size_t)(tok - 3 + j) * OD_N + OC_QD + col]); }
        o[p] = siluf_(a); }
    float sq = wave_sum(o[0] * o[0]), sk = wave_sum(o[1] * o[1]);
    if ((t & 63) == 0) { red[t >> 6][0] = sq; red[t >> 6][1] = sk; }
    __syncthreads();
    sq = red[0][0] + red[1][0]; sk = red[0][1] + red[1][1];
    const size_t o_ = (size_t)tok * W_D + h * 128 + t;
    Q2[o_] = o[0] * (1.0f / sqrtf(sq + EPS)); K2[o_] = o[1] * (1.0f / sqrtf(sk + EPS)); V2[o_] = o[2];
}
__global__ void __launch_bounds__(256) k_dn_scan(const bf16_t* __restrict__ PROJ, const float* __restrict__ Q2, const float* __restrict__ K2, const float* __restrict__ V2, const float* __restrict__ AB,
                                                 const float* __restrict__ a_log, const float* __restrict__ dt_bias, const float* __restrict__ onorm, bf16_t* __restrict__ Y) {
    __shared__ float ks[128], qs[128], part[2][128], red[2];
    const int h = blockIdx.x & 7, b = blockIdx.x >> 3, t = threadIdx.x, v = t & 127, kh = t >> 7;
    float S[64];
#pragma unroll
    for (int i = 0; i < 64; ++i) S[i] = 0.f;
    const float Aexp = expf(a_log[h]), dtb = dt_bias[h], og = onorm[v];
    for (int s = 0; s < SEQ; ++s) {
        const size_t tok = (size_t)b * SEQ + s; const size_t o_ = tok * W_D + h * 128;
        if (t < 128) ks[t] = K2[o_ + t]; else qs[t - 128] = Q2[o_ + t - 128] * 0.08838834764831845f;
        const float vv = V2[o_ + v];
        const float beta = sigmoidf_(AB[tok * 16 + 8 + h]); const float g = -Aexp * softplusf_(AB[tok * 16 + h] + dtb); const float al = expf(g);
        __syncthreads();
        float rp = 0.f;
#pragma unroll
        for (int i = 0; i < 64; ++i) rp += S[i] * ks[kh * 64 + i];
        part[kh][v] = rp;
        __syncthreads();
        const float r = part[0][v] + part[1][v];
        const float u = beta * (vv - al * r);
        float op = 0.f;
#pragma unroll
        for (int i = 0; i < 64; ++i) { S[i] = al * S[i] + ks[kh * 64 + i] * u; op += S[i] * qs[kh * 64 + i]; }
        __syncthreads();
        part[kh][v] = op;
        __syncthreads();
        const float o = part[0][v] + part[1][v];
        float sq = (t < 128) ? o * o : 0.f; sq = wave_sum(sq);
        if (t == 0) red[0] = sq; if (t == 64) red[1] = sq;
        __syncthreads();
        if (t < 128) { const float ms = (red[0] + red[1]) * (1.0f / 128.0f);
            const float zd = bf2f(PROJ[tok * OD_N + OC_ZD + h * 128 + t]);
            Y[tok * D_MODEL + W_C + h * 128 + t] = (bf16_t)f2bf(o * (1.0f / sqrtf(ms + EPS)) * og * siluf_(zd)); }
    }
}

__global__ void __launch_bounds__(512) k_prologue(Ptrs P) {
    extern __shared__ __attribute__((aligned(16))) unsigned char lds[];
    const int tid = threadIdx.x, lane = tid & 63, wave = __builtin_amdgcn_readfirstlane(tid >> 6);
    phase_prologue(P, (LAS unsigned char*)lds, wave, lane, blockIdx.x * NWAVES + wave, gridDim.x * NWAVES);
}
template <int WHICH> __device__ __forceinline__ void phase_gemm(const Ptrs& P, LAS unsigned char* lds, int G, int c) {
    unsigned char* ws = P.ws;
    bf16_t* W1T = (bf16_t*)(ws + WS_W1T); bf16_t* W2T = (bf16_t*)(ws + WS_W2T); bf16_t* W3T = (bf16_t*)(ws + WS_W3T); bf16_t* W4T = (bf16_t*)(ws + WS_W4T);
    bf16_t* XB = (bf16_t*)(ws + WS_XB); bf16_t* YB = (bf16_t*)(ws + WS_Y); bf16_t* PROJ = (bf16_t*)(ws + WS_PROJ);
    float* R0 = (float*)(ws + WS_R0); float* SS1 = (float*)(ws + WS_SS1);
    if constexpr (WHICH == 1) { pg8::Gemm g{XB, W1T, M_TOK, EV_N, D_MODEL}; pg8::EpiProj E{PROJ, EV_N, R0, 0}; pg8::StaticOrder S; S.init(g.M, g.N, G, c);
        pg8::gemm_phase<pg8::EpiProj, pg8::StaticOrder, true, true>(lds, g, S, E); }
    if constexpr (WHICH == 2) { pg8::Gemm g{YB, W2T, M_TOK, D_MODEL, D_MODEL}; pg8::EpiRes E{P.in[IN_X], P.out, XB, SS1, D_MODEL}; pg8::StaticOrder S; S.init(g.M, g.N, G, c);
        pg8::gemm_phase<pg8::EpiRes, pg8::StaticOrder, true, true>(lds, g, S, E); }
    if constexpr (WHICH == 3) { pg8::Gemm g{XB, W3T, M_TOK, OD_N, D_MODEL}; pg8::EpiProj E{PROJ, OD_N, SS1, 1}; pg8::StaticOrder S; S.init(g.M, g.N, G, c);
        pg8::gemm_phase<pg8::EpiProj, pg8::StaticOrder, true, true>(lds, g, S, E); }
    if constexpr (WHICH == 4) { pg8::Gemm g{YB, W4T, M_TOK, D_MODEL, D_MODEL}; pg8::EpiRes E{P.out, P.out, nullptr, nullptr, D_MODEL}; pg8::StaticOrder S; S.init(g.M, g.N, G, c);
        pg8::gemm_phase<pg8::EpiRes, pg8::StaticOrder, true, true>(lds, g, S, E); }
}
template <int WHICH> __global__ void __launch_bounds__(512, 2) k_gemm(Ptrs P) {
    extern __shared__ __attribute__((aligned(16))) unsigned char lds[];
    phase_gemm<WHICH>(P, (LAS unsigned char*)lds, gridDim.x, blockIdx.x);
}

__device__ __forceinline__ void phase_gates_ab(const Ptrs& P, int G) {
    unsigned char* ws = P.ws; const bf16_t* XB = (const bf16_t*)(ws + WS_XB); const bf16_t* W3T = (const bf16_t*)(ws + WS_W3T); const float* SS1 = (const float*)(ws + WS_SS1); float* AB = (float*)(ws + WS_AB);
    const int t = threadIdx.x, j = t & 15;
    for (int it = blockIdx.x; it < M_TOK / 32; it += G) { const int row = it * 32 + (t >> 4);
        const bf16_t* xp = XB + (size_t)row * D_MODEL; const bf16_t* wp = W3T + (size_t)(OD_N + j) * D_MODEL; float acc = 0.f;
        for (int k = 0; k < D_MODEL; k += 8) { float a[8], w[8]; ld8bf(xp + k, a); ld8bf(wp + k, w);
#pragma unroll
            for (int i = 0; i < 8; ++i) acc += a[i] * w[i]; }
        AB[(size_t)row * 16 + j] = acc * (1.0f / sqrtf(SS1[row] * (1.0f / D_MODEL) + EPS)); }
}
#ifdef SKELETON
__device__ __forceinline__ void phase_mix0(const Ptrs& P, LAS unsigned char* lds, int G) {
    v4u* Y = (v4u*)(P.ws + WS_Y); const v4u z = {0u, 0u, 0u, 0u};
    for (size_t i = (size_t)blockIdx.x * 512 + threadIdx.x; i < (size_t)M_TOK * D_MODEL / 8; i += (size_t)G * 512) Y[i] = z;
}
__device__ __forceinline__ void phase_mix1a(const Ptrs& P, LAS unsigned char* lds, int G) { phase_mix0(P, lds, G); }
__device__ __forceinline__ void phase_mix1b(const Ptrs& P, LAS unsigned char* lds, int G) { }
#endif
__device__ __forceinline__ void vb_attn(const bf16_t* __restrict__ PROJ, const float* __restrict__ qn_g, const float* __restrict__ kn_g, const float* __restrict__ rel_bias, bf16_t* __restrict__ Y,
                                        int bid, int t, LAS float* qs  , LAS float* S  , bool active) {
    if (!active) bid = 0;
    const int quarter = bid & 3, c = (bid >> 2) & 31, h = (bid >> 7) & 7, b = bid >> 10;
    { const int r = t >> 4, sub = t & 15; const int tok = b * SEQ + c * 64 + quarter * 16 + r;
      float v[8]; ld8bf(PROJ + (size_t)tok * EV_N + EC_QA + h * 128 + sub * 8, v);
      float ss = 0.f;
#pragma unroll
      for (int i = 0; i < 8; ++i) ss += v[i] * v[i];
      ss += __shfl_xor(ss, 1); ss += __shfl_xor(ss, 2); ss += __shfl_xor(ss, 4); ss += __shfl_xor(ss, 8);
      const float rs = 1.0f / sqrtf(ss * (1.0f / 128.0f) + EPS);
#pragma unroll
      for (int i = 0; i < 8; ++i) qs[r * 128 + sub * 8 + i] = v[i] * rs * qn_g[sub * 8 + i] * 0.08838834764831845f; }
    __syncthreads();
    for (int idx = t; idx < 16 * BAND; idx += 256) {
        const int r = idx / BAND, j = idx % BAND; const int kc = c - LOOKBACK + (j >> 6);
        float s;
        if (kc < 0) s = -1e30f;
        else { const bf16_t* kp = PROJ + (size_t)(b * SEQ + kc * 64 + (j & 63)) * EV_N + EC_KA + h * 128;
            float ss = 0.f, dot = 0.f;
            for (int d = 0; d < 128; d += 8) { float kv[8]; ld8bf(kp + d, kv);
#pragma unroll
                for (int i = 0; i < 8; ++i) { ss += kv[i] * kv[i]; dot += kv[i] * kn_g[d + i] * qs[r * 128 + d + i]; } }
            s = dot * (1.0f / sqrtf(ss * (1.0f / 128.0f) + EPS));
            const int qi = quarter * 16 + r; int rel = LOOKBACK * CHUNK + qi - j; rel = rel < -REL_MAX ? -REL_MAX : (rel > REL_MAX ? REL_MAX : rel); rel += REL_MAX;
            s += rel_bias[h * NREL + rel]; }
        S[r * 577 + j] = s;
    }
    __syncthreads();
    { const int r = t >> 4, sub = t & 15; float mx = -3.0e38f;
      for (int j = sub; j < BAND; j += 16) mx = fmaxf(mx, S[r * 577 + j]);
      mx = fmaxf(mx, __shfl_xor(mx, 1)); mx = fmaxf(mx, __shfl_xor(mx, 2)); mx = fmaxf(mx, __shfl_xor(mx, 4)); mx = fmaxf(mx, __shfl_xor(mx, 8));
      float sum = 0.f;
      for (int j = sub; j < BAND; j += 16) { const float e = expf(S[r * 577 + j] - mx); S[r * 577 + j] = e; sum += e; }
      sum += __shfl_xor(sum, 1); sum += __shfl_xor(sum, 2); sum += __shfl_xor(sum, 4); sum += __shfl_xor(sum, 8);
      const float inv = 1.0f / sum;
      for (int j = sub; j < BAND; j += 16) S[r * 577 + j] *= inv; }
    __syncthreads();
    { const int r = t >> 4, dg = t & 15; float acc[8];
#pragma unroll
      for (int i = 0; i < 8; ++i) acc[i] = 0.f;
      for (int j = 0; j < BAND; ++j) { const int kc = c - LOOKBACK + (j >> 6); if (kc < 0) continue;
          const float p = S[r * 577 + j]; float vv[8]; ld8bf(PROJ + (size_t)(b * SEQ + kc * 64 + (j & 63)) * EV_N + EC_VA + h * 128 + dg * 8, vv);
#pragma unroll
          for (int i = 0; i < 8; ++i) acc[i] += p * vv[i]; }
      const int tok = b * SEQ + c * 64 + quarter * 16 + r; float z[8]; ld8bf(PROJ + (size_t)tok * EV_N + EC_ZA + h * 128 + dg * 8, z);
      v4u o; o.x = pk2(acc[0] * siluf_(z[0]), acc[1] * siluf_(z[1])); o.y = pk2(acc[2] * siluf_(z[2]), acc[3] * siluf_(z[3]));
      o.z = pk2(acc[4] * siluf_(z[4]), acc[5] * siluf_(z[5])); o.w = pk2(acc[6] * siluf_(z[6]), acc[7] * siluf_(z[7]));
      if (active) *(v4u*)(Y + (size_t)tok * D_MODEL + h * 128 + dg * 8) = o; }
    __syncthreads();
}
__device__ __forceinline__ void vb_mlstm(const bf16_t* __restrict__ PROJ, const float* __restrict__ GIF, bf16_t* __restrict__ Y, int bid, int t, LAS float* sm  ) {
    LAS float* ks = sm; LAS float* qs = sm + 256; LAS float* part = sm + 512; LAS float* dpart = sm + 768;
    const int vs = bid & 3, h = (bid >> 2) & 3, b = bid >> 4, v = t & 63, kq = t >> 6;
    float C[64];
#pragma unroll
    for (int i = 0; i < 64; ++i) C[i] = 0.f;
    float nreg = 0.f;
    for (int s = 0; s < SEQ; ++s) {
        const size_t tok = (size_t)b * SEQ + s; const bf16_t* pr = PROJ + tok * EV_N;
        const float li = GIF[tok * 8 + h], fpre = GIF[tok * 8 + 4 + h];
        const float fw = sigmoidf_(fpre), iw = expf(li);
        const float kk = bf2f(pr[EC_KB + h * 256 + t]), qq = bf2f(pr[EC_QB + h * 256 + t]) * 0.0625f;
        const float vv = bf2f(pr[EC_VB + h * 256 + vs * 64 + v]);
        ks[t] = kk; qs[t] = qq;
        nreg = fw * nreg + iw * kk;
        float dp = nreg * qq; dp = wave_sum(dp);
        if ((t & 63) == 0) dpart[kq] = dp;
        __syncthreads();
        float np = 0.f; const float iv = iw * vv;
#pragma unroll
        for (int i = 0; i < 64; ++i) { C[i] = fw * C[i] + ks[kq * 64 + i] * iv; np += C[i] * qs[kq * 64 + i]; }
        part[kq * 64 + v] = np;
        __syncthreads();
        if (t < 64) { const float num = (part[t] + part[64 + t]) + (part[128 + t] + part[192 + t]); const float den = (dpart[0] + dpart[1]) + (dpart[2] + dpart[3]);
            const float hh = num / fmaxf(fabsf(den), 1.0f);
            const float ob = bf2f(pr[EC_OB + h * 256 + vs * 64 + t]), zb = bf2f(pr[EC_ZB + h * 256 + vs * 64 + t]);
            Y[tok * D_MODEL + W_A + h * 256 + vs * 64 + t] = (bf16_t)f2bf(sigmoidf_(ob) * hh * siluf_(zb)); }
        __syncthreads();
    }
}
__device__ __forceinline__ void phase_mix0(const Ptrs& P, LAS unsigned char* lds, int G) {
    const bf16_t* PROJ = (const bf16_t*)(P.ws + WS_PROJ); bf16_t* Y = (bf16_t*)(P.ws + WS_Y); const float* GIF = (const float*)(P.ws + WS_GIF);
    const int tid = threadIdx.x, half = tid >> 8, t = tid & 255, w = blockIdx.x;
    constexpr int NML = BATCH * H_B * 4 / 2;
    if (w < NML) { vb_mlstm(PROJ, GIF, Y, 2 * w + half, t, (LAS float*)(lds + half * 4096)); }
    else { const int NA = G - NML, wa = w - NML; constexpr int NVB = BATCH * H_A * NCH * 4;
        LAS float* qs = (LAS float*)(lds + half * 49152); LAS float* S = qs + 16 * 128;
        for (int it = 0; it * NA * 2 < NVB; ++it) { const int vb = (it * NA + wa) * 2 + half;
            vb_attn(PROJ, P.in[IN_EV_QNG], P.in[IN_EV_KNG], P.in[IN_EV_REL], Y, vb, t, qs, S, vb < NVB); } }
}
constexpr size_t WS_RA = WS_FREE1, WS_RINP = WS_XB, WS_Q2 = 4 * MiB, WS_K2 = 36 * MiB, WS_V2 = 465 * MiB;
__device__ __forceinline__ void vb_rglru_gates(const bf16_t* __restrict__ PROJ, const float* __restrict__ ccw, const float* __restrict__ ccb, const float* __restrict__ gw, const float* __restrict__ gb,
                                               const float* __restrict__ lam, float* __restrict__ A, float* __restrict__ INP, int bid, int t, LAS float* xs  ) {
    const int blk = bid & 7, tg = bid >> 3, c = blk * 128 + t;
    float xc[8];
#pragma unroll
    for (int i = 0; i < 8; ++i) { const int tok = tg * 8 + i, s = tok % SEQ; float a = ccb[c];
#pragma unroll
        for (int j = 0; j < 4; ++j) { const int sj = s - 3 + j; if (sj >= 0) a += ccw[j * W_C + c] * bf2f(PROJ[(size_t)(tok - 3 + j) * OD_N + OC_XC + c]); }
        xc[i] = a; xs[i * 128 + t] = a; }
    __syncthreads();
    float rp[8], ip[8];
#pragma unroll
    for (int i = 0; i < 8; ++i) { rp[i] = 0.f; ip[i] = 0.f; }
    const float* g0 = gw + (size_t)blk * 128 * 256;
    for (int k = 0; k < 128; ++k) { const float wr_ = g0[k * 256 + t], wi_ = g0[k * 256 + 128 + t];
#pragma unroll
        for (int i = 0; i < 8; ++i) { const float xv = xs[i * 128 + k]; rp[i] += xv * wr_; ip[i] += xv * wi_; } }
    const float sp = softplusf_(-lam[c]); const float gbr = gb[c], gbi = gb[W_C + c];
#pragma unroll
    for (int i = 0; i < 8; ++i) { const int tok = tg * 8 + i; const float r = sigmoidf_(rp[i] + gbr), ig = sigmoidf_(ip[i] + gbi);
        const float la = -8.0f * r * sp; A[(size_t)tok * W_C + c] = expf(la); INP[(size_t)tok * W_C + c] = sqrtf(-expm1f(2.0f * la)) * (ig * xc[i]); }
    __syncthreads();
}
__device__ __forceinline__ void vb_dn_prep(const bf16_t* __restrict__ PROJ, const float* __restrict__ cdw, bf16_t* __restrict__ Q2, bf16_t* __restrict__ K2, bf16_t* __restrict__ V2, int bid, int t, LAS float* red  ) {
    const int h = bid & 7, tok = bid >> 3, s = tok % SEQ; float o[3];
#pragma unroll
    for (int p = 0; p < 3; ++p) { const int col = p * W_D + h * 128 + t; float a = 0.f;
#pragma unroll
        for (int j = 0; j < 4; ++j) { const int sj = s - 3 + j; if (sj >= 0) a += cdw[j * 3 * W_D + col] * bf2f(PROJ[(size_t)(tok - 3 + j) * OD_N + OC_QD + col]); }
        o[p] = siluf_(a); }
    float sq = wave_sum(o[0] * o[0]), sk = wave_sum(o[1] * o[1]);
    if ((t & 63) == 0) { red[(t >> 6) * 2 + 0] = sq; red[(t >> 6) * 2 + 1] = sk; }
    __syncthreads();
    sq = red[0] + red[2]; sk = red[1] + red[3];
    const size_t o_ = (size_t)tok * W_D + h * 128 + t;
    Q2[o_] = (bf16_t)f2bf(o[0] * (1.0f / sqrtf(sq + EPS))); K2[o_] = (bf16_t)f2bf(o[1] * (1.0f / sqrtf(sk + EPS))); V2[o_] = (bf16_t)f2bf(o[2]);
    __syncthreads();
}
__device__ __forceinline__ void phase_mix1a(const Ptrs& P, LAS unsigned char* lds, int G) {
    const bf16_t* PROJ = (const bf16_t*)(P.ws + WS_PROJ);
    float* A = (float*)(P.ws + WS_RA); float* INP = (float*)(P.ws + WS_RINP); bf16_t* Q2 = (bf16_t*)(P.ws + WS_Q2); bf16_t* K2 = (bf16_t*)(P.ws + WS_K2); bf16_t* V2 = (bf16_t*)(P.ws + WS_V2);
    const int tid = threadIdx.x, q4 = tid >> 7, t = tid & 127;
    for (int it = blockIdx.x; it < M_TOK * 8 / 8 / 4; it += G)
        vb_rglru_gates(PROJ, P.in[IN_OD_CCW], P.in[IN_OD_CCB], P.in[IN_OD_GW], P.in[IN_OD_GB], P.in[IN_OD_LAM], A, INP, it * 4 + q4, t, (LAS float*)(lds + q4 * 4096));
    for (int it = blockIdx.x; it < M_TOK * H_D / 4; it += G)
        vb_dn_prep(PROJ, P.in[IN_OD_CDW], Q2, K2, V2, it * 4 + q4, t, (LAS float*)(lds + q4 * 64));
}
__device__ __forceinline__ void vb_dn_scan(const bf16_t* __restrict__ PROJ, const bf16_t* __restrict__ Q2, const bf16_t* __restrict__ K2, const bf16_t* __restrict__ V2, const float* __restrict__ AB,
                                           const float* __restrict__ a_log, const float* __restrict__ dt_bias, const float* __restrict__ onorm, bf16_t* __restrict__ Y, int bid, int t, LAS float* sm  ) {
    LAS float* ks = sm; LAS float* qs = sm + 128; LAS float* part = sm + 256; LAS float* red = sm + 512;
    const int h = bid & 7, b = bid >> 3, v = t & 127, kh = t >> 7;
    float S[64];
#pragma unroll
    for (int i = 0; i < 64; ++i) S[i] = 0.f;
    const float Aexp = expf(a_log[h]), dtb = dt_bias[h], og = onorm[v];
    for (int s = 0; s < SEQ; ++s) {
        const size_t tok = (size_t)b * SEQ + s; const size_t o_ = tok * W_D + h * 128;
        if (t < 128) ks[t] = bf2f(K2[o_ + t]); else qs[t - 128] = bf2f(Q2[o_ + t - 128]) * 0.08838834764831845f;
        const float vv = bf2f(V2[o_ + v]);
        const float beta = sigmoidf_(AB[tok * 16 + 8 + h]); const float g = -Aexp * softplusf_(AB[tok * 16 + h] + dtb); const float al = expf(g);
        __syncthreads();
        float rp = 0.f;
#pragma unroll
        for (int i = 0; i < 64; ++i) rp += S[i] * ks[kh * 64 + i];
        part[kh * 128 + v] = rp;
        __syncthreads();
        const float r = part[v] + part[128 + v];
        const float u = beta * (vv - al * r);
        float op = 0.f;
#pragma unroll
        for (int i = 0; i < 64; ++i) { S[i] = al * S[i] + ks[kh * 64 + i] * u; op += S[i] * qs[kh * 64 + i]; }
        __syncthreads();
        part[kh * 128 + v] = op;
        __syncthreads();
        const float o = part[v] + part[128 + v];
        float sq = (t < 128) ? o * o : 0.f; sq = wave_sum(sq);
        if (t == 0) red[0] = sq; if (t == 64) red[1] = sq;
        __syncthreads();
        if (t < 128) { const float ms = (red[0] + red[1]) * (1.0f / 128.0f);
            const float zd = bf2f(PROJ[tok * OD_N + OC_ZD + h * 128 + t]);
            Y[tok * D_MODEL + W_C + h * 128 + t] = (bf16_t)f2bf(o * (1.0f / sqrtf(ms + EPS)) * og * siluf_(zd)); }
    }
}
__device__ __forceinline__ void phase_mix1b(const Ptrs& P, LAS unsigned char* lds, int G) {
    const bf16_t* PROJ = (const bf16_t*)(P.ws + WS_PROJ); bf16_t* Y = (bf16_t*)(P.ws + WS_Y); const float* AB = (const float*)(P.ws + WS_AB);
    const float* A = (const float*)(P.ws + WS_RA); const float* INP = (const float*)(P.ws + WS_RINP); const bf16_t* Q2 = (const bf16_t*)(P.ws + WS_Q2); const bf16_t* K2 = (const bf16_t*)(P.ws + WS_K2); const bf16_t* V2 = (const bf16_t*)(P.ws + WS_V2);
    const int tid = threadIdx.x, w = blockIdx.x;
    if (w < 32) vb_dn_scan(PROJ, Q2, K2, V2, AB, P.in[IN_OD_ALOG], P.in[IN_OD_DTB], P.in[IN_OD_ONORM], Y, 2 * w + (tid >> 8), tid & 255, (LAS float*)(lds + (tid >> 8) * 4096));
    else if (w < 48) { const int gid = (w - 32) * 512 + tid, b = gid / W_C, c = gid % W_C; float h = 0.f;
        for (int s = 0; s < SEQ; ++s) { const size_t tok = (size_t)b * SEQ + s; h = A[tok * W_C + c] * h + INP[tok * W_C + c];
            Y[tok * D_MODEL + c] = (bf16_t)f2bf(h * siluf_(bf2f(PROJ[tok * OD_N + OC_ZC + c]))); } }
}
typedef GAS unsigned gu32;
#define RLX_AGENT __ATOMIC_RELAXED, __HIP_MEMORY_SCOPE_AGENT
constexpr int CW_BAR = 4096;
static_assert((CW_BAR + XCD_BAR_WORDS) * 4 <= (int)CTL_ZERO_BYTES, "CTL words inside the memset region");
constexpr int RING_OFF = 0, RING_BYTES = 131072;
constexpr int LDSCTL_OFF = RING_BYTES, MISC_OFF = LDSCTL_OFF + 320;
constexpr int LDS_BYTES = 147456;

struct Args { Ptrs P; int ph_lo, ph_hi; };
constexpr int N_PHASES = 8;

__global__ void __launch_bounds__(NWAVES * 64, 2) fwd_mega(Args args) {
    extern __shared__ __attribute__((aligned(16))) unsigned char lds_raw[];
    LAS unsigned char* lds = (LAS unsigned char*)lds_raw;
    volatile LAS unsigned* MISC = (volatile LAS unsigned*)(lds + MISC_OFF);
    const int tid = threadIdx.x, lane = tid & 63, wave = __builtin_amdgcn_readfirstlane(tid >> 6);
    const int G = gridDim.x;
    for (int u = tid; u < (LDS_BYTES - LDSCTL_OFF) / 4; u += NWAVES * 64) ((LAS unsigned*)(lds + LDSCTL_OFF))[u] = 0u;
    __syncthreads();
    const Ptrs& P = args.P;
    gu32* ctl = (gu32*)(P.ws + WS_CTL);
    const int lo = args.ph_lo, hi = args.ph_hi;
    XcdBarrier bar; bar.bar = (unsigned*)(ctl + CW_BAR); bar.x = 0; bar.st = nullptr;
    if (hi - lo > 1) bar = xcd_barrier_post((unsigned*)(ctl + CW_BAR), MISC + 8);
#define IN(k) (lo <= (k) && (k) < hi)
#define SEAM(k) do { if (IN(k) && IN((k) + 1)) xcd_barrier(bar); } while (0)
    if (IN(0)) { phase_prologue(P, lds, wave, lane, blockIdx.x * NWAVES + wave, G * NWAVES); }
    SEAM(0);
    if (IN(1)) { phase_gemm<1>(P, lds, G, blockIdx.x); }
    SEAM(1);
    if (IN(2)) { phase_mix0(P, lds, G); }
    SEAM(2);
    if (IN(3)) { phase_gemm<2>(P, lds, G, blockIdx.x); }
    SEAM(3);
    if (IN(4)) { phase_gemm<3>(P, lds, G, blockIdx.x); phase_gates_ab(P, G); }
    SEAM(4);
    if (IN(5)) { phase_mix1a(P, lds, G); }
    SEAM(5);
    if (IN(6)) { phase_mix1b(P, lds, G); }
    SEAM(6);
    if (IN(7)) { phase_gemm<4>(P, lds, G, blockIdx.x); }
#undef IN
#undef SEAM
}
extern "C" void kernel_launch(void* const* d_in, const int* in_sizes, int n_in, void* d_out, int out_size, void* d_ws, size_t ws_size, hipStream_t stream) {
    static int grid = 0;
    if (grid == 0) {
        if (n_in != 20 || in_sizes[0] != M_TOK * D_MODEL || out_size != M_TOK * D_MODEL || ws_size < WS_END) {
            fprintf(stderr, "kernel_launch: unexpected shapes: n_in %d in0 %d out %d ws %zu (need %zu)\n", n_in, n_in > 0 ? in_sizes[0] : -1, out_size, ws_size, (size_t)WS_END); grid = -1; return; }
        int dev = 0, cus = 0, per_cu = 0;
        if (hipGetDevice(&dev) != hipSuccess || hipDeviceGetAttribute(&cus, hipDeviceAttributeMultiprocessorCount, dev) != hipSuccess) { grid = -1; return; }
        if (hipFuncSetAttribute((const void*)fwd_mega, hipFuncAttributeMaxDynamicSharedMemorySize, LDS_BYTES) != hipSuccess) { fprintf(stderr, "kernel_launch: hipFuncSetAttribute failed\n"); grid = -1; return; }
        if (hipOccupancyMaxActiveBlocksPerMultiprocessor(&per_cu, (const void*)fwd_mega, NWAVES * 64, LDS_BYTES) != hipSuccess || per_cu < 1) { fprintf(stderr, "kernel_launch: occupancy query says %d blocks per CU\n", per_cu); per_cu = 1; }
        (void)hipGetLastError();
        grid = cus;
    }
    if (grid < 0) return;
    if (hipMemsetAsync((char*)d_ws + WS_CTL, 0, CTL_ZERO_BYTES, stream) != hipSuccess) { fprintf(stderr, "kernel_launch: memset failed\n"); return; }
    Args a{};
    for (int i = 0; i < 20; ++i) a.P.in[i] = (const float*)d_in[i];
    a.P.out = (float*)d_out; a.P.ws = (unsigned char*)d_ws; a.ph_lo = 0; a.ph_hi = N_PHASES;
    hipLaunchKernelGGL(fwd_mega, dim3(grid), dim3(NWAVES * 64), LDS_BYTES, stream, a);
    const hipError_t le = hipPeekAtLastError();
    if (le != hipSuccess) fprintf(stderr, "kernel_launch: launch failed: %s\n", hipGetErrorName(le));
}
```

```cpp
#include <hip/hip_runtime.h>
#include <cstdio>
#include <cstdint>
#include <cmath>

constexpr int D_MODEL = 2048, BATCH = 8, SEQ = 2048, M_TOK = BATCH * SEQ;
constexpr int CHUNK = 64, NCH = SEQ / CHUNK;
constexpr float EPS = 1e-6f;
constexpr int HD_A = 128, W_A = 1024, H_A = 8, LOOKBACK = 8, BAND = (LOOKBACK + 1) * CHUNK, REL_MAX = 256, NREL = 2 * REL_MAX + 1;
constexpr int H_B = 4, W_B = 1024, HD_B = 256;
constexpr int W_C = 1024, N_BLK_C = 8, BLK_C = 128;
constexpr int HD_D = 128, W_D = 1024, H_D = 8;
constexpr int EV_IN = 9224, EV_N = 9216;
constexpr int OD_IN = 6160, OD_N = 6144;
constexpr int EC_QA = 0, EC_KA = 1024, EC_VA = 2048, EC_ZA = 3072, EC_QB = 4096, EC_KB = 5120, EC_VB = 6144, EC_OB = 7168, EC_ZB = 8192;
constexpr int OC_XC = 0, OC_ZC = 1024, OC_QD = 2048, OC_KD = 3072, OC_VD = 4096, OC_ZD = 5120;

constexpr size_t MiB = 1u << 20;
constexpr size_t WS_CTL = 0, CTL_ZERO_BYTES = 1 * MiB;
constexpr size_t WS_R0 = 1 * MiB;
constexpr size_t WS_SS1 = WS_R0 + 64 * 1024;
constexpr size_t WS_GIF = WS_SS1 + 64 * 1024;
constexpr size_t WS_AB = WS_GIF + 512 * 1024;
constexpr size_t WS_W1T = 4 * MiB;
constexpr size_t WS_W2T = 40 * MiB;
constexpr size_t WS_W3T = 48 * MiB;
constexpr size_t WS_W4T = 73 * MiB;
constexpr size_t WS_XB = 81 * MiB;
constexpr size_t WS_Y = 145 * MiB;
constexpr size_t WS_PROJ = 209 * MiB;
constexpr size_t WS_END = 497 * MiB;
constexpr size_t WS_FREE1 = 401 * MiB;

typedef unsigned short bf16_t;
__device__ __forceinline__ float bf2f(unsigned short v) { return __builtin_bit_cast(float, (unsigned)v << 16); }
__device__ __forceinline__ unsigned f2bf(float f) { unsigned u = __builtin_bit_cast(unsigned, f); return (u + 0x7fffu + ((u >> 16) & 1u)) >> 16; }
__device__ __forceinline__ unsigned pk2(float lo, float hi) { return f2bf(lo) | (f2bf(hi) << 16); }
__device__ __forceinline__ float sigmoidf_(float x) { return 1.f / (1.f + expf(-x)); }
__device__ __forceinline__ float siluf_(float x) { return x / (1.f + expf(-x)); }
__device__ __forceinline__ float softplusf_(float x) { return fmaxf(x, 0.f) + log1pf(expf(-fabsf(x))); }
__device__ __forceinline__ float logsigmoidf_(float x) { return -softplusf_(-x); }

namespace pg8 {
#define PG8_LAS __attribute__((address_space(3)))
typedef unsigned short bf16_t;
typedef short bf16x8 __attribute__((ext_vector_type(8)));
typedef float f32x4 __attribute__((ext_vector_type(4)));
typedef unsigned u32x4 __attribute__((ext_vector_type(4)));
constexpr int BM = 256, BK = 64, HALF = 128, HTB = HALF * BK * 2  , STAGE_BYTES = 8 * HTB, NXCD = 8, WGM = 8;

__host__ __device__ __forceinline__ int lds_byte(int r, int c) { const int st = (r >> 4) * 2 + (c >> 5), rr = r & 15, cc = c & 31, ob = rr * 64 + cc * 2; return st * 1024 + (ob ^ (((ob >> 9) & 1) << 5)); }
__host__ __device__ __forceinline__ void stage_rc(int b, int& R, int& C) { const int st = b / 1024, sb = b % 1024, swz = sb ^ (((sb >> 9) & 1) << 5); R = (st >> 1) * 16 + swz / 64; C = (st & 1) * 32 + (swz % 64) / 2; }
__host__ __device__ __forceinline__ int perm32(int rho) { const int n = rho >> 4, i = rho & 15; return 8 * (i >> 2) + 4 * n + (i & 3); }

struct Unit { int pm, pn; };
struct Gemm { const bf16_t* A; const bf16_t* Bt; int M, N, K; };

struct StaticOrder {
    int nM, nN, nwg, G, c;
    __host__ __device__ void init(int M, int N, int G_, int c_) { nM = M / BM; nN = N / BM; nwg = nM * nN; G = G_; c = c_; }
    __host__ __device__ bool next(int i, Unit& u) const {
        const long L = (long)i * G + c; if (L >= nwg) return false;
        int wgid = (int)L; { const int q = nwg / NXCD, r = nwg % NXCD, xcd = wgid % NXCD, off = wgid / NXCD; wgid = (xcd < r ? xcd * (q + 1) : r * (q + 1) + (xcd - r) * q) + off; }
        const int nig = WGM * nN, gid = wgid / nig, fm = gid * WGM, gsz = (nM - fm) < WGM ? (nM - fm) : WGM;
        u.pm = fm + ((wgid % nig) % gsz); u.pn = (wgid % nig) / gsz; return true;
    }
    __device__ __forceinline__ void a_ready(const Unit&) const {}
    __device__ __forceinline__ void done(const Unit&) const {}
};

__device__ __forceinline__ unsigned cvt_pk_bf16(float lo, float hi) { unsigned r; asm volatile("v_cvt_pk_bf16_f32 %0, %1, %2" : "=v"(r) : "v"(lo), "v"(hi)); return r; }
struct EpiProj {
    static constexpr bool PERM = true, AFTER_DRAIN = false;
    bf16_t* O; int ldc; const float* rowv; int mode;
    __device__ __forceinline__ void operator()(const f32x4 (&acc)[2][2][4][2], const Unit& u, int wr, int wc, int fr, int fq) const {
        const int row0 = u.pm * BM + wr * 64 + fr; const int col0 = u.pn * BM + wc * 32 + 8 * fq;
#pragma unroll
        for (int ai = 0; ai < 2; ++ai)
#pragma unroll
            for (int m = 0; m < 4; ++m) { const int row = row0 + ai * HALF + m * 16; float sc = rowv[row]; if (mode) sc = 1.0f / sqrtf(sc * (1.0f / 2048.0f) + 1e-6f);
                bf16_t* rowp = O + (size_t)row * ldc + col0;
#pragma unroll
                for (int bj = 0; bj < 2; ++bj) { const f32x4 v0 = acc[ai][bj][m][0] * sc, v1 = acc[ai][bj][m][1] * sc;
                    u32x4 w; w.x = cvt_pk_bf16(v0[0], v0[1]); w.y = cvt_pk_bf16(v0[2], v0[3]); w.z = cvt_pk_bf16(v1[0], v1[1]); w.w = cvt_pk_bf16(v1[2], v1[3]);
                    *(u32x4*)(rowp + bj * HALF) = w; } }
    }
};
struct EpiRes {
    static constexpr bool PERM = false, AFTER_DRAIN = false;
    const float* base; float* out; bf16_t* xb; float* sumsq; int ldc;
    __device__ __forceinline__ void operator()(const f32x4 (&acc)[2][2][4][2], const Unit& u, int wr, int wc, int fr, int fq) const {
        typedef unsigned u32x2v __attribute__((ext_vector_type(2)));
        const int col0 = u.pn * BM + wc * 32 + 4 * fq;
#pragma unroll
        for (int ai = 0; ai < 2; ++ai)
#pragma unroll
            for (int m = 0; m < 4; ++m) { const int row = u.pm * BM + ai * HALF + wr * 64 + m * 16 + fr; const size_t off = (size_t)row * ldc + col0; float ss = 0.f;
#pragma unroll
                for (int bj = 0; bj < 2; ++bj)
#pragma unroll
                    for (int n = 0; n < 2; ++n) { const f32x4 o = *(const f32x4*)(base + off + bj * HALF + n * 16) + acc[ai][bj][m][n];
                        *(f32x4*)(out + off + bj * HALF + n * 16) = o;
                        if (xb) { u32x2v w; w.x = cvt_pk_bf16(o[0], o[1]); w.y = cvt_pk_bf16(o[2], o[3]); *(u32x2v*)(xb + off + bj * HALF + n * 16) = w; }
                        ss += (o[0] * o[0] + o[1] * o[1]) + (o[2] * o[2] + o[3] * o[3]); }
                if (sumsq) { ss += __shfl_xor(ss, 16); ss += __shfl_xor(ss, 32); if (fq == 0) atomicAdd(sumsq + row, ss); } }
    }
};

template <class Epi, class Sched, bool ALIGN_EPI = false, bool SP2 = false>
__device__ __forceinline__ void gemm_phase(PG8_LAS unsigned char* lds, const Gemm g, const Sched& S, const Epi& E) {
    const int tid = threadIdx.x, wid = __builtin_amdgcn_readfirstlane(tid >> 6), lane = tid & 63, wr = wid >> 2, wc = wid & 3, fr = lane & 15, fq = lane >> 4;
    const int K = g.K, nt = K / BK;
    unsigned voffA[2], voffB[2];
#pragma unroll
    for (int i = 0; i < 2; ++i) { int R, C; stage_rc(tid * 16 + i * 8192, R, C); const int Rb = Epi::PERM ? ((R & ~31) + perm32(R & 31)) : R;
        voffA[i] = (unsigned)(R * K + C) * 2u; voffB[i] = (unsigned)(Rb * K + C) * 2u; }
    const size_t kstep = (size_t)(BK * 2);
    const size_t hstep = (size_t)HALF * K * 2;
    const size_t tstep = 2 * hstep;
    const unsigned ldsw = (unsigned)wid * 1024u;
    const int aoff = lds_byte(wr * 64 + fr, fq * 8), boff = lds_byte(wc * 32 + fr, fq * 8);
#define PG8_SA(b, h) (((b) * 2 + (h)) * HTB)
#define PG8_SB(b, h) ((4 + (b) * 2 + (h)) * HTB)
#define PG8_STAGE(bufoff, gbase, voff) do { _Pragma("unroll") for (int _i = 0; _i < 2; ++_i) \
        __builtin_amdgcn_global_load_lds((const unsigned*)((const char*)(gbase) + (voff)[_i]), (PG8_LAS unsigned*)(lds + (bufoff) + ldsw + _i * 8192), 16, 0, 0); } while (0)
#define PG8_LDA(dst, b, h) do { _Pragma("unroll") for (int m = 0; m < 4; ++m) _Pragma("unroll") for (int k = 0; k < 2; ++k) dst[m][k] = *(const PG8_LAS bf16x8*)(lds + PG8_SA(b, h) + aoff + m * 2048 + k * 1024); } while (0)
#define PG8_LDB(dst, b, h) do { _Pragma("unroll") for (int n = 0; n < 2; ++n) _Pragma("unroll") for (int k = 0; k < 2; ++k) dst[n][k] = *(const PG8_LAS bf16x8*)(lds + PG8_SB(b, h) + boff + n * 2048 + k * 1024); } while (0)
#define PG8_MMA(ai, bj, At, Bt) do { __builtin_amdgcn_s_setprio(1); _Pragma("unroll") for (int m = 0; m < 4; ++m) _Pragma("unroll") for (int n = 0; n < 2; ++n) _Pragma("unroll") for (int k = 0; k < 2; ++k) \
        acc[ai][bj][m][n] = __builtin_amdgcn_mfma_f32_16x16x32_bf16(Bt[n][k], At[m][k], acc[ai][bj][m][n], 0, 0, 0); __builtin_amdgcn_s_setprio(0); } while (0)
#define PG8_WAIT_V(n) asm volatile("s_waitcnt vmcnt(" #n ")" ::: "memory")
#define PG8_WAIT_L(n) asm volatile("s_waitcnt lgkmcnt(" #n ")" ::: "memory")
#define PG8_BAR __builtin_amdgcn_s_barrier()
#define PG8_SCHED __builtin_amdgcn_sched_barrier(0)
    Unit cur, nxt; int ui = 0;
    if (!S.next(0, cur)) return;
    f32x4 acc[2][2][4][2];
#pragma unroll
    for (int a = 0; a < 2; ++a)
#pragma unroll
        for (int b = 0; b < 2; ++b)
#pragma unroll
            for (int m = 0; m < 4; ++m)
#pragma unroll
                for (int n = 0; n < 2; ++n) acc[a][b][m][n] = (f32x4){0.f, 0.f, 0.f, 0.f};
    bf16x8 At[4][2], B0[2][2], B1[2][2];
    const char* cA = (const char*)g.A + (size_t)cur.pm * tstep; const char* cB = (const char*)g.Bt + (size_t)cur.pn * tstep;
    S.a_ready(cur);
    if constexpr (SP2) {
        PG8_STAGE(PG8_SB(0, 0), cB, voffB); PG8_STAGE(PG8_SB(0, 1), cB + hstep, voffB); PG8_STAGE(PG8_SA(0, 0), cA, voffA); PG8_STAGE(PG8_SA(0, 1), cA + hstep, voffA);
        if (wr == 1) PG8_BAR;
        PG8_WAIT_V(2); PG8_BAR;
        PG8_STAGE(PG8_SB(1, 0), cB + kstep, voffB); PG8_STAGE(PG8_SA(1, 0), cA + kstep, voffA); PG8_STAGE(PG8_SB(1, 1), cB + hstep + kstep, voffB);
        PG8_WAIT_V(6); PG8_BAR;
    } else {
        PG8_STAGE(PG8_SB(0, 0), cB, voffB); PG8_STAGE(PG8_SA(0, 0), cA, voffA); PG8_STAGE(PG8_SB(0, 1), cB + hstep, voffB); PG8_STAGE(PG8_SA(0, 1), cA + hstep, voffA);
        if (wr == 1) PG8_BAR;
        PG8_WAIT_V(4); PG8_BAR;
        PG8_STAGE(PG8_SB(1, 0), cB + kstep, voffB); PG8_STAGE(PG8_SA(1, 0), cA + kstep, voffA); PG8_STAGE(PG8_SB(1, 1), cB + hstep + kstep, voffB);
        PG8_WAIT_V(6); PG8_BAR;
    }
    for (;;) {
        const bool has_next = S.next(ui + 1, nxt);
        const char* nA = has_next ? (const char*)g.A + (size_t)nxt.pm * tstep : cA; const char* nB = has_next ? (const char*)g.Bt + (size_t)nxt.pn * tstep : cB;
        for (int t = 0; t < nt; t += 2) {
            const bool last = (t == nt - 2);
            const char* a1 = cA + (size_t)(t + 1) * kstep;
            const char* a2 = last ? nA : cA + (size_t)(t + 2) * kstep; const char* b2 = last ? nB : cB + (size_t)(t + 2) * kstep;
            const char* a3 = a2 + kstep; const char* b3 = b2 + kstep;
            if (last && has_next) S.a_ready(nxt);
            if constexpr (SP2) {
            PG8_LDB(B0, 0, 0); PG8_LDB(B1, 0, 1); PG8_SCHED; PG8_LDA(At, 0, 0); PG8_STAGE(PG8_SA(1, 1), a1 + hstep, voffA);
            PG8_WAIT_V(8); PG8_WAIT_L(0); PG8_BAR; PG8_MMA(0, 0, At, B0); PG8_MMA(0, 1, At, B1); PG8_BAR; PG8_SCHED;
            PG8_LDA(At, 0, 1); PG8_STAGE(PG8_SB(0, 0), b2, voffB); PG8_STAGE(PG8_SB(0, 1), b2 + hstep, voffB); PG8_STAGE(PG8_SA(0, 0), a2, voffA);
            PG8_WAIT_V(8); PG8_WAIT_L(0); PG8_BAR; PG8_MMA(1, 0, At, B0); PG8_MMA(1, 1, At, B1); PG8_BAR; PG8_SCHED;
            PG8_LDB(B0, 1, 0); PG8_LDB(B1, 1, 1); PG8_SCHED; PG8_LDA(At, 1, 0); PG8_STAGE(PG8_SA(0, 1), a2 + hstep, voffA);
            PG8_WAIT_V(8); PG8_WAIT_L(0); PG8_BAR; PG8_MMA(0, 0, At, B0); PG8_MMA(0, 1, At, B1); PG8_BAR; PG8_SCHED;
            PG8_LDA(At, 1, 1); PG8_STAGE(PG8_SB(1, 0), b3, voffB); PG8_STAGE(PG8_SB(1, 1), b3 + hstep, voffB); PG8_STAGE(PG8_SA(1, 0), a3, voffA);
            PG8_WAIT_V(8); PG8_WAIT_L(0); PG8_BAR; PG8_MMA(1, 0, At, B0); PG8_MMA(1, 1, At, B1); PG8_BAR; PG8_SCHED;
            } else {
            PG8_LDB(B0, 0, 0); PG8_SCHED; PG8_LDA(At, 0, 0); PG8_STAGE(PG8_SA(1, 1), a1 + hstep, voffA);
            PG8_WAIT_L(8); PG8_BAR; PG8_WAIT_L(0); PG8_MMA(0, 0, At, B0); PG8_BAR; PG8_SCHED;
            PG8_LDB(B1, 0, 1); PG8_STAGE(PG8_SB(0, 0), b2, voffB);
            PG8_BAR; PG8_WAIT_L(0); PG8_MMA(0, 1, At, B1); PG8_BAR;
            PG8_LDA(At, 0, 1); PG8_STAGE(PG8_SA(0, 0), a2, voffA);
            PG8_BAR; PG8_WAIT_L(0); PG8_MMA(1, 0, At, B0); PG8_BAR; PG8_SCHED;
            PG8_STAGE(PG8_SB(0, 1), b2 + hstep, voffB);
            PG8_WAIT_V(6); PG8_BAR; PG8_MMA(1, 1, At, B1); PG8_BAR;
            PG8_LDB(B0, 1, 0); PG8_SCHED; PG8_LDA(At, 1, 0); PG8_STAGE(PG8_SA(0, 1), a2 + hstep, voffA);
            PG8_WAIT_L(8); PG8_BAR; PG8_WAIT_L(0); PG8_MMA(0, 0, At, B0); PG8_BAR; PG8_SCHED;
            PG8_LDB(B1, 1, 1); PG8_STAGE(PG8_SB(1, 0), b3, voffB);
            PG8_BAR; PG8_WAIT_L(0); PG8_MMA(0, 1, At, B1); PG8_BAR;
            PG8_LDA(At, 1, 1); PG8_STAGE(PG8_SA(1, 0), a3, voffA);
            PG8_BAR; PG8_WAIT_L(0); PG8_MMA(1, 0, At, B0); PG8_BAR; PG8_SCHED;
            PG8_STAGE(PG8_SB(1, 1), b3 + hstep, voffB);
            PG8_WAIT_V(6); PG8_BAR; PG8_MMA(1, 1, At, B1); PG8_BAR;
            }
        }
        if constexpr (ALIGN_EPI) { if (wr == 0) PG8_BAR; }
        if constexpr (!Epi::AFTER_DRAIN) { E(acc, cur, wr, wc, fr, fq); S.done(cur); }
        if (!has_next) break;
#pragma unroll
        for (int a = 0; a < 2; ++a)
#pragma unroll
            for (int b = 0; b < 2; ++b)
#pragma unroll
                for (int m = 0; m < 4; ++m)
#pragma unroll
                    for (int n = 0; n < 2; ++n) acc[a][b][m][n] = (f32x4){0.f, 0.f, 0.f, 0.f};
        cur = nxt; cA = nA; cB = nB; ++ui;
        if constexpr (ALIGN_EPI) { if (wr == 1) PG8_BAR; }
    }
    PG8_WAIT_V(0);
    if constexpr (!ALIGN_EPI) { if (wr == 0) PG8_BAR; }
    PG8_BAR;
    if constexpr (Epi::AFTER_DRAIN) { E.fused(acc, cur, wr, wc, fr, fq, lds, wid, lane); S.done(cur); }
#undef PG8_SA
#undef PG8_SB
#undef PG8_STAGE
#undef PG8_LDA
#undef PG8_LDB
#undef PG8_MMA
#undef PG8_WAIT_V
#undef PG8_WAIT_L
#undef PG8_BAR
#undef PG8_SCHED
}
}
#define GAS __attribute__((address_space(1)))
#define LAS __attribute__((address_space(3)))
typedef unsigned v4u __attribute__((ext_vector_type(4)));
typedef float f32x4 __attribute__((ext_vector_type(4)));
#define LDS_WAIT() asm volatile("s_waitcnt lgkmcnt(0)" ::: "memory")
constexpr int NWAVES = 8;
constexpr int GEMM_LDS = 131072;

struct Ptrs {
    const float* in[20]; float* out; unsigned char* ws;
};
#define IN_X 0
#define IN_EV_NORM 1
#define IN_EV_WIN 2
#define IN_EV_IFB 3
#define IN_EV_QNG 4
#define IN_EV_KNG 5
#define IN_EV_REL 6
#define IN_EV_WOUT 7
#define IN_OD_NORM 8
#define IN_OD_WIN 9
#define IN_OD_CCW 10
#define IN_OD_CCB 11
#define IN_OD_GW 12
#define IN_OD_GB 13
#define IN_OD_LAM 14
#define IN_OD_CDW 15
#define IN_OD_ALOG 16
#define IN_OD_DTB 17
#define IN_OD_ONORM 18
#define IN_OD_WOUT 19

__device__ __forceinline__ float wave_sum(float v) {
#pragma unroll
    for (int o = 1; o < 64; o <<= 1) v += __shfl_xor(v, o);
    return v;
}
__device__ __forceinline__ void p0_transpose_item(const float* W, int K, int ldw, int nblk, const float* gain, bf16_t* WT, LAS float* scr, int item, int lane) {
    const int kb = item / nblk, nb = item % nblk, k0 = 64 * kb, n0 = 32 * nb;
#pragma unroll 8
    for (int i = 0; i < 32; ++i) { const int kk = 2 * i + (lane >> 5); const float g = gain ? gain[k0 + kk] : 1.0f; scr[kk * 33 + (lane & 31)] = g * W[(size_t)(k0 + kk) * ldw + n0 + (lane & 31)]; }
    LDS_WAIT(); asm volatile("" ::: "memory");
    const int c = lane & 7;
#pragma unroll
    for (int j = 0; j < 4; ++j) { const int n = (lane >> 3) + 8 * j; const LAS float* s = scr + (8 * c) * 33 + n;
        v4u o; o.x = pk2(s[0 * 33], s[1 * 33]); o.y = pk2(s[2 * 33], s[3 * 33]); o.z = pk2(s[4 * 33], s[5 * 33]); o.w = pk2(s[6 * 33], s[7 * 33]);
        *(GAS v4u*)(WT + (size_t)(n0 + n) * K + k0 + 8 * c) = o; }
    LDS_WAIT(); asm volatile("" ::: "memory");
}
__device__ __forceinline__ void phase_prologue(const Ptrs& P, LAS unsigned char* lds, int wave, int lane, int gw, int NGW) {
    unsigned char* ws = P.ws;
    bf16_t* W1T = (bf16_t*)(ws + WS_W1T); bf16_t* W2T = (bf16_t*)(ws + WS_W2T); bf16_t* W3T = (bf16_t*)(ws + WS_W3T); bf16_t* W4T = (bf16_t*)(ws + WS_W4T);
    bf16_t* XB = (bf16_t*)(ws + WS_XB); float* R0 = (float*)(ws + WS_R0); float* SS1 = (float*)(ws + WS_SS1); float* GIF = (float*)(ws + WS_GIF);
    LAS float* scr = (LAS float*)(lds + wave * 16384);
    constexpr int I1 = (D_MODEL / 64) * (EV_N / 32), I2 = (D_MODEL / 64) * (D_MODEL / 32), I3 = (D_MODEL / 64) * (OD_N / 32), I4 = I2, NITEMS = I1 + I2 + I3 + I4;
    for (int it = gw; it < NITEMS; it += NGW) {
        int r = it;
        if (r < I1) { p0_transpose_item(P.in[IN_EV_WIN], D_MODEL, EV_IN, EV_N / 32, P.in[IN_EV_NORM], W1T, scr, r, lane); continue; } r -= I1;
        if (r < I2) { p0_transpose_item(P.in[IN_EV_WOUT], D_MODEL, D_MODEL, D_MODEL / 32, nullptr, W2T, scr, r, lane); continue; } r -= I2;
        if (r < I3) { p0_transpose_item(P.in[IN_OD_WIN], D_MODEL, OD_IN, OD_N / 32, P.in[IN_OD_NORM], W3T, scr, r, lane); continue; } r -= I3;
        p0_transpose_item(P.in[IN_OD_WOUT], D_MODEL, D_MODEL, D_MODEL / 32, nullptr, W4T, scr, r, lane);
    }
    { const int gt = gw * 64 + lane, NT = NGW * 64;
      for (int e = gt; e < 16 * D_MODEL; e += NT) { const int j = e / D_MODEL, k = e % D_MODEL; W3T[(size_t)(OD_N + j) * D_MODEL + k] = (bf16_t)f2bf(P.in[IN_OD_NORM][k] * P.in[IN_OD_WIN][(size_t)k * OD_IN + OD_N + j]); }
      for (int e = gt; e < M_TOK; e += NT) SS1[e] = 0.f; }
    __syncthreads();
    LAS float* G8 = (LAS float*)lds;
    for (int e = threadIdx.x; e < D_MODEL * 8; e += NWAVES * 64) { const int k = e >> 3, j = e & 7; G8[e] = P.in[IN_EV_NORM][k] * P.in[IN_EV_WIN][(size_t)k * EV_IN + EV_N + j]; }
    __syncthreads();
    const float* X = P.in[IN_X];
    for (int m = gw; m < M_TOK; m += NGW) {
        const GAS f32x4* xr = (const GAS f32x4*)(X + (size_t)m * D_MODEL) + lane;
        float s = 0.f;
        GAS unsigned long long* o8 = (GAS unsigned long long*)(XB + (size_t)m * D_MODEL) + lane;
#pragma unroll
        for (int j = 0; j < 8; ++j) { const f32x4 v = xr[64 * j]; s += (v.x * v.x + v.y * v.y) + (v.z * v.z + v.w * v.w);
            o8[64 * j] = (unsigned long long)pk2(v.x, v.y) | ((unsigned long long)pk2(v.z, v.w) << 32); }
        const float r0 = 1.0f / sqrtf(wave_sum(s) * (1.0f / D_MODEL) + EPS);
        float g[8];
#pragma unroll
        for (int i = 0; i < 8; ++i) g[i] = 0.f;
#pragma unroll 1
        for (int j = 0; j < 8; ++j) {
            const f32x4 v = xr[64 * j];
#pragma unroll
            for (int e = 0; e < 4; ++e) { const int k = 4 * lane + 256 * j + e; const f32x4 ga = *(const LAS f32x4*)(G8 + k * 8), gb = *(const LAS f32x4*)(G8 + k * 8 + 4); const float xv = v[e];
                g[0] += xv * ga.x; g[1] += xv * ga.y; g[2] += xv * ga.z; g[3] += xv * ga.w; g[4] += xv * gb.x; g[5] += xv * gb.y; g[6] += xv * gb.z; g[7] += xv * gb.w; }
        }
#pragma unroll
        for (int i = 0; i < 8; ++i) g[i] = wave_sum(g[i]);
        if (lane == 0) R0[m] = r0;
        if (lane < 8) { float gv = g[0];
#pragma unroll
            for (int i = 1; i < 8; ++i) gv = (lane == i) ? g[i] : gv;
            GIF[(size_t)m * 8 + lane] = r0 * gv + P.in[IN_EV_IFB][lane]; }
    }
}

#define XB_TMO      128
#define XB_XCNT(j)  (256  + 64 * (j))
#define XB_XSUB(j)  (1280 + 64 * (j))
#define XB_XGEN(j)  (2304 + 64 * (j))
#define XB_TOP      3328
#define XB_TOPGEN   3392
#define XCD_BAR_WORDS 3456
#define XB_SPIN_CAP (1u << 18)

__device__ __forceinline__ unsigned xb_ld(unsigned* p)              { return __hip_atomic_load(p, __ATOMIC_RELAXED, __HIP_MEMORY_SCOPE_AGENT); }
__device__ __forceinline__ unsigned xb_add(unsigned* p, unsigned v) { return __hip_atomic_fetch_add(p, v, __ATOMIC_RELAXED, __HIP_MEMORY_SCOPE_AGENT); }
__device__ __forceinline__ unsigned xb_xcc_id() { return (unsigned)__builtin_amdgcn_s_getreg((3 << 11) | 20) & 0xFu; }
#define XB_SPIN(cond, bar) do { unsigned _sp = 0; while (cond) { __builtin_amdgcn_s_sleep(1); \
    if ((++_sp & 255u) == 0u) { if (xb_ld(&(bar)[XB_TMO])) break; if (_sp > XB_SPIN_CAP) { atomicAdd(&(bar)[XB_TMO], 1u); break; } } } } while (0)

struct XcdBarrier {
    unsigned* bar; unsigned x;
    volatile LAS unsigned* st;
};

__device__ __forceinline__ XcdBarrier xcd_barrier_post(unsigned* bar, volatile LAS unsigned* st) {
    XcdBarrier b; b.bar = bar; b.x = xb_xcc_id(); b.st = st;
    if (threadIdx.x == 0) (void)xb_add(&bar[XB_XCNT(b.x)], 1u);
    return b;
}
__device__ __forceinline__ void xcd_barrier_complete(unsigned* bar, unsigned x, unsigned& nloc, unsigned& nx) {
    const unsigned G = gridDim.x * gridDim.y * gridDim.z;
    unsigned sum, cnt, mine, sp = 0u;
    for (;;) {
        sum = 0u; cnt = 0u; mine = 0u;
#pragma unroll
        for (unsigned j = 0; j < 16; ++j) { const unsigned c = xb_ld(&bar[XB_XCNT(j)]); sum += c; cnt += (c > 0u) ? 1u : 0u; mine = (j == x) ? c : mine; }
        if (sum == G) break;
        __builtin_amdgcn_s_sleep(1);
        if ((++sp & 255u) == 0u) { if (xb_ld(&bar[XB_TMO])) break; if (sp > XB_SPIN_CAP) { atomicAdd(&bar[XB_TMO], 1u); break; } }
    }
    nloc = mine > 0u ? mine : 1u; nx = cnt > 0u ? cnt : 1u;
}

__device__ __forceinline__ void xcd_barrier(const XcdBarrier& b) {
    asm volatile("s_waitcnt vmcnt(0)" ::: "memory");
    __syncthreads();
    if (threadIdx.x == 0) {
        unsigned* bar = b.bar;
        __builtin_amdgcn_s_waitcnt(0);
        unsigned nloc = b.st[0], nx = b.st[1];
        if (nloc == 0u) { xcd_barrier_complete(bar, b.x, nloc, nx); b.st[0] = nloc; b.st[1] = nx; }
        const unsigned old = xb_add(&bar[XB_XSUB(b.x)], 1u);
        const unsigned gen = old / nloc;
        if (old + 1u == (gen + 1u) * nloc) {
            __builtin_amdgcn_fence(__ATOMIC_RELEASE, "agent");
            asm volatile("s_waitcnt vmcnt(0)" ::: "memory");
            const unsigned og = xb_add(&bar[XB_TOP], 1u);
            const unsigned tg = og / nx;
            if (og + 1u == (tg + 1u) * nx) xb_add(&bar[XB_TOPGEN], 1u);
            else XB_SPIN(xb_ld(&bar[XB_TOPGEN]) == tg, bar);
            __builtin_amdgcn_fence(__ATOMIC_ACQUIRE, "agent");
            xb_add(&bar[XB_XGEN(b.x)], 1u);
            asm volatile("s_waitcnt vmcnt(0)" ::: "memory");
        } else {
            XB_SPIN(xb_ld(&bar[XB_XGEN(b.x)]) == gen, bar);
            __builtin_amdgcn_fence(__ATOMIC_ACQUIRE, "agent");
            asm volatile("s_waitcnt vmcnt(0)" ::: "memory");
        }
    }
    __syncthreads();
}
__device__ __forceinline__ void ld8bf(const bf16_t* p, float (&v)[8]) {
    const v4u w = *(const v4u*)p;
    v[0] = __builtin_bit_cast(float, w.x << 16); v[1] = __builtin_bit_cast(float, w.x & 0xffff0000u);
    v[2] = __builtin_bit_cast(float, w.y << 16); v[3] = __builtin_bit_cast(float, w.y & 0xffff0000u);
    v[4] = __builtin_bit_cast(float, w.z << 16); v[5] = __builtin_bit_cast(float, w.z & 0xffff0000u);
    v[6] = __builtin_bit_cast(float, w.w << 16); v[7] = __builtin_bit_cast(float, w.w & 0xffff0000u);
}
__global__ void __launch_bounds__(256) k_attn_naive(const bf16_t* __restrict__ PROJ, const float* __restrict__ qn_g, const float* __restrict__ kn_g, const float* __restrict__ rel_bias, bf16_t* __restrict__ Y) {
    __shared__ float qs[16][128];
    __shared__ float S[16][577];
    const int bid = blockIdx.x, quarter = bid & 3, c = (bid >> 2) & 31, h = (bid >> 7) & 7, b = bid >> 10, t = threadIdx.x;
    { const int r = t >> 4, sub = t & 15; const int tok = b * SEQ + c * 64 + quarter * 16 + r;
      float v[8]; ld8bf(PROJ + (size_t)tok * EV_N + EC_QA + h * 128 + sub * 8, v);
      float ss = 0.f;
#pragma unroll
      for (int i = 0; i < 8; ++i) ss += v[i] * v[i];
      ss += __shfl_xor(ss, 1); ss += __shfl_xor(ss, 2); ss += __shfl_xor(ss, 4); ss += __shfl_xor(ss, 8);
      const float rs = 1.0f / sqrtf(ss * (1.0f / 128.0f) + EPS);
#pragma unroll
      for (int i = 0; i < 8; ++i) qs[r][sub * 8 + i] = v[i] * rs * qn_g[sub * 8 + i] * 0.08838834764831845f; }
    __syncthreads();
    for (int idx = t; idx < 16 * BAND; idx += 256) {
        const int r = idx / BAND, j = idx % BAND; const int kc = c - LOOKBACK + (j >> 6);
        float s;
        if (kc < 0) s = -1e30f;
        else { const bf16_t* kp = PROJ + (size_t)(b * SEQ + kc * 64 + (j & 63)) * EV_N + EC_KA + h * 128;
            float ss = 0.f, dot = 0.f;
            for (int d = 0; d < 128; d += 8) { float kv[8]; ld8bf(kp + d, kv);
#pragma unroll
                for (int i = 0; i < 8; ++i) { ss += kv[i] * kv[i]; dot += kv[i] * kn_g[d + i] * qs[r][d + i]; } }
            s = dot * (1.0f / sqrtf(ss * (1.0f / 128.0f) + EPS));
            const int qi = quarter * 16 + r; int rel = LOOKBACK * CHUNK + qi - j; rel = rel < -REL_MAX ? -REL_MAX : (rel > REL_MAX ? REL_MAX : rel); rel += REL_MAX;
            s += rel_bias[h * NREL + rel]; }
        S[r][j] = s;
    }
    __syncthreads();
    { const int r = t >> 4, sub = t & 15; float mx = -3.0e38f;
      for (int j = sub; j < BAND; j += 16) mx = fmaxf(mx, S[r][j]);
      mx = fmaxf(mx, __shfl_xor(mx, 1)); mx = fmaxf(mx, __shfl_xor(mx, 2)); mx = fmaxf(mx, __shfl_xor(mx, 4)); mx = fmaxf(mx, __shfl_xor(mx, 8));
      float sum = 0.f;
      for (int j = sub; j < BAND; j += 16) { const float e = expf(S[r][j] - mx); S[r][j] = e; sum += e; }
      sum += __shfl_xor(sum, 1); sum += __shfl_xor(sum, 2); sum += __shfl_xor(sum, 4); sum += __shfl_xor(sum, 8);
      const float inv = 1.0f / sum;
      for (int j = sub; j < BAND; j += 16) S[r][j] *= inv; }
    __syncthreads();
    { const int r = t >> 4, dg = t & 15; float acc[8];
#pragma unroll
      for (int i = 0; i < 8; ++i) acc[i] = 0.f;
      for (int j = 0; j < BAND; ++j) { const int kc = c - LOOKBACK + (j >> 6); if (kc < 0) continue;
          const float p = S[r][j]; float vv[8]; ld8bf(PROJ + (size_t)(b * SEQ + kc * 64 + (j & 63)) * EV_N + EC_VA + h * 128 + dg * 8, vv);
#pragma unroll
          for (int i = 0; i < 8; ++i) acc[i] += p * vv[i]; }
      const int tok = b * SEQ + c * 64 + quarter * 16 + r; float z[8]; ld8bf(PROJ + (size_t)tok * EV_N + EC_ZA + h * 128 + dg * 8, z);
      v4u o; o.x = pk2(acc[0] * siluf_(z[0]), acc[1] * siluf_(z[1])); o.y = pk2(acc[2] * siluf_(z[2]), acc[3] * siluf_(z[3]));
      o.z = pk2(acc[4] * siluf_(z[4]), acc[5] * siluf_(z[5])); o.w = pk2(acc[6] * siluf_(z[6]), acc[7] * siluf_(z[7]));
      *(v4u*)(Y + (size_t)tok * D_MODEL + h * 128 + dg * 8) = o; }
}
__global__ void __launch_bounds__(256) k_mlstm_naive(const bf16_t* __restrict__ PROJ, const float* __restrict__ GIF, bf16_t* __restrict__ Y) {
    __shared__ float ks[256], qs[256], part[4][64], dpart[4];
    const int bid = blockIdx.x, vs = bid & 3, h = (bid >> 2) & 3, b = bid >> 4, t = threadIdx.x, v = t & 63, kq = t >> 6;
    float C[64];
#pragma unroll
    for (int i = 0; i < 64; ++i) C[i] = 0.f;
    float nreg = 0.f;
    for (int s = 0; s < SEQ; ++s) {
        const size_t tok = (size_t)b * SEQ + s; const bf16_t* pr = PROJ + tok * EV_N;
        const float li = GIF[tok * 8 + h], fpre = GIF[tok * 8 + 4 + h];
        const float fw = sigmoidf_(fpre), iw = expf(li);
        const float kk = bf2f(pr[EC_KB + h * 256 + t]), qq = bf2f(pr[EC_QB + h * 256 + t]) * 0.0625f;
        const float vv = bf2f(pr[EC_VB + h * 256 + vs * 64 + v]);
        ks[t] = kk; qs[t] = qq;
        nreg = fw * nreg + iw * kk;
        float dp = nreg * qq; dp = wave_sum(dp);
        if ((t & 63) == 0) dpart[kq] = dp;
        __syncthreads();
        float np = 0.f; const float iv = iw * vv;
#pragma unroll
        for (int i = 0; i < 64; ++i) { C[i] = fw * C[i] + ks[kq * 64 + i] * iv; np += C[i] * qs[kq * 64 + i]; }
        part[kq][v] = np;
        __syncthreads();
        if (t < 64) { const float num = (part[0][t] + part[1][t]) + (part[2][t] + part[3][t]); const float den = (dpart[0] + dpart[1]) + (dpart[2] + dpart[3]);
            const float hh = num / fmaxf(fabsf(den), 1.0f);
            const float ob = bf2f(pr[EC_OB + h * 256 + vs * 64 + t]), zb = bf2f(pr[EC_ZB + h * 256 + vs * 64 + t]);
            Y[tok * D_MODEL + W_A + h * 256 + vs * 64 + t] = (bf16_t)f2bf(sigmoidf_(ob) * hh * siluf_(zb)); }
        __syncthreads();
    }
}
__global__ void __launch_bounds__(128) k_rglru_gates(const bf16_t* __restrict__ PROJ, const float* __restrict__ ccw, const float* __restrict__ ccb, const float* __restrict__ gw, const float* __restrict__ gb,
                                                     const float* __restrict__ lam, float* __restrict__ A, float* __restrict__ INP) {
    __shared__ float xs[8][128];
    const int blk = blockIdx.x & 7, tg = blockIdx.x >> 3, t = threadIdx.x, c = blk * 128 + t;
    float xc[8];
#pragma unroll
    for (int i = 0; i < 8; ++i) { const int tok = tg * 8 + i, s = tok % SEQ; float a = ccb[c];
#pragma unroll
        for (int j = 0; j < 4; ++j) { const int sj = s - 3 + j; if (sj >= 0) a += ccw[j * W_C + c] * bf2f(PROJ[(size_t)(tok - 3 + j) * OD_N + OC_XC + c]); }
        xc[i] = a; xs[i][t] = a; }
    __syncthreads();
    float rp[8], ip[8];
#pragma unroll
    for (int i = 0; i < 8; ++i) { rp[i] = 0.f; ip[i] = 0.f; }
    const float* g0 = gw + (size_t)blk * 128 * 256;
    for (int k = 0; k < 128; ++k) { const float wr_ = g0[k * 256 + t], wi_ = g0[k * 256 + 128 + t];
#pragma unroll
        for (int i = 0; i < 8; ++i) { const float xv = xs[i][k]; rp[i] += xv * wr_; ip[i] += xv * wi_; } }
    const float sp = softplusf_(-lam[c]); const float gbr = gb[c], gbi = gb[W_C + c];
#pragma unroll
    for (int i = 0; i < 8; ++i) { const int tok = tg * 8 + i; const float r = sigmoidf_(rp[i] + gbr), ig = sigmoidf_(ip[i] + gbi);
        const float la = -8.0f * r * sp; A[(size_t)tok * W_C + c] = expf(la); INP[(size_t)tok * W_C + c] = sqrtf(-expm1f(2.0f * la)) * (ig * xc[i]); }
}
__global__ void __launch_bounds__(256) k_rglru_scan(const bf16_t* __restrict__ PROJ, const float* __restrict__ A, const float* __restrict__ INP, bf16_t* __restrict__ Y) {
    const int gid = blockIdx.x * 256 + threadIdx.x, b = gid / W_C, c = gid % W_C; float h = 0.f;
    for (int s = 0; s < SEQ; ++s) { const size_t tok = (size_t)b * SEQ + s; h = A[tok * W_C + c] * h + INP[tok * W_C + c];
        Y[tok * D_MODEL + c] = (bf16_t)f2bf(h * siluf_(bf2f(PROJ[tok * OD_N + OC_ZC + c]))); }
}
__global__ void __launch_bounds__(256) k_gates_ab(const bf16_t* __restrict__ XB, const bf16_t* __restrict__ W3T, const float* __restrict__ SS1, float* __restrict__ AB) {
    const int t = threadIdx.x, row = blockIdx.x * 16 + (t >> 4), j = t & 15;
    const bf16_t* xp = XB + (size_t)row * D_MODEL; const bf16_t* wp = W3T + (size_t)(OD_N + j) * D_MODEL; float acc = 0.f;
    for (int k = 0; k < D_MODEL; k += 8) { float a[8], w[8]; ld8bf(xp + k, a); ld8bf(wp + k, w);
#pragma unroll
        for (int i = 0; i < 8; ++i) acc += a[i] * w[i]; }
    AB[(size_t)row * 16 + j] = acc * (1.0f / sqrtf(SS1[row] * (1.0f / D_MODEL) + EPS));
}
__global__ void __launch_bounds__(128) k_dn_prep(const bf16_t* __restrict__ PROJ, const float* __restrict__ cdw, float* __restrict__ Q2, float* __restrict__ K2, float* __restrict__ V2) {
    __shared__ float red[2][2];
    const int h = blockIdx.x & 7, tok = blockIdx.x >> 3, s = tok % SEQ, t = threadIdx.x; float o[3];
#pragma unroll
    for (int p = 0; p < 3; ++p) { const int col = p * W_D + h * 128 + t; float a = 0.f;
#pragma unroll
        for (int j = 0; j < 4; ++j) { const int sj = s - 3 + j; if (sj >= 0) a += cdw[j * 3 * W_D + col] * bf2f(PROJ[(size_t)(tok - 3 + j) * OD_N + OC_QD + col]); }
        o[p] = siluf_(a); }
    float sq = wave_sum(o[0] * o[0]), sk = wave_sum(o[1] * o[1]);
    if ((t & 63) == 0) { red[t >> 6][0] = sq; red[t >> 6][1] = sk; }
    __syncthreads();
    sq = red[0][0] + red[1][0]; sk = red[0][1] + red[1][1];
    const size_t o_ = (size_t)tok * W_D + h * 128 + t;
    Q2[o_] = o[0] * (1.0f / sqrtf(sq + EPS)); K2[o_] = o[1] * (1.0f / sqrtf(sk + EPS)); V2[o_] = o[2];
}
__global__ void __launch_bounds__(256) k_dn_scan(const bf16_t* __restrict__ PROJ, const float* __restrict__ Q2, const float* __restrict__ K2, const float* __restrict__ V2, const float* __restrict__ AB,
                                                 const float* __restrict__ a_log, const float* __restrict__ dt_bias, const float* __restrict__ onorm, bf16_t* __restrict__ Y) {
    __shared__ float ks[128], qs[128], part[2][128], red[2];
    const int h = blockIdx.x & 7, b = blockIdx.x >> 3, t = threadIdx.x, v = t & 127, kh = t >> 7;
    float S[64];
#pragma unroll
    for (int i = 0; i < 64; ++i) S[i] = 0.f;
    const float Aexp = expf(a_log[h]), dtb = dt_bias[h], og = onorm[v];
    for (int s = 0; s < SEQ; ++s) {
        const size_t tok = (size_t)b * SEQ + s; const size_t o_ = tok * W_D + h * 128;
        if (t < 128) ks[t] = K2[o_ + t]; else qs[t - 128] = Q2[o_ + t - 128] * 0.08838834764831845f;
        const float vv = V2[o_ + v];
        const float beta = sigmoidf_(AB[tok * 16 + 8 + h]); const float g = -Aexp * softplusf_(AB[tok * 16 + h] + dtb); const float al = expf(g);
        __syncthreads();
        float rp = 0.f;
#pragma unroll
        for (int i = 0; i < 64; ++i) rp += S[i] * ks[kh * 64 + i];
        part[kh][v] = rp;
        __syncthreads();
        const float r = part[0][v] + part[1][v];
        const float u = beta * (vv - al * r);
        float op = 0.f;
#pragma unroll
        for (int i = 0; i < 64; ++i) { S[i] = al * S[i] + ks[kh * 64 + i] * u; op += S[i] * qs[kh * 64 + i]; }
        __syncthreads();
        part[kh][v] = op;
        __syncthreads();
        const float o = part[0][v] + part[1][v];
        float sq = (t < 128) ? o * o : 0.f; sq = wave_sum(sq);
        if (t == 0) red[0] = sq; if (t == 64) red[1] = sq;
        __syncthreads();
        if (t < 128) { const float ms = (red[0] + red[1]) * (1.0f / 128.0f);
            const float zd = bf2f(PROJ[tok * OD_N + OC_ZD + h * 128 + t]);
            Y[tok * D_MODEL + W_C + h * 128 + t] = (bf16_t)f2bf(o * (1.0f / sqrtf(ms + EPS)) * og * siluf_(zd)); }
    }
}

__global__ void __launch_bounds__(512) k_prologue(Ptrs P) {
    extern __shared__ __attribute__((aligned(16))) unsigned char lds[];
    const int tid = threadIdx.x, lane = tid & 63, wave = __builtin_amdgcn_readfirstlane(tid >> 6);
    phase_prologue(P, (LAS unsigned char*)lds, wave, lane, blockIdx.x * NWAVES + wave, gridDim.x * NWAVES);
}
template <int WHICH> __device__ __forceinline__ void phase_gemm(const Ptrs& P, LAS unsigned char* lds, int G, int c) {
    unsigned char* ws = P.ws;
    bf16_t* W1T = (bf16_t*)(ws + WS_W1T); bf16_t* W2T = (bf16_t*)(ws + WS_W2T); bf16_t* W3T = (bf16_t*)(ws + WS_W3T); bf16_t* W4T = (bf16_t*)(ws + WS_W4T);
    bf16_t* XB = (bf16_t*)(ws + WS_XB); bf16_t* YB = (bf16_t*)(ws + WS_Y); bf16_t* PROJ = (bf16_t*)(ws + WS_PROJ);
    float* R0 = (float*)(ws + WS_R0); float* SS1 = (float*)(ws + WS_SS1);
    if constexpr (WHICH == 1) { pg8::Gemm g{XB, W1T, M_TOK, EV_N, D_MODEL}; pg8::EpiProj E{PROJ, EV_N, R0, 0}; pg8::StaticOrder S; S.init(g.M, g.N, G, c);
        pg8::gemm_phase<pg8::EpiProj, pg8::StaticOrder, true, true>(lds, g, S, E); }
    if constexpr (WHICH == 2) { pg8::Gemm g{YB, W2T, M_TOK, D_MODEL, D_MODEL}; pg8::EpiRes E{P.in[IN_X], P.out, XB, SS1, D_MODEL}; pg8::StaticOrder S; S.init(g.M, g.N, G, c);
        pg8::gemm_phase<pg8::EpiRes, pg8::StaticOrder, true, true>(lds, g, S, E); }
    if constexpr (WHICH == 3) { pg8::Gemm g{XB, W3T, M_TOK, OD_N, D_MODEL}; pg8::EpiProj E{PROJ, OD_N, SS1, 1}; pg8::StaticOrder S; S.init(g.M, g.N, G, c);
        pg8::gemm_phase<pg8::EpiProj, pg8::StaticOrder, true, true>(lds, g, S, E); }
    if constexpr (WHICH == 4) { pg8::Gemm g{YB, W4T, M_TOK, D_MODEL, D_MODEL}; pg8::EpiRes E{P.out, P.out, nullptr, nullptr, D_MODEL}; pg8::StaticOrder S; S.init(g.M, g.N, G, c);
        pg8::gemm_phase<pg8::EpiRes, pg8::StaticOrder, true, true>(lds, g, S, E); }
}
template <int WHICH> __global__ void __launch_bounds__(512, 2) k_gemm(Ptrs P) {
    extern __shared__ __attribute__((aligned(16))) unsigned char lds[];
    phase_gemm<WHICH>(P, (LAS unsigned char*)lds, gridDim.x, blockIdx.x);
}

__device__ __forceinline__ void phase_gates_ab(const Ptrs& P, int G) {
    unsigned char* ws = P.ws; const bf16_t* XB = (const bf16_t*)(ws + WS_XB); const bf16_t* W3T = (const bf16_t*)(ws + WS_W3T); const float* SS1 = (const float*)(ws + WS_SS1); float* AB = (float*)(ws + WS_AB);
    const int t = threadIdx.x, j = t & 15;
    for (int it = blockIdx.x; it < M_TOK / 32; it += G) { const int row = it * 32 + (t >> 4);
        const bf16_t* xp = XB + (size_t)row * D_MODEL; const bf16_t* wp = W3T + (size_t)(OD_N + j) * D_MODEL; float acc = 0.f;
        for (int k = 0; k < D_MODEL; k += 8) { float a[8], w[8]; ld8bf(xp + k, a); ld8bf(wp + k, w);
#pragma unroll
            for (int i = 0; i < 8; ++i) acc += a[i] * w[i]; }
        AB[(size_t)row * 16 + j] = acc * (1.0f / sqrtf(SS1[row] * (1.0f / D_MODEL) + EPS)); }
}
#ifdef SKELETON
__device__ __forceinline__ void phase_mix0(const Ptrs& P, LAS unsigned char* lds, int G) {
    v4u* Y = (v4u*)(P.ws + WS_Y); const v4u z = {0u, 0u, 0u, 0u};
    for (size_t i = (size_t)blockIdx.x * 512 + threadIdx.x; i < (size_t)M_TOK * D_MODEL / 8; i += (size_t)G * 512) Y[i] = z;
}
__device__ __forceinline__ void phase_mix1a(const Ptrs& P, LAS unsigned char* lds, int G) { phase_mix0(P, lds, G); }
__device__ __forceinline__ void phase_mix1b(const Ptrs& P, LAS unsigned char* lds, int G) { }
#endif
typedef short bf16x8 __attribute__((ext_vector_type(8)));
typedef short bf16x4 __attribute__((ext_vector_type(4)));
typedef short v4i16_t __attribute__((ext_vector_type(4)));
#define MFMA16(a, b, c) __builtin_amdgcn_mfma_f32_16x16x32_bf16((a), (b), (c), 0, 0, 0)
__device__ __forceinline__ v4i16_t lds_tr(LAS const unsigned char* p) { return __builtin_amdgcn_ds_read_tr16_b64_v4i16((LAS v4i16_t*)p); }
__device__ __forceinline__ bf16x8 frag_row(LAS const unsigned char* base, int RS, int r0, int k0, int lane) { return *(LAS const bf16x8*)(base + (r0 + (lane & 15)) * RS + (k0 + 8 * (lane >> 4)) * 2); }
__device__ __forceinline__ bf16x8 frag_row_perm(LAS const unsigned char* base, int RS, int r0, int k0, int lane) {
    LAS const unsigned char* p = base + (r0 + (lane & 15)) * RS + (k0 + 4 * (lane >> 4)) * 2;
    const bf16x4 a = *(LAS const bf16x4*)p, b = *(LAS const bf16x4*)(p + 32); return (bf16x8){a[0], a[1], a[2], a[3], b[0], b[1], b[2], b[3]}; }
__device__ __forceinline__ bf16x8 frag_tr(LAS const unsigned char* base, int RS, int k0, int c0, int lane) {
    const int g = lane >> 4, q = (lane & 15) >> 2, p = lane & 3; LAS const unsigned char* a = base + (k0 + 8 * g + q) * RS + (c0 + 4 * p) * 2;
    const v4i16_t lo = lds_tr(a), hi = lds_tr(a + 4 * RS); return (bf16x8){lo[0], lo[1], lo[2], lo[3], hi[0], hi[1], hi[2], hi[3]}; }
__device__ __forceinline__ bf16x8 frag_tr_perm(LAS const unsigned char* base, int RS, int k0, int c0, int lane) {
    const int g = lane >> 4, q = (lane & 15) >> 2, p = lane & 3; LAS const unsigned char* a = base + (k0 + 4 * g + q) * RS + (c0 + 4 * p) * 2;
    const v4i16_t lo = lds_tr(a), hi = lds_tr(a + 16 * RS); return (bf16x8){lo[0], lo[1], lo[2], lo[3], hi[0], hi[1], hi[2], hi[3]}; }
__device__ __forceinline__ bf16x8 acc_pair_frag(const f32x4& lo, const f32x4& hi) {
    const unsigned a = pk2(lo[0], lo[1]), b = pk2(lo[2], lo[3]), c = pk2(hi[0], hi[1]), d = pk2(hi[2], hi[3]);
    typedef unsigned u32x4_ __attribute__((ext_vector_type(4))); const u32x4_ w = {a, b, c, d}; return __builtin_bit_cast(bf16x8, w); }
__device__ __forceinline__ float fexp2(float x) { return __builtin_amdgcn_exp2f(x); }
constexpr float LOG2E = 1.4426950408889634f;
constexpr int AT_RSK = 272, AT_RSV = 288, AT_KB = 64 * AT_RSK, AT_VB = 64 * AT_RSV;
constexpr int AT_OFF_K = 0, AT_OFF_V = 2 * AT_KB, AT_OFF_TBL = AT_OFF_V + 2 * AT_VB, AT_LDS = AT_OFF_TBL + 2064;
static_assert(AT_LDS <= 131072, "attention LDS");
__device__ __forceinline__ void attn_item(const Ptrs& P, LAS unsigned char* lds, int item) {
    const bf16_t* __restrict__ PROJ = (const bf16_t*)(P.ws + WS_PROJ); bf16_t* __restrict__ Y = (bf16_t*)(P.ws + WS_Y);
    const float* __restrict__ qn_g = P.in[IN_EV_QNG]; const float* __restrict__ kn_g = P.in[IN_EV_KNG];
    const int tid = threadIdx.x, lane = tid & 63, wave = tid >> 6, g = lane >> 4, l15 = lane & 15;
    const int cp = item & 15, h = (item >> 4) & 7, b = item >> 7;
    const int c = 2 * cp + (wave >> 2), qt = wave & 3;
    LAS float* tbl = (LAS float*)(lds + AT_OFF_TBL);
    for (int i = tid; i < NREL; i += 512) tbl[i] = P.in[IN_EV_REL][h * NREL + i] * LOG2E;
    bf16x8 qf[4];
    { const bf16_t* qp = PROJ + (size_t)(b * SEQ + c * 64 + qt * 16 + l15) * EV_N + EC_QA + h * 128 + 8 * g;
      float qv[4][8]; float ss = 0.f;
#pragma unroll
      for (int ks = 0; ks < 4; ++ks) { ld8bf(qp + 32 * ks, qv[ks]);
#pragma unroll
          for (int i = 0; i < 8; ++i) ss += qv[ks][i] * qv[ks][i]; }
      ss += __shfl_xor(ss, 16); ss += __shfl_xor(ss, 32);
      const float rs = (1.0f / sqrtf(ss * (1.0f / 128.0f) + EPS)) * (0.08838834764831845f * LOG2E);
#pragma unroll
      for (int ks = 0; ks < 4; ++ks) { const float* gp = qn_g + 32 * ks + 8 * g; typedef unsigned u32x4_ __attribute__((ext_vector_type(4)));
          const u32x4_ w = {pk2(qv[ks][0] * rs * gp[0], qv[ks][1] * rs * gp[1]), pk2(qv[ks][2] * rs * gp[2], qv[ks][3] * rs * gp[3]),
                            pk2(qv[ks][4] * rs * gp[4], qv[ks][5] * rs * gp[5]), pk2(qv[ks][6] * rs * gp[6], qv[ks][7] * rs * gp[7])};
          qf[ks] = __builtin_bit_cast(bf16x8, w); } }
    f32x4 o[8];
#pragma unroll
    for (int i = 0; i < 8; ++i) o[i] = (f32x4){0.f, 0.f, 0.f, 0.f};
    float mrun = -1.0e30f, lrun = 0.f;
    const int kt_lo = (2 * cp - LOOKBACK) < 0 ? 0 : (2 * cp - LOOKBACK), kt_hi = 2 * cp + 1;
    v4u kreg[2], vreg[2];
    const int srow0 = tid >> 4, sch = tid & 15;
    float kg[8];
#pragma unroll
    for (int i = 0; i < 8; ++i) kg[i] = kn_g[sch * 8 + i];
#define AT_LOAD(kt) do { _Pragma("unroll") for (int i_ = 0; i_ < 2; ++i_) { const bf16_t* rp_ = PROJ + (size_t)(b * SEQ + (kt) * 64 + srow0 + 32 * i_) * EV_N + h * 128 + sch * 8; \
        kreg[i_] = *(const v4u*)(rp_ + EC_KA); vreg[i_] = *(const v4u*)(rp_ + EC_VA); } } while (0)
#define AT_STORE(buf) do { _Pragma("unroll") for (int i_ = 0; i_ < 2; ++i_) { const int row_ = srow0 + 32 * i_; \
        float kv_[8]; kv_[0] = __builtin_bit_cast(float, kreg[i_].x << 16); kv_[1] = __builtin_bit_cast(float, kreg[i_].x & 0xffff0000u); kv_[2] = __builtin_bit_cast(float, kreg[i_].y << 16); kv_[3] = __builtin_bit_cast(float, kreg[i_].y & 0xffff0000u); \
        kv_[4] = __builtin_bit_cast(float, kreg[i_].z << 16); kv_[5] = __builtin_bit_cast(float, kreg[i_].z & 0xffff0000u); kv_[6] = __builtin_bit_cast(float, kreg[i_].w << 16); kv_[7] = __builtin_bit_cast(float, kreg[i_].w & 0xffff0000u); \
        float ss_ = 0.f; _Pragma("unroll") for (int e_ = 0; e_ < 8; ++e_) ss_ += kv_[e_] * kv_[e_]; \
        ss_ += __shfl_xor(ss_, 1); ss_ += __shfl_xor(ss_, 2); ss_ += __shfl_xor(ss_, 4); ss_ += __shfl_xor(ss_, 8); \
        const float rs_ = 1.0f / sqrtf(ss_ * (1.0f / 128.0f) + EPS); \
        v4u w_; w_.x = pk2(kv_[0] * rs_ * kg[0], kv_[1] * rs_ * kg[1]); w_.y = pk2(kv_[2] * rs_ * kg[2], kv_[3] * rs_ * kg[3]); w_.z = pk2(kv_[4] * rs_ * kg[4], kv_[5] * rs_ * kg[5]); w_.w = pk2(kv_[6] * rs_ * kg[6], kv_[7] * rs_ * kg[7]); \
        *(LAS v4u*)(lds + AT_OFF_K + (buf) * AT_KB + row_ * AT_RSK + sch * 16) = w_; \
        *(LAS v4u*)(lds + AT_OFF_V + (buf) * AT_VB + row_ * AT_RSV + sch * 16) = vreg[i_]; } } while (0)
    AT_LOAD(kt_lo); AT_STORE(0);
    __syncthreads();
    const int qi = qt * 16 + l15;
    for (int kt = kt_lo, it = 0; kt <= kt_hi; ++kt, ++it) {
        const int buf = it & 1;
        if (kt < kt_hi) AT_LOAD(kt + 1);
        const int to = kt - (c - LOOKBACK);
        if (to >= 0 && to <= LOOKBACK) {
            LAS const unsigned char* Kb = lds + AT_OFF_K + buf * AT_KB; LAS const unsigned char* Vb = lds + AT_OFF_V + buf * AT_VB;
            f32x4 s[4];
#pragma unroll
            for (int nt = 0; nt < 4; ++nt) { s[nt] = (f32x4){0.f, 0.f, 0.f, 0.f};
#pragma unroll
                for (int ks = 0; ks < 4; ++ks) s[nt] = MFMA16(frag_row(Kb, AT_RSK, 16 * nt, 32 * ks, lane), qf[ks], s[nt]); }
            { const int relb = LOOKBACK * CHUNK - 64 * to + qi - 4 * g;
#pragma unroll
              for (int nt = 0; nt < 4; ++nt)
#pragma unroll
                  for (int r = 0; r < 4; ++r) { int rel = relb - 16 * nt - r; rel = rel > REL_MAX ? REL_MAX : rel; s[nt][r] += tbl[rel + REL_MAX]; } }
            float tmax = fmaxf(fmaxf(s[0][0], s[0][1]), fmaxf(s[0][2], s[0][3]));
#pragma unroll
            for (int nt = 1; nt < 4; ++nt) tmax = fmaxf(tmax, fmaxf(fmaxf(s[nt][0], s[nt][1]), fmaxf(s[nt][2], s[nt][3])));
            tmax = fmaxf(tmax, __shfl_xor(tmax, 16)); tmax = fmaxf(tmax, __shfl_xor(tmax, 32));
            const float mnew = fmaxf(mrun, tmax), alpha = fexp2(mrun - mnew);
            float rsum = 0.f;
#pragma unroll
            for (int nt = 0; nt < 4; ++nt)
#pragma unroll
                for (int r = 0; r < 4; ++r) { s[nt][r] = fexp2(s[nt][r] - mnew); rsum += s[nt][r]; }
            rsum += __shfl_xor(rsum, 16); rsum += __shfl_xor(rsum, 32);
            lrun = lrun * alpha + rsum; mrun = mnew;
            const bf16x8 pf0 = acc_pair_frag(s[0], s[1]), pf1 = acc_pair_frag(s[2], s[3]);
            float al[4];
#pragma unroll
            for (int r = 0; r < 4; ++r) al[r] = __shfl(alpha, 4 * g + r);
#pragma unroll
            for (int dt = 0; dt < 8; ++dt) { o[dt][0] *= al[0]; o[dt][1] *= al[1]; o[dt][2] *= al[2]; o[dt][3] *= al[3];
                o[dt] = MFMA16(pf0, frag_tr_perm(Vb, AT_RSV, 0, 16 * dt, lane), o[dt]);
                o[dt] = MFMA16(pf1, frag_tr_perm(Vb, AT_RSV, 32, 16 * dt, lane), o[dt]); }
        }
        if (kt < kt_hi) AT_STORE(buf ^ 1);
        __syncthreads();
    }
#undef AT_LOAD
#undef AT_STORE
    float li[4];
#pragma unroll
    for (int r = 0; r < 4; ++r) li[r] = 1.0f / __shfl(lrun, 4 * g + r);
#pragma unroll
    for (int r = 0; r < 4; ++r) { const size_t tok = (size_t)b * SEQ + c * 64 + qt * 16 + 4 * g + r; const bf16_t* zp = PROJ + tok * EV_N + EC_ZA + h * 128 + l15; bf16_t* yp = Y + tok * D_MODEL + h * 128 + l15;
#pragma unroll
        for (int dt = 0; dt < 8; ++dt) yp[16 * dt] = (bf16_t)f2bf(o[dt][r] * li[r] * siluf_(bf2f(zp[16 * dt]))); }
}
constexpr int ML_RSQ = 528, ML_RSK = 544, ML_RSV = 288, ML_RSP = 144;
constexpr int ML_OFF_Q = 0, ML_OFF_K = ML_OFF_Q + 64 * ML_RSQ, ML_OFF_V = ML_OFF_K + 64 * ML_RSK, ML_OFF_P = ML_OFF_V + 64 * ML_RSV, ML_OFF_S = ML_OFF_P + 64 * ML_RSP;
constexpr int ML_E1 = 0, ML_E2 = 64, ML_WI = 128, ML_EMT = 192, ML_WS = 256, ML_RS = 320, ML_QN = 384, ML_NV = 448, ML_WC = 704, ML_LDS = ML_OFF_S + 708 * 4;
static_assert(ML_LDS <= 131072, "mLSTM LDS");
__device__ __forceinline__ void mlstm_item(const Ptrs& P, LAS unsigned char* lds, int item) {
    const bf16_t* __restrict__ PROJ = (const bf16_t*)(P.ws + WS_PROJ); bf16_t* __restrict__ Y = (bf16_t*)(P.ws + WS_Y); const float* __restrict__ GIF = (const float*)(P.ws + WS_GIF);
    const int tid = threadIdx.x, lane = tid & 63, wave = tid >> 6, g = lane >> 4, l15 = lane & 15;
    const int half = item & 1, h = (item >> 1) & 3, b = item >> 3;
    LAS float* sc = (LAS float*)(lds + ML_OFF_S);
    LAS const unsigned char* Qt = lds + ML_OFF_Q; LAS const unsigned char* Kt = lds + ML_OFF_K; LAS const unsigned char* Vt = lds + ML_OFF_V; LAS const unsigned char* Ps = lds + ML_OFF_P;
    f32x4 cacc[16];
#pragma unroll
    for (int i = 0; i < 16; ++i) cacc[i] = (f32x4){0.f, 0.f, 0.f, 0.f};
    if (tid < 256) sc[ML_NV + tid] = 0.f;
    float mcar = 0.f;
    v4u qreg[4], kreg[4], vreg[2];
    const size_t tok0 = (size_t)b * SEQ;
#define ML_LOAD(n) do { _Pragma("unroll") for (int i_ = 0; i_ < 4; ++i_) { const int id_ = tid + 512 * i_, row_ = id_ >> 5, ch_ = id_ & 31; const bf16_t* rp_ = PROJ + (tok0 + (n) * 64 + row_) * EV_N + h * 256 + ch_ * 8; \
            qreg[i_] = *(const v4u*)(rp_ + EC_QB); kreg[i_] = *(const v4u*)(rp_ + EC_KB); } \
        _Pragma("unroll") for (int i_ = 0; i_ < 2; ++i_) { const int id_ = tid + 512 * i_, row_ = id_ >> 4, ch_ = id_ & 15; vreg[i_] = *(const v4u*)(PROJ + (tok0 + (n) * 64 + row_) * EV_N + EC_VB + h * 256 + half * 128 + ch_ * 8); } } while (0)
#define ML_STORE() do { _Pragma("unroll") for (int i_ = 0; i_ < 4; ++i_) { const int id_ = tid + 512 * i_, row_ = id_ >> 5, ch_ = id_ & 31; \
            *(LAS v4u*)(lds + ML_OFF_Q + row_ * ML_RSQ + ch_ * 16) = qreg[i_]; *(LAS v4u*)(lds + ML_OFF_K + row_ * ML_RSK + ch_ * 16) = kreg[i_]; } \
        _Pragma("unroll") for (int i_ = 0; i_ < 2; ++i_) { const int id_ = tid + 512 * i_, row_ = id_ >> 4, ch_ = id_ & 15; *(LAS v4u*)(lds + ML_OFF_V + row_ * ML_RSV + ch_ * 16) = vreg[i_]; } } while (0)
    ML_LOAD(0);
    for (int n = 0; n < NCH; ++n) {
        ML_STORE();
        if (tid < 64) sc[ML_RS + tid] = 0.f;
        if (wave == 0) {
            const size_t tok = tok0 + n * 64 + lane;
            const float li = GIF[tok * 8 + h], lf = logsigmoidf_(GIF[tok * 8 + 4 + h]);
            float bc = lf;
#pragma unroll
            for (int o = 1; o < 64; o <<= 1) { const float t_ = __shfl_up(bc, o); if (lane >= o) bc += t_; }
            const float as = li - bc; float pm = as;
#pragma unroll
            for (int o = 1; o < 64; o <<= 1) { const float t_ = __shfl_up(pm, o); if (lane >= o) pm = fmaxf(pm, t_); }
            const float mt = bc + fmaxf(mcar, pm);
            const float blast = __shfl(bc, 63), pml = __shfl(pm, 63);
            const float mnew = blast + fmaxf(mcar, pml);
            sc[ML_E1 + lane] = (bc - mt) * LOG2E; sc[ML_E2 + lane] = as * LOG2E; sc[ML_WI + lane] = expf(bc + mcar - mt); sc[ML_EMT + lane] = expf(-mt);
            sc[ML_WS + lane] = expf(as + blast - mnew);
            if (lane == 0) sc[ML_WC] = expf(blast + mcar - mnew);
            mcar = mnew;
        }
        __syncthreads();
        if (n + 1 < NCH) ML_LOAD(n + 1);
        { const int t = tid >> 3, j = tid & 7; float a = 0.f;
#pragma unroll
          for (int i = 0; i < 4; ++i) { const v4u w = *(LAS const v4u*)(Qt + t * ML_RSQ + (32 * j + 8 * i) * 2); const LAS float* nv = sc + ML_NV + 32 * j + 8 * i;
              a += __builtin_bit_cast(float, w.x << 16) * nv[0] + __builtin_bit_cast(float, w.x & 0xffff0000u) * nv[1] + __builtin_bit_cast(float, w.y << 16) * nv[2] + __builtin_bit_cast(float, w.y & 0xffff0000u) * nv[3]
                 + __builtin_bit_cast(float, w.z << 16) * nv[4] + __builtin_bit_cast(float, w.z & 0xffff0000u) * nv[5] + __builtin_bit_cast(float, w.w << 16) * nv[6] + __builtin_bit_cast(float, w.w & 0xffff0000u) * nv[7]; }
          a += __shfl_xor(a, 1); a += __shfl_xor(a, 2); a += __shfl_xor(a, 4);
          if (j == 0) sc[ML_QN + t] = a * 0.0625f; }
        { const int tt = wave >> 1; const int t = 16 * tt + l15; const float e1 = sc[ML_E1 + t];
#pragma unroll
          for (int u = 0; u < 2; ++u) { const int st = 2 * (wave & 1) + u; unsigned long long pw = 0ull;
              if (st <= tt) { f32x4 s = (f32x4){0.f, 0.f, 0.f, 0.f};
#pragma unroll
                  for (int ks = 0; ks < 8; ++ks) s = MFMA16(frag_row(Kt, ML_RSK, 16 * st, 32 * ks, lane), frag_row(Qt, ML_RSQ, 16 * tt, 32 * ks, lane), s);
                  float pv_[4]; float rs = 0.f;
#pragma unroll
                  for (int r = 0; r < 4; ++r) { const int sidx = 16 * st + 4 * g + r; const float p = (sidx <= t) ? fexp2(e1 + sc[ML_E2 + sidx]) * s[r] * 0.0625f : 0.f; pv_[r] = p; rs += p; }
                  rs += __shfl_xor(rs, 16); rs += __shfl_xor(rs, 32);
                  if (g == 0) atomicAdd((float*)(sc + ML_RS + t), rs);
                  pw = (unsigned long long)pk2(pv_[0], pv_[1]) | ((unsigned long long)pk2(pv_[2], pv_[3]) << 32); }
              *(LAS unsigned long long*)(lds + ML_OFF_P + t * ML_RSP + (16 * st + 4 * g) * 2) = pw; } }
        __syncthreads();
        f32x4 nu[4];
#pragma unroll
        for (int tt = 0; tt < 4; ++tt) nu[tt] = (f32x4){0.f, 0.f, 0.f, 0.f};
#pragma unroll
        for (int j = 0; j < 8; ++j) { const bf16x8 cf = acc_pair_frag(cacc[2 * j], cacc[2 * j + 1]);
#pragma unroll
            for (int tt = 0; tt < 4; ++tt) nu[tt] = MFMA16(frag_row_perm(Qt, ML_RSQ, 16 * tt, 32 * j, lane), cf, nu[tt]); }
#pragma unroll
        for (int tt = 0; tt < 4; ++tt)
#pragma unroll
            for (int r = 0; r < 4; ++r) nu[tt][r] *= sc[ML_WI + 16 * tt + 4 * g + r] * 0.0625f;
        bf16x8 vf[2];
#pragma unroll
        for (int ks = 0; ks < 2; ++ks) { vf[ks] = frag_tr(Vt, ML_RSV, 32 * ks, 16 * wave, lane);
#pragma unroll
            for (int tt = 0; tt < 4; ++tt) nu[tt] = MFMA16(frag_row(Ps, ML_RSP, 16 * tt, 32 * ks, lane), vf[ks], nu[tt]); }
        { const int vcol = h * 256 + half * 128 + 16 * wave + l15;
#pragma unroll
          for (int tt = 0; tt < 4; ++tt)
#pragma unroll
              for (int r = 0; r < 4; ++r) { const int t = 16 * tt + 4 * g + r; const size_t tok = tok0 + n * 64 + t;
                  const float den = sc[ML_WI + t] * sc[ML_QN + t] + sc[ML_RS + t];
                  const float hh = nu[tt][r] / fmaxf(fabsf(den), sc[ML_EMT + t]);
                  const float ob = bf2f(PROJ[tok * EV_N + EC_OB + vcol]), zb = bf2f(PROJ[tok * EV_N + EC_ZB + vcol]);
                  Y[tok * D_MODEL + W_A + vcol] = (bf16_t)f2bf(sigmoidf_(ob) * hh * siluf_(zb)); } }
        { const float wc = sc[ML_WC];
          bf16x8 vw[2];
#pragma unroll
          for (int ks = 0; ks < 2; ++ks) { typedef unsigned u32x4_ __attribute__((ext_vector_type(4))); const u32x4_ w = __builtin_bit_cast(u32x4_, vf[ks]); const LAS float* wp = sc + ML_WS + 32 * ks + 8 * g;
              const u32x4_ o = {pk2(__builtin_bit_cast(float, w.x << 16) * wp[0], __builtin_bit_cast(float, w.x & 0xffff0000u) * wp[1]), pk2(__builtin_bit_cast(float, w.y << 16) * wp[2], __builtin_bit_cast(float, w.y & 0xffff0000u) * wp[3]),
                                pk2(__builtin_bit_cast(float, w.z << 16) * wp[4], __builtin_bit_cast(float, w.z & 0xffff0000u) * wp[5]), pk2(__builtin_bit_cast(float, w.w << 16) * wp[6], __builtin_bit_cast(float, w.w & 0xffff0000u) * wp[7])};
              vw[ks] = __builtin_bit_cast(bf16x8, o); }
#pragma unroll
          for (int kt = 0; kt < 16; ++kt) { cacc[kt] *= wc;
              cacc[kt] = MFMA16(frag_tr(Kt, ML_RSK, 0, 16 * kt, lane), vw[0], cacc[kt]);
              cacc[kt] = MFMA16(frag_tr(Kt, ML_RSK, 32, 16 * kt, lane), vw[1], cacc[kt]); }
          if (tid < 256) { float a = 0.f;
#pragma unroll 8
              for (int s = 0; s < 64; ++s) a += sc[ML_WS + s] * bf2f(*(LAS const unsigned short*)(Kt + s * ML_RSK + tid * 2));
              sc[ML_NV + tid] = wc * sc[ML_NV + tid] + a; } }
        __syncthreads();
    }
#undef ML_LOAD
#undef ML_STORE
}
constexpr int RG_RSG = 160, RG_RSX = 272, RG_RSF = 33 * 4;
constexpr int RG_OFF_G = 0, RG_OFF_X = RG_OFF_G + 128 * RG_RSG, RG_OFF_XF = RG_OFF_X + 64 * RG_RSX, RG_OFF_A = RG_OFF_XF + 64 * RG_RSF, RG_OFF_I = RG_OFF_A + 64 * RG_RSF, RG_OFF_H = RG_OFF_I + 64 * RG_RSF, RG_LDS = RG_OFF_H + 64 * RG_RSF;
static_assert(RG_LDS <= 131072, "RG-LRU LDS");
__device__ __forceinline__ void rglru_item(const Ptrs& P, LAS unsigned char* lds, int item) {
    const bf16_t* __restrict__ PROJ = (const bf16_t*)(P.ws + WS_PROJ); bf16_t* __restrict__ Y = (bf16_t*)(P.ws + WS_Y);
    const float* __restrict__ ccw = P.in[IN_OD_CCW]; const float* __restrict__ ccb = P.in[IN_OD_CCB]; const float* __restrict__ gw = P.in[IN_OD_GW]; const float* __restrict__ gb = P.in[IN_OD_GB]; const float* __restrict__ lam = P.in[IN_OD_LAM];
    const int tid = threadIdx.x, lane = tid & 63, wave = tid >> 6, g = lane >> 4, l15 = lane & 15;
    const int cq = item & 3, blk = (item >> 2) & 7, b = item >> 5;
    const size_t tok0 = (size_t)b * SEQ;
    for (int e = tid; e < 128 * 64; e += 512) { const int k = e >> 6, c = e & 63; const int d = (c < 32) ? (cq * 32 + c) : (128 + cq * 32 + c - 32);
        *(LAS unsigned short*)(lds + RG_OFF_G + k * RG_RSG + c * 2) = (unsigned short)f2bf(gw[((size_t)blk * 128 + k) * 256 + d]); }
    const int c8 = tid & 15, tq = tid >> 4, ch0 = blk * 128 + 8 * c8;
    float cw[4][8], cb[8];
#pragma unroll
    for (int i = 0; i < 8; ++i) { cb[i] = ccb[ch0 + i];
#pragma unroll
        for (int j = 0; j < 4; ++j) cw[j][i] = ccw[j * W_C + ch0 + i]; }
    const int chl = 16 * (wave & 1) + l15, cgl = blk * 128 + cq * 32 + chl;
    const float gbr = gb[cgl], gbi = gb[W_C + cgl], sp = softplusf_(-lam[cgl]);
    float hcar = 0.f;
    __syncthreads();
    for (int n = 0; n < NCH; ++n) {
#pragma unroll
        for (int u = 0; u < 2; ++u) { const int t = tq + 32 * u, s = n * 64 + t; float xv[8];
#pragma unroll
            for (int i = 0; i < 8; ++i) xv[i] = cb[i];
#pragma unroll
            for (int j = 0; j < 4; ++j) { if (s - 3 + j >= 0) { float pv[8]; ld8bf(PROJ + (tok0 + s - 3 + j) * OD_N + OC_XC + ch0, pv);
#pragma unroll
                    for (int i = 0; i < 8; ++i) xv[i] += cw[j][i] * pv[i]; } }
            v4u w; w.x = pk2(xv[0], xv[1]); w.y = pk2(xv[2], xv[3]); w.z = pk2(xv[4], xv[5]); w.w = pk2(xv[6], xv[7]);
            *(LAS v4u*)(lds + RG_OFF_X + t * RG_RSX + c8 * 16) = w;
            if ((c8 >> 2) == cq) { LAS float* xf = (LAS float*)(lds + RG_OFF_XF + t * RG_RSF) + 8 * (c8 & 3);
#pragma unroll
                for (int i = 0; i < 8; ++i) xf[i] = xv[i]; } }
        __syncthreads();
        { const int tt = wave >> 1, cp = wave & 1; f32x4 ar = (f32x4){0.f, 0.f, 0.f, 0.f}, ai = ar;
#pragma unroll
          for (int ks = 0; ks < 4; ++ks) { const bf16x8 xa = frag_row(lds + RG_OFF_X, RG_RSX, 16 * tt, 32 * ks, lane);
              ar = MFMA16(xa, frag_tr(lds + RG_OFF_G, RG_RSG, 32 * ks, 16 * cp, lane), ar);
              ai = MFMA16(xa, frag_tr(lds + RG_OFF_G, RG_RSG, 32 * ks, 32 + 16 * cp, lane), ai); }
#pragma unroll
          for (int r = 0; r < 4; ++r) { const int t = 16 * tt + 4 * g + r;
              const float rr = sigmoidf_(ar[r] + gbr), ig = sigmoidf_(ai[r] + gbi); const float la = -8.0f * rr * sp;
              const float xc = *((LAS const float*)(lds + RG_OFF_XF + t * RG_RSF) + chl);
              *((LAS float*)(lds + RG_OFF_A + t * RG_RSF) + chl) = expf(la);
              *((LAS float*)(lds + RG_OFF_I + t * RG_RSF) + chl) = sqrtf(-expm1f(2.0f * la)) * (ig * xc); } }
        __syncthreads();
        if (tid < 32) { float h = hcar;
#pragma unroll 8
            for (int t = 0; t < 64; ++t) { h = *((LAS const float*)(lds + RG_OFF_A + t * RG_RSF) + tid) * h + *((LAS const float*)(lds + RG_OFF_I + t * RG_RSF) + tid);
                *((LAS float*)(lds + RG_OFF_H + t * RG_RSF) + tid) = h; }
            hcar = h; }
        __syncthreads();
        { const int t = tid >> 3, c4 = tid & 7; const size_t tok = tok0 + n * 64 + t; const int cgo = blk * 128 + cq * 32 + 4 * c4;
          const unsigned long long zw = *(const unsigned long long*)(PROJ + tok * OD_N + OC_ZC + cgo);
          const LAS float* hp = (LAS const float*)(lds + RG_OFF_H + t * RG_RSF) + 4 * c4;
          const float z0 = __builtin_bit_cast(float, (unsigned)(zw & 0xffffull) << 16), z1 = __builtin_bit_cast(float, (unsigned)(zw >> 16 & 0xffffull) << 16), z2 = __builtin_bit_cast(float, (unsigned)(zw >> 32 & 0xffffull) << 16), z3 = __builtin_bit_cast(float, (unsigned)(zw >> 48) << 16);
          *(unsigned long long*)(Y + tok * D_MODEL + cgo) = (unsigned long long)pk2(hp[0] * siluf_(z0), hp[1] * siluf_(z1)) | ((unsigned long long)pk2(hp[2] * siluf_(z2), hp[3] * siluf_(z3)) << 32); }
    }
    __syncthreads();
}
constexpr size_t WS_DQ2 = 4 * MiB, WS_DK2 = 36 * MiB;
constexpr size_t WS_DWT = WS_XB, WS_DUT = WS_XB + 32 * MiB;
constexpr size_t WS_DQK = WS_FREE1, WS_DDEC = WS_FREE1 + 16 * MiB;
constexpr float DN_SCALE = 0.08838834764831845f;
template <int T> struct SolveRows {
    static __device__ __forceinline__ void run(float (&col)[32], LAS const unsigned char* Ab, int j) {
        SolveRows<T - 1>::run(col, Ab, j);
        float v = (T == j) ? 1.f : 0.f;
#pragma unroll
        for (int s4 = 0; s4 < (T + 3) / 4; ++s4) { const f32x4 a = *(LAS const f32x4*)(Ab + T * 272 + 16 * s4);
#pragma unroll
            for (int e = 0; e < 4; ++e) { if (4 * s4 + e < T) v -= a[e] * col[4 * s4 + e]; } }
        asm volatile("" : "+v"(v) :: "memory"); col[T] = v;
    }
};
template <> struct SolveRows<-1> { static __device__ __forceinline__ void run(float (&)[32], LAS const unsigned char*, int) {} };
constexpr int D1_RSQ = 272, D1_RSK = 288, D1_RSV = 288, D1_RSA = 272, D1_RST = 160;
constexpr int D1_OFF_Q = 0, D1_OFF_K = D1_OFF_Q + 64 * D1_RSQ, D1_OFF_V = D1_OFF_K + 64 * D1_RSK, D1_OFF_A = D1_OFF_V + 64 * D1_RSV, D1_OFF_T = D1_OFF_A + 64 * D1_RSA, D1_OFF_S = D1_OFF_T + 64 * D1_RST, D1_LDS = D1_OFF_S + 512;
static_assert(D1_LDS <= 131072, "D1 LDS");
__device__ __forceinline__ void dn1_item(const Ptrs& P, LAS unsigned char* lds, int item) {
    const bf16_t* __restrict__ PROJ = (const bf16_t*)(P.ws + WS_PROJ); const float* __restrict__ AB = (const float*)(P.ws + WS_AB); const float* __restrict__ cdw = P.in[IN_OD_CDW];
    bf16_t* __restrict__ Q2 = (bf16_t*)(P.ws + WS_DQ2); bf16_t* __restrict__ K2 = (bf16_t*)(P.ws + WS_DK2);
    bf16_t* __restrict__ WTg = (bf16_t*)(P.ws + WS_DWT) + (size_t)item * 8192; bf16_t* __restrict__ UTg = (bf16_t*)(P.ws + WS_DUT) + (size_t)item * 8192;
    bf16_t* __restrict__ QKg = (bf16_t*)(P.ws + WS_DQK) + (size_t)item * 4096; float* __restrict__ DECg = (float*)(P.ws + WS_DDEC) + (size_t)item * 64;
    const int tid = threadIdx.x, lane = tid & 63, wave = tid >> 6, g = lane >> 4, l15 = lane & 15;
    const int n = item & 31, h = (item >> 5) & 7, b = item >> 8;
    const size_t tok0 = (size_t)b * SEQ + n * 64;
    LAS float* beta_s = (LAS float*)(lds + D1_OFF_S); LAS float* dec_s = beta_s + 64;
    { const int t = tid >> 3, d16 = tid & 7, s = n * 64 + t; float qk_[2][16]; float ssq[2] = {0.f, 0.f};
#pragma unroll
      for (int p = 0; p < 3; ++p)
#pragma unroll
          for (int hf = 0; hf < 2; ++hf) { const int col = p * W_D + h * 128 + 16 * d16 + 8 * hf; float a[8];
#pragma unroll
              for (int i = 0; i < 8; ++i) a[i] = 0.f;
#pragma unroll
              for (int j = 0; j < 4; ++j) { if (s - 3 + j >= 0) { float xv[8]; ld8bf(PROJ + (tok0 + t - 3 + j) * OD_N + OC_QD + col, xv);
                      const f32x4 w0 = *(const f32x4*)(cdw + j * 3 * W_D + col), w1 = *(const f32x4*)(cdw + j * 3 * W_D + col + 4);
                      a[0] += w0[0] * xv[0]; a[1] += w0[1] * xv[1]; a[2] += w0[2] * xv[2]; a[3] += w0[3] * xv[3]; a[4] += w1[0] * xv[4]; a[5] += w1[1] * xv[5]; a[6] += w1[2] * xv[6]; a[7] += w1[3] * xv[7]; } }
#pragma unroll
              for (int i = 0; i < 8; ++i) a[i] = siluf_(a[i]);
              if (p < 2) {
#pragma unroll
                  for (int i = 0; i < 8; ++i) { qk_[p][8 * hf + i] = a[i]; ssq[p] += a[i] * a[i]; } }
              else { v4u w; w.x = pk2(a[0], a[1]); w.y = pk2(a[2], a[3]); w.z = pk2(a[4], a[5]); w.w = pk2(a[6], a[7]);
                  *(LAS v4u*)(lds + D1_OFF_V + t * D1_RSV + (16 * d16 + 8 * hf) * 2) = w; } }
#pragma unroll
      for (int p = 0; p < 2; ++p) { float ss = ssq[p]; ss += __shfl_xor(ss, 1); ss += __shfl_xor(ss, 2); ss += __shfl_xor(ss, 4); const float rs = 1.0f / sqrtf(ss + EPS);
#pragma unroll
          for (int hf = 0; hf < 2; ++hf) { v4u w; w.x = pk2(qk_[p][8 * hf + 0] * rs, qk_[p][8 * hf + 1] * rs); w.y = pk2(qk_[p][8 * hf + 2] * rs, qk_[p][8 * hf + 3] * rs);
              w.z = pk2(qk_[p][8 * hf + 4] * rs, qk_[p][8 * hf + 5] * rs); w.w = pk2(qk_[p][8 * hf + 6] * rs, qk_[p][8 * hf + 7] * rs);
              const int dd = 16 * d16 + 8 * hf;
              if (p == 0) { *(LAS v4u*)(lds + D1_OFF_Q + t * D1_RSQ + dd * 2) = w; *(v4u*)(Q2 + (tok0 + t) * W_D + h * 128 + dd) = w; }
              else { *(LAS v4u*)(lds + D1_OFF_K + t * D1_RSK + dd * 2) = w; *(v4u*)(K2 + (tok0 + t) * W_D + h * 128 + dd) = w; } } } }
    if (wave == 0) { const size_t tok = tok0 + lane;
        const float beta = sigmoidf_(AB[tok * 16 + 8 + h]); float dc = -expf(P.in[IN_OD_ALOG][h]) * softplusf_(AB[tok * 16 + h] + P.in[IN_OD_DTB][h]);
#pragma unroll
        for (int o = 1; o < 64; o <<= 1) { const float t_ = __shfl_up(dc, o); if (lane >= o) dc += t_; }
        beta_s[lane] = beta; dec_s[lane] = dc; DECg[lane] = dc; }
    __syncthreads();
    { const int tt = wave >> 1, t = 16 * tt + l15; const float dt_ = dec_s[t], bt = beta_s[t];
#pragma unroll
      for (int u = 0; u < 2; ++u) { const int st = 2 * (wave & 1) + u; unsigned long long qw = 0ull;
          if (st <= tt) { f32x4 kk = (f32x4){0.f, 0.f, 0.f, 0.f}, qk = kk;
#pragma unroll
              for (int ks = 0; ks < 4; ++ks) { const bf16x8 a = frag_row(lds + D1_OFF_K, D1_RSK, 16 * st, 32 * ks, lane);
                  kk = MFMA16(a, frag_row(lds + D1_OFF_K, D1_RSK, 16 * tt, 32 * ks, lane), kk); qk = MFMA16(a, frag_row(lds + D1_OFF_Q, D1_RSQ, 16 * tt, 32 * ks, lane), qk); }
              f32x4 am; float qv[4];
#pragma unroll
              for (int r = 0; r < 4; ++r) { const int s = 16 * st + 4 * g + r; const float gam = (s <= t) ? expf(dt_ - dec_s[s]) : 0.f; am[r] = (s < t) ? bt * kk[r] * gam : 0.f; qv[r] = qk[r] * gam * DN_SCALE; }
              *(LAS f32x4*)(lds + D1_OFF_A + t * D1_RSA + (16 * st + 4 * g) * 4) = am;
              qw = (unsigned long long)pk2(qv[0], qv[1]) | ((unsigned long long)pk2(qv[2], qv[3]) << 32); }
          *(unsigned long long*)(QKg + t * 64 + 16 * st + 4 * g) = qw; } }
    __syncthreads();
    if (wave == 0) { const int hb = lane >> 5, j = lane & 31; float col[32];
        LAS const unsigned char* Ab = lds + D1_OFF_A + (32 * hb) * D1_RSA + (32 * hb) * 4;
        SolveRows<31>::run(col, Ab, j);
        LAS unsigned char* trow = lds + D1_OFF_T + (32 * hb + j) * D1_RST;
#pragma unroll
        for (int c = 0; c < 4; ++c) { v4u w; w.x = pk2(col[8 * c], col[8 * c + 1]); w.y = pk2(col[8 * c + 2], col[8 * c + 3]); w.z = pk2(col[8 * c + 4], col[8 * c + 5]); w.w = pk2(col[8 * c + 6], col[8 * c + 7]);
            *(LAS v4u*)(trow + (32 * hb) * 2 + 16 * c) = w;
            if (hb) *(LAS v4u*)(trow + 16 * c) = (v4u){0u, 0u, 0u, 0u}; }
        bf16x8 af[2], bfr[2];
#pragma unroll
        for (int ti = 0; ti < 2; ++ti) { LAS const unsigned char* ap = lds + D1_OFF_A + (32 + 16 * ti + l15) * D1_RSA + (8 * g) * 4; const f32x4 a0 = *(LAS const f32x4*)ap, a1 = *(LAS const f32x4*)(ap + 16);
            typedef unsigned u32x4_ __attribute__((ext_vector_type(4))); const u32x4_ w = {pk2(a0[0], a0[1]), pk2(a0[2], a0[3]), pk2(a1[0], a1[1]), pk2(a1[2], a1[3])}; af[ti] = __builtin_bit_cast(bf16x8, w); }
#pragma unroll
        for (int nj = 0; nj < 2; ++nj) bfr[nj] = frag_row(lds + D1_OFF_T, D1_RST, 16 * nj, 0, lane);
        f32x4 X[2][2];
#pragma unroll
        for (int ti = 0; ti < 2; ++ti)
#pragma unroll
            for (int nj = 0; nj < 2; ++nj) X[ti][nj] = MFMA16(af[ti], bfr[nj], ((f32x4){0.f, 0.f, 0.f, 0.f}));
        LAS const unsigned char* T11b = lds + D1_OFF_T + 32 * D1_RST + 64;
#pragma unroll
        for (int nj = 0; nj < 2; ++nj) { const bf16x8 xb = acc_pair_frag(X[0][nj], X[1][nj]);
#pragma unroll
            for (int ti = 0; ti < 2; ++ti) { const f32x4 r_ = MFMA16(frag_tr_perm(T11b, D1_RST, 0, 16 * ti, lane), xb, ((f32x4){0.f, 0.f, 0.f, 0.f}));
                *(LAS unsigned long long*)(lds + D1_OFF_T + (16 * nj + l15) * D1_RST + (32 + 16 * ti + 4 * g) * 2) = (unsigned long long)pk2(-r_[0], -r_[1]) | ((unsigned long long)pk2(-r_[2], -r_[3]) << 32); } }
    }
    __syncthreads();
    { bf16x8 bv[2], bk[2];
#pragma unroll
      for (int ks = 0; ks < 2; ++ks) { typedef unsigned u32x4_ __attribute__((ext_vector_type(4)));
          const u32x4_ wv = __builtin_bit_cast(u32x4_, frag_tr(lds + D1_OFF_V, D1_RSV, 32 * ks, 16 * wave, lane)), wk = __builtin_bit_cast(u32x4_, frag_tr(lds + D1_OFF_K, D1_RSK, 32 * ks, 16 * wave, lane));
          float fb[8], fk[8];
#pragma unroll
          for (int i = 0; i < 8; ++i) { const int s = 32 * ks + 8 * g + i; fb[i] = beta_s[s]; fk[i] = fb[i] * expf(dec_s[s]); }
#define SC2(w_, f0, f1) pk2(__builtin_bit_cast(float, (w_) << 16) * (f0), __builtin_bit_cast(float, (w_) & 0xffff0000u) * (f1))
          const u32x4_ ov = {SC2(wv.x, fb[0], fb[1]), SC2(wv.y, fb[2], fb[3]), SC2(wv.z, fb[4], fb[5]), SC2(wv.w, fb[6], fb[7])};
          const u32x4_ ok = {SC2(wk.x, fk[0], fk[1]), SC2(wk.y, fk[2], fk[3]), SC2(wk.z, fk[4], fk[5]), SC2(wk.w, fk[6], fk[7])};
#undef SC2
          bv[ks] = __builtin_bit_cast(bf16x8, ov); bk[ks] = __builtin_bit_cast(bf16x8, ok); }
#pragma unroll
      for (int tt = 0; tt < 4; ++tt) { f32x4 u = (f32x4){0.f, 0.f, 0.f, 0.f}, wv = u;
#pragma unroll
          for (int ks = 0; ks < 2; ++ks) { const bf16x8 at = frag_tr(lds + D1_OFF_T, D1_RST, 32 * ks, 16 * tt, lane); u = MFMA16(at, bv[ks], u); wv = MFMA16(at, bk[ks], wv); }
          const size_t o_ = (size_t)(16 * wave + l15) * 64 + 16 * tt + 4 * g;
          *(unsigned long long*)(UTg + o_) = (unsigned long long)pk2(u[0], u[1]) | ((unsigned long long)pk2(u[2], u[3]) << 32);
          *(unsigned long long*)(WTg + o_) = (unsigned long long)pk2(wv[0], wv[1]) | ((unsigned long long)pk2(wv[2], wv[3]) << 32); } }
    __syncthreads();
}
constexpr int D2_RSW = 144, D2_RSQ = 272, D2_RSK = 288, D2_RSP = 144;
constexpr int D2_OFF_W = 0, D2_OFF_Q = D2_OFF_W + 128 * D2_RSW, D2_OFF_K = D2_OFF_Q + 64 * D2_RSQ, D2_OFF_P = D2_OFF_K + 64 * D2_RSK, D2_OFF_D = D2_OFF_P + 64 * D2_RSP, D2_OFF_TOT = D2_OFF_D + 256, D2_LDS = D2_OFF_TOT + 512;
static_assert(D2_LDS <= 131072, "D2 LDS");
__device__ __forceinline__ void dn2_item(const Ptrs& P, LAS unsigned char* lds, int item) {
    const bf16_t* __restrict__ PROJ = (const bf16_t*)(P.ws + WS_PROJ); bf16_t* __restrict__ Y = (bf16_t*)(P.ws + WS_Y);
    const bf16_t* __restrict__ Q2 = (const bf16_t*)(P.ws + WS_DQ2); const bf16_t* __restrict__ K2 = (const bf16_t*)(P.ws + WS_DK2);
    const int tid = threadIdx.x, lane = tid & 63, wave = tid >> 6, g = lane >> 4, l15 = lane & 15;
    const int h = item & 7, b = item >> 3;
    const size_t tok0 = (size_t)b * SEQ; const int it0 = item * 32;
    const bf16_t* __restrict__ WTg = (const bf16_t*)(P.ws + WS_DWT) + (size_t)it0 * 8192; const bf16_t* __restrict__ UTg = (const bf16_t*)(P.ws + WS_DUT) + (size_t)it0 * 8192;
    const bf16_t* __restrict__ QKg = (const bf16_t*)(P.ws + WS_DQK) + (size_t)it0 * 4096; const float* __restrict__ DECg = (const float*)(P.ws + WS_DDEC) + (size_t)it0 * 64;
    LAS float* dec_s = (LAS float*)(lds + D2_OFF_D); LAS float* tot = (LAS float*)(lds + D2_OFF_TOT);
    f32x4 sacc[8];
#pragma unroll
    for (int i = 0; i < 8; ++i) sacc[i] = (f32x4){0.f, 0.f, 0.f, 0.f};
    const float og = P.in[IN_OD_ONORM][16 * wave + l15];
    v4u wreg[2], qreg[2], kreg[2], preg; unsigned long long ureg[4]; float dreg = 0.f;
#define D2_LOAD(n) do { _Pragma("unroll") for (int i_ = 0; i_ < 2; ++i_) { const int id_ = tid + 512 * i_; wreg[i_] = *(const v4u*)(WTg + (size_t)(n) * 8192 + id_ * 8); \
            const int row_ = id_ >> 4, ch_ = id_ & 15; const size_t o2_ = (tok0 + (n) * 64 + row_) * W_D + h * 128 + ch_ * 8; qreg[i_] = *(const v4u*)(Q2 + o2_); kreg[i_] = *(const v4u*)(K2 + o2_); } \
        preg = *(const v4u*)(QKg + (size_t)(n) * 4096 + tid * 8); \
        _Pragma("unroll") for (int tt_ = 0; tt_ < 4; ++tt_) ureg[tt_] = *(const unsigned long long*)(UTg + (size_t)(n) * 8192 + (16 * wave + l15) * 64 + 16 * tt_ + 4 * g); \
        if (tid < 64) dreg = DECg[(n) * 64 + tid]; } while (0)
#define D2_STORE() do { _Pragma("unroll") for (int i_ = 0; i_ < 2; ++i_) { const int id_ = tid + 512 * i_; *(LAS v4u*)(lds + D2_OFF_W + (id_ >> 3) * D2_RSW + (id_ & 7) * 16) = wreg[i_]; \
            const int row_ = id_ >> 4, ch_ = id_ & 15; *(LAS v4u*)(lds + D2_OFF_Q + row_ * D2_RSQ + ch_ * 16) = qreg[i_]; *(LAS v4u*)(lds + D2_OFF_K + row_ * D2_RSK + ch_ * 16) = kreg[i_]; } \
        *(LAS v4u*)(lds + D2_OFF_P + (tid >> 3) * D2_RSP + (tid & 7) * 16) = preg; if (tid < 64) dec_s[tid] = dreg; } while (0)
    D2_LOAD(0);
    for (int n = 0; n < NCH; ++n) {
        D2_STORE();
        f32x4 un[4];
#pragma unroll
        for (int tt = 0; tt < 4; ++tt) { un[tt][0] = __builtin_bit_cast(float, (unsigned)(ureg[tt] & 0xffffull) << 16); un[tt][1] = __builtin_bit_cast(float, (unsigned)(ureg[tt] >> 16 & 0xffffull) << 16);
            un[tt][2] = __builtin_bit_cast(float, (unsigned)(ureg[tt] >> 32 & 0xffffull) << 16); un[tt][3] = __builtin_bit_cast(float, (unsigned)(ureg[tt] >> 48) << 16); }
        if (tid < 64) tot[(n & 1) * 64 + tid] = 0.f;
        __syncthreads();
        if (n + 1 < NCH) D2_LOAD(n + 1);
        const float dlast = dec_s[63];
        bf16x8 sf[4];
#pragma unroll
        for (int j = 0; j < 4; ++j) sf[j] = acc_pair_frag(sacc[2 * j], sacc[2 * j + 1]);
        f32x4 vn[4], o[4];
#pragma unroll
        for (int tt = 0; tt < 4; ++tt) { f32x4 ws_ = (f32x4){0.f, 0.f, 0.f, 0.f}, qs_ = ws_;
#pragma unroll
            for (int j = 0; j < 4; ++j) { ws_ = MFMA16(frag_tr_perm(lds + D2_OFF_W, D2_RSW, 32 * j, 16 * tt, lane), sf[j], ws_); qs_ = MFMA16(frag_row_perm(lds + D2_OFF_Q, D2_RSQ, 16 * tt, 32 * j, lane), sf[j], qs_); }
#pragma unroll
            for (int r = 0; r < 4; ++r) { vn[tt][r] = un[tt][r] - ws_[r]; o[tt][r] = qs_[r] * (expf(dec_s[16 * tt + 4 * g + r]) * DN_SCALE); } }
        bf16x8 vf[2], vsf[2];
#pragma unroll
        for (int ks = 0; ks < 2; ++ks) { vf[ks] = acc_pair_frag(vn[2 * ks], vn[2 * ks + 1]); f32x4 a_ = vn[2 * ks], b_ = vn[2 * ks + 1];
#pragma unroll
            for (int r = 0; r < 4; ++r) { a_[r] *= expf(dlast - dec_s[32 * ks + 4 * g + r]); b_[r] *= expf(dlast - dec_s[32 * ks + 16 + 4 * g + r]); }
            vsf[ks] = acc_pair_frag(a_, b_); }
#pragma unroll
        for (int tt = 0; tt < 4; ++tt)
#pragma unroll
            for (int ks = 0; ks < 2; ++ks) o[tt] = MFMA16(frag_row_perm(lds + D2_OFF_P, D2_RSP, 16 * tt, 32 * ks, lane), vf[ks], o[tt]);
        { const float edl = expf(dlast);
#pragma unroll
          for (int kt = 0; kt < 8; ++kt) { sacc[kt] *= edl;
#pragma unroll
              for (int ks = 0; ks < 2; ++ks) sacc[kt] = MFMA16(frag_tr_perm(lds + D2_OFF_K, D2_RSK, 32 * ks, 16 * kt, lane), vsf[ks], sacc[kt]); } }
#pragma unroll
        for (int tt = 0; tt < 4; ++tt)
#pragma unroll
            for (int r = 0; r < 4; ++r) { float p = o[tt][r] * o[tt][r]; p += __shfl_xor(p, 1); p += __shfl_xor(p, 2); p += __shfl_xor(p, 4); p += __shfl_xor(p, 8);
                if (l15 == 0) atomicAdd((float*)(tot + (n & 1) * 64 + 16 * tt + 4 * g + r), p); }
        __syncthreads();
#pragma unroll
        for (int tt = 0; tt < 4; ++tt)
#pragma unroll
            for (int r = 0; r < 4; ++r) { const int t = 16 * tt + 4 * g + r; const size_t tok = tok0 + n * 64 + t; const int vcol = h * 128 + 16 * wave + l15;
                const float rs = 1.0f / sqrtf(tot[(n & 1) * 64 + t] * (1.0f / 128.0f) + EPS); const float zd = bf2f(PROJ[tok * OD_N + OC_ZD + vcol]);
                Y[tok * D_MODEL + W_C + vcol] = (bf16_t)f2bf(o[tt][r] * rs * og * siluf_(zd)); }
    }
#undef D2_LOAD
#undef D2_STORE
    __syncthreads();
}
__device__ __forceinline__ void vb_attn(const bf16_t* __restrict__ PROJ, const float* __restrict__ qn_g, const float* __restrict__ kn_g, const float* __restrict__ rel_bias, bf16_t* __restrict__ Y,
                                        int bid, int t, LAS float* qs  , LAS float* S  , bool active) {
    if (!active) bid = 0;
    const int quarter = bid & 3, c = (bid >> 2) & 31, h = (bid >> 7) & 7, b = bid >> 10;
    { const int r = t >> 4, sub = t & 15; const int tok = b * SEQ + c * 64 + quarter * 16 + r;
      float v[8]; ld8bf(PROJ + (size_t)tok * EV_N + EC_QA + h * 128 + sub * 8, v);
      float ss = 0.f;
#pragma unroll
      for (int i = 0; i < 8; ++i) ss += v[i] * v[i];
      ss += __shfl_xor(ss, 1); ss += __shfl_xor(ss, 2); ss += __shfl_xor(ss, 4); ss += __shfl_xor(ss, 8);
      const float rs = 1.0f / sqrtf(ss * (1.0f / 128.0f) + EPS);
#pragma unroll
      for (int i = 0; i < 8; ++i) qs[r * 128 + sub * 8 + i] = v[i] * rs * qn_g[sub * 8 + i] * 0.08838834764831845f; }
    __syncthreads();
    for (int idx = t; idx < 16 * BAND; idx += 256) {
        const int r = idx / BAND, j = idx % BAND; const int kc = c - LOOKBACK + (j >> 6);
        float s;
        if (kc < 0) s = -1e30f;
        else { const bf16_t* kp = PROJ + (size_t)(b * SEQ + kc * 64 + (j & 63)) * EV_N + EC_KA + h * 128;
            float ss = 0.f, dot = 0.f;
            for (int d = 0; d < 128; d += 8) { float kv[8]; ld8bf(kp + d, kv);
#pragma unroll
                for (int i = 0; i < 8; ++i) { ss += kv[i] * kv[i]; dot += kv[i] * kn_g[d + i] * qs[r * 128 + d + i]; } }
            s = dot * (1.0f / sqrtf(ss * (1.0f / 128.0f) + EPS));
            const int qi = quarter * 16 + r; int rel = LOOKBACK * CHUNK + qi - j; rel = rel < -REL_MAX ? -REL_MAX : (rel > REL_MAX ? REL_MAX : rel); rel += REL_MAX;
            s += rel_bias[h * NREL + rel]; }
        S[r * 577 + j] = s;
    }
    __syncthreads();
    { const int r = t >> 4, sub = t & 15; float mx = -3.0e38f;
      for (int j = sub; j < BAND; j += 16) mx = fmaxf(mx, S[r * 577 + j]);
      mx = fmaxf(mx, __shfl_xor(mx, 1)); mx = fmaxf(mx, __shfl_xor(mx, 2)); mx = fmaxf(mx, __shfl_xor(mx, 4)); mx = fmaxf(mx, __shfl_xor(mx, 8));
      float sum = 0.f;
      for (int j = sub; j < BAND; j += 16) { const float e = expf(S[r * 577 + j] - mx); S[r * 577 + j] = e; sum += e; }
      sum += __shfl_xor(sum, 1); sum += __shfl_xor(sum, 2); sum += __shfl_xor(sum, 4); sum += __shfl_xor(sum, 8);
      const float inv = 1.0f / sum;
      for (int j = sub; j < BAND; j += 16) S[r * 577 + j] *= inv; }
    __syncthreads();
    { const int r = t >> 4, dg = t & 15; float acc[8];
#pragma unroll
      for (int i = 0; i < 8; ++i) acc[i] = 0.f;
      for (int j = 0; j < BAND; ++j) { const int kc = c - LOOKBACK + (j >> 6); if (kc < 0) continue;
          const float p = S[r * 577 + j]; float vv[8]; ld8bf(PROJ + (size_t)(b * SEQ + kc * 64 + (j & 63)) * EV_N + EC_VA + h * 128 + dg * 8, vv);
#pragma unroll
          for (int i = 0; i < 8; ++i) acc[i] += p * vv[i]; }
      const int tok = b * SEQ + c * 64 + quarter * 16 + r; float z[8]; ld8bf(PROJ + (size_t)tok * EV_N + EC_ZA + h * 128 + dg * 8, z);
      v4u o; o.x = pk2(acc[0] * siluf_(z[0]), acc[1] * siluf_(z[1])); o.y = pk2(acc[2] * siluf_(z[2]), acc[3] * siluf_(z[3]));
      o.z = pk2(acc[4] * siluf_(z[4]), acc[5] * siluf_(z[5])); o.w = pk2(acc[6] * siluf_(z[6]), acc[7] * siluf_(z[7]));
      if (active) *(v4u*)(Y + (size_t)tok * D_MODEL + h * 128 + dg * 8) = o; }
    __syncthreads();
}
__device__ __forceinline__ void vb_mlstm(const bf16_t* __restrict__ PROJ, const float* __restrict__ GIF, bf16_t* __restrict__ Y, int bid, int t, LAS float* sm  ) {
    LAS float* ks = sm; LAS float* qs = sm + 256; LAS float* part = sm + 512; LAS float* dpart = sm + 768;
    const int vs = bid & 3, h = (bid >> 2) & 3, b = bid >> 4, v = t & 63, kq = t >> 6;
    float C[64];
#pragma unroll
    for (int i = 0; i < 64; ++i) C[i] = 0.f;
    float nreg = 0.f;
    for (int s = 0; s < SEQ; ++s) {
        const size_t tok = (size_t)b * SEQ + s; const bf16_t* pr = PROJ + tok * EV_N;
        const float li = GIF[tok * 8 + h], fpre = GIF[tok * 8 + 4 + h];
        const float fw = sigmoidf_(fpre), iw = expf(li);
        const float kk = bf2f(pr[EC_KB + h * 256 + t]), qq = bf2f(pr[EC_QB + h * 256 + t]) * 0.0625f;
        const float vv = bf2f(pr[EC_VB + h * 256 + vs * 64 + v]);
        ks[t] = kk; qs[t] = qq;
        nreg = fw * nreg + iw * kk;
        float dp = nreg * qq; dp = wave_sum(dp);
        if ((t & 63) == 0) dpart[kq] = dp;
        __syncthreads();
        float np = 0.f; const float iv = iw * vv;
#pragma unroll
        for (int i = 0; i < 64; ++i) { C[i] = fw * C[i] + ks[kq * 64 + i] * iv; np += C[i] * qs[kq * 64 + i]; }
        part[kq * 64 + v] = np;
        __syncthreads();
        if (t < 64) { const float num = (part[t] + part[64 + t]) + (part[128 + t] + part[192 + t]); const float den = (dpart[0] + dpart[1]) + (dpart[2] + dpart[3]);
            const float hh = num / fmaxf(fabsf(den), 1.0f);
            const float ob = bf2f(pr[EC_OB + h * 256 + vs * 64 + t]), zb = bf2f(pr[EC_ZB + h * 256 + vs * 64 + t]);
            Y[tok * D_MODEL + W_A + h * 256 + vs * 64 + t] = (bf16_t)f2bf(sigmoidf_(ob) * hh * siluf_(zb)); }
        __syncthreads();
    }
}
__device__ __forceinline__ void phase_mix0(const Ptrs& P, LAS unsigned char* lds, int G) {
    const int w = blockIdx.x;
    constexpr int NML = BATCH * H_B * 2;
    if (w < NML) mlstm_item(P, lds, w);
    else { for (int item = w - NML; item < BATCH * H_A * (NCH / 2); item += G - NML) attn_item(P, lds, item); }
}
constexpr size_t WS_RA = WS_FREE1, WS_RINP = WS_XB, WS_Q2 = 4 * MiB, WS_K2 = 36 * MiB, WS_V2 = 465 * MiB;
__device__ __forceinline__ void vb_rglru_gates(const bf16_t* __restrict__ PROJ, const float* __restrict__ ccw, const float* __restrict__ ccb, const float* __restrict__ gw, const float* __restrict__ gb,
                                               const float* __restrict__ lam, float* __restrict__ A, float* __restrict__ INP, int bid, int t, LAS float* xs  ) {
    const int blk = bid & 7, tg = bid >> 3, c = blk * 128 + t;
    float xc[8];
#pragma unroll
    for (int i = 0; i < 8; ++i) { const int tok = tg * 8 + i, s = tok % SEQ; float a = ccb[c];
#pragma unroll
        for (int j = 0; j < 4; ++j) { const int sj = s - 3 + j; if (sj >= 0) a += ccw[j * W_C + c] * bf2f(PROJ[(size_t)(tok - 3 + j) * OD_N + OC_XC + c]); }
        xc[i] = a; xs[i * 128 + t] = a; }
    __syncthreads();
    float rp[8], ip[8];
#pragma unroll
    for (int i = 0; i < 8; ++i) { rp[i] = 0.f; ip[i] = 0.f; }
    const float* g0 = gw + (size_t)blk * 128 * 256;
    for (int k = 0; k < 128; ++k) { const float wr_ = g0[k * 256 + t], wi_ = g0[k * 256 + 128 + t];
#pragma unroll
        for (int i = 0; i < 8; ++i) { const float xv = xs[i * 128 + k]; rp[i] += xv * wr_; ip[i] += xv * wi_; } }
    const float sp = softplusf_(-lam[c]); const float gbr = gb[c], gbi = gb[W_C + c];
#pragma unroll
    for (int i = 0; i < 8; ++i) { const int tok = tg * 8 + i; const float r = sigmoidf_(rp[i] + gbr), ig = sigmoidf_(ip[i] + gbi);
        const float la = -8.0f * r * sp; A[(size_t)tok * W_C + c] = expf(la); INP[(size_t)tok * W_C + c] = sqrtf(-expm1f(2.0f * la)) * (ig * xc[i]); }
    __syncthreads();
}
__device__ __forceinline__ void vb_dn_prep(const bf16_t* __restrict__ PROJ, const float* __restrict__ cdw, bf16_t* __restrict__ Q2, bf16_t* __restrict__ K2, bf16_t* __restrict__ V2, int bid, int t, LAS float* red  ) {
    const int h = bid & 7, tok = bid >> 3, s = tok % SEQ; float o[3];
#pragma unroll
    for (int p = 0; p < 3; ++p) { const int col = p * W_D + h * 128 + t; float a = 0.f;
#pragma unroll
        for (int j = 0; j < 4; ++j) { const int sj = s - 3 + j; if (sj >= 0) a += cdw[j * 3 * W_D + col] * bf2f(PROJ[(size_t)(tok - 3 + j) * OD_N + OC_QD + col]); }
        o[p] = siluf_(a); }
    float sq = wave_sum(o[0] * o[0]), sk = wave_sum(o[1] * o[1]);
    if ((t & 63) == 0) { red[(t >> 6) * 2 + 0] = sq; red[(t >> 6) * 2 + 1] = sk; }
    __syncthreads();
    sq = red[0] + red[2]; sk = red[1] + red[3];
    const size_t o_ = (size_t)tok * W_D + h * 128 + t;
    Q2[o_] = (bf16_t)f2bf(o[0] * (1.0f / sqrtf(sq + EPS))); K2[o_] = (bf16_t)f2bf(o[1] * (1.0f / sqrtf(sk + EPS))); V2[o_] = (bf16_t)f2bf(o[2]);
    __syncthreads();
}
__device__ __forceinline__ void phase_mix1a(const Ptrs& P, LAS unsigned char* lds, int G) {
    for (int it = blockIdx.x; it < BATCH * N_BLK_C * 4; it += G) rglru_item(P, lds, it);
    for (int it = blockIdx.x; it < BATCH * H_D * NCH; it += G) dn1_item(P, lds, it);
}
__device__ __forceinline__ void vb_dn_scan(const bf16_t* __restrict__ PROJ, const bf16_t* __restrict__ Q2, const bf16_t* __restrict__ K2, const bf16_t* __restrict__ V2, const float* __restrict__ AB,
                                           const float* __restrict__ a_log, const float* __restrict__ dt_bias, const float* __restrict__ onorm, bf16_t* __restrict__ Y, int bid, int t, LAS float* sm  ) {
    LAS float* ks = sm; LAS float* qs = sm + 128; LAS float* part = sm + 256; LAS float* red = sm + 512;
    const int h = bid & 7, b = bid >> 3, v = t & 127, kh = t >> 7;
    float S[64];
#pragma unroll
    for (int i = 0; i < 64; ++i) S[i] = 0.f;
    const float Aexp = expf(a_log[h]), dtb = dt_bias[h], og = onorm[v];
    for (int s = 0; s < SEQ; ++s) {
        const size_t tok = (size_t)b * SEQ + s; const size_t o_ = tok * W_D + h * 128;
        if (t < 128) ks[t] = bf2f(K2[o_ + t]); else qs[t - 128] = bf2f(Q2[o_ + t - 128]) * 0.08838834764831845f;
        const float vv = bf2f(V2[o_ + v]);
        const float beta = sigmoidf_(AB[tok * 16 + 8 + h]); const float g = -Aexp * softplusf_(AB[tok * 16 + h] + dtb); const float al = expf(g);
        __syncthreads();
        float rp = 0.f;
#pragma unroll
        for (int i = 0; i < 64; ++i) rp += S[i] * ks[kh * 64 + i];
        part[kh * 128 + v] = rp;
        __syncthreads();
        const float r = part[v] + part[128 + v];
        const float u = beta * (vv - al * r);
        float op = 0.f;
#pragma unroll
        for (int i = 0; i < 64; ++i) { S[i] = al * S[i] + ks[kh * 64 + i] * u; op += S[i] * qs[kh * 64 + i]; }
        __syncthreads();
        part[kh * 128 + v] = op;
        __syncthreads();
        const float o = part[v] + part[128 + v];
        float sq = (t < 128) ? o * o : 0.f; sq = wave_sum(sq);
        if (t == 0) red[0] = sq; if (t == 64) red[1] = sq;
        __syncthreads();
        if (t < 128) { const float ms = (red[0] + red[1]) * (1.0f / 128.0f);
            const float zd = bf2f(PROJ[tok * OD_N + OC_ZD + h * 128 + t]);
            Y[tok * D_MODEL + W_C + h * 128 + t] = (bf16_t)f2bf(o * (1.0f / sqrtf(ms + EPS)) * og * siluf_(zd)); }
    }
}
__device__ __forceinline__ void phase_mix1b(const Ptrs& P, LAS unsigned char* lds, int G) {
    for (int it = blockIdx.x; it < BATCH * H_D; it += G) dn2_item(P, lds, it);
}
typedef GAS unsigned gu32;
#define RLX_AGENT __ATOMIC_RELAXED, __HIP_MEMORY_SCOPE_AGENT
constexpr int CW_BAR = 4096;
static_assert((CW_BAR + XCD_BAR_WORDS) * 4 <= (int)CTL_ZERO_BYTES, "CTL words inside the memset region");
constexpr int RING_OFF = 0, RING_BYTES = 131072;
constexpr int LDSCTL_OFF = RING_BYTES, MISC_OFF = LDSCTL_OFF + 320;
constexpr int LDS_BYTES = 147456;

struct Args { Ptrs P; int ph_lo, ph_hi; };
constexpr int N_PHASES = 8;

__global__ void __launch_bounds__(NWAVES * 64, 2) fwd_mega(Args args) {
    extern __shared__ __attribute__((aligned(16))) unsigned char lds_raw[];
    LAS unsigned char* lds = (LAS unsigned char*)lds_raw;
    volatile LAS unsigned* MISC = (volatile LAS unsigned*)(lds + MISC_OFF);
    const int tid = threadIdx.x, lane = tid & 63, wave = __builtin_amdgcn_readfirstlane(tid >> 6);
    const int G = gridDim.x;
    for (int u = tid; u < (LDS_BYTES - LDSCTL_OFF) / 4; u += NWAVES * 64) ((LAS unsigned*)(lds + LDSCTL_OFF))[u] = 0u;
    __syncthreads();
    const Ptrs& P = args.P;
    gu32* ctl = (gu32*)(P.ws + WS_CTL);
    const int lo = args.ph_lo, hi = args.ph_hi;
    XcdBarrier bar; bar.bar = (unsigned*)(ctl + CW_BAR); bar.x = 0; bar.st = nullptr;
    if (hi - lo > 1) bar = xcd_barrier_post((unsigned*)(ctl + CW_BAR), MISC + 8);
#define IN(k) (lo <= (k) && (k) < hi)
#define SEAM(k) do { if (IN(k) && IN((k) + 1)) xcd_barrier(bar); } while (0)
    if (IN(0)) { phase_prologue(P, lds, wave, lane, blockIdx.x * NWAVES + wave, G * NWAVES); }
    SEAM(0);
    if (IN(1)) { phase_gemm<1>(P, lds, G, blockIdx.x); }
    SEAM(1);
    if (IN(2)) { phase_mix0(P, lds, G); }
    SEAM(2);
    if (IN(3)) { phase_gemm<2>(P, lds, G, blockIdx.x); }
    SEAM(3);
    if (IN(4)) { phase_gemm<3>(P, lds, G, blockIdx.x); phase_gates_ab(P, G); }
    SEAM(4);
    if (IN(5)) { phase_mix1a(P, lds, G); }
    SEAM(5);
    if (IN(6)) { phase_mix1b(P, lds, G); }
    SEAM(6);
    if (IN(7)) { phase_gemm<4>(P, lds, G, blockIdx.x); }
#undef IN
#undef SEAM
}
extern "C" void kernel_launch(void* const* d_in, const int* in_sizes, int n_in, void* d_out, int out_size, void* d_ws, size_t ws_size, hipStream_t stream) {
    static int grid = 0;
    if (grid == 0) {
        if (n_in != 20 || in_sizes[0] != M_TOK * D_MODEL || out_size != M_TOK * D_MODEL || ws_size < WS_END) {
            fprintf(stderr, "kernel_launch: unexpected shapes: n_in %d in0 %d out %d ws %zu (need %zu)\n", n_in, n_in > 0 ? in_sizes[0] : -1, out_size, ws_size, (size_t)WS_END); grid = -1; return; }
        int dev = 0, cus = 0, per_cu = 0;
        if (hipGetDevice(&dev) != hipSuccess || hipDeviceGetAttribute(&cus, hipDeviceAttributeMultiprocessorCount, dev) != hipSuccess) { grid = -1; return; }
        if (hipFuncSetAttribute((const void*)fwd_mega, hipFuncAttributeMaxDynamicSharedMemorySize, LDS_BYTES) != hipSuccess) { fprintf(stderr, "kernel_launch: hipFuncSetAttribute failed\n"); grid = -1; return; }
        if (hipOccupancyMaxActiveBlocksPerMultiprocessor(&per_cu, (const void*)fwd_mega, NWAVES * 64, LDS_BYTES) != hipSuccess || per_cu < 1) { fprintf(stderr, "kernel_launch: occupancy query says %d blocks per CU\n", per_cu); per_cu = 1; }
        (void)hipGetLastError();
        grid = cus;
    }
    if (grid < 0) return;
    if (hipMemsetAsync((char*)d_ws + WS_CTL, 0, CTL_ZERO_BYTES, stream) != hipSuccess) { fprintf(stderr, "kernel_launch: memset failed\n"); return; }
    Args a{};
    for (int i = 0; i < 20; ++i) a.P.in[i] = (const float*)d_in[i];
    a.P.out = (float*)d_out; a.P.ws = (unsigned char*)d_ws; a.ph_lo = 0; a.ph_hi = N_PHASES;
    hipLaunchKernelGGL(fwd_mega, dim3(grid), dim3(NWAVES * 64), LDS_BYTES, stream, a);
    const hipError_t le = hipPeekAtLastError();
    if (le != hipSuccess) fprintf(stderr, "kernel_launch: launch failed: %s\n", hipGetErrorName(le));
}
```

```cpp
#include <hip/hip_runtime.h>
#include <cstdio>
#include <cstdint>
#include <cmath>

constexpr int D_MODEL = 2048, BATCH = 8, SEQ = 2048, M_TOK = BATCH * SEQ;
constexpr int CHUNK = 64, NCH = SEQ / CHUNK;
constexpr float EPS = 1e-6f;
constexpr int HD_A = 128, W_A = 1024, H_A = 8, LOOKBACK = 8, BAND = (LOOKBACK + 1) * CHUNK, REL_MAX = 256, NREL = 2 * REL_MAX + 1;
constexpr int H_B = 4, W_B = 1024, HD_B = 256;
constexpr int W_C = 1024, N_BLK_C = 8, BLK_C = 128;
constexpr int HD_D = 128, W_D = 1024, H_D = 8;
constexpr int EV_IN = 9224, EV_N = 9216;
constexpr int OD_IN = 6160, OD_N = 6144;
constexpr int EC_QA = 0, EC_KA = 1024, EC_VA = 2048, EC_ZA = 3072, EC_QB = 4096, EC_KB = 5120, EC_VB = 6144, EC_OB = 7168, EC_ZB = 8192;
constexpr int OC_XC = 0, OC_ZC = 1024, OC_QD = 2048, OC_KD = 3072, OC_VD = 4096, OC_ZD = 5120;

constexpr size_t MiB = 1u << 20;
constexpr size_t WS_CTL = 0, CTL_ZERO_BYTES = 1 * MiB;
constexpr size_t WS_R0 = 1 * MiB;
constexpr size_t WS_SS1 = WS_R0 + 64 * 1024;
constexpr size_t WS_GIF = WS_SS1 + 64 * 1024;
constexpr size_t WS_AB = WS_GIF + 512 * 1024;
constexpr size_t WS_W1T = 4 * MiB;
constexpr size_t WS_W2T = 40 * MiB;
constexpr size_t WS_W3T = 48 * MiB;
constexpr size_t WS_W4T = 73 * MiB;
constexpr size_t WS_XB = 81 * MiB;
constexpr size_t WS_Y = 145 * MiB;
constexpr size_t WS_PROJ = 209 * MiB;
constexpr size_t WS_END = 497 * MiB;
constexpr size_t WS_FREE1 = 401 * MiB;

typedef unsigned short bf16_t;
__device__ __forceinline__ float bf2f(unsigned short v) { return __builtin_bit_cast(float, (unsigned)v << 16); }
__device__ __forceinline__ unsigned f2bf(float f) { unsigned u = __builtin_bit_cast(unsigned, f); return (u + 0x7fffu + ((u >> 16) & 1u)) >> 16; }
typedef float f32x2_t_ __attribute__((ext_vector_type(2))); typedef __bf16 bf16x2_t_ __attribute__((ext_vector_type(2)));
__device__ __forceinline__ unsigned pk2(float lo, float hi) { const f32x2_t_ v = {lo, hi}; return __builtin_bit_cast(unsigned, __builtin_convertvector(v, bf16x2_t_)); }
__device__ __forceinline__ float sigmoidf_(float x) { return 1.f / (1.f + expf(-x)); }
__device__ __forceinline__ float siluf_(float x) { return x / (1.f + expf(-x)); }
__device__ __forceinline__ float softplusf_(float x) { return fmaxf(x, 0.f) + log1pf(expf(-fabsf(x))); }
__device__ __forceinline__ float logsigmoidf_(float x) { return -softplusf_(-x); }

namespace pg8 {
#define PG8_LAS __attribute__((address_space(3)))
typedef unsigned short bf16_t;
typedef short bf16x8 __attribute__((ext_vector_type(8)));
typedef float f32x4 __attribute__((ext_vector_type(4)));
typedef unsigned u32x4 __attribute__((ext_vector_type(4)));
constexpr int BM = 256, BK = 64, HALF = 128, HTB = HALF * BK * 2  , STAGE_BYTES = 8 * HTB, NXCD = 8, WGM = 4;

__host__ __device__ __forceinline__ int lds_byte(int r, int c) { const int st = (r >> 4) * 2 + (c >> 5), rr = r & 15, cc = c & 31, ob = rr * 64 + cc * 2; return st * 1024 + (ob ^ (((ob >> 9) & 1) << 5)); }
__host__ __device__ __forceinline__ void stage_rc(int b, int& R, int& C) { const int st = b / 1024, sb = b % 1024, swz = sb ^ (((sb >> 9) & 1) << 5); R = (st >> 1) * 16 + swz / 64; C = (st & 1) * 32 + (swz % 64) / 2; }
__host__ __device__ __forceinline__ int perm32(int rho) { const int n = rho >> 4, i = rho & 15; return 8 * (i >> 2) + 4 * n + (i & 3); }

struct Unit { int pm, pn; };
struct Gemm { const bf16_t* A; const bf16_t* Bt; int M, N, K; };

struct StaticOrder {
    int nM, nN, nwg, G, c;
    __host__ __device__ void init(int M, int N, int G_, int c_) { nM = M / BM; nN = N / BM; nwg = nM * nN; G = G_; c = c_; }
    __host__ __device__ bool next(int i, Unit& u) const {
        const long L = (long)i * G + c; if (L >= nwg) return false;
        int wgid = (int)L; { const int q = nwg / NXCD, r = nwg % NXCD, xcd = wgid % NXCD, off = wgid / NXCD; wgid = (xcd < r ? xcd * (q + 1) : r * (q + 1) + (xcd - r) * q) + off; }
        const int nig = WGM * nN, gid = wgid / nig, fm = gid * WGM, gsz = (nM - fm) < WGM ? (nM - fm) : WGM;
        u.pm = fm + ((wgid % nig) % gsz); u.pn = (wgid % nig) / gsz; return true;
    }
    __device__ __forceinline__ void a_ready(const Unit&) const {}
    __device__ __forceinline__ void done(const Unit&) const {}
};

__device__ __forceinline__ unsigned cvt_pk_bf16(float lo, float hi) { unsigned r; asm volatile("v_cvt_pk_bf16_f32 %0, %1, %2" : "=v"(r) : "v"(lo), "v"(hi)); return r; }
struct EpiProj {
    static constexpr bool PERM = true, AFTER_DRAIN = false;
    bf16_t* O; int ldc; const float* rowv; int mode;
    __device__ __forceinline__ void operator()(const f32x4 (&acc)[2][2][4][2], const Unit& u, int wr, int wc, int fr, int fq) const {
        const int row0 = u.pm * BM + wr * 64 + fr; const int col0 = u.pn * BM + wc * 32 + 8 * fq;
#pragma unroll
        for (int ai = 0; ai < 2; ++ai)
#pragma unroll
            for (int m = 0; m < 4; ++m) { const int row = row0 + ai * HALF + m * 16; float sc = rowv[row]; if (mode) sc = 1.0f / sqrtf(sc * (1.0f / 2048.0f) + 1e-6f);
                bf16_t* rowp = O + (size_t)row * ldc + col0;
#pragma unroll
                for (int bj = 0; bj < 2; ++bj) { const f32x4 v0 = acc[ai][bj][m][0] * sc, v1 = acc[ai][bj][m][1] * sc;
                    u32x4 w; w.x = cvt_pk_bf16(v0[0], v0[1]); w.y = cvt_pk_bf16(v0[2], v0[3]); w.z = cvt_pk_bf16(v1[0], v1[1]); w.w = cvt_pk_bf16(v1[2], v1[3]);
                    *(u32x4*)(rowp + bj * HALF) = w; } }
    }
};
struct EpiRes {
    static constexpr bool PERM = false, AFTER_DRAIN = false;
    const float* base; float* out; bf16_t* xb; float* sumsq; int ldc;
    __device__ __forceinline__ void operator()(const f32x4 (&acc)[2][2][4][2], const Unit& u, int wr, int wc, int fr, int fq) const {
        typedef unsigned u32x2v __attribute__((ext_vector_type(2)));
        const int col0 = u.pn * BM + wc * 32 + 4 * fq;
#pragma unroll
        for (int ai = 0; ai < 2; ++ai)
#pragma unroll
            for (int m = 0; m < 4; ++m) { const int row = u.pm * BM + ai * HALF + wr * 64 + m * 16 + fr; const size_t off = (size_t)row * ldc + col0; float ss = 0.f;
#pragma unroll
                for (int bj = 0; bj < 2; ++bj)
#pragma unroll
                    for (int n = 0; n < 2; ++n) { const f32x4 o = *(const f32x4*)(base + off + bj * HALF + n * 16) + acc[ai][bj][m][n];
                        *(f32x4*)(out + off + bj * HALF + n * 16) = o;
                        if (xb) { u32x2v w; w.x = cvt_pk_bf16(o[0], o[1]); w.y = cvt_pk_bf16(o[2], o[3]); *(u32x2v*)(xb + off + bj * HALF + n * 16) = w; }
                        ss += (o[0] * o[0] + o[1] * o[1]) + (o[2] * o[2] + o[3] * o[3]); }
                if (sumsq) { ss += __shfl_xor(ss, 16); ss += __shfl_xor(ss, 32); if (fq == 0) atomicAdd(sumsq + row, ss); } }
    }
};

template <class Epi, class Sched, bool ALIGN_EPI = false, bool SP2 = false>
__device__ __forceinline__ void gemm_phase(PG8_LAS unsigned char* lds, const Gemm g, const Sched& S, const Epi& E) {
    const int tid = threadIdx.x, wid = __builtin_amdgcn_readfirstlane(tid >> 6), lane = tid & 63, wr = wid >> 2, wc = wid & 3, fr = lane & 15, fq = lane >> 4;
    const int K = g.K, nt = K / BK;
    unsigned voffA[2], voffB[2];
#pragma unroll
    for (int i = 0; i < 2; ++i) { int R, C; stage_rc(tid * 16 + i * 8192, R, C); const int Rb = Epi::PERM ? ((R & ~31) + perm32(R & 31)) : R;
        voffA[i] = (unsigned)(R * K + C) * 2u; voffB[i] = (unsigned)(Rb * K + C) * 2u; }
    const size_t kstep = (size_t)(BK * 2);
    const size_t hstep = (size_t)HALF * K * 2;
    const size_t tstep = 2 * hstep;
    const unsigned ldsw = (unsigned)wid * 1024u;
    const int aoff = lds_byte(wr * 64 + fr, fq * 8), boff = lds_byte(wc * 32 + fr, fq * 8);
#define PG8_SA(b, h) (((b) * 2 + (h)) * HTB)
#define PG8_SB(b, h) ((4 + (b) * 2 + (h)) * HTB)
#define PG8_STAGE(bufoff, gbase, voff) do { _Pragma("unroll") for (int _i = 0; _i < 2; ++_i) \
        __builtin_amdgcn_global_load_lds((const unsigned*)((const char*)(gbase) + (voff)[_i]), (PG8_LAS unsigned*)(lds + (bufoff) + ldsw + _i * 8192), 16, 0, 0); } while (0)
#define PG8_LDA(dst, b, h) do { _Pragma("unroll") for (int m = 0; m < 4; ++m) _Pragma("unroll") for (int k = 0; k < 2; ++k) dst[m][k] = *(const PG8_LAS bf16x8*)(lds + PG8_SA(b, h) + aoff + m * 2048 + k * 1024); } while (0)
#define PG8_LDB(dst, b, h) do { _Pragma("unroll") for (int n = 0; n < 2; ++n) _Pragma("unroll") for (int k = 0; k < 2; ++k) dst[n][k] = *(const PG8_LAS bf16x8*)(lds + PG8_SB(b, h) + boff + n * 2048 + k * 1024); } while (0)
#define PG8_MMA(ai, bj, At, Bt) do { __builtin_amdgcn_s_setprio(1); _Pragma("unroll") for (int m = 0; m < 4; ++m) _Pragma("unroll") for (int n = 0; n < 2; ++n) _Pragma("unroll") for (int k = 0; k < 2; ++k) \
        acc[ai][bj][m][n] = __builtin_amdgcn_mfma_f32_16x16x32_bf16(Bt[n][k], At[m][k], acc[ai][bj][m][n], 0, 0, 0); __builtin_amdgcn_s_setprio(0); } while (0)
#define PG8_WAIT_V(n) asm volatile("s_waitcnt vmcnt(" #n ")" ::: "memory")
#define PG8_WAIT_L(n) asm volatile("s_waitcnt lgkmcnt(" #n ")" ::: "memory")
#define PG8_BAR __builtin_amdgcn_s_barrier()
#define PG8_SCHED __builtin_amdgcn_sched_barrier(0)
    Unit cur, nxt; int ui = 0;
    if (!S.next(0, cur)) return;
    f32x4 acc[2][2][4][2];
#pragma unroll
    for (int a = 0; a < 2; ++a)
#pragma unroll
        for (int b = 0; b < 2; ++b)
#pragma unroll
            for (int m = 0; m < 4; ++m)
#pragma unroll
                for (int n = 0; n < 2; ++n) acc[a][b][m][n] = (f32x4){0.f, 0.f, 0.f, 0.f};
    bf16x8 At[4][2], B0[2][2], B1[2][2];
    const char* cA = (const char*)g.A + (size_t)cur.pm * tstep; const char* cB = (const char*)g.Bt + (size_t)cur.pn * tstep;
    S.a_ready(cur);
    if constexpr (SP2) {
        PG8_STAGE(PG8_SB(0, 0), cB, voffB); PG8_STAGE(PG8_SB(0, 1), cB + hstep, voffB); PG8_STAGE(PG8_SA(0, 0), cA, voffA); PG8_STAGE(PG8_SA(0, 1), cA + hstep, voffA);
        if (wr == 1) PG8_BAR;
        PG8_WAIT_V(2); PG8_BAR;
        PG8_STAGE(PG8_SB(1, 0), cB + kstep, voffB); PG8_STAGE(PG8_SA(1, 0), cA + kstep, voffA); PG8_STAGE(PG8_SB(1, 1), cB + hstep + kstep, voffB);
        PG8_WAIT_V(6); PG8_BAR;
    } else {
        PG8_STAGE(PG8_SB(0, 0), cB, voffB); PG8_STAGE(PG8_SA(0, 0), cA, voffA); PG8_STAGE(PG8_SB(0, 1), cB + hstep, voffB); PG8_STAGE(PG8_SA(0, 1), cA + hstep, voffA);
        if (wr == 1) PG8_BAR;
        PG8_WAIT_V(4); PG8_BAR;
        PG8_STAGE(PG8_SB(1, 0), cB + kstep, voffB); PG8_STAGE(PG8_SA(1, 0), cA + kstep, voffA); PG8_STAGE(PG8_SB(1, 1), cB + hstep + kstep, voffB);
        PG8_WAIT_V(6); PG8_BAR;
    }
    for (;;) {
        const bool has_next = S.next(ui + 1, nxt);
        const char* nA = has_next ? (const char*)g.A + (size_t)nxt.pm * tstep : cA; const char* nB = has_next ? (const char*)g.Bt + (size_t)nxt.pn * tstep : cB;
        for (int t = 0; t < nt; t += 2) {
            const bool last = (t == nt - 2);
            const char* a1 = cA + (size_t)(t + 1) * kstep;
            const char* a2 = last ? nA : cA + (size_t)(t + 2) * kstep; const char* b2 = last ? nB : cB + (size_t)(t + 2) * kstep;
            const char* a3 = a2 + kstep; const char* b3 = b2 + kstep;
            if (last && has_next) S.a_ready(nxt);
            if constexpr (SP2) {
            PG8_LDB(B0, 0, 0); PG8_LDB(B1, 0, 1); PG8_SCHED; PG8_LDA(At, 0, 0); PG8_STAGE(PG8_SA(1, 1), a1 + hstep, voffA);
            PG8_WAIT_V(8); PG8_WAIT_L(0); PG8_BAR; PG8_MMA(0, 0, At, B0); PG8_MMA(0, 1, At, B1); PG8_BAR; PG8_SCHED;
            PG8_LDA(At, 0, 1); PG8_STAGE(PG8_SB(0, 0), b2, voffB); PG8_STAGE(PG8_SB(0, 1), b2 + hstep, voffB); PG8_STAGE(PG8_SA(0, 0), a2, voffA);
            PG8_WAIT_V(8); PG8_WAIT_L(0); PG8_BAR; PG8_MMA(1, 0, At, B0); PG8_MMA(1, 1, At, B1); PG8_BAR; PG8_SCHED;
            PG8_LDB(B0, 1, 0); PG8_LDB(B1, 1, 1); PG8_SCHED; PG8_LDA(At, 1, 0); PG8_STAGE(PG8_SA(0, 1), a2 + hstep, voffA);
            PG8_WAIT_V(8); PG8_WAIT_L(0); PG8_BAR; PG8_MMA(0, 0, At, B0); PG8_MMA(0, 1, At, B1); PG8_BAR; PG8_SCHED;
            PG8_LDA(At, 1, 1); PG8_STAGE(PG8_SB(1, 0), b3, voffB); PG8_STAGE(PG8_SB(1, 1), b3 + hstep, voffB); PG8_STAGE(PG8_SA(1, 0), a3, voffA);
            PG8_WAIT_V(8); PG8_WAIT_L(0); PG8_BAR; PG8_MMA(1, 0, At, B0); PG8_MMA(1, 1, At, B1); PG8_BAR; PG8_SCHED;
            } else {
            PG8_LDB(B0, 0, 0); PG8_SCHED; PG8_LDA(At, 0, 0); PG8_STAGE(PG8_SA(1, 1), a1 + hstep, voffA);
            PG8_WAIT_L(8); PG8_BAR; PG8_WAIT_L(0); PG8_MMA(0, 0, At, B0); PG8_BAR; PG8_SCHED;
            PG8_LDB(B1, 0, 1); PG8_STAGE(PG8_SB(0, 0), b2, voffB);
            PG8_BAR; PG8_WAIT_L(0); PG8_MMA(0, 1, At, B1); PG8_BAR;
            PG8_LDA(At, 0, 1); PG8_STAGE(PG8_SA(0, 0), a2, voffA);
            PG8_BAR; PG8_WAIT_L(0); PG8_MMA(1, 0, At, B0); PG8_BAR; PG8_SCHED;
            PG8_STAGE(PG8_SB(0, 1), b2 + hstep, voffB);
            PG8_WAIT_V(6); PG8_BAR; PG8_MMA(1, 1, At, B1); PG8_BAR;
            PG8_LDB(B0, 1, 0); PG8_SCHED; PG8_LDA(At, 1, 0); PG8_STAGE(PG8_SA(0, 1), a2 + hstep, voffA);
            PG8_WAIT_L(8); PG8_BAR; PG8_WAIT_L(0); PG8_MMA(0, 0, At, B0); PG8_BAR; PG8_SCHED;
            PG8_LDB(B1, 1, 1); PG8_STAGE(PG8_SB(1, 0), b3, voffB);
            PG8_BAR; PG8_WAIT_L(0); PG8_MMA(0, 1, At, B1); PG8_BAR;
            PG8_LDA(At, 1, 1); PG8_STAGE(PG8_SA(1, 0), a3, voffA);
            PG8_BAR; PG8_WAIT_L(0); PG8_MMA(1, 0, At, B0); PG8_BAR; PG8_SCHED;
            PG8_STAGE(PG8_SB(1, 1), b3 + hstep, voffB);
            PG8_WAIT_V(6); PG8_BAR; PG8_MMA(1, 1, At, B1); PG8_BAR;
            }
        }
        if constexpr (ALIGN_EPI) { if (wr == 0) PG8_BAR; }
        if constexpr (!Epi::AFTER_DRAIN) { E(acc, cur, wr, wc, fr, fq); S.done(cur); }
        if (!has_next) break;
#pragma unroll
        for (int a = 0; a < 2; ++a)
#pragma unroll
            for (int b = 0; b < 2; ++b)
#pragma unroll
                for (int m = 0; m < 4; ++m)
#pragma unroll
                    for (int n = 0; n < 2; ++n) acc[a][b][m][n] = (f32x4){0.f, 0.f, 0.f, 0.f};
        cur = nxt; cA = nA; cB = nB; ++ui;
        if constexpr (ALIGN_EPI) { if (wr == 1) PG8_BAR; }
    }
    PG8_WAIT_V(0);
    if constexpr (!ALIGN_EPI) { if (wr == 0) PG8_BAR; }
    PG8_BAR;
    if constexpr (Epi::AFTER_DRAIN) { E.fused(acc, cur, wr, wc, fr, fq, lds, wid, lane); S.done(cur); }
#undef PG8_SA
#undef PG8_SB
#undef PG8_STAGE
#undef PG8_LDA
#undef PG8_LDB
#undef PG8_MMA
#undef PG8_WAIT_V
#undef PG8_WAIT_L
#undef PG8_BAR
#undef PG8_SCHED
}
}
#define GAS __attribute__((address_space(1)))
#define LAS __attribute__((address_space(3)))
typedef unsigned v4u __attribute__((ext_vector_type(4)));
typedef float f32x4 __attribute__((ext_vector_type(4)));
#define LDS_WAIT() asm volatile("s_waitcnt lgkmcnt(0)" ::: "memory")
constexpr int NWAVES = 8;
constexpr int GEMM_LDS = 131072;

struct Ptrs {
    const float* in[20]; float* out; unsigned char* ws;
};
#define IN_X 0
#define IN_EV_NORM 1
#define IN_EV_WIN 2
#define IN_EV_IFB 3
#define IN_EV_QNG 4
#define IN_EV_KNG 5
#define IN_EV_REL 6
#define IN_EV_WOUT 7
#define IN_OD_NORM 8
#define IN_OD_WIN 9
#define IN_OD_CCW 10
#define IN_OD_CCB 11
#define IN_OD_GW 12
#define IN_OD_GB 13
#define IN_OD_LAM 14
#define IN_OD_CDW 15
#define IN_OD_ALOG 16
#define IN_OD_DTB 17
#define IN_OD_ONORM 18
#define IN_OD_WOUT 19

__device__ __forceinline__ float frsq_(float x) { return __builtin_amdgcn_rsqf(x); }
__device__ __forceinline__ float wave_sum(float v) {
#pragma unroll
    for (int o = 1; o < 64; o <<= 1) v += __shfl_xor(v, o);
    return v;
}
struct TrItem { const float* W; const float* gain; bf16_t* WT; int ldw, nblk, item; };
__device__ __forceinline__ void p0_tr_load(const TrItem& t, float (&r)[32], int lane) {
    const int kb = t.item / t.nblk, nb = t.item % t.nblk, k0 = 64 * kb, n0 = 32 * nb;
#pragma unroll
    for (int i = 0; i < 32; ++i) { const int kk = 2 * i + (lane >> 5); r[i] = t.W[(size_t)(k0 + kk) * t.ldw + n0 + (lane & 31)]; }
}
__device__ __forceinline__ void p0_tr_store(const TrItem& t, const float (&r)[32], LAS float* scr, int lane) {
    const int kb = t.item / t.nblk, nb = t.item % t.nblk, k0 = 64 * kb, n0 = 32 * nb; constexpr int K = D_MODEL;
#pragma unroll
    for (int i = 0; i < 32; ++i) { const int kk = 2 * i + (lane >> 5); const float g = t.gain ? t.gain[k0 + kk] : 1.0f; scr[kk * 33 + (lane & 31)] = g * r[i]; }
    LDS_WAIT(); asm volatile("" ::: "memory");
    const int c = lane & 7;
#pragma unroll
    for (int j = 0; j < 4; ++j) { const int n = (lane >> 3) + 8 * j; const LAS float* s = scr + (8 * c) * 33 + n;
        v4u o; o.x = pk2(s[0 * 33], s[1 * 33]); o.y = pk2(s[2 * 33], s[3 * 33]); o.z = pk2(s[4 * 33], s[5 * 33]); o.w = pk2(s[6 * 33], s[7 * 33]);
        *(GAS v4u*)(t.WT + (size_t)(n0 + n) * K + k0 + 8 * c) = o; }
    LDS_WAIT(); asm volatile("" ::: "memory");
}
__device__ __forceinline__ void p0_transposes(const Ptrs& P, LAS float* scr, int lane, int gw, int NGW, int it0, int it1) {
    unsigned char* ws = P.ws;
    bf16_t* W1T = (bf16_t*)(ws + WS_W1T); bf16_t* W2T = (bf16_t*)(ws + WS_W2T); bf16_t* W3T = (bf16_t*)(ws + WS_W3T); bf16_t* W4T = (bf16_t*)(ws + WS_W4T);
    constexpr int I1 = (D_MODEL / 64) * (EV_N / 32), I2 = (D_MODEL / 64) * (D_MODEL / 32), I3 = (D_MODEL / 64) * (OD_N / 32);
    auto mk = [&](int it) { TrItem t; int r = it;
        if (r < I1) { t = TrItem{P.in[IN_EV_WIN], P.in[IN_EV_NORM], W1T, EV_IN, EV_N / 32, r}; return t; } r -= I1;
        if (r < I2) { t = TrItem{P.in[IN_EV_WOUT], nullptr, W2T, D_MODEL, D_MODEL / 32, r}; return t; } r -= I2;
        if (r < I3) { t = TrItem{P.in[IN_OD_WIN], P.in[IN_OD_NORM], W3T, OD_IN, OD_N / 32, r}; return t; } r -= I3;
        t = TrItem{P.in[IN_OD_WOUT], nullptr, W4T, D_MODEL, D_MODEL / 32, r}; return t; };
    float ra[32], rb[32]; int it = it0 + gw;
    if (it < it1) { TrItem ta = mk(it); p0_tr_load(ta, ra, lane);
        for (;;) { const int itb = it + NGW; TrItem tb = ta; const bool hb = itb < it1; if (hb) { tb = mk(itb); p0_tr_load(tb, rb, lane); }
            p0_tr_store(ta, ra, scr, lane); if (!hb) break;
            const int itc = itb + NGW; const bool hc = itc < it1; if (hc) { ta = mk(itc); p0_tr_load(ta, ra, lane); }
            p0_tr_store(tb, rb, scr, lane); if (!hc) break; it = itc; } }
}
constexpr int TR_I1 = (D_MODEL / 64) * (EV_N / 32), TR_ALL = TR_I1 + 2 * (D_MODEL / 64) * (D_MODEL / 32) + (D_MODEL / 64) * (OD_N / 32);
__device__ __forceinline__ void late_weights(const Ptrs& P, LAS unsigned char* lds, int wave, int lane, int gw, int NGW) {
    p0_transposes(P, (LAS float*)(lds + wave * 16384), lane, gw, NGW, TR_I1, TR_ALL);
    bf16_t* W3T = (bf16_t*)(P.ws + WS_W3T); const int gt = gw * 64 + lane, NT = NGW * 64;
    for (int e = gt; e < 16 * D_MODEL; e += NT) { const int j = e / D_MODEL, k = e % D_MODEL; W3T[(size_t)(OD_N + j) * D_MODEL + k] = (bf16_t)f2bf(P.in[IN_OD_NORM][k] * P.in[IN_OD_WIN][(size_t)k * OD_IN + OD_N + j]); }
}
__device__ __forceinline__ void phase_prologue(const Ptrs& P, LAS unsigned char* lds, int wave, int lane, int gw, int NGW) {
    unsigned char* ws = P.ws;
    bf16_t* W1T = (bf16_t*)(ws + WS_W1T); bf16_t* W2T = (bf16_t*)(ws + WS_W2T); bf16_t* W3T = (bf16_t*)(ws + WS_W3T); bf16_t* W4T = (bf16_t*)(ws + WS_W4T);
    bf16_t* XB = (bf16_t*)(ws + WS_XB); float* R0 = (float*)(ws + WS_R0); float* SS1 = (float*)(ws + WS_SS1); float* GIF = (float*)(ws + WS_GIF);
    LAS float* scr = (LAS float*)(lds + wave * 16384);
    p0_transposes(P, scr, lane, gw, NGW, 0, TR_I1);
    { const int gt = gw * 64 + lane, NT = NGW * 64;
      for (int e = gt; e < M_TOK; e += NT) SS1[e] = 0.f; }
    __syncthreads();
    LAS float* G8 = (LAS float*)lds;
#pragma unroll 8
    for (int e = threadIdx.x; e < D_MODEL * 8; e += NWAVES * 64) { const int k = e >> 3, j = e & 7; G8[e] = P.in[IN_EV_NORM][k] * P.in[IN_EV_WIN][(size_t)k * EV_IN + EV_N + j]; }
    __syncthreads();
    const float* X = P.in[IN_X];
    f32x4 vnx[8];
    if (gw < M_TOK) { const GAS f32x4* xr0 = (const GAS f32x4*)(X + (size_t)gw * D_MODEL) + lane;
#pragma unroll
        for (int j = 0; j < 8; ++j) vnx[j] = xr0[64 * j]; }
    for (int m = gw; m < M_TOK; m += NGW) {
        float s = 0.f;
        GAS unsigned long long* o8 = (GAS unsigned long long*)(XB + (size_t)m * D_MODEL) + lane;
        f32x4 v[8];
#pragma unroll
        for (int j = 0; j < 8; ++j) v[j] = vnx[j];
        if (m + NGW < M_TOK) { const GAS f32x4* xr1 = (const GAS f32x4*)(X + (size_t)(m + NGW) * D_MODEL) + lane;
#pragma unroll
            for (int j = 0; j < 8; ++j) vnx[j] = xr1[64 * j]; }
#pragma unroll
        for (int j = 0; j < 8; ++j) { s += (v[j].x * v[j].x + v[j].y * v[j].y) + (v[j].z * v[j].z + v[j].w * v[j].w);
            o8[64 * j] = (unsigned long long)pk2(v[j].x, v[j].y) | ((unsigned long long)pk2(v[j].z, v[j].w) << 32); }
        const float r0 = frsq_(wave_sum(s) * (1.0f / D_MODEL) + EPS);
        float g[8];
#pragma unroll
        for (int i = 0; i < 8; ++i) g[i] = 0.f;
#pragma unroll
        for (int j = 0; j < 8; ++j) {
#pragma unroll
            for (int e = 0; e < 4; ++e) { const int k = 4 * lane + 256 * j + e; const f32x4 ga = *(const LAS f32x4*)(G8 + k * 8), gb = *(const LAS f32x4*)(G8 + k * 8 + 4); const float xv = v[j][e];
                g[0] += xv * ga.x; g[1] += xv * ga.y; g[2] += xv * ga.z; g[3] += xv * ga.w; g[4] += xv * gb.x; g[5] += xv * gb.y; g[6] += xv * gb.z; g[7] += xv * gb.w; }
            asm volatile("" : "+v"(g[0]), "+v"(g[1]), "+v"(g[2]), "+v"(g[3]), "+v"(g[4]), "+v"(g[5]), "+v"(g[6]), "+v"(g[7]) :: "memory");
        }
#pragma unroll
        for (int i = 0; i < 8; ++i) g[i] = wave_sum(g[i]);
        if (lane == 0) R0[m] = r0;
        if (lane < 8) { float gv = g[0];
#pragma unroll
            for (int i = 1; i < 8; ++i) gv = (lane == i) ? g[i] : gv;
            GIF[(size_t)m * 8 + lane] = r0 * gv + P.in[IN_EV_IFB][lane]; }
    }
}

#define XB_TMO      128
#define XB_XCNT(j)  (256  + 64 * (j))
#define XB_XSUB(j)  (1280 + 64 * (j))
#define XB_XGEN(j)  (2304 + 64 * (j))
#define XB_TOP      3328
#define XB_TOPGEN   3392
#define XCD_BAR_WORDS 3456
#define XB_SPIN_CAP (1u << 18)

__device__ __forceinline__ unsigned xb_ld(unsigned* p)              { return __hip_atomic_load(p, __ATOMIC_RELAXED, __HIP_MEMORY_SCOPE_AGENT); }
__device__ __forceinline__ unsigned xb_add(unsigned* p, unsigned v) { return __hip_atomic_fetch_add(p, v, __ATOMIC_RELAXED, __HIP_MEMORY_SCOPE_AGENT); }
__device__ __forceinline__ unsigned xb_xcc_id() { return (unsigned)__builtin_amdgcn_s_getreg((3 << 11) | 20) & 0xFu; }
#define XB_SPIN(cond, bar) do { unsigned _sp = 0; while (cond) { __builtin_amdgcn_s_sleep(1); \
    if ((++_sp & 255u) == 0u) { if (xb_ld(&(bar)[XB_TMO])) break; if (_sp > XB_SPIN_CAP) { atomicAdd(&(bar)[XB_TMO], 1u); break; } } } } while (0)

struct XcdBarrier {
    unsigned* bar; unsigned x;
    volatile LAS unsigned* st;
};

__device__ __forceinline__ XcdBarrier xcd_barrier_post(unsigned* bar, volatile LAS unsigned* st) {
    XcdBarrier b; b.bar = bar; b.x = xb_xcc_id(); b.st = st;
    if (threadIdx.x == 0) (void)xb_add(&bar[XB_XCNT(b.x)], 1u);
    return b;
}
__device__ __forceinline__ void xcd_barrier_complete(unsigned* bar, unsigned x, unsigned& nloc, unsigned& nx) {
    const unsigned G = gridDim.x * gridDim.y * gridDim.z;
    unsigned sum, cnt, mine, sp = 0u;
    for (;;) {
        sum = 0u; cnt = 0u; mine = 0u;
#pragma unroll
        for (unsigned j = 0; j < 16; ++j) { const unsigned c = xb_ld(&bar[XB_XCNT(j)]); sum += c; cnt += (c > 0u) ? 1u : 0u; mine = (j == x) ? c : mine; }
        if (sum == G) break;
        __builtin_amdgcn_s_sleep(1);
        if ((++sp & 255u) == 0u) { if (xb_ld(&bar[XB_TMO])) break; if (sp > XB_SPIN_CAP) { atomicAdd(&bar[XB_TMO], 1u); break; } }
    }
    nloc = mine > 0u ? mine : 1u; nx = cnt > 0u ? cnt : 1u;
}

__device__ __forceinline__ void xcd_barrier(const XcdBarrier& b) {
    asm volatile("s_waitcnt vmcnt(0)" ::: "memory");
    __syncthreads();
    if (threadIdx.x == 0) {
        unsigned* bar = b.bar;
        __builtin_amdgcn_s_waitcnt(0);
        unsigned nloc = b.st[0], nx = b.st[1];
        if (nloc == 0u) { xcd_barrier_complete(bar, b.x, nloc, nx); b.st[0] = nloc; b.st[1] = nx; }
        const unsigned old = xb_add(&bar[XB_XSUB(b.x)], 1u);
        const unsigned gen = old / nloc;
        if (old + 1u == (gen + 1u) * nloc) {
            __builtin_amdgcn_fence(__ATOMIC_RELEASE, "agent");
            asm volatile("s_waitcnt vmcnt(0)" ::: "memory");
            const unsigned og = xb_add(&bar[XB_TOP], 1u);
            const unsigned tg = og / nx;
            if (og + 1u == (tg + 1u) * nx) xb_add(&bar[XB_TOPGEN], 1u);
            else XB_SPIN(xb_ld(&bar[XB_TOPGEN]) == tg, bar);
            __builtin_amdgcn_fence(__ATOMIC_ACQUIRE, "agent");
            xb_add(&bar[XB_XGEN(b.x)], 1u);
            asm volatile("s_waitcnt vmcnt(0)" ::: "memory");
        } else {
            XB_SPIN(xb_ld(&bar[XB_XGEN(b.x)]) == gen, bar);
            __builtin_amdgcn_fence(__ATOMIC_ACQUIRE, "agent");
            asm volatile("s_waitcnt vmcnt(0)" ::: "memory");
        }
    }
    __syncthreads();
}
__device__ __forceinline__ void ld8bf(const bf16_t* p, float (&v)[8]) {
    const v4u w = *(const v4u*)p;
    v[0] = __builtin_bit_cast(float, w.x << 16); v[1] = __builtin_bit_cast(float, w.x & 0xffff0000u);
    v[2] = __builtin_bit_cast(float, w.y << 16); v[3] = __builtin_bit_cast(float, w.y & 0xffff0000u);
    v[4] = __builtin_bit_cast(float, w.z << 16); v[5] = __builtin_bit_cast(float, w.z & 0xffff0000u);
    v[6] = __builtin_bit_cast(float, w.w << 16); v[7] = __builtin_bit_cast(float, w.w & 0xffff0000u);
}
__global__ void __launch_bounds__(256) k_attn_naive(const bf16_t* __restrict__ PROJ, const float* __restrict__ qn_g, const float* __restrict__ kn_g, const float* __restrict__ rel_bias, bf16_t* __restrict__ Y) {
    __shared__ float qs[16][128];
    __shared__ float S[16][577];
    const int bid = blockIdx.x, quarter = bid & 3, c = (bid >> 2) & 31, h = (bid >> 7) & 7, b = bid >> 10, t = threadIdx.x;
    { const int r = t >> 4, sub = t & 15; const int tok = b * SEQ + c * 64 + quarter * 16 + r;
      float v[8]; ld8bf(PROJ + (size_t)tok * EV_N + EC_QA + h * 128 + sub * 8, v);
      float ss = 0.f;
#pragma unroll
      for (int i = 0; i < 8; ++i) ss += v[i] * v[i];
      ss += __shfl_xor(ss, 1); ss += __shfl_xor(ss, 2); ss += __shfl_xor(ss, 4); ss += __shfl_xor(ss, 8);
      const float rs = 1.0f / sqrtf(ss * (1.0f / 128.0f) + EPS);
#pragma unroll
      for (int i = 0; i < 8; ++i) qs[r][sub * 8 + i] = v[i] * rs * qn_g[sub * 8 + i] * 0.08838834764831845f; }
    __syncthreads();
    for (int idx = t; idx < 16 * BAND; idx += 256) {
        const int r = idx / BAND, j = idx % BAND; const int kc = c - LOOKBACK + (j >> 6);
        float s;
        if (kc < 0) s = -1e30f;
        else { const bf16_t* kp = PROJ + (size_t)(b * SEQ + kc * 64 + (j & 63)) * EV_N + EC_KA + h * 128;
            float ss = 0.f, dot = 0.f;
            for (int d = 0; d < 128; d += 8) { float kv[8]; ld8bf(kp + d, kv);
#pragma unroll
                for (int i = 0; i < 8; ++i) { ss += kv[i] * kv[i]; dot += kv[i] * kn_g[d + i] * qs[r][d + i]; } }
            s = dot * (1.0f / sqrtf(ss * (1.0f / 128.0f) + EPS));
            const int qi = quarter * 16 + r; int rel = LOOKBACK * CHUNK + qi - j; rel = rel < -REL_MAX ? -REL_MAX : (rel > REL_MAX ? REL_MAX : rel); rel += REL_MAX;
            s += rel_bias[h * NREL + rel]; }
        S[r][j] = s;
    }
    __syncthreads();
    { const int r = t >> 4, sub = t & 15; float mx = -3.0e38f;
      for (int j = sub; j < BAND; j += 16) mx = fmaxf(mx, S[r][j]);
      mx = fmaxf(mx, __shfl_xor(mx, 1)); mx = fmaxf(mx, __shfl_xor(mx, 2)); mx = fmaxf(mx, __shfl_xor(mx, 4)); mx = fmaxf(mx, __shfl_xor(mx, 8));
      float sum = 0.f;
      for (int j = sub; j < BAND; j += 16) { const float e = expf(S[r][j] - mx); S[r][j] = e; sum += e; }
      sum += __shfl_xor(sum, 1); sum += __shfl_xor(sum, 2); sum += __shfl_xor(sum, 4); sum += __shfl_xor(sum, 8);
      const float inv = 1.0f / sum;
      for (int j = sub; j < BAND; j += 16) S[r][j] *= inv; }
    __syncthreads();
    { const int r = t >> 4, dg = t & 15; float acc[8];
#pragma unroll
      for (int i = 0; i < 8; ++i) acc[i] = 0.f;
      for (int j = 0; j < BAND; ++j) { const int kc = c - LOOKBACK + (j >> 6); if (kc < 0) continue;
          const float p = S[r][j]; float vv[8]; ld8bf(PROJ + (size_t)(b * SEQ + kc * 64 + (j & 63)) * EV_N + EC_VA + h * 128 + dg * 8, vv);
#pragma unroll
          for (int i = 0; i < 8; ++i) acc[i] += p * vv[i]; }
      const int tok = b * SEQ + c * 64 + quarter * 16 + r; float z[8]; ld8bf(PROJ + (size_t)tok * EV_N + EC_ZA + h * 128 + dg * 8, z);
      v4u o; o.x = pk2(acc[0] * siluf_(z[0]), acc[1] * siluf_(z[1])); o.y = pk2(acc[2] * siluf_(z[2]), acc[3] * siluf_(z[3]));
      o.z = pk2(acc[4] * siluf_(z[4]), acc[5] * siluf_(z[5])); o.w = pk2(acc[6] * siluf_(z[6]), acc[7] * siluf_(z[7]));
      *(v4u*)(Y + (size_t)tok * D_MODEL + h * 128 + dg * 8) = o; }
}
__global__ void __launch_bounds__(256) k_mlstm_naive(const bf16_t* __restrict__ PROJ, const float* __restrict__ GIF, bf16_t* __restrict__ Y) {
    __shared__ float ks[256], qs[256], part[4][64], dpart[4];
    const int bid = blockIdx.x, vs = bid & 3, h = (bid >> 2) & 3, b = bid >> 4, t = threadIdx.x, v = t & 63, kq = t >> 6;
    float C[64];
#pragma unroll
    for (int i = 0; i < 64; ++i) C[i] = 0.f;
    float nreg = 0.f;
    for (int s = 0; s < SEQ; ++s) {
        const size_t tok = (size_t)b * SEQ + s; const bf16_t* pr = PROJ + tok * EV_N;
        const float li = GIF[tok * 8 + h], fpre = GIF[tok * 8 + 4 + h];
        const float fw = sigmoidf_(fpre), iw = expf(li);
        const float kk = bf2f(pr[EC_KB + h * 256 + t]), qq = bf2f(pr[EC_QB + h * 256 + t]) * 0.0625f;
        const float vv = bf2f(pr[EC_VB + h * 256 + vs * 64 + v]);
        ks[t] = kk; qs[t] = qq;
        nreg = fw * nreg + iw * kk;
        float dp = nreg * qq; dp = wave_sum(dp);
        if ((t & 63) == 0) dpart[kq] = dp;
        __syncthreads();
        float np = 0.f; const float iv = iw * vv;
#pragma unroll
        for (int i = 0; i < 64; ++i) { C[i] = fw * C[i] + ks[kq * 64 + i] * iv; np += C[i] * qs[kq * 64 + i]; }
        part[kq][v] = np;
        __syncthreads();
        if (t < 64) { const float num = (part[0][t] + part[1][t]) + (part[2][t] + part[3][t]); const float den = (dpart[0] + dpart[1]) + (dpart[2] + dpart[3]);
            const float hh = num / fmaxf(fabsf(den), 1.0f);
            const float ob = bf2f(pr[EC_OB + h * 256 + vs * 64 + t]), zb = bf2f(pr[EC_ZB + h * 256 + vs * 64 + t]);
            Y[tok * D_MODEL + W_A + h * 256 + vs * 64 + t] = (bf16_t)f2bf(sigmoidf_(ob) * hh * siluf_(zb)); }
        __syncthreads();
    }
}
__global__ void __launch_bounds__(128) k_rglru_gates(const bf16_t* __restrict__ PROJ, const float* __restrict__ ccw, const float* __restrict__ ccb, const float* __restrict__ gw, const float* __restrict__ gb,
                                                     const float* __restrict__ lam, float* __restrict__ A, float* __restrict__ INP) {
    __shared__ float xs[8][128];
    const int blk = blockIdx.x & 7, tg = blockIdx.x >> 3, t = threadIdx.x, c = blk * 128 + t;
    float xc[8];
#pragma unroll
    for (int i = 0; i < 8; ++i) { const int tok = tg * 8 + i, s = tok % SEQ; float a = ccb[c];
#pragma unroll
        for (int j = 0; j < 4; ++j) { const int sj = s - 3 + j; if (sj >= 0) a += ccw[j * W_C + c] * bf2f(PROJ[(size_t)(tok - 3 + j) * OD_N + OC_XC + c]); }
        xc[i] = a; xs[i][t] = a; }
    __syncthreads();
    float rp[8], ip[8];
#pragma unroll
    for (int i = 0; i < 8; ++i) { rp[i] = 0.f; ip[i] = 0.f; }
    const float* g0 = gw + (size_t)blk * 128 * 256;
    for (int k = 0; k < 128; ++k) { const float wr_ = g0[k * 256 + t], wi_ = g0[k * 256 + 128 + t];
#pragma unroll
        for (int i = 0; i < 8; ++i) { const float xv = xs[i][k]; rp[i] += xv * wr_; ip[i] += xv * wi_; } }
    const float sp = softplusf_(-lam[c]); const float gbr = gb[c], gbi = gb[W_C + c];
#pragma unroll
    for (int i = 0; i < 8; ++i) { const int tok = tg * 8 + i; const float r = sigmoidf_(rp[i] + gbr), ig = sigmoidf_(ip[i] + gbi);
        const float la = -8.0f * r * sp; A[(size_t)tok * W_C + c] = expf(la); INP[(size_t)tok * W_C + c] = sqrtf(-expm1f(2.0f * la)) * (ig * xc[i]); }
}
__global__ void __launch_bounds__(256) k_rglru_scan(const bf16_t* __restrict__ PROJ, const float* __restrict__ A, const float* __restrict__ INP, bf16_t* __restrict__ Y) {
    const int gid = blockIdx.x * 256 + threadIdx.x, b = gid / W_C, c = gid % W_C; float h = 0.f;
    for (int s = 0; s < SEQ; ++s) { const size_t tok = (size_t)b * SEQ + s; h = A[tok * W_C + c] * h + INP[tok * W_C + c];
        Y[tok * D_MODEL + c] = (bf16_t)f2bf(h * siluf_(bf2f(PROJ[tok * OD_N + OC_ZC + c]))); }
}
__global__ void __launch_bounds__(256) k_gates_ab(const bf16_t* __restrict__ XB, const bf16_t* __restrict__ W3T, const float* __restrict__ SS1, float* __restrict__ AB) {
    const int t = threadIdx.x, row = blockIdx.x * 16 + (t >> 4), j = t & 15;
    const bf16_t* xp = XB + (size_t)row * D_MODEL; const bf16_t* wp = W3T + (size_t)(OD_N + j) * D_MODEL; float acc = 0.f;
    for (int k = 0; k < D_MODEL; k += 8) { float a[8], w[8]; ld8bf(xp + k, a); ld8bf(wp + k, w);
#pragma unroll
        for (int i = 0; i < 8; ++i) acc += a[i] * w[i]; }
    AB[(size_t)row * 16 + j] = acc * (1.0f / sqrtf(SS1[row] * (1.0f / D_MODEL) + EPS));
}
__global__ void __launch_bounds__(128) k_dn_prep(const bf16_t* __restrict__ PROJ, const float* __restrict__ cdw, float* __restrict__ Q2, float* __restrict__ K2, float* __restrict__ V2) {
    __shared__ float red[2][2];
    const int h = blockIdx.x & 7, tok = blockIdx.x >> 3, s = tok % SEQ, t = threadIdx.x; float o[3];
#pragma unroll
    for (int p = 0; p < 3; ++p) { const int col = p * W_D + h * 128 + t; float a = 0.f;
#pragma unroll
        for (int j = 0; j < 4; ++j) { const int sj = s - 3 + j; if (sj >= 0) a += cdw[j * 3 * W_D + col] * bf2f(PROJ[(size_t)(tok - 3 + j) * OD_N + OC_QD + col]); }
        o[p] = siluf_(a); }
    float sq = wave_sum(o[0] * o[0]), sk = wave_sum(o[1] * o[1]);
    if ((t & 63) == 0) { red[t >> 6][0] = sq; red[t >> 6][1] = sk; }
    __syncthreads();
    sq = red[0][0] + red[1][0]; sk = red[0][1] + red[1][1];
    const size_t o_ = (size_t)tok * W_D + h * 128 + t;
    Q2[o_] = o[0] * (1.0f / sqrtf(sq + EPS)); K2[o_] = o[1] * (1.0f / sqrtf(sk + EPS)); V2[o_] = o[2];
}
__global__ void __launch_bounds__(256) k_dn_scan(const bf16_t* __restrict__ PROJ, const float* __restrict__ Q2, const float* __restrict__ K2, const float* __restrict__ V2, const float* __restrict__ AB,
                                                 const float* __restrict__ a_log, const float* __restrict__ dt_bias, const float* __restrict__ onorm, bf16_t* __restrict__ Y) {
    __shared__ float ks[128], qs[128], part[2][128], red[2];
    const int h = blockIdx.x & 7, b = blockIdx.x >> 3, t = threadIdx.x, v = t & 127, kh = t >> 7;
    float S[64];
#pragma unroll
    for (int i = 0; i < 64; ++i) S[i] = 0.f;
    const float Aexp = expf(a_log[h]), dtb = dt_bias[h], og = onorm[v];
    for (int s = 0; s < SEQ; ++s) {
        const size_t tok = (size_t)b * SEQ + s; const size_t o_ = tok * W_D + h * 128;
        if (t < 128) ks[t] = K2[o_ + t]; else qs[t - 128] = Q2[o_ + t - 128] * 0.08838834764831845f;
        const float vv = V2[o_ + v];
        const float beta = sigmoidf_(AB[tok * 16 + 8 + h]); const float g = -Aexp * softplusf_(AB[tok * 16 + h] + dtb); const float al = expf(g);
        __syncthreads();
        float rp = 0.f;
#pragma unroll
        for (int i = 0; i < 64; ++i) rp += S[i] * ks[kh * 64 + i];
        part[kh][v] = rp;
        __syncthreads();
        const float r = part[0][v] + part[1][v];
        const float u = beta * (vv - al * r);
        float op = 0.f;
#pragma unroll
        for (int i = 0; i < 64; ++i) { S[i] = al * S[i] + ks[kh * 64 + i] * u; op += S[i] * qs[kh * 64 + i]; }
        __syncthreads();
        part[kh][v] = op;
        __syncthreads();
        const float o = part[0][v] + part[1][v];
        float sq = (t < 128) ? o * o : 0.f; sq = wave_sum(sq);
        if (t == 0) red[0] = sq; if (t == 64) red[1] = sq;
        __syncthreads();
        if (t < 128) { const float ms = (red[0] + red[1]) * (1.0f / 128.0f);
            const float zd = bf2f(PROJ[tok * OD_N + OC_ZD + h * 128 + t]);
            Y[tok * D_MODEL + W_C + h * 128 + t] = (bf16_t)f2bf(o * (1.0f / sqrtf(ms + EPS)) * og * siluf_(zd)); }
    }
}

__global__ void __launch_bounds__(512) k_prologue(Ptrs P) {
    extern __shared__ __attribute__((aligned(16))) unsigned char lds[];
    const int tid = threadIdx.x, lane = tid & 63, wave = __builtin_amdgcn_readfirstlane(tid >> 6);
    phase_prologue(P, (LAS unsigned char*)lds, wave, lane, blockIdx.x * NWAVES + wave, gridDim.x * NWAVES);
}
template <int WHICH> __device__ __forceinline__ void phase_gemm(const Ptrs& P, LAS unsigned char* lds, int G, int c) {
    unsigned char* ws = P.ws;
    bf16_t* W1T = (bf16_t*)(ws + WS_W1T); bf16_t* W2T = (bf16_t*)(ws + WS_W2T); bf16_t* W3T = (bf16_t*)(ws + WS_W3T); bf16_t* W4T = (bf16_t*)(ws + WS_W4T);
    bf16_t* XB = (bf16_t*)(ws + WS_XB); bf16_t* YB = (bf16_t*)(ws + WS_Y); bf16_t* PROJ = (bf16_t*)(ws + WS_PROJ);
    float* R0 = (float*)(ws + WS_R0); float* SS1 = (float*)(ws + WS_SS1);
    if constexpr (WHICH == 1) { pg8::Gemm g{XB, W1T, M_TOK, EV_N, D_MODEL}; pg8::EpiProj E{PROJ, EV_N, R0, 0}; pg8::StaticOrder S; S.init(g.M, g.N, G, c);
        pg8::gemm_phase<pg8::EpiProj, pg8::StaticOrder, true, true>(lds, g, S, E); }
    if constexpr (WHICH == 2) { pg8::Gemm g{YB, W2T, M_TOK, D_MODEL, D_MODEL}; pg8::EpiRes E{P.in[IN_X], P.out, XB, SS1, D_MODEL}; pg8::StaticOrder S; S.init(g.M, g.N, G, c);
        pg8::gemm_phase<pg8::EpiRes, pg8::StaticOrder, true, true>(lds, g, S, E); }
    if constexpr (WHICH == 3) { pg8::Gemm g{XB, W3T, M_TOK, OD_N, D_MODEL}; pg8::EpiProj E{PROJ, OD_N, SS1, 1}; pg8::StaticOrder S; S.init(g.M, g.N, G, c);
        pg8::gemm_phase<pg8::EpiProj, pg8::StaticOrder, true, true>(lds, g, S, E); }
    if constexpr (WHICH == 4) { pg8::Gemm g{YB, W4T, M_TOK, D_MODEL, D_MODEL}; pg8::EpiRes E{P.out, P.out, nullptr, nullptr, D_MODEL}; pg8::StaticOrder S; S.init(g.M, g.N, G, c);
        pg8::gemm_phase<pg8::EpiRes, pg8::StaticOrder, true, true>(lds, g, S, E); }
}
template <int WHICH> __global__ void __launch_bounds__(512, 2) k_gemm(Ptrs P) {
    extern __shared__ __attribute__((aligned(16))) unsigned char lds[];
    phase_gemm<WHICH>(P, (LAS unsigned char*)lds, gridDim.x, blockIdx.x);
}

__device__ __forceinline__ void phase_gates_ab(const Ptrs& P, int G) {
    unsigned char* ws = P.ws; const bf16_t* XB = (const bf16_t*)(ws + WS_XB); const bf16_t* W3T = (const bf16_t*)(ws + WS_W3T); const float* SS1 = (const float*)(ws + WS_SS1); float* AB = (float*)(ws + WS_AB);
    const int t = threadIdx.x, j = t & 15;
    for (int it = blockIdx.x; it < M_TOK / 32; it += G) { const int row = it * 32 + (t >> 4);
        const bf16_t* xp = XB + (size_t)row * D_MODEL; const bf16_t* wp = W3T + (size_t)(OD_N + j) * D_MODEL; float acc = 0.f;
        for (int k = 0; k < D_MODEL; k += 8) { float a[8], w[8]; ld8bf(xp + k, a); ld8bf(wp + k, w);
#pragma unroll
            for (int i = 0; i < 8; ++i) acc += a[i] * w[i]; }
        AB[(size_t)row * 16 + j] = acc * (1.0f / sqrtf(SS1[row] * (1.0f / D_MODEL) + EPS)); }
}
#ifdef SKELETON
__device__ __forceinline__ void phase_mix0(const Ptrs& P, LAS unsigned char* lds, int G) {
    v4u* Y = (v4u*)(P.ws + WS_Y); const v4u z = {0u, 0u, 0u, 0u};
    for (size_t i = (size_t)blockIdx.x * 512 + threadIdx.x; i < (size_t)M_TOK * D_MODEL / 8; i += (size_t)G * 512) Y[i] = z;
}
__device__ __forceinline__ void phase_mix1a(const Ptrs& P, LAS unsigned char* lds, int G) { phase_mix0(P, lds, G); }
__device__ __forceinline__ void phase_mix1b(const Ptrs& P, LAS unsigned char* lds, int G) { }
#endif
typedef short bf16x8 __attribute__((ext_vector_type(8)));
typedef short bf16x4 __attribute__((ext_vector_type(4)));
typedef short v4i16_t __attribute__((ext_vector_type(4)));
#define MFMA16(a, b, c) __builtin_amdgcn_mfma_f32_16x16x32_bf16((a), (b), (c), 0, 0, 0)
__device__ __forceinline__ v4i16_t lds_tr(LAS const unsigned char* p) { return __builtin_amdgcn_ds_read_tr16_b64_v4i16((LAS v4i16_t*)p); }
__device__ __forceinline__ bf16x8 frag_row(LAS const unsigned char* base, int RS, int r0, int k0, int lane) { return *(LAS const bf16x8*)(base + (r0 + (lane & 15)) * RS + (k0 + 8 * (lane >> 4)) * 2); }
__device__ __forceinline__ bf16x8 frag_row_perm(LAS const unsigned char* base, int RS, int r0, int k0, int lane) {
    LAS const unsigned char* p = base + (r0 + (lane & 15)) * RS + (k0 + 4 * (lane >> 4)) * 2;
    const bf16x4 a = *(LAS const bf16x4*)p, b = *(LAS const bf16x4*)(p + 32); return (bf16x8){a[0], a[1], a[2], a[3], b[0], b[1], b[2], b[3]}; }
__device__ __forceinline__ bf16x8 frag_tr(LAS const unsigned char* base, int RS, int k0, int c0, int lane) {
    const int g = lane >> 4, q = (lane & 15) >> 2, p = lane & 3; LAS const unsigned char* a = base + (k0 + 8 * g + q) * RS + (c0 + 4 * p) * 2;
    const v4i16_t lo = lds_tr(a), hi = lds_tr(a + 4 * RS); return (bf16x8){lo[0], lo[1], lo[2], lo[3], hi[0], hi[1], hi[2], hi[3]}; }
__device__ __forceinline__ bf16x8 frag_tr_perm(LAS const unsigned char* base, int RS, int k0, int c0, int lane) {
    const int g = lane >> 4, q = (lane & 15) >> 2, p = lane & 3; LAS const unsigned char* a = base + (k0 + 4 * g + q) * RS + (c0 + 4 * p) * 2;
    const v4i16_t lo = lds_tr(a), hi = lds_tr(a + 16 * RS); return (bf16x8){lo[0], lo[1], lo[2], lo[3], hi[0], hi[1], hi[2], hi[3]}; }
__device__ __forceinline__ bf16x8 acc_pair_frag(const f32x4& lo, const f32x4& hi) {
    const unsigned a = pk2(lo[0], lo[1]), b = pk2(lo[2], lo[3]), c = pk2(hi[0], hi[1]), d = pk2(hi[2], hi[3]);
    typedef unsigned u32x4_ __attribute__((ext_vector_type(4))); const u32x4_ w = {a, b, c, d}; return __builtin_bit_cast(bf16x8, w); }
__device__ __forceinline__ float fexp2(float x) { return __builtin_amdgcn_exp2f(x); }
constexpr float LOG2E = 1.4426950408889634f;
__device__ __forceinline__ float fexp(float x) { return __builtin_amdgcn_exp2f(x * LOG2E); }
__device__ __forceinline__ float frcp(float x) { return __builtin_amdgcn_rcpf(x); }
__device__ __forceinline__ float frsq(float x) { return __builtin_amdgcn_rsqf(x); }
__device__ __forceinline__ float fsqrt(float x) { return __builtin_amdgcn_sqrtf(x); }
__device__ __forceinline__ float fsigmoid(float x) { return __builtin_amdgcn_rcpf(1.0f + __builtin_amdgcn_exp2f(-x * LOG2E)); }
__device__ __forceinline__ float fsilu(float x) { return x * fsigmoid(x); }
constexpr int AT_RSK = 272, AT_RSV = 288, AT_KB = 64 * AT_RSK, AT_VB = 64 * AT_RSV;
constexpr int AT_OFF_K = 0, AT_OFF_V = 2 * AT_KB, AT_OFF_TBL = AT_OFF_V + 2 * AT_VB, AT_LDS = AT_OFF_TBL + 2064;
static_assert(AT_LDS <= 163328, "attention LDS");
__device__ __forceinline__ void attn_item(const Ptrs& P, LAS unsigned char* lds, int item) {
    const bf16_t* __restrict__ PROJ = (const bf16_t*)(P.ws + WS_PROJ); bf16_t* __restrict__ Y = (bf16_t*)(P.ws + WS_Y);
    const float* __restrict__ qn_g = P.in[IN_EV_QNG]; const float* __restrict__ kn_g = P.in[IN_EV_KNG];
    const int tid = threadIdx.x, lane = tid & 63, wave = tid >> 6, g = lane >> 4, l15 = lane & 15;
    const int cp = item & 15, h = (item >> 4) & 7, b = item >> 7;
    const int c = 2 * cp + (wave >> 2), qt = wave & 3;
    LAS float* tbl = (LAS float*)(lds + AT_OFF_TBL);
    for (int i = tid; i < NREL; i += 512) tbl[i] = P.in[IN_EV_REL][h * NREL + i] * LOG2E;
    bf16x8 qf[4];
    { const bf16_t* qp = PROJ + (size_t)(b * SEQ + c * 64 + qt * 16 + l15) * EV_N + EC_QA + h * 128 + 8 * g;
      float qv[4][8]; float ss = 0.f;
#pragma unroll
      for (int ks = 0; ks < 4; ++ks) { ld8bf(qp + 32 * ks, qv[ks]);
#pragma unroll
          for (int i = 0; i < 8; ++i) ss += qv[ks][i] * qv[ks][i]; }
      ss += __shfl_xor(ss, 16); ss += __shfl_xor(ss, 32);
      const float rs = frsq(ss * (1.0f / 128.0f) + EPS) * (0.08838834764831845f * LOG2E);
#pragma unroll
      for (int ks = 0; ks < 4; ++ks) { const float* gp = qn_g + 32 * ks + 8 * g; typedef unsigned u32x4_ __attribute__((ext_vector_type(4)));
          const u32x4_ w = {pk2(qv[ks][0] * rs * gp[0], qv[ks][1] * rs * gp[1]), pk2(qv[ks][2] * rs * gp[2], qv[ks][3] * rs * gp[3]),
                            pk2(qv[ks][4] * rs * gp[4], qv[ks][5] * rs * gp[5]), pk2(qv[ks][6] * rs * gp[6], qv[ks][7] * rs * gp[7])};
          qf[ks] = __builtin_bit_cast(bf16x8, w); } }
    f32x4 o[8];
#pragma unroll
    for (int i = 0; i < 8; ++i) o[i] = (f32x4){0.f, 0.f, 0.f, 0.f};
    float mrun = -1.0e30f, lrun = 0.f;
    const int kt_lo = (2 * cp - LOOKBACK) < 0 ? 0 : (2 * cp - LOOKBACK), kt_hi = 2 * cp + 1;
    v4u kreg[2], vreg[2];
    const int srow0 = tid >> 4, sch = tid & 15;
    float kg[8];
#pragma unroll
    for (int i = 0; i < 8; ++i) kg[i] = kn_g[sch * 8 + i];
#define AT_LOAD(kt) do { _Pragma("unroll") for (int i_ = 0; i_ < 2; ++i_) { const bf16_t* rp_ = PROJ + (size_t)(b * SEQ + (kt) * 64 + srow0 + 32 * i_) * EV_N + h * 128 + sch * 8; \
        kreg[i_] = *(const v4u*)(rp_ + EC_KA); vreg[i_] = *(const v4u*)(rp_ + EC_VA); } } while (0)
#define AT_STORE(buf) do { _Pragma("unroll") for (int i_ = 0; i_ < 2; ++i_) { const int row_ = srow0 + 32 * i_; \
        float kv_[8]; kv_[0] = __builtin_bit_cast(float, kreg[i_].x << 16); kv_[1] = __builtin_bit_cast(float, kreg[i_].x & 0xffff0000u); kv_[2] = __builtin_bit_cast(float, kreg[i_].y << 16); kv_[3] = __builtin_bit_cast(float, kreg[i_].y & 0xffff0000u); \
        kv_[4] = __builtin_bit_cast(float, kreg[i_].z << 16); kv_[5] = __builtin_bit_cast(float, kreg[i_].z & 0xffff0000u); kv_[6] = __builtin_bit_cast(float, kreg[i_].w << 16); kv_[7] = __builtin_bit_cast(float, kreg[i_].w & 0xffff0000u); \
        float ss_ = 0.f; _Pragma("unroll") for (int e_ = 0; e_ < 8; ++e_) ss_ += kv_[e_] * kv_[e_]; \
        ss_ += __shfl_xor(ss_, 1); ss_ += __shfl_xor(ss_, 2); ss_ += __shfl_xor(ss_, 4); ss_ += __shfl_xor(ss_, 8); \
        const float rs_ = frsq(ss_ * (1.0f / 128.0f) + EPS); \
        v4u w_; w_.x = pk2(kv_[0] * rs_ * kg[0], kv_[1] * rs_ * kg[1]); w_.y = pk2(kv_[2] * rs_ * kg[2], kv_[3] * rs_ * kg[3]); w_.z = pk2(kv_[4] * rs_ * kg[4], kv_[5] * rs_ * kg[5]); w_.w = pk2(kv_[6] * rs_ * kg[6], kv_[7] * rs_ * kg[7]); \
        *(LAS v4u*)(lds + AT_OFF_K + (buf) * AT_KB + row_ * AT_RSK + sch * 16) = w_; \
        *(LAS v4u*)(lds + AT_OFF_V + (buf) * AT_VB + row_ * AT_RSV + sch * 16) = vreg[i_]; } } while (0)
    AT_LOAD(kt_lo); AT_STORE(0);
    __syncthreads();
    const int qi = qt * 16 + l15;
    for (int kt = kt_lo, it = 0; kt <= kt_hi; ++kt, ++it) {
        const int buf = it & 1;
        if (kt < kt_hi) AT_LOAD(kt + 1);
        const int to = kt - (c - LOOKBACK);
        if (to >= 0 && to <= LOOKBACK) {
            LAS const unsigned char* Kb = lds + AT_OFF_K + buf * AT_KB; LAS const unsigned char* Vb = lds + AT_OFF_V + buf * AT_VB;
            f32x4 s[4];
#pragma unroll
            for (int nt = 0; nt < 4; ++nt) { s[nt] = (f32x4){0.f, 0.f, 0.f, 0.f};
#pragma unroll
                for (int ks = 0; ks < 4; ++ks) s[nt] = MFMA16(frag_row(Kb, AT_RSK, 16 * nt, 32 * ks, lane), qf[ks], s[nt]); }
            { const int relb = LOOKBACK * CHUNK - 64 * to + qi - 4 * g;
#pragma unroll
              for (int nt = 0; nt < 4; ++nt)
#pragma unroll
                  for (int r = 0; r < 4; ++r) { int rel = relb - 16 * nt - r; rel = rel > REL_MAX ? REL_MAX : rel; s[nt][r] += tbl[rel + REL_MAX]; } }
            float tmax = fmaxf(fmaxf(s[0][0], s[0][1]), fmaxf(s[0][2], s[0][3]));
#pragma unroll
            for (int nt = 1; nt < 4; ++nt) tmax = fmaxf(tmax, fmaxf(fmaxf(s[nt][0], s[nt][1]), fmaxf(s[nt][2], s[nt][3])));
            tmax = fmaxf(tmax, __shfl_xor(tmax, 16)); tmax = fmaxf(tmax, __shfl_xor(tmax, 32));
            const float mnew = fmaxf(mrun, tmax), alpha = fexp2(mrun - mnew);
            float rsum = 0.f;
#pragma unroll
            for (int nt = 0; nt < 4; ++nt)
#pragma unroll
                for (int r = 0; r < 4; ++r) { s[nt][r] = fexp2(s[nt][r] - mnew); rsum += s[nt][r]; }
            rsum += __shfl_xor(rsum, 16); rsum += __shfl_xor(rsum, 32);
            lrun = lrun * alpha + rsum; mrun = mnew;
            const bf16x8 pf0 = acc_pair_frag(s[0], s[1]), pf1 = acc_pair_frag(s[2], s[3]);
            float al[4];
#pragma unroll
            for (int r = 0; r < 4; ++r) al[r] = __shfl(alpha, 4 * g + r);
#pragma unroll
            for (int dt = 0; dt < 8; ++dt) { o[dt][0] *= al[0]; o[dt][1] *= al[1]; o[dt][2] *= al[2]; o[dt][3] *= al[3];
                o[dt] = MFMA16(pf0, frag_tr_perm(Vb, AT_RSV, 0, 16 * dt, lane), o[dt]);
                o[dt] = MFMA16(pf1, frag_tr_perm(Vb, AT_RSV, 32, 16 * dt, lane), o[dt]); }
        }
        if (kt < kt_hi) AT_STORE(buf ^ 1);
        __syncthreads();
    }
#undef AT_LOAD
#undef AT_STORE
    float li[4];
#pragma unroll
    for (int r = 0; r < 4; ++r) li[r] = frcp(__shfl(lrun, 4 * g + r));
#pragma unroll
    for (int r = 0; r < 4; ++r) { const size_t tok = (size_t)b * SEQ + c * 64 + qt * 16 + 4 * g + r; const bf16_t* zp = PROJ + tok * EV_N + EC_ZA + h * 128 + l15; bf16_t* yp = Y + tok * D_MODEL + h * 128 + l15;
#pragma unroll
        for (int dt = 0; dt < 8; ++dt) yp[16 * dt] = (bf16_t)f2bf(o[dt][r] * li[r] * fsilu(bf2f(zp[16 * dt]))); }
}
constexpr int ML_RSQ = 528, ML_RSK = 544, ML_RSV = 160, ML_RSP = 144, ML_RSH = 144;
constexpr int ML_OFF_Q = 0, ML_OFF_K = ML_OFF_Q + 64 * ML_RSQ, ML_OFF_V = ML_OFF_K + 64 * ML_RSK, ML_OFF_P = ML_OFF_V + 64 * ML_RSV, ML_OFF_H = ML_OFF_P + 64 * ML_RSP, ML_OFF_S = ML_OFF_H + 64 * ML_RSH;
constexpr int ML_BC = 0, ML_AA = 2048, ML_PM = 4096, ML_MCH = 6144  , ML_BL = 6184  , ML_PL = 6216  ;
constexpr int ML_E1 = 6248, ML_E2 = ML_E1 + 64, ML_WI = ML_E2 + 64, ML_EMT = ML_WI + 64, ML_WS = ML_EMT + 64, ML_RS = ML_WS + 64, ML_QN = ML_RS + 64, ML_NV = ML_QN + 64, ML_NP = ML_NV + 256, ML_WC = ML_NP + 512, ML_LDS = ML_OFF_S + (ML_WC + 4) * 4;
static_assert(ML_LDS <= 163328, "mLSTM LDS");
__device__ __forceinline__ void mlstm_item(const Ptrs& P, LAS unsigned char* lds, int item) {
    const bf16_t* __restrict__ PROJ = (const bf16_t*)(P.ws + WS_PROJ); bf16_t* __restrict__ Y = (bf16_t*)(P.ws + WS_Y); const float* __restrict__ GIF = (const float*)(P.ws + WS_GIF);
    const int tid = threadIdx.x, lane = tid & 63, wave = tid >> 6, g = lane >> 4, l15 = lane & 15;
    const int quarter = item & 3, h = (item >> 2) & 3, b = item >> 4;
    LAS float* sc = (LAS float*)(lds + ML_OFF_S);
    LAS const unsigned char* Qt = lds + ML_OFF_Q; LAS const unsigned char* Kt = lds + ML_OFF_K; LAS const unsigned char* Vt = lds + ML_OFF_V; LAS const unsigned char* Ps = lds + ML_OFF_P;
    const size_t tok0 = (size_t)b * SEQ;
    f32x4 cacc[16];
#pragma unroll
    for (int i = 0; i < 16; ++i) cacc[i] = (f32x4){0.f, 0.f, 0.f, 0.f};
    if (tid < 256) sc[ML_NV + tid] = 0.f;
    for (int e = tid; e < 64 * ML_RSP / 8; e += 512) *(LAS unsigned long long*)(lds + ML_OFF_P + e * 8) = 0ull;
#pragma unroll 1
    for (int c = wave * 4; c < wave * 4 + 4; ++c) { const size_t tok = tok0 + c * 64 + lane;
        const float li = GIF[tok * 8 + h], lf = logsigmoidf_(GIF[tok * 8 + 4 + h]);
        float bc = lf;
#pragma unroll
        for (int o = 1; o < 64; o <<= 1) { const float t_ = __shfl_up(bc, o); if (lane >= o) bc += t_; }
        const float as = li - bc; float pm = as;
#pragma unroll
        for (int o = 1; o < 64; o <<= 1) { const float t_ = __shfl_up(pm, o); if (lane >= o) pm = fmaxf(pm, t_); }
        sc[ML_BC + c * 64 + lane] = bc; sc[ML_AA + c * 64 + lane] = as; sc[ML_PM + c * 64 + lane] = pm;
        if (lane == 63) { sc[ML_BL + c] = bc; sc[ML_PL + c] = pm; } }
    __syncthreads();
    if (tid == 0) { float m = 0.f; sc[ML_MCH] = 0.f;
        for (int c = 0; c < NCH; ++c) { m = sc[ML_BL + c] + fmaxf(m, sc[ML_PL + c]); sc[ML_MCH + c + 1] = m; } }
    v4u qreg[4], kreg[4], vreg, oreg, zreg;
    const int ot = tid >> 3, oc = (tid & 7) * 8, ocol = h * 256 + quarter * 64 + oc;
#define ML_LOAD(n) do { _Pragma("unroll") for (int i_ = 0; i_ < 4; ++i_) { const int id_ = tid + 512 * i_, row_ = id_ >> 5, ch_ = id_ & 31; const bf16_t* rp_ = PROJ + (tok0 + (n) * 64 + row_) * EV_N + h * 256 + ch_ * 8; \
            qreg[i_] = *(const v4u*)(rp_ + EC_QB); kreg[i_] = *(const v4u*)(rp_ + EC_KB); } \
        vreg = *(const v4u*)(PROJ + (tok0 + (n) * 64 + (tid >> 3)) * EV_N + EC_VB + h * 256 + quarter * 64 + (tid & 7) * 8); } while (0)
#define ML_LOAD_OZ(n) do { const bf16_t* rp_ = PROJ + (tok0 + (n) * 64 + ot) * EV_N + ocol; oreg = *(const v4u*)(rp_ + EC_OB); zreg = *(const v4u*)(rp_ + EC_ZB); } while (0)
#define ML_STORE() do { _Pragma("unroll") for (int i_ = 0; i_ < 4; ++i_) { const int id_ = tid + 512 * i_, row_ = id_ >> 5, ch_ = id_ & 31; \
            *(LAS v4u*)(lds + ML_OFF_Q + row_ * ML_RSQ + ch_ * 16) = qreg[i_]; *(LAS v4u*)(lds + ML_OFF_K + row_ * ML_RSK + ch_ * 16) = kreg[i_]; } \
        *(LAS v4u*)(lds + ML_OFF_V + (tid >> 3) * ML_RSV + (tid & 7) * 16) = vreg; } while (0)
    ML_LOAD(0);
    __syncthreads();
    for (int n = 0; n < NCH; ++n) {
        ML_STORE();
        const float m0 = sc[ML_MCH + n], m1 = sc[ML_MCH + n + 1], blast = sc[ML_BL + n];
        if (tid < 64) { const float bc = sc[ML_BC + n * 64 + tid], as = sc[ML_AA + n * 64 + tid], mx = fmaxf(m0, sc[ML_PM + n * 64 + tid]);
            sc[ML_E1 + tid] = -mx * LOG2E; sc[ML_E2 + tid] = as * LOG2E; sc[ML_WI + tid] = fexp(m0 - mx); sc[ML_EMT + tid] = fexp(-bc - mx); sc[ML_WS + tid] = fexp(as + blast - m1); sc[ML_RS + tid] = 0.f;
            if (tid == 0) sc[ML_WC] = fexp(blast + m0 - m1); }
        __syncthreads();
        if (n + 1 < NCH) ML_LOAD(n + 1);
        f32x4 nu[4];
        if (wave >= 4) {
            { const int id = tid - 256, t = id >> 2, j = id & 3; float a = 0.f;
#pragma unroll
              for (int i = 0; i < 8; ++i) { const v4u w = *(LAS const v4u*)(Qt + t * ML_RSQ + (64 * j + 8 * i) * 2); const LAS float* nv = sc + ML_NV + 64 * j + 8 * i;
                  a += __builtin_bit_cast(float, w.x << 16) * nv[0] + __builtin_bit_cast(float, w.x & 0xffff0000u) * nv[1] + __builtin_bit_cast(float, w.y << 16) * nv[2] + __builtin_bit_cast(float, w.y & 0xffff0000u) * nv[3]
                     + __builtin_bit_cast(float, w.z << 16) * nv[4] + __builtin_bit_cast(float, w.z & 0xffff0000u) * nv[5] + __builtin_bit_cast(float, w.w << 16) * nv[6] + __builtin_bit_cast(float, w.w & 0xffff0000u) * nv[7]; }
              a += __shfl_xor(a, 1); a += __shfl_xor(a, 2);
              if (j == 0) sc[ML_QN + t] = a * 0.0625f; }
#pragma unroll 1
            for (int q = wave - 4; q < 10; q += 4) { const int tt = (q >= 6) ? 3 : (q >= 3) ? 2 : (q >= 1) ? 1 : 0; const int st = q - (tt * (tt + 1)) / 2;
                const int t = 16 * tt + l15; const float e1 = sc[ML_E1 + t];
                f32x4 s_ = (f32x4){0.f, 0.f, 0.f, 0.f};
#pragma unroll
                for (int ks = 0; ks < 8; ++ks) s_ = MFMA16(frag_row(Kt, ML_RSK, 16 * st, 32 * ks, lane), frag_row(Qt, ML_RSQ, 16 * tt, 32 * ks, lane), s_);
                float pv_[4]; float rs = 0.f;
#pragma unroll
                for (int r = 0; r < 4; ++r) { const int sidx = 16 * st + 4 * g + r; const float p = (sidx <= t) ? fexp2(e1 + sc[ML_E2 + sidx]) * s_[r] * 0.0625f : 0.f; pv_[r] = p; rs += p; }
                rs += __shfl_xor(rs, 16); rs += __shfl_xor(rs, 32);
                if (g == 0) atomicAdd((float*)(sc + ML_RS + t), rs);
                *(LAS unsigned long long*)(lds + ML_OFF_P + t * ML_RSP + (16 * st + 4 * g) * 2) = (unsigned long long)pk2(pv_[0], pv_[1]) | ((unsigned long long)pk2(pv_[2], pv_[3]) << 32); }
        } else {
#pragma unroll
            for (int tt = 0; tt < 4; ++tt) nu[tt] = (f32x4){0.f, 0.f, 0.f, 0.f};
#pragma unroll
            for (int j = 0; j < 8; ++j) { const bf16x8 cf = acc_pair_frag(cacc[2 * j], cacc[2 * j + 1]);
#pragma unroll
                for (int tt = 0; tt < 4; ++tt) nu[tt] = MFMA16(frag_row_perm(Qt, ML_RSQ, 16 * tt, 32 * j, lane), cf, nu[tt]);
                if (j & 1) __builtin_amdgcn_sched_barrier(0); }
#pragma unroll
            for (int tt = 0; tt < 4; ++tt) { const f32x4 wi = *(LAS const f32x4*)(sc + ML_WI + 16 * tt + 4 * g); nu[tt] *= wi * 0.0625f; }
        }
        __syncthreads();
        ML_LOAD_OZ(n);
        if (wave < 4) {
            bf16x8 vf[2];
#pragma unroll
            for (int ks = 0; ks < 2; ++ks) { vf[ks] = frag_tr_perm(Vt, ML_RSV, 32 * ks, 16 * wave, lane);
#pragma unroll
                for (int tt = 0; tt < 4; ++tt) nu[tt] = MFMA16(frag_row_perm(Ps, ML_RSP, 16 * tt, 32 * ks, lane), vf[ks], nu[tt]); }
#pragma unroll
            for (int tt = 0; tt < 4; ++tt)
#pragma unroll
                for (int r = 0; r < 4; ++r) *(LAS unsigned short*)(lds + ML_OFF_H + (16 * tt + 4 * g + r) * ML_RSH + (16 * wave + l15) * 2) = (unsigned short)(pk2(nu[tt][r], 0.f) & 0xffffu);
            __builtin_amdgcn_sched_barrier(0);
            const float wc = sc[ML_WC];
            bf16x8 vw[2];
#pragma unroll
            for (int ks = 0; ks < 2; ++ks) { typedef unsigned u32x4_ __attribute__((ext_vector_type(4))); const u32x4_ w = __builtin_bit_cast(u32x4_, vf[ks]);
                const f32x4 wa = *(LAS const f32x4*)(sc + ML_WS + 32 * ks + 4 * g), wb = *(LAS const f32x4*)(sc + ML_WS + 32 * ks + 16 + 4 * g);
                const u32x4_ o = {pk2(__builtin_bit_cast(float, w.x << 16) * wa[0], __builtin_bit_cast(float, w.x & 0xffff0000u) * wa[1]), pk2(__builtin_bit_cast(float, w.y << 16) * wa[2], __builtin_bit_cast(float, w.y & 0xffff0000u) * wa[3]),
                                  pk2(__builtin_bit_cast(float, w.z << 16) * wb[0], __builtin_bit_cast(float, w.z & 0xffff0000u) * wb[1]), pk2(__builtin_bit_cast(float, w.w << 16) * wb[2], __builtin_bit_cast(float, w.w & 0xffff0000u) * wb[3])};
                vw[ks] = __builtin_bit_cast(bf16x8, o); }
#pragma unroll
            for (int kt = 0; kt < 16; ++kt) { cacc[kt] *= wc;
                cacc[kt] = MFMA16(frag_tr_perm(Kt, ML_RSK, 0, 16 * kt, lane), vw[0], cacc[kt]);
                cacc[kt] = MFMA16(frag_tr_perm(Kt, ML_RSK, 32, 16 * kt, lane), vw[1], cacc[kt]);
                if ((kt & 3) == 3) __builtin_amdgcn_sched_barrier(0); }
#pragma unroll
            for (int kt = 0; kt < 16; ++kt) asm volatile("" : "+v"(cacc[kt]));
        } else {
            const int kd = tid - 256; float a = 0.f;
#pragma unroll 8
            for (int s_ = 0; s_ < 64; ++s_) a += sc[ML_WS + s_] * bf2f(*(LAS const unsigned short*)(Kt + s_ * ML_RSK + kd * 2));
            sc[ML_NV + kd] = sc[ML_WC] * sc[ML_NV + kd] + a;
        }
        __syncthreads();
        { const float den = sc[ML_WI + ot] * sc[ML_QN + ot] + sc[ML_RS + ot]; const float inv = frcp(fmaxf(fabsf(den), sc[ML_EMT + ot]));
          const v4u hw = *(LAS const v4u*)(lds + ML_OFF_H + ot * ML_RSH + oc * 2); const v4u ow = oreg, zw = zreg;
#define ML_Y(hx, ox, zx, lo) (fsigmoid(__builtin_bit_cast(float, (lo) ? ((ox) << 16) : ((ox) & 0xffff0000u))) * (__builtin_bit_cast(float, (lo) ? ((hx) << 16) : ((hx) & 0xffff0000u)) * inv) * fsilu(__builtin_bit_cast(float, (lo) ? ((zx) << 16) : ((zx) & 0xffff0000u))))
          v4u yw; yw.x = pk2(ML_Y(hw.x, ow.x, zw.x, 1), ML_Y(hw.x, ow.x, zw.x, 0)); yw.y = pk2(ML_Y(hw.y, ow.y, zw.y, 1), ML_Y(hw.y, ow.y, zw.y, 0));
          yw.z = pk2(ML_Y(hw.z, ow.z, zw.z, 1), ML_Y(hw.z, ow.z, zw.z, 0)); yw.w = pk2(ML_Y(hw.w, ow.w, zw.w, 1), ML_Y(hw.w, ow.w, zw.w, 0));
#undef ML_Y
          *(v4u*)(Y + (tok0 + n * 64 + ot) * D_MODEL + W_A + ocol) = yw; }
    }
#undef ML_LOAD
#undef ML_LOAD_OZ
#undef ML_STORE
    __syncthreads();
}
constexpr int RG_RSG = 160, RG_RSX = 272, RG_RSF = 33 * 4;
constexpr int RG_OFF_G = 0, RG_OFF_X = RG_OFF_G + 128 * RG_RSG, RG_OFF_XF = RG_OFF_X + 64 * RG_RSX, RG_OFF_A = RG_OFF_XF + 64 * RG_RSF, RG_OFF_I = RG_OFF_A + 64 * RG_RSF, RG_OFF_H = RG_OFF_I + 64 * RG_RSF, RG_LDS = RG_OFF_H + 64 * RG_RSF;
static_assert(RG_LDS <= 163328, "RG-LRU LDS");
__device__ __forceinline__ void rglru_item(const Ptrs& P, LAS unsigned char* lds, int item) {
    const bf16_t* __restrict__ PROJ = (const bf16_t*)(P.ws + WS_PROJ); bf16_t* __restrict__ Y = (bf16_t*)(P.ws + WS_Y);
    const float* __restrict__ ccw = P.in[IN_OD_CCW]; const float* __restrict__ ccb = P.in[IN_OD_CCB]; const float* __restrict__ gw = P.in[IN_OD_GW]; const float* __restrict__ gb = P.in[IN_OD_GB]; const float* __restrict__ lam = P.in[IN_OD_LAM];
    const int tid = threadIdx.x, lane = tid & 63, wave = tid >> 6, g = lane >> 4, l15 = lane & 15;
    const int cq = item & 3, blk = (item >> 2) & 7, b = item >> 5;
    const size_t tok0 = (size_t)b * SEQ;
    for (int e = tid; e < 128 * 64; e += 512) { const int k = e >> 6, c = e & 63; const int d = (c < 32) ? (cq * 32 + c) : (128 + cq * 32 + c - 32);
        *(LAS unsigned short*)(lds + RG_OFF_G + k * RG_RSG + c * 2) = (unsigned short)f2bf(gw[((size_t)blk * 128 + k) * 256 + d]); }
    const int c8 = tid & 15, tq = tid >> 4, ch0 = blk * 128 + 8 * c8;
    float cw[4][8], cb[8];
#pragma unroll
    for (int i = 0; i < 8; ++i) { cb[i] = ccb[ch0 + i];
#pragma unroll
        for (int j = 0; j < 4; ++j) cw[j][i] = ccw[j * W_C + ch0 + i]; }
    const int chl = 16 * (wave & 1) + l15, cgl = blk * 128 + cq * 32 + chl;
    const float gbr = gb[cgl], gbi = gb[W_C + cgl], sp = softplusf_(-lam[cgl]);
    float hcar = 0.f;
    v4u xin[2][4]; unsigned long long zin = 0ull;
    const int ot = tid >> 3, oc4 = tid & 7, cgo = blk * 128 + cq * 32 + 4 * oc4;
#define RG_LOAD(n) do { _Pragma("unroll") for (int u_ = 0; u_ < 2; ++u_) { const int s_ = (n) * 64 + tq + 32 * u_; \
            _Pragma("unroll") for (int j_ = 0; j_ < 4; ++j_) { xin[u_][j_] = (v4u){0u, 0u, 0u, 0u}; if (s_ - 3 + j_ >= 0) xin[u_][j_] = *(const v4u*)(PROJ + (tok0 + s_ - 3 + j_) * OD_N + OC_XC + ch0); } } \
        zin = *(const unsigned long long*)(PROJ + (tok0 + (n) * 64 + ot) * OD_N + OC_ZC + cgo); } while (0)
    RG_LOAD(0);
    __syncthreads();
    for (int n = 0; n < NCH; ++n) {
        const unsigned long long zw = zin;
#pragma unroll
        for (int u = 0; u < 2; ++u) { const int t = tq + 32 * u; float xv[8];
#pragma unroll
            for (int i = 0; i < 8; ++i) xv[i] = cb[i];
#pragma unroll
            for (int j = 0; j < 4; ++j) { const v4u w_ = xin[u][j];
                xv[0] += cw[j][0] * __builtin_bit_cast(float, w_.x << 16); xv[1] += cw[j][1] * __builtin_bit_cast(float, w_.x & 0xffff0000u); xv[2] += cw[j][2] * __builtin_bit_cast(float, w_.y << 16); xv[3] += cw[j][3] * __builtin_bit_cast(float, w_.y & 0xffff0000u);
                xv[4] += cw[j][4] * __builtin_bit_cast(float, w_.z << 16); xv[5] += cw[j][5] * __builtin_bit_cast(float, w_.z & 0xffff0000u); xv[6] += cw[j][6] * __builtin_bit_cast(float, w_.w << 16); xv[7] += cw[j][7] * __builtin_bit_cast(float, w_.w & 0xffff0000u); }
            v4u w; w.x = pk2(xv[0], xv[1]); w.y = pk2(xv[2], xv[3]); w.z = pk2(xv[4], xv[5]); w.w = pk2(xv[6], xv[7]);
            *(LAS v4u*)(lds + RG_OFF_X + t * RG_RSX + c8 * 16) = w;
            if ((c8 >> 2) == cq) { LAS float* xf = (LAS float*)(lds + RG_OFF_XF + t * RG_RSF) + 8 * (c8 & 3);
#pragma unroll
                for (int i = 0; i < 8; ++i) xf[i] = xv[i]; } }
        if (n + 1 < NCH) RG_LOAD(n + 1);
        __syncthreads();
        { const int tt = wave >> 1, cp = wave & 1; f32x4 ar = (f32x4){0.f, 0.f, 0.f, 0.f}, ai = ar;
#pragma unroll
          for (int ks = 0; ks < 4; ++ks) { const bf16x8 xa = frag_row(lds + RG_OFF_X, RG_RSX, 16 * tt, 32 * ks, lane);
              ar = MFMA16(xa, frag_tr(lds + RG_OFF_G, RG_RSG, 32 * ks, 16 * cp, lane), ar);
              ai = MFMA16(xa, frag_tr(lds + RG_OFF_G, RG_RSG, 32 * ks, 32 + 16 * cp, lane), ai); }
#pragma unroll
          for (int r = 0; r < 4; ++r) { const int t = 16 * tt + 4 * g + r;
              const float rr = fsigmoid(ar[r] + gbr), ig = fsigmoid(ai[r] + gbi); const float la = -8.0f * rr * sp;
              const float xc = *((LAS const float*)(lds + RG_OFF_XF + t * RG_RSF) + chl);
              *((LAS float*)(lds + RG_OFF_A + t * RG_RSF) + chl) = fexp(la);
              *((LAS float*)(lds + RG_OFF_I + t * RG_RSF) + chl) = fsqrt(1.0f - fexp(2.0f * la)) * (ig * xc); } }
        __syncthreads();
        if (tid < 32) { float h = hcar;
#pragma unroll 8
            for (int t = 0; t < 64; ++t) { h = *((LAS const float*)(lds + RG_OFF_A + t * RG_RSF) + tid) * h + *((LAS const float*)(lds + RG_OFF_I + t * RG_RSF) + tid);
                *((LAS float*)(lds + RG_OFF_H + t * RG_RSF) + tid) = h; }
            hcar = h; }
        __syncthreads();
        { const size_t tok = tok0 + n * 64 + ot;
          const LAS float* hp = (LAS const float*)(lds + RG_OFF_H + ot * RG_RSF) + 4 * oc4;
          const float z0 = __builtin_bit_cast(float, (unsigned)(zw & 0xffffull) << 16), z1 = __builtin_bit_cast(float, (unsigned)(zw >> 16 & 0xffffull) << 16), z2 = __builtin_bit_cast(float, (unsigned)(zw >> 32 & 0xffffull) << 16), z3 = __builtin_bit_cast(float, (unsigned)(zw >> 48) << 16);
          *(unsigned long long*)(Y + tok * D_MODEL + cgo) = (unsigned long long)pk2(hp[0] * fsilu(z0), hp[1] * fsilu(z1)) | ((unsigned long long)pk2(hp[2] * fsilu(z2), hp[3] * fsilu(z3)) << 32); }
    }
#undef RG_LOAD
    __syncthreads();
}
constexpr size_t WS_DQ2 = 4 * MiB, WS_DK2 = 36 * MiB;
constexpr size_t WS_DWT = WS_XB, WS_DUT = WS_XB + 32 * MiB;
constexpr size_t WS_DQK = WS_FREE1, WS_DDEC = WS_FREE1 + 16 * MiB;
constexpr float DN_SCALE = 0.08838834764831845f;
template <int T> struct SolveRows {
    static __device__ __forceinline__ void run(float (&col)[32], LAS const unsigned char* Ab, int j) {
        SolveRows<T - 1>::run(col, Ab, j);
        float v = (T == j) ? 1.f : 0.f;
#pragma unroll
        for (int s4 = 0; s4 < (T + 3) / 4; ++s4) { const f32x4 a = *(LAS const f32x4*)(Ab + T * 272 + 16 * s4);
#pragma unroll
            for (int e = 0; e < 4; ++e) { if (4 * s4 + e < T) v -= a[e] * col[4 * s4 + e]; } }
        asm volatile("" : "+v"(v) :: "memory"); col[T] = v;
    }
};
template <> struct SolveRows<-1> { static __device__ __forceinline__ void run(float (&)[32], LAS const unsigned char*, int) {} };
constexpr int D1_RSQ = 272, D1_RSK = 288, D1_RSV = 288, D1_RSA = 272, D1_RST = 160;
constexpr int D1_OFF_Q = 0, D1_OFF_K = D1_OFF_Q + 64 * D1_RSQ, D1_OFF_V = D1_OFF_K + 64 * D1_RSK, D1_OFF_A = D1_OFF_V + 64 * D1_RSV, D1_OFF_T = D1_OFF_A + 64 * D1_RSA, D1_OFF_S = D1_OFF_T + 64 * D1_RST, D1_LDS = D1_OFF_S + 512;
static_assert(D1_LDS <= 163328, "D1 LDS");
__device__ __forceinline__ void dn1_item(const Ptrs& P, LAS unsigned char* lds, int item) {
    const bf16_t* __restrict__ PROJ = (const bf16_t*)(P.ws + WS_PROJ); const float* __restrict__ AB = (const float*)(P.ws + WS_AB); const float* __restrict__ cdw = P.in[IN_OD_CDW];
    bf16_t* __restrict__ Q2 = (bf16_t*)(P.ws + WS_DQ2); bf16_t* __restrict__ K2 = (bf16_t*)(P.ws + WS_DK2);
    bf16_t* __restrict__ WTg = (bf16_t*)(P.ws + WS_DWT) + (size_t)item * 8192; bf16_t* __restrict__ UTg = (bf16_t*)(P.ws + WS_DUT) + (size_t)item * 8192;
    bf16_t* __restrict__ QKg = (bf16_t*)(P.ws + WS_DQK) + (size_t)item * 4096; float* __restrict__ DECg = (float*)(P.ws + WS_DDEC) + (size_t)item * 64;
    const int tid = threadIdx.x, lane = tid & 63, wave = tid >> 6, g = lane >> 4, l15 = lane & 15;
    const int n = item & 31, h = (item >> 5) & 7, b = item >> 8;
    const size_t tok0 = (size_t)b * SEQ + n * 64;
    LAS float* beta_s = (LAS float*)(lds + D1_OFF_S); LAS float* dec_s = beta_s + 64;
    { const int t = tid >> 3, d16 = tid & 7, s = n * 64 + t; float qk_[2][16]; float ssq[2] = {0.f, 0.f};
#pragma unroll
      for (int p = 0; p < 3; ++p)
#pragma unroll
          for (int hf = 0; hf < 2; ++hf) { const int col = p * W_D + h * 128 + 16 * d16 + 8 * hf; float a[8];
#pragma unroll
              for (int i = 0; i < 8; ++i) a[i] = 0.f;
#pragma unroll
              for (int j = 0; j < 4; ++j) { if (s - 3 + j >= 0) { float xv[8]; ld8bf(PROJ + (tok0 + t - 3 + j) * OD_N + OC_QD + col, xv);
                      const f32x4 w0 = *(const f32x4*)(cdw + j * 3 * W_D + col), w1 = *(const f32x4*)(cdw + j * 3 * W_D + col + 4);
                      a[0] += w0[0] * xv[0]; a[1] += w0[1] * xv[1]; a[2] += w0[2] * xv[2]; a[3] += w0[3] * xv[3]; a[4] += w1[0] * xv[4]; a[5] += w1[1] * xv[5]; a[6] += w1[2] * xv[6]; a[7] += w1[3] * xv[7]; } }
#pragma unroll
              for (int i = 0; i < 8; ++i) a[i] = fsilu(a[i]);
              if (p < 2) {
#pragma unroll
                  for (int i = 0; i < 8; ++i) { qk_[p][8 * hf + i] = a[i]; ssq[p] += a[i] * a[i]; } }
              else { v4u w; w.x = pk2(a[0], a[1]); w.y = pk2(a[2], a[3]); w.z = pk2(a[4], a[5]); w.w = pk2(a[6], a[7]);
                  *(LAS v4u*)(lds + D1_OFF_V + t * D1_RSV + (16 * d16 + 8 * hf) * 2) = w; } }
#pragma unroll
      for (int p = 0; p < 2; ++p) { float ss = ssq[p]; ss += __shfl_xor(ss, 1); ss += __shfl_xor(ss, 2); ss += __shfl_xor(ss, 4); const float rs = frsq(ss + EPS);
#pragma unroll
          for (int hf = 0; hf < 2; ++hf) { v4u w; w.x = pk2(qk_[p][8 * hf + 0] * rs, qk_[p][8 * hf + 1] * rs); w.y = pk2(qk_[p][8 * hf + 2] * rs, qk_[p][8 * hf + 3] * rs);
              w.z = pk2(qk_[p][8 * hf + 4] * rs, qk_[p][8 * hf + 5] * rs); w.w = pk2(qk_[p][8 * hf + 6] * rs, qk_[p][8 * hf + 7] * rs);
              const int dd = 16 * d16 + 8 * hf;
              if (p == 0) { *(LAS v4u*)(lds + D1_OFF_Q + t * D1_RSQ + dd * 2) = w; *(v4u*)(Q2 + (tok0 + t) * W_D + h * 128 + dd) = w; }
              else { *(LAS v4u*)(lds + D1_OFF_K + t * D1_RSK + dd * 2) = w; *(v4u*)(K2 + (tok0 + t) * W_D + h * 128 + dd) = w; } } } }
    if (wave == 0) { const size_t tok = tok0 + lane;
        const float beta = fsigmoid(AB[tok * 16 + 8 + h]); float dc = -fexp(P.in[IN_OD_ALOG][h]) * softplusf_(AB[tok * 16 + h] + P.in[IN_OD_DTB][h]);
#pragma unroll
        for (int o = 1; o < 64; o <<= 1) { const float t_ = __shfl_up(dc, o); if (lane >= o) dc += t_; }
        beta_s[lane] = beta; dec_s[lane] = dc; DECg[lane] = dc; }
    __syncthreads();
    { const int tt = wave >> 1, t = 16 * tt + l15; const float dt_ = dec_s[t], bt = beta_s[t];
#pragma unroll
      for (int u = 0; u < 2; ++u) { const int st = 2 * (wave & 1) + u; unsigned long long qw = 0ull;
          if (st <= tt) { f32x4 kk = (f32x4){0.f, 0.f, 0.f, 0.f}, qk = kk;
#pragma unroll
              for (int ks = 0; ks < 4; ++ks) { const bf16x8 a = frag_row(lds + D1_OFF_K, D1_RSK, 16 * st, 32 * ks, lane);
                  kk = MFMA16(a, frag_row(lds + D1_OFF_K, D1_RSK, 16 * tt, 32 * ks, lane), kk); qk = MFMA16(a, frag_row(lds + D1_OFF_Q, D1_RSQ, 16 * tt, 32 * ks, lane), qk); }
              f32x4 am; float qv[4];
#pragma unroll
              for (int r = 0; r < 4; ++r) { const int s = 16 * st + 4 * g + r; const float gam = (s <= t) ? fexp(dt_ - dec_s[s]) : 0.f; am[r] = (s < t) ? bt * kk[r] * gam : 0.f; qv[r] = qk[r] * gam * DN_SCALE; }
              *(LAS f32x4*)(lds + D1_OFF_A + t * D1_RSA + (16 * st + 4 * g) * 4) = am;
              qw = (unsigned long long)pk2(qv[0], qv[1]) | ((unsigned long long)pk2(qv[2], qv[3]) << 32); }
          *(unsigned long long*)(QKg + t * 64 + 16 * st + 4 * g) = qw; } }
    __syncthreads();
    if (wave == 0) { const int hb = lane >> 5, j = lane & 31; float col[32];
        LAS const unsigned char* Ab = lds + D1_OFF_A + (32 * hb) * D1_RSA + (32 * hb) * 4;
        SolveRows<31>::run(col, Ab, j);
        LAS unsigned char* trow = lds + D1_OFF_T + (32 * hb + j) * D1_RST;
#pragma unroll
        for (int c = 0; c < 4; ++c) { v4u w; w.x = pk2(col[8 * c], col[8 * c + 1]); w.y = pk2(col[8 * c + 2], col[8 * c + 3]); w.z = pk2(col[8 * c + 4], col[8 * c + 5]); w.w = pk2(col[8 * c + 6], col[8 * c + 7]);
            *(LAS v4u*)(trow + (32 * hb) * 2 + 16 * c) = w;
            if (hb) *(LAS v4u*)(trow + 16 * c) = (v4u){0u, 0u, 0u, 0u}; }
        bf16x8 af[2], bfr[2];
#pragma unroll
        for (int ti = 0; ti < 2; ++ti) { LAS const unsigned char* ap = lds + D1_OFF_A + (32 + 16 * ti + l15) * D1_RSA + (8 * g) * 4; const f32x4 a0 = *(LAS const f32x4*)ap, a1 = *(LAS const f32x4*)(ap + 16);
            typedef unsigned u32x4_ __attribute__((ext_vector_type(4))); const u32x4_ w = {pk2(a0[0], a0[1]), pk2(a0[2], a0[3]), pk2(a1[0], a1[1]), pk2(a1[2], a1[3])}; af[ti] = __builtin_bit_cast(bf16x8, w); }
#pragma unroll
        for (int nj = 0; nj < 2; ++nj) bfr[nj] = frag_row(lds + D1_OFF_T, D1_RST, 16 * nj, 0, lane);
        f32x4 X[2][2];
#pragma unroll
        for (int ti = 0; ti < 2; ++ti)
#pragma unroll
            for (int nj = 0; nj < 2; ++nj) X[ti][nj] = MFMA16(af[ti], bfr[nj], ((f32x4){0.f, 0.f, 0.f, 0.f}));
        LAS const unsigned char* T11b = lds + D1_OFF_T + 32 * D1_RST + 64;
#pragma unroll
        for (int nj = 0; nj < 2; ++nj) { const bf16x8 xb = acc_pair_frag(X[0][nj], X[1][nj]);
#pragma unroll
            for (int ti = 0; ti < 2; ++ti) { const f32x4 r_ = MFMA16(frag_tr_perm(T11b, D1_RST, 0, 16 * ti, lane), xb, ((f32x4){0.f, 0.f, 0.f, 0.f}));
                *(LAS unsigned long long*)(lds + D1_OFF_T + (16 * nj + l15) * D1_RST + (32 + 16 * ti + 4 * g) * 2) = (unsigned long long)pk2(-r_[0], -r_[1]) | ((unsigned long long)pk2(-r_[2], -r_[3]) << 32); } }
    }
    __syncthreads();
    { bf16x8 bv[2], bk[2];
#pragma unroll
      for (int ks = 0; ks < 2; ++ks) { typedef unsigned u32x4_ __attribute__((ext_vector_type(4)));
          const u32x4_ wv = __builtin_bit_cast(u32x4_, frag_tr(lds + D1_OFF_V, D1_RSV, 32 * ks, 16 * wave, lane)), wk = __builtin_bit_cast(u32x4_, frag_tr(lds + D1_OFF_K, D1_RSK, 32 * ks, 16 * wave, lane));
          float fb[8], fk[8];
#pragma unroll
          for (int i = 0; i < 8; ++i) { const int s = 32 * ks + 8 * g + i; fb[i] = beta_s[s]; fk[i] = fb[i] * fexp(dec_s[s]); }
#define SC2(w_, f0, f1) pk2(__builtin_bit_cast(float, (w_) << 16) * (f0), __builtin_bit_cast(float, (w_) & 0xffff0000u) * (f1))
          const u32x4_ ov = {SC2(wv.x, fb[0], fb[1]), SC2(wv.y, fb[2], fb[3]), SC2(wv.z, fb[4], fb[5]), SC2(wv.w, fb[6], fb[7])};
          const u32x4_ ok = {SC2(wk.x, fk[0], fk[1]), SC2(wk.y, fk[2], fk[3]), SC2(wk.z, fk[4], fk[5]), SC2(wk.w, fk[6], fk[7])};
#undef SC2
          bv[ks] = __builtin_bit_cast(bf16x8, ov); bk[ks] = __builtin_bit_cast(bf16x8, ok); }
#pragma unroll
      for (int tt = 0; tt < 4; ++tt) { f32x4 u = (f32x4){0.f, 0.f, 0.f, 0.f}, wv = u;
#pragma unroll
          for (int ks = 0; ks < 2; ++ks) { const bf16x8 at = frag_tr(lds + D1_OFF_T, D1_RST, 32 * ks, 16 * tt, lane); u = MFMA16(at, bv[ks], u); wv = MFMA16(at, bk[ks], wv); }
          const size_t o_ = (size_t)(16 * wave + l15) * 64 + 16 * tt + 4 * g;
          *(unsigned long long*)(UTg + o_) = (unsigned long long)pk2(u[0], u[1]) | ((unsigned long long)pk2(u[2], u[3]) << 32);
          *(unsigned long long*)(WTg + o_) = (unsigned long long)pk2(wv[0], wv[1]) | ((unsigned long long)pk2(wv[2], wv[3]) << 32); } }
    __syncthreads();
}
constexpr int D2_RSW = 144, D2_RSQ = 272, D2_RSK = 288, D2_RSP = 144, D2_RSO = 528;
constexpr int D2_OFF_W = 0, D2_OFF_Q = D2_OFF_W + 128 * D2_RSW, D2_OFF_K = D2_OFF_Q + 64 * D2_RSQ, D2_OFF_P = D2_OFF_K + 64 * D2_RSK, D2_OFF_O = D2_OFF_P + 64 * D2_RSP, D2_OFF_D = D2_OFF_O + 64 * D2_RSO, D2_LDS = D2_OFF_D + 1024;
static_assert(D2_LDS <= 163328, "D2 LDS");
__device__ __forceinline__ void dn2_item(const Ptrs& P, LAS unsigned char* lds, int item) {
    const bf16_t* __restrict__ PROJ = (const bf16_t*)(P.ws + WS_PROJ); bf16_t* __restrict__ Y = (bf16_t*)(P.ws + WS_Y);
    const bf16_t* __restrict__ Q2 = (const bf16_t*)(P.ws + WS_DQ2); const bf16_t* __restrict__ K2 = (const bf16_t*)(P.ws + WS_DK2);
    const int tid = threadIdx.x, lane = tid & 63, wave = tid >> 6, g = lane >> 4, l15 = lane & 15;
    const int h = item & 7, b = item >> 3;
    const size_t tok0 = (size_t)b * SEQ; const int it0 = item * 32;
    const bf16_t* __restrict__ WTg = (const bf16_t*)(P.ws + WS_DWT) + (size_t)it0 * 8192; const bf16_t* __restrict__ UTg = (const bf16_t*)(P.ws + WS_DUT) + (size_t)it0 * 8192;
    const bf16_t* __restrict__ QKg = (const bf16_t*)(P.ws + WS_DQK) + (size_t)it0 * 4096; const float* __restrict__ DECg = (const float*)(P.ws + WS_DDEC) + (size_t)it0 * 64;
    LAS float* ed_s = (LAS float*)(lds + D2_OFF_D); LAS float* ek_s = ed_s + 64; LAS float* edl_s = ed_s + 128;
    f32x4 sacc[8];
#pragma unroll
    for (int i = 0; i < 8; ++i) sacc[i] = (f32x4){0.f, 0.f, 0.f, 0.f};
    const int ot = tid >> 3, oc = (tid & 7) * 16;
    float og[16];
#pragma unroll
    for (int i = 0; i < 16; ++i) og[i] = P.in[IN_OD_ONORM][oc + i];
    v4u wreg[2], qreg[2], kreg[2], preg, zreg[2]; unsigned long long ureg[4]; float dreg = 0.f, dlreg = 0.f;
#define D2_LOAD(n) do { _Pragma("unroll") for (int i_ = 0; i_ < 2; ++i_) { const int id_ = tid + 512 * i_; wreg[i_] = *(const v4u*)(WTg + (size_t)(n) * 8192 + id_ * 8); \
            const int row_ = id_ >> 4, ch_ = id_ & 15; const size_t o2_ = (tok0 + (n) * 64 + row_) * W_D + h * 128 + ch_ * 8; qreg[i_] = *(const v4u*)(Q2 + o2_); kreg[i_] = *(const v4u*)(K2 + o2_); } \
        preg = *(const v4u*)(QKg + (size_t)(n) * 4096 + tid * 8); \
        _Pragma("unroll") for (int tt_ = 0; tt_ < 4; ++tt_) ureg[tt_] = *(const unsigned long long*)(UTg + (size_t)(n) * 8192 + (16 * wave + l15) * 64 + 16 * tt_ + 4 * g); \
        if (tid < 64) { dreg = DECg[(n) * 64 + tid]; dlreg = DECg[(n) * 64 + 63]; } } while (0)
#define D2_LOAD_Z(n) do { const bf16_t* zp_ = PROJ + (tok0 + (n) * 64 + ot) * OD_N + OC_ZD + h * 128 + oc; zreg[0] = *(const v4u*)zp_; zreg[1] = *(const v4u*)(zp_ + 8); } while (0)
#define D2_STORE() do { _Pragma("unroll") for (int i_ = 0; i_ < 2; ++i_) { const int id_ = tid + 512 * i_; *(LAS v4u*)(lds + D2_OFF_W + (id_ >> 3) * D2_RSW + (id_ & 7) * 16) = wreg[i_]; \
            const int row_ = id_ >> 4, ch_ = id_ & 15; *(LAS v4u*)(lds + D2_OFF_Q + row_ * D2_RSQ + ch_ * 16) = qreg[i_]; *(LAS v4u*)(lds + D2_OFF_K + row_ * D2_RSK + ch_ * 16) = kreg[i_]; } \
        *(LAS v4u*)(lds + D2_OFF_P + (tid >> 3) * D2_RSP + (tid & 7) * 16) = preg; \
        if (tid < 64) { ed_s[tid] = fexp(dreg) * DN_SCALE; ek_s[tid] = fexp(dlreg - dreg); if (tid == 0) edl_s[0] = fexp(dlreg); } } while (0)
    D2_LOAD(0);
    for (int n = 0; n < NCH; ++n) {
        D2_STORE();
        f32x4 un[4];
#pragma unroll
        for (int tt = 0; tt < 4; ++tt) { un[tt][0] = __builtin_bit_cast(float, (unsigned)(ureg[tt] & 0xffffull) << 16); un[tt][1] = __builtin_bit_cast(float, (unsigned)(ureg[tt] >> 16 & 0xffffull) << 16);
            un[tt][2] = __builtin_bit_cast(float, (unsigned)(ureg[tt] >> 32 & 0xffffull) << 16); un[tt][3] = __builtin_bit_cast(float, (unsigned)(ureg[tt] >> 48) << 16); }
        __syncthreads();
        if (n + 1 < NCH) D2_LOAD(n + 1);
        bf16x8 sf[4];
#pragma unroll
        for (int j = 0; j < 4; ++j) sf[j] = acc_pair_frag(sacc[2 * j], sacc[2 * j + 1]);
        f32x4 vn[4], o[4];
#pragma unroll
        for (int tt = 0; tt < 4; ++tt) { f32x4 ws_ = (f32x4){0.f, 0.f, 0.f, 0.f}, qs_ = ws_;
#pragma unroll
            for (int j = 0; j < 4; ++j) { ws_ = MFMA16(frag_tr_perm(lds + D2_OFF_W, D2_RSW, 32 * j, 16 * tt, lane), sf[j], ws_); qs_ = MFMA16(frag_row_perm(lds + D2_OFF_Q, D2_RSQ, 16 * tt, 32 * j, lane), sf[j], qs_); }
            vn[tt] = un[tt] - ws_; o[tt] = qs_ * *(LAS const f32x4*)(ed_s + 16 * tt + 4 * g); }
        __builtin_amdgcn_sched_barrier(0);
        bf16x8 vf[2], vsf[2];
#pragma unroll
        for (int ks = 0; ks < 2; ++ks) { vf[ks] = acc_pair_frag(vn[2 * ks], vn[2 * ks + 1]);
            const f32x4 a_ = vn[2 * ks] * *(LAS const f32x4*)(ek_s + 32 * ks + 4 * g), b_ = vn[2 * ks + 1] * *(LAS const f32x4*)(ek_s + 32 * ks + 16 + 4 * g);
            vsf[ks] = acc_pair_frag(a_, b_); }
#pragma unroll
        for (int tt = 0; tt < 4; ++tt)
#pragma unroll
            for (int ks = 0; ks < 2; ++ks) o[tt] = MFMA16(frag_row_perm(lds + D2_OFF_P, D2_RSP, 16 * tt, 32 * ks, lane), vf[ks], o[tt]);
#pragma unroll
        for (int tt = 0; tt < 4; ++tt)
#pragma unroll
            for (int r = 0; r < 4; ++r) *(LAS float*)(lds + D2_OFF_O + (16 * tt + 4 * g + r) * D2_RSO + (16 * wave + l15) * 4) = o[tt][r];
        __builtin_amdgcn_sched_barrier(0);
        D2_LOAD_Z(n);
        { const float edl = edl_s[0];
#pragma unroll
          for (int kt = 0; kt < 8; ++kt) { sacc[kt] *= edl;
#pragma unroll
              for (int ks = 0; ks < 2; ++ks) sacc[kt] = MFMA16(frag_tr_perm(lds + D2_OFF_K, D2_RSK, 32 * ks, 16 * kt, lane), vsf[ks], sacc[kt]);
              if ((kt & 3) == 3) __builtin_amdgcn_sched_barrier(0); }
#pragma unroll
          for (int kt = 0; kt < 8; ++kt) asm volatile("" : "+v"(sacc[kt])); }
        __syncthreads();
        { f32x4 ov[4]; float ss = 0.f;
#pragma unroll
          for (int c = 0; c < 4; ++c) { ov[c] = *(LAS const f32x4*)(lds + D2_OFF_O + ot * D2_RSO + (oc + 4 * c) * 4); ss += (ov[c][0] * ov[c][0] + ov[c][1] * ov[c][1]) + (ov[c][2] * ov[c][2] + ov[c][3] * ov[c][3]); }
          ss += __shfl_xor(ss, 1); ss += __shfl_xor(ss, 2); ss += __shfl_xor(ss, 4);
          const float rs = frsq(ss * (1.0f / 128.0f) + EPS);
          bf16_t* yp = Y + (tok0 + n * 64 + ot) * D_MODEL + W_C + h * 128 + oc;
#pragma unroll
          for (int c = 0; c < 2; ++c) { const v4u zw = zreg[c]; const f32x4 a = ov[2 * c], b_ = ov[2 * c + 1];
#define D2_Y(ov_, gi, zx, lo) ((ov_) * rs * og[gi] * fsilu(__builtin_bit_cast(float, (lo) ? ((zx) << 16) : ((zx) & 0xffff0000u))))
              v4u yw; yw.x = pk2(D2_Y(a[0], 8 * c + 0, zw.x, 1), D2_Y(a[1], 8 * c + 1, zw.x, 0)); yw.y = pk2(D2_Y(a[2], 8 * c + 2, zw.y, 1), D2_Y(a[3], 8 * c + 3, zw.y, 0));
              yw.z = pk2(D2_Y(b_[0], 8 * c + 4, zw.z, 1), D2_Y(b_[1], 8 * c + 5, zw.z, 0)); yw.w = pk2(D2_Y(b_[2], 8 * c + 6, zw.w, 1), D2_Y(b_[3], 8 * c + 7, zw.w, 0));
#undef D2_Y
              *(v4u*)(yp + 8 * c) = yw; } }
    }
#undef D2_LOAD
#undef D2_LOAD_Z
#undef D2_STORE
    __syncthreads();
}
__device__ __forceinline__ void vb_attn(const bf16_t* __restrict__ PROJ, const float* __restrict__ qn_g, const float* __restrict__ kn_g, const float* __restrict__ rel_bias, bf16_t* __restrict__ Y,
                                        int bid, int t, LAS float* qs  , LAS float* S  , bool active) {
    if (!active) bid = 0;
    const int quarter = bid & 3, c = (bid >> 2) & 31, h = (bid >> 7) & 7, b = bid >> 10;
    { const int r = t >> 4, sub = t & 15; const int tok = b * SEQ + c * 64 + quarter * 16 + r;
      float v[8]; ld8bf(PROJ + (size_t)tok * EV_N + EC_QA + h * 128 + sub * 8, v);
      float ss = 0.f;
#pragma unroll
      for (int i = 0; i < 8; ++i) ss += v[i] * v[i];
      ss += __shfl_xor(ss, 1); ss += __shfl_xor(ss, 2); ss += __shfl_xor(ss, 4); ss += __shfl_xor(ss, 8);
      const float rs = 1.0f / sqrtf(ss * (1.0f / 128.0f) + EPS);
#pragma unroll
      for (int i = 0; i < 8; ++i) qs[r * 128 + sub * 8 + i] = v[i] * rs * qn_g[sub * 8 + i] * 0.08838834764831845f; }
    __syncthreads();
    for (int idx = t; idx < 16 * BAND; idx += 256) {
        const int r = idx / BAND, j = idx % BAND; const int kc = c - LOOKBACK + (j >> 6);
        float s;
        if (kc < 0) s = -1e30f;
        else { const bf16_t* kp = PROJ + (size_t)(b * SEQ + kc * 64 + (j & 63)) * EV_N + EC_KA + h * 128;
            float ss = 0.f, dot = 0.f;
            for (int d = 0; d < 128; d += 8) { float kv[8]; ld8bf(kp + d, kv);
#pragma unroll
                for (int i = 0; i < 8; ++i) { ss += kv[i] * kv[i]; dot += kv[i] * kn_g[d + i] * qs[r * 128 + d + i]; } }
            s = dot * (1.0f / sqrtf(ss * (1.0f / 128.0f) + EPS));
            const int qi = quarter * 16 + r; int rel = LOOKBACK * CHUNK + qi - j; rel = rel < -REL_MAX ? -REL_MAX : (rel > REL_MAX ? REL_MAX : rel); rel += REL_MAX;
            s += rel_bias[h * NREL + rel]; }
        S[r * 577 + j] = s;
    }
    __syncthreads();
    { const int r = t >> 4, sub = t & 15; float mx = -3.0e38f;
      for (int j = sub; j < BAND; j += 16) mx = fmaxf(mx, S[r * 577 + j]);
      mx = fmaxf(mx, __shfl_xor(mx, 1)); mx = fmaxf(mx, __shfl_xor(mx, 2)); mx = fmaxf(mx, __shfl_xor(mx, 4)); mx = fmaxf(mx, __shfl_xor(mx, 8));
      float sum = 0.f;
      for (int j = sub; j < BAND; j += 16) { const float e = expf(S[r * 577 + j] - mx); S[r * 577 + j] = e; sum += e; }
      sum += __shfl_xor(sum, 1); sum += __shfl_xor(sum, 2); sum += __shfl_xor(sum, 4); sum += __shfl_xor(sum, 8);
      const float inv = 1.0f / sum;
      for (int j = sub; j < BAND; j += 16) S[r * 577 + j] *= inv; }
    __syncthreads();
    { const int r = t >> 4, dg = t & 15; float acc[8];
#pragma unroll
      for (int i = 0; i < 8; ++i) acc[i] = 0.f;
      for (int j = 0; j < BAND; ++j) { const int kc = c - LOOKBACK + (j >> 6); if (kc < 0) continue;
          const float p = S[r * 577 + j]; float vv[8]; ld8bf(PROJ + (size_t)(b * SEQ + kc * 64 + (j & 63)) * EV_N + EC_VA + h * 128 + dg * 8, vv);
#pragma unroll
          for (int i = 0; i < 8; ++i) acc[i] += p * vv[i]; }
      const int tok = b * SEQ + c * 64 + quarter * 16 + r; float z[8]; ld8bf(PROJ + (size_t)tok * EV_N + EC_ZA + h * 128 + dg * 8, z);
      v4u o; o.x = pk2(acc[0] * siluf_(z[0]), acc[1] * siluf_(z[1])); o.y = pk2(acc[2] * siluf_(z[2]), acc[3] * siluf_(z[3]));
      o.z = pk2(acc[4] * siluf_(z[4]), acc[5] * siluf_(z[5])); o.w = pk2(acc[6] * siluf_(z[6]), acc[7] * siluf_(z[7]));
      if (active) *(v4u*)(Y + (size_t)tok * D_MODEL + h * 128 + dg * 8) = o; }
    __syncthreads();
}
__device__ __forceinline__ void vb_mlstm(const bf16_t* __restrict__ PROJ, const float* __restrict__ GIF, bf16_t* __restrict__ Y, int bid, int t, LAS float* sm  ) {
    LAS float* ks = sm; LAS float* qs = sm + 256; LAS float* part = sm + 512; LAS float* dpart = sm + 768;
    const int vs = bid & 3, h = (bid >> 2) & 3, b = bid >> 4, v = t & 63, kq = t >> 6;
    float C[64];
#pragma unroll
    for (int i = 0; i < 64; ++i) C[i] = 0.f;
    float nreg = 0.f;
    for (int s = 0; s < SEQ; ++s) {
        const size_t tok = (size_t)b * SEQ + s; const bf16_t* pr = PROJ + tok * EV_N;
        const float li = GIF[tok * 8 + h], fpre = GIF[tok * 8 + 4 + h];
        const float fw = sigmoidf_(fpre), iw = expf(li);
        const float kk = bf2f(pr[EC_KB + h * 256 + t]), qq = bf2f(pr[EC_QB + h * 256 + t]) * 0.0625f;
        const float vv = bf2f(pr[EC_VB + h * 256 + vs * 64 + v]);
        ks[t] = kk; qs[t] = qq;
        nreg = fw * nreg + iw * kk;
        float dp = nreg * qq; dp = wave_sum(dp);
        if ((t & 63) == 0) dpart[kq] = dp;
        __syncthreads();
        float np = 0.f; const float iv = iw * vv;
#pragma unroll
        for (int i = 0; i < 64; ++i) { C[i] = fw * C[i] + ks[kq * 64 + i] * iv; np += C[i] * qs[kq * 64 + i]; }
        part[kq * 64 + v] = np;
        __syncthreads();
        if (t < 64) { const float num = (part[t] + part[64 + t]) + (part[128 + t] + part[192 + t]); const float den = (dpart[0] + dpart[1]) + (dpart[2] + dpart[3]);
            const float hh = num / fmaxf(fabsf(den), 1.0f);
            const float ob = bf2f(pr[EC_OB + h * 256 + vs * 64 + t]), zb = bf2f(pr[EC_ZB + h * 256 + vs * 64 + t]);
            Y[tok * D_MODEL + W_A + h * 256 + vs * 64 + t] = (bf16_t)f2bf(sigmoidf_(ob) * hh * siluf_(zb)); }
        __syncthreads();
    }
}
__device__ __forceinline__ void phase_mix0(const Ptrs& P, LAS unsigned char* lds, int G) {
    const int w = blockIdx.x;
    constexpr int NML = BATCH * H_B * 4;
    if (w < NML) mlstm_item(P, lds, w);
    else { for (int item = w - NML; item < BATCH * H_A * (NCH / 2); item += G - NML) attn_item(P, lds, item); }
    { const int wave = threadIdx.x >> 6, lane = threadIdx.x & 63; late_weights(P, lds, wave, lane, w * NWAVES + wave, G * NWAVES); }
}
constexpr size_t WS_RA = WS_FREE1, WS_RINP = WS_XB, WS_Q2 = 4 * MiB, WS_K2 = 36 * MiB, WS_V2 = 465 * MiB;
__device__ __forceinline__ void vb_rglru_gates(const bf16_t* __restrict__ PROJ, const float* __restrict__ ccw, const float* __restrict__ ccb, const float* __restrict__ gw, const float* __restrict__ gb,
                                               const float* __restrict__ lam, float* __restrict__ A, float* __restrict__ INP, int bid, int t, LAS float* xs  ) {
    const int blk = bid & 7, tg = bid >> 3, c = blk * 128 + t;
    float xc[8];
#pragma unroll
    for (int i = 0; i < 8; ++i) { const int tok = tg * 8 + i, s = tok % SEQ; float a = ccb[c];
#pragma unroll
        for (int j = 0; j < 4; ++j) { const int sj = s - 3 + j; if (sj >= 0) a += ccw[j * W_C + c] * bf2f(PROJ[(size_t)(tok - 3 + j) * OD_N + OC_XC + c]); }
        xc[i] = a; xs[i * 128 + t] = a; }
    __syncthreads();
    float rp[8], ip[8];
#pragma unroll
    for (int i = 0; i < 8; ++i) { rp[i] = 0.f; ip[i] = 0.f; }
    const float* g0 = gw + (size_t)blk * 128 * 256;
    for (int k = 0; k < 128; ++k) { const float wr_ = g0[k * 256 + t], wi_ = g0[k * 256 + 128 + t];
#pragma unroll
        for (int i = 0; i < 8; ++i) { const float xv = xs[i * 128 + k]; rp[i] += xv * wr_; ip[i] += xv * wi_; } }
    const float sp = softplusf_(-lam[c]); const float gbr = gb[c], gbi = gb[W_C + c];
#pragma unroll
    for (int i = 0; i < 8; ++i) { const int tok = tg * 8 + i; const float r = sigmoidf_(rp[i] + gbr), ig = sigmoidf_(ip[i] + gbi);
        const float la = -8.0f * r * sp; A[(size_t)tok * W_C + c] = expf(la); INP[(size_t)tok * W_C + c] = sqrtf(-expm1f(2.0f * la)) * (ig * xc[i]); }
    __syncthreads();
}
__device__ __forceinline__ void vb_dn_prep(const bf16_t* __restrict__ PROJ, const float* __restrict__ cdw, bf16_t* __restrict__ Q2, bf16_t* __restrict__ K2, bf16_t* __restrict__ V2, int bid, int t, LAS float* red  ) {
    const int h = bid & 7, tok = bid >> 3, s = tok % SEQ; float o[3];
#pragma unroll
    for (int p = 0; p < 3; ++p) { const int col = p * W_D + h * 128 + t; float a = 0.f;
#pragma unroll
        for (int j = 0; j < 4; ++j) { const int sj = s - 3 + j; if (sj >= 0) a += cdw[j * 3 * W_D + col] * bf2f(PROJ[(size_t)(tok - 3 + j) * OD_N + OC_QD + col]); }
        o[p] = siluf_(a); }
    float sq = wave_sum(o[0] * o[0]), sk = wave_sum(o[1] * o[1]);
    if ((t & 63) == 0) { red[(t >> 6) * 2 + 0] = sq; red[(t >> 6) * 2 + 1] = sk; }
    __syncthreads();
    sq = red[0] + red[2]; sk = red[1] + red[3];
    const size_t o_ = (size_t)tok * W_D + h * 128 + t;
    Q2[o_] = (bf16_t)f2bf(o[0] * (1.0f / sqrtf(sq + EPS))); K2[o_] = (bf16_t)f2bf(o[1] * (1.0f / sqrtf(sk + EPS))); V2[o_] = (bf16_t)f2bf(o[2]);
    __syncthreads();
}
__device__ __forceinline__ void phase_mix1a(const Ptrs& P, LAS unsigned char* lds, int G) {
    for (int it = blockIdx.x; it < BATCH * H_D * NCH; it += G) dn1_item(P, lds, it);
}
__device__ __forceinline__ void phase_mix1b(const Ptrs& P, LAS unsigned char* lds, int G) {
    constexpr int ND2 = BATCH * H_D;
    if ((int)blockIdx.x < ND2) dn2_item(P, lds, blockIdx.x);
    else { for (int it = blockIdx.x - ND2; it < BATCH * N_BLK_C * 4; it += G - ND2) rglru_item(P, lds, it); }
}
typedef GAS unsigned gu32;
#define RLX_AGENT __ATOMIC_RELAXED, __HIP_MEMORY_SCOPE_AGENT
constexpr int CW_BAR = 4096;
static_assert((CW_BAR + XCD_BAR_WORDS) * 4 <= (int)CTL_ZERO_BYTES, "CTL words inside the memset region");
constexpr int LDS_BYTES = 163840;
constexpr int RING_OFF = 0, RING_BYTES = LDS_BYTES - 512;
constexpr int LDSCTL_OFF = RING_BYTES, MISC_OFF = LDSCTL_OFF + 320;

struct Args { Ptrs P; int ph_lo, ph_hi; };
constexpr int N_PHASES = 8;

__global__ void __launch_bounds__(NWAVES * 64, 2) fwd_mega(Args args) {
    extern __shared__ __attribute__((aligned(16))) unsigned char lds_raw[];
    LAS unsigned char* lds = (LAS unsigned char*)lds_raw;
    volatile LAS unsigned* MISC = (volatile LAS unsigned*)(lds + MISC_OFF);
    const int tid = threadIdx.x, lane = tid & 63, wave = __builtin_amdgcn_readfirstlane(tid >> 6);
    const int G = gridDim.x;
    for (int u = tid; u < (LDS_BYTES - LDSCTL_OFF) / 4; u += NWAVES * 64) ((LAS unsigned*)(lds + LDSCTL_OFF))[u] = 0u;
    __syncthreads();
    const Ptrs& P = args.P;
    gu32* ctl = (gu32*)(P.ws + WS_CTL);
    const int lo = args.ph_lo, hi = args.ph_hi;
    XcdBarrier bar; bar.bar = (unsigned*)(ctl + CW_BAR); bar.x = 0; bar.st = nullptr;
    if (hi - lo > 1) bar = xcd_barrier_post((unsigned*)(ctl + CW_BAR), MISC + 8);
#define IN(k) (lo <= (k) && (k) < hi)
#define SEAM(k) do { if (IN(k) && IN((k) + 1)) xcd_barrier(bar); } while (0)
#ifndef DUP_PHASE
#define DUP_PHASE -1
#endif
#define RUN(k) do { \
    if ((k) == 0) phase_prologue(P, lds, wave, lane, blockIdx.x * NWAVES + wave, G * NWAVES); \
    else if ((k) == 1) phase_gemm<1>(P, lds, G, blockIdx.x); \
    else if ((k) == 2) phase_mix0(P, lds, G); \
    else if ((k) == 3) phase_gemm<2>(P, lds, G, blockIdx.x); \
    else if ((k) == 4) { phase_gemm<3>(P, lds, G, blockIdx.x); phase_gates_ab(P, G); } \
    else if ((k) == 5) phase_mix1a(P, lds, G); \
    else if ((k) == 6) phase_mix1b(P, lds, G); \
    else phase_gemm<4>(P, lds, G, blockIdx.x); } while (0)
#define STEP(k) do { if (IN(k)) { RUN(k); if (DUP_PHASE == (k)) { xcd_barrier(bar); RUN(k); } \
        if ((k) == 2 && DUP_PHASE == 20) { xcd_barrier(bar); if (blockIdx.x >= 128) phase_mix0(P, lds, G); } \
        if ((k) == 2 && DUP_PHASE == 21) { xcd_barrier(bar); if (blockIdx.x < 128) phase_mix0(P, lds, G); } \
        if ((k) == 5 && DUP_PHASE == 50) { xcd_barrier(bar); for (int it_ = blockIdx.x; it_ < BATCH * N_BLK_C * 4; it_ += G) rglru_item(P, lds, it_); } \
        if ((k) == 5 && DUP_PHASE == 51) { xcd_barrier(bar); for (int it_ = blockIdx.x; it_ < BATCH * H_D * NCH; it_ += G) dn1_item(P, lds, it_); } \
        } SEAM(k); } while (0)
    STEP(0); STEP(1); STEP(2); STEP(3); STEP(4); STEP(5); STEP(6); STEP(7);
#undef STEP
#undef RUN
#undef IN
#undef SEAM
}
extern "C" void kernel_launch(void* const* d_in, const int* in_sizes, int n_in, void* d_out, int out_size, void* d_ws, size_t ws_size, hipStream_t stream) {
    static int grid = 0;
    if (grid == 0) {
        if (n_in != 20 || in_sizes[0] != M_TOK * D_MODEL || out_size != M_TOK * D_MODEL || ws_size < WS_END) {
            fprintf(stderr, "kernel_launch: unexpected shapes: n_in %d in0 %d out %d ws %zu (need %zu)\n", n_in, n_in > 0 ? in_sizes[0] : -1, out_size, ws_size, (size_t)WS_END); grid = -1; return; }
        int dev = 0, cus = 0, per_cu = 0;
        if (hipGetDevice(&dev) != hipSuccess || hipDeviceGetAttribute(&cus, hipDeviceAttributeMultiprocessorCount, dev) != hipSuccess) { grid = -1; return; }
        if (hipFuncSetAttribute((const void*)fwd_mega, hipFuncAttributeMaxDynamicSharedMemorySize, LDS_BYTES) != hipSuccess) { fprintf(stderr, "kernel_launch: hipFuncSetAttribute failed\n"); grid = -1; return; }
        if (hipOccupancyMaxActiveBlocksPerMultiprocessor(&per_cu, (const void*)fwd_mega, NWAVES * 64, LDS_BYTES) != hipSuccess || per_cu < 1) { fprintf(stderr, "kernel_launch: occupancy query says %d blocks per CU\n", per_cu); per_cu = 1; }
        (void)hipGetLastError();
        grid = cus;
    }
    if (grid < 0) return;
    if (hipMemsetAsync((char*)d_ws + WS_CTL, 0, CTL_ZERO_BYTES, stream) != hipSuccess) { fprintf(stderr, "kernel_launch: memset failed\n"); return; }
    Args a{};
    for (int i = 0; i < 20; ++i) a.P.in[i] = (const float*)d_in[i];
    a.P.out = (float*)d_out; a.P.ws = (unsigned char*)d_ws; a.ph_lo = 0; a.ph_hi = N_PHASES;
    hipLaunchKernelGGL(fwd_mega, dim3(grid), dim3(NWAVES * 64), LDS_BYTES, stream, a);
    const hipError_t le = hipPeekAtLastError();
    if (le != hipSuccess) fprintf(stderr, "kernel_launch: launch failed: %s\n", hipGetErrorName(le));
}
```

```cpp
#include <hip/hip_runtime.h>
#include <cstdio>
#include <cstdint>
#include <cmath>

constexpr int D_MODEL = 2048, BATCH = 8, SEQ = 2048, M_TOK = BATCH * SEQ;
constexpr int CHUNK = 64, NCH = SEQ / CHUNK;
constexpr float EPS = 1e-6f;
constexpr int HD_A = 128, W_A = 1024, H_A = 8, LOOKBACK = 8, BAND = (LOOKBACK + 1) * CHUNK, REL_MAX = 256, NREL = 2 * REL_MAX + 1;
constexpr int H_B = 4, W_B = 1024, HD_B = 256;
constexpr int W_C = 1024, N_BLK_C = 8, BLK_C = 128;
constexpr int HD_D = 128, W_D = 1024, H_D = 8;
constexpr int EV_IN = 9224, EV_N = 9216;
constexpr int OD_IN = 6160, OD_N = 6144;
constexpr int EC_QA = 0, EC_KA = 1024, EC_VA = 2048, EC_ZA = 3072, EC_QB = 4096, EC_KB = 5120, EC_VB = 6144, EC_OB = 7168, EC_ZB = 8192;
constexpr int OC_XC = 0, OC_ZC = 1024, OC_QD = 2048, OC_KD = 3072, OC_VD = 4096, OC_ZD = 5120;

constexpr size_t MiB = 1u << 20;
constexpr size_t WS_CTL = 0, CTL_ZERO_BYTES = 1 * MiB;
constexpr size_t WS_R0 = 1 * MiB;
constexpr size_t WS_SS1 = WS_R0 + 64 * 1024;
constexpr size_t WS_GIF = WS_SS1 + 64 * 1024;
constexpr size_t WS_AB = WS_GIF + 512 * 1024;
constexpr size_t WS_W1T = 4 * MiB;
constexpr size_t WS_W2T = 40 * MiB;
constexpr size_t WS_W3T = 48 * MiB;
constexpr size_t WS_W4T = 73 * MiB;
constexpr size_t WS_XB = 81 * MiB;
constexpr size_t WS_Y = 145 * MiB;
constexpr size_t WS_PROJ = 209 * MiB;
constexpr size_t WS_END = 497 * MiB;
constexpr size_t WS_FREE1 = 401 * MiB;

typedef unsigned short bf16_t;
__device__ __forceinline__ float bf2f(unsigned short v) { return __builtin_bit_cast(float, (unsigned)v << 16); }
__device__ __forceinline__ unsigned f2bf(float f) { unsigned u = __builtin_bit_cast(unsigned, f); return (u + 0x7fffu + ((u >> 16) & 1u)) >> 16; }
typedef float f32x2_t_ __attribute__((ext_vector_type(2))); typedef __bf16 bf16x2_t_ __attribute__((ext_vector_type(2)));
__device__ __forceinline__ unsigned pk2(float lo, float hi) { const f32x2_t_ v = {lo, hi}; return __builtin_bit_cast(unsigned, __builtin_convertvector(v, bf16x2_t_)); }
__device__ __forceinline__ float sigmoidf_(float x) { return 1.f / (1.f + expf(-x)); }
__device__ __forceinline__ float siluf_(float x) { return x / (1.f + expf(-x)); }
__device__ __forceinline__ float softplusf_(float x) { return fmaxf(x, 0.f) + log1pf(expf(-fabsf(x))); }
__device__ __forceinline__ float logsigmoidf_(float x) { return -softplusf_(-x); }

namespace pg8 {
#define PG8_LAS __attribute__((address_space(3)))
typedef unsigned short bf16_t;
typedef short bf16x8 __attribute__((ext_vector_type(8)));
typedef float f32x4 __attribute__((ext_vector_type(4)));
typedef unsigned u32x4 __attribute__((ext_vector_type(4)));
constexpr int BM = 256, BK = 64, HALF = 128, HTB = HALF * BK * 2  , STAGE_BYTES = 8 * HTB, NXCD = 8, WGM = 4;

__host__ __device__ __forceinline__ int lds_byte(int r, int c) { const int st = (r >> 4) * 2 + (c >> 5), rr = r & 15, cc = c & 31, ob = rr * 64 + cc * 2; return st * 1024 + (ob ^ (((ob >> 9) & 1) << 5)); }
__host__ __device__ __forceinline__ void stage_rc(int b, int& R, int& C) { const int st = b / 1024, sb = b % 1024, swz = sb ^ (((sb >> 9) & 1) << 5); R = (st >> 1) * 16 + swz / 64; C = (st & 1) * 32 + (swz % 64) / 2; }
__host__ __device__ __forceinline__ int perm32(int rho) { const int n = rho >> 4, i = rho & 15; return 8 * (i >> 2) + 4 * n + (i & 3); }

struct Unit { int pm, pn; };
struct Gemm { const bf16_t* A; const bf16_t* Bt; int M, N, K; };

struct StaticOrder {
    int nM, nN, nwg, G, c;
    __host__ __device__ void init(int M, int N, int G_, int c_) { nM = M / BM; nN = N / BM; nwg = nM * nN; G = G_; c = c_; }
    __host__ __device__ bool next(int i, Unit& u) const {
        const long L = (long)i * G + c; if (L >= nwg) return false;
        int wgid = (int)L; { const int q = nwg / NXCD, r = nwg % NXCD, xcd = wgid % NXCD, off = wgid / NXCD; wgid = (xcd < r ? xcd * (q + 1) : r * (q + 1) + (xcd - r) * q) + off; }
        const int nig = WGM * nN, gid = wgid / nig, fm = gid * WGM, gsz = (nM - fm) < WGM ? (nM - fm) : WGM;
        u.pm = fm + ((wgid % nig) % gsz); u.pn = (wgid % nig) / gsz; return true;
    }
    __device__ __forceinline__ void a_ready(const Unit&) const {}
    __device__ __forceinline__ void done(const Unit&) const {}
};

__device__ __forceinline__ unsigned cvt_pk_bf16(float lo, float hi) { unsigned r; asm volatile("v_cvt_pk_bf16_f32 %0, %1, %2" : "=v"(r) : "v"(lo), "v"(hi)); return r; }
struct EpiProj {
    static constexpr bool PERM = true, AFTER_DRAIN = false;
    bf16_t* O; int ldc; const float* rowv; int mode;
    __device__ __forceinline__ void operator()(const f32x4 (&acc)[2][2][4][2], const Unit& u, int wr, int wc, int fr, int fq) const {
        const int row0 = u.pm * BM + wr * 64 + fr; const int col0 = u.pn * BM + wc * 32 + 8 * fq;
#pragma unroll
        for (int ai = 0; ai < 2; ++ai)
#pragma unroll
            for (int m = 0; m < 4; ++m) { const int row = row0 + ai * HALF + m * 16; float sc = rowv[row]; if (mode) sc = 1.0f / sqrtf(sc * (1.0f / 2048.0f) + 1e-6f);
                bf16_t* rowp = O + (size_t)row * ldc + col0;
#pragma unroll
                for (int bj = 0; bj < 2; ++bj) { const f32x4 v0 = acc[ai][bj][m][0] * sc, v1 = acc[ai][bj][m][1] * sc;
                    u32x4 w; w.x = cvt_pk_bf16(v0[0], v0[1]); w.y = cvt_pk_bf16(v0[2], v0[3]); w.z = cvt_pk_bf16(v1[0], v1[1]); w.w = cvt_pk_bf16(v1[2], v1[3]);
                    *(u32x4*)(rowp + bj * HALF) = w; } }
    }
};
struct EpiRes {
    static constexpr bool PERM = false, AFTER_DRAIN = false;
    const float* base; float* out; bf16_t* xb; float* sumsq; int ldc;
    __device__ __forceinline__ void operator()(const f32x4 (&acc)[2][2][4][2], const Unit& u, int wr, int wc, int fr, int fq) const {
        typedef unsigned u32x2v __attribute__((ext_vector_type(2)));
        const int col0 = u.pn * BM + wc * 32 + 4 * fq;
#pragma unroll
        for (int ai = 0; ai < 2; ++ai)
#pragma unroll
            for (int m = 0; m < 4; ++m) { const int row = u.pm * BM + ai * HALF + wr * 64 + m * 16 + fr; const size_t off = (size_t)row * ldc + col0; float ss = 0.f;
#pragma unroll
                for (int bj = 0; bj < 2; ++bj)
#pragma unroll
                    for (int n = 0; n < 2; ++n) { const f32x4 o = *(const f32x4*)(base + off + bj * HALF + n * 16) + acc[ai][bj][m][n];
                        *(f32x4*)(out + off + bj * HALF + n * 16) = o;
                        if (xb) { u32x2v w; w.x = cvt_pk_bf16(o[0], o[1]); w.y = cvt_pk_bf16(o[2], o[3]); *(u32x2v*)(xb + off + bj * HALF + n * 16) = w; }
                        ss += (o[0] * o[0] + o[1] * o[1]) + (o[2] * o[2] + o[3] * o[3]); }
                if (sumsq) { ss += __shfl_xor(ss, 16); ss += __shfl_xor(ss, 32); if (fq == 0) atomicAdd(sumsq + row, ss); } }
    }
};

template <class Epi, class Sched, bool ALIGN_EPI = false, bool SP2 = false>
__device__ __forceinline__ void gemm_phase(PG8_LAS unsigned char* lds, const Gemm g, const Sched& S, const Epi& E) {
    const int tid = threadIdx.x, wid = __builtin_amdgcn_readfirstlane(tid >> 6), lane = tid & 63, wr = wid >> 2, wc = wid & 3, fr = lane & 15, fq = lane >> 4;
    const int K = g.K, nt = K / BK;
    unsigned voffA[2], voffB[2];
#pragma unroll
    for (int i = 0; i < 2; ++i) { int R, C; stage_rc(tid * 16 + i * 8192, R, C); const int Rb = Epi::PERM ? ((R & ~31) + perm32(R & 31)) : R;
        voffA[i] = (unsigned)(R * K + C) * 2u; voffB[i] = (unsigned)(Rb * K + C) * 2u; }
    const size_t kstep = (size_t)(BK * 2);
    const size_t hstep = (size_t)HALF * K * 2;
    const size_t tstep = 2 * hstep;
    const unsigned ldsw = (unsigned)wid * 1024u;
    const int aoff = lds_byte(wr * 64 + fr, fq * 8), boff = lds_byte(wc * 32 + fr, fq * 8);
#define PG8_SA(b, h) (((b) * 2 + (h)) * HTB)
#define PG8_SB(b, h) ((4 + (b) * 2 + (h)) * HTB)
#define PG8_STAGE(bufoff, gbase, voff) do { _Pragma("unroll") for (int _i = 0; _i < 2; ++_i) \
        __builtin_amdgcn_global_load_lds((const unsigned*)((const char*)(gbase) + (voff)[_i]), (PG8_LAS unsigned*)(lds + (bufoff) + ldsw + _i * 8192), 16, 0, 0); } while (0)
#define PG8_LDA(dst, b, h) do { _Pragma("unroll") for (int m = 0; m < 4; ++m) _Pragma("unroll") for (int k = 0; k < 2; ++k) dst[m][k] = *(const PG8_LAS bf16x8*)(lds + PG8_SA(b, h) + aoff + m * 2048 + k * 1024); } while (0)
#define PG8_LDB(dst, b, h) do { _Pragma("unroll") for (int n = 0; n < 2; ++n) _Pragma("unroll") for (int k = 0; k < 2; ++k) dst[n][k] = *(const PG8_LAS bf16x8*)(lds + PG8_SB(b, h) + boff + n * 2048 + k * 1024); } while (0)
#define PG8_MMA(ai, bj, At, Bt) do { __builtin_amdgcn_s_setprio(1); _Pragma("unroll") for (int m = 0; m < 4; ++m) _Pragma("unroll") for (int n = 0; n < 2; ++n) _Pragma("unroll") for (int k = 0; k < 2; ++k) \
        acc[ai][bj][m][n] = __builtin_amdgcn_mfma_f32_16x16x32_bf16(Bt[n][k], At[m][k], acc[ai][bj][m][n], 0, 0, 0); __builtin_amdgcn_s_setprio(0); } while (0)
#define PG8_WAIT_V(n) asm volatile("s_waitcnt vmcnt(" #n ")" ::: "memory")
#define PG8_WAIT_L(n) asm volatile("s_waitcnt lgkmcnt(" #n ")" ::: "memory")
#define PG8_BAR __builtin_amdgcn_s_barrier()
#define PG8_SCHED __builtin_amdgcn_sched_barrier(0)
    Unit cur, nxt; int ui = 0;
    if (!S.next(0, cur)) return;
    f32x4 acc[2][2][4][2];
#pragma unroll
    for (int a = 0; a < 2; ++a)
#pragma unroll
        for (int b = 0; b < 2; ++b)
#pragma unroll
            for (int m = 0; m < 4; ++m)
#pragma unroll
                for (int n = 0; n < 2; ++n) acc[a][b][m][n] = (f32x4){0.f, 0.f, 0.f, 0.f};
    bf16x8 At[4][2], B0[2][2], B1[2][2];
    const char* cA = (const char*)g.A + (size_t)cur.pm * tstep; const char* cB = (const char*)g.Bt + (size_t)cur.pn * tstep;
    S.a_ready(cur);
    if constexpr (SP2) {
        PG8_STAGE(PG8_SB(0, 0), cB, voffB); PG8_STAGE(PG8_SB(0, 1), cB + hstep, voffB); PG8_STAGE(PG8_SA(0, 0), cA, voffA); PG8_STAGE(PG8_SA(0, 1), cA + hstep, voffA);
        if (wr == 1) PG8_BAR;
        PG8_WAIT_V(2); PG8_BAR;
        PG8_STAGE(PG8_SB(1, 0), cB + kstep, voffB); PG8_STAGE(PG8_SA(1, 0), cA + kstep, voffA); PG8_STAGE(PG8_SB(1, 1), cB + hstep + kstep, voffB);
        PG8_WAIT_V(6); PG8_BAR;
    } else {
        PG8_STAGE(PG8_SB(0, 0), cB, voffB); PG8_STAGE(PG8_SA(0, 0), cA, voffA); PG8_STAGE(PG8_SB(0, 1), cB + hstep, voffB); PG8_STAGE(PG8_SA(0, 1), cA + hstep, voffA);
        if (wr == 1) PG8_BAR;
        PG8_WAIT_V(4); PG8_BAR;
        PG8_STAGE(PG8_SB(1, 0), cB + kstep, voffB); PG8_STAGE(PG8_SA(1, 0), cA + kstep, voffA); PG8_STAGE(PG8_SB(1, 1), cB + hstep + kstep, voffB);
        PG8_WAIT_V(6); PG8_BAR;
    }
    for (;;) {
        const bool has_next = S.next(ui + 1, nxt);
        const char* nA = has_next ? (const char*)g.A + (size_t)nxt.pm * tstep : cA; const char* nB = has_next ? (const char*)g.Bt + (size_t)nxt.pn * tstep : cB;
        for (int t = 0; t < nt; t += 2) {
            const bool last = (t == nt - 2);
            const char* a1 = cA + (size_t)(t + 1) * kstep;
            const char* a2 = last ? nA : cA + (size_t)(t + 2) * kstep; const char* b2 = last ? nB : cB + (size_t)(t + 2) * kstep;
            const char* a3 = a2 + kstep; const char* b3 = b2 + kstep;
            if (last && has_next) S.a_ready(nxt);
            if constexpr (SP2) {
            PG8_LDB(B0, 0, 0); PG8_LDB(B1, 0, 1); PG8_SCHED; PG8_LDA(At, 0, 0); PG8_STAGE(PG8_SA(1, 1), a1 + hstep, voffA);
            PG8_WAIT_V(8); PG8_WAIT_L(0); PG8_BAR; PG8_MMA(0, 0, At, B0); PG8_MMA(0, 1, At, B1); PG8_BAR; PG8_SCHED;
            PG8_LDA(At, 0, 1); PG8_STAGE(PG8_SB(0, 0), b2, voffB); PG8_STAGE(PG8_SB(0, 1), b2 + hstep, voffB); PG8_STAGE(PG8_SA(0, 0), a2, voffA);
            PG8_WAIT_V(8); PG8_WAIT_L(0); PG8_BAR; PG8_MMA(1, 0, At, B0); PG8_MMA(1, 1, At, B1); PG8_BAR; PG8_SCHED;
            PG8_LDB(B0, 1, 0); PG8_LDB(B1, 1, 1); PG8_SCHED; PG8_LDA(At, 1, 0); PG8_STAGE(PG8_SA(0, 1), a2 + hstep, voffA);
            PG8_WAIT_V(8); PG8_WAIT_L(0); PG8_BAR; PG8_MMA(0, 0, At, B0); PG8_MMA(0, 1, At, B1); PG8_BAR; PG8_SCHED;
            PG8_LDA(At, 1, 1); PG8_STAGE(PG8_SB(1, 0), b3, voffB); PG8_STAGE(PG8_SB(1, 1), b3 + hstep, voffB); PG8_STAGE(PG8_SA(1, 0), a3, voffA);
            PG8_WAIT_V(8); PG8_WAIT_L(0); PG8_BAR; PG8_MMA(1, 0, At, B0); PG8_MMA(1, 1, At, B1); PG8_BAR; PG8_SCHED;
            } else {
            PG8_LDB(B0, 0, 0); PG8_SCHED; PG8_LDA(At, 0, 0); PG8_STAGE(PG8_SA(1, 1), a1 + hstep, voffA);
            PG8_WAIT_L(8); PG8_BAR; PG8_WAIT_L(0); PG8_MMA(0, 0, At, B0); PG8_BAR; PG8_SCHED;
            PG8_LDB(B1, 0, 1); PG8_STAGE(PG8_SB(0, 0), b2, voffB);
            PG8_BAR; PG8_WAIT_L(0); PG8_MMA(0, 1, At, B1); PG8_BAR;
            PG8_LDA(At, 0, 1); PG8_STAGE(PG8_SA(0, 0), a2, voffA);
            PG8_BAR; PG8_WAIT_L(0); PG8_MMA(1, 0, At, B0); PG8_BAR; PG8_SCHED;
            PG8_STAGE(PG8_SB(0, 1), b2 + hstep, voffB);
            PG8_WAIT_V(6); PG8_BAR; PG8_MMA(1, 1, At, B1); PG8_BAR;
            PG8_LDB(B0, 1, 0); PG8_SCHED; PG8_LDA(At, 1, 0); PG8_STAGE(PG8_SA(0, 1), a2 + hstep, voffA);
            PG8_WAIT_L(8); PG8_BAR; PG8_WAIT_L(0); PG8_MMA(0, 0, At, B0); PG8_BAR; PG8_SCHED;
            PG8_LDB(B1, 1, 1); PG8_STAGE(PG8_SB(1, 0), b3, voffB);
            PG8_BAR; PG8_WAIT_L(0); PG8_MMA(0, 1, At, B1); PG8_BAR;
            PG8_LDA(At, 1, 1); PG8_STAGE(PG8_SA(1, 0), a3, voffA);
            PG8_BAR; PG8_WAIT_L(0); PG8_MMA(1, 0, At, B0); PG8_BAR; PG8_SCHED;
            PG8_STAGE(PG8_SB(1, 1), b3 + hstep, voffB);
            PG8_WAIT_V(6); PG8_BAR; PG8_MMA(1, 1, At, B1); PG8_BAR;
            }
        }
        if constexpr (ALIGN_EPI) { if (wr == 0) PG8_BAR; }
        if constexpr (!Epi::AFTER_DRAIN) { E(acc, cur, wr, wc, fr, fq); S.done(cur); }
        if (!has_next) break;
#pragma unroll
        for (int a = 0; a < 2; ++a)
#pragma unroll
            for (int b = 0; b < 2; ++b)
#pragma unroll
                for (int m = 0; m < 4; ++m)
#pragma unroll
                    for (int n = 0; n < 2; ++n) acc[a][b][m][n] = (f32x4){0.f, 0.f, 0.f, 0.f};
        cur = nxt; cA = nA; cB = nB; ++ui;
        if constexpr (ALIGN_EPI) { if (wr == 1) PG8_BAR; }
    }
    PG8_WAIT_V(0);
    if constexpr (!ALIGN_EPI) { if (wr == 0) PG8_BAR; }
    PG8_BAR;
    if constexpr (Epi::AFTER_DRAIN) { E.fused(acc, cur, wr, wc, fr, fq, lds, wid, lane); S.done(cur); }
#undef PG8_SA
#undef PG8_SB
#undef PG8_STAGE
#undef PG8_LDA
#undef PG8_LDB
#undef PG8_MMA
#undef PG8_WAIT_V
#undef PG8_WAIT_L
#undef PG8_BAR
#undef PG8_SCHED
}
}
#define GAS __attribute__((address_space(1)))
#define LAS __attribute__((address_space(3)))
typedef unsigned v4u __attribute__((ext_vector_type(4)));
typedef float f32x4 __attribute__((ext_vector_type(4)));
#define LDS_WAIT() asm volatile("s_waitcnt lgkmcnt(0)" ::: "memory")
constexpr int NWAVES = 8;
constexpr int GEMM_LDS = 131072;

struct Ptrs {
    const float* in[20]; float* out; unsigned char* ws;
};
#define IN_X 0
#define IN_EV_NORM 1
#define IN_EV_WIN 2
#define IN_EV_IFB 3
#define IN_EV_QNG 4
#define IN_EV_KNG 5
#define IN_EV_REL 6
#define IN_EV_WOUT 7
#define IN_OD_NORM 8
#define IN_OD_WIN 9
#define IN_OD_CCW 10
#define IN_OD_CCB 11
#define IN_OD_GW 12
#define IN_OD_GB 13
#define IN_OD_LAM 14
#define IN_OD_CDW 15
#define IN_OD_ALOG 16
#define IN_OD_DTB 17
#define IN_OD_ONORM 18
#define IN_OD_WOUT 19

__device__ __forceinline__ float frsq_(float x) { return __builtin_amdgcn_rsqf(x); }
__device__ __forceinline__ float wave_sum(float v) {
#pragma unroll
    for (int o = 1; o < 64; o <<= 1) v += __shfl_xor(v, o);
    return v;
}
struct TrItem { const float* W; const float* gain; bf16_t* WT; int ldw, nblk, item; };
__device__ __forceinline__ void p0_tr_load(const TrItem& t, float (&r)[32], int lane) {
    const int kb = t.item / t.nblk, nb = t.item % t.nblk, k0 = 64 * kb, n0 = 32 * nb;
#pragma unroll
    for (int i = 0; i < 32; ++i) { const int kk = 2 * i + (lane >> 5); r[i] = t.W[(size_t)(k0 + kk) * t.ldw + n0 + (lane & 31)]; }
}
__device__ __forceinline__ void p0_tr_store(const TrItem& t, const float (&r)[32], LAS float* scr, int lane) {
    const int kb = t.item / t.nblk, nb = t.item % t.nblk, k0 = 64 * kb, n0 = 32 * nb; constexpr int K = D_MODEL;
#pragma unroll
    for (int i = 0; i < 32; ++i) { const int kk = 2 * i + (lane >> 5); const float g = t.gain ? t.gain[k0 + kk] : 1.0f; scr[kk * 33 + (lane & 31)] = g * r[i]; }
    LDS_WAIT(); asm volatile("" ::: "memory");
    const int c = lane & 7;
#pragma unroll
    for (int j = 0; j < 4; ++j) { const int n = (lane >> 3) + 8 * j; const LAS float* s = scr + (8 * c) * 33 + n;
        v4u o; o.x = pk2(s[0 * 33], s[1 * 33]); o.y = pk2(s[2 * 33], s[3 * 33]); o.z = pk2(s[4 * 33], s[5 * 33]); o.w = pk2(s[6 * 33], s[7 * 33]);
        *(GAS v4u*)(t.WT + (size_t)(n0 + n) * K + k0 + 8 * c) = o; }
    LDS_WAIT(); asm volatile("" ::: "memory");
}
__device__ __forceinline__ void p0_transposes(const Ptrs& P, LAS float* scr, int lane, int gw, int NGW, int it0, int it1) {
    unsigned char* ws = P.ws;
    bf16_t* W1T = (bf16_t*)(ws + WS_W1T); bf16_t* W2T = (bf16_t*)(ws + WS_W2T); bf16_t* W3T = (bf16_t*)(ws + WS_W3T); bf16_t* W4T = (bf16_t*)(ws + WS_W4T);
    constexpr int I1 = (D_MODEL / 64) * (EV_N / 32), I2 = (D_MODEL / 64) * (D_MODEL / 32), I3 = (D_MODEL / 64) * (OD_N / 32);
    auto mk = [&](int it) { TrItem t; int r = it;
        if (r < I1) { t = TrItem{P.in[IN_EV_WIN], P.in[IN_EV_NORM], W1T, EV_IN, EV_N / 32, r}; return t; } r -= I1;
        if (r < I2) { t = TrItem{P.in[IN_EV_WOUT], nullptr, W2T, D_MODEL, D_MODEL / 32, r}; return t; } r -= I2;
        if (r < I3) { t = TrItem{P.in[IN_OD_WIN], P.in[IN_OD_NORM], W3T, OD_IN, OD_N / 32, r}; return t; } r -= I3;
        t = TrItem{P.in[IN_OD_WOUT], nullptr, W4T, D_MODEL, D_MODEL / 32, r}; return t; };
    float ra[32], rb[32]; int it = it0 + gw;
    if (it < it1) { TrItem ta = mk(it); p0_tr_load(ta, ra, lane);
        for (;;) { const int itb = it + NGW; TrItem tb = ta; const bool hb = itb < it1; if (hb) { tb = mk(itb); p0_tr_load(tb, rb, lane); }
            p0_tr_store(ta, ra, scr, lane); if (!hb) break;
            const int itc = itb + NGW; const bool hc = itc < it1; if (hc) { ta = mk(itc); p0_tr_load(ta, ra, lane); }
            p0_tr_store(tb, rb, scr, lane); if (!hc) break; it = itc; } }
}
constexpr int TR_I1 = (D_MODEL / 64) * (EV_N / 32), TR_ALL = TR_I1 + 2 * (D_MODEL / 64) * (D_MODEL / 32) + (D_MODEL / 64) * (OD_N / 32);
__device__ __forceinline__ void late_weights(const Ptrs& P, LAS unsigned char* lds, int wave, int lane, int gw, int NGW) {
    p0_transposes(P, (LAS float*)(lds + wave * 16384), lane, gw, NGW, TR_I1, TR_ALL);
    bf16_t* W3T = (bf16_t*)(P.ws + WS_W3T); const int gt = gw * 64 + lane, NT = NGW * 64;
    for (int e = gt; e < 16 * D_MODEL; e += NT) { const int j = e / D_MODEL, k = e % D_MODEL; W3T[(size_t)(OD_N + j) * D_MODEL + k] = (bf16_t)f2bf(P.in[IN_OD_NORM][k] * P.in[IN_OD_WIN][(size_t)k * OD_IN + OD_N + j]); }
}
__device__ __forceinline__ void phase_prologue(const Ptrs& P, LAS unsigned char* lds, int wave, int lane, int gw, int NGW) {
    unsigned char* ws = P.ws;
    bf16_t* W1T = (bf16_t*)(ws + WS_W1T); bf16_t* W2T = (bf16_t*)(ws + WS_W2T); bf16_t* W3T = (bf16_t*)(ws + WS_W3T); bf16_t* W4T = (bf16_t*)(ws + WS_W4T);
    bf16_t* XB = (bf16_t*)(ws + WS_XB); float* R0 = (float*)(ws + WS_R0); float* SS1 = (float*)(ws + WS_SS1); float* GIF = (float*)(ws + WS_GIF);
    LAS float* scr = (LAS float*)(lds + wave * 16384);
    p0_transposes(P, scr, lane, gw, NGW, 0, TR_I1);
    { const int gt = gw * 64 + lane, NT = NGW * 64;
      for (int e = gt; e < M_TOK; e += NT) SS1[e] = 0.f; }
    __syncthreads();
    LAS float* G8 = (LAS float*)lds;
#pragma unroll 8
    for (int e = threadIdx.x; e < D_MODEL * 8; e += NWAVES * 64) { const int k = e >> 3, j = e & 7; G8[e] = P.in[IN_EV_NORM][k] * P.in[IN_EV_WIN][(size_t)k * EV_IN + EV_N + j]; }
    __syncthreads();
    const float* X = P.in[IN_X];
    f32x4 vnx[8];
    if (gw < M_TOK) { const GAS f32x4* xr0 = (const GAS f32x4*)(X + (size_t)gw * D_MODEL) + lane;
#pragma unroll
        for (int j = 0; j < 8; ++j) vnx[j] = xr0[64 * j]; }
    for (int m = gw; m < M_TOK; m += NGW) {
        float s = 0.f;
        GAS unsigned long long* o8 = (GAS unsigned long long*)(XB + (size_t)m * D_MODEL) + lane;
        f32x4 v[8];
#pragma unroll
        for (int j = 0; j < 8; ++j) v[j] = vnx[j];
        if (m + NGW < M_TOK) { const GAS f32x4* xr1 = (const GAS f32x4*)(X + (size_t)(m + NGW) * D_MODEL) + lane;
#pragma unroll
            for (int j = 0; j < 8; ++j) vnx[j] = xr1[64 * j]; }
#pragma unroll
        for (int j = 0; j < 8; ++j) { s += (v[j].x * v[j].x + v[j].y * v[j].y) + (v[j].z * v[j].z + v[j].w * v[j].w);
            o8[64 * j] = (unsigned long long)pk2(v[j].x, v[j].y) | ((unsigned long long)pk2(v[j].z, v[j].w) << 32); }
        const float r0 = frsq_(wave_sum(s) * (1.0f / D_MODEL) + EPS);
        float g[8];
#pragma unroll
        for (int i = 0; i < 8; ++i) g[i] = 0.f;
#pragma unroll
        for (int j = 0; j < 8; ++j) {
#pragma unroll
            for (int e = 0; e < 4; ++e) { const int k = 4 * lane + 256 * j + e; const f32x4 ga = *(const LAS f32x4*)(G8 + k * 8), gb = *(const LAS f32x4*)(G8 + k * 8 + 4); const float xv = v[j][e];
                g[0] += xv * ga.x; g[1] += xv * ga.y; g[2] += xv * ga.z; g[3] += xv * ga.w; g[4] += xv * gb.x; g[5] += xv * gb.y; g[6] += xv * gb.z; g[7] += xv * gb.w; }
            asm volatile("" : "+v"(g[0]), "+v"(g[1]), "+v"(g[2]), "+v"(g[3]), "+v"(g[4]), "+v"(g[5]), "+v"(g[6]), "+v"(g[7]) :: "memory");
        }
#pragma unroll
        for (int i = 0; i < 8; ++i) g[i] = wave_sum(g[i]);
        if (lane == 0) R0[m] = r0;
        if (lane < 8) { float gv = g[0];
#pragma unroll
            for (int i = 1; i < 8; ++i) gv = (lane == i) ? g[i] : gv;
            GIF[(size_t)m * 8 + lane] = r0 * gv + P.in[IN_EV_IFB][lane]; }
    }
}

#define XB_TMO      128
#define XB_XCNT(j)  (256  + 64 * (j))
#define XB_XSUB(j)  (1280 + 64 * (j))
#define XB_XGEN(j)  (2304 + 64 * (j))
#define XB_TOP      3328
#define XB_TOPGEN   3392
#define XCD_BAR_WORDS 3456
#define XB_SPIN_CAP (1u << 18)

__device__ __forceinline__ unsigned xb_ld(unsigned* p)              { return __hip_atomic_load(p, __ATOMIC_RELAXED, __HIP_MEMORY_SCOPE_AGENT); }
__device__ __forceinline__ unsigned xb_add(unsigned* p, unsigned v) { return __hip_atomic_fetch_add(p, v, __ATOMIC_RELAXED, __HIP_MEMORY_SCOPE_AGENT); }
__device__ __forceinline__ unsigned xb_xcc_id() { return (unsigned)__builtin_amdgcn_s_getreg((3 << 11) | 20) & 0xFu; }
#define XB_SPIN(cond, bar) do { unsigned _sp = 0; while (cond) { __builtin_amdgcn_s_sleep(1); \
    if ((++_sp & 255u) == 0u) { if (xb_ld(&(bar)[XB_TMO])) break; if (_sp > XB_SPIN_CAP) { atomicAdd(&(bar)[XB_TMO], 1u); break; } } } } while (0)

struct XcdBarrier {
    unsigned* bar; unsigned x;
    volatile LAS unsigned* st;
};

__device__ __forceinline__ XcdBarrier xcd_barrier_post(unsigned* bar, volatile LAS unsigned* st) {
    XcdBarrier b; b.bar = bar; b.x = xb_xcc_id(); b.st = st;
    if (threadIdx.x == 0) (void)xb_add(&bar[XB_XCNT(b.x)], 1u);
    return b;
}
__device__ __forceinline__ void xcd_barrier_complete(unsigned* bar, unsigned x, unsigned& nloc, unsigned& nx) {
    const unsigned G = gridDim.x * gridDim.y * gridDim.z;
    unsigned sum, cnt, mine, sp = 0u;
    for (;;) {
        sum = 0u; cnt = 0u; mine = 0u;
#pragma unroll
        for (unsigned j = 0; j < 16; ++j) { const unsigned c = xb_ld(&bar[XB_XCNT(j)]); sum += c; cnt += (c > 0u) ? 1u : 0u; mine = (j == x) ? c : mine; }
        if (sum == G) break;
        __builtin_amdgcn_s_sleep(1);
        if ((++sp & 255u) == 0u) { if (xb_ld(&bar[XB_TMO])) break; if (sp > XB_SPIN_CAP) { atomicAdd(&bar[XB_TMO], 1u); break; } }
    }
    nloc = mine > 0u ? mine : 1u; nx = cnt > 0u ? cnt : 1u;
}

__device__ __forceinline__ void xcd_barrier(const XcdBarrier& b) {
    asm volatile("s_waitcnt vmcnt(0)" ::: "memory");
    __syncthreads();
    if (threadIdx.x == 0) {
        unsigned* bar = b.bar;
        __builtin_amdgcn_s_waitcnt(0);
        unsigned nloc = b.st[0], nx = b.st[1];
        if (nloc == 0u) { xcd_barrier_complete(bar, b.x, nloc, nx); b.st[0] = nloc; b.st[1] = nx; }
        const unsigned old = xb_add(&bar[XB_XSUB(b.x)], 1u);
        const unsigned gen = old / nloc;
        if (old + 1u == (gen + 1u) * nloc) {
            __builtin_amdgcn_fence(__ATOMIC_RELEASE, "agent");
            asm volatile("s_waitcnt vmcnt(0)" ::: "memory");
            const unsigned og = xb_add(&bar[XB_TOP], 1u);
            const unsigned tg = og / nx;
            if (og + 1u == (tg + 1u) * nx) xb_add(&bar[XB_TOPGEN], 1u);
            else XB_SPIN(xb_ld(&bar[XB_TOPGEN]) == tg, bar);
            __builtin_amdgcn_fence(__ATOMIC_ACQUIRE, "agent");
            xb_add(&bar[XB_XGEN(b.x)], 1u);
            asm volatile("s_waitcnt vmcnt(0)" ::: "memory");
        } else {
            XB_SPIN(xb_ld(&bar[XB_XGEN(b.x)]) == gen, bar);
            __builtin_amdgcn_fence(__ATOMIC_ACQUIRE, "agent");
            asm volatile("s_waitcnt vmcnt(0)" ::: "memory");
        }
    }
    __syncthreads();
}
__device__ __forceinline__ void ld8bf(const bf16_t* p, float (&v)[8]) {
    const v4u w = *(const v4u*)p;
    v[0] = __builtin_bit_cast(float, w.x << 16); v[1] = __builtin_bit_cast(float, w.x & 0xffff0000u);
    v[2] = __builtin_bit_cast(float, w.y << 16); v[3] = __builtin_bit_cast(float, w.y & 0xffff0000u);
    v[4] = __builtin_bit_cast(float, w.z << 16); v[5] = __builtin_bit_cast(float, w.z & 0xffff0000u);
    v[6] = __builtin_bit_cast(float, w.w << 16); v[7] = __builtin_bit_cast(float, w.w & 0xffff0000u);
}
__global__ void __launch_bounds__(256) k_attn_naive(const bf16_t* __restrict__ PROJ, const float* __restrict__ qn_g, const float* __restrict__ kn_g, const float* __restrict__ rel_bias, bf16_t* __restrict__ Y) {
    __shared__ float qs[16][128];
    __shared__ float S[16][577];
    const int bid = blockIdx.x, quarter = bid & 3, c = (bid >> 2) & 31, h = (bid >> 7) & 7, b = bid >> 10, t = threadIdx.x;
    { const int r = t >> 4, sub = t & 15; const int tok = b * SEQ + c * 64 + quarter * 16 + r;
      float v[8]; ld8bf(PROJ + (size_t)tok * EV_N + EC_QA + h * 128 + sub * 8, v);
      float ss = 0.f;
#pragma unroll
      for (int i = 0; i < 8; ++i) ss += v[i] * v[i];
      ss += __shfl_xor(ss, 1); ss += __shfl_xor(ss, 2); ss += __shfl_xor(ss, 4); ss += __shfl_xor(ss, 8);
      const float rs = 1.0f / sqrtf(ss * (1.0f / 128.0f) + EPS);
#pragma unroll
      for (int i = 0; i < 8; ++i) qs[r][sub * 8 + i] = v[i] * rs * qn_g[sub * 8 + i] * 0.08838834764831845f; }
    __syncthreads();
    for (int idx = t; idx < 16 * BAND; idx += 256) {
        const int r = idx / BAND, j = idx % BAND; const int kc = c - LOOKBACK + (j >> 6);
        float s;
        if (kc < 0) s = -1e30f;
        else { const bf16_t* kp = PROJ + (size_t)(b * SEQ + kc * 64 + (j & 63)) * EV_N + EC_KA + h * 128;
            float ss = 0.f, dot = 0.f;
            for (int d = 0; d < 128; d += 8) { float kv[8]; ld8bf(kp + d, kv);
#pragma unroll
                for (int i = 0; i < 8; ++i) { ss += kv[i] * kv[i]; dot += kv[i] * kn_g[d + i] * qs[r][d + i]; } }
            s = dot * (1.0f / sqrtf(ss * (1.0f / 128.0f) + EPS));
            const int qi = quarter * 16 + r; int rel = LOOKBACK * CHUNK + qi - j; rel = rel < -REL_MAX ? -REL_MAX : (rel > REL_MAX ? REL_MAX : rel); rel += REL_MAX;
            s += rel_bias[h * NREL + rel]; }
        S[r][j] = s;
    }
    __syncthreads();
    { const int r = t >> 4, sub = t & 15; float mx = -3.0e38f;
      for (int j = sub; j < BAND; j += 16) mx = fmaxf(mx, S[r][j]);
      mx = fmaxf(mx, __shfl_xor(mx, 1)); mx = fmaxf(mx, __shfl_xor(mx, 2)); mx = fmaxf(mx, __shfl_xor(mx, 4)); mx = fmaxf(mx, __shfl_xor(mx, 8));
      float sum = 0.f;
      for (int j = sub; j < BAND; j += 16) { const float e = expf(S[r][j] - mx); S[r][j] = e; sum += e; }
      sum += __shfl_xor(sum, 1); sum += __shfl_xor(sum, 2); sum += __shfl_xor(sum, 4); sum += __shfl_xor(sum, 8);
      const float inv = 1.0f / sum;
      for (int j = sub; j < BAND; j += 16) S[r][j] *= inv; }
    __syncthreads();
    { const int r = t >> 4, dg = t & 15; float acc[8];
#pragma unroll
      for (int i = 0; i < 8; ++i) acc[i] = 0.f;
      for (int j = 0; j < BAND; ++j) { const int kc = c - LOOKBACK + (j >> 6); if (kc < 0) continue;
          const float p = S[r][j]; float vv[8]; ld8bf(PROJ + (size_t)(b * SEQ + kc * 64 + (j & 63)) * EV_N + EC_VA + h * 128 + dg * 8, vv);
#pragma unroll
          for (int i = 0; i < 8; ++i) acc[i] += p * vv[i]; }
      const int tok = b * SEQ + c * 64 + quarter * 16 + r; float z[8]; ld8bf(PROJ + (size_t)tok * EV_N + EC_ZA + h * 128 + dg * 8, z);
      v4u o; o.x = pk2(acc[0] * siluf_(z[0]), acc[1] * siluf_(z[1])); o.y = pk2(acc[2] * siluf_(z[2]), acc[3] * siluf_(z[3]));
      o.z = pk2(acc[4] * siluf_(z[4]), acc[5] * siluf_(z[5])); o.w = pk2(acc[6] * siluf_(z[6]), acc[7] * siluf_(z[7]));
      *(v4u*)(Y + (size_t)tok * D_MODEL + h * 128 + dg * 8) = o; }
}
__global__ void __launch_bounds__(256) k_mlstm_naive(const bf16_t* __restrict__ PROJ, const float* __restrict__ GIF, bf16_t* __restrict__ Y) {
    __shared__ float ks[256], qs[256], part[4][64], dpart[4];
    const int bid = blockIdx.x, vs = bid & 3, h = (bid >> 2) & 3, b = bid >> 4, t = threadIdx.x, v = t & 63, kq = t >> 6;
    float C[64];
#pragma unroll
    for (int i = 0; i < 64; ++i) C[i] = 0.f;
    float nreg = 0.f;
    for (int s = 0; s < SEQ; ++s) {
        const size_t tok = (size_t)b * SEQ + s; const bf16_t* pr = PROJ + tok * EV_N;
        const float li = GIF[tok * 8 + h], fpre = GIF[tok * 8 + 4 + h];
        const float fw = sigmoidf_(fpre), iw = expf(li);
        const float kk = bf2f(pr[EC_KB + h * 256 + t]), qq = bf2f(pr[EC_QB + h * 256 + t]) * 0.0625f;
        const float vv = bf2f(pr[EC_VB + h * 256 + vs * 64 + v]);
        ks[t] = kk; qs[t] = qq;
        nreg = fw * nreg + iw * kk;
        float dp = nreg * qq; dp = wave_sum(dp);
        if ((t & 63) == 0) dpart[kq] = dp;
        __syncthreads();
        float np = 0.f; const float iv = iw * vv;
#pragma unroll
        for (int i = 0; i < 64; ++i) { C[i] = fw * C[i] + ks[kq * 64 + i] * iv; np += C[i] * qs[kq * 64 + i]; }
        part[kq][v] = np;
        __syncthreads();
        if (t < 64) { const float num = (part[0][t] + part[1][t]) + (part[2][t] + part[3][t]); const float den = (dpart[0] + dpart[1]) + (dpart[2] + dpart[3]);
            const float hh = num / fmaxf(fabsf(den), 1.0f);
            const float ob = bf2f(pr[EC_OB + h * 256 + vs * 64 + t]), zb = bf2f(pr[EC_ZB + h * 256 + vs * 64 + t]);
            Y[tok * D_MODEL + W_A + h * 256 + vs * 64 + t] = (bf16_t)f2bf(sigmoidf_(ob) * hh * siluf_(zb)); }
        __syncthreads();
    }
}
__global__ void __launch_bounds__(128) k_rglru_gates(const bf16_t* __restrict__ PROJ, const float* __restrict__ ccw, const float* __restrict__ ccb, const float* __restrict__ gw, const float* __restrict__ gb,
                                                     const float* __restrict__ lam, float* __restrict__ A, float* __restrict__ INP) {
    __shared__ float xs[8][128];
    const int blk = blockIdx.x & 7, tg = blockIdx.x >> 3, t = threadIdx.x, c = blk * 128 + t;
    float xc[8];
#pragma unroll
    for (int i = 0; i < 8; ++i) { const int tok = tg * 8 + i, s = tok % SEQ; float a = ccb[c];
#pragma unroll
        for (int j = 0; j < 4; ++j) { const int sj = s - 3 + j; if (sj >= 0) a += ccw[j * W_C + c] * bf2f(PROJ[(size_t)(tok - 3 + j) * OD_N + OC_XC + c]); }
        xc[i] = a; xs[i][t] = a; }
    __syncthreads();
    float rp[8], ip[8];
#pragma unroll
    for (int i = 0; i < 8; ++i) { rp[i] = 0.f; ip[i] = 0.f; }
    const float* g0 = gw + (size_t)blk * 128 * 256;
    for (int k = 0; k < 128; ++k) { const float wr_ = g0[k * 256 + t], wi_ = g0[k * 256 + 128 + t];
#pragma unroll
        for (int i = 0; i < 8; ++i) { const float xv = xs[i][k]; rp[i] += xv * wr_; ip[i] += xv * wi_; } }
    const float sp = softplusf_(-lam[c]); const float gbr = gb[c], gbi = gb[W_C + c];
#pragma unroll
    for (int i = 0; i < 8; ++i) { const int tok = tg * 8 + i; const float r = sigmoidf_(rp[i] + gbr), ig = sigmoidf_(ip[i] + gbi);
        const float la = -8.0f * r * sp; A[(size_t)tok * W_C + c] = expf(la); INP[(size_t)tok * W_C + c] = sqrtf(-expm1f(2.0f * la)) * (ig * xc[i]); }
}
__global__ void __launch_bounds__(256) k_rglru_scan(const bf16_t* __restrict__ PROJ, const float* __restrict__ A, const float* __restrict__ INP, bf16_t* __restrict__ Y) {
    const int gid = blockIdx.x * 256 + threadIdx.x, b = gid / W_C, c = gid % W_C; float h = 0.f;
    for (int s = 0; s < SEQ; ++s) { const size_t tok = (size_t)b * SEQ + s; h = A[tok * W_C + c] * h + INP[tok * W_C + c];
        Y[tok * D_MODEL + c] = (bf16_t)f2bf(h * siluf_(bf2f(PROJ[tok * OD_N + OC_ZC + c]))); }
}
__global__ void __launch_bounds__(256) k_gates_ab(const bf16_t* __restrict__ XB, const bf16_t* __restrict__ W3T, const float* __restrict__ SS1, float* __restrict__ AB) {
    const int t = threadIdx.x, row = blockIdx.x * 16 + (t >> 4), j = t & 15;
    const bf16_t* xp = XB + (size_t)row * D_MODEL; const bf16_t* wp = W3T + (size_t)(OD_N + j) * D_MODEL; float acc = 0.f;
    for (int k = 0; k < D_MODEL; k += 8) { float a[8], w[8]; ld8bf(xp + k, a); ld8bf(wp + k, w);
#pragma unroll
        for (int i = 0; i < 8; ++i) acc += a[i] * w[i]; }
    AB[(size_t)row * 16 + j] = acc * (1.0f / sqrtf(SS1[row] * (1.0f / D_MODEL) + EPS));
}
__global__ void __launch_bounds__(128) k_dn_prep(const bf16_t* __restrict__ PROJ, const float* __restrict__ cdw, float* __restrict__ Q2, float* __restrict__ K2, float* __restrict__ V2) {
    __shared__ float red[2][2];
    const int h = blockIdx.x & 7, tok = blockIdx.x >> 3, s = tok % SEQ, t = threadIdx.x; float o[3];
#pragma unroll
    for (int p = 0; p < 3; ++p) { const int col = p * W_D + h * 128 + t; float a = 0.f;
#pragma unroll
        for (int j = 0; j < 4; ++j) { const int sj = s - 3 + j; if (sj >= 0) a += cdw[j * 3 * W_D + col] * bf2f(PROJ[(size_t)(tok - 3 + j) * OD_N + OC_QD + col]); }
        o[p] = siluf_(a); }
    float sq = wave_sum(o[0] * o[0]), sk = wave_sum(o[1] * o[1]);
    if ((t & 63) == 0) { red[t >> 6][0] = sq; red[t >> 6][1] = sk; }
    __syncthreads();
    sq = red[0][0] + red[1][0]; sk = red[0][1] + red[1][1];
    const size_t o_ = (size_t)tok * W_D + h * 128 + t;
    Q2[o_] = o[0] * (1.0f / sqrtf(sq + EPS)); K2[o_] = o[1] * (1.0f / sqrtf(sk + EPS)); V2[o_] = o[2];
}
__global__ void __launch_bounds__(256) k_dn_scan(const bf16_t* __restrict__ PROJ, const float* __restrict__ Q2, const float* __restrict__ K2, const float* __restrict__ V2, const float* __restrict__ AB,
                                                 const float* __restrict__ a_log, const float* __restrict__ dt_bias, const float* __restrict__ onorm, bf16_t* __restrict__ Y) {
    __shared__ float ks[128], qs[128], part[2][128], red[2];
    const int h = blockIdx.x & 7, b = blockIdx.x >> 3, t = threadIdx.x, v = t & 127, kh = t >> 7;
    float S[64];
#pragma unroll
    for (int i = 0; i < 64; ++i) S[i] = 0.f;
    const float Aexp = expf(a_log[h]), dtb = dt_bias[h], og = onorm[v];
    for (int s = 0; s < SEQ; ++s) {
        const size_t tok = (size_t)b * SEQ + s; const size_t o_ = tok * W_D + h * 128;
        if (t < 128) ks[t] = K2[o_ + t]; else qs[t - 128] = Q2[o_ + t - 128] * 0.08838834764831845f;
        const float vv = V2[o_ + v];
        const float beta = sigmoidf_(AB[tok * 16 + 8 + h]); const float g = -Aexp * softplusf_(AB[tok * 16 + h] + dtb); const float al = expf(g);
        __syncthreads();
        float rp = 0.f;
#pragma unroll
        for (int i = 0; i < 64; ++i) rp += S[i] * ks[kh * 64 + i];
        part[kh][v] = rp;
        __syncthreads();
        const float r = part[0][v] + part[1][v];
        const float u = beta * (vv - al * r);
        float op = 0.f;
#pragma unroll
        for (int i = 0; i < 64; ++i) { S[i] = al * S[i] + ks[kh * 64 + i] * u; op += S[i] * qs[kh * 64 + i]; }
        __syncthreads();
        part[kh][v] = op;
        __syncthreads();
        const float o = part[0][v] + part[1][v];
        float sq = (t < 128) ? o * o : 0.f; sq = wave_sum(sq);
        if (t == 0) red[0] = sq; if (t == 64) red[1] = sq;
        __syncthreads();
        if (t < 128) { const float ms = (red[0] + red[1]) * (1.0f / 128.0f);
            const float zd = bf2f(PROJ[tok * OD_N + OC_ZD + h * 128 + t]);
            Y[tok * D_MODEL + W_C + h * 128 + t] = (bf16_t)f2bf(o * (1.0f / sqrtf(ms + EPS)) * og * siluf_(zd)); }
    }
}

__global__ void __launch_bounds__(512) k_prologue(Ptrs P) {
    extern __shared__ __attribute__((aligned(16))) unsigned char lds[];
    const int tid = threadIdx.x, lane = tid & 63, wave = __builtin_amdgcn_readfirstlane(tid >> 6);
    phase_prologue(P, (LAS unsigned char*)lds, wave, lane, blockIdx.x * NWAVES + wave, gridDim.x * NWAVES);
}
template <int WHICH> __device__ __forceinline__ void phase_gemm(const Ptrs& P, LAS unsigned char* lds, int G, int c) {
    unsigned char* ws = P.ws;
    bf16_t* W1T = (bf16_t*)(ws + WS_W1T); bf16_t* W2T = (bf16_t*)(ws + WS_W2T); bf16_t* W3T = (bf16_t*)(ws + WS_W3T); bf16_t* W4T = (bf16_t*)(ws + WS_W4T);
    bf16_t* XB = (bf16_t*)(ws + WS_XB); bf16_t* YB = (bf16_t*)(ws + WS_Y); bf16_t* PROJ = (bf16_t*)(ws + WS_PROJ);
    float* R0 = (float*)(ws + WS_R0); float* SS1 = (float*)(ws + WS_SS1);
    if constexpr (WHICH == 1) { pg8::Gemm g{XB, W1T, M_TOK, EV_N, D_MODEL}; pg8::EpiProj E{PROJ, EV_N, R0, 0}; pg8::StaticOrder S; S.init(g.M, g.N, G, c);
        pg8::gemm_phase<pg8::EpiProj, pg8::StaticOrder, true, true>(lds, g, S, E); }
    if constexpr (WHICH == 2) { pg8::Gemm g{YB, W2T, M_TOK, D_MODEL, D_MODEL}; pg8::EpiRes E{P.in[IN_X], P.out, XB, SS1, D_MODEL}; pg8::StaticOrder S; S.init(g.M, g.N, G, c);
        pg8::gemm_phase<pg8::EpiRes, pg8::StaticOrder, true, true>(lds, g, S, E); }
    if constexpr (WHICH == 3) { pg8::Gemm g{XB, W3T, M_TOK, OD_N, D_MODEL}; pg8::EpiProj E{PROJ, OD_N, SS1, 1}; pg8::StaticOrder S; S.init(g.M, g.N, G, c);
        pg8::gemm_phase<pg8::EpiProj, pg8::StaticOrder, true, true>(lds, g, S, E); }
    if constexpr (WHICH == 4) { pg8::Gemm g{YB, W4T, M_TOK, D_MODEL, D_MODEL}; pg8::EpiRes E{P.out, P.out, nullptr, nullptr, D_MODEL}; pg8::StaticOrder S; S.init(g.M, g.N, G, c);
        pg8::gemm_phase<pg8::EpiRes, pg8::StaticOrder, true, true>(lds, g, S, E); }
}
template <int WHICH> __global__ void __launch_bounds__(512, 2) k_gemm(Ptrs P) {
    extern __shared__ __attribute__((aligned(16))) unsigned char lds[];
    phase_gemm<WHICH>(P, (LAS unsigned char*)lds, gridDim.x, blockIdx.x);
}

__device__ __forceinline__ void phase_gates_ab(const Ptrs& P, int G) {
    unsigned char* ws = P.ws; const bf16_t* XB = (const bf16_t*)(ws + WS_XB); const bf16_t* W3T = (const bf16_t*)(ws + WS_W3T); const float* SS1 = (const float*)(ws + WS_SS1); float* AB = (float*)(ws + WS_AB);
    const int t = threadIdx.x, j = t & 15;
    for (int it = blockIdx.x; it < M_TOK / 32; it += G) { const int row = it * 32 + (t >> 4);
        const bf16_t* xp = XB + (size_t)row * D_MODEL; const bf16_t* wp = W3T + (size_t)(OD_N + j) * D_MODEL; float acc = 0.f;
#pragma unroll 8
        for (int k = 0; k < D_MODEL; k += 8) { float a[8], w[8]; ld8bf(xp + k, a); ld8bf(wp + k, w);
#pragma unroll
            for (int i = 0; i < 8; ++i) acc += a[i] * w[i]; }
        AB[(size_t)row * 16 + j] = acc * (1.0f / sqrtf(SS1[row] * (1.0f / D_MODEL) + EPS)); }
}
#ifdef SKELETON
__device__ __forceinline__ void phase_mix0(const Ptrs& P, LAS unsigned char* lds, int G) {
    v4u* Y = (v4u*)(P.ws + WS_Y); const v4u z = {0u, 0u, 0u, 0u};
    for (size_t i = (size_t)blockIdx.x * 512 + threadIdx.x; i < (size_t)M_TOK * D_MODEL / 8; i += (size_t)G * 512) Y[i] = z;
}
__device__ __forceinline__ void phase_mix1a(const Ptrs& P, LAS unsigned char* lds, int G) { phase_mix0(P, lds, G); }
__device__ __forceinline__ void phase_mix1b(const Ptrs& P, LAS unsigned char* lds, int G) { }
#endif
typedef short bf16x8 __attribute__((ext_vector_type(8)));
typedef short bf16x4 __attribute__((ext_vector_type(4)));
typedef short v4i16_t __attribute__((ext_vector_type(4)));
#define MFMA16(a, b, c) __builtin_amdgcn_mfma_f32_16x16x32_bf16((a), (b), (c), 0, 0, 0)
__device__ __forceinline__ v4i16_t lds_tr(LAS const unsigned char* p) { return __builtin_amdgcn_ds_read_tr16_b64_v4i16((LAS v4i16_t*)p); }
__device__ __forceinline__ bf16x8 frag_row(LAS const unsigned char* base, int RS, int r0, int k0, int lane) { return *(LAS const bf16x8*)(base + (r0 + (lane & 15)) * RS + (k0 + 8 * (lane >> 4)) * 2); }
__device__ __forceinline__ bf16x8 frag_row_perm(LAS const unsigned char* base, int RS, int r0, int k0, int lane) {
    LAS const unsigned char* p = base + (r0 + (lane & 15)) * RS + (k0 + 4 * (lane >> 4)) * 2;
    const bf16x4 a = *(LAS const bf16x4*)p, b = *(LAS const bf16x4*)(p + 32); return (bf16x8){a[0], a[1], a[2], a[3], b[0], b[1], b[2], b[3]}; }
__device__ __forceinline__ bf16x8 frag_tr(LAS const unsigned char* base, int RS, int k0, int c0, int lane) {
    const int g = lane >> 4, q = (lane & 15) >> 2, p = lane & 3; LAS const unsigned char* a = base + (k0 + 8 * g + q) * RS + (c0 + 4 * p) * 2;
    const v4i16_t lo = lds_tr(a), hi = lds_tr(a + 4 * RS); return (bf16x8){lo[0], lo[1], lo[2], lo[3], hi[0], hi[1], hi[2], hi[3]}; }
__device__ __forceinline__ bf16x8 frag_tr_perm(LAS const unsigned char* base, int RS, int k0, int c0, int lane) {
    const int g = lane >> 4, q = (lane & 15) >> 2, p = lane & 3; LAS const unsigned char* a = base + (k0 + 4 * g + q) * RS + (c0 + 4 * p) * 2;
    const v4i16_t lo = lds_tr(a), hi = lds_tr(a + 16 * RS); return (bf16x8){lo[0], lo[1], lo[2], lo[3], hi[0], hi[1], hi[2], hi[3]}; }
__device__ __forceinline__ bf16x8 acc_pair_frag(const f32x4& lo, const f32x4& hi) {
    const unsigned a = pk2(lo[0], lo[1]), b = pk2(lo[2], lo[3]), c = pk2(hi[0], hi[1]), d = pk2(hi[2], hi[3]);
    typedef unsigned u32x4_ __attribute__((ext_vector_type(4))); const u32x4_ w = {a, b, c, d}; return __builtin_bit_cast(bf16x8, w); }
__device__ __forceinline__ float fexp2(float x) { return __builtin_amdgcn_exp2f(x); }
constexpr float LOG2E = 1.4426950408889634f;
__device__ __forceinline__ float fexp(float x) { return __builtin_amdgcn_exp2f(x * LOG2E); }
__device__ __forceinline__ float frcp(float x) { return __builtin_amdgcn_rcpf(x); }
__device__ __forceinline__ float frsq(float x) { return __builtin_amdgcn_rsqf(x); }
__device__ __forceinline__ float fsqrt(float x) { return __builtin_amdgcn_sqrtf(x); }
__device__ __forceinline__ float fsigmoid(float x) { return __builtin_amdgcn_rcpf(1.0f + __builtin_amdgcn_exp2f(-x * LOG2E)); }
__device__ __forceinline__ float fsilu(float x) { return x * fsigmoid(x); }
constexpr int AT_RSK = 272, AT_RSV = 288, AT_KB = 64 * AT_RSK, AT_VB = 64 * AT_RSV;
constexpr int AT_OFF_K = 0, AT_OFF_V = 2 * AT_KB, AT_OFF_TBL = AT_OFF_V + 2 * AT_VB, AT_LDS = AT_OFF_TBL + 2064;
static_assert(AT_LDS <= 163328, "attention LDS");
__device__ __forceinline__ void attn_item(const Ptrs& P, LAS unsigned char* lds, int item) {
    const bf16_t* __restrict__ PROJ = (const bf16_t*)(P.ws + WS_PROJ); bf16_t* __restrict__ Y = (bf16_t*)(P.ws + WS_Y);
    const float* __restrict__ qn_g = P.in[IN_EV_QNG]; const float* __restrict__ kn_g = P.in[IN_EV_KNG];
    const int tid = threadIdx.x, lane = tid & 63, wave = tid >> 6, g = lane >> 4, l15 = lane & 15;
    const int cp = item & 15, h = (item >> 4) & 7, b = item >> 7;
    const int c = 2 * cp + (wave >> 2), qt = wave & 3;
    LAS float* tbl = (LAS float*)(lds + AT_OFF_TBL);
    for (int i = tid; i < NREL; i += 512) tbl[i] = P.in[IN_EV_REL][h * NREL + i] * LOG2E;
    bf16x8 qf[4];
    { const bf16_t* qp = PROJ + (size_t)(b * SEQ + c * 64 + qt * 16 + l15) * EV_N + EC_QA + h * 128 + 8 * g;
      float qv[4][8]; float ss = 0.f;
#pragma unroll
      for (int ks = 0; ks < 4; ++ks) { ld8bf(qp + 32 * ks, qv[ks]);
#pragma unroll
          for (int i = 0; i < 8; ++i) ss += qv[ks][i] * qv[ks][i]; }
      ss += __shfl_xor(ss, 16); ss += __shfl_xor(ss, 32);
      const float rs = frsq(ss * (1.0f / 128.0f) + EPS) * (0.08838834764831845f * LOG2E);
#pragma unroll
      for (int ks = 0; ks < 4; ++ks) { const float* gp = qn_g + 32 * ks + 8 * g; typedef unsigned u32x4_ __attribute__((ext_vector_type(4)));
          const u32x4_ w = {pk2(qv[ks][0] * rs * gp[0], qv[ks][1] * rs * gp[1]), pk2(qv[ks][2] * rs * gp[2], qv[ks][3] * rs * gp[3]),
                            pk2(qv[ks][4] * rs * gp[4], qv[ks][5] * rs * gp[5]), pk2(qv[ks][6] * rs * gp[6], qv[ks][7] * rs * gp[7])};
          qf[ks] = __builtin_bit_cast(bf16x8, w); } }
    f32x4 o[8];
#pragma unroll
    for (int i = 0; i < 8; ++i) o[i] = (f32x4){0.f, 0.f, 0.f, 0.f};
    float mrun = -1.0e30f, lrun = 0.f;
    const int kt_lo = (2 * cp - LOOKBACK) < 0 ? 0 : (2 * cp - LOOKBACK), kt_hi = 2 * cp + 1;
    v4u kreg[2], vreg[2];
    const int srow0 = tid >> 4, sch = tid & 15;
    float kg[8];
#pragma unroll
    for (int i = 0; i < 8; ++i) kg[i] = kn_g[sch * 8 + i];
#define AT_LOAD(kt) do { _Pragma("unroll") for (int i_ = 0; i_ < 2; ++i_) { const bf16_t* rp_ = PROJ + (size_t)(b * SEQ + (kt) * 64 + srow0 + 32 * i_) * EV_N + h * 128 + sch * 8; \
        kreg[i_] = *(const v4u*)(rp_ + EC_KA); vreg[i_] = *(const v4u*)(rp_ + EC_VA); } } while (0)
#define AT_STORE(buf) do { _Pragma("unroll") for (int i_ = 0; i_ < 2; ++i_) { const int row_ = srow0 + 32 * i_; \
        float kv_[8]; kv_[0] = __builtin_bit_cast(float, kreg[i_].x << 16); kv_[1] = __builtin_bit_cast(float, kreg[i_].x & 0xffff0000u); kv_[2] = __builtin_bit_cast(float, kreg[i_].y << 16); kv_[3] = __builtin_bit_cast(float, kreg[i_].y & 0xffff0000u); \
        kv_[4] = __builtin_bit_cast(float, kreg[i_].z << 16); kv_[5] = __builtin_bit_cast(float, kreg[i_].z & 0xffff0000u); kv_[6] = __builtin_bit_cast(float, kreg[i_].w << 16); kv_[7] = __builtin_bit_cast(float, kreg[i_].w & 0xffff0000u); \
        float ss_ = 0.f; _Pragma("unroll") for (int e_ = 0; e_ < 8; ++e_) ss_ += kv_[e_] * kv_[e_]; \
        ss_ += __shfl_xor(ss_, 1); ss_ += __shfl_xor(ss_, 2); ss_ += __shfl_xor(ss_, 4); ss_ += __shfl_xor(ss_, 8); \
        const float rs_ = frsq(ss_ * (1.0f / 128.0f) + EPS); \
        v4u w_; w_.x = pk2(kv_[0] * rs_ * kg[0], kv_[1] * rs_ * kg[1]); w_.y = pk2(kv_[2] * rs_ * kg[2], kv_[3] * rs_ * kg[3]); w_.z = pk2(kv_[4] * rs_ * kg[4], kv_[5] * rs_ * kg[5]); w_.w = pk2(kv_[6] * rs_ * kg[6], kv_[7] * rs_ * kg[7]); \
        *(LAS v4u*)(lds + AT_OFF_K + (buf) * AT_KB + row_ * AT_RSK + sch * 16) = w_; \
        *(LAS v4u*)(lds + AT_OFF_V + (buf) * AT_VB + row_ * AT_RSV + sch * 16) = vreg[i_]; } } while (0)
    AT_LOAD(kt_lo); AT_STORE(0);
    __syncthreads();
    const int qi = qt * 16 + l15;
    for (int kt = kt_lo, it = 0; kt <= kt_hi; ++kt, ++it) {
        const int buf = it & 1;
        if (kt < kt_hi) AT_LOAD(kt + 1);
        const int to = kt - (c - LOOKBACK);
        if (to >= 0 && to <= LOOKBACK) {
            LAS const unsigned char* Kb = lds + AT_OFF_K + buf * AT_KB; LAS const unsigned char* Vb = lds + AT_OFF_V + buf * AT_VB;
            f32x4 s[4];
#pragma unroll
            for (int nt = 0; nt < 4; ++nt) { s[nt] = (f32x4){0.f, 0.f, 0.f, 0.f};
#pragma unroll
                for (int ks = 0; ks < 4; ++ks) s[nt] = MFMA16(frag_row(Kb, AT_RSK, 16 * nt, 32 * ks, lane), qf[ks], s[nt]); }
            { const int relb = LOOKBACK * CHUNK - 64 * to + qi - 4 * g;
#pragma unroll
              for (int nt = 0; nt < 4; ++nt)
#pragma unroll
                  for (int r = 0; r < 4; ++r) { int rel = relb - 16 * nt - r; rel = rel > REL_MAX ? REL_MAX : rel; s[nt][r] += tbl[rel + REL_MAX]; } }
            float tmax = fmaxf(fmaxf(s[0][0], s[0][1]), fmaxf(s[0][2], s[0][3]));
#pragma unroll
            for (int nt = 1; nt < 4; ++nt) tmax = fmaxf(tmax, fmaxf(fmaxf(s[nt][0], s[nt][1]), fmaxf(s[nt][2], s[nt][3])));
            tmax = fmaxf(tmax, __shfl_xor(tmax, 16)); tmax = fmaxf(tmax, __shfl_xor(tmax, 32));
            const float mnew = fmaxf(mrun, tmax), alpha = fexp2(mrun - mnew);
            float rsum = 0.f;
#pragma unroll
            for (int nt = 0; nt < 4; ++nt)
#pragma unroll
                for (int r = 0; r < 4; ++r) { s[nt][r] = fexp2(s[nt][r] - mnew); rsum += s[nt][r]; }
            rsum += __shfl_xor(rsum, 16); rsum += __shfl_xor(rsum, 32);
            lrun = lrun * alpha + rsum; mrun = mnew;
            const bf16x8 pf0 = acc_pair_frag(s[0], s[1]), pf1 = acc_pair_frag(s[2], s[3]);
            float al[4];
#pragma unroll
            for (int r = 0; r < 4; ++r) al[r] = __shfl(alpha, 4 * g + r);
#pragma unroll
            for (int dt = 0; dt < 8; ++dt) { o[dt][0] *= al[0]; o[dt][1] *= al[1]; o[dt][2] *= al[2]; o[dt][3] *= al[3];
                o[dt] = MFMA16(pf0, frag_tr_perm(Vb, AT_RSV, 0, 16 * dt, lane), o[dt]);
                o[dt] = MFMA16(pf1, frag_tr_perm(Vb, AT_RSV, 32, 16 * dt, lane), o[dt]); }
        }
        if (kt < kt_hi) AT_STORE(buf ^ 1);
        __syncthreads();
    }
#undef AT_LOAD
#undef AT_STORE
    float li[4];
#pragma unroll
    for (int r = 0; r < 4; ++r) li[r] = frcp(__shfl(lrun, 4 * g + r));
#pragma unroll
    for (int r = 0; r < 4; ++r) { const size_t tok = (size_t)b * SEQ + c * 64 + qt * 16 + 4 * g + r; const bf16_t* zp = PROJ + tok * EV_N + EC_ZA + h * 128 + l15; bf16_t* yp = Y + tok * D_MODEL + h * 128 + l15;
#pragma unroll
        for (int dt = 0; dt < 8; ++dt) yp[16 * dt] = (bf16_t)f2bf(o[dt][r] * li[r] * fsilu(bf2f(zp[16 * dt]))); }
}
constexpr int ML_RSQ = 528, ML_RSK = 544, ML_RSV = 160, ML_RSP = 144, ML_RSH = 144;
constexpr int ML_OFF_Q = 0, ML_OFF_K = ML_OFF_Q + 64 * ML_RSQ, ML_OFF_V = ML_OFF_K + 64 * ML_RSK, ML_OFF_P = ML_OFF_V + 64 * ML_RSV, ML_OFF_H = ML_OFF_P + 64 * ML_RSP, ML_OFF_S = ML_OFF_H + 64 * ML_RSH;
constexpr int ML_BC = 0, ML_AA = 2048, ML_PM = 4096, ML_MCH = 6144  , ML_BL = 6184  , ML_PL = 6216  ;
constexpr int ML_E1 = 6248, ML_E2 = ML_E1 + 64, ML_WI = ML_E2 + 64, ML_EMT = ML_WI + 64, ML_WS = ML_EMT + 64, ML_RS = ML_WS + 64, ML_QN = ML_RS + 64, ML_NV = ML_QN + 64, ML_NP = ML_NV + 256, ML_WC = ML_NP + 512, ML_LDS = ML_OFF_S + (ML_WC + 4) * 4;
static_assert(ML_LDS <= 163328, "mLSTM LDS");
__device__ __forceinline__ void mlstm_item(const Ptrs& P, LAS unsigned char* lds, int item) {
    const bf16_t* __restrict__ PROJ = (const bf16_t*)(P.ws + WS_PROJ); bf16_t* __restrict__ Y = (bf16_t*)(P.ws + WS_Y); const float* __restrict__ GIF = (const float*)(P.ws + WS_GIF);
    const int tid = threadIdx.x, lane = tid & 63, wave = tid >> 6, g = lane >> 4, l15 = lane & 15;
    const int quarter = item & 3, h = (item >> 2) & 3, b = item >> 4;
    LAS float* sc = (LAS float*)(lds + ML_OFF_S);
    LAS const unsigned char* Qt = lds + ML_OFF_Q; LAS const unsigned char* Kt = lds + ML_OFF_K; LAS const unsigned char* Vt = lds + ML_OFF_V; LAS const unsigned char* Ps = lds + ML_OFF_P;
    const size_t tok0 = (size_t)b * SEQ;
    f32x4 cacc[16];
#pragma unroll
    for (int i = 0; i < 16; ++i) cacc[i] = (f32x4){0.f, 0.f, 0.f, 0.f};
    if (tid < 256) sc[ML_NV + tid] = 0.f;
    for (int e = tid; e < 64 * ML_RSP / 8; e += 512) *(LAS unsigned long long*)(lds + ML_OFF_P + e * 8) = 0ull;
#pragma unroll 1
    for (int c = wave * 4; c < wave * 4 + 4; ++c) { const size_t tok = tok0 + c * 64 + lane;
        const float li = GIF[tok * 8 + h], lf = logsigmoidf_(GIF[tok * 8 + 4 + h]);
        float bc = lf;
#pragma unroll
        for (int o = 1; o < 64; o <<= 1) { const float t_ = __shfl_up(bc, o); if (lane >= o) bc += t_; }
        const float as = li - bc; float pm = as;
#pragma unroll
        for (int o = 1; o < 64; o <<= 1) { const float t_ = __shfl_up(pm, o); if (lane >= o) pm = fmaxf(pm, t_); }
        sc[ML_BC + c * 64 + lane] = bc; sc[ML_AA + c * 64 + lane] = as; sc[ML_PM + c * 64 + lane] = pm;
        if (lane == 63) { sc[ML_BL + c] = bc; sc[ML_PL + c] = pm; } }
    __syncthreads();
    if (tid == 0) { float m = 0.f; sc[ML_MCH] = 0.f;
        for (int c = 0; c < NCH; ++c) { m = sc[ML_BL + c] + fmaxf(m, sc[ML_PL + c]); sc[ML_MCH + c + 1] = m; } }
    v4u qreg[4], kreg[4], vreg, oreg, zreg;
    const int ot = tid >> 3, oc = (tid & 7) * 8, ocol = h * 256 + quarter * 64 + oc;
#define ML_LOAD(n) do { _Pragma("unroll") for (int i_ = 0; i_ < 4; ++i_) { const int id_ = tid + 512 * i_, row_ = id_ >> 5, ch_ = id_ & 31; const bf16_t* rp_ = PROJ + (tok0 + (n) * 64 + row_) * EV_N + h * 256 + ch_ * 8; \
            qreg[i_] = *(const v4u*)(rp_ + EC_QB); kreg[i_] = *(const v4u*)(rp_ + EC_KB); } \
        vreg = *(const v4u*)(PROJ + (tok0 + (n) * 64 + (tid >> 3)) * EV_N + EC_VB + h * 256 + quarter * 64 + (tid & 7) * 8); } while (0)
#define ML_LOAD_OZ(n) do { const bf16_t* rp_ = PROJ + (tok0 + (n) * 64 + ot) * EV_N + ocol; oreg = *(const v4u*)(rp_ + EC_OB); zreg = *(const v4u*)(rp_ + EC_ZB); } while (0)
#define ML_STORE() do { _Pragma("unroll") for (int i_ = 0; i_ < 4; ++i_) { const int id_ = tid + 512 * i_, row_ = id_ >> 5, ch_ = id_ & 31; \
            *(LAS v4u*)(lds + ML_OFF_Q + row_ * ML_RSQ + ch_ * 16) = qreg[i_]; *(LAS v4u*)(lds + ML_OFF_K + row_ * ML_RSK + ch_ * 16) = kreg[i_]; } \
        *(LAS v4u*)(lds + ML_OFF_V + (tid >> 3) * ML_RSV + (tid & 7) * 16) = vreg; } while (0)
    ML_LOAD(0);
    __syncthreads();
    for (int n = 0; n < NCH; ++n) {
        ML_STORE();
        const float m0 = sc[ML_MCH + n], m1 = sc[ML_MCH + n + 1], blast = sc[ML_BL + n];
        if (tid < 64) { const float bc = sc[ML_BC + n * 64 + tid], as = sc[ML_AA + n * 64 + tid], mx = fmaxf(m0, sc[ML_PM + n * 64 + tid]);
            sc[ML_E1 + tid] = -mx * LOG2E; sc[ML_E2 + tid] = as * LOG2E; sc[ML_WI + tid] = fexp(m0 - mx); sc[ML_EMT + tid] = fexp(-bc - mx); sc[ML_WS + tid] = fexp(as + blast - m1); sc[ML_RS + tid] = 0.f;
            if (tid == 0) sc[ML_WC] = fexp(blast + m0 - m1); }
        __syncthreads();
        if (n + 1 < NCH) ML_LOAD(n + 1);
        f32x4 nu[4]; bf16x8 vf[2];
        if (wave >= 4) {
            { const int id = tid - 256, t = id >> 2, j = id & 3; float a = 0.f;
#pragma unroll
              for (int i = 0; i < 8; ++i) { const v4u w = *(LAS const v4u*)(Qt + t * ML_RSQ + (64 * j + 8 * i) * 2); const LAS float* nv = sc + ((n & 1) ? ML_NP : ML_NV) + 64 * j + 8 * i;
                  a += __builtin_bit_cast(float, w.x << 16) * nv[0] + __builtin_bit_cast(float, w.x & 0xffff0000u) * nv[1] + __builtin_bit_cast(float, w.y << 16) * nv[2] + __builtin_bit_cast(float, w.y & 0xffff0000u) * nv[3]
                     + __builtin_bit_cast(float, w.z << 16) * nv[4] + __builtin_bit_cast(float, w.z & 0xffff0000u) * nv[5] + __builtin_bit_cast(float, w.w << 16) * nv[6] + __builtin_bit_cast(float, w.w & 0xffff0000u) * nv[7]; }
              a += __shfl_xor(a, 1); a += __shfl_xor(a, 2);
              if (j == 0) sc[ML_QN + t] = a * 0.0625f; }
#pragma unroll 1
            for (int q = wave - 4; q < 10; q += 4) { const int tt = (q >= 6) ? 3 : (q >= 3) ? 2 : (q >= 1) ? 1 : 0; const int st = q - (tt * (tt + 1)) / 2;
                const int t = 16 * tt + l15; const float e1 = sc[ML_E1 + t];
                f32x4 s_ = (f32x4){0.f, 0.f, 0.f, 0.f};
#pragma unroll
                for (int ks = 0; ks < 8; ++ks) s_ = MFMA16(frag_row(Kt, ML_RSK, 16 * st, 32 * ks, lane), frag_row(Qt, ML_RSQ, 16 * tt, 32 * ks, lane), s_);
                float pv_[4]; float rs = 0.f;
#pragma unroll
                for (int r = 0; r < 4; ++r) { const int sidx = 16 * st + 4 * g + r; const float p = (sidx <= t) ? fexp2(e1 + sc[ML_E2 + sidx]) * s_[r] * 0.0625f : 0.f; pv_[r] = p; rs += p; }
                rs += __shfl_xor(rs, 16); rs += __shfl_xor(rs, 32);
                if (g == 0) atomicAdd((float*)(sc + ML_RS + t), rs);
                *(LAS unsigned long long*)(lds + ML_OFF_P + t * ML_RSP + (16 * st + 4 * g) * 2) = (unsigned long long)pk2(pv_[0], pv_[1]) | ((unsigned long long)pk2(pv_[2], pv_[3]) << 32); }
            const int kd = tid - 256; float an = 0.f;
#pragma unroll 8
            for (int s_ = 0; s_ < 64; ++s_) an += sc[ML_WS + s_] * bf2f(*(LAS const unsigned short*)(Kt + s_ * ML_RSK + kd * 2));
            sc[((n & 1) ? ML_NV : ML_NP) + kd] = sc[ML_WC] * sc[((n & 1) ? ML_NP : ML_NV) + kd] + an;
        } else {
#pragma unroll
            for (int tt = 0; tt < 4; ++tt) nu[tt] = (f32x4){0.f, 0.f, 0.f, 0.f};
#pragma unroll
            for (int j = 0; j < 8; ++j) { const bf16x8 cf = acc_pair_frag(cacc[2 * j], cacc[2 * j + 1]);
#pragma unroll
                for (int tt = 0; tt < 4; ++tt) nu[tt] = MFMA16(frag_row_perm(Qt, ML_RSQ, 16 * tt, 32 * j, lane), cf, nu[tt]);
                if (j & 1) __builtin_amdgcn_sched_barrier(0); }
#pragma unroll
            for (int tt = 0; tt < 4; ++tt) { const f32x4 wi = *(LAS const f32x4*)(sc + ML_WI + 16 * tt + 4 * g); nu[tt] *= wi * 0.0625f; }
            __builtin_amdgcn_sched_barrier(0);
#pragma unroll
            for (int ks = 0; ks < 2; ++ks) vf[ks] = frag_tr_perm(Vt, ML_RSV, 32 * ks, 16 * wave, lane);
            const float wc = sc[ML_WC];
            bf16x8 vw[2];
#pragma unroll
            for (int ks = 0; ks < 2; ++ks) { typedef unsigned u32x4_ __attribute__((ext_vector_type(4))); const u32x4_ w = __builtin_bit_cast(u32x4_, vf[ks]);
                const f32x4 wa = *(LAS const f32x4*)(sc + ML_WS + 32 * ks + 4 * g), wb = *(LAS const f32x4*)(sc + ML_WS + 32 * ks + 16 + 4 * g);
                const u32x4_ o = {pk2(__builtin_bit_cast(float, w.x << 16) * wa[0], __builtin_bit_cast(float, w.x & 0xffff0000u) * wa[1]), pk2(__builtin_bit_cast(float, w.y << 16) * wa[2], __builtin_bit_cast(float, w.y & 0xffff0000u) * wa[3]),
                                  pk2(__builtin_bit_cast(float, w.z << 16) * wb[0], __builtin_bit_cast(float, w.z & 0xffff0000u) * wb[1]), pk2(__builtin_bit_cast(float, w.w << 16) * wb[2], __builtin_bit_cast(float, w.w & 0xffff0000u) * wb[3])};
                vw[ks] = __builtin_bit_cast(bf16x8, o); }
#pragma unroll
            for (int kt = 0; kt < 16; ++kt) { cacc[kt] *= wc;
                cacc[kt] = MFMA16(frag_tr_perm(Kt, ML_RSK, 0, 16 * kt, lane), vw[0], cacc[kt]);
                cacc[kt] = MFMA16(frag_tr_perm(Kt, ML_RSK, 32, 16 * kt, lane), vw[1], cacc[kt]);
                if ((kt & 3) == 3) __builtin_amdgcn_sched_barrier(0); }
#pragma unroll
            for (int kt = 0; kt < 16; ++kt) asm volatile("" : "+v"(cacc[kt]));
        }
        __syncthreads();
        ML_LOAD_OZ(n);
        if (wave < 4) {
#pragma unroll
            for (int ks = 0; ks < 2; ++ks) {
#pragma unroll
                for (int tt = 0; tt < 4; ++tt) nu[tt] = MFMA16(frag_row_perm(Ps, ML_RSP, 16 * tt, 32 * ks, lane), vf[ks], nu[tt]); }
#pragma unroll
            for (int tt = 0; tt < 4; ++tt)
#pragma unroll
                for (int r = 0; r < 4; ++r) *(LAS unsigned short*)(lds + ML_OFF_H + (16 * tt + 4 * g + r) * ML_RSH + (16 * wave + l15) * 2) = (unsigned short)(pk2(nu[tt][r], 0.f) & 0xffffu);
            __builtin_amdgcn_sched_barrier(0);
        }
        __syncthreads();
        { const float den = sc[ML_WI + ot] * sc[ML_QN + ot] + sc[ML_RS + ot]; const float inv = frcp(fmaxf(fabsf(den), sc[ML_EMT + ot]));
          const v4u hw = *(LAS const v4u*)(lds + ML_OFF_H + ot * ML_RSH + oc * 2); const v4u ow = oreg, zw = zreg;
#define ML_Y(hx, ox, zx, lo) (fsigmoid(__builtin_bit_cast(float, (lo) ? ((ox) << 16) : ((ox) & 0xffff0000u))) * (__builtin_bit_cast(float, (lo) ? ((hx) << 16) : ((hx) & 0xffff0000u)) * inv) * fsilu(__builtin_bit_cast(float, (lo) ? ((zx) << 16) : ((zx) & 0xffff0000u))))
          v4u yw; yw.x = pk2(ML_Y(hw.x, ow.x, zw.x, 1), ML_Y(hw.x, ow.x, zw.x, 0)); yw.y = pk2(ML_Y(hw.y, ow.y, zw.y, 1), ML_Y(hw.y, ow.y, zw.y, 0));
          yw.z = pk2(ML_Y(hw.z, ow.z, zw.z, 1), ML_Y(hw.z, ow.z, zw.z, 0)); yw.w = pk2(ML_Y(hw.w, ow.w, zw.w, 1), ML_Y(hw.w, ow.w, zw.w, 0));
#undef ML_Y
          *(v4u*)(Y + (tok0 + n * 64 + ot) * D_MODEL + W_A + ocol) = yw; }
    }
#undef ML_LOAD
#undef ML_LOAD_OZ
#undef ML_STORE
    __syncthreads();
}
constexpr int RG_RSG = 160, RG_RSX = 272, RG_RSF = 33 * 4;
constexpr int RG_OFF_G = 0, RG_OFF_X = RG_OFF_G + 128 * RG_RSG, RG_OFF_XF = RG_OFF_X + 64 * RG_RSX, RG_OFF_A = RG_OFF_XF + 64 * RG_RSF, RG_OFF_I = RG_OFF_A + 64 * RG_RSF, RG_OFF_H = RG_OFF_I + 64 * RG_RSF, RG_LDS = RG_OFF_H + 64 * RG_RSF;
static_assert(RG_LDS <= 163328, "RG-LRU LDS");
__device__ __forceinline__ void rglru_item(const Ptrs& P, LAS unsigned char* lds, int item) {
    const bf16_t* __restrict__ PROJ = (const bf16_t*)(P.ws + WS_PROJ); bf16_t* __restrict__ Y = (bf16_t*)(P.ws + WS_Y);
    const float* __restrict__ ccw = P.in[IN_OD_CCW]; const float* __restrict__ ccb = P.in[IN_OD_CCB]; const float* __restrict__ gw = P.in[IN_OD_GW]; const float* __restrict__ gb = P.in[IN_OD_GB]; const float* __restrict__ lam = P.in[IN_OD_LAM];
    const int tid = threadIdx.x, lane = tid & 63, wave = tid >> 6, g = lane >> 4, l15 = lane & 15;
    const int cq = item & 3, blk = (item >> 2) & 7, b = item >> 5;
    const size_t tok0 = (size_t)b * SEQ;
    for (int e = tid; e < 128 * 64; e += 512) { const int k = e >> 6, c = e & 63; const int d = (c < 32) ? (cq * 32 + c) : (128 + cq * 32 + c - 32);
        *(LAS unsigned short*)(lds + RG_OFF_G + k * RG_RSG + c * 2) = (unsigned short)f2bf(gw[((size_t)blk * 128 + k) * 256 + d]); }
    const int c8 = tid & 15, tq = tid >> 4, ch0 = blk * 128 + 8 * c8;
    float cw[4][8], cb[8];
#pragma unroll
    for (int i = 0; i < 8; ++i) { cb[i] = ccb[ch0 + i];
#pragma unroll
        for (int j = 0; j < 4; ++j) cw[j][i] = ccw[j * W_C + ch0 + i]; }
    const int chl = 16 * (wave & 1) + l15, cgl = blk * 128 + cq * 32 + chl;
    const float gbr = gb[cgl], gbi = gb[W_C + cgl], sp = softplusf_(-lam[cgl]);
    float hcar = 0.f;
    v4u xin[2][4]; unsigned long long zin = 0ull;
    const int ot = tid >> 3, oc4 = tid & 7, cgo = blk * 128 + cq * 32 + 4 * oc4;
#define RG_LOAD(n) do { _Pragma("unroll") for (int u_ = 0; u_ < 2; ++u_) { const int s_ = (n) * 64 + tq + 32 * u_; \
            _Pragma("unroll") for (int j_ = 0; j_ < 4; ++j_) { xin[u_][j_] = (v4u){0u, 0u, 0u, 0u}; if (s_ - 3 + j_ >= 0) xin[u_][j_] = *(const v4u*)(PROJ + (tok0 + s_ - 3 + j_) * OD_N + OC_XC + ch0); } } \
        zin = *(const unsigned long long*)(PROJ + (tok0 + (n) * 64 + ot) * OD_N + OC_ZC + cgo); } while (0)
    RG_LOAD(0);
    __syncthreads();
    for (int n = 0; n < NCH; ++n) {
        const unsigned long long zw = zin;
#pragma unroll
        for (int u = 0; u < 2; ++u) { const int t = tq + 32 * u; float xv[8];
#pragma unroll
            for (int i = 0; i < 8; ++i) xv[i] = cb[i];
#pragma unroll
            for (int j = 0; j < 4; ++j) { const v4u w_ = xin[u][j];
                xv[0] += cw[j][0] * __builtin_bit_cast(float, w_.x << 16); xv[1] += cw[j][1] * __builtin_bit_cast(float, w_.x & 0xffff0000u); xv[2] += cw[j][2] * __builtin_bit_cast(float, w_.y << 16); xv[3] += cw[j][3] * __builtin_bit_cast(float, w_.y & 0xffff0000u);
                xv[4] += cw[j][4] * __builtin_bit_cast(float, w_.z << 16); xv[5] += cw[j][5] * __builtin_bit_cast(float, w_.z & 0xffff0000u); xv[6] += cw[j][6] * __builtin_bit_cast(float, w_.w << 16); xv[7] += cw[j][7] * __builtin_bit_cast(float, w_.w & 0xffff0000u); }
            v4u w; w.x = pk2(xv[0], xv[1]); w.y = pk2(xv[2], xv[3]); w.z = pk2(xv[4], xv[5]); w.w = pk2(xv[6], xv[7]);
            *(LAS v4u*)(lds + RG_OFF_X + t * RG_RSX + c8 * 16) = w;
            if ((c8 >> 2) == cq) { LAS float* xf = (LAS float*)(lds + RG_OFF_XF + t * RG_RSF) + 8 * (c8 & 3);
#pragma unroll
                for (int i = 0; i < 8; ++i) xf[i] = xv[i]; } }
        if (n + 1 < NCH) RG_LOAD(n + 1);
        __syncthreads();
        { const int tt = wave >> 1, cp = wave & 1; f32x4 ar = (f32x4){0.f, 0.f, 0.f, 0.f}, ai = ar;
#pragma unroll
          for (int ks = 0; ks < 4; ++ks) { const bf16x8 xa = frag_row(lds + RG_OFF_X, RG_RSX, 16 * tt, 32 * ks, lane);
              ar = MFMA16(xa, frag_tr(lds + RG_OFF_G, RG_RSG, 32 * ks, 16 * cp, lane), ar);
              ai = MFMA16(xa, frag_tr(lds + RG_OFF_G, RG_RSG, 32 * ks, 32 + 16 * cp, lane), ai); }
#pragma unroll
          for (int r = 0; r < 4; ++r) { const int t = 16 * tt + 4 * g + r;
              const float rr = fsigmoid(ar[r] + gbr), ig = fsigmoid(ai[r] + gbi); const float la = -8.0f * rr * sp;
              const float xc = *((LAS const float*)(lds + RG_OFF_XF + t * RG_RSF) + chl);
              *((LAS float*)(lds + RG_OFF_A + t * RG_RSF) + chl) = fexp(la);
              *((LAS float*)(lds + RG_OFF_I + t * RG_RSF) + chl) = fsqrt(1.0f - fexp(2.0f * la)) * (ig * xc); } }
        __syncthreads();
        if (tid < 32) { float h = hcar;
#pragma unroll 8
            for (int t = 0; t < 64; ++t) { h = *((LAS const float*)(lds + RG_OFF_A + t * RG_RSF) + tid) * h + *((LAS const float*)(lds + RG_OFF_I + t * RG_RSF) + tid);
                *((LAS float*)(lds + RG_OFF_H + t * RG_RSF) + tid) = h; }
            hcar = h; }
        __syncthreads();
        { const size_t tok = tok0 + n * 64 + ot;
          const LAS float* hp = (LAS const float*)(lds + RG_OFF_H + ot * RG_RSF) + 4 * oc4;
          const float z0 = __builtin_bit_cast(float, (unsigned)(zw & 0xffffull) << 16), z1 = __builtin_bit_cast(float, (unsigned)(zw >> 16 & 0xffffull) << 16), z2 = __builtin_bit_cast(float, (unsigned)(zw >> 32 & 0xffffull) << 16), z3 = __builtin_bit_cast(float, (unsigned)(zw >> 48) << 16);
          *(unsigned long long*)(Y + tok * D_MODEL + cgo) = (unsigned long long)pk2(hp[0] * fsilu(z0), hp[1] * fsilu(z1)) | ((unsigned long long)pk2(hp[2] * fsilu(z2), hp[3] * fsilu(z3)) << 32); }
    }
#undef RG_LOAD
    __syncthreads();
}
constexpr size_t WS_DQ2 = 4 * MiB, WS_DK2 = 36 * MiB;
constexpr size_t WS_DWT = WS_XB, WS_DUT = WS_XB + 32 * MiB;
constexpr size_t WS_DQK = WS_FREE1, WS_DDEC = WS_FREE1 + 16 * MiB;
constexpr float DN_SCALE = 0.08838834764831845f;
template <int T> struct SolveRows {
    static __device__ __forceinline__ void run(float (&col)[32], LAS const unsigned char* Ab, int j) {
        SolveRows<T - 1>::run(col, Ab, j);
        float v = (T == j) ? 1.f : 0.f;
#pragma unroll
        for (int s4 = 0; s4 < (T + 3) / 4; ++s4) { const f32x4 a = *(LAS const f32x4*)(Ab + T * 272 + 16 * s4);
#pragma unroll
            for (int e = 0; e < 4; ++e) { if (4 * s4 + e < T) v -= a[e] * col[4 * s4 + e]; } }
        asm volatile("" : "+v"(v) :: "memory"); col[T] = v;
    }
};
template <> struct SolveRows<-1> { static __device__ __forceinline__ void run(float (&)[32], LAS const unsigned char*, int) {} };
constexpr int D1_RSQ = 272, D1_RSK = 288, D1_RSV = 288, D1_RSA = 272, D1_RST = 160;
constexpr int D1_OFF_Q = 0, D1_OFF_K = D1_OFF_Q + 64 * D1_RSQ, D1_OFF_V = D1_OFF_K + 64 * D1_RSK, D1_OFF_A = D1_OFF_V + 64 * D1_RSV, D1_OFF_T = D1_OFF_A + 64 * D1_RSA, D1_OFF_S = D1_OFF_T + 64 * D1_RST, D1_LDS = D1_OFF_S + 512;
static_assert(D1_LDS <= 163328, "D1 LDS");
__device__ __forceinline__ void dn1_item(const Ptrs& P, LAS unsigned char* lds, int item) {
    const bf16_t* __restrict__ PROJ = (const bf16_t*)(P.ws + WS_PROJ); const float* __restrict__ AB = (const float*)(P.ws + WS_AB); const float* __restrict__ cdw = P.in[IN_OD_CDW];
    bf16_t* __restrict__ Q2 = (bf16_t*)(P.ws + WS_DQ2); bf16_t* __restrict__ K2 = (bf16_t*)(P.ws + WS_DK2);
    bf16_t* __restrict__ WTg = (bf16_t*)(P.ws + WS_DWT) + (size_t)item * 8192; bf16_t* __restrict__ UTg = (bf16_t*)(P.ws + WS_DUT) + (size_t)item * 8192;
    bf16_t* __restrict__ QKg = (bf16_t*)(P.ws + WS_DQK) + (size_t)item * 4096; float* __restrict__ DECg = (float*)(P.ws + WS_DDEC) + (size_t)item * 64;
    const int tid = threadIdx.x, lane = tid & 63, wave = tid >> 6, g = lane >> 4, l15 = lane & 15;
    const int n = item & 31, h = (item >> 5) & 7, b = item >> 8;
    const size_t tok0 = (size_t)b * SEQ + n * 64;
    LAS float* beta_s = (LAS float*)(lds + D1_OFF_S); LAS float* dec_s = beta_s + 64;
    { const int t = tid >> 3, d16 = tid & 7, s = n * 64 + t; float qk_[2][16]; float ssq[2] = {0.f, 0.f};
#pragma unroll
      for (int p = 0; p < 3; ++p)
#pragma unroll
          for (int hf = 0; hf < 2; ++hf) { const int col = p * W_D + h * 128 + 16 * d16 + 8 * hf; float a[8];
#pragma unroll
              for (int i = 0; i < 8; ++i) a[i] = 0.f;
#pragma unroll
              for (int j = 0; j < 4; ++j) { if (s - 3 + j >= 0) { float xv[8]; ld8bf(PROJ + (tok0 + t - 3 + j) * OD_N + OC_QD + col, xv);
                      const f32x4 w0 = *(const f32x4*)(cdw + j * 3 * W_D + col), w1 = *(const f32x4*)(cdw + j * 3 * W_D + col + 4);
                      a[0] += w0[0] * xv[0]; a[1] += w0[1] * xv[1]; a[2] += w0[2] * xv[2]; a[3] += w0[3] * xv[3]; a[4] += w1[0] * xv[4]; a[5] += w1[1] * xv[5]; a[6] += w1[2] * xv[6]; a[7] += w1[3] * xv[7]; } }
#pragma unroll
              for (int i = 0; i < 8; ++i) a[i] = fsilu(a[i]);
              if (p < 2) {
#pragma unroll
                  for (int i = 0; i < 8; ++i) { qk_[p][8 * hf + i] = a[i]; ssq[p] += a[i] * a[i]; } }
              else { v4u w; w.x = pk2(a[0], a[1]); w.y = pk2(a[2], a[3]); w.z = pk2(a[4], a[5]); w.w = pk2(a[6], a[7]);
                  *(LAS v4u*)(lds + D1_OFF_V + t * D1_RSV + (16 * d16 + 8 * hf) * 2) = w; } }
#pragma unroll
      for (int p = 0; p < 2; ++p) { float ss = ssq[p]; ss += __shfl_xor(ss, 1); ss += __shfl_xor(ss, 2); ss += __shfl_xor(ss, 4); const float rs = frsq(ss + EPS);
#pragma unroll
          for (int hf = 0; hf < 2; ++hf) { v4u w; w.x = pk2(qk_[p][8 * hf + 0] * rs, qk_[p][8 * hf + 1] * rs); w.y = pk2(qk_[p][8 * hf + 2] * rs, qk_[p][8 * hf + 3] * rs);
              w.z = pk2(qk_[p][8 * hf + 4] * rs, qk_[p][8 * hf + 5] * rs); w.w = pk2(qk_[p][8 * hf + 6] * rs, qk_[p][8 * hf + 7] * rs);
              const int dd = 16 * d16 + 8 * hf;
              if (p == 0) { *(LAS v4u*)(lds + D1_OFF_Q + t * D1_RSQ + dd * 2) = w; *(v4u*)(Q2 + (tok0 + t) * W_D + h * 128 + dd) = w; }
              else { *(LAS v4u*)(lds + D1_OFF_K + t * D1_RSK + dd * 2) = w; *(v4u*)(K2 + (tok0 + t) * W_D + h * 128 + dd) = w; } } } }
    if (wave == 0) { const size_t tok = tok0 + lane;
        const float beta = fsigmoid(AB[tok * 16 + 8 + h]); float dc = -fexp(P.in[IN_OD_ALOG][h]) * softplusf_(AB[tok * 16 + h] + P.in[IN_OD_DTB][h]);
#pragma unroll
        for (int o = 1; o < 64; o <<= 1) { const float t_ = __shfl_up(dc, o); if (lane >= o) dc += t_; }
        beta_s[lane] = beta; dec_s[lane] = dc; DECg[lane] = dc; }
    __syncthreads();
    { const int tt = wave >> 1, t = 16 * tt + l15; const float dt_ = dec_s[t], bt = beta_s[t];
#pragma unroll
      for (int u = 0; u < 2; ++u) { const int st = 2 * (wave & 1) + u; unsigned long long qw = 0ull;
          if (st <= tt) { f32x4 kk = (f32x4){0.f, 0.f, 0.f, 0.f}, qk = kk;
#pragma unroll
              for (int ks = 0; ks < 4; ++ks) { const bf16x8 a = frag_row(lds + D1_OFF_K, D1_RSK, 16 * st, 32 * ks, lane);
                  kk = MFMA16(a, frag_row(lds + D1_OFF_K, D1_RSK, 16 * tt, 32 * ks, lane), kk); qk = MFMA16(a, frag_row(lds + D1_OFF_Q, D1_RSQ, 16 * tt, 32 * ks, lane), qk); }
              f32x4 am; float qv[4];
#pragma unroll
              for (int r = 0; r < 4; ++r) { const int s = 16 * st + 4 * g + r; const float gam = (s <= t) ? fexp(dt_ - dec_s[s]) : 0.f; am[r] = (s < t) ? bt * kk[r] * gam : 0.f; qv[r] = qk[r] * gam * DN_SCALE; }
              *(LAS f32x4*)(lds + D1_OFF_A + t * D1_RSA + (16 * st + 4 * g) * 4) = am;
              qw = (unsigned long long)pk2(qv[0], qv[1]) | ((unsigned long long)pk2(qv[2], qv[3]) << 32); }
          *(unsigned long long*)(QKg + t * 64 + 16 * st + 4 * g) = qw; } }
    __syncthreads();
    if (wave == 0) { const int hb = lane >> 5, j = lane & 31; float col[32];
        LAS const unsigned char* Ab = lds + D1_OFF_A + (32 * hb) * D1_RSA + (32 * hb) * 4;
        SolveRows<31>::run(col, Ab, j);
        LAS unsigned char* trow = lds + D1_OFF_T + (32 * hb + j) * D1_RST;
#pragma unroll
        for (int c = 0; c < 4; ++c) { v4u w; w.x = pk2(col[8 * c], col[8 * c + 1]); w.y = pk2(col[8 * c + 2], col[8 * c + 3]); w.z = pk2(col[8 * c + 4], col[8 * c + 5]); w.w = pk2(col[8 * c + 6], col[8 * c + 7]);
            *(LAS v4u*)(trow + (32 * hb) * 2 + 16 * c) = w;
            if (hb) *(LAS v4u*)(trow + 16 * c) = (v4u){0u, 0u, 0u, 0u}; }
        bf16x8 af[2], bfr[2];
#pragma unroll
        for (int ti = 0; ti < 2; ++ti) { LAS const unsigned char* ap = lds + D1_OFF_A + (32 + 16 * ti + l15) * D1_RSA + (8 * g) * 4; const f32x4 a0 = *(LAS const f32x4*)ap, a1 = *(LAS const f32x4*)(ap + 16);
            typedef unsigned u32x4_ __attribute__((ext_vector_type(4))); const u32x4_ w = {pk2(a0[0], a0[1]), pk2(a0[2], a0[3]), pk2(a1[0], a1[1]), pk2(a1[2], a1[3])}; af[ti] = __builtin_bit_cast(bf16x8, w); }
#pragma unroll
        for (int nj = 0; nj < 2; ++nj) bfr[nj] = frag_row(lds + D1_OFF_T, D1_RST, 16 * nj, 0, lane);
        f32x4 X[2][2];
#pragma unroll
        for (int ti = 0; ti < 2; ++ti)
#pragma unroll
            for (int nj = 0; nj < 2; ++nj) X[ti][nj] = MFMA16(af[ti], bfr[nj], ((f32x4){0.f, 0.f, 0.f, 0.f}));
        LAS const unsigned char* T11b = lds + D1_OFF_T + 32 * D1_RST + 64;
#pragma unroll
        for (int nj = 0; nj < 2; ++nj) { const bf16x8 xb = acc_pair_frag(X[0][nj], X[1][nj]);
#pragma unroll
            for (int ti = 0; ti < 2; ++ti) { const f32x4 r_ = MFMA16(frag_tr_perm(T11b, D1_RST, 0, 16 * ti, lane), xb, ((f32x4){0.f, 0.f, 0.f, 0.f}));
                *(LAS unsigned long long*)(lds + D1_OFF_T + (16 * nj + l15) * D1_RST + (32 + 16 * ti + 4 * g) * 2) = (unsigned long long)pk2(-r_[0], -r_[1]) | ((unsigned long long)pk2(-r_[2], -r_[3]) << 32); } }
    }
    __syncthreads();
    { bf16x8 bv[2], bk[2];
#pragma unroll
      for (int ks = 0; ks < 2; ++ks) { typedef unsigned u32x4_ __attribute__((ext_vector_type(4)));
          const u32x4_ wv = __builtin_bit_cast(u32x4_, frag_tr(lds + D1_OFF_V, D1_RSV, 32 * ks, 16 * wave, lane)), wk = __builtin_bit_cast(u32x4_, frag_tr(lds + D1_OFF_K, D1_RSK, 32 * ks, 16 * wave, lane));
          float fb[8], fk[8];
#pragma unroll
          for (int i = 0; i < 8; ++i) { const int s = 32 * ks + 8 * g + i; fb[i] = beta_s[s]; fk[i] = fb[i] * fexp(dec_s[s]); }
#define SC2(w_, f0, f1) pk2(__builtin_bit_cast(float, (w_) << 16) * (f0), __builtin_bit_cast(float, (w_) & 0xffff0000u) * (f1))
          const u32x4_ ov = {SC2(wv.x, fb[0], fb[1]), SC2(wv.y, fb[2], fb[3]), SC2(wv.z, fb[4], fb[5]), SC2(wv.w, fb[6], fb[7])};
          const u32x4_ ok = {SC2(wk.x, fk[0], fk[1]), SC2(wk.y, fk[2], fk[3]), SC2(wk.z, fk[4], fk[5]), SC2(wk.w, fk[6], fk[7])};
#undef SC2
          bv[ks] = __builtin_bit_cast(bf16x8, ov); bk[ks] = __builtin_bit_cast(bf16x8, ok); }
#pragma unroll
      for (int tt = 0; tt < 4; ++tt) { f32x4 u = (f32x4){0.f, 0.f, 0.f, 0.f}, wv = u;
#pragma unroll
          for (int ks = 0; ks < 2; ++ks) { const bf16x8 at = frag_tr(lds + D1_OFF_T, D1_RST, 32 * ks, 16 * tt, lane); u = MFMA16(at, bv[ks], u); wv = MFMA16(at, bk[ks], wv); }
          const size_t o_ = (size_t)(16 * wave + l15) * 64 + 16 * tt + 4 * g;
          *(unsigned long long*)(UTg + o_) = (unsigned long long)pk2(u[0], u[1]) | ((unsigned long long)pk2(u[2], u[3]) << 32);
          *(unsigned long long*)(WTg + o_) = (unsigned long long)pk2(wv[0], wv[1]) | ((unsigned long long)pk2(wv[2], wv[3]) << 32); } }
    __syncthreads();
}
constexpr int D2_RSW = 144, D2_RSQ = 272, D2_RSK = 288, D2_RSP = 144, D2_RSO = 528;
constexpr int D2_OFF_W = 0, D2_OFF_Q = D2_OFF_W + 128 * D2_RSW, D2_OFF_K = D2_OFF_Q + 64 * D2_RSQ, D2_OFF_P = D2_OFF_K + 64 * D2_RSK, D2_OFF_O = D2_OFF_P + 64 * D2_RSP, D2_OFF_D = D2_OFF_O + 64 * D2_RSO, D2_LDS = D2_OFF_D + 1024;
static_assert(D2_LDS <= 163328, "D2 LDS");
__device__ __forceinline__ void dn2_item(const Ptrs& P, LAS unsigned char* lds, int item) {
    const bf16_t* __restrict__ PROJ = (const bf16_t*)(P.ws + WS_PROJ); bf16_t* __restrict__ Y = (bf16_t*)(P.ws + WS_Y);
    const bf16_t* __restrict__ Q2 = (const bf16_t*)(P.ws + WS_DQ2); const bf16_t* __restrict__ K2 = (const bf16_t*)(P.ws + WS_DK2);
    const int tid = threadIdx.x, lane = tid & 63, wave = tid >> 6, g = lane >> 4, l15 = lane & 15;
    const int h = item & 7, b = item >> 3;
    const size_t tok0 = (size_t)b * SEQ; const int it0 = item * 32;
    const bf16_t* __restrict__ WTg = (const bf16_t*)(P.ws + WS_DWT) + (size_t)it0 * 8192; const bf16_t* __restrict__ UTg = (const bf16_t*)(P.ws + WS_DUT) + (size_t)it0 * 8192;
    const bf16_t* __restrict__ QKg = (const bf16_t*)(P.ws + WS_DQK) + (size_t)it0 * 4096; const float* __restrict__ DECg = (const float*)(P.ws + WS_DDEC) + (size_t)it0 * 64;
    LAS float* ed_s = (LAS float*)(lds + D2_OFF_D); LAS float* ek_s = ed_s + 64; LAS float* edl_s = ed_s + 128;
    f32x4 sacc[8];
#pragma unroll
    for (int i = 0; i < 8; ++i) sacc[i] = (f32x4){0.f, 0.f, 0.f, 0.f};
    const int ot = tid >> 3, oc = (tid & 7) * 16;
    float og[16];
#pragma unroll
    for (int i = 0; i < 16; ++i) og[i] = P.in[IN_OD_ONORM][oc + i];
    v4u wreg[2], qreg[2], kreg[2], preg, zreg[2]; unsigned long long ureg[4]; float dreg = 0.f, dlreg = 0.f;
#define D2_LOAD(n) do { _Pragma("unroll") for (int i_ = 0; i_ < 2; ++i_) { const int id_ = tid + 512 * i_; wreg[i_] = *(const v4u*)(WTg + (size_t)(n) * 8192 + id_ * 8); \
            const int row_ = id_ >> 4, ch_ = id_ & 15; const size_t o2_ = (tok0 + (n) * 64 + row_) * W_D + h * 128 + ch_ * 8; qreg[i_] = *(const v4u*)(Q2 + o2_); kreg[i_] = *(const v4u*)(K2 + o2_); } \
        preg = *(const v4u*)(QKg + (size_t)(n) * 4096 + tid * 8); \
        _Pragma("unroll") for (int tt_ = 0; tt_ < 4; ++tt_) ureg[tt_] = *(const unsigned long long*)(UTg + (size_t)(n) * 8192 + (16 * wave + l15) * 64 + 16 * tt_ + 4 * g); \
        if (tid < 64) { dreg = DECg[(n) * 64 + tid]; dlreg = DECg[(n) * 64 + 63]; } } while (0)
#define D2_LOAD_Z(n) do { const bf16_t* zp_ = PROJ + (tok0 + (n) * 64 + ot) * OD_N + OC_ZD + h * 128 + oc; zreg[0] = *(const v4u*)zp_; zreg[1] = *(const v4u*)(zp_ + 8); } while (0)
#define D2_STORE() do { _Pragma("unroll") for (int i_ = 0; i_ < 2; ++i_) { const int id_ = tid + 512 * i_; *(LAS v4u*)(lds + D2_OFF_W + (id_ >> 3) * D2_RSW + (id_ & 7) * 16) = wreg[i_]; \
            const int row_ = id_ >> 4, ch_ = id_ & 15; *(LAS v4u*)(lds + D2_OFF_Q + row_ * D2_RSQ + ch_ * 16) = qreg[i_]; *(LAS v4u*)(lds + D2_OFF_K + row_ * D2_RSK + ch_ * 16) = kreg[i_]; } \
        *(LAS v4u*)(lds + D2_OFF_P + (tid >> 3) * D2_RSP + (tid & 7) * 16) = preg; \
        if (tid < 64) { ed_s[tid] = fexp(dreg) * DN_SCALE; ek_s[tid] = fexp(dlreg - dreg); if (tid == 0) edl_s[0] = fexp(dlreg); } } while (0)
    D2_LOAD(0);
    for (int n = 0; n < NCH; ++n) {
        D2_STORE();
        f32x4 un[4];
#pragma unroll
        for (int tt = 0; tt < 4; ++tt) { un[tt][0] = __builtin_bit_cast(float, (unsigned)(ureg[tt] & 0xffffull) << 16); un[tt][1] = __builtin_bit_cast(float, (unsigned)(ureg[tt] >> 16 & 0xffffull) << 16);
            un[tt][2] = __builtin_bit_cast(float, (unsigned)(ureg[tt] >> 32 & 0xffffull) << 16); un[tt][3] = __builtin_bit_cast(float, (unsigned)(ureg[tt] >> 48) << 16); }
        __syncthreads();
        if (n + 1 < NCH) D2_LOAD(n + 1);
        bf16x8 sf[4];
#pragma unroll
        for (int j = 0; j < 4; ++j) sf[j] = acc_pair_frag(sacc[2 * j], sacc[2 * j + 1]);
        f32x4 vn[4], o[4];
#pragma unroll
        for (int tt = 0; tt < 4; ++tt) { f32x4 ws_ = (f32x4){0.f, 0.f, 0.f, 0.f}, qs_ = ws_;
#pragma unroll
            for (int j = 0; j < 4; ++j) { ws_ = MFMA16(frag_tr_perm(lds + D2_OFF_W, D2_RSW, 32 * j, 16 * tt, lane), sf[j], ws_); qs_ = MFMA16(frag_row_perm(lds + D2_OFF_Q, D2_RSQ, 16 * tt, 32 * j, lane), sf[j], qs_); }
            vn[tt] = un[tt] - ws_; o[tt] = qs_ * *(LAS const f32x4*)(ed_s + 16 * tt + 4 * g); }
        __builtin_amdgcn_sched_barrier(0);
        bf16x8 vf[2], vsf[2];
#pragma unroll
        for (int ks = 0; ks < 2; ++ks) { vf[ks] = acc_pair_frag(vn[2 * ks], vn[2 * ks + 1]);
            const f32x4 a_ = vn[2 * ks] * *(LAS const f32x4*)(ek_s + 32 * ks + 4 * g), b_ = vn[2 * ks + 1] * *(LAS const f32x4*)(ek_s + 32 * ks + 16 + 4 * g);
            vsf[ks] = acc_pair_frag(a_, b_); }
#pragma unroll
        for (int tt = 0; tt < 4; ++tt)
#pragma unroll
            for (int ks = 0; ks < 2; ++ks) o[tt] = MFMA16(frag_row_perm(lds + D2_OFF_P, D2_RSP, 16 * tt, 32 * ks, lane), vf[ks], o[tt]);
#pragma unroll
        for (int tt = 0; tt < 4; ++tt)
#pragma unroll
            for (int r = 0; r < 4; ++r) *(LAS float*)(lds + D2_OFF_O + (16 * tt + 4 * g + r) * D2_RSO + (16 * wave + l15) * 4) = o[tt][r];
        __builtin_amdgcn_sched_barrier(0);
        D2_LOAD_Z(n);
        { const float edl = edl_s[0];
#pragma unroll
          for (int kt = 0; kt < 8; ++kt) { sacc[kt] *= edl;
#pragma unroll
              for (int ks = 0; ks < 2; ++ks) sacc[kt] = MFMA16(frag_tr_perm(lds + D2_OFF_K, D2_RSK, 32 * ks, 16 * kt, lane), vsf[ks], sacc[kt]);
              if ((kt & 3) == 3) __builtin_amdgcn_sched_barrier(0); }
#pragma unroll
          for (int kt = 0; kt < 8; ++kt) asm volatile("" : "+v"(sacc[kt])); }
        __syncthreads();
        { f32x4 ov[4]; float ss = 0.f;
#pragma unroll
          for (int c = 0; c < 4; ++c) { ov[c] = *(LAS const f32x4*)(lds + D2_OFF_O + ot * D2_RSO + (oc + 4 * c) * 4); ss += (ov[c][0] * ov[c][0] + ov[c][1] * ov[c][1]) + (ov[c][2] * ov[c][2] + ov[c][3] * ov[c][3]); }
          ss += __shfl_xor(ss, 1); ss += __shfl_xor(ss, 2); ss += __shfl_xor(ss, 4);
          const float rs = frsq(ss * (1.0f / 128.0f) + EPS);
          bf16_t* yp = Y + (tok0 + n * 64 + ot) * D_MODEL + W_C + h * 128 + oc;
#pragma unroll
          for (int c = 0; c < 2; ++c) { const v4u zw = zreg[c]; const f32x4 a = ov[2 * c], b_ = ov[2 * c + 1];
#define D2_Y(ov_, gi, zx, lo) ((ov_) * rs * og[gi] * fsilu(__builtin_bit_cast(float, (lo) ? ((zx) << 16) : ((zx) & 0xffff0000u))))
              v4u yw; yw.x = pk2(D2_Y(a[0], 8 * c + 0, zw.x, 1), D2_Y(a[1], 8 * c + 1, zw.x, 0)); yw.y = pk2(D2_Y(a[2], 8 * c + 2, zw.y, 1), D2_Y(a[3], 8 * c + 3, zw.y, 0));
              yw.z = pk2(D2_Y(b_[0], 8 * c + 4, zw.z, 1), D2_Y(b_[1], 8 * c + 5, zw.z, 0)); yw.w = pk2(D2_Y(b_[2], 8 * c + 6, zw.w, 1), D2_Y(b_[3], 8 * c + 7, zw.w, 0));
#undef D2_Y
              *(v4u*)(yp + 8 * c) = yw; } }
    }
#undef D2_LOAD
#undef D2_LOAD_Z
#undef D2_STORE
    __syncthreads();
}
__device__ __forceinline__ void vb_attn(const bf16_t* __restrict__ PROJ, const float* __restrict__ qn_g, const float* __restrict__ kn_g, const float* __restrict__ rel_bias, bf16_t* __restrict__ Y,
                                        int bid, int t, LAS float* qs  , LAS float* S  , bool active) {
    if (!active) bid = 0;
    const int quarter = bid & 3, c = (bid >> 2) & 31, h = (bid >> 7) & 7, b = bid >> 10;
    { const int r = t >> 4, sub = t & 15; const int tok = b * SEQ + c * 64 + quarter * 16 + r;
      float v[8]; ld8bf(PROJ + (size_t)tok * EV_N + EC_QA + h * 128 + sub * 8, v);
      float ss = 0.f;
#pragma unroll
      for (int i = 0; i < 8; ++i) ss += v[i] * v[i];
      ss += __shfl_xor(ss, 1); ss += __shfl_xor(ss, 2); ss += __shfl_xor(ss, 4); ss += __shfl_xor(ss, 8);
      const float rs = 1.0f / sqrtf(ss * (1.0f / 128.0f) + EPS);
#pragma unroll
      for (int i = 0; i < 8; ++i) qs[r * 128 + sub * 8 + i] = v[i] * rs * qn_g[sub * 8 + i] * 0.08838834764831845f; }
    __syncthreads();
    for (int idx = t; idx < 16 * BAND; idx += 256) {
        const int r = idx / BAND, j = idx % BAND; const int kc = c - LOOKBACK + (j >> 6);
        float s;
        if (kc < 0) s = -1e30f;
        else { const bf16_t* kp = PROJ + (size_t)(b * SEQ + kc * 64 + (j & 63)) * EV_N + EC_KA + h * 128;
            float ss = 0.f, dot = 0.f;
            for (int d = 0; d < 128; d += 8) { float kv[8]; ld8bf(kp + d, kv);
#pragma unroll
                for (int i = 0; i < 8; ++i) { ss += kv[i] * kv[i]; dot += kv[i] * kn_g[d + i] * qs[r * 128 + d + i]; } }
            s = dot * (1.0f / sqrtf(ss * (1.0f / 128.0f) + EPS));
            const int qi = quarter * 16 + r; int rel = LOOKBACK * CHUNK + qi - j; rel = rel < -REL_MAX ? -REL_MAX : (rel > REL_MAX ? REL_MAX : rel); rel += REL_MAX;
            s += rel_bias[h * NREL + rel]; }
        S[r * 577 + j] = s;
    }
    __syncthreads();
    { const int r = t >> 4, sub = t & 15; float mx = -3.0e38f;
      for (int j = sub; j < BAND; j += 16) mx = fmaxf(mx, S[r * 577 + j]);
      mx = fmaxf(mx, __shfl_xor(mx, 1)); mx = fmaxf(mx, __shfl_xor(mx, 2)); mx = fmaxf(mx, __shfl_xor(mx, 4)); mx = fmaxf(mx, __shfl_xor(mx, 8));
      float sum = 0.f;
      for (int j = sub; j < BAND; j += 16) { const float e = expf(S[r * 577 + j] - mx); S[r * 577 + j] = e; sum += e; }
      sum += __shfl_xor(sum, 1); sum += __shfl_xor(sum, 2); sum += __shfl_xor(sum, 4); sum += __shfl_xor(sum, 8);
      const float inv = 1.0f / sum;
      for (int j = sub; j < BAND; j += 16) S[r * 577 + j] *= inv; }
    __syncthreads();
    { const int r = t >> 4, dg = t & 15; float acc[8];
#pragma unroll
      for (int i = 0; i < 8; ++i) acc[i] = 0.f;
      for (int j = 0; j < BAND; ++j) { const int kc = c - LOOKBACK + (j >> 6); if (kc < 0) continue;
          const float p = S[r * 577 + j]; float vv[8]; ld8bf(PROJ + (size_t)(b * SEQ + kc * 64 + (j & 63)) * EV_N + EC_VA + h * 128 + dg * 8, vv);
#pragma unroll
          for (int i = 0; i < 8; ++i) acc[i] += p * vv[i]; }
      const int tok = b * SEQ + c * 64 + quarter * 16 + r; float z[8]; ld8bf(PROJ + (size_t)tok * EV_N + EC_ZA + h * 128 + dg * 8, z);
      v4u o; o.x = pk2(acc[0] * siluf_(z[0]), acc[1] * siluf_(z[1])); o.y = pk2(acc[2] * siluf_(z[2]), acc[3] * siluf_(z[3]));
      o.z = pk2(acc[4] * siluf_(z[4]), acc[5] * siluf_(z[5])); o.w = pk2(acc[6] * siluf_(z[6]), acc[7] * siluf_(z[7]));
      if (active) *(v4u*)(Y + (size_t)tok * D_MODEL + h * 128 + dg * 8) = o; }
    __syncthreads();
}
__device__ __forceinline__ void vb_mlstm(const bf16_t* __restrict__ PROJ, const float* __restrict__ GIF, bf16_t* __restrict__ Y, int bid, int t, LAS float* sm  ) {
    LAS float* ks = sm; LAS float* qs = sm + 256; LAS float* part = sm + 512; LAS float* dpart = sm + 768;
    const int vs = bid & 3, h = (bid >> 2) & 3, b = bid >> 4, v = t & 63, kq = t >> 6;
    float C[64];
#pragma unroll
    for (int i = 0; i < 64; ++i) C[i] = 0.f;
    float nreg = 0.f;
    for (int s = 0; s < SEQ; ++s) {
        const size_t tok = (size_t)b * SEQ + s; const bf16_t* pr = PROJ + tok * EV_N;
        const float li = GIF[tok * 8 + h], fpre = GIF[tok * 8 + 4 + h];
        const float fw = sigmoidf_(fpre), iw = expf(li);
        const float kk = bf2f(pr[EC_KB + h * 256 + t]), qq = bf2f(pr[EC_QB + h * 256 + t]) * 0.0625f;
        const float vv = bf2f(pr[EC_VB + h * 256 + vs * 64 + v]);
        ks[t] = kk; qs[t] = qq;
        nreg = fw * nreg + iw * kk;
        float dp = nreg * qq; dp = wave_sum(dp);
        if ((t & 63) == 0) dpart[kq] = dp;
        __syncthreads();
        float np = 0.f; const float iv = iw * vv;
#pragma unroll
        for (int i = 0; i < 64; ++i) { C[i] = fw * C[i] + ks[kq * 64 + i] * iv; np += C[i] * qs[kq * 64 + i]; }
        part[kq * 64 + v] = np;
        __syncthreads();
        if (t < 64) { const float num = (part[t] + part[64 + t]) + (part[128 + t] + part[192 + t]); const float den = (dpart[0] + dpart[1]) + (dpart[2] + dpart[3]);
            const float hh = num / fmaxf(fabsf(den), 1.0f);
            const float ob = bf2f(pr[EC_OB + h * 256 + vs * 64 + t]), zb = bf2f(pr[EC_ZB + h * 256 + vs * 64 + t]);
            Y[tok * D_MODEL + W_A + h * 256 + vs * 64 + t] = (bf16_t)f2bf(sigmoidf_(ob) * hh * siluf_(zb)); }
        __syncthreads();
    }
}
__device__ __forceinline__ void phase_mix0(const Ptrs& P, LAS unsigned char* lds, int G) {
    const int w = blockIdx.x;
    constexpr int NML = BATCH * H_B * 4;
    if (w < NML) mlstm_item(P, lds, w);
    else if (G - NML == 128) {
        const int wa = w - NML, bh = wa >> 1, par = wa & 1;
        for (int k = 7; k >= 0; --k) attn_item(P, lds, bh * 16 + 2 * k + par); }
    else { for (int item = w - NML; item < BATCH * H_A * (NCH / 2); item += G - NML) attn_item(P, lds, item); }
    { const int wave = threadIdx.x >> 6, lane = threadIdx.x & 63; late_weights(P, lds, wave, lane, w * NWAVES + wave, G * NWAVES); }
}
constexpr size_t WS_RA = WS_FREE1, WS_RINP = WS_XB, WS_Q2 = 4 * MiB, WS_K2 = 36 * MiB, WS_V2 = 465 * MiB;
__device__ __forceinline__ void vb_rglru_gates(const bf16_t* __restrict__ PROJ, const float* __restrict__ ccw, const float* __restrict__ ccb, const float* __restrict__ gw, const float* __restrict__ gb,
                                               const float* __restrict__ lam, float* __restrict__ A, float* __restrict__ INP, int bid, int t, LAS float* xs  ) {
    const int blk = bid & 7, tg = bid >> 3, c = blk * 128 + t;
    float xc[8];
#pragma unroll
    for (int i = 0; i < 8; ++i) { const int tok = tg * 8 + i, s = tok % SEQ; float a = ccb[c];
#pragma unroll
        for (int j = 0; j < 4; ++j) { const int sj = s - 3 + j; if (sj >= 0) a += ccw[j * W_C + c] * bf2f(PROJ[(size_t)(tok - 3 + j) * OD_N + OC_XC + c]); }
        xc[i] = a; xs[i * 128 + t] = a; }
    __syncthreads();
    float rp[8], ip[8];
#pragma unroll
    for (int i = 0; i < 8; ++i) { rp[i] = 0.f; ip[i] = 0.f; }
    const float* g0 = gw + (size_t)blk * 128 * 256;
    for (int k = 0; k < 128; ++k) { const float wr_ = g0[k * 256 + t], wi_ = g0[k * 256 + 128 + t];
#pragma unroll
        for (int i = 0; i < 8; ++i) { const float xv = xs[i * 128 + k]; rp[i] += xv * wr_; ip[i] += xv * wi_; } }
    const float sp = softplusf_(-lam[c]); const float gbr = gb[c], gbi = gb[W_C + c];
#pragma unroll
    for (int i = 0; i < 8; ++i) { const int tok = tg * 8 + i; const float r = sigmoidf_(rp[i] + gbr), ig = sigmoidf_(ip[i] + gbi);
        const float la = -8.0f * r * sp; A[(size_t)tok * W_C + c] = expf(la); INP[(size_t)tok * W_C + c] = sqrtf(-expm1f(2.0f * la)) * (ig * xc[i]); }
    __syncthreads();
}
__device__ __forceinline__ void vb_dn_prep(const bf16_t* __restrict__ PROJ, const float* __restrict__ cdw, bf16_t* __restrict__ Q2, bf16_t* __restrict__ K2, bf16_t* __restrict__ V2, int bid, int t, LAS float* red  ) {
    const int h = bid & 7, tok = bid >> 3, s = tok % SEQ; float o[3];
#pragma unroll
    for (int p = 0; p < 3; ++p) { const int col = p * W_D + h * 128 + t; float a = 0.f;
#pragma unroll
        for (int j = 0; j < 4; ++j) { const int sj = s - 3 + j; if (sj >= 0) a += cdw[j * 3 * W_D + col] * bf2f(PROJ[(size_t)(tok - 3 + j) * OD_N + OC_QD + col]); }
        o[p] = siluf_(a); }
    float sq = wave_sum(o[0] * o[0]), sk = wave_sum(o[1] * o[1]);
    if ((t & 63) == 0) { red[(t >> 6) * 2 + 0] = sq; red[(t >> 6) * 2 + 1] = sk; }
    __syncthreads();
    sq = red[0] + red[2]; sk = red[1] + red[3];
    const size_t o_ = (size_t)tok * W_D + h * 128 + t;
    Q2[o_] = (bf16_t)f2bf(o[0] * (1.0f / sqrtf(sq + EPS))); K2[o_] = (bf16_t)f2bf(o[1] * (1.0f / sqrtf(sk + EPS))); V2[o_] = (bf16_t)f2bf(o[2]);
    __syncthreads();
}
__device__ __forceinline__ void phase_mix1a(const Ptrs& P, LAS unsigned char* lds, int G) {
    for (int it = blockIdx.x; it < BATCH * H_D * NCH; it += G) dn1_item(P, lds, it);
}
__device__ __forceinline__ void phase_mix1b(const Ptrs& P, LAS unsigned char* lds, int G) {
    constexpr int ND2 = BATCH * H_D;
    if ((int)blockIdx.x < ND2) dn2_item(P, lds, blockIdx.x);
    else { for (int it = blockIdx.x - ND2; it < BATCH * N_BLK_C * 4; it += G - ND2) rglru_item(P, lds, it); }
}
typedef GAS unsigned gu32;
#define RLX_AGENT __ATOMIC_RELAXED, __HIP_MEMORY_SCOPE_AGENT
constexpr int CW_BAR = 4096;
static_assert((CW_BAR + XCD_BAR_WORDS) * 4 <= (int)CTL_ZERO_BYTES, "CTL words inside the memset region");
constexpr int LDS_BYTES = 163840;
constexpr int RING_OFF = 0, RING_BYTES = LDS_BYTES - 512;
constexpr int LDSCTL_OFF = RING_BYTES, MISC_OFF = LDSCTL_OFF + 320;

struct Args { Ptrs P; int ph_lo, ph_hi; };
constexpr int N_PHASES = 8;

__global__ void __launch_bounds__(NWAVES * 64, 2) fwd_mega(Args args) {
    extern __shared__ __attribute__((aligned(16))) unsigned char lds_raw[];
    LAS unsigned char* lds = (LAS unsigned char*)lds_raw;
    volatile LAS unsigned* MISC = (volatile LAS unsigned*)(lds + MISC_OFF);
    const int tid = threadIdx.x, lane = tid & 63, wave = __builtin_amdgcn_readfirstlane(tid >> 6);
    const int G = gridDim.x;
    for (int u = tid; u < (LDS_BYTES - LDSCTL_OFF) / 4; u += NWAVES * 64) ((LAS unsigned*)(lds + LDSCTL_OFF))[u] = 0u;
    __syncthreads();
    const Ptrs& P = args.P;
    gu32* ctl = (gu32*)(P.ws + WS_CTL);
    const int lo = args.ph_lo, hi = args.ph_hi;
    XcdBarrier bar; bar.bar = (unsigned*)(ctl + CW_BAR); bar.x = 0; bar.st = nullptr;
    if (hi - lo > 1) bar = xcd_barrier_post((unsigned*)(ctl + CW_BAR), MISC + 8);
#define IN(k) (lo <= (k) && (k) < hi)
#define SEAM(k) do { if (IN(k) && IN((k) + 1)) xcd_barrier(bar); } while (0)
#ifndef DUP_PHASE
#define DUP_PHASE -1
#endif
#define RUN(k) do { \
    if ((k) == 0) phase_prologue(P, lds, wave, lane, blockIdx.x * NWAVES + wave, G * NWAVES); \
    else if ((k) == 1) phase_gemm<1>(P, lds, G, blockIdx.x); \
    else if ((k) == 2) phase_mix0(P, lds, G); \
    else if ((k) == 3) phase_gemm<2>(P, lds, G, blockIdx.x); \
    else if ((k) == 4) { phase_gemm<3>(P, lds, G, blockIdx.x); phase_gates_ab(P, G); } \
    else if ((k) == 5) phase_mix1a(P, lds, G); \
    else if ((k) == 6) phase_mix1b(P, lds, G); \
    else phase_gemm<4>(P, lds, G, blockIdx.x); } while (0)
#define STEP(k) do { if (IN(k)) { RUN(k); if (DUP_PHASE == (k)) { xcd_barrier(bar); RUN(k); } \
        if ((k) == 2 && DUP_PHASE == 20) { xcd_barrier(bar); if (blockIdx.x >= 128) phase_mix0(P, lds, G); } \
        if ((k) == 2 && DUP_PHASE == 21) { xcd_barrier(bar); if (blockIdx.x < 128) phase_mix0(P, lds, G); } \
        if ((k) == 5 && DUP_PHASE == 50) { xcd_barrier(bar); for (int it_ = blockIdx.x; it_ < BATCH * N_BLK_C * 4; it_ += G) rglru_item(P, lds, it_); } \
        if ((k) == 5 && DUP_PHASE == 51) { xcd_barrier(bar); phase_mix1a(P, lds, G); } \
        } SEAM(k); } while (0)
    STEP(0); STEP(1); STEP(2); STEP(3); STEP(4); STEP(5); STEP(6); STEP(7);
#undef STEP
#undef RUN
#undef IN
#undef SEAM
}
extern "C" void kernel_launch(void* const* d_in, const int* in_sizes, int n_in, void* d_out, int out_size, void* d_ws, size_t ws_size, hipStream_t stream) {
    static int grid = 0;
    if (grid == 0) {
        if (n_in != 20 || in_sizes[0] != M_TOK * D_MODEL || out_size != M_TOK * D_MODEL || ws_size < WS_END) {
            fprintf(stderr, "kernel_launch: unexpected shapes: n_in %d in0 %d out %d ws %zu (need %zu)\n", n_in, n_in > 0 ? in_sizes[0] : -1, out_size, ws_size, (size_t)WS_END); grid = -1; return; }
        int dev = 0, cus = 0, per_cu = 0;
        if (hipGetDevice(&dev) != hipSuccess || hipDeviceGetAttribute(&cus, hipDeviceAttributeMultiprocessorCount, dev) != hipSuccess) { grid = -1; return; }
        if (hipFuncSetAttribute((const void*)fwd_mega, hipFuncAttributeMaxDynamicSharedMemorySize, LDS_BYTES) != hipSuccess) { fprintf(stderr, "kernel_launch: hipFuncSetAttribute failed\n"); grid = -1; return; }
        if (hipOccupancyMaxActiveBlocksPerMultiprocessor(&per_cu, (const void*)fwd_mega, NWAVES * 64, LDS_BYTES) != hipSuccess || per_cu < 1) { fprintf(stderr, "kernel_launch: occupancy query says %d blocks per CU\n", per_cu); per_cu = 1; }
        (void)hipGetLastError();
        grid = cus;
    }
    if (grid < 0) return;
    if (hipMemsetAsync((char*)d_ws + WS_CTL, 0, CTL_ZERO_BYTES, stream) != hipSuccess) { fprintf(stderr, "kernel_launch: memset failed\n"); return; }
    Args a{};
    for (int i = 0; i < 20; ++i) a.P.in[i] = (const float*)d_in[i];
    a.P.out = (float*)d_out; a.P.ws = (unsigned char*)d_ws; a.ph_lo = 0; a.ph_hi = N_PHASES;
    hipLaunchKernelGGL(fwd_mega, dim3(grid), dim3(NWAVES * 64), LDS_BYTES, stream, a);
    const hipError_t le = hipPeekAtLastError();
    if (le != hipSuccess) fprintf(stderr, "kernel_launch: launch failed: %s\n", hipGetErrorName(le));
}
```

```cpp
#include <hip/hip_runtime.h>
#include <cstdio>
#include <cstdint>
#include <cmath>
#include <type_traits>

constexpr int D_MODEL = 2048, BATCH = 8, SEQ = 2048, M_TOK = BATCH * SEQ;
constexpr int CHUNK = 64, NCH = SEQ / CHUNK;
constexpr float EPS = 1e-6f;
constexpr int HD_A = 128, W_A = 1024, H_A = 8, LOOKBACK = 8, BAND = (LOOKBACK + 1) * CHUNK, REL_MAX = 256, NREL = 2 * REL_MAX + 1;
constexpr int H_B = 4, W_B = 1024, HD_B = 256;
constexpr int W_C = 1024, N_BLK_C = 8, BLK_C = 128;
constexpr int HD_D = 128, W_D = 1024, H_D = 8;
constexpr int EV_IN = 9224, EV_N = 9216;
constexpr int OD_IN = 6160, OD_N = 6144;
constexpr int EC_QA = 0, EC_KA = 1024, EC_VA = 2048, EC_ZA = 3072, EC_QB = 4096, EC_KB = 5120, EC_VB = 6144, EC_OB = 7168, EC_ZB = 8192;
constexpr int OC_XC = 0, OC_ZC = 1024, OC_QD = 2048, OC_KD = 3072, OC_VD = 4096, OC_ZD = 5120;

constexpr size_t MiB = 1u << 20;
constexpr size_t WS_CTL = 0, CTL_ZERO_BYTES = 1 * MiB;
constexpr size_t WS_R0 = 1 * MiB;
constexpr size_t WS_SS1 = WS_R0 + 64 * 1024;
constexpr size_t WS_GIF = WS_SS1 + 64 * 1024;
constexpr size_t WS_AB = WS_GIF + 512 * 1024;
constexpr size_t WS_W1T = 4 * MiB;
constexpr size_t WS_W2T = 40 * MiB;
constexpr size_t WS_W3T = 48 * MiB;
constexpr size_t WS_W4T = 73 * MiB;
constexpr size_t WS_XB = 81 * MiB;
constexpr size_t WS_Y = 145 * MiB;
constexpr size_t WS_PROJ = 209 * MiB;
constexpr size_t WS_END = 497 * MiB;
constexpr size_t WS_FREE1 = 401 * MiB;

typedef unsigned short bf16_t;
__device__ __forceinline__ float bf2f(unsigned short v) { return __builtin_bit_cast(float, (unsigned)v << 16); }
__device__ __forceinline__ unsigned f2bf(float f) { unsigned u = __builtin_bit_cast(unsigned, f); return (u + 0x7fffu + ((u >> 16) & 1u)) >> 16; }
typedef float f32x2_t_ __attribute__((ext_vector_type(2))); typedef __bf16 bf16x2_t_ __attribute__((ext_vector_type(2)));
__device__ __forceinline__ unsigned pk2(float lo, float hi) { const f32x2_t_ v = {lo, hi}; return __builtin_bit_cast(unsigned, __builtin_convertvector(v, bf16x2_t_)); }
__device__ __forceinline__ float sigmoidf_(float x) { return 1.f / (1.f + expf(-x)); }
__device__ __forceinline__ float siluf_(float x) { return x / (1.f + expf(-x)); }
__device__ __forceinline__ float softplusf_(float x) { return fmaxf(x, 0.f) + log1pf(expf(-fabsf(x))); }
__device__ __forceinline__ float logsigmoidf_(float x) { return -softplusf_(-x); }

namespace pg8 {
#define PG8_LAS __attribute__((address_space(3)))
typedef unsigned short bf16_t;
typedef short bf16x8 __attribute__((ext_vector_type(8)));
typedef float f32x4 __attribute__((ext_vector_type(4)));
typedef unsigned u32x4 __attribute__((ext_vector_type(4)));
constexpr int BM = 256, BK = 64, HALF = 128, HTB = HALF * BK * 2  , STAGE_BYTES = 8 * HTB, NXCD = 8, WGM = 4;

__host__ __device__ __forceinline__ int lds_byte(int r, int c) { const int st = (r >> 4) * 2 + (c >> 5), rr = r & 15, cc = c & 31, ob = rr * 64 + cc * 2; return st * 1024 + (ob ^ (((ob >> 9) & 1) << 5)); }
__host__ __device__ __forceinline__ void stage_rc(int b, int& R, int& C) { const int st = b / 1024, sb = b % 1024, swz = sb ^ (((sb >> 9) & 1) << 5); R = (st >> 1) * 16 + swz / 64; C = (st & 1) * 32 + (swz % 64) / 2; }
__host__ __device__ __forceinline__ int perm32(int rho) { const int n = rho >> 4, i = rho & 15; return 8 * (i >> 2) + 4 * n + (i & 3); }

struct Unit { int pm, pn; };
struct Gemm { const bf16_t* A; const bf16_t* Bt; int M, N, K; };

struct StaticOrder {
    int nM, nN, nwg, G, c;
    __host__ __device__ void init(int M, int N, int G_, int c_) { nM = M / BM; nN = N / BM; nwg = nM * nN; G = G_; c = c_; }
    __host__ __device__ bool next(int i, Unit& u) const {
        const long L = (long)i * G + c; if (L >= nwg) return false;
        int wgid = (int)L; { const int q = nwg / NXCD, r = nwg % NXCD, xcd = wgid % NXCD, off = wgid / NXCD; wgid = (xcd < r ? xcd * (q + 1) : r * (q + 1) + (xcd - r) * q) + off; }
        const int nig = WGM * nN, gid = wgid / nig, fm = gid * WGM, gsz = (nM - fm) < WGM ? (nM - fm) : WGM;
        u.pm = fm + ((wgid % nig) % gsz); u.pn = (wgid % nig) / gsz; return true;
    }
    __device__ __forceinline__ void a_ready(const Unit&) const {}
    __device__ __forceinline__ void done(const Unit&) const {}
};

__device__ __forceinline__ unsigned cvt_pk_bf16(float lo, float hi) { unsigned r; asm volatile("v_cvt_pk_bf16_f32 %0, %1, %2" : "=v"(r) : "v"(lo), "v"(hi)); return r; }
struct EpiProj {
    static constexpr bool PERM = true, AFTER_DRAIN = false;
    bf16_t* O; int ldc; const float* rowv; int mode;
    __device__ __forceinline__ void operator()(const f32x4 (&acc)[2][2][4][2], const Unit& u, int wr, int wc, int fr, int fq) const {
        const int row0 = u.pm * BM + wr * 64 + fr; const int col0 = u.pn * BM + wc * 32 + 8 * fq;
#pragma unroll
        for (int ai = 0; ai < 2; ++ai)
#pragma unroll
            for (int m = 0; m < 4; ++m) { const int row = row0 + ai * HALF + m * 16; float sc = rowv[row]; if (mode) sc = 1.0f / sqrtf(sc * (1.0f / 2048.0f) + 1e-6f);
                bf16_t* rowp = O + (size_t)row * ldc + col0;
#pragma unroll
                for (int bj = 0; bj < 2; ++bj) { const f32x4 v0 = acc[ai][bj][m][0] * sc, v1 = acc[ai][bj][m][1] * sc;
                    u32x4 w; w.x = cvt_pk_bf16(v0[0], v0[1]); w.y = cvt_pk_bf16(v0[2], v0[3]); w.z = cvt_pk_bf16(v1[0], v1[1]); w.w = cvt_pk_bf16(v1[2], v1[3]);
                    *(u32x4*)(rowp + bj * HALF) = w; } }
    }
};
struct EpiRes {
    static constexpr bool PERM = false, AFTER_DRAIN = false;
    const float* base; float* out; bf16_t* xb; float* sumsq; int ldc;
    __device__ __forceinline__ void operator()(const f32x4 (&acc)[2][2][4][2], const Unit& u, int wr, int wc, int fr, int fq) const {
        typedef unsigned u32x2v __attribute__((ext_vector_type(2)));
        const int col0 = u.pn * BM + wc * 32 + 4 * fq;
#pragma unroll
        for (int ai = 0; ai < 2; ++ai)
#pragma unroll
            for (int m = 0; m < 4; ++m) { const int row = u.pm * BM + ai * HALF + wr * 64 + m * 16 + fr; const size_t off = (size_t)row * ldc + col0; float ss = 0.f;
#pragma unroll
                for (int bj = 0; bj < 2; ++bj)
#pragma unroll
                    for (int n = 0; n < 2; ++n) { const f32x4 o = *(const f32x4*)(base + off + bj * HALF + n * 16) + acc[ai][bj][m][n];
                        *(f32x4*)(out + off + bj * HALF + n * 16) = o;
                        if (xb) { u32x2v w; w.x = cvt_pk_bf16(o[0], o[1]); w.y = cvt_pk_bf16(o[2], o[3]); *(u32x2v*)(xb + off + bj * HALF + n * 16) = w; }
                        ss += (o[0] * o[0] + o[1] * o[1]) + (o[2] * o[2] + o[3] * o[3]); }
                if (sumsq) { ss += __shfl_xor(ss, 16); ss += __shfl_xor(ss, 32); if (fq == 0) atomicAdd(sumsq + row, ss); } }
    }
};

template <class Epi, class Sched, bool ALIGN_EPI = false, bool SP2 = false>
__device__ __forceinline__ void gemm_phase(PG8_LAS unsigned char* lds, const Gemm g, const Sched& S, const Epi& E) {
    const int tid = threadIdx.x, wid = __builtin_amdgcn_readfirstlane(tid >> 6), lane = tid & 63, wr = wid >> 2, wc = wid & 3, fr = lane & 15, fq = lane >> 4;
    const int K = g.K, nt = K / BK;
    unsigned voffA[2], voffB[2];
#pragma unroll
    for (int i = 0; i < 2; ++i) { int R, C; stage_rc(tid * 16 + i * 8192, R, C); const int Rb = Epi::PERM ? ((R & ~31) + perm32(R & 31)) : R;
        voffA[i] = (unsigned)(R * K + C) * 2u; voffB[i] = (unsigned)(Rb * K + C) * 2u; }
    const size_t kstep = (size_t)(BK * 2);
    const size_t hstep = (size_t)HALF * K * 2;
    const size_t tstep = 2 * hstep;
    const unsigned ldsw = (unsigned)wid * 1024u;
    const int aoff = lds_byte(wr * 64 + fr, fq * 8), boff = lds_byte(wc * 32 + fr, fq * 8);
#define PG8_SA(b, h) (((b) * 2 + (h)) * HTB)
#define PG8_SB(b, h) ((4 + (b) * 2 + (h)) * HTB)
#define PG8_STAGE(bufoff, gbase, voff) do { _Pragma("unroll") for (int _i = 0; _i < 2; ++_i) \
        __builtin_amdgcn_global_load_lds((const unsigned*)((const char*)(gbase) + (voff)[_i]), (PG8_LAS unsigned*)(lds + (bufoff) + ldsw + _i * 8192), 16, 0, 0); } while (0)
#define PG8_LDA(dst, b, h) do { _Pragma("unroll") for (int m = 0; m < 4; ++m) _Pragma("unroll") for (int k = 0; k < 2; ++k) dst[m][k] = *(const PG8_LAS bf16x8*)(lds + PG8_SA(b, h) + aoff + m * 2048 + k * 1024); } while (0)
#define PG8_LDB(dst, b, h) do { _Pragma("unroll") for (int n = 0; n < 2; ++n) _Pragma("unroll") for (int k = 0; k < 2; ++k) dst[n][k] = *(const PG8_LAS bf16x8*)(lds + PG8_SB(b, h) + boff + n * 2048 + k * 1024); } while (0)
#define PG8_MMA(ai, bj, At, Bt) do { __builtin_amdgcn_s_setprio(1); _Pragma("unroll") for (int m = 0; m < 4; ++m) _Pragma("unroll") for (int n = 0; n < 2; ++n) _Pragma("unroll") for (int k = 0; k < 2; ++k) \
        acc[ai][bj][m][n] = __builtin_amdgcn_mfma_f32_16x16x32_bf16(Bt[n][k], At[m][k], acc[ai][bj][m][n], 0, 0, 0); __builtin_amdgcn_s_setprio(0); } while (0)
#define PG8_WAIT_V(n) asm volatile("s_waitcnt vmcnt(" #n ")" ::: "memory")
#define PG8_WAIT_L(n) asm volatile("s_waitcnt lgkmcnt(" #n ")" ::: "memory")
#define PG8_BAR __builtin_amdgcn_s_barrier()
#define PG8_SCHED __builtin_amdgcn_sched_barrier(0)
    Unit cur, nxt; int ui = 0;
    if (!S.next(0, cur)) return;
    f32x4 acc[2][2][4][2];
#pragma unroll
    for (int a = 0; a < 2; ++a)
#pragma unroll
        for (int b = 0; b < 2; ++b)
#pragma unroll
            for (int m = 0; m < 4; ++m)
#pragma unroll
                for (int n = 0; n < 2; ++n) acc[a][b][m][n] = (f32x4){0.f, 0.f, 0.f, 0.f};
    bf16x8 At[4][2], B0[2][2], B1[2][2];
    const char* cA = (const char*)g.A + (size_t)cur.pm * tstep; const char* cB = (const char*)g.Bt + (size_t)cur.pn * tstep;
    S.a_ready(cur);
    if constexpr (SP2) {
        PG8_STAGE(PG8_SB(0, 0), cB, voffB); PG8_STAGE(PG8_SB(0, 1), cB + hstep, voffB); PG8_STAGE(PG8_SA(0, 0), cA, voffA); PG8_STAGE(PG8_SA(0, 1), cA + hstep, voffA);
        if (wr == 1) PG8_BAR;
        PG8_WAIT_V(2); PG8_BAR;
        PG8_STAGE(PG8_SB(1, 0), cB + kstep, voffB); PG8_STAGE(PG8_SA(1, 0), cA + kstep, voffA); PG8_STAGE(PG8_SB(1, 1), cB + hstep + kstep, voffB);
        PG8_WAIT_V(6); PG8_BAR;
    } else {
        PG8_STAGE(PG8_SB(0, 0), cB, voffB); PG8_STAGE(PG8_SA(0, 0), cA, voffA); PG8_STAGE(PG8_SB(0, 1), cB + hstep, voffB); PG8_STAGE(PG8_SA(0, 1), cA + hstep, voffA);
        if (wr == 1) PG8_BAR;
        PG8_WAIT_V(4); PG8_BAR;
        PG8_STAGE(PG8_SB(1, 0), cB + kstep, voffB); PG8_STAGE(PG8_SA(1, 0), cA + kstep, voffA); PG8_STAGE(PG8_SB(1, 1), cB + hstep + kstep, voffB);
        PG8_WAIT_V(6); PG8_BAR;
    }
    for (;;) {
        const bool has_next = S.next(ui + 1, nxt);
        const char* nA = has_next ? (const char*)g.A + (size_t)nxt.pm * tstep : cA; const char* nB = has_next ? (const char*)g.Bt + (size_t)nxt.pn * tstep : cB;
        for (int t = 0; t < nt; t += 2) {
            const bool last = (t == nt - 2);
            const char* a1 = cA + (size_t)(t + 1) * kstep;
            const char* a2 = last ? nA : cA + (size_t)(t + 2) * kstep; const char* b2 = last ? nB : cB + (size_t)(t + 2) * kstep;
            const char* a3 = a2 + kstep; const char* b3 = b2 + kstep;
            if (last && has_next) S.a_ready(nxt);
            if constexpr (SP2) {
            PG8_LDB(B0, 0, 0); PG8_LDB(B1, 0, 1); PG8_SCHED; PG8_LDA(At, 0, 0); PG8_STAGE(PG8_SA(1, 1), a1 + hstep, voffA);
            PG8_WAIT_V(8); PG8_WAIT_L(0); PG8_BAR; PG8_MMA(0, 0, At, B0); PG8_MMA(0, 1, At, B1); PG8_BAR; PG8_SCHED;
            PG8_LDA(At, 0, 1); PG8_STAGE(PG8_SB(0, 0), b2, voffB); PG8_STAGE(PG8_SB(0, 1), b2 + hstep, voffB); PG8_STAGE(PG8_SA(0, 0), a2, voffA);
            PG8_WAIT_V(8); PG8_WAIT_L(0); PG8_BAR; PG8_MMA(1, 0, At, B0); PG8_MMA(1, 1, At, B1); PG8_BAR; PG8_SCHED;
            PG8_LDB(B0, 1, 0); PG8_LDB(B1, 1, 1); PG8_SCHED; PG8_LDA(At, 1, 0); PG8_STAGE(PG8_SA(0, 1), a2 + hstep, voffA);
            PG8_WAIT_V(8); PG8_WAIT_L(0); PG8_BAR; PG8_MMA(0, 0, At, B0); PG8_MMA(0, 1, At, B1); PG8_BAR; PG8_SCHED;
            PG8_LDA(At, 1, 1); PG8_STAGE(PG8_SB(1, 0), b3, voffB); PG8_STAGE(PG8_SB(1, 1), b3 + hstep, voffB); PG8_STAGE(PG8_SA(1, 0), a3, voffA);
            PG8_WAIT_V(8); PG8_WAIT_L(0); PG8_BAR; PG8_MMA(1, 0, At, B0); PG8_MMA(1, 1, At, B1); PG8_BAR; PG8_SCHED;
            } else {
            PG8_LDB(B0, 0, 0); PG8_SCHED; PG8_LDA(At, 0, 0); PG8_STAGE(PG8_SA(1, 1), a1 + hstep, voffA);
            PG8_WAIT_L(8); PG8_BAR; PG8_WAIT_L(0); PG8_MMA(0, 0, At, B0); PG8_BAR; PG8_SCHED;
            PG8_LDB(B1, 0, 1); PG8_STAGE(PG8_SB(0, 0), b2, voffB);
            PG8_BAR; PG8_WAIT_L(0); PG8_MMA(0, 1, At, B1); PG8_BAR;
            PG8_LDA(At, 0, 1); PG8_STAGE(PG8_SA(0, 0), a2, voffA);
            PG8_BAR; PG8_WAIT_L(0); PG8_MMA(1, 0, At, B0); PG8_BAR; PG8_SCHED;
            PG8_STAGE(PG8_SB(0, 1), b2 + hstep, voffB);
            PG8_WAIT_V(6); PG8_BAR; PG8_MMA(1, 1, At, B1); PG8_BAR;
            PG8_LDB(B0, 1, 0); PG8_SCHED; PG8_LDA(At, 1, 0); PG8_STAGE(PG8_SA(0, 1), a2 + hstep, voffA);
            PG8_WAIT_L(8); PG8_BAR; PG8_WAIT_L(0); PG8_MMA(0, 0, At, B0); PG8_BAR; PG8_SCHED;
            PG8_LDB(B1, 1, 1); PG8_STAGE(PG8_SB(1, 0), b3, voffB);
            PG8_BAR; PG8_WAIT_L(0); PG8_MMA(0, 1, At, B1); PG8_BAR;
            PG8_LDA(At, 1, 1); PG8_STAGE(PG8_SA(1, 0), a3, voffA);
            PG8_BAR; PG8_WAIT_L(0); PG8_MMA(1, 0, At, B0); PG8_BAR; PG8_SCHED;
            PG8_STAGE(PG8_SB(1, 1), b3 + hstep, voffB);
            PG8_WAIT_V(6); PG8_BAR; PG8_MMA(1, 1, At, B1); PG8_BAR;
            }
        }
        if constexpr (ALIGN_EPI) { if (wr == 0) PG8_BAR; }
        if constexpr (!Epi::AFTER_DRAIN) { E(acc, cur, wr, wc, fr, fq); S.done(cur); }
        if (!has_next) break;
#pragma unroll
        for (int a = 0; a < 2; ++a)
#pragma unroll
            for (int b = 0; b < 2; ++b)
#pragma unroll
                for (int m = 0; m < 4; ++m)
#pragma unroll
                    for (int n = 0; n < 2; ++n) acc[a][b][m][n] = (f32x4){0.f, 0.f, 0.f, 0.f};
        cur = nxt; cA = nA; cB = nB; ++ui;
        if constexpr (ALIGN_EPI) { if (wr == 1) PG8_BAR; }
    }
    PG8_WAIT_V(0);
    if constexpr (!ALIGN_EPI) { if (wr == 0) PG8_BAR; }
    PG8_BAR;
    if constexpr (Epi::AFTER_DRAIN) { E.fused(acc, cur, wr, wc, fr, fq, lds, wid, lane); S.done(cur); }
#undef PG8_SA
#undef PG8_SB
#undef PG8_STAGE
#undef PG8_LDA
#undef PG8_LDB
#undef PG8_MMA
#undef PG8_WAIT_V
#undef PG8_WAIT_L
#undef PG8_BAR
#undef PG8_SCHED
}
}
#define GAS __attribute__((address_space(1)))
#define LAS __attribute__((address_space(3)))
typedef unsigned v4u __attribute__((ext_vector_type(4)));
typedef float f32x4 __attribute__((ext_vector_type(4)));
#define LDS_WAIT() asm volatile("s_waitcnt lgkmcnt(0)" ::: "memory")
constexpr int NWAVES = 8;
constexpr int GEMM_LDS = 131072;

struct Ptrs {
    const float* in[20]; float* out; unsigned char* ws;
};
#define IN_X 0
#define IN_EV_NORM 1
#define IN_EV_WIN 2
#define IN_EV_IFB 3
#define IN_EV_QNG 4
#define IN_EV_KNG 5
#define IN_EV_REL 6
#define IN_EV_WOUT 7
#define IN_OD_NORM 8
#define IN_OD_WIN 9
#define IN_OD_CCW 10
#define IN_OD_CCB 11
#define IN_OD_GW 12
#define IN_OD_GB 13
#define IN_OD_LAM 14
#define IN_OD_CDW 15
#define IN_OD_ALOG 16
#define IN_OD_DTB 17
#define IN_OD_ONORM 18
#define IN_OD_WOUT 19

__device__ __forceinline__ float frsq_(float x) { return __builtin_amdgcn_rsqf(x); }
__device__ __forceinline__ float wave_sum(float v) {
#pragma unroll
    for (int o = 1; o < 64; o <<= 1) v += __shfl_xor(v, o);
    return v;
}
struct TrItem { const float* W; const float* gain; bf16_t* WT; int ldw, nblk, item; };
__device__ __forceinline__ void p0_tr_load(const TrItem& t, float (&r)[32], int lane) {
    const int kb = t.item / t.nblk, nb = t.item % t.nblk, k0 = 64 * kb, n0 = 32 * nb;
#pragma unroll
    for (int i = 0; i < 32; ++i) { const int kk = 2 * i + (lane >> 5); r[i] = t.W[(size_t)(k0 + kk) * t.ldw + n0 + (lane & 31)]; }
}
__device__ __forceinline__ void p0_tr_store(const TrItem& t, const float (&r)[32], LAS float* scr, int lane) {
    const int kb = t.item / t.nblk, nb = t.item % t.nblk, k0 = 64 * kb, n0 = 32 * nb; constexpr int K = D_MODEL;
#pragma unroll
    for (int i = 0; i < 32; ++i) { const int kk = 2 * i + (lane >> 5); const float g = t.gain ? t.gain[k0 + kk] : 1.0f; scr[kk * 33 + (lane & 31)] = g * r[i]; }
    LDS_WAIT(); asm volatile("" ::: "memory");
    const int c = lane & 7;
#pragma unroll
    for (int j = 0; j < 4; ++j) { const int n = (lane >> 3) + 8 * j; const LAS float* s = scr + (8 * c) * 33 + n;
        v4u o; o.x = pk2(s[0 * 33], s[1 * 33]); o.y = pk2(s[2 * 33], s[3 * 33]); o.z = pk2(s[4 * 33], s[5 * 33]); o.w = pk2(s[6 * 33], s[7 * 33]);
        *(GAS v4u*)(t.WT + (size_t)(n0 + n) * K + k0 + 8 * c) = o; }
    LDS_WAIT(); asm volatile("" ::: "memory");
}
__device__ __forceinline__ void p0_transposes(const Ptrs& P, LAS float* scr, int lane, int gw, int NGW, int it0, int it1) {
    unsigned char* ws = P.ws;
    bf16_t* W1T = (bf16_t*)(ws + WS_W1T); bf16_t* W2T = (bf16_t*)(ws + WS_W2T); bf16_t* W3T = (bf16_t*)(ws + WS_W3T); bf16_t* W4T = (bf16_t*)(ws + WS_W4T);
    constexpr int I1 = (D_MODEL / 64) * (EV_N / 32), I2 = (D_MODEL / 64) * (D_MODEL / 32), I3 = (D_MODEL / 64) * (OD_N / 32);
    auto mk = [&](int it) { TrItem t; int r = it;
        if (r < I1) { t = TrItem{P.in[IN_EV_WIN], P.in[IN_EV_NORM], W1T, EV_IN, EV_N / 32, r}; return t; } r -= I1;
        if (r < I2) { t = TrItem{P.in[IN_EV_WOUT], nullptr, W2T, D_MODEL, D_MODEL / 32, r}; return t; } r -= I2;
        if (r < I3) { t = TrItem{P.in[IN_OD_WIN], P.in[IN_OD_NORM], W3T, OD_IN, OD_N / 32, r}; return t; } r -= I3;
        t = TrItem{P.in[IN_OD_WOUT], nullptr, W4T, D_MODEL, D_MODEL / 32, r}; return t; };
    float ra[32], rb[32]; int it = it0 + gw;
    if (it < it1) { TrItem ta = mk(it); p0_tr_load(ta, ra, lane);
        for (;;) { const int itb = it + NGW; TrItem tb = ta; const bool hb = itb < it1; if (hb) { tb = mk(itb); p0_tr_load(tb, rb, lane); }
            p0_tr_store(ta, ra, scr, lane); if (!hb) break;
            const int itc = itb + NGW; const bool hc = itc < it1; if (hc) { ta = mk(itc); p0_tr_load(ta, ra, lane); }
            p0_tr_store(tb, rb, scr, lane); if (!hc) break; it = itc; } }
}
constexpr int TR_I1 = (D_MODEL / 64) * (EV_N / 32), TR_ALL = TR_I1 + 2 * (D_MODEL / 64) * (D_MODEL / 32) + (D_MODEL / 64) * (OD_N / 32), TR_I4 = TR_ALL - (D_MODEL / 64) * (D_MODEL / 32);
__device__ __forceinline__ void late_weights(const Ptrs& P, LAS unsigned char* lds, int wave, int lane, int gw, int NGW) {
    p0_transposes(P, (LAS float*)(lds + wave * 16384), lane, gw, NGW, TR_I1, TR_I4);
    bf16_t* W3T = (bf16_t*)(P.ws + WS_W3T); const int gt = gw * 64 + lane, NT = NGW * 64;
    for (int e = gt; e < 16 * D_MODEL; e += NT) { const int j = e / D_MODEL, k = e % D_MODEL; W3T[(size_t)(OD_N + j) * D_MODEL + k] = (bf16_t)f2bf(P.in[IN_OD_NORM][k] * P.in[IN_OD_WIN][(size_t)k * OD_IN + OD_N + j]); }
}
__device__ __forceinline__ void last_weight(const Ptrs& P, LAS unsigned char* lds, int wave, int lane, int gw, int NGW) { p0_transposes(P, (LAS float*)(lds + wave * 16384), lane, gw, NGW, TR_I4, TR_ALL); }
__device__ __forceinline__ void phase_prologue(const Ptrs& P, LAS unsigned char* lds, int wave, int lane, int gw, int NGW) {
    unsigned char* ws = P.ws;
    bf16_t* W1T = (bf16_t*)(ws + WS_W1T); bf16_t* W2T = (bf16_t*)(ws + WS_W2T); bf16_t* W3T = (bf16_t*)(ws + WS_W3T); bf16_t* W4T = (bf16_t*)(ws + WS_W4T);
    bf16_t* XB = (bf16_t*)(ws + WS_XB); float* R0 = (float*)(ws + WS_R0); float* SS1 = (float*)(ws + WS_SS1); float* GIF = (float*)(ws + WS_GIF);
    LAS float* scr = (LAS float*)(lds + wave * 16384);
    p0_transposes(P, scr, lane, gw, NGW, 0, TR_I1);
    { const int gt = gw * 64 + lane, NT = NGW * 64;
      for (int e = gt; e < M_TOK; e += NT) SS1[e] = 0.f; }
    __syncthreads();
    LAS float* G8 = (LAS float*)lds;
#pragma unroll 8
    for (int e = threadIdx.x; e < D_MODEL * 8; e += NWAVES * 64) { const int k = e >> 3, j = e & 7; G8[e] = P.in[IN_EV_NORM][k] * P.in[IN_EV_WIN][(size_t)k * EV_IN + EV_N + j]; }
    __syncthreads();
    const float* X = P.in[IN_X];
    f32x4 vnx[8];
    if (gw < M_TOK) { const GAS f32x4* xr0 = (const GAS f32x4*)(X + (size_t)gw * D_MODEL) + lane;
#pragma unroll
        for (int j = 0; j < 8; ++j) vnx[j] = xr0[64 * j]; }
    for (int m = gw; m < M_TOK; m += NGW) {
        float s = 0.f;
        GAS unsigned long long* o8 = (GAS unsigned long long*)(XB + (size_t)m * D_MODEL) + lane;
        f32x4 v[8];
#pragma unroll
        for (int j = 0; j < 8; ++j) v[j] = vnx[j];
        if (m + NGW < M_TOK) { const GAS f32x4* xr1 = (const GAS f32x4*)(X + (size_t)(m + NGW) * D_MODEL) + lane;
#pragma unroll
            for (int j = 0; j < 8; ++j) vnx[j] = xr1[64 * j]; }
#pragma unroll
        for (int j = 0; j < 8; ++j) { s += (v[j].x * v[j].x + v[j].y * v[j].y) + (v[j].z * v[j].z + v[j].w * v[j].w);
            o8[64 * j] = (unsigned long long)pk2(v[j].x, v[j].y) | ((unsigned long long)pk2(v[j].z, v[j].w) << 32); }
        const float r0 = frsq_(wave_sum(s) * (1.0f / D_MODEL) + EPS);
        float g[8];
#pragma unroll
        for (int i = 0; i < 8; ++i) g[i] = 0.f;
#pragma unroll
        for (int j = 0; j < 8; ++j) {
#pragma unroll
            for (int e = 0; e < 4; ++e) { const int k = 4 * lane + 256 * j + e; const f32x4 ga = *(const LAS f32x4*)(G8 + k * 8), gb = *(const LAS f32x4*)(G8 + k * 8 + 4); const float xv = v[j][e];
                g[0] += xv * ga.x; g[1] += xv * ga.y; g[2] += xv * ga.z; g[3] += xv * ga.w; g[4] += xv * gb.x; g[5] += xv * gb.y; g[6] += xv * gb.z; g[7] += xv * gb.w; }
            asm volatile("" : "+v"(g[0]), "+v"(g[1]), "+v"(g[2]), "+v"(g[3]), "+v"(g[4]), "+v"(g[5]), "+v"(g[6]), "+v"(g[7]) :: "memory");
        }
#pragma unroll
        for (int i = 0; i < 8; ++i) g[i] = wave_sum(g[i]);
        if (lane == 0) R0[m] = r0;
        if (lane < 8) { float gv = g[0];
#pragma unroll
            for (int i = 1; i < 8; ++i) gv = (lane == i) ? g[i] : gv;
            GIF[(size_t)m * 8 + lane] = r0 * gv + P.in[IN_EV_IFB][lane]; }
    }
}

#define XB_TMO      128
#define XB_XCNT(j)  (256  + 64 * (j))
#define XB_XSUB(j)  (1280 + 64 * (j))
#define XB_XGEN(j)  (2304 + 64 * (j))
#define XB_TOP      3328
#define XB_TOPGEN   3392
#define XCD_BAR_WORDS 3456
#define XB_SPIN_CAP (1u << 18)

__device__ __forceinline__ unsigned xb_ld(unsigned* p)              { return __hip_atomic_load(p, __ATOMIC_RELAXED, __HIP_MEMORY_SCOPE_AGENT); }
__device__ __forceinline__ unsigned xb_add(unsigned* p, unsigned v) { return __hip_atomic_fetch_add(p, v, __ATOMIC_RELAXED, __HIP_MEMORY_SCOPE_AGENT); }
__device__ __forceinline__ unsigned xb_xcc_id() { return (unsigned)__builtin_amdgcn_s_getreg((3 << 11) | 20) & 0xFu; }
#define XB_SPIN(cond, bar) do { unsigned _sp = 0; while (cond) { __builtin_amdgcn_s_sleep(1); \
    if ((++_sp & 255u) == 0u) { if (xb_ld(&(bar)[XB_TMO])) break; if (_sp > XB_SPIN_CAP) { atomicAdd(&(bar)[XB_TMO], 1u); break; } } } } while (0)

struct XcdBarrier {
    unsigned* bar; unsigned x;
    volatile LAS unsigned* st;
};

__device__ __forceinline__ XcdBarrier xcd_barrier_post(unsigned* bar, volatile LAS unsigned* st) {
    XcdBarrier b; b.bar = bar; b.x = xb_xcc_id(); b.st = st;
    if (threadIdx.x == 0) (void)xb_add(&bar[XB_XCNT(b.x)], 1u);
    return b;
}
__device__ __forceinline__ void xcd_barrier_complete(unsigned* bar, unsigned x, unsigned& nloc, unsigned& nx) {
    const unsigned G = gridDim.x * gridDim.y * gridDim.z;
    unsigned sum, cnt, mine, sp = 0u;
    for (;;) {
        sum = 0u; cnt = 0u; mine = 0u;
#pragma unroll
        for (unsigned j = 0; j < 16; ++j) { const unsigned c = xb_ld(&bar[XB_XCNT(j)]); sum += c; cnt += (c > 0u) ? 1u : 0u; mine = (j == x) ? c : mine; }
        if (sum == G) break;
        __builtin_amdgcn_s_sleep(1);
        if ((++sp & 255u) == 0u) { if (xb_ld(&bar[XB_TMO])) break; if (sp > XB_SPIN_CAP) { atomicAdd(&bar[XB_TMO], 1u); break; } }
    }
    nloc = mine > 0u ? mine : 1u; nx = cnt > 0u ? cnt : 1u;
}

__device__ __forceinline__ void xcd_barrier(const XcdBarrier& b) {
    asm volatile("s_waitcnt vmcnt(0)" ::: "memory");
    __syncthreads();
    if (threadIdx.x == 0) {
        unsigned* bar = b.bar;
        __builtin_amdgcn_s_waitcnt(0);
        unsigned nloc = b.st[0], nx = b.st[1];
        if (nloc == 0u) { xcd_barrier_complete(bar, b.x, nloc, nx); b.st[0] = nloc; b.st[1] = nx; }
        const unsigned old = xb_add(&bar[XB_XSUB(b.x)], 1u);
        const unsigned gen = old / nloc;
        if (old + 1u == (gen + 1u) * nloc) {
            __builtin_amdgcn_fence(__ATOMIC_RELEASE, "agent");
            asm volatile("s_waitcnt vmcnt(0)" ::: "memory");
            const unsigned og = xb_add(&bar[XB_TOP], 1u);
            const unsigned tg = og / nx;
            if (og + 1u == (tg + 1u) * nx) xb_add(&bar[XB_TOPGEN], 1u);
            else XB_SPIN(xb_ld(&bar[XB_TOPGEN]) == tg, bar);
            __builtin_amdgcn_fence(__ATOMIC_ACQUIRE, "agent");
            xb_add(&bar[XB_XGEN(b.x)], 1u);
            asm volatile("s_waitcnt vmcnt(0)" ::: "memory");
        } else {
            XB_SPIN(xb_ld(&bar[XB_XGEN(b.x)]) == gen, bar);
            __builtin_amdgcn_fence(__ATOMIC_ACQUIRE, "agent");
            asm volatile("s_waitcnt vmcnt(0)" ::: "memory");
        }
    }
    __syncthreads();
}
__device__ __forceinline__ void ld8bf(const bf16_t* p, float (&v)[8]) {
    const v4u w = *(const v4u*)p;
    v[0] = __builtin_bit_cast(float, w.x << 16); v[1] = __builtin_bit_cast(float, w.x & 0xffff0000u);
    v[2] = __builtin_bit_cast(float, w.y << 16); v[3] = __builtin_bit_cast(float, w.y & 0xffff0000u);
    v[4] = __builtin_bit_cast(float, w.z << 16); v[5] = __builtin_bit_cast(float, w.z & 0xffff0000u);
    v[6] = __builtin_bit_cast(float, w.w << 16); v[7] = __builtin_bit_cast(float, w.w & 0xffff0000u);
}
__global__ void __launch_bounds__(256) k_attn_naive(const bf16_t* __restrict__ PROJ, const float* __restrict__ qn_g, const float* __restrict__ kn_g, const float* __restrict__ rel_bias, bf16_t* __restrict__ Y) {
    __shared__ float qs[16][128];
    __shared__ float S[16][577];
    const int bid = blockIdx.x, quarter = bid & 3, c = (bid >> 2) & 31, h = (bid >> 7) & 7, b = bid >> 10, t = threadIdx.x;
    { const int r = t >> 4, sub = t & 15; const int tok = b * SEQ + c * 64 + quarter * 16 + r;
      float v[8]; ld8bf(PROJ + (size_t)tok * EV_N + EC_QA + h * 128 + sub * 8, v);
      float ss = 0.f;
#pragma unroll
      for (int i = 0; i < 8; ++i) ss += v[i] * v[i];
      ss += __shfl_xor(ss, 1); ss += __shfl_xor(ss, 2); ss += __shfl_xor(ss, 4); ss += __shfl_xor(ss, 8);
      const float rs = 1.0f / sqrtf(ss * (1.0f / 128.0f) + EPS);
#pragma unroll
      for (int i = 0; i < 8; ++i) qs[r][sub * 8 + i] = v[i] * rs * qn_g[sub * 8 + i] * 0.08838834764831845f; }
    __syncthreads();
    for (int idx = t; idx < 16 * BAND; idx += 256) {
        const int r = idx / BAND, j = idx % BAND; const int kc = c - LOOKBACK + (j >> 6);
        float s;
        if (kc < 0) s = -1e30f;
        else { const bf16_t* kp = PROJ + (size_t)(b * SEQ + kc * 64 + (j & 63)) * EV_N + EC_KA + h * 128;
            float ss = 0.f, dot = 0.f;
            for (int d = 0; d < 128; d += 8) { float kv[8]; ld8bf(kp + d, kv);
#pragma unroll
                for (int i = 0; i < 8; ++i) { ss += kv[i] * kv[i]; dot += kv[i] * kn_g[d + i] * qs[r][d + i]; } }
            s = dot * (1.0f / sqrtf(ss * (1.0f / 128.0f) + EPS));
            const int qi = quarter * 16 + r; int rel = LOOKBACK * CHUNK + qi - j; rel = rel < -REL_MAX ? -REL_MAX : (rel > REL_MAX ? REL_MAX : rel); rel += REL_MAX;
            s += rel_bias[h * NREL + rel]; }
        S[r][j] = s;
    }
    __syncthreads();
    { const int r = t >> 4, sub = t & 15; float mx = -3.0e38f;
      for (int j = sub; j < BAND; j += 16) mx = fmaxf(mx, S[r][j]);
      mx = fmaxf(mx, __shfl_xor(mx, 1)); mx = fmaxf(mx, __shfl_xor(mx, 2)); mx = fmaxf(mx, __shfl_xor(mx, 4)); mx = fmaxf(mx, __shfl_xor(mx, 8));
      float sum = 0.f;
      for (int j = sub; j < BAND; j += 16) { const float e = expf(S[r][j] - mx); S[r][j] = e; sum += e; }
      sum += __shfl_xor(sum, 1); sum += __shfl_xor(sum, 2); sum += __shfl_xor(sum, 4); sum += __shfl_xor(sum, 8);
      const float inv = 1.0f / sum;
      for (int j = sub; j < BAND; j += 16) S[r][j] *= inv; }
    __syncthreads();
    { const int r = t >> 4, dg = t & 15; float acc[8];
#pragma unroll
      for (int i = 0; i < 8; ++i) acc[i] = 0.f;
      for (int j = 0; j < BAND; ++j) { const int kc = c - LOOKBACK + (j >> 6); if (kc < 0) continue;
          const float p = S[r][j]; float vv[8]; ld8bf(PROJ + (size_t)(b * SEQ + kc * 64 + (j & 63)) * EV_N + EC_VA + h * 128 + dg * 8, vv);
#pragma unroll
          for (int i = 0; i < 8; ++i) acc[i] += p * vv[i]; }
      const int tok = b * SEQ + c * 64 + quarter * 16 + r; float z[8]; ld8bf(PROJ + (size_t)tok * EV_N + EC_ZA + h * 128 + dg * 8, z);
      v4u o; o.x = pk2(acc[0] * siluf_(z[0]), acc[1] * siluf_(z[1])); o.y = pk2(acc[2] * siluf_(z[2]), acc[3] * siluf_(z[3]));
      o.z = pk2(acc[4] * siluf_(z[4]), acc[5] * siluf_(z[5])); o.w = pk2(acc[6] * siluf_(z[6]), acc[7] * siluf_(z[7]));
      *(v4u*)(Y + (size_t)tok * D_MODEL + h * 128 + dg * 8) = o; }
}
__global__ void __launch_bounds__(256) k_mlstm_naive(const bf16_t* __restrict__ PROJ, const float* __restrict__ GIF, bf16_t* __restrict__ Y) {
    __shared__ float ks[256], qs[256], part[4][64], dpart[4];
    const int bid = blockIdx.x, vs = bid & 3, h = (bid >> 2) & 3, b = bid >> 4, t = threadIdx.x, v = t & 63, kq = t >> 6;
    float C[64];
#pragma unroll
    for (int i = 0; i < 64; ++i) C[i] = 0.f;
    float nreg = 0.f;
    for (int s = 0; s < SEQ; ++s) {
        const size_t tok = (size_t)b * SEQ + s; const bf16_t* pr = PROJ + tok * EV_N;
        const float li = GIF[tok * 8 + h], fpre = GIF[tok * 8 + 4 + h];
        const float fw = sigmoidf_(fpre), iw = expf(li);
        const float kk = bf2f(pr[EC_KB + h * 256 + t]), qq = bf2f(pr[EC_QB + h * 256 + t]) * 0.0625f;
        const float vv = bf2f(pr[EC_VB + h * 256 + vs * 64 + v]);
        ks[t] = kk; qs[t] = qq;
        nreg = fw * nreg + iw * kk;
        float dp = nreg * qq; dp = wave_sum(dp);
        if ((t & 63) == 0) dpart[kq] = dp;
        __syncthreads();
        float np = 0.f; const float iv = iw * vv;
#pragma unroll
        for (int i = 0; i < 64; ++i) { C[i] = fw * C[i] + ks[kq * 64 + i] * iv; np += C[i] * qs[kq * 64 + i]; }
        part[kq][v] = np;
        __syncthreads();
        if (t < 64) { const float num = (part[0][t] + part[1][t]) + (part[2][t] + part[3][t]); const float den = (dpart[0] + dpart[1]) + (dpart[2] + dpart[3]);
            const float hh = num / fmaxf(fabsf(den), 1.0f);
            const float ob = bf2f(pr[EC_OB + h * 256 + vs * 64 + t]), zb = bf2f(pr[EC_ZB + h * 256 + vs * 64 + t]);
            Y[tok * D_MODEL + W_A + h * 256 + vs * 64 + t] = (bf16_t)f2bf(sigmoidf_(ob) * hh * siluf_(zb)); }
        __syncthreads();
    }
}
__global__ void __launch_bounds__(128) k_rglru_gates(const bf16_t* __restrict__ PROJ, const float* __restrict__ ccw, const float* __restrict__ ccb, const float* __restrict__ gw, const float* __restrict__ gb,
                                                     const float* __restrict__ lam, float* __restrict__ A, float* __restrict__ INP) {
    __shared__ float xs[8][128];
    const int blk = blockIdx.x & 7, tg = blockIdx.x >> 3, t = threadIdx.x, c = blk * 128 + t;
    float xc[8];
#pragma unroll
    for (int i = 0; i < 8; ++i) { const int tok = tg * 8 + i, s = tok % SEQ; float a = ccb[c];
#pragma unroll
        for (int j = 0; j < 4; ++j) { const int sj = s - 3 + j; if (sj >= 0) a += ccw[j * W_C + c] * bf2f(PROJ[(size_t)(tok - 3 + j) * OD_N + OC_XC + c]); }
        xc[i] = a; xs[i][t] = a; }
    __syncthreads();
    float rp[8], ip[8];
#pragma unroll
    for (int i = 0; i < 8; ++i) { rp[i] = 0.f; ip[i] = 0.f; }
    const float* g0 = gw + (size_t)blk * 128 * 256;
    for (int k = 0; k < 128; ++k) { const float wr_ = g0[k * 256 + t], wi_ = g0[k * 256 + 128 + t];
#pragma unroll
        for (int i = 0; i < 8; ++i) { const float xv = xs[i][k]; rp[i] += xv * wr_; ip[i] += xv * wi_; } }
    const float sp = softplusf_(-lam[c]); const float gbr = gb[c], gbi = gb[W_C + c];
#pragma unroll
    for (int i = 0; i < 8; ++i) { const int tok = tg * 8 + i; const float r = sigmoidf_(rp[i] + gbr), ig = sigmoidf_(ip[i] + gbi);
        const float la = -8.0f * r * sp; A[(size_t)tok * W_C + c] = expf(la); INP[(size_t)tok * W_C + c] = sqrtf(-expm1f(2.0f * la)) * (ig * xc[i]); }
}
__global__ void __launch_bounds__(256) k_rglru_scan(const bf16_t* __restrict__ PROJ, const float* __restrict__ A, const float* __restrict__ INP, bf16_t* __restrict__ Y) {
    const int gid = blockIdx.x * 256 + threadIdx.x, b = gid / W_C, c = gid % W_C; float h = 0.f;
    for (int s = 0; s < SEQ; ++s) { const size_t tok = (size_t)b * SEQ + s; h = A[tok * W_C + c] * h + INP[tok * W_C + c];
        Y[tok * D_MODEL + c] = (bf16_t)f2bf(h * siluf_(bf2f(PROJ[tok * OD_N + OC_ZC + c]))); }
}
__global__ void __launch_bounds__(256) k_gates_ab(const bf16_t* __restrict__ XB, const bf16_t* __restrict__ W3T, const float* __restrict__ SS1, float* __restrict__ AB) {
    const int t = threadIdx.x, row = blockIdx.x * 16 + (t >> 4), j = t & 15;
    const bf16_t* xp = XB + (size_t)row * D_MODEL; const bf16_t* wp = W3T + (size_t)(OD_N + j) * D_MODEL; float acc = 0.f;
    for (int k = 0; k < D_MODEL; k += 8) { float a[8], w[8]; ld8bf(xp + k, a); ld8bf(wp + k, w);
#pragma unroll
        for (int i = 0; i < 8; ++i) acc += a[i] * w[i]; }
    AB[(size_t)row * 16 + j] = acc * (1.0f / sqrtf(SS1[row] * (1.0f / D_MODEL) + EPS));
}
__global__ void __launch_bounds__(128) k_dn_prep(const bf16_t* __restrict__ PROJ, const float* __restrict__ cdw, float* __restrict__ Q2, float* __restrict__ K2, float* __restrict__ V2) {
    __shared__ float red[2][2];
    const int h = blockIdx.x & 7, tok = blockIdx.x >> 3, s = tok % SEQ, t = threadIdx.x; float o[3];
#pragma unroll
    for (int p = 0; p < 3; ++p) { const int col = p * W_D + h * 128 + t; float a = 0.f;
#pragma unroll
        for (int j = 0; j < 4; ++j) { const int sj = s - 3 + j; if (sj >= 0) a += cdw[j * 3 * W_D + col] * bf2f(PROJ[(size_t)(tok - 3 + j) * OD_N + OC_QD + col]); }
        o[p] = siluf_(a); }
    float sq = wave_sum(o[0] * o[0]), sk = wave_sum(o[1] * o[1]);
    if ((t & 63) == 0) { red[t >> 6][0] = sq; red[t >> 6][1] = sk; }
    __syncthreads();
    sq = red[0][0] + red[1][0]; sk = red[0][1] + red[1][1];
    const size_t o_ = (size_t)tok * W_D + h * 128 + t;
    Q2[o_] = o[0] * (1.0f / sqrtf(sq + EPS)); K2[o_] = o[1] * (1.0f / sqrtf(sk + EPS)); V2[o_] = o[2];
}
__global__ void __launch_bounds__(256) k_dn_scan(const bf16_t* __restrict__ PROJ, const float* __restrict__ Q2, const float* __restrict__ K2, const float* __restrict__ V2, const float* __restrict__ AB,
                                                 const float* __restrict__ a_log, const float* __restrict__ dt_bias, const float* __restrict__ onorm, bf16_t* __restrict__ Y) {
    __shared__ float ks[128], qs[128], part[2][128], red[2];
    const int h = blockIdx.x & 7, b = blockIdx.x >> 3, t = threadIdx.x, v = t & 127, kh = t >> 7;
    float S[64];
#pragma unroll
    for (int i = 0; i < 64; ++i) S[i] = 0.f;
    const float Aexp = expf(a_log[h]), dtb = dt_bias[h], og = onorm[v];
    for (int s = 0; s < SEQ; ++s) {
        const size_t tok = (size_t)b * SEQ + s; const size_t o_ = tok * W_D + h * 128;
        if (t < 128) ks[t] = K2[o_ + t]; else qs[t - 128] = Q2[o_ + t - 128] * 0.08838834764831845f;
        const float vv = V2[o_ + v];
        const float beta = sigmoidf_(AB[tok * 16 + 8 + h]); const float g = -Aexp * softplusf_(AB[tok * 16 + h] + dtb); const float al = expf(g);
        __syncthreads();
        float rp = 0.f;
#pragma unroll
        for (int i = 0; i < 64; ++i) rp += S[i] * ks[kh * 64 + i];
        part[kh][v] = rp;
        __syncthreads();
        const float r = part[0][v] + part[1][v];
        const float u = beta * (vv - al * r);
        float op = 0.f;
#pragma unroll
        for (int i = 0; i < 64; ++i) { S[i] = al * S[i] + ks[kh * 64 + i] * u; op += S[i] * qs[kh * 64 + i]; }
        __syncthreads();
        part[kh][v] = op;
        __syncthreads();
        const float o = part[0][v] + part[1][v];
        float sq = (t < 128) ? o * o : 0.f; sq = wave_sum(sq);
        if (t == 0) red[0] = sq; if (t == 64) red[1] = sq;
        __syncthreads();
        if (t < 128) { const float ms = (red[0] + red[1]) * (1.0f / 128.0f);
            const float zd = bf2f(PROJ[tok * OD_N + OC_ZD + h * 128 + t]);
            Y[tok * D_MODEL + W_C + h * 128 + t] = (bf16_t)f2bf(o * (1.0f / sqrtf(ms + EPS)) * og * siluf_(zd)); }
    }
}

__global__ void __launch_bounds__(512) k_prologue(Ptrs P) {
    extern __shared__ __attribute__((aligned(16))) unsigned char lds[];
    const int tid = threadIdx.x, lane = tid & 63, wave = __builtin_amdgcn_readfirstlane(tid >> 6);
    phase_prologue(P, (LAS unsigned char*)lds, wave, lane, blockIdx.x * NWAVES + wave, gridDim.x * NWAVES);
}
template <int WHICH> __device__ __forceinline__ void phase_gemm(const Ptrs& P, LAS unsigned char* lds, int G, int c) {
    unsigned char* ws = P.ws;
    bf16_t* W1T = (bf16_t*)(ws + WS_W1T); bf16_t* W2T = (bf16_t*)(ws + WS_W2T); bf16_t* W3T = (bf16_t*)(ws + WS_W3T); bf16_t* W4T = (bf16_t*)(ws + WS_W4T);
    bf16_t* XB = (bf16_t*)(ws + WS_XB); bf16_t* YB = (bf16_t*)(ws + WS_Y); bf16_t* PROJ = (bf16_t*)(ws + WS_PROJ);
    float* R0 = (float*)(ws + WS_R0); float* SS1 = (float*)(ws + WS_SS1);
    if constexpr (WHICH == 1) { pg8::Gemm g{XB, W1T, M_TOK, EV_N, D_MODEL}; pg8::EpiProj E{PROJ, EV_N, R0, 0}; pg8::StaticOrder S; S.init(g.M, g.N, G, c);
        pg8::gemm_phase<pg8::EpiProj, pg8::StaticOrder, true, true>(lds, g, S, E); }
    if constexpr (WHICH == 2) { pg8::Gemm g{YB, W2T, M_TOK, D_MODEL, D_MODEL}; pg8::EpiRes E{P.in[IN_X], P.out, XB, SS1, D_MODEL}; pg8::StaticOrder S; S.init(g.M, g.N, G, c);
        pg8::gemm_phase<pg8::EpiRes, pg8::StaticOrder, true, true>(lds, g, S, E); }
    if constexpr (WHICH == 3) { pg8::Gemm g{XB, W3T, M_TOK, OD_N, D_MODEL}; pg8::EpiProj E{PROJ, OD_N, SS1, 1}; pg8::StaticOrder S; S.init(g.M, g.N, G, c);
        pg8::gemm_phase<pg8::EpiProj, pg8::StaticOrder, true, true>(lds, g, S, E); }
    if constexpr (WHICH == 4) { pg8::Gemm g{YB, W4T, M_TOK, D_MODEL, D_MODEL}; pg8::EpiRes E{P.out, P.out, nullptr, nullptr, D_MODEL}; pg8::StaticOrder S; S.init(g.M, g.N, G, c);
        pg8::gemm_phase<pg8::EpiRes, pg8::StaticOrder, true, true>(lds, g, S, E); }
}
template <int WHICH> __global__ void __launch_bounds__(512, 2) k_gemm(Ptrs P) {
    extern __shared__ __attribute__((aligned(16))) unsigned char lds[];
    phase_gemm<WHICH>(P, (LAS unsigned char*)lds, gridDim.x, blockIdx.x);
}

__device__ __forceinline__ void phase_gates_ab(const Ptrs& P, int G) {
    unsigned char* ws = P.ws; const bf16_t* XB = (const bf16_t*)(ws + WS_XB); const bf16_t* W3T = (const bf16_t*)(ws + WS_W3T); const float* SS1 = (const float*)(ws + WS_SS1); float* AB = (float*)(ws + WS_AB);
    const int t = threadIdx.x, j = t & 15;
    for (int it = blockIdx.x; it < M_TOK / 32; it += G) { const int row = it * 32 + (t >> 4);
        const bf16_t* xp = XB + (size_t)row * D_MODEL; const bf16_t* wp = W3T + (size_t)(OD_N + j) * D_MODEL; float acc = 0.f;
#pragma unroll 8
        for (int k = 0; k < D_MODEL; k += 8) { float a[8], w[8]; ld8bf(xp + k, a); ld8bf(wp + k, w);
#pragma unroll
            for (int i = 0; i < 8; ++i) acc += a[i] * w[i]; }
        AB[(size_t)row * 16 + j] = acc * (1.0f / sqrtf(SS1[row] * (1.0f / D_MODEL) + EPS)); }
}
#ifdef SKELETON
__device__ __forceinline__ void phase_mix0(const Ptrs& P, LAS unsigned char* lds, int G) {
    v4u* Y = (v4u*)(P.ws + WS_Y); const v4u z = {0u, 0u, 0u, 0u};
    for (size_t i = (size_t)blockIdx.x * 512 + threadIdx.x; i < (size_t)M_TOK * D_MODEL / 8; i += (size_t)G * 512) Y[i] = z;
}
__device__ __forceinline__ void phase_mix1a(const Ptrs& P, LAS unsigned char* lds, int G) { phase_mix0(P, lds, G); }
__device__ __forceinline__ void phase_mix1b(const Ptrs& P, LAS unsigned char* lds, int G) { }
#endif
typedef short bf16x8 __attribute__((ext_vector_type(8)));
typedef short bf16x4 __attribute__((ext_vector_type(4)));
typedef short v4i16_t __attribute__((ext_vector_type(4)));
#define MFMA16(a, b, c) __builtin_amdgcn_mfma_f32_16x16x32_bf16((a), (b), (c), 0, 0, 0)
__device__ __forceinline__ v4i16_t lds_tr(LAS const unsigned char* p) { return __builtin_amdgcn_ds_read_tr16_b64_v4i16((LAS v4i16_t*)p); }
__device__ __forceinline__ bf16x8 frag_row(LAS const unsigned char* base, int RS, int r0, int k0, int lane) { return *(LAS const bf16x8*)(base + (r0 + (lane & 15)) * RS + (k0 + 8 * (lane >> 4)) * 2); }
__device__ __forceinline__ bf16x8 frag_row_perm(LAS const unsigned char* base, int RS, int r0, int k0, int lane) {
    LAS const unsigned char* p = base + (r0 + (lane & 15)) * RS + (k0 + 4 * (lane >> 4)) * 2;
    const bf16x4 a = *(LAS const bf16x4*)p, b = *(LAS const bf16x4*)(p + 32); return (bf16x8){a[0], a[1], a[2], a[3], b[0], b[1], b[2], b[3]}; }
__device__ __forceinline__ bf16x8 frag_tr(LAS const unsigned char* base, int RS, int k0, int c0, int lane) {
    const int g = lane >> 4, q = (lane & 15) >> 2, p = lane & 3; LAS const unsigned char* a = base + (k0 + 8 * g + q) * RS + (c0 + 4 * p) * 2;
    const v4i16_t lo = lds_tr(a), hi = lds_tr(a + 4 * RS); return (bf16x8){lo[0], lo[1], lo[2], lo[3], hi[0], hi[1], hi[2], hi[3]}; }
__device__ __forceinline__ bf16x8 frag_tr_perm(LAS const unsigned char* base, int RS, int k0, int c0, int lane) {
    const int g = lane >> 4, q = (lane & 15) >> 2, p = lane & 3; LAS const unsigned char* a = base + (k0 + 4 * g + q) * RS + (c0 + 4 * p) * 2;
    const v4i16_t lo = lds_tr(a), hi = lds_tr(a + 16 * RS); return (bf16x8){lo[0], lo[1], lo[2], lo[3], hi[0], hi[1], hi[2], hi[3]}; }
__device__ __forceinline__ bf16x8 acc_pair_frag(const f32x4& lo, const f32x4& hi) {
    const unsigned a = pk2(lo[0], lo[1]), b = pk2(lo[2], lo[3]), c = pk2(hi[0], hi[1]), d = pk2(hi[2], hi[3]);
    typedef unsigned u32x4_ __attribute__((ext_vector_type(4))); const u32x4_ w = {a, b, c, d}; return __builtin_bit_cast(bf16x8, w); }
__device__ __forceinline__ float fexp2(float x) { return __builtin_amdgcn_exp2f(x); }
constexpr float LOG2E = 1.4426950408889634f;
__device__ __forceinline__ float fexp(float x) { return __builtin_amdgcn_exp2f(x * LOG2E); }
__device__ __forceinline__ float frcp(float x) { return __builtin_amdgcn_rcpf(x); }
__device__ __forceinline__ float frsq(float x) { return __builtin_amdgcn_rsqf(x); }
__device__ __forceinline__ float fsqrt(float x) { return __builtin_amdgcn_sqrtf(x); }
__device__ __forceinline__ float fsigmoid(float x) { return __builtin_amdgcn_rcpf(1.0f + __builtin_amdgcn_exp2f(-x * LOG2E)); }
__device__ __forceinline__ float fsilu(float x) { return x * fsigmoid(x); }
constexpr int AT_RSK = 272, AT_RSV = 288, AT_KB = 64 * AT_RSK, AT_VB = 64 * AT_RSV;
constexpr int AT_OFF_K = 0, AT_OFF_V = 2 * AT_KB, AT_OFF_TBL = AT_OFF_V + 2 * AT_VB, AT_LDS = AT_OFF_TBL + 2064;
static_assert(AT_LDS <= 163328, "attention LDS");
template <int SKIP = 0> __device__ __forceinline__ void attn_item(const Ptrs& P, LAS unsigned char* lds, int item, size_t yoff = WS_Y) {
    const bf16_t* __restrict__ PROJ = (const bf16_t*)(P.ws + WS_PROJ); bf16_t* __restrict__ Y = (bf16_t*)(P.ws + yoff);
    const float* __restrict__ qn_g = P.in[IN_EV_QNG]; const float* __restrict__ kn_g = P.in[IN_EV_KNG];
    const int tid = threadIdx.x, lane = tid & 63, wave = tid >> 6, g = lane >> 4, l15 = lane & 15;
    const int cp = item & 15, h = (item >> 4) & 7, b = item >> 7;
    const int c = 2 * cp + (wave >> 2), qt = wave & 3;
    LAS float* tbl = (LAS float*)(lds + AT_OFF_TBL);
    for (int i = tid; i < NREL; i += 512) tbl[i] = P.in[IN_EV_REL][h * NREL + i] * LOG2E;
    bf16x8 qf[4];
    { const bf16_t* qp = PROJ + (size_t)(b * SEQ + c * 64 + qt * 16 + l15) * EV_N + EC_QA + h * 128 + 8 * g;
      float qv[4][8]; float ss = 0.f;
#pragma unroll
      for (int ks = 0; ks < 4; ++ks) { ld8bf(qp + 32 * ks, qv[ks]);
#pragma unroll
          for (int i = 0; i < 8; ++i) ss += qv[ks][i] * qv[ks][i]; }
      ss += __shfl_xor(ss, 16); ss += __shfl_xor(ss, 32);
      const float rs = frsq(ss * (1.0f / 128.0f) + EPS) * (0.08838834764831845f * LOG2E);
#pragma unroll
      for (int ks = 0; ks < 4; ++ks) { const float* gp = qn_g + 32 * ks + 8 * g; typedef unsigned u32x4_ __attribute__((ext_vector_type(4)));
          const u32x4_ w = {pk2(qv[ks][0] * rs * gp[0], qv[ks][1] * rs * gp[1]), pk2(qv[ks][2] * rs * gp[2], qv[ks][3] * rs * gp[3]),
                            pk2(qv[ks][4] * rs * gp[4], qv[ks][5] * rs * gp[5]), pk2(qv[ks][6] * rs * gp[6], qv[ks][7] * rs * gp[7])};
          qf[ks] = __builtin_bit_cast(bf16x8, w); } }
    f32x4 o[8];
#pragma unroll
    for (int i = 0; i < 8; ++i) o[i] = (f32x4){0.f, 0.f, 0.f, 0.f};
    float mrun = -1.0e30f, lrun = 0.f;
    const int kt_lo = (2 * cp - LOOKBACK) < 0 ? 0 : (2 * cp - LOOKBACK), kt_hi = 2 * cp + 1;
    v4u kreg[2], vreg[2];
    const int srow0 = tid >> 4, sch = tid & 15;
    float kg[8];
#pragma unroll
    for (int i = 0; i < 8; ++i) kg[i] = kn_g[sch * 8 + i];
#define AT_LOAD(kt) do { _Pragma("unroll") for (int i_ = 0; i_ < 2; ++i_) { const bf16_t* rp_ = PROJ + (size_t)(b * SEQ + (kt) * 64 + srow0 + 32 * i_) * EV_N + h * 128 + sch * 8; \
        kreg[i_] = *(const v4u*)(rp_ + EC_KA); vreg[i_] = *(const v4u*)(rp_ + EC_VA); } } while (0)
#define AT_STORE(buf) do { _Pragma("unroll") for (int i_ = 0; i_ < 2; ++i_) { const int row_ = srow0 + 32 * i_; \
        float kv_[8]; kv_[0] = __builtin_bit_cast(float, kreg[i_].x << 16); kv_[1] = __builtin_bit_cast(float, kreg[i_].x & 0xffff0000u); kv_[2] = __builtin_bit_cast(float, kreg[i_].y << 16); kv_[3] = __builtin_bit_cast(float, kreg[i_].y & 0xffff0000u); \
        kv_[4] = __builtin_bit_cast(float, kreg[i_].z << 16); kv_[5] = __builtin_bit_cast(float, kreg[i_].z & 0xffff0000u); kv_[6] = __builtin_bit_cast(float, kreg[i_].w << 16); kv_[7] = __builtin_bit_cast(float, kreg[i_].w & 0xffff0000u); \
        float ss_ = 0.f; _Pragma("unroll") for (int e_ = 0; e_ < 8; ++e_) ss_ += kv_[e_] * kv_[e_]; \
        ss_ += __shfl_xor(ss_, 1); ss_ += __shfl_xor(ss_, 2); ss_ += __shfl_xor(ss_, 4); ss_ += __shfl_xor(ss_, 8); \
        const float rs_ = frsq(ss_ * (1.0f / 128.0f) + EPS); \
        v4u w_; w_.x = pk2(kv_[0] * rs_ * kg[0], kv_[1] * rs_ * kg[1]); w_.y = pk2(kv_[2] * rs_ * kg[2], kv_[3] * rs_ * kg[3]); w_.z = pk2(kv_[4] * rs_ * kg[4], kv_[5] * rs_ * kg[5]); w_.w = pk2(kv_[6] * rs_ * kg[6], kv_[7] * rs_ * kg[7]); \
        *(LAS v4u*)(lds + AT_OFF_K + (buf) * AT_KB + row_ * AT_RSK + sch * 16) = w_; \
        *(LAS v4u*)(lds + AT_OFF_V + (buf) * AT_VB + row_ * AT_RSV + sch * 16) = vreg[i_]; } } while (0)
    AT_LOAD(kt_lo); AT_STORE(0);
    __syncthreads();
    const int qi = qt * 16 + l15;
    for (int kt = kt_lo, it = 0; kt <= kt_hi; ++kt, ++it) {
        const int buf = it & 1;
        if (kt < kt_hi) AT_LOAD(kt + 1);
        const int to = kt - (c - LOOKBACK);
        if (to >= 0 && to <= LOOKBACK) {
            LAS const unsigned char* Kb = lds + AT_OFF_K + buf * AT_KB; LAS const unsigned char* Vb = lds + AT_OFF_V + buf * AT_VB;
            f32x4 s[4];
#pragma unroll
            for (int nt = 0; nt < 4; ++nt) { s[nt] = (f32x4){0.f, 0.f, 0.f, 0.f};
#pragma unroll
                for (int ks = 0; ks < ((SKIP & 16) ? 0 : 4); ++ks) s[nt] = MFMA16(frag_row(Kb, AT_RSK, 16 * nt, 32 * ks, lane), qf[ks], s[nt]); }
            if constexpr (!(SKIP & 2)) { const int relb = LOOKBACK * CHUNK - 64 * to + qi - 4 * g;
#pragma unroll
              for (int nt = 0; nt < 4; ++nt)
#pragma unroll
                  for (int r = 0; r < 4; ++r) { int rel = relb - 16 * nt - r; rel = rel > REL_MAX ? REL_MAX : rel; s[nt][r] += tbl[rel + REL_MAX]; } }
            float tmax = fmaxf(fmaxf(s[0][0], s[0][1]), fmaxf(s[0][2], s[0][3]));
#pragma unroll
            for (int nt = 1; nt < 4; ++nt) tmax = fmaxf(tmax, fmaxf(fmaxf(s[nt][0], s[nt][1]), fmaxf(s[nt][2], s[nt][3])));
            tmax = fmaxf(tmax, __shfl_xor(tmax, 16)); tmax = fmaxf(tmax, __shfl_xor(tmax, 32));
            const float mnew = fmaxf(mrun, tmax), alpha = fexp2(mrun - mnew);
            float rsum = 0.f;
#pragma unroll
            for (int nt = 0; nt < 4; ++nt)
#pragma unroll
                for (int r = 0; r < 4; ++r) { s[nt][r] = (SKIP & 4) ? (s[nt][r] - mnew) : fexp2(s[nt][r] - mnew); rsum += s[nt][r]; }
            rsum += __shfl_xor(rsum, 16); rsum += __shfl_xor(rsum, 32);
            lrun = lrun * alpha + rsum; mrun = mnew;
            const bf16x8 pf0 = acc_pair_frag(s[0], s[1]), pf1 = acc_pair_frag(s[2], s[3]);
            float al[4];
#pragma unroll
            for (int r = 0; r < 4; ++r) al[r] = __shfl(alpha, 4 * g + r);
#pragma unroll
            for (int dt = 0; dt < ((SKIP & 8) ? 0 : 8); ++dt) { o[dt][0] *= al[0]; o[dt][1] *= al[1]; o[dt][2] *= al[2]; o[dt][3] *= al[3];
                o[dt] = MFMA16(pf0, frag_tr_perm(Vb, AT_RSV, 0, 16 * dt, lane), o[dt]);
                o[dt] = MFMA16(pf1, frag_tr_perm(Vb, AT_RSV, 32, 16 * dt, lane), o[dt]); }
        }
        if (kt < kt_hi) AT_STORE(buf ^ 1);
        __syncthreads();
    }
#undef AT_LOAD
#undef AT_STORE
    float li[4];
#pragma unroll
    for (int r = 0; r < 4; ++r) li[r] = frcp(__shfl(lrun, 4 * g + r));
#pragma unroll
    for (int r = 0; r < 4; ++r) { const size_t tok = (size_t)b * SEQ + c * 64 + qt * 16 + 4 * g + r; const bf16_t* zp = PROJ + tok * EV_N + EC_ZA + h * 128 + l15; bf16_t* yp = Y + tok * D_MODEL + h * 128 + l15;
#pragma unroll
        for (int dt = 0; dt < 8; ++dt) yp[16 * dt] = (bf16_t)f2bf(o[dt][r] * li[r] * fsilu(bf2f(zp[16 * dt]))); }
}
constexpr int A2_KB = 64 * AT_RSK, A2_VB = 64 * AT_RSV, A2_BUF = 2 * A2_KB + 2 * A2_VB;
constexpr int A2_OFF_TBL = 2 * A2_BUF, A2_LDS = A2_OFF_TBL + 2 * 2064;
static_assert(A2_LDS <= 163328, "attention (2-head) LDS");
template <int SKIP = 0> __device__ __forceinline__ void attn2_item(const Ptrs& P, LAS unsigned char* lds, int item, size_t yoff = WS_Y) {
    const bf16_t* __restrict__ PROJ = (const bf16_t*)(P.ws + WS_PROJ); bf16_t* __restrict__ Y = (bf16_t*)(P.ws + yoff);
    const float* __restrict__ qn_g = P.in[IN_EV_QNG]; const float* __restrict__ kn_g = P.in[IN_EV_KNG];
    const int tid = threadIdx.x, lane = tid & 63, wave = tid >> 6, g = lane >> 4, l15 = lane & 15;
    const int cp = item & 15, hp = (item >> 4) & 3, b = item >> 6;
    const int hs = wave >> 2, h = 2 * hp + hs, c = 2 * cp + ((wave >> 1) & 1), q0 = 32 * (wave & 1);
    LAS float* tbl = (LAS float*)(lds + A2_OFF_TBL);
    for (int i = tid; i < 2 * NREL; i += 512) { const int hh = i / NREL, r = i - hh * NREL; tbl[hh * 516 + r] = P.in[IN_EV_REL][(2 * hp + hh) * NREL + r] * LOG2E; }
    bf16x8 qf[2][4];
#pragma unroll
    for (int q = 0; q < 2; ++q) { const bf16_t* qp = PROJ + (size_t)(b * SEQ + c * 64 + q0 + 16 * q + l15) * EV_N + EC_QA + h * 128 + 8 * g;
        float qv[4][8]; float ss = 0.f;
#pragma unroll
        for (int ks = 0; ks < 4; ++ks) { ld8bf(qp + 32 * ks, qv[ks]);
#pragma unroll
            for (int i = 0; i < 8; ++i) ss += qv[ks][i] * qv[ks][i]; }
        ss += __shfl_xor(ss, 16); ss += __shfl_xor(ss, 32);
        const float rs = frsq(ss * (1.0f / 128.0f) + EPS) * (0.08838834764831845f * LOG2E);
#pragma unroll
        for (int ks = 0; ks < 4; ++ks) { const float* gp = qn_g + 32 * ks + 8 * g; typedef unsigned u32x4_ __attribute__((ext_vector_type(4)));
            const u32x4_ w = {pk2(qv[ks][0] * rs * gp[0], qv[ks][1] * rs * gp[1]), pk2(qv[ks][2] * rs * gp[2], qv[ks][3] * rs * gp[3]),
                              pk2(qv[ks][4] * rs * gp[4], qv[ks][5] * rs * gp[5]), pk2(qv[ks][6] * rs * gp[6], qv[ks][7] * rs * gp[7])};
            qf[q][ks] = __builtin_bit_cast(bf16x8, w); } }
    f32x4 o[2][8];
#pragma unroll
    for (int q = 0; q < 2; ++q)
#pragma unroll
        for (int i = 0; i < 8; ++i) o[q][i] = (f32x4){0.f, 0.f, 0.f, 0.f};
    float mrun[2] = {-1.0e30f, -1.0e30f}, lrun[2] = {0.f, 0.f};
    const int kt_lo = (2 * cp - LOOKBACK) < 0 ? 0 : (2 * cp - LOOKBACK), kt_hi = 2 * cp + 1;
    v4u kreg[2][2], vreg[2][2];
    const int srow0 = tid >> 4, sch = tid & 15;
#define A2_LOAD(kt) do { _Pragma("unroll") for (int hh_ = 0; hh_ < 2; ++hh_) _Pragma("unroll") for (int i_ = 0; i_ < 2; ++i_) { \
        const bf16_t* rp_ = PROJ + (size_t)(b * SEQ + (kt) * 64 + srow0 + 32 * i_) * EV_N + (2 * hp + hh_) * 128 + sch * 8; kreg[hh_][i_] = *(const v4u*)(rp_ + EC_KA); vreg[hh_][i_] = *(const v4u*)(rp_ + EC_VA); } } while (0)
#define A2_STORE(buf) do { _Pragma("unroll") for (int hh_ = 0; hh_ < 2; ++hh_) _Pragma("unroll") for (int i_ = 0; i_ < 2; ++i_) { const int row_ = srow0 + 32 * i_; const v4u kr_ = kreg[hh_][i_]; \
        float kv_[8]; kv_[0] = __builtin_bit_cast(float, kr_.x << 16); kv_[1] = __builtin_bit_cast(float, kr_.x & 0xffff0000u); kv_[2] = __builtin_bit_cast(float, kr_.y << 16); kv_[3] = __builtin_bit_cast(float, kr_.y & 0xffff0000u); \
        kv_[4] = __builtin_bit_cast(float, kr_.z << 16); kv_[5] = __builtin_bit_cast(float, kr_.z & 0xffff0000u); kv_[6] = __builtin_bit_cast(float, kr_.w << 16); kv_[7] = __builtin_bit_cast(float, kr_.w & 0xffff0000u); \
        float ss_ = 0.f; _Pragma("unroll") for (int e_ = 0; e_ < 8; ++e_) ss_ += kv_[e_] * kv_[e_]; \
        ss_ += __shfl_xor(ss_, 1); ss_ += __shfl_xor(ss_, 2); ss_ += __shfl_xor(ss_, 4); ss_ += __shfl_xor(ss_, 8); \
        const float rs_ = frsq(ss_ * (1.0f / 128.0f) + EPS); const f32x4 kga_ = *(const f32x4*)(kn_g + sch * 8), kgb_ = *(const f32x4*)(kn_g + sch * 8 + 4); const float kg[8] = {kga_[0], kga_[1], kga_[2], kga_[3], kgb_[0], kgb_[1], kgb_[2], kgb_[3]}; \
        v4u w_; w_.x = pk2(kv_[0] * rs_ * kg[0], kv_[1] * rs_ * kg[1]); w_.y = pk2(kv_[2] * rs_ * kg[2], kv_[3] * rs_ * kg[3]); w_.z = pk2(kv_[4] * rs_ * kg[4], kv_[5] * rs_ * kg[5]); w_.w = pk2(kv_[6] * rs_ * kg[6], kv_[7] * rs_ * kg[7]); \
        *(LAS v4u*)(lds + (buf) * A2_BUF + hh_ * A2_KB + row_ * AT_RSK + sch * 16) = w_; \
        *(LAS v4u*)(lds + (buf) * A2_BUF + 2 * A2_KB + hh_ * A2_VB + row_ * AT_RSV + sch * 16) = vreg[hh_][i_]; } } while (0)
    A2_LOAD(kt_lo); A2_STORE(0);
    __syncthreads();
    LAS const float* tb = tbl + hs * 516;
    for (int kt = kt_lo, it = 0; kt <= kt_hi; ++kt, ++it) {
        const int buf = it & 1;
        if (kt < kt_hi) A2_LOAD(kt + 1);
        const int to = kt - (c - LOOKBACK);
        if (to >= 0 && to <= LOOKBACK) {
            LAS const unsigned char* Kb = lds + buf * A2_BUF + hs * A2_KB; LAS const unsigned char* Vb = lds + buf * A2_BUF + 2 * A2_KB + hs * A2_VB;
            f32x4 s[2][4];
#pragma unroll
            for (int nt = 0; nt < 4; ++nt) { s[0][nt] = (f32x4){0.f, 0.f, 0.f, 0.f}; s[1][nt] = s[0][nt];
#pragma unroll
                for (int ks = 0; ks < 4; ++ks) { const bf16x8 kf = frag_row(Kb, AT_RSK, 16 * nt, 32 * ks, lane); s[0][nt] = MFMA16(kf, qf[0][ks], s[0][nt]); s[1][nt] = MFMA16(kf, qf[1][ks], s[1][nt]); }
                if (nt & 1) __builtin_amdgcn_sched_barrier(0); }
            bf16x8 pf[2][2]; float al[2][4];
#pragma unroll
            for (int q = 0; q < 2; ++q) {
                const int relb = LOOKBACK * CHUNK - 64 * to + (q0 + 16 * q + l15) - 4 * g;
                if (to <= 3) { const float cb = tb[2 * REL_MAX];
#pragma unroll
                    for (int nt = 0; nt < 4; ++nt) s[q][nt] += cb; }
                else if (to >= 5) { const LAS float* tp = tb + relb + REL_MAX;
#pragma unroll
                    for (int nt = 0; nt < 4; ++nt)
#pragma unroll
                        for (int r = 0; r < 4; ++r) s[q][nt][r] += tp[-(16 * nt + r)]; }
                else {
#pragma unroll
                    for (int nt = 0; nt < 4; ++nt)
#pragma unroll
                        for (int r = 0; r < 4; ++r) { int rel = relb - 16 * nt - r; rel = rel > REL_MAX ? REL_MAX : rel; s[q][nt][r] += tb[rel + REL_MAX]; } }
                float tmax = fmaxf(fmaxf(s[q][0][0], s[q][0][1]), fmaxf(s[q][0][2], s[q][0][3]));
#pragma unroll
                for (int nt = 1; nt < 4; ++nt) tmax = fmaxf(tmax, fmaxf(fmaxf(s[q][nt][0], s[q][nt][1]), fmaxf(s[q][nt][2], s[q][nt][3])));
                tmax = fmaxf(tmax, __shfl_xor(tmax, 16)); tmax = fmaxf(tmax, __shfl_xor(tmax, 32));
                const float mnew = fmaxf(mrun[q], tmax), alpha = fexp2(mrun[q] - mnew);
                float rsum = 0.f;
#pragma unroll
                for (int nt = 0; nt < 4; ++nt)
#pragma unroll
                    for (int r = 0; r < 4; ++r) { s[q][nt][r] = fexp2(s[q][nt][r] - mnew); rsum += s[q][nt][r]; }
                rsum += __shfl_xor(rsum, 16); rsum += __shfl_xor(rsum, 32);
                lrun[q] = lrun[q] * alpha + rsum; mrun[q] = mnew;
                pf[q][0] = acc_pair_frag(s[q][0], s[q][1]); pf[q][1] = acc_pair_frag(s[q][2], s[q][3]);
#pragma unroll
                for (int r = 0; r < 4; ++r) al[q][r] = __shfl(alpha, 4 * g + r); }
#pragma unroll
            for (int dt = 0; dt < 8; ++dt) { const bf16x8 v0 = frag_tr_perm(Vb, AT_RSV, 0, 16 * dt, lane), v1 = frag_tr_perm(Vb, AT_RSV, 32, 16 * dt, lane);
#pragma unroll
                for (int q = 0; q < 2; ++q) { o[q][dt][0] *= al[q][0]; o[q][dt][1] *= al[q][1]; o[q][dt][2] *= al[q][2]; o[q][dt][3] *= al[q][3];
                    o[q][dt] = MFMA16(pf[q][0], v0, o[q][dt]); o[q][dt] = MFMA16(pf[q][1], v1, o[q][dt]); }
                if (dt & 1) __builtin_amdgcn_sched_barrier(0); }
        }
        if (kt < kt_hi) A2_STORE(buf ^ 1);
        __syncthreads();
    }
#undef A2_LOAD
#undef A2_STORE
#pragma unroll
    for (int q = 0; q < 2; ++q) { float li[4];
#pragma unroll
        for (int r = 0; r < 4; ++r) li[r] = frcp(__shfl(lrun[q], 4 * g + r));
#pragma unroll
        for (int r = 0; r < 4; ++r) { const size_t tok = (size_t)b * SEQ + c * 64 + q0 + 16 * q + 4 * g + r; const bf16_t* zp = PROJ + tok * EV_N + EC_ZA + h * 128 + l15; bf16_t* yp = Y + tok * D_MODEL + h * 128 + l15;
#pragma unroll
            for (int dt = 0; dt < 8; ++dt) yp[16 * dt] = (bf16_t)f2bf(o[q][dt][r] * li[r] * fsilu(bf2f(zp[16 * dt]))); } }
}
constexpr int ML_RSQ = 528, ML_RSK = 544, ML_RSV = 160, ML_RSP = 144, ML_RSH = 144;
constexpr int ML_OFF_Q = 0, ML_OFF_K = ML_OFF_Q + 64 * ML_RSQ, ML_OFF_V = ML_OFF_K + 64 * ML_RSK, ML_OFF_P = ML_OFF_V + 64 * ML_RSV, ML_OFF_H = ML_OFF_P + 64 * ML_RSP, ML_OFF_S = ML_OFF_H + 64 * ML_RSH;
constexpr int ML_BC = 0, ML_AA = 2048, ML_PM = 4096, ML_MCH = 6144  , ML_BL = 6184  , ML_PL = 6216  ;
constexpr int ML_E1 = 6248, ML_E2 = ML_E1 + 64, ML_WI = ML_E2 + 64, ML_EMT = ML_WI + 64, ML_WS = ML_EMT + 64, ML_RS = ML_WS + 64, ML_QN = ML_RS + 64, ML_NV = ML_QN + 64, ML_NP = ML_NV + 256, ML_WC = ML_NP + 512, ML_LDS = ML_OFF_S + (ML_WC + 4) * 4;
static_assert(ML_LDS <= 163328, "mLSTM LDS");
template <int SKIP = 0> __device__ __forceinline__ void mlstm_item(const Ptrs& P, LAS unsigned char* lds, int item, size_t yoff = WS_Y) {
    const bf16_t* __restrict__ PROJ = (const bf16_t*)(P.ws + WS_PROJ); bf16_t* __restrict__ Y = (bf16_t*)(P.ws + yoff); const float* __restrict__ GIF = (const float*)(P.ws + WS_GIF);
    const int tid = threadIdx.x, lane = tid & 63, wave = tid >> 6, g = lane >> 4, l15 = lane & 15;
    const int quarter = item & 3, h = (item >> 2) & 3, b = item >> 4;
    LAS float* sc = (LAS float*)(lds + ML_OFF_S);
    LAS const unsigned char* Qt = lds + ML_OFF_Q; LAS const unsigned char* Kt = lds + ML_OFF_K; LAS const unsigned char* Vt = lds + ML_OFF_V; LAS const unsigned char* Ps = lds + ML_OFF_P;
    const size_t tok0 = (size_t)b * SEQ;
    f32x4 cacc[16];
#pragma unroll
    for (int i = 0; i < 16; ++i) cacc[i] = (f32x4){0.f, 0.f, 0.f, 0.f};
    if (tid < 256) sc[ML_NV + tid] = 0.f;
    for (int e = tid; e < 64 * ML_RSP / 8; e += 512) *(LAS unsigned long long*)(lds + ML_OFF_P + e * 8) = 0ull;
#pragma unroll 1
    for (int c = wave * 4; c < wave * 4 + 4; ++c) { const size_t tok = tok0 + c * 64 + lane;
        const float li = GIF[tok * 8 + h], lf = logsigmoidf_(GIF[tok * 8 + 4 + h]);
        float bc = lf;
#pragma unroll
        for (int o = 1; o < 64; o <<= 1) { const float t_ = __shfl_up(bc, o); if (lane >= o) bc += t_; }
        const float as = li - bc; float pm = as;
#pragma unroll
        for (int o = 1; o < 64; o <<= 1) { const float t_ = __shfl_up(pm, o); if (lane >= o) pm = fmaxf(pm, t_); }
        sc[ML_BC + c * 64 + lane] = bc; sc[ML_AA + c * 64 + lane] = as; sc[ML_PM + c * 64 + lane] = pm;
        if (lane == 63) { sc[ML_BL + c] = bc; sc[ML_PL + c] = pm; } }
    __syncthreads();
    if (tid == 0) { float m = 0.f; sc[ML_MCH] = 0.f;
        for (int c = 0; c < NCH; ++c) { m = sc[ML_BL + c] + fmaxf(m, sc[ML_PL + c]); sc[ML_MCH + c + 1] = m; } }
    v4u qreg[4], kreg[4], vreg, oreg, zreg;
    const int ot = tid >> 3, oc = (tid & 7) * 8, ocol = h * 256 + quarter * 64 + oc;
#define ML_LOAD(n) do { _Pragma("unroll") for (int i_ = 0; i_ < 4; ++i_) { const int id_ = tid + 512 * i_, row_ = id_ >> 5, ch_ = id_ & 31; const bf16_t* rp_ = PROJ + (tok0 + (n) * 64 + row_) * EV_N + h * 256 + ch_ * 8; \
            qreg[i_] = *(const v4u*)(rp_ + EC_QB); kreg[i_] = *(const v4u*)(rp_ + EC_KB); } \
        vreg = *(const v4u*)(PROJ + (tok0 + (n) * 64 + (tid >> 3)) * EV_N + EC_VB + h * 256 + quarter * 64 + (tid & 7) * 8); } while (0)
#define ML_LOAD_OZ(n) do { const bf16_t* rp_ = PROJ + (tok0 + (n) * 64 + ot) * EV_N + ocol; oreg = *(const v4u*)(rp_ + EC_OB); zreg = *(const v4u*)(rp_ + EC_ZB); } while (0)
#define ML_STORE() do { _Pragma("unroll") for (int i_ = 0; i_ < 4; ++i_) { const int id_ = tid + 512 * i_, row_ = id_ >> 5, ch_ = id_ & 31; \
            *(LAS v4u*)(lds + ML_OFF_Q + row_ * ML_RSQ + ch_ * 16) = qreg[i_]; *(LAS v4u*)(lds + ML_OFF_K + row_ * ML_RSK + ch_ * 16) = kreg[i_]; } \
        *(LAS v4u*)(lds + ML_OFF_V + (tid >> 3) * ML_RSV + (tid & 7) * 16) = vreg; } while (0)
    ML_LOAD(0);
    __syncthreads();
    for (int n = 0; n < NCH; ++n) {
        if constexpr (!(SKIP & 64)) ML_STORE();
        const float m0 = sc[ML_MCH + n], m1 = sc[ML_MCH + n + 1], blast = sc[ML_BL + n];
        if (tid < 64) { const float bc = sc[ML_BC + n * 64 + tid], as = sc[ML_AA + n * 64 + tid], mx = fmaxf(m0, sc[ML_PM + n * 64 + tid]);
            sc[ML_E1 + tid] = -mx * LOG2E; sc[ML_E2 + tid] = as * LOG2E; sc[ML_WI + tid] = fexp(m0 - mx); sc[ML_EMT + tid] = fexp(-bc - mx); sc[ML_WS + tid] = fexp(as + blast - m1); sc[ML_RS + tid] = 0.f;
            if (tid == 0) sc[ML_WC] = fexp(blast + m0 - m1); }
        __syncthreads();
        if constexpr (!(SKIP & 64)) { if (n + 1 < NCH) ML_LOAD(n + 1); }
        f32x4 nu[4]; bf16x8 vf[2];
        if (wave >= 4) {
#pragma unroll 1
            for (int q = wave - 4; q < ((SKIP & 2) ? 0 : 10); q += 4) { const int tt = (q >= 6) ? 3 : (q >= 3) ? 2 : (q >= 1) ? 1 : 0; const int st = q - (tt * (tt + 1)) / 2;
                const int t = 16 * tt + l15; const float e1 = sc[ML_E1 + t];
                f32x4 s_ = (f32x4){0.f, 0.f, 0.f, 0.f};
#pragma unroll
                for (int ks = 0; ks < 8; ++ks) s_ = MFMA16(frag_row(Kt, ML_RSK, 16 * st, 32 * ks, lane), frag_row(Qt, ML_RSQ, 16 * tt, 32 * ks, lane), s_);
                float pv_[4]; float rs = 0.f;
#pragma unroll
                for (int r = 0; r < 4; ++r) { const int sidx = 16 * st + 4 * g + r; const float p = (sidx <= t) ? fexp2(e1 + sc[ML_E2 + sidx]) * s_[r] * 0.0625f : 0.f; pv_[r] = p; rs += p; }
                rs += __shfl_xor(rs, 16); rs += __shfl_xor(rs, 32);
                if (g == 0) atomicAdd((float*)(sc + ML_RS + t), rs);
                *(LAS unsigned long long*)(lds + ML_OFF_P + t * ML_RSP + (16 * st + 4 * g) * 2) = (unsigned long long)pk2(pv_[0], pv_[1]) | ((unsigned long long)pk2(pv_[2], pv_[3]) << 32); }
        } else {
#pragma unroll
            for (int tt = 0; tt < 4; ++tt) nu[tt] = (f32x4){0.f, 0.f, 0.f, 0.f};
#pragma unroll
            for (int j = 0; j < ((SKIP & 4) ? 0 : 8); ++j) { const bf16x8 cf = acc_pair_frag(cacc[2 * j], cacc[2 * j + 1]);
#pragma unroll
                for (int tt = 0; tt < 4; ++tt) nu[tt] = MFMA16(frag_row_perm(Qt, ML_RSQ, 16 * tt, 32 * j, lane), cf, nu[tt]);
                if (j & 1) __builtin_amdgcn_sched_barrier(0); }
            if constexpr (!(SKIP & 32)) { f32x4 qna = (f32x4){0.f, 0.f, 0.f, 0.f}; const LAS float* nvc = sc + ((n & 1) ? ML_NP : ML_NV);
#pragma unroll
              for (int j = 0; j < 8; ++j) { const f32x4 n0_ = *(LAS const f32x4*)(nvc + 32 * j + 4 * g), n1_ = *(LAS const f32x4*)(nvc + 32 * j + 16 + 4 * g);
                  qna = MFMA16(frag_row_perm(Qt, ML_RSQ, 16 * wave, 32 * j, lane), acc_pair_frag(n0_, n1_), qna); }
              if (l15 == 0) *(LAS f32x4*)(sc + ML_QN + 16 * wave + 4 * g) = qna * 0.0625f; }
            __builtin_amdgcn_sched_barrier(0);
#pragma unroll
            for (int tt = 0; tt < 4; ++tt) { const f32x4 wi = *(LAS const f32x4*)(sc + ML_WI + 16 * tt + 4 * g); nu[tt] *= wi * 0.0625f; }
            __builtin_amdgcn_sched_barrier(0);
#pragma unroll
            for (int ks = 0; ks < 2; ++ks) vf[ks] = frag_tr_perm(Vt, ML_RSV, 32 * ks, 16 * wave, lane);
            const float wc = sc[ML_WC];
            bf16x8 vw[2];
#pragma unroll
            for (int ks = 0; ks < 2; ++ks) { typedef unsigned u32x4_ __attribute__((ext_vector_type(4))); const u32x4_ w = __builtin_bit_cast(u32x4_, vf[ks]);
                const f32x4 wa = *(LAS const f32x4*)(sc + ML_WS + 32 * ks + 4 * g), wb = *(LAS const f32x4*)(sc + ML_WS + 32 * ks + 16 + 4 * g);
                const u32x4_ o = {pk2(__builtin_bit_cast(float, w.x << 16) * wa[0], __builtin_bit_cast(float, w.x & 0xffff0000u) * wa[1]), pk2(__builtin_bit_cast(float, w.y << 16) * wa[2], __builtin_bit_cast(float, w.y & 0xffff0000u) * wa[3]),
                                  pk2(__builtin_bit_cast(float, w.z << 16) * wb[0], __builtin_bit_cast(float, w.z & 0xffff0000u) * wb[1]), pk2(__builtin_bit_cast(float, w.w << 16) * wb[2], __builtin_bit_cast(float, w.w & 0xffff0000u) * wb[3])};
                vw[ks] = __builtin_bit_cast(bf16x8, o); }
#pragma unroll
            for (int kt = 0; kt < ((SKIP & 8) ? 0 : 16); ++kt) { cacc[kt] *= wc;
                cacc[kt] = MFMA16(frag_tr_perm(Kt, ML_RSK, 0, 16 * kt, lane), vw[0], cacc[kt]);
                cacc[kt] = MFMA16(frag_tr_perm(Kt, ML_RSK, 32, 16 * kt, lane), vw[1], cacc[kt]);
                if ((kt & 3) == 3) __builtin_amdgcn_sched_barrier(0); }
#pragma unroll
            for (int kt = 0; kt < 16; ++kt) asm volatile("" : "+v"(cacc[kt]));
            if constexpr (!(SKIP & 32)) { bf16x8 wsf[2];
#pragma unroll
              for (int ks = 0; ks < 2; ++ks) { const f32x4 w0_ = *(LAS const f32x4*)(sc + ML_WS + 32 * ks + 4 * g), w1_ = *(LAS const f32x4*)(sc + ML_WS + 32 * ks + 16 + 4 * g); wsf[ks] = acc_pair_frag(w0_, w1_); }
              const LAS float* nvo = sc + ((n & 1) ? ML_NP : ML_NV); LAS float* nvn = sc + ((n & 1) ? ML_NV : ML_NP);
#pragma unroll
              for (int i = 0; i < 4; ++i) { const int kt = 4 * wave + i; f32x4 na = (f32x4){0.f, 0.f, 0.f, 0.f};
                  na = MFMA16(frag_tr_perm(Kt, ML_RSK, 0, 16 * kt, lane), wsf[0], na); na = MFMA16(frag_tr_perm(Kt, ML_RSK, 32, 16 * kt, lane), wsf[1], na);
                  if (l15 == 0) *(LAS f32x4*)(nvn + 16 * kt + 4 * g) = *(LAS const f32x4*)(nvo + 16 * kt + 4 * g) * wc + na; } }
        }
        __syncthreads();
        if constexpr (!(SKIP & 1)) ML_LOAD_OZ(n);
        if (wave < 4) {
#pragma unroll
            for (int ks = 0; ks < ((SKIP & 16) ? 0 : 2); ++ks) {
#pragma unroll
                for (int tt = 0; tt < 4; ++tt) nu[tt] = MFMA16(frag_row_perm(Ps, ML_RSP, 16 * tt, 32 * ks, lane), vf[ks], nu[tt]); }
#pragma unroll
            for (int tt = 0; tt < 4; ++tt)
#pragma unroll
                for (int r = 0; r < 4; ++r) *(LAS unsigned short*)(lds + ML_OFF_H + (16 * tt + 4 * g + r) * ML_RSH + (16 * wave + l15) * 2) = (unsigned short)(pk2(nu[tt][r], 0.f) & 0xffffu);
            __builtin_amdgcn_sched_barrier(0);
        }
        __syncthreads();
        if constexpr (!(SKIP & 1)) { const float den = sc[ML_WI + ot] * sc[ML_QN + ot] + sc[ML_RS + ot]; const float inv = frcp(fmaxf(fabsf(den), sc[ML_EMT + ot]));
          const v4u hw = *(LAS const v4u*)(lds + ML_OFF_H + ot * ML_RSH + oc * 2); const v4u ow = oreg, zw = zreg;
#define ML_Y(hx, ox, zx, lo) (fsigmoid(__builtin_bit_cast(float, (lo) ? ((ox) << 16) : ((ox) & 0xffff0000u))) * (__builtin_bit_cast(float, (lo) ? ((hx) << 16) : ((hx) & 0xffff0000u)) * inv) * fsilu(__builtin_bit_cast(float, (lo) ? ((zx) << 16) : ((zx) & 0xffff0000u))))
          v4u yw; yw.x = pk2(ML_Y(hw.x, ow.x, zw.x, 1), ML_Y(hw.x, ow.x, zw.x, 0)); yw.y = pk2(ML_Y(hw.y, ow.y, zw.y, 1), ML_Y(hw.y, ow.y, zw.y, 0));
          yw.z = pk2(ML_Y(hw.z, ow.z, zw.z, 1), ML_Y(hw.z, ow.z, zw.z, 0)); yw.w = pk2(ML_Y(hw.w, ow.w, zw.w, 1), ML_Y(hw.w, ow.w, zw.w, 0));
#undef ML_Y
          *(v4u*)(Y + (tok0 + n * 64 + ot) * D_MODEL + W_A + ocol) = yw; }
    }
#undef ML_LOAD
#undef ML_LOAD_OZ
#undef ML_STORE
    __syncthreads();
}
constexpr int RG_RSG = 160, RG_RSX = 272, RG_RSF = 33 * 4;
constexpr int RG_OFF_G = 0, RG_OFF_X = RG_OFF_G + 128 * RG_RSG, RG_OFF_XF = RG_OFF_X + 64 * RG_RSX, RG_OFF_A = RG_OFF_XF + 64 * RG_RSF, RG_OFF_I = RG_OFF_A + 64 * RG_RSF, RG_OFF_H = RG_OFF_I + 64 * RG_RSF, RG_LDS = RG_OFF_H + 64 * RG_RSF;
static_assert(RG_LDS <= 163328, "RG-LRU LDS");
template <int SKIP = 0> __device__ __forceinline__ void rglru_item(const Ptrs& P, LAS unsigned char* lds, int item, size_t yoff = WS_Y) {
    const bf16_t* __restrict__ PROJ = (const bf16_t*)(P.ws + WS_PROJ); bf16_t* __restrict__ Y = (bf16_t*)(P.ws + yoff);
    const float* __restrict__ ccw = P.in[IN_OD_CCW]; const float* __restrict__ ccb = P.in[IN_OD_CCB]; const float* __restrict__ gw = P.in[IN_OD_GW]; const float* __restrict__ gb = P.in[IN_OD_GB]; const float* __restrict__ lam = P.in[IN_OD_LAM];
    const int tid = threadIdx.x, lane = tid & 63, wave = tid >> 6, g = lane >> 4, l15 = lane & 15;
    const int cq = item & 3, blk = (item >> 2) & 7, b = item >> 5;
    const size_t tok0 = (size_t)b * SEQ;
    for (int e = tid; e < 128 * 64; e += 512) { const int k = e >> 6, c = e & 63; const int d = (c < 32) ? (cq * 32 + c) : (128 + cq * 32 + c - 32);
        *(LAS unsigned short*)(lds + RG_OFF_G + k * RG_RSG + c * 2) = (unsigned short)f2bf(gw[((size_t)blk * 128 + k) * 256 + d]); }
    const int c8 = tid & 15, tq = tid >> 4, ch0 = blk * 128 + 8 * c8;
    float cw[4][8], cb[8];
#pragma unroll
    for (int i = 0; i < 8; ++i) { cb[i] = ccb[ch0 + i];
#pragma unroll
        for (int j = 0; j < 4; ++j) cw[j][i] = ccw[j * W_C + ch0 + i]; }
    const int chl = 16 * (wave & 1) + l15, cgl = blk * 128 + cq * 32 + chl;
    const float gbr = gb[cgl], gbi = gb[W_C + cgl], sp = softplusf_(-lam[cgl]);
    float hcar = 0.f;
    v4u xin[2][4]; unsigned long long zin = 0ull;
    const int ot = tid >> 3, oc4 = tid & 7, cgo = blk * 128 + cq * 32 + 4 * oc4;
#define RG_LOAD(n) do { _Pragma("unroll") for (int u_ = 0; u_ < 2; ++u_) { const int s_ = (n) * 64 + tq + 32 * u_; \
            _Pragma("unroll") for (int j_ = 0; j_ < 4; ++j_) { const bool ok_ = (s_ - 3 + j_ >= 0); const v4u x_ = *(const v4u*)(PROJ + (tok0 + (ok_ ? s_ - 3 + j_ : 0)) * OD_N + OC_XC + ch0); \
                xin[u_][j_].x = ok_ ? x_.x : 0u; xin[u_][j_].y = ok_ ? x_.y : 0u; xin[u_][j_].z = ok_ ? x_.z : 0u; xin[u_][j_].w = ok_ ? x_.w : 0u; } } \
        zin = *(const unsigned long long*)(PROJ + (tok0 + (n) * 64 + ot) * OD_N + OC_ZC + cgo); } while (0)
    RG_LOAD(0);
    __syncthreads();
    for (int n = 0; n < NCH; ++n) {
        const unsigned long long zw = zin;
#pragma unroll
        for (int u = 0; u < ((SKIP & 1) ? 0 : 2); ++u) { const int t = tq + 32 * u; float xv[8];
#pragma unroll
            for (int i = 0; i < 8; ++i) xv[i] = cb[i];
#pragma unroll
            for (int j = 0; j < 4; ++j) { const v4u w_ = xin[u][j];
                xv[0] += cw[j][0] * __builtin_bit_cast(float, w_.x << 16); xv[1] += cw[j][1] * __builtin_bit_cast(float, w_.x & 0xffff0000u); xv[2] += cw[j][2] * __builtin_bit_cast(float, w_.y << 16); xv[3] += cw[j][3] * __builtin_bit_cast(float, w_.y & 0xffff0000u);
                xv[4] += cw[j][4] * __builtin_bit_cast(float, w_.z << 16); xv[5] += cw[j][5] * __builtin_bit_cast(float, w_.z & 0xffff0000u); xv[6] += cw[j][6] * __builtin_bit_cast(float, w_.w << 16); xv[7] += cw[j][7] * __builtin_bit_cast(float, w_.w & 0xffff0000u); }
            v4u w; w.x = pk2(xv[0], xv[1]); w.y = pk2(xv[2], xv[3]); w.z = pk2(xv[4], xv[5]); w.w = pk2(xv[6], xv[7]);
            *(LAS v4u*)(lds + RG_OFF_X + t * RG_RSX + c8 * 16) = w;
            if ((c8 >> 2) == cq) { LAS float* xf = (LAS float*)(lds + RG_OFF_XF + t * RG_RSF) + 8 * (c8 & 3);
#pragma unroll
                for (int i = 0; i < 8; ++i) xf[i] = xv[i]; } }
        if (n + 1 < NCH) RG_LOAD(n + 1);
        __syncthreads();
        { const int tt = wave >> 1, cp = wave & 1; f32x4 ar = (f32x4){0.f, 0.f, 0.f, 0.f}, ai = ar;
#pragma unroll
          for (int ks = 0; ks < ((SKIP & 2) ? 0 : 4); ++ks) { const bf16x8 xa = frag_row(lds + RG_OFF_X, RG_RSX, 16 * tt, 32 * ks, lane);
              ar = MFMA16(xa, frag_tr(lds + RG_OFF_G, RG_RSG, 32 * ks, 16 * cp, lane), ar);
              ai = MFMA16(xa, frag_tr(lds + RG_OFF_G, RG_RSG, 32 * ks, 32 + 16 * cp, lane), ai); }
#pragma unroll
          for (int r = 0; r < ((SKIP & 4) ? 0 : 4); ++r) { const int t = 16 * tt + 4 * g + r;
              const float rr = fsigmoid(ar[r] + gbr), ig = fsigmoid(ai[r] + gbi); const float la = -8.0f * rr * sp;
              const float xc = *((LAS const float*)(lds + RG_OFF_XF + t * RG_RSF) + chl);
              *((LAS float*)(lds + RG_OFF_A + t * RG_RSF) + chl) = fexp(la);
              *((LAS float*)(lds + RG_OFF_I + t * RG_RSF) + chl) = fsqrt(1.0f - fexp(2.0f * la)) * (ig * xc); } }
        __syncthreads();
        if ((SKIP & 8) == 0 && tid < 32) { float h = hcar;
#pragma unroll 8
            for (int t = 0; t < 64; ++t) { h = *((LAS const float*)(lds + RG_OFF_A + t * RG_RSF) + tid) * h + *((LAS const float*)(lds + RG_OFF_I + t * RG_RSF) + tid);
                *((LAS float*)(lds + RG_OFF_H + t * RG_RSF) + tid) = h; }
            hcar = h; }
        __syncthreads();
        if constexpr (!(SKIP & 16)) { const size_t tok = tok0 + n * 64 + ot;
          const LAS float* hp = (LAS const float*)(lds + RG_OFF_H + ot * RG_RSF) + 4 * oc4;
          const float z0 = __builtin_bit_cast(float, (unsigned)(zw & 0xffffull) << 16), z1 = __builtin_bit_cast(float, (unsigned)(zw >> 16 & 0xffffull) << 16), z2 = __builtin_bit_cast(float, (unsigned)(zw >> 32 & 0xffffull) << 16), z3 = __builtin_bit_cast(float, (unsigned)(zw >> 48) << 16);
          *(unsigned long long*)(Y + tok * D_MODEL + cgo) = (unsigned long long)pk2(hp[0] * fsilu(z0), hp[1] * fsilu(z1)) | ((unsigned long long)pk2(hp[2] * fsilu(z2), hp[3] * fsilu(z3)) << 32); }
    }
#undef RG_LOAD
    __syncthreads();
}
constexpr size_t WS_DQ2 = 4 * MiB, WS_DK2 = 36 * MiB;
constexpr size_t WS_DWT = WS_XB, WS_DUT = WS_XB + 32 * MiB;
constexpr size_t WS_DQK = WS_FREE1, WS_DDEC = WS_FREE1 + 16 * MiB;
constexpr float DN_SCALE = 0.08838834764831845f;
template <int T> struct SolveRows {
    static __device__ __forceinline__ void run(float (&col)[32], LAS const unsigned char* Ab, int j) {
        SolveRows<T - 1>::run(col, Ab, j);
        float v = (T == j) ? 1.f : 0.f;
#pragma unroll
        for (int s4 = 0; s4 < (T + 3) / 4; ++s4) { const f32x4 a = *(LAS const f32x4*)(Ab + T * 272 + 16 * s4);
#pragma unroll
            for (int e = 0; e < 4; ++e) { if (4 * s4 + e < T) v -= a[e] * col[4 * s4 + e]; } }
        asm volatile("" : "+v"(v) :: "memory"); col[T] = v;
    }
};
template <> struct SolveRows<-1> { static __device__ __forceinline__ void run(float (&)[32], LAS const unsigned char*, int) {} };
constexpr int D1_RSQ = 272, D1_RSK = 288, D1_RSV = 288, D1_RSA = 272, D1_RST = 160;
constexpr int D1_OFF_Q = 0, D1_OFF_K = D1_OFF_Q + 64 * D1_RSQ, D1_OFF_V = D1_OFF_K + 64 * D1_RSK, D1_OFF_A = D1_OFF_V + 64 * D1_RSV, D1_OFF_T = D1_OFF_A + 64 * D1_RSA, D1_OFF_S = D1_OFF_T + 64 * D1_RST, D1_LDS = D1_OFF_S + 512;
static_assert(D1_LDS <= 163328, "D1 LDS");
template <int SKIP = 0> __device__ __forceinline__ void dn1_item(const Ptrs& P, LAS unsigned char* lds, int item) {
    const bf16_t* __restrict__ PROJ = (const bf16_t*)(P.ws + WS_PROJ); const float* __restrict__ AB = (const float*)(P.ws + WS_AB); const float* __restrict__ cdw = P.in[IN_OD_CDW];
    bf16_t* __restrict__ Q2 = (bf16_t*)(P.ws + WS_DQ2); bf16_t* __restrict__ K2 = (bf16_t*)(P.ws + WS_DK2);
    bf16_t* __restrict__ WTg = (bf16_t*)(P.ws + WS_DWT) + (size_t)item * 8192; bf16_t* __restrict__ UTg = (bf16_t*)(P.ws + WS_DUT) + (size_t)item * 8192;
    bf16_t* __restrict__ QKg = (bf16_t*)(P.ws + WS_DQK) + (size_t)item * 4096; float* __restrict__ DECg = (float*)(P.ws + WS_DDEC) + (size_t)item * 64;
    int tid_ = threadIdx.x; asm volatile("" : "+v"(tid_));
    const int tid = tid_, lane = tid & 63, wave = tid >> 6, g = lane >> 4, l15 = lane & 15;
    const int n = item & 31, h = (item >> 5) & 7, b = item >> 8;
    const size_t tok0 = (size_t)b * SEQ + n * 64;
    LAS float* beta_s = (LAS float*)(lds + D1_OFF_S); LAS float* dec_s = beta_s + 64;
    asm volatile("" ::: "memory");
    if constexpr (!(SKIP & 1)) { const int t = tid >> 3, d16 = tid & 7, s = n * 64 + t; float qk_[2][16]; float ssq[2] = {0.f, 0.f};
#pragma unroll
      for (int pp = 0; pp < 3; ++pp) { const int p = (pp + 2) % 3;
#pragma unroll
          for (int hf = 0; hf < 2; ++hf) { const int col = p * W_D + h * 128 + 16 * d16 + 8 * hf; float a[8];
              v4u xw[4];
#pragma unroll
              for (int j = 0; j < 4; ++j) { const bool ok = (s - 3 + j >= 0); xw[j] = *(const v4u*)(PROJ + (ok ? tok0 + t - 3 + j : tok0) * OD_N + OC_QD + col); }
#pragma unroll
              for (int i = 0; i < 8; ++i) a[i] = 0.f;
#pragma unroll
              for (int j = 0; j < 4; ++j) { const float m_ = (s - 3 + j >= 0) ? 1.0f : 0.0f; const f32x4 w0 = *(const f32x4*)(cdw + j * 3 * W_D + col) * m_, w1 = *(const f32x4*)(cdw + j * 3 * W_D + col + 4) * m_; const v4u x_ = xw[j];
                  a[0] += w0[0] * __builtin_bit_cast(float, x_.x << 16); a[1] += w0[1] * __builtin_bit_cast(float, x_.x & 0xffff0000u); a[2] += w0[2] * __builtin_bit_cast(float, x_.y << 16); a[3] += w0[3] * __builtin_bit_cast(float, x_.y & 0xffff0000u);
                  a[4] += w1[0] * __builtin_bit_cast(float, x_.z << 16); a[5] += w1[1] * __builtin_bit_cast(float, x_.z & 0xffff0000u); a[6] += w1[2] * __builtin_bit_cast(float, x_.w << 16); a[7] += w1[3] * __builtin_bit_cast(float, x_.w & 0xffff0000u); }
#pragma unroll
              for (int i = 0; i < 8; ++i) a[i] = fsilu(a[i]);
              if (p < 2) {
#pragma unroll
                  for (int i = 0; i < 8; ++i) { qk_[p][8 * hf + i] = a[i]; ssq[p] += a[i] * a[i]; } }
              else { v4u w; w.x = pk2(a[0], a[1]); w.y = pk2(a[2], a[3]); w.z = pk2(a[4], a[5]); w.w = pk2(a[6], a[7]);
                  *(LAS v4u*)(lds + D1_OFF_V + t * D1_RSV + (16 * d16 + 8 * hf) * 2) = w; }
              asm volatile("" ::: "memory"); } }
#pragma unroll
      for (int p = 0; p < 2; ++p) { float ss = ssq[p]; ss += __shfl_xor(ss, 1); ss += __shfl_xor(ss, 2); ss += __shfl_xor(ss, 4); const float rs = frsq(ss + EPS);
#pragma unroll
          for (int hf = 0; hf < 2; ++hf) { v4u w; w.x = pk2(qk_[p][8 * hf + 0] * rs, qk_[p][8 * hf + 1] * rs); w.y = pk2(qk_[p][8 * hf + 2] * rs, qk_[p][8 * hf + 3] * rs);
              w.z = pk2(qk_[p][8 * hf + 4] * rs, qk_[p][8 * hf + 5] * rs); w.w = pk2(qk_[p][8 * hf + 6] * rs, qk_[p][8 * hf + 7] * rs);
              const int dd = 16 * d16 + 8 * hf;
              if (p == 0) { *(LAS v4u*)(lds + D1_OFF_Q + t * D1_RSQ + dd * 2) = w; *(v4u*)(Q2 + (tok0 + t) * W_D + h * 128 + dd) = w; }
              else { *(LAS v4u*)(lds + D1_OFF_K + t * D1_RSK + dd * 2) = w; *(v4u*)(K2 + (tok0 + t) * W_D + h * 128 + dd) = w; } } } }
    if (wave == 0) { const size_t tok = tok0 + lane;
        const float beta = fsigmoid(AB[tok * 16 + 8 + h]); float dc = -fexp(P.in[IN_OD_ALOG][h]) * softplusf_(AB[tok * 16 + h] + P.in[IN_OD_DTB][h]);
#pragma unroll
        for (int o = 1; o < 64; o <<= 1) { const float t_ = __shfl_up(dc, o); if (lane >= o) dc += t_; }
        beta_s[lane] = beta; dec_s[lane] = dc; DECg[lane] = dc; }
    __syncthreads();
    { const int tt = wave >> 1, t = 16 * tt + l15; const float dt_ = dec_s[t], bt = beta_s[t];
#pragma unroll
      for (int u = 0; u < 2; ++u) { const int st = 2 * (wave & 1) + u; unsigned long long qw = 0ull;
          if (st <= tt && !(SKIP & 2)) { f32x4 kk = (f32x4){0.f, 0.f, 0.f, 0.f}, qk = kk;
#pragma unroll
              for (int ks = 0; ks < 4; ++ks) { const bf16x8 a = frag_row(lds + D1_OFF_K, D1_RSK, 16 * st, 32 * ks, lane);
                  kk = MFMA16(a, frag_row(lds + D1_OFF_K, D1_RSK, 16 * tt, 32 * ks, lane), kk); qk = MFMA16(a, frag_row(lds + D1_OFF_Q, D1_RSQ, 16 * tt, 32 * ks, lane), qk); }
              f32x4 am; float qv[4];
#pragma unroll
              for (int r = 0; r < 4; ++r) { const int s = 16 * st + 4 * g + r; const float gam = (s <= t) ? fexp(dt_ - dec_s[s]) : 0.f; am[r] = (s < t) ? bt * kk[r] * gam : 0.f; qv[r] = qk[r] * gam * DN_SCALE; }
              *(LAS f32x4*)(lds + D1_OFF_A + t * D1_RSA + (16 * st + 4 * g) * 4) = am;
              qw = (unsigned long long)pk2(qv[0], qv[1]) | ((unsigned long long)pk2(qv[2], qv[3]) << 32); }
          *(unsigned long long*)(QKg + t * 64 + 16 * st + 4 * g) = qw; } }
    __syncthreads();
    if (wave == 0 && !(SKIP & 4)) { const int hb = lane >> 5, j = lane & 31; float col[32];
        LAS const unsigned char* Ab = lds + D1_OFF_A + (32 * hb) * D1_RSA + (32 * hb) * 4;
        SolveRows<31>::run(col, Ab, j);
        LAS unsigned char* trow = lds + D1_OFF_T + (32 * hb + j) * D1_RST;
#pragma unroll
        for (int c = 0; c < 4; ++c) { v4u w; w.x = pk2(col[8 * c], col[8 * c + 1]); w.y = pk2(col[8 * c + 2], col[8 * c + 3]); w.z = pk2(col[8 * c + 4], col[8 * c + 5]); w.w = pk2(col[8 * c + 6], col[8 * c + 7]);
            *(LAS v4u*)(trow + (32 * hb) * 2 + 16 * c) = w;
            if (hb) *(LAS v4u*)(trow + 16 * c) = (v4u){0u, 0u, 0u, 0u}; }
        bf16x8 af[2], bfr[2];
#pragma unroll
        for (int ti = 0; ti < 2; ++ti) { LAS const unsigned char* ap = lds + D1_OFF_A + (32 + 16 * ti + l15) * D1_RSA + (8 * g) * 4; const f32x4 a0 = *(LAS const f32x4*)ap, a1 = *(LAS const f32x4*)(ap + 16);
            typedef unsigned u32x4_ __attribute__((ext_vector_type(4))); const u32x4_ w = {pk2(a0[0], a0[1]), pk2(a0[2], a0[3]), pk2(a1[0], a1[1]), pk2(a1[2], a1[3])}; af[ti] = __builtin_bit_cast(bf16x8, w); }
#pragma unroll
        for (int nj = 0; nj < 2; ++nj) bfr[nj] = frag_row(lds + D1_OFF_T, D1_RST, 16 * nj, 0, lane);
        f32x4 X[2][2];
#pragma unroll
        for (int ti = 0; ti < 2; ++ti)
#pragma unroll
            for (int nj = 0; nj < 2; ++nj) X[ti][nj] = MFMA16(af[ti], bfr[nj], ((f32x4){0.f, 0.f, 0.f, 0.f}));
        LAS const unsigned char* T11b = lds + D1_OFF_T + 32 * D1_RST + 64;
#pragma unroll
        for (int nj = 0; nj < 2; ++nj) { const bf16x8 xb = acc_pair_frag(X[0][nj], X[1][nj]);
#pragma unroll
            for (int ti = 0; ti < 2; ++ti) { const f32x4 r_ = MFMA16(frag_tr_perm(T11b, D1_RST, 0, 16 * ti, lane), xb, ((f32x4){0.f, 0.f, 0.f, 0.f}));
                *(LAS unsigned long long*)(lds + D1_OFF_T + (16 * nj + l15) * D1_RST + (32 + 16 * ti + 4 * g) * 2) = (unsigned long long)pk2(-r_[0], -r_[1]) | ((unsigned long long)pk2(-r_[2], -r_[3]) << 32); } }
    }
    __syncthreads();
    if constexpr (!(SKIP & 8)) { bf16x8 bv[2], bk[2];
#pragma unroll
      for (int ks = 0; ks < 2; ++ks) { typedef unsigned u32x4_ __attribute__((ext_vector_type(4)));
          const u32x4_ wv = __builtin_bit_cast(u32x4_, frag_tr(lds + D1_OFF_V, D1_RSV, 32 * ks, 16 * wave, lane)), wk = __builtin_bit_cast(u32x4_, frag_tr(lds + D1_OFF_K, D1_RSK, 32 * ks, 16 * wave, lane));
          float fb[8], fk[8];
#pragma unroll
          for (int i = 0; i < 8; ++i) { const int s = 32 * ks + 8 * g + i; fb[i] = beta_s[s]; fk[i] = fb[i] * fexp(dec_s[s]); }
#define SC2(w_, f0, f1) pk2(__builtin_bit_cast(float, (w_) << 16) * (f0), __builtin_bit_cast(float, (w_) & 0xffff0000u) * (f1))
          const u32x4_ ov = {SC2(wv.x, fb[0], fb[1]), SC2(wv.y, fb[2], fb[3]), SC2(wv.z, fb[4], fb[5]), SC2(wv.w, fb[6], fb[7])};
          const u32x4_ ok = {SC2(wk.x, fk[0], fk[1]), SC2(wk.y, fk[2], fk[3]), SC2(wk.z, fk[4], fk[5]), SC2(wk.w, fk[6], fk[7])};
#undef SC2
          bv[ks] = __builtin_bit_cast(bf16x8, ov); bk[ks] = __builtin_bit_cast(bf16x8, ok); }
#pragma unroll
      for (int tt = 0; tt < 4; ++tt) { f32x4 u = (f32x4){0.f, 0.f, 0.f, 0.f}, wv = u;
#pragma unroll
          for (int ks = 0; ks < 2; ++ks) { const bf16x8 at = frag_tr(lds + D1_OFF_T, D1_RST, 32 * ks, 16 * tt, lane); u = MFMA16(at, bv[ks], u); wv = MFMA16(at, bk[ks], wv); }
          const size_t o_ = (size_t)(16 * wave + l15) * 64 + 16 * tt + 4 * g;
          *(unsigned long long*)(UTg + o_) = (unsigned long long)pk2(u[0], u[1]) | ((unsigned long long)pk2(u[2], u[3]) << 32);
          *(unsigned long long*)(WTg + o_) = (unsigned long long)pk2(wv[0], wv[1]) | ((unsigned long long)pk2(wv[2], wv[3]) << 32); } }
    __syncthreads();
}
constexpr int D2_RSW = 144, D2_RSQ = 272, D2_RSK = 288, D2_RSP = 144, D2_RSO = 528;
constexpr int D2_OFF_W = 0, D2_OFF_Q = D2_OFF_W + 128 * D2_RSW, D2_OFF_K = D2_OFF_Q + 64 * D2_RSQ, D2_OFF_P = D2_OFF_K + 64 * D2_RSK, D2_OFF_O = D2_OFF_P + 64 * D2_RSP, D2_OFF_D = D2_OFF_O + 64 * D2_RSO, D2_LDS = D2_OFF_D + 1024;
static_assert(D2_LDS <= 163328, "D2 LDS");
template <int SKIP = 0> __device__ __forceinline__ void dn2_item(const Ptrs& P, LAS unsigned char* lds, int item, size_t yoff = WS_Y) {
    const bf16_t* __restrict__ PROJ = (const bf16_t*)(P.ws + WS_PROJ); bf16_t* __restrict__ Y = (bf16_t*)(P.ws + yoff);
    const bf16_t* __restrict__ Q2 = (const bf16_t*)(P.ws + WS_DQ2); const bf16_t* __restrict__ K2 = (const bf16_t*)(P.ws + WS_DK2);
    const int tid = threadIdx.x, lane = tid & 63, wave = tid >> 6, g = lane >> 4, l15 = lane & 15;
    const int h = item & 7, b = item >> 3;
    const size_t tok0 = (size_t)b * SEQ; const int it0 = item * 32;
    const bf16_t* __restrict__ WTg = (const bf16_t*)(P.ws + WS_DWT) + (size_t)it0 * 8192; const bf16_t* __restrict__ UTg = (const bf16_t*)(P.ws + WS_DUT) + (size_t)it0 * 8192;
    const bf16_t* __restrict__ QKg = (const bf16_t*)(P.ws + WS_DQK) + (size_t)it0 * 4096; const float* __restrict__ DECg = (const float*)(P.ws + WS_DDEC) + (size_t)it0 * 64;
    LAS float* ed_s = (LAS float*)(lds + D2_OFF_D); LAS float* ek_s = ed_s + 64; LAS float* edl_s = ed_s + 128;
    f32x4 sacc[8];
#pragma unroll
    for (int i = 0; i < 8; ++i) sacc[i] = (f32x4){0.f, 0.f, 0.f, 0.f};
    const int ot = tid >> 3, oc = (tid & 7) * 16;
    float og[16];
#pragma unroll
    for (int i = 0; i < 16; ++i) og[i] = P.in[IN_OD_ONORM][oc + i];
    v4u wreg[2], qreg[2], kreg[2], preg, zreg[2]; unsigned long long ureg[4]; float dreg = 0.f, dlreg = 0.f;
#define D2_LOAD(n) do { _Pragma("unroll") for (int i_ = 0; i_ < 2; ++i_) { const int id_ = tid + 512 * i_; wreg[i_] = *(const v4u*)(WTg + (size_t)(n) * 8192 + id_ * 8); \
            const int row_ = id_ >> 4, ch_ = id_ & 15; const size_t o2_ = (tok0 + (n) * 64 + row_) * W_D + h * 128 + ch_ * 8; qreg[i_] = *(const v4u*)(Q2 + o2_); kreg[i_] = *(const v4u*)(K2 + o2_); } \
        preg = *(const v4u*)(QKg + (size_t)(n) * 4096 + tid * 8); \
        _Pragma("unroll") for (int tt_ = 0; tt_ < 4; ++tt_) ureg[tt_] = *(const unsigned long long*)(UTg + (size_t)(n) * 8192 + (16 * wave + l15) * 64 + 16 * tt_ + 4 * g); \
        if (tid < 64) { dreg = DECg[(n) * 64 + tid]; dlreg = DECg[(n) * 64 + 63]; } } while (0)
#define D2_LOAD_Z(n) do { const bf16_t* zp_ = PROJ + (tok0 + (n) * 64 + ot) * OD_N + OC_ZD + h * 128 + oc; zreg[0] = *(const v4u*)zp_; zreg[1] = *(const v4u*)(zp_ + 8); } while (0)
#define D2_STORE() do { _Pragma("unroll") for (int i_ = 0; i_ < 2; ++i_) { const int id_ = tid + 512 * i_; *(LAS v4u*)(lds + D2_OFF_W + (id_ >> 3) * D2_RSW + (id_ & 7) * 16) = wreg[i_]; \
            const int row_ = id_ >> 4, ch_ = id_ & 15; *(LAS v4u*)(lds + D2_OFF_Q + row_ * D2_RSQ + ch_ * 16) = qreg[i_]; *(LAS v4u*)(lds + D2_OFF_K + row_ * D2_RSK + ch_ * 16) = kreg[i_]; } \
        *(LAS v4u*)(lds + D2_OFF_P + (tid >> 3) * D2_RSP + (tid & 7) * 16) = preg; \
        if (tid < 64) { ed_s[tid] = fexp(dreg) * DN_SCALE; ek_s[tid] = fexp(dlreg - dreg); if (tid == 0) edl_s[0] = fexp(dlreg); } } while (0)
    D2_LOAD(0);
    for (int n = 0; n < NCH; ++n) {
        if constexpr (!(SKIP & 16)) D2_STORE();
        f32x4 un[4];
#pragma unroll
        for (int tt = 0; tt < 4; ++tt) { un[tt][0] = __builtin_bit_cast(float, (unsigned)(ureg[tt] & 0xffffull) << 16); un[tt][1] = __builtin_bit_cast(float, (unsigned)(ureg[tt] >> 16 & 0xffffull) << 16);
            un[tt][2] = __builtin_bit_cast(float, (unsigned)(ureg[tt] >> 32 & 0xffffull) << 16); un[tt][3] = __builtin_bit_cast(float, (unsigned)(ureg[tt] >> 48) << 16); }
        __syncthreads();
        if constexpr (!(SKIP & 16)) { if (n + 1 < NCH) D2_LOAD(n + 1); }
        bf16x8 sf[4];
#pragma unroll
        for (int j = 0; j < 4; ++j) sf[j] = acc_pair_frag(sacc[2 * j], sacc[2 * j + 1]);
        f32x4 vn[4], o[4];
#pragma unroll
        for (int tt = 0; tt < 4; ++tt) { f32x4 ws_ = (f32x4){0.f, 0.f, 0.f, 0.f}, qs_ = ws_;
#pragma unroll
            for (int j = 0; j < ((SKIP & 2) ? 0 : 4); ++j) { ws_ = MFMA16(frag_tr_perm(lds + D2_OFF_W, D2_RSW, 32 * j, 16 * tt, lane), sf[j], ws_); qs_ = MFMA16(frag_row_perm(lds + D2_OFF_Q, D2_RSQ, 16 * tt, 32 * j, lane), sf[j], qs_); }
            vn[tt] = un[tt] - ws_; o[tt] = qs_ * *(LAS const f32x4*)(ed_s + 16 * tt + 4 * g); }
        __builtin_amdgcn_sched_barrier(0);
        bf16x8 vf[2], vsf[2];
#pragma unroll
        for (int ks = 0; ks < 2; ++ks) { vf[ks] = acc_pair_frag(vn[2 * ks], vn[2 * ks + 1]);
            const f32x4 a_ = vn[2 * ks] * *(LAS const f32x4*)(ek_s + 32 * ks + 4 * g), b_ = vn[2 * ks + 1] * *(LAS const f32x4*)(ek_s + 32 * ks + 16 + 4 * g);
            vsf[ks] = acc_pair_frag(a_, b_); }
#pragma unroll
        for (int tt = 0; tt < 4; ++tt)
#pragma unroll
            for (int ks = 0; ks < ((SKIP & 4) ? 0 : 2); ++ks) o[tt] = MFMA16(frag_row_perm(lds + D2_OFF_P, D2_RSP, 16 * tt, 32 * ks, lane), vf[ks], o[tt]);
#pragma unroll
        for (int tt = 0; tt < 4; ++tt)
#pragma unroll
            for (int r = 0; r < 4; ++r) *(LAS float*)(lds + D2_OFF_O + (16 * tt + 4 * g + r) * D2_RSO + (16 * wave + l15) * 4) = o[tt][r];
        __builtin_amdgcn_sched_barrier(0);
        if constexpr (!(SKIP & 1)) D2_LOAD_Z(n);
        { const float edl = edl_s[0];
#pragma unroll
          for (int kt = 0; kt < ((SKIP & 8) ? 0 : 8); ++kt) { sacc[kt] *= edl;
#pragma unroll
              for (int ks = 0; ks < 2; ++ks) sacc[kt] = MFMA16(frag_tr_perm(lds + D2_OFF_K, D2_RSK, 32 * ks, 16 * kt, lane), vsf[ks], sacc[kt]);
              if ((kt & 3) == 3) __builtin_amdgcn_sched_barrier(0); }
#pragma unroll
          for (int kt = 0; kt < 8; ++kt) asm volatile("" : "+v"(sacc[kt])); }
        __syncthreads();
        if constexpr (!(SKIP & 1)) { f32x4 ov[4]; float ss = 0.f;
#pragma unroll
          for (int c = 0; c < 4; ++c) { ov[c] = *(LAS const f32x4*)(lds + D2_OFF_O + ot * D2_RSO + (oc + 4 * c) * 4); ss += (ov[c][0] * ov[c][0] + ov[c][1] * ov[c][1]) + (ov[c][2] * ov[c][2] + ov[c][3] * ov[c][3]); }
          ss += __shfl_xor(ss, 1); ss += __shfl_xor(ss, 2); ss += __shfl_xor(ss, 4);
          const float rs = frsq(ss * (1.0f / 128.0f) + EPS);
          bf16_t* yp = Y + (tok0 + n * 64 + ot) * D_MODEL + W_C + h * 128 + oc;
#pragma unroll
          for (int c = 0; c < 2; ++c) { const v4u zw = zreg[c]; const f32x4 a = ov[2 * c], b_ = ov[2 * c + 1];
#define D2_Y(ov_, gi, zx, lo) ((ov_) * rs * og[gi] * fsilu(__builtin_bit_cast(float, (lo) ? ((zx) << 16) : ((zx) & 0xffff0000u))))
              v4u yw; yw.x = pk2(D2_Y(a[0], 8 * c + 0, zw.x, 1), D2_Y(a[1], 8 * c + 1, zw.x, 0)); yw.y = pk2(D2_Y(a[2], 8 * c + 2, zw.y, 1), D2_Y(a[3], 8 * c + 3, zw.y, 0));
              yw.z = pk2(D2_Y(b_[0], 8 * c + 4, zw.z, 1), D2_Y(b_[1], 8 * c + 5, zw.z, 0)); yw.w = pk2(D2_Y(b_[2], 8 * c + 6, zw.w, 1), D2_Y(b_[3], 8 * c + 7, zw.w, 0));
#undef D2_Y
              *(v4u*)(yp + 8 * c) = yw; } }
    }
#undef D2_LOAD
#undef D2_LOAD_Z
#undef D2_STORE
    __syncthreads();
}
__device__ __forceinline__ void vb_attn(const bf16_t* __restrict__ PROJ, const float* __restrict__ qn_g, const float* __restrict__ kn_g, const float* __restrict__ rel_bias, bf16_t* __restrict__ Y,
                                        int bid, int t, LAS float* qs  , LAS float* S  , bool active) {
    if (!active) bid = 0;
    const int quarter = bid & 3, c = (bid >> 2) & 31, h = (bid >> 7) & 7, b = bid >> 10;
    { const int r = t >> 4, sub = t & 15; const int tok = b * SEQ + c * 64 + quarter * 16 + r;
      float v[8]; ld8bf(PROJ + (size_t)tok * EV_N + EC_QA + h * 128 + sub * 8, v);
      float ss = 0.f;
#pragma unroll
      for (int i = 0; i < 8; ++i) ss += v[i] * v[i];
      ss += __shfl_xor(ss, 1); ss += __shfl_xor(ss, 2); ss += __shfl_xor(ss, 4); ss += __shfl_xor(ss, 8);
      const float rs = 1.0f / sqrtf(ss * (1.0f / 128.0f) + EPS);
#pragma unroll
      for (int i = 0; i < 8; ++i) qs[r * 128 + sub * 8 + i] = v[i] * rs * qn_g[sub * 8 + i] * 0.08838834764831845f; }
    __syncthreads();
    for (int idx = t; idx < 16 * BAND; idx += 256) {
        const int r = idx / BAND, j = idx % BAND; const int kc = c - LOOKBACK + (j >> 6);
        float s;
        if (kc < 0) s = -1e30f;
        else { const bf16_t* kp = PROJ + (size_t)(b * SEQ + kc * 64 + (j & 63)) * EV_N + EC_KA + h * 128;
            float ss = 0.f, dot = 0.f;
            for (int d = 0; d < 128; d += 8) { float kv[8]; ld8bf(kp + d, kv);
#pragma unroll
                for (int i = 0; i < 8; ++i) { ss += kv[i] * kv[i]; dot += kv[i] * kn_g[d + i] * qs[r * 128 + d + i]; } }
            s = dot * (1.0f / sqrtf(ss * (1.0f / 128.0f) + EPS));
            const int qi = quarter * 16 + r; int rel = LOOKBACK * CHUNK + qi - j; rel = rel < -REL_MAX ? -REL_MAX : (rel > REL_MAX ? REL_MAX : rel); rel += REL_MAX;
            s += rel_bias[h * NREL + rel]; }
        S[r * 577 + j] = s;
    }
    __syncthreads();
    { const int r = t >> 4, sub = t & 15; float mx = -3.0e38f;
      for (int j = sub; j < BAND; j += 16) mx = fmaxf(mx, S[r * 577 + j]);
      mx = fmaxf(mx, __shfl_xor(mx, 1)); mx = fmaxf(mx, __shfl_xor(mx, 2)); mx = fmaxf(mx, __shfl_xor(mx, 4)); mx = fmaxf(mx, __shfl_xor(mx, 8));
      float sum = 0.f;
      for (int j = sub; j < BAND; j += 16) { const float e = expf(S[r * 577 + j] - mx); S[r * 577 + j] = e; sum += e; }
      sum += __shfl_xor(sum, 1); sum += __shfl_xor(sum, 2); sum += __shfl_xor(sum, 4); sum += __shfl_xor(sum, 8);
      const float inv = 1.0f / sum;
      for (int j = sub; j < BAND; j += 16) S[r * 577 + j] *= inv; }
    __syncthreads();
    { const int r = t >> 4, dg = t & 15; float acc[8];
#pragma unroll
      for (int i = 0; i < 8; ++i) acc[i] = 0.f;
      for (int j = 0; j < BAND; ++j) { const int kc = c - LOOKBACK + (j >> 6); if (kc < 0) continue;
          const float p = S[r * 577 + j]; float vv[8]; ld8bf(PROJ + (size_t)(b * SEQ + kc * 64 + (j & 63)) * EV_N + EC_VA + h * 128 + dg * 8, vv);
#pragma unroll
          for (int i = 0; i < 8; ++i) acc[i] += p * vv[i]; }
      const int tok = b * SEQ + c * 64 + quarter * 16 + r; float z[8]; ld8bf(PROJ + (size_t)tok * EV_N + EC_ZA + h * 128 + dg * 8, z);
      v4u o; o.x = pk2(acc[0] * siluf_(z[0]), acc[1] * siluf_(z[1])); o.y = pk2(acc[2] * siluf_(z[2]), acc[3] * siluf_(z[3]));
      o.z = pk2(acc[4] * siluf_(z[4]), acc[5] * siluf_(z[5])); o.w = pk2(acc[6] * siluf_(z[6]), acc[7] * siluf_(z[7]));
      if (active) *(v4u*)(Y + (size_t)tok * D_MODEL + h * 128 + dg * 8) = o; }
    __syncthreads();
}
__device__ __forceinline__ void vb_mlstm(const bf16_t* __restrict__ PROJ, const float* __restrict__ GIF, bf16_t* __restrict__ Y, int bid, int t, LAS float* sm  ) {
    LAS float* ks = sm; LAS float* qs = sm + 256; LAS float* part = sm + 512; LAS float* dpart = sm + 768;
    const int vs = bid & 3, h = (bid >> 2) & 3, b = bid >> 4, v = t & 63, kq = t >> 6;
    float C[64];
#pragma unroll
    for (int i = 0; i < 64; ++i) C[i] = 0.f;
    float nreg = 0.f;
    for (int s = 0; s < SEQ; ++s) {
        const size_t tok = (size_t)b * SEQ + s; const bf16_t* pr = PROJ + tok * EV_N;
        const float li = GIF[tok * 8 + h], fpre = GIF[tok * 8 + 4 + h];
        const float fw = sigmoidf_(fpre), iw = expf(li);
        const float kk = bf2f(pr[EC_KB + h * 256 + t]), qq = bf2f(pr[EC_QB + h * 256 + t]) * 0.0625f;
        const float vv = bf2f(pr[EC_VB + h * 256 + vs * 64 + v]);
        ks[t] = kk; qs[t] = qq;
        nreg = fw * nreg + iw * kk;
        float dp = nreg * qq; dp = wave_sum(dp);
        if ((t & 63) == 0) dpart[kq] = dp;
        __syncthreads();
        float np = 0.f; const float iv = iw * vv;
#pragma unroll
        for (int i = 0; i < 64; ++i) { C[i] = fw * C[i] + ks[kq * 64 + i] * iv; np += C[i] * qs[kq * 64 + i]; }
        part[kq * 64 + v] = np;
        __syncthreads();
        if (t < 64) { const float num = (part[t] + part[64 + t]) + (part[128 + t] + part[192 + t]); const float den = (dpart[0] + dpart[1]) + (dpart[2] + dpart[3]);
            const float hh = num / fmaxf(fabsf(den), 1.0f);
            const float ob = bf2f(pr[EC_OB + h * 256 + vs * 64 + t]), zb = bf2f(pr[EC_ZB + h * 256 + vs * 64 + t]);
            Y[tok * D_MODEL + W_A + h * 256 + vs * 64 + t] = (bf16_t)f2bf(sigmoidf_(ob) * hh * siluf_(zb)); }
        __syncthreads();
    }
}
__device__ __forceinline__ void phase_mix0(const Ptrs& P, LAS unsigned char* lds, int G) {
    const int w = blockIdx.x;
    constexpr int NML = BATCH * H_B * 4;
    if (w < NML) mlstm_item(P, lds, w);
    else if (G - NML == 128) {
        const int wa = w - NML, bhp = wa >> 2, k0 = wa & 3;
        for (int k = 3; k >= 0; --k) attn2_item(P, lds, bhp * 16 + 4 * k + k0); }
    else { for (int item = w - NML; item < BATCH * H_A * (NCH / 2); item += G - NML) attn_item(P, lds, item); }
    { const int wave = threadIdx.x >> 6, lane = threadIdx.x & 63; late_weights(P, lds, wave, lane, w * NWAVES + wave, G * NWAVES); }
}
constexpr size_t WS_RA = WS_FREE1, WS_RINP = WS_XB, WS_Q2 = 4 * MiB, WS_K2 = 36 * MiB, WS_V2 = 465 * MiB;
__device__ __forceinline__ void vb_rglru_gates(const bf16_t* __restrict__ PROJ, const float* __restrict__ ccw, const float* __restrict__ ccb, const float* __restrict__ gw, const float* __restrict__ gb,
                                               const float* __restrict__ lam, float* __restrict__ A, float* __restrict__ INP, int bid, int t, LAS float* xs  ) {
    const int blk = bid & 7, tg = bid >> 3, c = blk * 128 + t;
    float xc[8];
#pragma unroll
    for (int i = 0; i < 8; ++i) { const int tok = tg * 8 + i, s = tok % SEQ; float a = ccb[c];
#pragma unroll
        for (int j = 0; j < 4; ++j) { const int sj = s - 3 + j; if (sj >= 0) a += ccw[j * W_C + c] * bf2f(PROJ[(size_t)(tok - 3 + j) * OD_N + OC_XC + c]); }
        xc[i] = a; xs[i * 128 + t] = a; }
    __syncthreads();
    float rp[8], ip[8];
#pragma unroll
    for (int i = 0; i < 8; ++i) { rp[i] = 0.f; ip[i] = 0.f; }
    const float* g0 = gw + (size_t)blk * 128 * 256;
    for (int k = 0; k < 128; ++k) { const float wr_ = g0[k * 256 + t], wi_ = g0[k * 256 + 128 + t];
#pragma unroll
        for (int i = 0; i < 8; ++i) { const float xv = xs[i * 128 + k]; rp[i] += xv * wr_; ip[i] += xv * wi_; } }
    const float sp = softplusf_(-lam[c]); const float gbr = gb[c], gbi = gb[W_C + c];
#pragma unroll
    for (int i = 0; i < 8; ++i) { const int tok = tg * 8 + i; const float r = sigmoidf_(rp[i] + gbr), ig = sigmoidf_(ip[i] + gbi);
        const float la = -8.0f * r * sp; A[(size_t)tok * W_C + c] = expf(la); INP[(size_t)tok * W_C + c] = sqrtf(-expm1f(2.0f * la)) * (ig * xc[i]); }
    __syncthreads();
}
__device__ __forceinline__ void vb_dn_prep(const bf16_t* __restrict__ PROJ, const float* __restrict__ cdw, bf16_t* __restrict__ Q2, bf16_t* __restrict__ K2, bf16_t* __restrict__ V2, int bid, int t, LAS float* red  ) {
    const int h = bid & 7, tok = bid >> 3, s = tok % SEQ; float o[3];
#pragma unroll
    for (int p = 0; p < 3; ++p) { const int col = p * W_D + h * 128 + t; float a = 0.f;
#pragma unroll
        for (int j = 0; j < 4; ++j) { const int sj = s - 3 + j; if (sj >= 0) a += cdw[j * 3 * W_D + col] * bf2f(PROJ[(size_t)(tok - 3 + j) * OD_N + OC_QD + col]); }
        o[p] = siluf_(a); }
    float sq = wave_sum(o[0] * o[0]), sk = wave_sum(o[1] * o[1]);
    if ((t & 63) == 0) { red[(t >> 6) * 2 + 0] = sq; red[(t >> 6) * 2 + 1] = sk; }
    __syncthreads();
    sq = red[0] + red[2]; sk = red[1] + red[3];
    const size_t o_ = (size_t)tok * W_D + h * 128 + t;
    Q2[o_] = (bf16_t)f2bf(o[0] * (1.0f / sqrtf(sq + EPS))); K2[o_] = (bf16_t)f2bf(o[1] * (1.0f / sqrtf(sk + EPS))); V2[o_] = (bf16_t)f2bf(o[2]);
    __syncthreads();
}
__device__ __forceinline__ void phase_mix1a(const Ptrs& P, LAS unsigned char* lds, int G) {
    const int w = blockIdx.x; constexpr int ND1 = BATCH * H_D * NCH, NRG = BATCH * N_BLK_C * 4;
    if (G == 256) {
        if (w < 64) rglru_item<0>(P, lds, 192 + w);
        else { const int wd = w - 64; const int cnt = wd < 128 ? 11 : 10, first = wd < 128 ? wd * 11 : 1408 + (wd - 128) * 10;
            for (int i = 0; i < cnt; ++i) dn1_item(P, lds, first + i); }
    } else {
        for (int it = 192 + w; it < NRG; it += G) rglru_item<0>(P, lds, it);
        for (int it = w; it < ND1; it += G) dn1_item(P, lds, it); }
}
__device__ __forceinline__ void phase_mix1b(const Ptrs& P, LAS unsigned char* lds, int G) {
    constexpr int ND2 = BATCH * H_D;
    if ((int)blockIdx.x < ND2) dn2_item(P, lds, blockIdx.x);
    else { for (int it = blockIdx.x - ND2; it < 192; it += G - ND2) rglru_item<0>(P, lds, it);
        const int wave = threadIdx.x >> 6, lane = threadIdx.x & 63; last_weight(P, lds, wave, lane, (blockIdx.x - ND2) * NWAVES + wave, (G - ND2) * NWAVES); }
}
typedef GAS unsigned gu32;
#define RLX_AGENT __ATOMIC_RELAXED, __HIP_MEMORY_SCOPE_AGENT
constexpr int CW_BAR = 4096;
static_assert((CW_BAR + XCD_BAR_WORDS) * 4 <= (int)CTL_ZERO_BYTES, "CTL words inside the memset region");
constexpr int LDS_BYTES = 163840;
constexpr int RING_OFF = 0, RING_BYTES = LDS_BYTES - 512;
constexpr int LDSCTL_OFF = RING_BYTES, MISC_OFF = LDSCTL_OFF + 320;

struct Args { Ptrs P; int ph_lo, ph_hi; };
constexpr int N_PHASES = 8;

__global__ void __launch_bounds__(NWAVES * 64, 2) fwd_mega(Args args) {
    extern __shared__ __attribute__((aligned(16))) unsigned char lds_raw[];
    LAS unsigned char* lds = (LAS unsigned char*)lds_raw;
    volatile LAS unsigned* MISC = (volatile LAS unsigned*)(lds + MISC_OFF);
    const int tid = threadIdx.x, lane = tid & 63, wave = __builtin_amdgcn_readfirstlane(tid >> 6);
    const int G = gridDim.x;
    for (int u = tid; u < (LDS_BYTES - LDSCTL_OFF) / 4; u += NWAVES * 64) ((LAS unsigned*)(lds + LDSCTL_OFF))[u] = 0u;
    __syncthreads();
    const Ptrs& P = args.P;
    gu32* ctl = (gu32*)(P.ws + WS_CTL);
    const int lo = args.ph_lo, hi = args.ph_hi;
    XcdBarrier bar; bar.bar = (unsigned*)(ctl + CW_BAR); bar.x = 0; bar.st = nullptr;
    if (hi - lo > 1) bar = xcd_barrier_post((unsigned*)(ctl + CW_BAR), MISC + 8);
#define IN(k) (lo <= (k) && (k) < hi)
#define SEAM(k) do { if (IN(k) && IN((k) + 1)) xcd_barrier(bar); } while (0)
#ifndef DUP_PHASE
#define DUP_PHASE -1
#endif
#define RUN(k) do { \
    if ((k) == 0) phase_prologue(P, lds, wave, lane, blockIdx.x * NWAVES + wave, G * NWAVES); \
    else if ((k) == 1) phase_gemm<1>(P, lds, G, blockIdx.x); \
    else if ((k) == 2) phase_mix0(P, lds, G); \
    else if ((k) == 3) phase_gemm<2>(P, lds, G, blockIdx.x); \
    else if ((k) == 4) { phase_gemm<3>(P, lds, G, blockIdx.x); phase_gates_ab(P, G); } \
    else if ((k) == 5) phase_mix1a(P, lds, G); \
    else if ((k) == 6) phase_mix1b(P, lds, G); \
    else phase_gemm<4>(P, lds, G, blockIdx.x); } while (0)
#define STEP(k) do { if (IN(k)) { if ((k) == 5 && DUP_PHASE >= 5000 && DUP_PHASE < 5016) { for (int it_ = blockIdx.x; it_ < BATCH * H_D * NCH; it_ += G) dn1_item<(DUP_PHASE >= 5000 ? DUP_PHASE - 5000 : 0)>(P, lds, it_); xcd_barrier(bar); } RUN(k); if (DUP_PHASE == (k)) { xcd_barrier(bar); RUN(k); } \
        if ((k) == 2 && DUP_PHASE == 20) { xcd_barrier(bar); if (blockIdx.x >= 128) phase_mix0(P, lds, G); } \
        if ((k) == 2 && DUP_PHASE == 21) { xcd_barrier(bar); if (blockIdx.x < 128) phase_mix0(P, lds, G); } \
        if ((k) == 2 && DUP_PHASE >= 2000 && DUP_PHASE < 2128) { xcd_barrier(bar); if (blockIdx.x >= 128) { const int wa_ = blockIdx.x - 128; for (int k_ = 3; k_ >= 0; --k_) attn2_item<(DUP_PHASE >= 2000 ? DUP_PHASE - 2000 : 0)>(P, lds, (wa_ >> 2) * 16 + 4 * k_ + (wa_ & 3), WS_XB); } } \
        if ((k) == 2 && DUP_PHASE >= 1000 && DUP_PHASE < 1128) { xcd_barrier(bar); if (blockIdx.x < 128) mlstm_item<(DUP_PHASE >= 1000 ? DUP_PHASE - 1000 : 0)>(P, lds, blockIdx.x, WS_XB); } \
        if ((k) == 6 && DUP_PHASE >= 3000 && DUP_PHASE < 3032) { xcd_barrier(bar); if (blockIdx.x < 64) dn2_item<(DUP_PHASE >= 3000 ? DUP_PHASE - 3000 : 0)>(P, lds, blockIdx.x, 420 * MiB); } \
        if ((k) == 6 && DUP_PHASE >= 4000 && DUP_PHASE < 4032) { xcd_barrier(bar); rglru_item<(DUP_PHASE >= 4000 ? DUP_PHASE - 4000 : 0)>(P, lds, blockIdx.x, 420 * MiB); } \
        if ((k) == 5 && DUP_PHASE == 50) { xcd_barrier(bar); for (int it_ = blockIdx.x; it_ < BATCH * N_BLK_C * 4; it_ += G) rglru_item<0>(P, lds, it_); } \
        if ((k) == 5 && DUP_PHASE == 51) { xcd_barrier(bar); phase_mix1a(P, lds, G); } \
        } SEAM(k); } while (0)
    STEP(0); STEP(1); STEP(2); STEP(3); STEP(4); STEP(5); STEP(6); STEP(7);
#undef STEP
#undef RUN
#undef IN
#undef SEAM
}
extern "C" void kernel_launch(void* const* d_in, const int* in_sizes, int n_in, void* d_out, int out_size, void* d_ws, size_t ws_size, hipStream_t stream) {
    static int grid = 0;
    if (grid == 0) {
        if (n_in != 20 || in_sizes[0] != M_TOK * D_MODEL || out_size != M_TOK * D_MODEL || ws_size < WS_END) {
            fprintf(stderr, "kernel_launch: unexpected shapes: n_in %d in0 %d out %d ws %zu (need %zu)\n", n_in, n_in > 0 ? in_sizes[0] : -1, out_size, ws_size, (size_t)WS_END); grid = -1; return; }
        int dev = 0, cus = 0, per_cu = 0;
        if (hipGetDevice(&dev) != hipSuccess || hipDeviceGetAttribute(&cus, hipDeviceAttributeMultiprocessorCount, dev) != hipSuccess) { grid = -1; return; }
        if (hipFuncSetAttribute((const void*)fwd_mega, hipFuncAttributeMaxDynamicSharedMemorySize, LDS_BYTES) != hipSuccess) { fprintf(stderr, "kernel_launch: hipFuncSetAttribute failed\n"); grid = -1; return; }
        if (hipOccupancyMaxActiveBlocksPerMultiprocessor(&per_cu, (const void*)fwd_mega, NWAVES * 64, LDS_BYTES) != hipSuccess || per_cu < 1) { fprintf(stderr, "kernel_launch: occupancy query says %d blocks per CU\n", per_cu); per_cu = 1; }
        (void)hipGetLastError();
        grid = cus;
    }
    if (grid < 0) return;
    if (hipMemsetAsync((char*)d_ws + WS_CTL, 0, CTL_ZERO_BYTES, stream) != hipSuccess) { fprintf(stderr, "kernel_launch: memset failed\n"); return; }
    Args a{};
    for (int i = 0; i < 20; ++i) a.P.in[i] = (const float*)d_in[i];
    a.P.out = (float*)d_out; a.P.ws = (unsigned char*)d_ws; a.ph_lo = 0; a.ph_hi = N_PHASES;
    hipLaunchKernelGGL(fwd_mega, dim3(grid), dim3(NWAVES * 64), LDS_BYTES, stream, a);
    const hipError_t le = hipPeekAtLastError();
    if (le != hipSuccess) fprintf(stderr, "kernel_launch: launch failed: %s\n", hipGetErrorName(le));
}
```

```cpp
#include <hip/hip_runtime.h>
#include <cstdio>
#include <cstdint>
#include <cmath>
#include <type_traits>

constexpr int D_MODEL = 2048, BATCH = 8, SEQ = 2048, M_TOK = BATCH * SEQ;
constexpr int CHUNK = 64, NCH = SEQ / CHUNK;
constexpr float EPS = 1e-6f;
constexpr int HD_A = 128, W_A = 1024, H_A = 8, LOOKBACK = 8, BAND = (LOOKBACK + 1) * CHUNK, REL_MAX = 256, NREL = 2 * REL_MAX + 1;
constexpr int H_B = 4, W_B = 1024, HD_B = 256;
constexpr int W_C = 1024, N_BLK_C = 8, BLK_C = 128;
constexpr int HD_D = 128, W_D = 1024, H_D = 8;
constexpr int EV_IN = 9224, EV_N = 9216;
constexpr int OD_IN = 6160, OD_N = 6144;
constexpr int EC_QA = 0, EC_KA = 1024, EC_VA = 2048, EC_ZA = 3072, EC_QB = 4096, EC_KB = 5120, EC_VB = 6144, EC_OB = 7168, EC_ZB = 8192;
constexpr int OC_XC = 0, OC_ZC = 1024, OC_QD = 2048, OC_KD = 3072, OC_VD = 4096, OC_ZD = 5120;

constexpr size_t MiB = 1u << 20;
constexpr size_t WS_CTL = 0, CTL_ZERO_BYTES = 1 * MiB;
constexpr size_t WS_R0 = 1 * MiB;
constexpr size_t WS_SS1 = WS_R0 + 64 * 1024;
constexpr size_t WS_GIF = WS_SS1 + 64 * 1024;
constexpr size_t WS_AB = WS_GIF + 512 * 1024;
constexpr size_t WS_W1T = 4 * MiB;
constexpr size_t WS_W2T = 40 * MiB;
constexpr size_t WS_W3T = 48 * MiB;
constexpr size_t WS_W4T = 73 * MiB;
constexpr size_t WS_XB = 81 * MiB;
constexpr size_t WS_Y = 145 * MiB;
constexpr size_t WS_PROJ = 209 * MiB;
constexpr size_t WS_END = 497 * MiB;
constexpr size_t WS_FREE1 = 401 * MiB;

typedef unsigned short bf16_t;
__device__ __forceinline__ float bf2f(unsigned short v) { return __builtin_bit_cast(float, (unsigned)v << 16); }
__device__ __forceinline__ unsigned f2bf(float f) { unsigned u = __builtin_bit_cast(unsigned, f); return (u + 0x7fffu + ((u >> 16) & 1u)) >> 16; }
typedef float f32x2_t_ __attribute__((ext_vector_type(2))); typedef __bf16 bf16x2_t_ __attribute__((ext_vector_type(2)));
__device__ __forceinline__ unsigned pk2(float lo, float hi) { const f32x2_t_ v = {lo, hi}; return __builtin_bit_cast(unsigned, __builtin_convertvector(v, bf16x2_t_)); }
__device__ __forceinline__ float sigmoidf_(float x) { return 1.f / (1.f + expf(-x)); }
__device__ __forceinline__ float siluf_(float x) { return x / (1.f + expf(-x)); }
__device__ __forceinline__ float softplusf_(float x) { return fmaxf(x, 0.f) + log1pf(expf(-fabsf(x))); }
__device__ __forceinline__ float logsigmoidf_(float x) { return -softplusf_(-x); }

namespace pg8 {
#define PG8_LAS __attribute__((address_space(3)))
typedef unsigned short bf16_t;
typedef short bf16x8 __attribute__((ext_vector_type(8)));
typedef float f32x4 __attribute__((ext_vector_type(4)));
typedef unsigned u32x4 __attribute__((ext_vector_type(4)));
constexpr int BM = 256, BK = 64, HALF = 128, HTB = HALF * BK * 2  , STAGE_BYTES = 8 * HTB, NXCD = 8, WGM = 4;

__host__ __device__ __forceinline__ int lds_byte(int r, int c) { const int st = (r >> 4) * 2 + (c >> 5), rr = r & 15, cc = c & 31, ob = rr * 64 + cc * 2; return st * 1024 + (ob ^ (((ob >> 9) & 1) << 5)); }
__host__ __device__ __forceinline__ void stage_rc(int b, int& R, int& C) { const int st = b / 1024, sb = b % 1024, swz = sb ^ (((sb >> 9) & 1) << 5); R = (st >> 1) * 16 + swz / 64; C = (st & 1) * 32 + (swz % 64) / 2; }
__host__ __device__ __forceinline__ int perm32(int rho) { const int n = rho >> 4, i = rho & 15; return 8 * (i >> 2) + 4 * n + (i & 3); }

struct Unit { int pm, pn; };
struct Gemm { const bf16_t* A; const bf16_t* Bt; int M, N, K; };

struct StaticOrder {
    int nM, nN, nwg, G, c;
    __host__ __device__ void init(int M, int N, int G_, int c_) { nM = M / BM; nN = N / BM; nwg = nM * nN; G = G_; c = c_; }
    __host__ __device__ bool next(int i, Unit& u) const {
        const long L = (long)i * G + c; if (L >= nwg) return false;
        int wgid = (int)L; { const int q = nwg / NXCD, r = nwg % NXCD, xcd = wgid % NXCD, off = wgid / NXCD; wgid = (xcd < r ? xcd * (q + 1) : r * (q + 1) + (xcd - r) * q) + off; }
        const int nig = WGM * nN, gid = wgid / nig, fm = gid * WGM, gsz = (nM - fm) < WGM ? (nM - fm) : WGM;
        u.pm = fm + ((wgid % nig) % gsz); u.pn = (wgid % nig) / gsz; return true;
    }
    __device__ __forceinline__ void a_ready(const Unit&) const {}
    __device__ __forceinline__ void done(const Unit&) const {}
};

__device__ __forceinline__ unsigned cvt_pk_bf16(float lo, float hi) { unsigned r; asm volatile("v_cvt_pk_bf16_f32 %0, %1, %2" : "=v"(r) : "v"(lo), "v"(hi)); return r; }
struct EpiProj {
    static constexpr bool PERM = true, AFTER_DRAIN = false;
    bf16_t* O; int ldc; const float* rowv; int mode;
    __device__ __forceinline__ void operator()(const f32x4 (&acc)[2][2][4][2], const Unit& u, int wr, int wc, int fr, int fq) const {
        const int row0 = u.pm * BM + wr * 64 + fr; const int col0 = u.pn * BM + wc * 32 + 8 * fq;
#pragma unroll
        for (int ai = 0; ai < 2; ++ai)
#pragma unroll
            for (int m = 0; m < 4; ++m) { const int row = row0 + ai * HALF + m * 16; float sc = rowv[row]; if (mode) sc = 1.0f / sqrtf(sc * (1.0f / 2048.0f) + 1e-6f);
                bf16_t* rowp = O + (size_t)row * ldc + col0;
#pragma unroll
                for (int bj = 0; bj < 2; ++bj) { const f32x4 v0 = acc[ai][bj][m][0] * sc, v1 = acc[ai][bj][m][1] * sc;
                    u32x4 w; w.x = cvt_pk_bf16(v0[0], v0[1]); w.y = cvt_pk_bf16(v0[2], v0[3]); w.z = cvt_pk_bf16(v1[0], v1[1]); w.w = cvt_pk_bf16(v1[2], v1[3]);
                    *(u32x4*)(rowp + bj * HALF) = w; } }
    }
};
struct EpiRes {
    static constexpr bool PERM = false, AFTER_DRAIN = false;
    const float* base; float* out; bf16_t* xb; float* sumsq; int ldc;
    __device__ __forceinline__ void operator()(const f32x4 (&acc)[2][2][4][2], const Unit& u, int wr, int wc, int fr, int fq) const {
        typedef unsigned u32x2v __attribute__((ext_vector_type(2)));
        const int col0 = u.pn * BM + wc * 32 + 4 * fq;
#pragma unroll
        for (int ai = 0; ai < 2; ++ai)
#pragma unroll
            for (int m = 0; m < 4; ++m) { const int row = u.pm * BM + ai * HALF + wr * 64 + m * 16 + fr; const size_t off = (size_t)row * ldc + col0; float ss = 0.f;
#pragma unroll
                for (int bj = 0; bj < 2; ++bj)
#pragma unroll
                    for (int n = 0; n < 2; ++n) { const f32x4 o = *(const f32x4*)(base + off + bj * HALF + n * 16) + acc[ai][bj][m][n];
                        *(f32x4*)(out + off + bj * HALF + n * 16) = o;
                        if (xb) { u32x2v w; w.x = cvt_pk_bf16(o[0], o[1]); w.y = cvt_pk_bf16(o[2], o[3]); *(u32x2v*)(xb + off + bj * HALF + n * 16) = w; }
                        ss += (o[0] * o[0] + o[1] * o[1]) + (o[2] * o[2] + o[3] * o[3]); }
                if (sumsq) { ss += __shfl_xor(ss, 16); ss += __shfl_xor(ss, 32); if (fq == 0) atomicAdd(sumsq + row, ss); } }
    }
};

template <class Epi, class Sched, bool ALIGN_EPI = false, bool SP2 = false>
__device__ __forceinline__ void gemm_phase(PG8_LAS unsigned char* lds, const Gemm g, const Sched& S, const Epi& E) {
    const int tid = threadIdx.x, wid = __builtin_amdgcn_readfirstlane(tid >> 6), lane = tid & 63, wr = wid >> 2, wc = wid & 3, fr = lane & 15, fq = lane >> 4;
    const int K = g.K, nt = K / BK;
    unsigned voffA[2], voffB[2];
#pragma unroll
    for (int i = 0; i < 2; ++i) { int R, C; stage_rc(tid * 16 + i * 8192, R, C); const int Rb = Epi::PERM ? ((R & ~31) + perm32(R & 31)) : R;
        voffA[i] = (unsigned)(R * K + C) * 2u; voffB[i] = (unsigned)(Rb * K + C) * 2u; }
    const size_t kstep = (size_t)(BK * 2);
    const size_t hstep = (size_t)HALF * K * 2;
    const size_t tstep = 2 * hstep;
    const unsigned ldsw = (unsigned)wid * 1024u;
    const int aoff = lds_byte(wr * 64 + fr, fq * 8), boff = lds_byte(wc * 32 + fr, fq * 8);
#define PG8_SA(b, h) (((b) * 2 + (h)) * HTB)
#define PG8_SB(b, h) ((4 + (b) * 2 + (h)) * HTB)
#define PG8_STAGE(bufoff, gbase, voff) do { _Pragma("unroll") for (int _i = 0; _i < 2; ++_i) \
        __builtin_amdgcn_global_load_lds((const unsigned*)((const char*)(gbase) + (voff)[_i]), (PG8_LAS unsigned*)(lds + (bufoff) + ldsw + _i * 8192), 16, 0, 0); } while (0)
#define PG8_LDA(dst, b, h) do { _Pragma("unroll") for (int m = 0; m < 4; ++m) _Pragma("unroll") for (int k = 0; k < 2; ++k) dst[m][k] = *(const PG8_LAS bf16x8*)(lds + PG8_SA(b, h) + aoff + m * 2048 + k * 1024); } while (0)
#define PG8_LDB(dst, b, h) do { _Pragma("unroll") for (int n = 0; n < 2; ++n) _Pragma("unroll") for (int k = 0; k < 2; ++k) dst[n][k] = *(const PG8_LAS bf16x8*)(lds + PG8_SB(b, h) + boff + n * 2048 + k * 1024); } while (0)
#define PG8_MMA(ai, bj, At, Bt) do { __builtin_amdgcn_s_setprio(1); _Pragma("unroll") for (int m = 0; m < 4; ++m) _Pragma("unroll") for (int n = 0; n < 2; ++n) _Pragma("unroll") for (int k = 0; k < 2; ++k) \
        acc[ai][bj][m][n] = __builtin_amdgcn_mfma_f32_16x16x32_bf16(Bt[n][k], At[m][k], acc[ai][bj][m][n], 0, 0, 0); __builtin_amdgcn_s_setprio(0); } while (0)
#define PG8_WAIT_V(n) asm volatile("s_waitcnt vmcnt(" #n ")" ::: "memory")
#define PG8_WAIT_L(n) asm volatile("s_waitcnt lgkmcnt(" #n ")" ::: "memory")
#define PG8_BAR __builtin_amdgcn_s_barrier()
#define PG8_SCHED __builtin_amdgcn_sched_barrier(0)
    Unit cur, nxt; int ui = 0;
    if (!S.next(0, cur)) return;
    f32x4 acc[2][2][4][2];
#pragma unroll
    for (int a = 0; a < 2; ++a)
#pragma unroll
        for (int b = 0; b < 2; ++b)
#pragma unroll
            for (int m = 0; m < 4; ++m)
#pragma unroll
                for (int n = 0; n < 2; ++n) acc[a][b][m][n] = (f32x4){0.f, 0.f, 0.f, 0.f};
    bf16x8 At[4][2], B0[2][2], B1[2][2];
    const char* cA = (const char*)g.A + (size_t)cur.pm * tstep; const char* cB = (const char*)g.Bt + (size_t)cur.pn * tstep;
    S.a_ready(cur);
    if constexpr (SP2) {
        PG8_STAGE(PG8_SB(0, 0), cB, voffB); PG8_STAGE(PG8_SB(0, 1), cB + hstep, voffB); PG8_STAGE(PG8_SA(0, 0), cA, voffA); PG8_STAGE(PG8_SA(0, 1), cA + hstep, voffA);
        if (wr == 1) PG8_BAR;
        PG8_WAIT_V(2); PG8_BAR;
        PG8_STAGE(PG8_SB(1, 0), cB + kstep, voffB); PG8_STAGE(PG8_SA(1, 0), cA + kstep, voffA); PG8_STAGE(PG8_SB(1, 1), cB + hstep + kstep, voffB);
        PG8_WAIT_V(6); PG8_BAR;
    } else {
        PG8_STAGE(PG8_SB(0, 0), cB, voffB); PG8_STAGE(PG8_SA(0, 0), cA, voffA); PG8_STAGE(PG8_SB(0, 1), cB + hstep, voffB); PG8_STAGE(PG8_SA(0, 1), cA + hstep, voffA);
        if (wr == 1) PG8_BAR;
        PG8_WAIT_V(4); PG8_BAR;
        PG8_STAGE(PG8_SB(1, 0), cB + kstep, voffB); PG8_STAGE(PG8_SA(1, 0), cA + kstep, voffA); PG8_STAGE(PG8_SB(1, 1), cB + hstep + kstep, voffB);
        PG8_WAIT_V(6); PG8_BAR;
    }
    for (;;) {
        const bool has_next = S.next(ui + 1, nxt);
        const char* nA = has_next ? (const char*)g.A + (size_t)nxt.pm * tstep : cA; const char* nB = has_next ? (const char*)g.Bt + (size_t)nxt.pn * tstep : cB;
        for (int t = 0; t < nt; t += 2) {
            const bool last = (t == nt - 2);
            const char* a1 = cA + (size_t)(t + 1) * kstep;
            const char* a2 = last ? nA : cA + (size_t)(t + 2) * kstep; const char* b2 = last ? nB : cB + (size_t)(t + 2) * kstep;
            const char* a3 = a2 + kstep; const char* b3 = b2 + kstep;
            if (last && has_next) S.a_ready(nxt);
            if constexpr (SP2) {
            PG8_LDB(B0, 0, 0); PG8_LDB(B1, 0, 1); PG8_SCHED; PG8_LDA(At, 0, 0); PG8_STAGE(PG8_SA(1, 1), a1 + hstep, voffA);
            PG8_WAIT_V(8); PG8_WAIT_L(0); PG8_BAR; PG8_MMA(0, 0, At, B0); PG8_MMA(0, 1, At, B1); PG8_BAR; PG8_SCHED;
            PG8_LDA(At, 0, 1); PG8_STAGE(PG8_SB(0, 0), b2, voffB); PG8_STAGE(PG8_SB(0, 1), b2 + hstep, voffB); PG8_STAGE(PG8_SA(0, 0), a2, voffA);
            PG8_WAIT_V(8); PG8_WAIT_L(0); PG8_BAR; PG8_MMA(1, 0, At, B0); PG8_MMA(1, 1, At, B1); PG8_BAR; PG8_SCHED;
            PG8_LDB(B0, 1, 0); PG8_LDB(B1, 1, 1); PG8_SCHED; PG8_LDA(At, 1, 0); PG8_STAGE(PG8_SA(0, 1), a2 + hstep, voffA);
            PG8_WAIT_V(8); PG8_WAIT_L(0); PG8_BAR; PG8_MMA(0, 0, At, B0); PG8_MMA(0, 1, At, B1); PG8_BAR; PG8_SCHED;
            PG8_LDA(At, 1, 1); PG8_STAGE(PG8_SB(1, 0), b3, voffB); PG8_STAGE(PG8_SB(1, 1), b3 + hstep, voffB); PG8_STAGE(PG8_SA(1, 0), a3, voffA);
            PG8_WAIT_V(8); PG8_WAIT_L(0); PG8_BAR; PG8_MMA(1, 0, At, B0); PG8_MMA(1, 1, At, B1); PG8_BAR; PG8_SCHED;
            } else {
            PG8_LDB(B0, 0, 0); PG8_SCHED; PG8_LDA(At, 0, 0); PG8_STAGE(PG8_SA(1, 1), a1 + hstep, voffA);
            PG8_WAIT_L(8); PG8_BAR; PG8_WAIT_L(0); PG8_MMA(0, 0, At, B0); PG8_BAR; PG8_SCHED;
            PG8_LDB(B1, 0, 1); PG8_STAGE(PG8_SB(0, 0), b2, voffB);
            PG8_BAR; PG8_WAIT_L(0); PG8_MMA(0, 1, At, B1); PG8_BAR;
            PG8_LDA(At, 0, 1); PG8_STAGE(PG8_SA(0, 0), a2, voffA);
            PG8_BAR; PG8_WAIT_L(0); PG8_MMA(1, 0, At, B0); PG8_BAR; PG8_SCHED;
            PG8_STAGE(PG8_SB(0, 1), b2 + hstep, voffB);
            PG8_WAIT_V(6); PG8_BAR; PG8_MMA(1, 1, At, B1); PG8_BAR;
            PG8_LDB(B0, 1, 0); PG8_SCHED; PG8_LDA(At, 1, 0); PG8_STAGE(PG8_SA(0, 1), a2 + hstep, voffA);
            PG8_WAIT_L(8); PG8_BAR; PG8_WAIT_L(0); PG8_MMA(0, 0, At, B0); PG8_BAR; PG8_SCHED;
            PG8_LDB(B1, 1, 1); PG8_STAGE(PG8_SB(1, 0), b3, voffB);
            PG8_BAR; PG8_WAIT_L(0); PG8_MMA(0, 1, At, B1); PG8_BAR;
            PG8_LDA(At, 1, 1); PG8_STAGE(PG8_SA(1, 0), a3, voffA);
            PG8_BAR; PG8_WAIT_L(0); PG8_MMA(1, 0, At, B0); PG8_BAR; PG8_SCHED;
            PG8_STAGE(PG8_SB(1, 1), b3 + hstep, voffB);
            PG8_WAIT_V(6); PG8_BAR; PG8_MMA(1, 1, At, B1); PG8_BAR;
            }
        }
        if constexpr (ALIGN_EPI) { if (wr == 0) PG8_BAR; }
        if constexpr (!Epi::AFTER_DRAIN) { E(acc, cur, wr, wc, fr, fq); S.done(cur); }
        if (!has_next) break;
#pragma unroll
        for (int a = 0; a < 2; ++a)
#pragma unroll
            for (int b = 0; b < 2; ++b)
#pragma unroll
                for (int m = 0; m < 4; ++m)
#pragma unroll
                    for (int n = 0; n < 2; ++n) acc[a][b][m][n] = (f32x4){0.f, 0.f, 0.f, 0.f};
        cur = nxt; cA = nA; cB = nB; ++ui;
        if constexpr (ALIGN_EPI) { if (wr == 1) PG8_BAR; }
    }
    PG8_WAIT_V(0);
    if constexpr (!ALIGN_EPI) { if (wr == 0) PG8_BAR; }
    PG8_BAR;
    if constexpr (Epi::AFTER_DRAIN) { E.fused(acc, cur, wr, wc, fr, fq, lds, wid, lane); S.done(cur); }
#undef PG8_SA
#undef PG8_SB
#undef PG8_STAGE
#undef PG8_LDA
#undef PG8_LDB
#undef PG8_MMA
#undef PG8_WAIT_V
#undef PG8_WAIT_L
#undef PG8_BAR
#undef PG8_SCHED
}
}
#define GAS __attribute__((address_space(1)))
#define LAS __attribute__((address_space(3)))
typedef unsigned v4u __attribute__((ext_vector_type(4)));
typedef float f32x4 __attribute__((ext_vector_type(4)));
#define LDS_WAIT() asm volatile("s_waitcnt lgkmcnt(0)" ::: "memory")
constexpr int NWAVES = 8;
constexpr int GEMM_LDS = 131072;

struct Ptrs {
    const float* in[20]; float* out; unsigned char* ws;
};
#define IN_X 0
#define IN_EV_NORM 1
#define IN_EV_WIN 2
#define IN_EV_IFB 3
#define IN_EV_QNG 4
#define IN_EV_KNG 5
#define IN_EV_REL 6
#define IN_EV_WOUT 7
#define IN_OD_NORM 8
#define IN_OD_WIN 9
#define IN_OD_CCW 10
#define IN_OD_CCB 11
#define IN_OD_GW 12
#define IN_OD_GB 13
#define IN_OD_LAM 14
#define IN_OD_CDW 15
#define IN_OD_ALOG 16
#define IN_OD_DTB 17
#define IN_OD_ONORM 18
#define IN_OD_WOUT 19

__device__ __forceinline__ float frsq_(float x) { return __builtin_amdgcn_rsqf(x); }
__device__ __forceinline__ float wave_sum(float v) {
#pragma unroll
    for (int o = 1; o < 64; o <<= 1) v += __shfl_xor(v, o);
    return v;
}
struct TrItem { const float* W; const float* gain; bf16_t* WT; int ldw, nblk, item; };
__device__ __forceinline__ void p0_tr_load(const TrItem& t, float (&r)[32], int lane) {
    const int kb = t.item / t.nblk, nb = t.item % t.nblk, k0 = 64 * kb, n0 = 32 * nb;
#pragma unroll
    for (int i = 0; i < 32; ++i) { const int kk = 2 * i + (lane >> 5); r[i] = t.W[(size_t)(k0 + kk) * t.ldw + n0 + (lane & 31)]; }
}
__device__ __forceinline__ void p0_tr_store(const TrItem& t, const float (&r)[32], LAS float* scr, int lane) {
    const int kb = t.item / t.nblk, nb = t.item % t.nblk, k0 = 64 * kb, n0 = 32 * nb; constexpr int K = D_MODEL;
#pragma unroll
    for (int i = 0; i < 32; ++i) { const int kk = 2 * i + (lane >> 5); const float g = t.gain ? t.gain[k0 + kk] : 1.0f; scr[kk * 33 + (lane & 31)] = g * r[i]; }
    LDS_WAIT(); asm volatile("" ::: "memory");
    const int c = lane & 7;
#pragma unroll
    for (int j = 0; j < 4; ++j) { const int n = (lane >> 3) + 8 * j; const LAS float* s = scr + (8 * c) * 33 + n;
        v4u o; o.x = pk2(s[0 * 33], s[1 * 33]); o.y = pk2(s[2 * 33], s[3 * 33]); o.z = pk2(s[4 * 33], s[5 * 33]); o.w = pk2(s[6 * 33], s[7 * 33]);
        *(GAS v4u*)(t.WT + (size_t)(n0 + n) * K + k0 + 8 * c) = o; }
    LDS_WAIT(); asm volatile("" ::: "memory");
}
__device__ __forceinline__ void p0_transposes(const Ptrs& P, LAS float* scr, int lane, int gw, int NGW, int it0, int it1) {
    unsigned char* ws = P.ws;
    bf16_t* W1T = (bf16_t*)(ws + WS_W1T); bf16_t* W2T = (bf16_t*)(ws + WS_W2T); bf16_t* W3T = (bf16_t*)(ws + WS_W3T); bf16_t* W4T = (bf16_t*)(ws + WS_W4T);
    constexpr int I1 = (D_MODEL / 64) * (EV_N / 32), I2 = (D_MODEL / 64) * (D_MODEL / 32), I3 = (D_MODEL / 64) * (OD_N / 32);
    auto mk = [&](int it) { TrItem t; int r = it;
        if (r < I1) { t = TrItem{P.in[IN_EV_WIN], P.in[IN_EV_NORM], W1T, EV_IN, EV_N / 32, r}; return t; } r -= I1;
        if (r < I2) { t = TrItem{P.in[IN_EV_WOUT], nullptr, W2T, D_MODEL, D_MODEL / 32, r}; return t; } r -= I2;
        if (r < I3) { t = TrItem{P.in[IN_OD_WIN], P.in[IN_OD_NORM], W3T, OD_IN, OD_N / 32, r}; return t; } r -= I3;
        t = TrItem{P.in[IN_OD_WOUT], nullptr, W4T, D_MODEL, D_MODEL / 32, r}; return t; };
    float ra[32], rb[32]; int it = it0 + gw;
    if (it < it1) { TrItem ta = mk(it); p0_tr_load(ta, ra, lane);
        for (;;) { const int itb = it + NGW; TrItem tb = ta; const bool hb = itb < it1; if (hb) { tb = mk(itb); p0_tr_load(tb, rb, lane); }
            p0_tr_store(ta, ra, scr, lane); if (!hb) break;
            const int itc = itb + NGW; const bool hc = itc < it1; if (hc) { ta = mk(itc); p0_tr_load(ta, ra, lane); }
            p0_tr_store(tb, rb, scr, lane); if (!hc) break; it = itc; } }
}
constexpr int TR_I1 = (D_MODEL / 64) * (EV_N / 32), TR_ALL = TR_I1 + 2 * (D_MODEL / 64) * (D_MODEL / 32) + (D_MODEL / 64) * (OD_N / 32), TR_I4 = TR_ALL - (D_MODEL / 64) * (D_MODEL / 32);
__device__ __forceinline__ void late_weights(const Ptrs& P, LAS unsigned char* lds, int wave, int lane, int gw, int NGW) {
    p0_transposes(P, (LAS float*)(lds + wave * 16384), lane, gw, NGW, TR_I1, TR_I4);
    bf16_t* W3T = (bf16_t*)(P.ws + WS_W3T); const int gt = gw * 64 + lane, NT = NGW * 64;
    for (int e = gt; e < 16 * D_MODEL; e += NT) { const int j = e / D_MODEL, k = e % D_MODEL; W3T[(size_t)(OD_N + j) * D_MODEL + k] = (bf16_t)f2bf(P.in[IN_OD_NORM][k] * P.in[IN_OD_WIN][(size_t)k * OD_IN + OD_N + j]); }
}
__device__ __forceinline__ void last_weight(const Ptrs& P, LAS unsigned char* lds, int wave, int lane, int gw, int NGW) { p0_transposes(P, (LAS float*)(lds + wave * 16384), lane, gw, NGW, TR_I4, TR_ALL); }
__device__ __forceinline__ void phase_prologue(const Ptrs& P, LAS unsigned char* lds, int wave, int lane, int gw, int NGW) {
    unsigned char* ws = P.ws;
    bf16_t* W1T = (bf16_t*)(ws + WS_W1T); bf16_t* W2T = (bf16_t*)(ws + WS_W2T); bf16_t* W3T = (bf16_t*)(ws + WS_W3T); bf16_t* W4T = (bf16_t*)(ws + WS_W4T);
    bf16_t* XB = (bf16_t*)(ws + WS_XB); float* R0 = (float*)(ws + WS_R0); float* SS1 = (float*)(ws + WS_SS1); float* GIF = (float*)(ws + WS_GIF);
    LAS float* scr = (LAS float*)(lds + wave * 16384);
    p0_transposes(P, scr, lane, gw, NGW, 0, TR_I1);
    { const int gt = gw * 64 + lane, NT = NGW * 64;
      for (int e = gt; e < M_TOK; e += NT) SS1[e] = 0.f; }
    __syncthreads();
    LAS float* G8 = (LAS float*)lds;
#pragma unroll 8
    for (int e = threadIdx.x; e < D_MODEL * 8; e += NWAVES * 64) { const int k = e >> 3, j = e & 7; G8[e] = P.in[IN_EV_NORM][k] * P.in[IN_EV_WIN][(size_t)k * EV_IN + EV_N + j]; }
    __syncthreads();
    const float* X = P.in[IN_X];
    f32x4 vnx[8];
    if (gw < M_TOK) { const GAS f32x4* xr0 = (const GAS f32x4*)(X + (size_t)gw * D_MODEL) + lane;
#pragma unroll
        for (int j = 0; j < 8; ++j) vnx[j] = xr0[64 * j]; }
    for (int m = gw; m < M_TOK; m += NGW) {
        float s = 0.f;
        GAS unsigned long long* o8 = (GAS unsigned long long*)(XB + (size_t)m * D_MODEL) + lane;
        f32x4 v[8];
#pragma unroll
        for (int j = 0; j < 8; ++j) v[j] = vnx[j];
        if (m + NGW < M_TOK) { const GAS f32x4* xr1 = (const GAS f32x4*)(X + (size_t)(m + NGW) * D_MODEL) + lane;
#pragma unroll
            for (int j = 0; j < 8; ++j) vnx[j] = xr1[64 * j]; }
#pragma unroll
        for (int j = 0; j < 8; ++j) { s += (v[j].x * v[j].x + v[j].y * v[j].y) + (v[j].z * v[j].z + v[j].w * v[j].w);
            o8[64 * j] = (unsigned long long)pk2(v[j].x, v[j].y) | ((unsigned long long)pk2(v[j].z, v[j].w) << 32); }
        const float r0 = frsq_(wave_sum(s) * (1.0f / D_MODEL) + EPS);
        float g[8];
#pragma unroll
        for (int i = 0; i < 8; ++i) g[i] = 0.f;
#pragma unroll
        for (int j = 0; j < 8; ++j) {
#pragma unroll
            for (int e = 0; e < 4; ++e) { const int k = 4 * lane + 256 * j + e; const f32x4 ga = *(const LAS f32x4*)(G8 + k * 8), gb = *(const LAS f32x4*)(G8 + k * 8 + 4); const float xv = v[j][e];
                g[0] += xv * ga.x; g[1] += xv * ga.y; g[2] += xv * ga.z; g[3] += xv * ga.w; g[4] += xv * gb.x; g[5] += xv * gb.y; g[6] += xv * gb.z; g[7] += xv * gb.w; }
            asm volatile("" : "+v"(g[0]), "+v"(g[1]), "+v"(g[2]), "+v"(g[3]), "+v"(g[4]), "+v"(g[5]), "+v"(g[6]), "+v"(g[7]) :: "memory");
        }
#pragma unroll
        for (int i = 0; i < 8; ++i) g[i] = wave_sum(g[i]);
        if (lane == 0) R0[m] = r0;
        if (lane < 8) { float gv = g[0];
#pragma unroll
            for (int i = 1; i < 8; ++i) gv = (lane == i) ? g[i] : gv;
            GIF[(size_t)m * 8 + lane] = r0 * gv + P.in[IN_EV_IFB][lane]; }
    }
}

#define XB_TMO      128
#define XB_XCNT(j)  (256  + 64 * (j))
#define XB_XSUB(j)  (1280 + 64 * (j))
#define XB_XGEN(j)  (2304 + 64 * (j))
#define XB_TOP      3328
#define XB_TOPGEN   3392
#define XCD_BAR_WORDS 3456
#define XB_SPIN_CAP (1u << 18)

__device__ __forceinline__ unsigned xb_ld(unsigned* p)              { return __hip_atomic_load(p, __ATOMIC_RELAXED, __HIP_MEMORY_SCOPE_AGENT); }
__device__ __forceinline__ unsigned xb_add(unsigned* p, unsigned v) { return __hip_atomic_fetch_add(p, v, __ATOMIC_RELAXED, __HIP_MEMORY_SCOPE_AGENT); }
__device__ __forceinline__ unsigned xb_xcc_id() { return (unsigned)__builtin_amdgcn_s_getreg((3 << 11) | 20) & 0xFu; }
#define XB_SPIN(cond, bar) do { unsigned _sp = 0; while (cond) { __builtin_amdgcn_s_sleep(1); \
    if ((++_sp & 255u) == 0u) { if (xb_ld(&(bar)[XB_TMO])) break; if (_sp > XB_SPIN_CAP) { atomicAdd(&(bar)[XB_TMO], 1u); break; } } } } while (0)

struct XcdBarrier {
    unsigned* bar; unsigned x;
    volatile LAS unsigned* st;
};

__device__ __forceinline__ XcdBarrier xcd_barrier_post(unsigned* bar, volatile LAS unsigned* st) {
    XcdBarrier b; b.bar = bar; b.x = xb_xcc_id(); b.st = st;
    if (threadIdx.x == 0) (void)xb_add(&bar[XB_XCNT(b.x)], 1u);
    return b;
}
__device__ __forceinline__ void xcd_barrier_complete(unsigned* bar, unsigned x, unsigned& nloc, unsigned& nx) {
    const unsigned G = gridDim.x * gridDim.y * gridDim.z;
    unsigned sum, cnt, mine, sp = 0u;
    for (;;) {
        sum = 0u; cnt = 0u; mine = 0u;
#pragma unroll
        for (unsigned j = 0; j < 16; ++j) { const unsigned c = xb_ld(&bar[XB_XCNT(j)]); sum += c; cnt += (c > 0u) ? 1u : 0u; mine = (j == x) ? c : mine; }
        if (sum == G) break;
        __builtin_amdgcn_s_sleep(1);
        if ((++sp & 255u) == 0u) { if (xb_ld(&bar[XB_TMO])) break; if (sp > XB_SPIN_CAP) { atomicAdd(&bar[XB_TMO], 1u); break; } }
    }
    nloc = mine > 0u ? mine : 1u; nx = cnt > 0u ? cnt : 1u;
}

__device__ __forceinline__ void xcd_barrier(const XcdBarrier& b) {
    asm volatile("s_waitcnt vmcnt(0)" ::: "memory");
    __syncthreads();
    if (threadIdx.x == 0) {
        unsigned* bar = b.bar;
        __builtin_amdgcn_s_waitcnt(0);
        unsigned nloc = b.st[0], nx = b.st[1];
        if (nloc == 0u) { xcd_barrier_complete(bar, b.x, nloc, nx); b.st[0] = nloc; b.st[1] = nx; }
        const unsigned old = xb_add(&bar[XB_XSUB(b.x)], 1u);
        const unsigned gen = old / nloc;
        if (old + 1u == (gen + 1u) * nloc) {
            __builtin_amdgcn_fence(__ATOMIC_RELEASE, "agent");
            asm volatile("s_waitcnt vmcnt(0)" ::: "memory");
            const unsigned og = xb_add(&bar[XB_TOP], 1u);
            const unsigned tg = og / nx;
            if (og + 1u == (tg + 1u) * nx) xb_add(&bar[XB_TOPGEN], 1u);
            else XB_SPIN(xb_ld(&bar[XB_TOPGEN]) == tg, bar);
            __builtin_amdgcn_fence(__ATOMIC_ACQUIRE, "agent");
            xb_add(&bar[XB_XGEN(b.x)], 1u);
            asm volatile("s_waitcnt vmcnt(0)" ::: "memory");
        } else {
            XB_SPIN(xb_ld(&bar[XB_XGEN(b.x)]) == gen, bar);
            __builtin_amdgcn_fence(__ATOMIC_ACQUIRE, "agent");
            asm volatile("s_waitcnt vmcnt(0)" ::: "memory");
        }
    }
    __syncthreads();
}
__device__ __forceinline__ void ld8bf(const bf16_t* p, float (&v)[8]) {
    const v4u w = *(const v4u*)p;
    v[0] = __builtin_bit_cast(float, w.x << 16); v[1] = __builtin_bit_cast(float, w.x & 0xffff0000u);
    v[2] = __builtin_bit_cast(float, w.y << 16); v[3] = __builtin_bit_cast(float, w.y & 0xffff0000u);
    v[4] = __builtin_bit_cast(float, w.z << 16); v[5] = __builtin_bit_cast(float, w.z & 0xffff0000u);
    v[6] = __builtin_bit_cast(float, w.w << 16); v[7] = __builtin_bit_cast(float, w.w & 0xffff0000u);
}
template <int WHICH> __device__ __forceinline__ void phase_gemm(const Ptrs& P, LAS unsigned char* lds, int G, int c) {
    unsigned char* ws = P.ws;
    bf16_t* W1T = (bf16_t*)(ws + WS_W1T); bf16_t* W2T = (bf16_t*)(ws + WS_W2T); bf16_t* W3T = (bf16_t*)(ws + WS_W3T); bf16_t* W4T = (bf16_t*)(ws + WS_W4T);
    bf16_t* XB = (bf16_t*)(ws + WS_XB); bf16_t* YB = (bf16_t*)(ws + WS_Y); bf16_t* PROJ = (bf16_t*)(ws + WS_PROJ);
    float* R0 = (float*)(ws + WS_R0); float* SS1 = (float*)(ws + WS_SS1);
    if constexpr (WHICH == 1) { pg8::Gemm g{XB, W1T, M_TOK, EV_N, D_MODEL}; pg8::EpiProj E{PROJ, EV_N, R0, 0}; pg8::StaticOrder S; S.init(g.M, g.N, G, c);
        pg8::gemm_phase<pg8::EpiProj, pg8::StaticOrder, true, true>(lds, g, S, E); }
    if constexpr (WHICH == 2) { pg8::Gemm g{YB, W2T, M_TOK, D_MODEL, D_MODEL}; pg8::EpiRes E{P.in[IN_X], P.out, XB, SS1, D_MODEL}; pg8::StaticOrder S; S.init(g.M, g.N, G, c);
        pg8::gemm_phase<pg8::EpiRes, pg8::StaticOrder, true, true>(lds, g, S, E); }
    if constexpr (WHICH == 3) { pg8::Gemm g{XB, W3T, M_TOK, OD_N, D_MODEL}; pg8::EpiProj E{PROJ, OD_N, SS1, 1}; pg8::StaticOrder S; S.init(g.M, g.N, G, c);
        pg8::gemm_phase<pg8::EpiProj, pg8::StaticOrder, true, true>(lds, g, S, E); }
    if constexpr (WHICH == 4) { pg8::Gemm g{YB, W4T, M_TOK, D_MODEL, D_MODEL}; pg8::EpiRes E{P.out, P.out, nullptr, nullptr, D_MODEL}; pg8::StaticOrder S; S.init(g.M, g.N, G, c);
        pg8::gemm_phase<pg8::EpiRes, pg8::StaticOrder, true, true>(lds, g, S, E); }
}
__device__ __forceinline__ void phase_gates_ab(const Ptrs& P, int G) {
    unsigned char* ws = P.ws; const bf16_t* XB = (const bf16_t*)(ws + WS_XB); const bf16_t* W3T = (const bf16_t*)(ws + WS_W3T); const float* SS1 = (const float*)(ws + WS_SS1); float* AB = (float*)(ws + WS_AB);
    const int t = threadIdx.x, j = t & 15;
    for (int it = blockIdx.x; it < M_TOK / 32; it += G) { const int row = it * 32 + (t >> 4);
        const bf16_t* xp = XB + (size_t)row * D_MODEL; const bf16_t* wp = W3T + (size_t)(OD_N + j) * D_MODEL; float acc = 0.f;
#pragma unroll 8
        for (int k = 0; k < D_MODEL; k += 8) { float a[8], w[8]; ld8bf(xp + k, a); ld8bf(wp + k, w);
#pragma unroll
            for (int i = 0; i < 8; ++i) acc += a[i] * w[i]; }
        AB[(size_t)row * 16 + j] = acc * (1.0f / sqrtf(SS1[row] * (1.0f / D_MODEL) + EPS)); }
}
#ifdef SKELETON
__device__ __forceinline__ void phase_mix0(const Ptrs& P, LAS unsigned char* lds, int G) {
    v4u* Y = (v4u*)(P.ws + WS_Y); const v4u z = {0u, 0u, 0u, 0u};
    for (size_t i = (size_t)blockIdx.x * 512 + threadIdx.x; i < (size_t)M_TOK * D_MODEL / 8; i += (size_t)G * 512) Y[i] = z;
}
__device__ __forceinline__ void phase_mix1a(const Ptrs& P, LAS unsigned char* lds, int G) { phase_mix0(P, lds, G); }
__device__ __forceinline__ void phase_mix1b(const Ptrs& P, LAS unsigned char* lds, int G) { }
#endif
typedef short bf16x8 __attribute__((ext_vector_type(8)));
typedef short bf16x4 __attribute__((ext_vector_type(4)));
typedef short v4i16_t __attribute__((ext_vector_type(4)));
#define MFMA16(a, b, c) __builtin_amdgcn_mfma_f32_16x16x32_bf16((a), (b), (c), 0, 0, 0)
__device__ __forceinline__ v4i16_t lds_tr(LAS const unsigned char* p) { return __builtin_amdgcn_ds_read_tr16_b64_v4i16((LAS v4i16_t*)p); }
__device__ __forceinline__ bf16x8 frag_row(LAS const unsigned char* base, int RS, int r0, int k0, int lane) { return *(LAS const bf16x8*)(base + (r0 + (lane & 15)) * RS + (k0 + 8 * (lane >> 4)) * 2); }
__device__ __forceinline__ bf16x8 frag_row_perm(LAS const unsigned char* base, int RS, int r0, int k0, int lane) {
    LAS const unsigned char* p = base + (r0 + (lane & 15)) * RS + (k0 + 4 * (lane >> 4)) * 2;
    const bf16x4 a = *(LAS const bf16x4*)p, b = *(LAS const bf16x4*)(p + 32); return (bf16x8){a[0], a[1], a[2], a[3], b[0], b[1], b[2], b[3]}; }
__device__ __forceinline__ bf16x8 frag_tr(LAS const unsigned char* base, int RS, int k0, int c0, int lane) {
    const int g = lane >> 4, q = (lane & 15) >> 2, p = lane & 3; LAS const unsigned char* a = base + (k0 + 8 * g + q) * RS + (c0 + 4 * p) * 2;
    const v4i16_t lo = lds_tr(a), hi = lds_tr(a + 4 * RS); return (bf16x8){lo[0], lo[1], lo[2], lo[3], hi[0], hi[1], hi[2], hi[3]}; }
__device__ __forceinline__ bf16x8 frag_tr_perm(LAS const unsigned char* base, int RS, int k0, int c0, int lane) {
    const int g = lane >> 4, q = (lane & 15) >> 2, p = lane & 3; LAS const unsigned char* a = base + (k0 + 4 * g + q) * RS + (c0 + 4 * p) * 2;
    const v4i16_t lo = lds_tr(a), hi = lds_tr(a + 16 * RS); return (bf16x8){lo[0], lo[1], lo[2], lo[3], hi[0], hi[1], hi[2], hi[3]}; }
__device__ __forceinline__ bf16x8 acc_pair_frag(const f32x4& lo, const f32x4& hi) {
    const unsigned a = pk2(lo[0], lo[1]), b = pk2(lo[2], lo[3]), c = pk2(hi[0], hi[1]), d = pk2(hi[2], hi[3]);
    typedef unsigned u32x4_ __attribute__((ext_vector_type(4))); const u32x4_ w = {a, b, c, d}; return __builtin_bit_cast(bf16x8, w); }
__device__ __forceinline__ float fexp2(float x) { return __builtin_amdgcn_exp2f(x); }
constexpr float LOG2E = 1.4426950408889634f;
__device__ __forceinline__ float fexp(float x) { return __builtin_amdgcn_exp2f(x * LOG2E); }
__device__ __forceinline__ float frcp(float x) { return __builtin_amdgcn_rcpf(x); }
__device__ __forceinline__ float frsq(float x) { return __builtin_amdgcn_rsqf(x); }
__device__ __forceinline__ float fsqrt(float x) { return __builtin_amdgcn_sqrtf(x); }
__device__ __forceinline__ float fsigmoid(float x) { return __builtin_amdgcn_rcpf(1.0f + __builtin_amdgcn_exp2f(-x * LOG2E)); }
__device__ __forceinline__ float fsilu(float x) { return x * fsigmoid(x); }
constexpr int AT_RSK = 272, AT_RSV = 288, AT_KB = 64 * AT_RSK, AT_VB = 64 * AT_RSV;
constexpr int AT_OFF_K = 0, AT_OFF_V = 2 * AT_KB, AT_OFF_TBL = AT_OFF_V + 2 * AT_VB, AT_LDS = AT_OFF_TBL + 2064;
static_assert(AT_LDS <= 163328, "attention LDS");
template <int SKIP = 0> __device__ __forceinline__ void attn_item(const Ptrs& P, LAS unsigned char* lds, int item, size_t yoff = WS_Y) {
    const bf16_t* __restrict__ PROJ = (const bf16_t*)(P.ws + WS_PROJ); bf16_t* __restrict__ Y = (bf16_t*)(P.ws + yoff);
    const float* __restrict__ qn_g = P.in[IN_EV_QNG]; const float* __restrict__ kn_g = P.in[IN_EV_KNG];
    const int tid = threadIdx.x, lane = tid & 63, wave = tid >> 6, g = lane >> 4, l15 = lane & 15;
    const int cp = item & 15, h = (item >> 4) & 7, b = item >> 7;
    const int c = 2 * cp + (wave >> 2), qt = wave & 3;
    LAS float* tbl = (LAS float*)(lds + AT_OFF_TBL);
    for (int i = tid; i < NREL; i += 512) tbl[i] = P.in[IN_EV_REL][h * NREL + i] * LOG2E;
    bf16x8 qf[4];
    { const bf16_t* qp = PROJ + (size_t)(b * SEQ + c * 64 + qt * 16 + l15) * EV_N + EC_QA + h * 128 + 8 * g;
      float qv[4][8]; float ss = 0.f;
#pragma unroll
      for (int ks = 0; ks < 4; ++ks) { ld8bf(qp + 32 * ks, qv[ks]);
#pragma unroll
          for (int i = 0; i < 8; ++i) ss += qv[ks][i] * qv[ks][i]; }
      ss += __shfl_xor(ss, 16); ss += __shfl_xor(ss, 32);
      const float rs = frsq(ss * (1.0f / 128.0f) + EPS) * (0.08838834764831845f * LOG2E);
#pragma unroll
      for (int ks = 0; ks < 4; ++ks) { const float* gp = qn_g + 32 * ks + 8 * g; typedef unsigned u32x4_ __attribute__((ext_vector_type(4)));
          const u32x4_ w = {pk2(qv[ks][0] * rs * gp[0], qv[ks][1] * rs * gp[1]), pk2(qv[ks][2] * rs * gp[2], qv[ks][3] * rs * gp[3]),
                            pk2(qv[ks][4] * rs * gp[4], qv[ks][5] * rs * gp[5]), pk2(qv[ks][6] * rs * gp[6], qv[ks][7] * rs * gp[7])};
          qf[ks] = __builtin_bit_cast(bf16x8, w); } }
    f32x4 o[8];
#pragma unroll
    for (int i = 0; i < 8; ++i) o[i] = (f32x4){0.f, 0.f, 0.f, 0.f};
    float mrun = -1.0e30f, lrun = 0.f;
    const int kt_lo = (2 * cp - LOOKBACK) < 0 ? 0 : (2 * cp - LOOKBACK), kt_hi = 2 * cp + 1;
    v4u kreg[2], vreg[2];
    const int srow0 = tid >> 4, sch = tid & 15;
    float kg[8];
#pragma unroll
    for (int i = 0; i < 8; ++i) kg[i] = kn_g[sch * 8 + i];
#define AT_LOAD(kt) do { _Pragma("unroll") for (int i_ = 0; i_ < 2; ++i_) { const bf16_t* rp_ = PROJ + (size_t)(b * SEQ + (kt) * 64 + srow0 + 32 * i_) * EV_N + h * 128 + sch * 8; \
        kreg[i_] = *(const v4u*)(rp_ + EC_KA); vreg[i_] = *(const v4u*)(rp_ + EC_VA); } } while (0)
#define AT_STORE(buf) do { _Pragma("unroll") for (int i_ = 0; i_ < 2; ++i_) { const int row_ = srow0 + 32 * i_; \
        float kv_[8]; kv_[0] = __builtin_bit_cast(float, kreg[i_].x << 16); kv_[1] = __builtin_bit_cast(float, kreg[i_].x & 0xffff0000u); kv_[2] = __builtin_bit_cast(float, kreg[i_].y << 16); kv_[3] = __builtin_bit_cast(float, kreg[i_].y & 0xffff0000u); \
        kv_[4] = __builtin_bit_cast(float, kreg[i_].z << 16); kv_[5] = __builtin_bit_cast(float, kreg[i_].z & 0xffff0000u); kv_[6] = __builtin_bit_cast(float, kreg[i_].w << 16); kv_[7] = __builtin_bit_cast(float, kreg[i_].w & 0xffff0000u); \
        float ss_ = 0.f; _Pragma("unroll") for (int e_ = 0; e_ < 8; ++e_) ss_ += kv_[e_] * kv_[e_]; \
        ss_ += __shfl_xor(ss_, 1); ss_ += __shfl_xor(ss_, 2); ss_ += __shfl_xor(ss_, 4); ss_ += __shfl_xor(ss_, 8); \
        const float rs_ = frsq(ss_ * (1.0f / 128.0f) + EPS); \
        v4u w_; w_.x = pk2(kv_[0] * rs_ * kg[0], kv_[1] * rs_ * kg[1]); w_.y = pk2(kv_[2] * rs_ * kg[2], kv_[3] * rs_ * kg[3]); w_.z = pk2(kv_[4] * rs_ * kg[4], kv_[5] * rs_ * kg[5]); w_.w = pk2(kv_[6] * rs_ * kg[6], kv_[7] * rs_ * kg[7]); \
        *(LAS v4u*)(lds + AT_OFF_K + (buf) * AT_KB + row_ * AT_RSK + sch * 16) = w_; \
        *(LAS v4u*)(lds + AT_OFF_V + (buf) * AT_VB + row_ * AT_RSV + sch * 16) = vreg[i_]; } } while (0)
    AT_LOAD(kt_lo); AT_STORE(0);
    __syncthreads();
    const int qi = qt * 16 + l15;
    for (int kt = kt_lo, it = 0; kt <= kt_hi; ++kt, ++it) {
        const int buf = it & 1;
        if (kt < kt_hi) AT_LOAD(kt + 1);
        const int to = kt - (c - LOOKBACK);
        if (to >= 0 && to <= LOOKBACK) {
            LAS const unsigned char* Kb = lds + AT_OFF_K + buf * AT_KB; LAS const unsigned char* Vb = lds + AT_OFF_V + buf * AT_VB;
            f32x4 s[4];
#pragma unroll
            for (int nt = 0; nt < 4; ++nt) { s[nt] = (f32x4){0.f, 0.f, 0.f, 0.f};
#pragma unroll
                for (int ks = 0; ks < ((SKIP & 16) ? 0 : 4); ++ks) s[nt] = MFMA16(frag_row(Kb, AT_RSK, 16 * nt, 32 * ks, lane), qf[ks], s[nt]); }
            if constexpr (!(SKIP & 2)) { const int relb = LOOKBACK * CHUNK - 64 * to + qi - 4 * g;
#pragma unroll
              for (int nt = 0; nt < 4; ++nt)
#pragma unroll
                  for (int r = 0; r < 4; ++r) { int rel = relb - 16 * nt - r; rel = rel > REL_MAX ? REL_MAX : rel; s[nt][r] += tbl[rel + REL_MAX]; } }
            float tmax = fmaxf(fmaxf(s[0][0], s[0][1]), fmaxf(s[0][2], s[0][3]));
#pragma unroll
            for (int nt = 1; nt < 4; ++nt) tmax = fmaxf(tmax, fmaxf(fmaxf(s[nt][0], s[nt][1]), fmaxf(s[nt][2], s[nt][3])));
            tmax = fmaxf(tmax, __shfl_xor(tmax, 16)); tmax = fmaxf(tmax, __shfl_xor(tmax, 32));
            const float mnew = fmaxf(mrun, tmax), alpha = fexp2(mrun - mnew);
            float rsum = 0.f;
#pragma unroll
            for (int nt = 0; nt < 4; ++nt)
#pragma unroll
                for (int r = 0; r < 4; ++r) { s[nt][r] = (SKIP & 4) ? (s[nt][r] - mnew) : fexp2(s[nt][r] - mnew); rsum += s[nt][r]; }
            rsum += __shfl_xor(rsum, 16); rsum += __shfl_xor(rsum, 32);
            lrun = lrun * alpha + rsum; mrun = mnew;
            const bf16x8 pf0 = acc_pair_frag(s[0], s[1]), pf1 = acc_pair_frag(s[2], s[3]);
            float al[4];
#pragma unroll
            for (int r = 0; r < 4; ++r) al[r] = __shfl(alpha, 4 * g + r);
#pragma unroll
            for (int dt = 0; dt < ((SKIP & 8) ? 0 : 8); ++dt) { o[dt][0] *= al[0]; o[dt][1] *= al[1]; o[dt][2] *= al[2]; o[dt][3] *= al[3];
                o[dt] = MFMA16(pf0, frag_tr_perm(Vb, AT_RSV, 0, 16 * dt, lane), o[dt]);
                o[dt] = MFMA16(pf1, frag_tr_perm(Vb, AT_RSV, 32, 16 * dt, lane), o[dt]); }
        }
        if (kt < kt_hi) AT_STORE(buf ^ 1);
        __syncthreads();
    }
#undef AT_LOAD
#undef AT_STORE
    float li[4];
#pragma unroll
    for (int r = 0; r < 4; ++r) li[r] = frcp(__shfl(lrun, 4 * g + r));
#pragma unroll
    for (int r = 0; r < 4; ++r) { const size_t tok = (size_t)b * SEQ + c * 64 + qt * 16 + 4 * g + r; const bf16_t* zp = PROJ + tok * EV_N + EC_ZA + h * 128 + l15; bf16_t* yp = Y + tok * D_MODEL + h * 128 + l15;
#pragma unroll
        for (int dt = 0; dt < 8; ++dt) yp[16 * dt] = (bf16_t)f2bf(o[dt][r] * li[r] * fsilu(bf2f(zp[16 * dt]))); }
}
constexpr int A2_KB = 64 * AT_RSK, A2_VB = 64 * AT_RSV, A2_BUF = 2 * A2_KB + 2 * A2_VB;
constexpr int A2_OFF_TBL = 2 * A2_BUF, A2_LDS = A2_OFF_TBL + 2 * 2064;
static_assert(A2_LDS <= 163328, "attention (2-head) LDS");
template <int SKIP = 0> __device__ __forceinline__ void attn2_item(const Ptrs& P, LAS unsigned char* lds, int item, size_t yoff = WS_Y) {
    const bf16_t* __restrict__ PROJ = (const bf16_t*)(P.ws + WS_PROJ); bf16_t* __restrict__ Y = (bf16_t*)(P.ws + yoff);
    const float* __restrict__ qn_g = P.in[IN_EV_QNG]; const float* __restrict__ kn_g = P.in[IN_EV_KNG];
    const int tid = threadIdx.x, lane = tid & 63, wave = tid >> 6, g = lane >> 4, l15 = lane & 15;
    const int cp = item & 15, hp = (item >> 4) & 3, b = item >> 6;
    const int hs = wave >> 2, h = 2 * hp + hs, c = 2 * cp + ((wave >> 1) & 1), q0 = 32 * (wave & 1);
    LAS float* tbl = (LAS float*)(lds + A2_OFF_TBL);
    for (int i = tid; i < 2 * NREL; i += 512) { const int hh = i / NREL, r = i - hh * NREL; tbl[hh * 516 + r] = P.in[IN_EV_REL][(2 * hp + hh) * NREL + r] * LOG2E; }
    bf16x8 qf[2][4];
#pragma unroll
    for (int q = 0; q < 2; ++q) { const bf16_t* qp = PROJ + (size_t)(b * SEQ + c * 64 + q0 + 16 * q + l15) * EV_N + EC_QA + h * 128 + 8 * g;
        float qv[4][8]; float ss = 0.f;
#pragma unroll
        for (int ks = 0; ks < 4; ++ks) { ld8bf(qp + 32 * ks, qv[ks]);
#pragma unroll
            for (int i = 0; i < 8; ++i) ss += qv[ks][i] * qv[ks][i]; }
        ss += __shfl_xor(ss, 16); ss += __shfl_xor(ss, 32);
        const float rs = frsq(ss * (1.0f / 128.0f) + EPS) * (0.08838834764831845f * LOG2E);
#pragma unroll
        for (int ks = 0; ks < 4; ++ks) { const float* gp = qn_g + 32 * ks + 8 * g; typedef unsigned u32x4_ __attribute__((ext_vector_type(4)));
            const u32x4_ w = {pk2(qv[ks][0] * rs * gp[0], qv[ks][1] * rs * gp[1]), pk2(qv[ks][2] * rs * gp[2], qv[ks][3] * rs * gp[3]),
                              pk2(qv[ks][4] * rs * gp[4], qv[ks][5] * rs * gp[5]), pk2(qv[ks][6] * rs * gp[6], qv[ks][7] * rs * gp[7])};
            qf[q][ks] = __builtin_bit_cast(bf16x8, w); } }
    f32x4 o[2][8];
#pragma unroll
    for (int q = 0; q < 2; ++q)
#pragma unroll
        for (int i = 0; i < 8; ++i) o[q][i] = (f32x4){0.f, 0.f, 0.f, 0.f};
    float mrun[2] = {-1.0e30f, -1.0e30f}, lrun[2] = {0.f, 0.f};
    const int kt_lo = (2 * cp - LOOKBACK) < 0 ? 0 : (2 * cp - LOOKBACK), kt_hi = 2 * cp + 1;
    v4u kreg[2][2], vreg[2][2];
    const int srow0 = tid >> 4, sch = tid & 15;
#define A2_LOAD(kt) do { _Pragma("unroll") for (int hh_ = 0; hh_ < 2; ++hh_) _Pragma("unroll") for (int i_ = 0; i_ < 2; ++i_) { \
        const bf16_t* rp_ = PROJ + (size_t)(b * SEQ + (kt) * 64 + srow0 + 32 * i_) * EV_N + (2 * hp + hh_) * 128 + sch * 8; kreg[hh_][i_] = *(const v4u*)(rp_ + EC_KA); vreg[hh_][i_] = *(const v4u*)(rp_ + EC_VA); } } while (0)
#define A2_STORE(buf) do { _Pragma("unroll") for (int hh_ = 0; hh_ < 2; ++hh_) _Pragma("unroll") for (int i_ = 0; i_ < 2; ++i_) { const int row_ = srow0 + 32 * i_; const v4u kr_ = kreg[hh_][i_]; \
        float kv_[8]; kv_[0] = __builtin_bit_cast(float, kr_.x << 16); kv_[1] = __builtin_bit_cast(float, kr_.x & 0xffff0000u); kv_[2] = __builtin_bit_cast(float, kr_.y << 16); kv_[3] = __builtin_bit_cast(float, kr_.y & 0xffff0000u); \
        kv_[4] = __builtin_bit_cast(float, kr_.z << 16); kv_[5] = __builtin_bit_cast(float, kr_.z & 0xffff0000u); kv_[6] = __builtin_bit_cast(float, kr_.w << 16); kv_[7] = __builtin_bit_cast(float, kr_.w & 0xffff0000u); \
        float ss_ = 0.f; _Pragma("unroll") for (int e_ = 0; e_ < 8; ++e_) ss_ += kv_[e_] * kv_[e_]; \
        ss_ += __shfl_xor(ss_, 1); ss_ += __shfl_xor(ss_, 2); ss_ += __shfl_xor(ss_, 4); ss_ += __shfl_xor(ss_, 8); \
        const float rs_ = frsq(ss_ * (1.0f / 128.0f) + EPS); const f32x4 kga_ = *(const f32x4*)(kn_g + sch * 8), kgb_ = *(const f32x4*)(kn_g + sch * 8 + 4); const float kg[8] = {kga_[0], kga_[1], kga_[2], kga_[3], kgb_[0], kgb_[1], kgb_[2], kgb_[3]}; \
        v4u w_; w_.x = pk2(kv_[0] * rs_ * kg[0], kv_[1] * rs_ * kg[1]); w_.y = pk2(kv_[2] * rs_ * kg[2], kv_[3] * rs_ * kg[3]); w_.z = pk2(kv_[4] * rs_ * kg[4], kv_[5] * rs_ * kg[5]); w_.w = pk2(kv_[6] * rs_ * kg[6], kv_[7] * rs_ * kg[7]); \
        *(LAS v4u*)(lds + (buf) * A2_BUF + hh_ * A2_KB + row_ * AT_RSK + sch * 16) = w_; \
        *(LAS v4u*)(lds + (buf) * A2_BUF + 2 * A2_KB + hh_ * A2_VB + row_ * AT_RSV + sch * 16) = vreg[hh_][i_]; } } while (0)
    A2_LOAD(kt_lo); A2_STORE(0);
    __syncthreads();
    LAS const float* tb = tbl + hs * 516;
    for (int kt = kt_lo, it = 0; kt <= kt_hi; ++kt, ++it) {
        const int buf = it & 1;
        if (kt < kt_hi) A2_LOAD(kt + 1);
        const int to = kt - (c - LOOKBACK);
        if (to >= 0 && to <= LOOKBACK) {
            LAS const unsigned char* Kb = lds + buf * A2_BUF + hs * A2_KB; LAS const unsigned char* Vb = lds + buf * A2_BUF + 2 * A2_KB + hs * A2_VB;
            f32x4 s[2][4];
#pragma unroll
            for (int nt = 0; nt < 4; ++nt) { s[0][nt] = (f32x4){0.f, 0.f, 0.f, 0.f}; s[1][nt] = s[0][nt];
#pragma unroll
                for (int ks = 0; ks < 4; ++ks) { const bf16x8 kf = frag_row(Kb, AT_RSK, 16 * nt, 32 * ks, lane); s[0][nt] = MFMA16(kf, qf[0][ks], s[0][nt]); s[1][nt] = MFMA16(kf, qf[1][ks], s[1][nt]); }
                if (nt & 1) __builtin_amdgcn_sched_barrier(0); }
            bf16x8 pf[2][2]; float al[2][4];
#pragma unroll
            for (int q = 0; q < 2; ++q) {
                const int relb = LOOKBACK * CHUNK - 64 * to + (q0 + 16 * q + l15) - 4 * g;
                if (to <= 3) { const float cb = tb[2 * REL_MAX];
#pragma unroll
                    for (int nt = 0; nt < 4; ++nt) s[q][nt] += cb; }
                else if (to >= 5) { const LAS float* tp = tb + relb + REL_MAX;
#pragma unroll
                    for (int nt = 0; nt < 4; ++nt)
#pragma unroll
                        for (int r = 0; r < 4; ++r) s[q][nt][r] += tp[-(16 * nt + r)]; }
                else {
#pragma unroll
                    for (int nt = 0; nt < 4; ++nt)
#pragma unroll
                        for (int r = 0; r < 4; ++r) { int rel = relb - 16 * nt - r; rel = rel > REL_MAX ? REL_MAX : rel; s[q][nt][r] += tb[rel + REL_MAX]; } }
                float tmax = fmaxf(fmaxf(s[q][0][0], s[q][0][1]), fmaxf(s[q][0][2], s[q][0][3]));
#pragma unroll
                for (int nt = 1; nt < 4; ++nt) tmax = fmaxf(tmax, fmaxf(fmaxf(s[q][nt][0], s[q][nt][1]), fmaxf(s[q][nt][2], s[q][nt][3])));
                tmax = fmaxf(tmax, __shfl_xor(tmax, 16)); tmax = fmaxf(tmax, __shfl_xor(tmax, 32));
                const float mnew = fmaxf(mrun[q], tmax), alpha = fexp2(mrun[q] - mnew);
                float rsum = 0.f;
#pragma unroll
                for (int nt = 0; nt < 4; ++nt)
#pragma unroll
                    for (int r = 0; r < 4; ++r) { s[q][nt][r] = fexp2(s[q][nt][r] - mnew); rsum += s[q][nt][r]; }
                rsum += __shfl_xor(rsum, 16); rsum += __shfl_xor(rsum, 32);
                lrun[q] = lrun[q] * alpha + rsum; mrun[q] = mnew;
                pf[q][0] = acc_pair_frag(s[q][0], s[q][1]); pf[q][1] = acc_pair_frag(s[q][2], s[q][3]);
#pragma unroll
                for (int r = 0; r < 4; ++r) al[q][r] = __shfl(alpha, 4 * g + r); }
#pragma unroll
            for (int dt = 0; dt < 8; ++dt) { const bf16x8 v0 = frag_tr_perm(Vb, AT_RSV, 0, 16 * dt, lane), v1 = frag_tr_perm(Vb, AT_RSV, 32, 16 * dt, lane);
#pragma unroll
                for (int q = 0; q < 2; ++q) { o[q][dt][0] *= al[q][0]; o[q][dt][1] *= al[q][1]; o[q][dt][2] *= al[q][2]; o[q][dt][3] *= al[q][3];
                    o[q][dt] = MFMA16(pf[q][0], v0, o[q][dt]); o[q][dt] = MFMA16(pf[q][1], v1, o[q][dt]); }
                if (dt & 1) __builtin_amdgcn_sched_barrier(0); }
        }
        if (kt < kt_hi) A2_STORE(buf ^ 1);
        __syncthreads();
    }
#undef A2_LOAD
#undef A2_STORE
#pragma unroll
    for (int q = 0; q < 2; ++q) { float li[4];
#pragma unroll
        for (int r = 0; r < 4; ++r) li[r] = frcp(__shfl(lrun[q], 4 * g + r));
#pragma unroll
        for (int r = 0; r < 4; ++r) { const size_t tok = (size_t)b * SEQ + c * 64 + q0 + 16 * q + 4 * g + r; const bf16_t* zp = PROJ + tok * EV_N + EC_ZA + h * 128 + l15; bf16_t* yp = Y + tok * D_MODEL + h * 128 + l15;
#pragma unroll
            for (int dt = 0; dt < 8; ++dt) yp[16 * dt] = (bf16_t)f2bf(o[q][dt][r] * li[r] * fsilu(bf2f(zp[16 * dt]))); } }
}
constexpr int ML_RSQ = 528, ML_RSK = 544, ML_RSV = 160, ML_RSP = 144, ML_RSH = 144;
constexpr int ML_OFF_Q = 0, ML_OFF_K = ML_OFF_Q + 64 * ML_RSQ, ML_OFF_V = ML_OFF_K + 64 * ML_RSK, ML_OFF_P = ML_OFF_V + 64 * ML_RSV, ML_OFF_H = ML_OFF_P + 64 * ML_RSP, ML_OFF_S = ML_OFF_H + 64 * ML_RSH;
constexpr int ML_BC = 0, ML_AA = 2048, ML_PM = 4096, ML_MCH = 6144  , ML_BL = 6184  , ML_PL = 6216  ;
constexpr int ML_E1 = 6248, ML_E2 = ML_E1 + 64, ML_WI = ML_E2 + 64, ML_EMT = ML_WI + 64, ML_WS = ML_EMT + 64, ML_RS = ML_WS + 64, ML_QN = ML_RS + 64, ML_NV = ML_QN + 64, ML_NP = ML_NV + 256, ML_WC = ML_NP + 512, ML_LDS = ML_OFF_S + (ML_WC + 4) * 4;
static_assert(ML_LDS <= 163328, "mLSTM LDS");
template <int SKIP = 0> __device__ __forceinline__ void mlstm_item(const Ptrs& P, LAS unsigned char* lds, int item, size_t yoff = WS_Y) {
    const bf16_t* __restrict__ PROJ = (const bf16_t*)(P.ws + WS_PROJ); bf16_t* __restrict__ Y = (bf16_t*)(P.ws + yoff); const float* __restrict__ GIF = (const float*)(P.ws + WS_GIF);
    const int tid = threadIdx.x, lane = tid & 63, wave = tid >> 6, g = lane >> 4, l15 = lane & 15;
    const int quarter = item & 3, h = (item >> 2) & 3, b = item >> 4;
    LAS float* sc = (LAS float*)(lds + ML_OFF_S);
    LAS const unsigned char* Qt = lds + ML_OFF_Q; LAS const unsigned char* Kt = lds + ML_OFF_K; LAS const unsigned char* Vt = lds + ML_OFF_V; LAS const unsigned char* Ps = lds + ML_OFF_P;
    const size_t tok0 = (size_t)b * SEQ;
    f32x4 cacc[16];
#pragma unroll
    for (int i = 0; i < 16; ++i) cacc[i] = (f32x4){0.f, 0.f, 0.f, 0.f};
    if (tid < 256) sc[ML_NV + tid] = 0.f;
    for (int e = tid; e < 64 * ML_RSP / 8; e += 512) *(LAS unsigned long long*)(lds + ML_OFF_P + e * 8) = 0ull;
#pragma unroll 1
    for (int c = wave * 4; c < wave * 4 + 4; ++c) { const size_t tok = tok0 + c * 64 + lane;
        const float li = GIF[tok * 8 + h], lf = logsigmoidf_(GIF[tok * 8 + 4 + h]);
        float bc = lf;
#pragma unroll
        for (int o = 1; o < 64; o <<= 1) { const float t_ = __shfl_up(bc, o); if (lane >= o) bc += t_; }
        const float as = li - bc; float pm = as;
#pragma unroll
        for (int o = 1; o < 64; o <<= 1) { const float t_ = __shfl_up(pm, o); if (lane >= o) pm = fmaxf(pm, t_); }
        sc[ML_BC + c * 64 + lane] = bc; sc[ML_AA + c * 64 + lane] = as; sc[ML_PM + c * 64 + lane] = pm;
        if (lane == 63) { sc[ML_BL + c] = bc; sc[ML_PL + c] = pm; } }
    __syncthreads();
    if (tid == 0) { float m = 0.f; sc[ML_MCH] = 0.f;
        for (int c = 0; c < NCH; ++c) { m = sc[ML_BL + c] + fmaxf(m, sc[ML_PL + c]); sc[ML_MCH + c + 1] = m; } }
    v4u qreg[4], kreg[4], vreg, oreg, zreg;
    const int ot = tid >> 3, oc = (tid & 7) * 8, ocol = h * 256 + quarter * 64 + oc;
#define ML_LOAD(n) do { _Pragma("unroll") for (int i_ = 0; i_ < 4; ++i_) { const int id_ = tid + 512 * i_, row_ = id_ >> 5, ch_ = id_ & 31; const bf16_t* rp_ = PROJ + (tok0 + (n) * 64 + row_) * EV_N + h * 256 + ch_ * 8; \
            qreg[i_] = *(const v4u*)(rp_ + EC_QB); kreg[i_] = *(const v4u*)(rp_ + EC_KB); } \
        vreg = *(const v4u*)(PROJ + (tok0 + (n) * 64 + (tid >> 3)) * EV_N + EC_VB + h * 256 + quarter * 64 + (tid & 7) * 8); } while (0)
#define ML_LOAD_OZ(n) do { const bf16_t* rp_ = PROJ + (tok0 + (n) * 64 + ot) * EV_N + ocol; oreg = *(const v4u*)(rp_ + EC_OB); zreg = *(const v4u*)(rp_ + EC_ZB); } while (0)
#define ML_STORE() do { _Pragma("unroll") for (int i_ = 0; i_ < 4; ++i_) { const int id_ = tid + 512 * i_, row_ = id_ >> 5, ch_ = id_ & 31; \
            *(LAS v4u*)(lds + ML_OFF_Q + row_ * ML_RSQ + ch_ * 16) = qreg[i_]; *(LAS v4u*)(lds + ML_OFF_K + row_ * ML_RSK + ch_ * 16) = kreg[i_]; } \
        *(LAS v4u*)(lds + ML_OFF_V + (tid >> 3) * ML_RSV + (tid & 7) * 16) = vreg; } while (0)
    ML_LOAD(0);
    __syncthreads();
    for (int n = 0; n < NCH; ++n) {
        if constexpr (!(SKIP & 64)) ML_STORE();
        const float m0 = sc[ML_MCH + n], m1 = sc[ML_MCH + n + 1], blast = sc[ML_BL + n];
        if (tid < 64) { const float bc = sc[ML_BC + n * 64 + tid], as = sc[ML_AA + n * 64 + tid], mx = fmaxf(m0, sc[ML_PM + n * 64 + tid]);
            sc[ML_E1 + tid] = -mx * LOG2E; sc[ML_E2 + tid] = as * LOG2E; sc[ML_WI + tid] = fexp(m0 - mx); sc[ML_EMT + tid] = fexp(-bc - mx); sc[ML_WS + tid] = fexp(as + blast - m1); sc[ML_RS + tid] = 0.f;
            if (tid == 0) sc[ML_WC] = fexp(blast + m0 - m1); }
        __syncthreads();
        if constexpr (!(SKIP & 64)) { if (n + 1 < NCH) ML_LOAD(n + 1); }
        f32x4 nu[4]; bf16x8 vf[2];
        if (wave >= 4) {
#pragma unroll 1
            for (int q = wave - 4; q < ((SKIP & 2) ? 0 : 10); q += 4) { const int tt = (q >= 6) ? 3 : (q >= 3) ? 2 : (q >= 1) ? 1 : 0; const int st = q - (tt * (tt + 1)) / 2;
                const int t = 16 * tt + l15; const float e1 = sc[ML_E1 + t];
                f32x4 s_ = (f32x4){0.f, 0.f, 0.f, 0.f};
#pragma unroll
                for (int ks = 0; ks < 8; ++ks) s_ = MFMA16(frag_row(Kt, ML_RSK, 16 * st, 32 * ks, lane), frag_row(Qt, ML_RSQ, 16 * tt, 32 * ks, lane), s_);
                float pv_[4]; float rs = 0.f;
#pragma unroll
                for (int r = 0; r < 4; ++r) { const int sidx = 16 * st + 4 * g + r; const float p = (sidx <= t) ? fexp2(e1 + sc[ML_E2 + sidx]) * s_[r] * 0.0625f : 0.f; pv_[r] = p; rs += p; }
                rs += __shfl_xor(rs, 16); rs += __shfl_xor(rs, 32);
                if (g == 0) atomicAdd((float*)(sc + ML_RS + t), rs);
                *(LAS unsigned long long*)(lds + ML_OFF_P + t * ML_RSP + (16 * st + 4 * g) * 2) = (unsigned long long)pk2(pv_[0], pv_[1]) | ((unsigned long long)pk2(pv_[2], pv_[3]) << 32); }
        } else {
#pragma unroll
            for (int tt = 0; tt < 4; ++tt) nu[tt] = (f32x4){0.f, 0.f, 0.f, 0.f};
#pragma unroll
            for (int j = 0; j < ((SKIP & 4) ? 0 : 8); ++j) { const bf16x8 cf = acc_pair_frag(cacc[2 * j], cacc[2 * j + 1]);
#pragma unroll
                for (int tt = 0; tt < 4; ++tt) nu[tt] = MFMA16(frag_row_perm(Qt, ML_RSQ, 16 * tt, 32 * j, lane), cf, nu[tt]);
                if (j & 1) __builtin_amdgcn_sched_barrier(0); }
            if constexpr (!(SKIP & 32)) { f32x4 qna = (f32x4){0.f, 0.f, 0.f, 0.f}; const LAS float* nvc = sc + ((n & 1) ? ML_NP : ML_NV);
#pragma unroll
              for (int j = 0; j < 8; ++j) { const f32x4 n0_ = *(LAS const f32x4*)(nvc + 32 * j + 4 * g), n1_ = *(LAS const f32x4*)(nvc + 32 * j + 16 + 4 * g);
                  qna = MFMA16(frag_row_perm(Qt, ML_RSQ, 16 * wave, 32 * j, lane), acc_pair_frag(n0_, n1_), qna); }
              if (l15 == 0) *(LAS f32x4*)(sc + ML_QN + 16 * wave + 4 * g) = qna * 0.0625f; }
            __builtin_amdgcn_sched_barrier(0);
#pragma unroll
            for (int tt = 0; tt < 4; ++tt) { const f32x4 wi = *(LAS const f32x4*)(sc + ML_WI + 16 * tt + 4 * g); nu[tt] *= wi * 0.0625f; }
            __builtin_amdgcn_sched_barrier(0);
#pragma unroll
            for (int ks = 0; ks < 2; ++ks) vf[ks] = frag_tr_perm(Vt, ML_RSV, 32 * ks, 16 * wave, lane);
            const float wc = sc[ML_WC];
            bf16x8 vw[2];
#pragma unroll
            for (int ks = 0; ks < 2; ++ks) { typedef unsigned u32x4_ __attribute__((ext_vector_type(4))); const u32x4_ w = __builtin_bit_cast(u32x4_, vf[ks]);
                const f32x4 wa = *(LAS const f32x4*)(sc + ML_WS + 32 * ks + 4 * g), wb = *(LAS const f32x4*)(sc + ML_WS + 32 * ks + 16 + 4 * g);
                const u32x4_ o = {pk2(__builtin_bit_cast(float, w.x << 16) * wa[0], __builtin_bit_cast(float, w.x & 0xffff0000u) * wa[1]), pk2(__builtin_bit_cast(float, w.y << 16) * wa[2], __builtin_bit_cast(float, w.y & 0xffff0000u) * wa[3]),
                                  pk2(__builtin_bit_cast(float, w.z << 16) * wb[0], __builtin_bit_cast(float, w.z & 0xffff0000u) * wb[1]), pk2(__builtin_bit_cast(float, w.w << 16) * wb[2], __builtin_bit_cast(float, w.w & 0xffff0000u) * wb[3])};
                vw[ks] = __builtin_bit_cast(bf16x8, o); }
#pragma unroll
            for (int kt = 0; kt < ((SKIP & 8) ? 0 : 16); ++kt) { cacc[kt] *= wc;
                cacc[kt] = MFMA16(frag_tr_perm(Kt, ML_RSK, 0, 16 * kt, lane), vw[0], cacc[kt]);
                cacc[kt] = MFMA16(frag_tr_perm(Kt, ML_RSK, 32, 16 * kt, lane), vw[1], cacc[kt]);
                if ((kt & 3) == 3) __builtin_amdgcn_sched_barrier(0); }
#pragma unroll
            for (int kt = 0; kt < 16; ++kt) asm volatile("" : "+v"(cacc[kt]));
            if constexpr (!(SKIP & 32)) { bf16x8 wsf[2];
#pragma unroll
              for (int ks = 0; ks < 2; ++ks) { const f32x4 w0_ = *(LAS const f32x4*)(sc + ML_WS + 32 * ks + 4 * g), w1_ = *(LAS const f32x4*)(sc + ML_WS + 32 * ks + 16 + 4 * g); wsf[ks] = acc_pair_frag(w0_, w1_); }
              const LAS float* nvo = sc + ((n & 1) ? ML_NP : ML_NV); LAS float* nvn = sc + ((n & 1) ? ML_NV : ML_NP);
#pragma unroll
              for (int i = 0; i < 4; ++i) { const int kt = 4 * wave + i; f32x4 na = (f32x4){0.f, 0.f, 0.f, 0.f};
                  na = MFMA16(frag_tr_perm(Kt, ML_RSK, 0, 16 * kt, lane), wsf[0], na); na = MFMA16(frag_tr_perm(Kt, ML_RSK, 32, 16 * kt, lane), wsf[1], na);
                  if (l15 == 0) *(LAS f32x4*)(nvn + 16 * kt + 4 * g) = *(LAS const f32x4*)(nvo + 16 * kt + 4 * g) * wc + na; } }
        }
        __syncthreads();
        if constexpr (!(SKIP & 1)) ML_LOAD_OZ(n);
        if (wave < 4) {
#pragma unroll
            for (int ks = 0; ks < ((SKIP & 16) ? 0 : 2); ++ks) {
#pragma unroll
                for (int tt = 0; tt < 4; ++tt) nu[tt] = MFMA16(frag_row_perm(Ps, ML_RSP, 16 * tt, 32 * ks, lane), vf[ks], nu[tt]); }
#pragma unroll
            for (int tt = 0; tt < 4; ++tt)
#pragma unroll
                for (int r = 0; r < 4; ++r) *(LAS unsigned short*)(lds + ML_OFF_H + (16 * tt + 4 * g + r) * ML_RSH + (16 * wave + l15) * 2) = (unsigned short)(pk2(nu[tt][r], 0.f) & 0xffffu);
            __builtin_amdgcn_sched_barrier(0);
        }
        __syncthreads();
        if constexpr (!(SKIP & 1)) { const float den = sc[ML_WI + ot] * sc[ML_QN + ot] + sc[ML_RS + ot]; const float inv = frcp(fmaxf(fabsf(den), sc[ML_EMT + ot]));
          const v4u hw = *(LAS const v4u*)(lds + ML_OFF_H + ot * ML_RSH + oc * 2); const v4u ow = oreg, zw = zreg;
#define ML_Y(hx, ox, zx, lo) (fsigmoid(__builtin_bit_cast(float, (lo) ? ((ox) << 16) : ((ox) & 0xffff0000u))) * (__builtin_bit_cast(float, (lo) ? ((hx) << 16) : ((hx) & 0xffff0000u)) * inv) * fsilu(__builtin_bit_cast(float, (lo) ? ((zx) << 16) : ((zx) & 0xffff0000u))))
          v4u yw; yw.x = pk2(ML_Y(hw.x, ow.x, zw.x, 1), ML_Y(hw.x, ow.x, zw.x, 0)); yw.y = pk2(ML_Y(hw.y, ow.y, zw.y, 1), ML_Y(hw.y, ow.y, zw.y, 0));
          yw.z = pk2(ML_Y(hw.z, ow.z, zw.z, 1), ML_Y(hw.z, ow.z, zw.z, 0)); yw.w = pk2(ML_Y(hw.w, ow.w, zw.w, 1), ML_Y(hw.w, ow.w, zw.w, 0));
#undef ML_Y
          *(v4u*)(Y + (tok0 + n * 64 + ot) * D_MODEL + W_A + ocol) = yw; }
    }
#undef ML_LOAD
#undef ML_LOAD_OZ
#undef ML_STORE
    __syncthreads();
}
constexpr int RG_RSG = 160, RG_RSX = 272, RG_RSF = 33 * 4;
constexpr int RG_OFF_G = 0, RG_OFF_X = RG_OFF_G + 128 * RG_RSG, RG_OFF_XF = RG_OFF_X + 64 * RG_RSX, RG_OFF_A = RG_OFF_XF + 64 * RG_RSF, RG_OFF_I = RG_OFF_A + 64 * RG_RSF, RG_OFF_H = RG_OFF_I + 64 * RG_RSF, RG_LDS = RG_OFF_H + 64 * RG_RSF;
static_assert(RG_LDS <= 163328, "RG-LRU LDS");
template <int SKIP = 0> __device__ __forceinline__ void rglru_item(const Ptrs& P, LAS unsigned char* lds, int item, size_t yoff = WS_Y) {
    const bf16_t* __restrict__ PROJ = (const bf16_t*)(P.ws + WS_PROJ); bf16_t* __restrict__ Y = (bf16_t*)(P.ws + yoff);
    const float* __restrict__ ccw = P.in[IN_OD_CCW]; const float* __restrict__ ccb = P.in[IN_OD_CCB]; const float* __restrict__ gw = P.in[IN_OD_GW]; const float* __restrict__ gb = P.in[IN_OD_GB]; const float* __restrict__ lam = P.in[IN_OD_LAM];
    const int tid = threadIdx.x, lane = tid & 63, wave = tid >> 6, g = lane >> 4, l15 = lane & 15;
    const int cq = item & 3, blk = (item >> 2) & 7, b = item >> 5;
    const size_t tok0 = (size_t)b * SEQ;
    for (int e = tid; e < 128 * 64; e += 512) { const int k = e >> 6, c = e & 63; const int d = (c < 32) ? (cq * 32 + c) : (128 + cq * 32 + c - 32);
        *(LAS unsigned short*)(lds + RG_OFF_G + k * RG_RSG + c * 2) = (unsigned short)f2bf(gw[((size_t)blk * 128 + k) * 256 + d]); }
    const int c8 = tid & 15, tq = tid >> 4, ch0 = blk * 128 + 8 * c8;
    float cw[4][8], cb[8];
#pragma unroll
    for (int i = 0; i < 8; ++i) { cb[i] = ccb[ch0 + i];
#pragma unroll
        for (int j = 0; j < 4; ++j) cw[j][i] = ccw[j * W_C + ch0 + i]; }
    const int chl = 16 * (wave & 1) + l15, cgl = blk * 128 + cq * 32 + chl;
    const float gbr = gb[cgl], gbi = gb[W_C + cgl], sp = softplusf_(-lam[cgl]);
    float hcar = 0.f;
    v4u xin[2][4]; unsigned long long zin = 0ull;
    const int ot = tid >> 3, oc4 = tid & 7, cgo = blk * 128 + cq * 32 + 4 * oc4;
#define RG_LOAD(n) do { _Pragma("unroll") for (int u_ = 0; u_ < 2; ++u_) { const int s_ = (n) * 64 + tq + 32 * u_; \
            _Pragma("unroll") for (int j_ = 0; j_ < 4; ++j_) { const bool ok_ = (s_ - 3 + j_ >= 0); const v4u x_ = *(const v4u*)(PROJ + (tok0 + (ok_ ? s_ - 3 + j_ : 0)) * OD_N + OC_XC + ch0); \
                xin[u_][j_].x = ok_ ? x_.x : 0u; xin[u_][j_].y = ok_ ? x_.y : 0u; xin[u_][j_].z = ok_ ? x_.z : 0u; xin[u_][j_].w = ok_ ? x_.w : 0u; } } \
        zin = *(const unsigned long long*)(PROJ + (tok0 + (n) * 64 + ot) * OD_N + OC_ZC + cgo); } while (0)
    RG_LOAD(0);
    __syncthreads();
    for (int n = 0; n < NCH; ++n) {
        const unsigned long long zw = zin;
#pragma unroll
        for (int u = 0; u < ((SKIP & 1) ? 0 : 2); ++u) { const int t = tq + 32 * u; float xv[8];
#pragma unroll
            for (int i = 0; i < 8; ++i) xv[i] = cb[i];
#pragma unroll
            for (int j = 0; j < 4; ++j) { const v4u w_ = xin[u][j];
                xv[0] += cw[j][0] * __builtin_bit_cast(float, w_.x << 16); xv[1] += cw[j][1] * __builtin_bit_cast(float, w_.x & 0xffff0000u); xv[2] += cw[j][2] * __builtin_bit_cast(float, w_.y << 16); xv[3] += cw[j][3] * __builtin_bit_cast(float, w_.y & 0xffff0000u);
                xv[4] += cw[j][4] * __builtin_bit_cast(float, w_.z << 16); xv[5] += cw[j][5] * __builtin_bit_cast(float, w_.z & 0xffff0000u); xv[6] += cw[j][6] * __builtin_bit_cast(float, w_.w << 16); xv[7] += cw[j][7] * __builtin_bit_cast(float, w_.w & 0xffff0000u); }
            v4u w; w.x = pk2(xv[0], xv[1]); w.y = pk2(xv[2], xv[3]); w.z = pk2(xv[4], xv[5]); w.w = pk2(xv[6], xv[7]);
            *(LAS v4u*)(lds + RG_OFF_X + t * RG_RSX + c8 * 16) = w;
            if ((c8 >> 2) == cq) { LAS float* xf = (LAS float*)(lds + RG_OFF_XF + t * RG_RSF) + 8 * (c8 & 3);
#pragma unroll
                for (int i = 0; i < 8; ++i) xf[i] = xv[i]; } }
        if (n + 1 < NCH) RG_LOAD(n + 1);
        __syncthreads();
        { const int tt = wave >> 1, cp = wave & 1; f32x4 ar = (f32x4){0.f, 0.f, 0.f, 0.f}, ai = ar;
#pragma unroll
          for (int ks = 0; ks < ((SKIP & 2) ? 0 : 4); ++ks) { const bf16x8 xa = frag_row(lds + RG_OFF_X, RG_RSX, 16 * tt, 32 * ks, lane);
              ar = MFMA16(xa, frag_tr(lds + RG_OFF_G, RG_RSG, 32 * ks, 16 * cp, lane), ar);
              ai = MFMA16(xa, frag_tr(lds + RG_OFF_G, RG_RSG, 32 * ks, 32 + 16 * cp, lane), ai); }
#pragma unroll
          for (int r = 0; r < ((SKIP & 4) ? 0 : 4); ++r) { const int t = 16 * tt + 4 * g + r;
              const float rr = fsigmoid(ar[r] + gbr), ig = fsigmoid(ai[r] + gbi); const float la = -8.0f * rr * sp;
              const float xc = *((LAS const float*)(lds + RG_OFF_XF + t * RG_RSF) + chl);
              *((LAS float*)(lds + RG_OFF_A + t * RG_RSF) + chl) = fexp(la);
              *((LAS float*)(lds + RG_OFF_I + t * RG_RSF) + chl) = fsqrt(1.0f - fexp(2.0f * la)) * (ig * xc); } }
        __syncthreads();
        if ((SKIP & 8) == 0 && tid < 32) { float h = hcar;
#pragma unroll 8
            for (int t = 0; t < 64; ++t) { h = *((LAS const float*)(lds + RG_OFF_A + t * RG_RSF) + tid) * h + *((LAS const float*)(lds + RG_OFF_I + t * RG_RSF) + tid);
                *((LAS float*)(lds + RG_OFF_H + t * RG_RSF) + tid) = h; }
            hcar = h; }
        __syncthreads();
        if constexpr (!(SKIP & 16)) { const size_t tok = tok0 + n * 64 + ot;
          const LAS float* hp = (LAS const float*)(lds + RG_OFF_H + ot * RG_RSF) + 4 * oc4;
          const float z0 = __builtin_bit_cast(float, (unsigned)(zw & 0xffffull) << 16), z1 = __builtin_bit_cast(float, (unsigned)(zw >> 16 & 0xffffull) << 16), z2 = __builtin_bit_cast(float, (unsigned)(zw >> 32 & 0xffffull) << 16), z3 = __builtin_bit_cast(float, (unsigned)(zw >> 48) << 16);
          *(unsigned long long*)(Y + tok * D_MODEL + cgo) = (unsigned long long)pk2(hp[0] * fsilu(z0), hp[1] * fsilu(z1)) | ((unsigned long long)pk2(hp[2] * fsilu(z2), hp[3] * fsilu(z3)) << 32); }
    }
#undef RG_LOAD
    __syncthreads();
}
constexpr size_t WS_DQ2 = 4 * MiB, WS_DK2 = 36 * MiB;
constexpr size_t WS_DWT = WS_XB, WS_DUT = WS_XB + 32 * MiB;
constexpr size_t WS_DQK = WS_FREE1, WS_DDEC = WS_FREE1 + 16 * MiB;
constexpr float DN_SCALE = 0.08838834764831845f;
template <int T> struct SolveRows {
    static __device__ __forceinline__ void run(float (&col)[32], LAS const unsigned char* Ab, int j) {
        SolveRows<T - 1>::run(col, Ab, j);
        float v = (T == j) ? 1.f : 0.f;
#pragma unroll
        for (int s4 = 0; s4 < (T + 3) / 4; ++s4) { const f32x4 a = *(LAS const f32x4*)(Ab + T * 272 + 16 * s4);
#pragma unroll
            for (int e = 0; e < 4; ++e) { if (4 * s4 + e < T) v -= a[e] * col[4 * s4 + e]; } }
        asm volatile("" : "+v"(v) :: "memory"); col[T] = v;
    }
};
template <> struct SolveRows<-1> { static __device__ __forceinline__ void run(float (&)[32], LAS const unsigned char*, int) {} };
constexpr int D1_RSQ = 272, D1_RSK = 288, D1_RSV = 288, D1_RSA = 272, D1_RST = 160;
constexpr int D1_OFF_Q = 0, D1_OFF_K = D1_OFF_Q + 64 * D1_RSQ, D1_OFF_V = D1_OFF_K + 64 * D1_RSK, D1_OFF_A = D1_OFF_V + 64 * D1_RSV, D1_OFF_T = D1_OFF_A + 64 * D1_RSA, D1_OFF_S = D1_OFF_T + 64 * D1_RST, D1_LDS = D1_OFF_S + 512;
static_assert(D1_LDS <= 163328, "D1 LDS");
template <int SKIP = 0> __device__ __forceinline__ void dn1_item(const Ptrs& P, LAS unsigned char* lds, int item) {
    const bf16_t* __restrict__ PROJ = (const bf16_t*)(P.ws + WS_PROJ); const float* __restrict__ AB = (const float*)(P.ws + WS_AB); const float* __restrict__ cdw = P.in[IN_OD_CDW];
    bf16_t* __restrict__ Q2 = (bf16_t*)(P.ws + WS_DQ2); bf16_t* __restrict__ K2 = (bf16_t*)(P.ws + WS_DK2);
    bf16_t* __restrict__ WTg = (bf16_t*)(P.ws + WS_DWT) + (size_t)item * 8192; bf16_t* __restrict__ UTg = (bf16_t*)(P.ws + WS_DUT) + (size_t)item * 8192;
    bf16_t* __restrict__ QKg = (bf16_t*)(P.ws + WS_DQK) + (size_t)item * 4096; float* __restrict__ DECg = (float*)(P.ws + WS_DDEC) + (size_t)item * 64;
    int tid_ = threadIdx.x; asm volatile("" : "+v"(tid_));
    const int tid = tid_, lane = tid & 63, wave = tid >> 6, g = lane >> 4, l15 = lane & 15;
    const int n = item & 31, h = (item >> 5) & 7, b = item >> 8;
    const size_t tok0 = (size_t)b * SEQ + n * 64;
    LAS float* beta_s = (LAS float*)(lds + D1_OFF_S); LAS float* dec_s = beta_s + 64;
    asm volatile("" ::: "memory");
    if constexpr (!(SKIP & 1)) { const int t = tid >> 3, d16 = tid & 7, s = n * 64 + t; float qk_[2][16]; float ssq[2] = {0.f, 0.f};
#pragma unroll
      for (int pp = 0; pp < 3; ++pp) { const int p = (pp + 2) % 3;
#pragma unroll
          for (int hf = 0; hf < 2; ++hf) { const int col = p * W_D + h * 128 + 16 * d16 + 8 * hf; float a[8];
              v4u xw[4];
#pragma unroll
              for (int j = 0; j < 4; ++j) { const bool ok = (s - 3 + j >= 0); xw[j] = *(const v4u*)(PROJ + (ok ? tok0 + t - 3 + j : tok0) * OD_N + OC_QD + col); }
#pragma unroll
              for (int i = 0; i < 8; ++i) a[i] = 0.f;
#pragma unroll
              for (int j = 0; j < 4; ++j) { const float m_ = (s - 3 + j >= 0) ? 1.0f : 0.0f; const f32x4 w0 = *(const f32x4*)(cdw + j * 3 * W_D + col) * m_, w1 = *(const f32x4*)(cdw + j * 3 * W_D + col + 4) * m_; const v4u x_ = xw[j];
                  a[0] += w0[0] * __builtin_bit_cast(float, x_.x << 16); a[1] += w0[1] * __builtin_bit_cast(float, x_.x & 0xffff0000u); a[2] += w0[2] * __builtin_bit_cast(float, x_.y << 16); a[3] += w0[3] * __builtin_bit_cast(float, x_.y & 0xffff0000u);
                  a[4] += w1[0] * __builtin_bit_cast(float, x_.z << 16); a[5] += w1[1] * __builtin_bit_cast(float, x_.z & 0xffff0000u); a[6] += w1[2] * __builtin_bit_cast(float, x_.w << 16); a[7] += w1[3] * __builtin_bit_cast(float, x_.w & 0xffff0000u); }
#pragma unroll
              for (int i = 0; i < 8; ++i) a[i] = fsilu(a[i]);
              if (p < 2) {
#pragma unroll
                  for (int i = 0; i < 8; ++i) { qk_[p][8 * hf + i] = a[i]; ssq[p] += a[i] * a[i]; } }
              else { v4u w; w.x = pk2(a[0], a[1]); w.y = pk2(a[2], a[3]); w.z = pk2(a[4], a[5]); w.w = pk2(a[6], a[7]);
                  *(LAS v4u*)(lds + D1_OFF_V + t * D1_RSV + (16 * d16 + 8 * hf) * 2) = w; }
              asm volatile("" ::: "memory"); } }
#pragma unroll
      for (int p = 0; p < 2; ++p) { float ss = ssq[p]; ss += __shfl_xor(ss, 1); ss += __shfl_xor(ss, 2); ss += __shfl_xor(ss, 4); const float rs = frsq(ss + EPS);
#pragma unroll
          for (int hf = 0; hf < 2; ++hf) { v4u w; w.x = pk2(qk_[p][8 * hf + 0] * rs, qk_[p][8 * hf + 1] * rs); w.y = pk2(qk_[p][8 * hf + 2] * rs, qk_[p][8 * hf + 3] * rs);
              w.z = pk2(qk_[p][8 * hf + 4] * rs, qk_[p][8 * hf + 5] * rs); w.w = pk2(qk_[p][8 * hf + 6] * rs, qk_[p][8 * hf + 7] * rs);
              const int dd = 16 * d16 + 8 * hf;
              if (p == 0) { *(LAS v4u*)(lds + D1_OFF_Q + t * D1_RSQ + dd * 2) = w; *(v4u*)(Q2 + (tok0 + t) * W_D + h * 128 + dd) = w; }
              else { *(LAS v4u*)(lds + D1_OFF_K + t * D1_RSK + dd * 2) = w; *(v4u*)(K2 + (tok0 + t) * W_D + h * 128 + dd) = w; } } } }
    if (wave == 0) { const size_t tok = tok0 + lane;
        const float beta = fsigmoid(AB[tok * 16 + 8 + h]); float dc = -fexp(P.in[IN_OD_ALOG][h]) * softplusf_(AB[tok * 16 + h] + P.in[IN_OD_DTB][h]);
#pragma unroll
        for (int o = 1; o < 64; o <<= 1) { const float t_ = __shfl_up(dc, o); if (lane >= o) dc += t_; }
        beta_s[lane] = beta; dec_s[lane] = dc; DECg[lane] = dc; }
    __syncthreads();
    { const int tt = wave >> 1, t = 16 * tt + l15; const float dt_ = dec_s[t], bt = beta_s[t];
#pragma unroll
      for (int u = 0; u < 2; ++u) { const int st = 2 * (wave & 1) + u; unsigned long long qw = 0ull;
          if (st <= tt && !(SKIP & 2)) { f32x4 kk = (f32x4){0.f, 0.f, 0.f, 0.f}, qk = kk;
#pragma unroll
              for (int ks = 0; ks < 4; ++ks) { const bf16x8 a = frag_row(lds + D1_OFF_K, D1_RSK, 16 * st, 32 * ks, lane);
                  kk = MFMA16(a, frag_row(lds + D1_OFF_K, D1_RSK, 16 * tt, 32 * ks, lane), kk); qk = MFMA16(a, frag_row(lds + D1_OFF_Q, D1_RSQ, 16 * tt, 32 * ks, lane), qk); }
              f32x4 am; float qv[4];
#pragma unroll
              for (int r = 0; r < 4; ++r) { const int s = 16 * st + 4 * g + r; const float gam = (s <= t) ? fexp(dt_ - dec_s[s]) : 0.f; am[r] = (s < t) ? bt * kk[r] * gam : 0.f; qv[r] = qk[r] * gam * DN_SCALE; }
              *(LAS f32x4*)(lds + D1_OFF_A + t * D1_RSA + (16 * st + 4 * g) * 4) = am;
              qw = (unsigned long long)pk2(qv[0], qv[1]) | ((unsigned long long)pk2(qv[2], qv[3]) << 32); }
          *(unsigned long long*)(QKg + t * 64 + 16 * st + 4 * g) = qw; } }
    __syncthreads();
    if (wave == 0 && !(SKIP & 4)) { const int hb = lane >> 5, j = lane & 31; float col[32];
        LAS const unsigned char* Ab = lds + D1_OFF_A + (32 * hb) * D1_RSA + (32 * hb) * 4;
        SolveRows<31>::run(col, Ab, j);
        LAS unsigned char* trow = lds + D1_OFF_T + (32 * hb + j) * D1_RST;
#pragma unroll
        for (int c = 0; c < 4; ++c) { v4u w; w.x = pk2(col[8 * c], col[8 * c + 1]); w.y = pk2(col[8 * c + 2], col[8 * c + 3]); w.z = pk2(col[8 * c + 4], col[8 * c + 5]); w.w = pk2(col[8 * c + 6], col[8 * c + 7]);
            *(LAS v4u*)(trow + (32 * hb) * 2 + 16 * c) = w;
            if (hb) *(LAS v4u*)(trow + 16 * c) = (v4u){0u, 0u, 0u, 0u}; }
        bf16x8 af[2], bfr[2];
#pragma unroll
        for (int ti = 0; ti < 2; ++ti) { LAS const unsigned char* ap = lds + D1_OFF_A + (32 + 16 * ti + l15) * D1_RSA + (8 * g) * 4; const f32x4 a0 = *(LAS const f32x4*)ap, a1 = *(LAS const f32x4*)(ap + 16);
            typedef unsigned u32x4_ __attribute__((ext_vector_type(4))); const u32x4_ w = {pk2(a0[0], a0[1]), pk2(a0[2], a0[3]), pk2(a1[0], a1[1]), pk2(a1[2], a1[3])}; af[ti] = __builtin_bit_cast(bf16x8, w); }
#pragma unroll
        for (int nj = 0; nj < 2; ++nj) bfr[nj] = frag_row(lds + D1_OFF_T, D1_RST, 16 * nj, 0, lane);
        f32x4 X[2][2];
#pragma unroll
        for (int ti = 0; ti < 2; ++ti)
#pragma unroll
            for (int nj = 0; nj < 2; ++nj) X[ti][nj] = MFMA16(af[ti], bfr[nj], ((f32x4){0.f, 0.f, 0.f, 0.f}));
        LAS const unsigned char* T11b = lds + D1_OFF_T + 32 * D1_RST + 64;
#pragma unroll
        for (int nj = 0; nj < 2; ++nj) { const bf16x8 xb = acc_pair_frag(X[0][nj], X[1][nj]);
#pragma unroll
            for (int ti = 0; ti < 2; ++ti) { const f32x4 r_ = MFMA16(frag_tr_perm(T11b, D1_RST, 0, 16 * ti, lane), xb, ((f32x4){0.f, 0.f, 0.f, 0.f}));
                *(LAS unsigned long long*)(lds + D1_OFF_T + (16 * nj + l15) * D1_RST + (32 + 16 * ti + 4 * g) * 2) = (unsigned long long)pk2(-r_[0], -r_[1]) | ((unsigned long long)pk2(-r_[2], -r_[3]) << 32); } }
    }
    __syncthreads();
    if constexpr (!(SKIP & 8)) { bf16x8 bv[2], bk[2];
#pragma unroll
      for (int ks = 0; ks < 2; ++ks) { typedef unsigned u32x4_ __attribute__((ext_vector_type(4)));
          const u32x4_ wv = __builtin_bit_cast(u32x4_, frag_tr(lds + D1_OFF_V, D1_RSV, 32 * ks, 16 * wave, lane)), wk = __builtin_bit_cast(u32x4_, frag_tr(lds + D1_OFF_K, D1_RSK, 32 * ks, 16 * wave, lane));
          float fb[8], fk[8];
#pragma unroll
          for (int i = 0; i < 8; ++i) { const int s = 32 * ks + 8 * g + i; fb[i] = beta_s[s]; fk[i] = fb[i] * fexp(dec_s[s]); }
#define SC2(w_, f0, f1) pk2(__builtin_bit_cast(float, (w_) << 16) * (f0), __builtin_bit_cast(float, (w_) & 0xffff0000u) * (f1))
          const u32x4_ ov = {SC2(wv.x, fb[0], fb[1]), SC2(wv.y, fb[2], fb[3]), SC2(wv.z, fb[4], fb[5]), SC2(wv.w, fb[6], fb[7])};
          const u32x4_ ok = {SC2(wk.x, fk[0], fk[1]), SC2(wk.y, fk[2], fk[3]), SC2(wk.z, fk[4], fk[5]), SC2(wk.w, fk[6], fk[7])};
#undef SC2
          bv[ks] = __builtin_bit_cast(bf16x8, ov); bk[ks] = __builtin_bit_cast(bf16x8, ok); }
#pragma unroll
      for (int tt = 0; tt < 4; ++tt) { f32x4 u = (f32x4){0.f, 0.f, 0.f, 0.f}, wv = u;
#pragma unroll
          for (int ks = 0; ks < 2; ++ks) { const bf16x8 at = frag_tr(lds + D1_OFF_T, D1_RST, 32 * ks, 16 * tt, lane); u = MFMA16(at, bv[ks], u); wv = MFMA16(at, bk[ks], wv); }
          const size_t o_ = (size_t)(16 * wave + l15) * 64 + 16 * tt + 4 * g;
          *(unsigned long long*)(UTg + o_) = (unsigned long long)pk2(u[0], u[1]) | ((unsigned long long)pk2(u[2], u[3]) << 32);
          *(unsigned long long*)(WTg + o_) = (unsigned long long)pk2(wv[0], wv[1]) | ((unsigned long long)pk2(wv[2], wv[3]) << 32); } }
    __syncthreads();
}
constexpr int D2_RSW = 144, D2_RSQ = 272, D2_RSK = 288, D2_RSP = 144, D2_RSO = 528;
constexpr int D2_OFF_W = 0, D2_OFF_Q = D2_OFF_W + 128 * D2_RSW, D2_OFF_K = D2_OFF_Q + 64 * D2_RSQ, D2_OFF_P = D2_OFF_K + 64 * D2_RSK, D2_OFF_O = D2_OFF_P + 64 * D2_RSP, D2_OFF_D = D2_OFF_O + 64 * D2_RSO, D2_LDS = D2_OFF_D + 1024;
static_assert(D2_LDS <= 163328, "D2 LDS");
template <int SKIP = 0> __device__ __forceinline__ void dn2_item(const Ptrs& P, LAS unsigned char* lds, int item, size_t yoff = WS_Y) {
    const bf16_t* __restrict__ PROJ = (const bf16_t*)(P.ws + WS_PROJ); bf16_t* __restrict__ Y = (bf16_t*)(P.ws + yoff);
    const bf16_t* __restrict__ Q2 = (const bf16_t*)(P.ws + WS_DQ2); const bf16_t* __restrict__ K2 = (const bf16_t*)(P.ws + WS_DK2);
    const int tid = threadIdx.x, lane = tid & 63, wave = tid >> 6, g = lane >> 4, l15 = lane & 15;
    const int h = item & 7, b = item >> 3;
    const size_t tok0 = (size_t)b * SEQ; const int it0 = item * 32;
    const bf16_t* __restrict__ WTg = (const bf16_t*)(P.ws + WS_DWT) + (size_t)it0 * 8192; const bf16_t* __restrict__ UTg = (const bf16_t*)(P.ws + WS_DUT) + (size_t)it0 * 8192;
    const bf16_t* __restrict__ QKg = (const bf16_t*)(P.ws + WS_DQK) + (size_t)it0 * 4096; const float* __restrict__ DECg = (const float*)(P.ws + WS_DDEC) + (size_t)it0 * 64;
    LAS float* ed_s = (LAS float*)(lds + D2_OFF_D); LAS float* ek_s = ed_s + 64; LAS float* edl_s = ed_s + 128;
    f32x4 sacc[8];
#pragma unroll
    for (int i = 0; i < 8; ++i) sacc[i] = (f32x4){0.f, 0.f, 0.f, 0.f};
    const int ot = tid >> 3, oc = (tid & 7) * 16;
    float og[16];
#pragma unroll
    for (int i = 0; i < 16; ++i) og[i] = P.in[IN_OD_ONORM][oc + i];
    v4u wreg[2], qreg[2], kreg[2], preg, zreg[2]; unsigned long long ureg[4]; float dreg = 0.f, dlreg = 0.f;
#define D2_LOAD(n) do { _Pragma("unroll") for (int i_ = 0; i_ < 2; ++i_) { const int id_ = tid + 512 * i_; wreg[i_] = *(const v4u*)(WTg + (size_t)(n) * 8192 + id_ * 8); \
            const int row_ = id_ >> 4, ch_ = id_ & 15; const size_t o2_ = (tok0 + (n) * 64 + row_) * W_D + h * 128 + ch_ * 8; qreg[i_] = *(const v4u*)(Q2 + o2_); kreg[i_] = *(const v4u*)(K2 + o2_); } \
        preg = *(const v4u*)(QKg + (size_t)(n) * 4096 + tid * 8); \
        _Pragma("unroll") for (int tt_ = 0; tt_ < 4; ++tt_) ureg[tt_] = *(const unsigned long long*)(UTg + (size_t)(n) * 8192 + (16 * wave + l15) * 64 + 16 * tt_ + 4 * g); \
        if (tid < 64) { dreg = DECg[(n) * 64 + tid]; dlreg = DECg[(n) * 64 + 63]; } } while (0)
#define D2_LOAD_Z(n) do { const bf16_t* zp_ = PROJ + (tok0 + (n) * 64 + ot) * OD_N + OC_ZD + h * 128 + oc; zreg[0] = *(const v4u*)zp_; zreg[1] = *(const v4u*)(zp_ + 8); } while (0)
#define D2_STORE() do { _Pragma("unroll") for (int i_ = 0; i_ < 2; ++i_) { const int id_ = tid + 512 * i_; *(LAS v4u*)(lds + D2_OFF_W + (id_ >> 3) * D2_RSW + (id_ & 7) * 16) = wreg[i_]; \
            const int row_ = id_ >> 4, ch_ = id_ & 15; *(LAS v4u*)(lds + D2_OFF_Q + row_ * D2_RSQ + ch_ * 16) = qreg[i_]; *(LAS v4u*)(lds + D2_OFF_K + row_ * D2_RSK + ch_ * 16) = kreg[i_]; } \
        *(LAS v4u*)(lds + D2_OFF_P + (tid >> 3) * D2_RSP + (tid & 7) * 16) = preg; \
        if (tid < 64) { ed_s[tid] = fexp(dreg) * DN_SCALE; ek_s[tid] = fexp(dlreg - dreg); if (tid == 0) edl_s[0] = fexp(dlreg); } } while (0)
    D2_LOAD(0);
    for (int n = 0; n < NCH; ++n) {
        if constexpr (!(SKIP & 16)) D2_STORE();
        f32x4 un[4];
#pragma unroll
        for (int tt = 0; tt < 4; ++tt) { un[tt][0] = __builtin_bit_cast(float, (unsigned)(ureg[tt] & 0xffffull) << 16); un[tt][1] = __builtin_bit_cast(float, (unsigned)(ureg[tt] >> 16 & 0xffffull) << 16);
            un[tt][2] = __builtin_bit_cast(float, (unsigned)(ureg[tt] >> 32 & 0xffffull) << 16); un[tt][3] = __builtin_bit_cast(float, (unsigned)(ureg[tt] >> 48) << 16); }
        __syncthreads();
        if constexpr (!(SKIP & 16)) { if (n + 1 < NCH) D2_LOAD(n + 1); }
        bf16x8 sf[4];
#pragma unroll
        for (int j = 0; j < 4; ++j) sf[j] = acc_pair_frag(sacc[2 * j], sacc[2 * j + 1]);
        f32x4 vn[4], o[4];
#pragma unroll
        for (int tt = 0; tt < 4; ++tt) { f32x4 ws_ = (f32x4){0.f, 0.f, 0.f, 0.f}, qs_ = ws_;
#pragma unroll
            for (int j = 0; j < ((SKIP & 2) ? 0 : 4); ++j) { ws_ = MFMA16(frag_tr_perm(lds + D2_OFF_W, D2_RSW, 32 * j, 16 * tt, lane), sf[j], ws_); qs_ = MFMA16(frag_row_perm(lds + D2_OFF_Q, D2_RSQ, 16 * tt, 32 * j, lane), sf[j], qs_); }
            vn[tt] = un[tt] - ws_; o[tt] = qs_ * *(LAS const f32x4*)(ed_s + 16 * tt + 4 * g); }
        __builtin_amdgcn_sched_barrier(0);
        bf16x8 vf[2], vsf[2];
#pragma unroll
        for (int ks = 0; ks < 2; ++ks) { vf[ks] = acc_pair_frag(vn[2 * ks], vn[2 * ks + 1]);
            const f32x4 a_ = vn[2 * ks] * *(LAS const f32x4*)(ek_s + 32 * ks + 4 * g), b_ = vn[2 * ks + 1] * *(LAS const f32x4*)(ek_s + 32 * ks + 16 + 4 * g);
            vsf[ks] = acc_pair_frag(a_, b_); }
#pragma unroll
        for (int tt = 0; tt < 4; ++tt)
#pragma unroll
            for (int ks = 0; ks < ((SKIP & 4) ? 0 : 2); ++ks) o[tt] = MFMA16(frag_row_perm(lds + D2_OFF_P, D2_RSP, 16 * tt, 32 * ks, lane), vf[ks], o[tt]);
#pragma unroll
        for (int tt = 0; tt < 4; ++tt)
#pragma unroll
            for (int r = 0; r < 4; ++r) *(LAS float*)(lds + D2_OFF_O + (16 * tt + 4 * g + r) * D2_RSO + (16 * wave + l15) * 4) = o[tt][r];
        __builtin_amdgcn_sched_barrier(0);
        if constexpr (!(SKIP & 1)) D2_LOAD_Z(n);
        { const float edl = edl_s[0];
#pragma unroll
          for (int kt = 0; kt < ((SKIP & 8) ? 0 : 8); ++kt) { sacc[kt] *= edl;
#pragma unroll
              for (int ks = 0; ks < 2; ++ks) sacc[kt] = MFMA16(frag_tr_perm(lds + D2_OFF_K, D2_RSK, 32 * ks, 16 * kt, lane), vsf[ks], sacc[kt]);
              if ((kt & 3) == 3) __builtin_amdgcn_sched_barrier(0); }
#pragma unroll
          for (int kt = 0; kt < 8; ++kt) asm volatile("" : "+v"(sacc[kt])); }
        __syncthreads();
        if constexpr (!(SKIP & 1)) { f32x4 ov[4]; float ss = 0.f;
#pragma unroll
          for (int c = 0; c < 4; ++c) { ov[c] = *(LAS const f32x4*)(lds + D2_OFF_O + ot * D2_RSO + (oc + 4 * c) * 4); ss += (ov[c][0] * ov[c][0] + ov[c][1] * ov[c][1]) + (ov[c][2] * ov[c][2] + ov[c][3] * ov[c][3]); }
          ss += __shfl_xor(ss, 1); ss += __shfl_xor(ss, 2); ss += __shfl_xor(ss, 4);
          const float rs = frsq(ss * (1.0f / 128.0f) + EPS);
          bf16_t* yp = Y + (tok0 + n * 64 + ot) * D_MODEL + W_C + h * 128 + oc;
#pragma unroll
          for (int c = 0; c < 2; ++c) { const v4u zw = zreg[c]; const f32x4 a = ov[2 * c], b_ = ov[2 * c + 1];
#define D2_Y(ov_, gi, zx, lo) ((ov_) * rs * og[gi] * fsilu(__builtin_bit_cast(float, (lo) ? ((zx) << 16) : ((zx) & 0xffff0000u))))
              v4u yw; yw.x = pk2(D2_Y(a[0], 8 * c + 0, zw.x, 1), D2_Y(a[1], 8 * c + 1, zw.x, 0)); yw.y = pk2(D2_Y(a[2], 8 * c + 2, zw.y, 1), D2_Y(a[3], 8 * c + 3, zw.y, 0));
              yw.z = pk2(D2_Y(b_[0], 8 * c + 4, zw.z, 1), D2_Y(b_[1], 8 * c + 5, zw.z, 0)); yw.w = pk2(D2_Y(b_[2], 8 * c + 6, zw.w, 1), D2_Y(b_[3], 8 * c + 7, zw.w, 0));
#undef D2_Y
              *(v4u*)(yp + 8 * c) = yw; } }
    }
#undef D2_LOAD
#undef D2_LOAD_Z
#undef D2_STORE
    __syncthreads();
}
__device__ __forceinline__ void phase_mix0(const Ptrs& P, LAS unsigned char* lds, int G) {
    const int w = blockIdx.x;
    constexpr int NML = BATCH * H_B * 4;
    if (w < NML) mlstm_item(P, lds, w);
    else if (G - NML == 128) {
        const int wa = w - NML, bhp = wa >> 2, k0 = wa & 3;
        for (int k = 3; k >= 0; --k) attn2_item(P, lds, bhp * 16 + 4 * k + k0); }
    else { for (int item = w - NML; item < BATCH * H_A * (NCH / 2); item += G - NML) attn_item(P, lds, item); }
    { const int wave = threadIdx.x >> 6, lane = threadIdx.x & 63; late_weights(P, lds, wave, lane, w * NWAVES + wave, G * NWAVES); }
}
__device__ __forceinline__ void phase_mix1a(const Ptrs& P, LAS unsigned char* lds, int G) {
    const int w = blockIdx.x; constexpr int ND1 = BATCH * H_D * NCH, NRG = BATCH * N_BLK_C * 4;
    if (G == 256) {
        if (w < 64) rglru_item<0>(P, lds, 192 + w);
        else { const int wd = w - 64; const int cnt = wd < 128 ? 11 : 10, first = wd < 128 ? wd * 11 : 1408 + (wd - 128) * 10;
            for (int i = 0; i < cnt; ++i) dn1_item(P, lds, first + i); }
    } else {
        for (int it = 192 + w; it < NRG; it += G) rglru_item<0>(P, lds, it);
        for (int it = w; it < ND1; it += G) dn1_item(P, lds, it); }
}
__device__ __forceinline__ void phase_mix1b(const Ptrs& P, LAS unsigned char* lds, int G) {
    constexpr int ND2 = BATCH * H_D;
    if ((int)blockIdx.x < ND2) dn2_item(P, lds, blockIdx.x);
    else { for (int it = blockIdx.x - ND2; it < 192; it += G - ND2) rglru_item<0>(P, lds, it);
        const int wave = threadIdx.x >> 6, lane = threadIdx.x & 63; last_weight(P, lds, wave, lane, (blockIdx.x - ND2) * NWAVES + wave, (G - ND2) * NWAVES); }
}
typedef GAS unsigned gu32;
#define RLX_AGENT __ATOMIC_RELAXED, __HIP_MEMORY_SCOPE_AGENT
constexpr int CW_BAR = 4096;
static_assert((CW_BAR + XCD_BAR_WORDS) * 4 <= (int)CTL_ZERO_BYTES, "CTL words inside the memset region");
constexpr int LDS_BYTES = 163840;
constexpr int RING_OFF = 0, RING_BYTES = LDS_BYTES - 512;
constexpr int LDSCTL_OFF = RING_BYTES, MISC_OFF = LDSCTL_OFF + 320;

struct Args { Ptrs P; int ph_lo, ph_hi; };
constexpr int N_PHASES = 8;

__global__ void __launch_bounds__(NWAVES * 64, 2) fwd_mega(Args args) {
    extern __shared__ __attribute__((aligned(16))) unsigned char lds_raw[];
    LAS unsigned char* lds = (LAS unsigned char*)lds_raw;
    volatile LAS unsigned* MISC = (volatile LAS unsigned*)(lds + MISC_OFF);
    const int tid = threadIdx.x, lane = tid & 63, wave = __builtin_amdgcn_readfirstlane(tid >> 6);
    const int G = gridDim.x;
    for (int u = tid; u < (LDS_BYTES - LDSCTL_OFF) / 4; u += NWAVES * 64) ((LAS unsigned*)(lds + LDSCTL_OFF))[u] = 0u;
    __syncthreads();
    const Ptrs& P = args.P;
    gu32* ctl = (gu32*)(P.ws + WS_CTL);
    const int lo = args.ph_lo, hi = args.ph_hi;
    XcdBarrier bar; bar.bar = (unsigned*)(ctl + CW_BAR); bar.x = 0; bar.st = nullptr;
    if (hi - lo > 1) bar = xcd_barrier_post((unsigned*)(ctl + CW_BAR), MISC + 8);
#define IN(k) (lo <= (k) && (k) < hi)
#define SEAM(k) do { if (IN(k) && IN((k) + 1)) xcd_barrier(bar); } while (0)
#ifndef DUP_PHASE
#define DUP_PHASE -1
#endif
#define RUN(k) do { \
    if ((k) == 0) phase_prologue(P, lds, wave, lane, blockIdx.x * NWAVES + wave, G * NWAVES); \
    else if ((k) == 1) phase_gemm<1>(P, lds, G, blockIdx.x); \
    else if ((k) == 2) phase_mix0(P, lds, G); \
    else if ((k) == 3) phase_gemm<2>(P, lds, G, blockIdx.x); \
    else if ((k) == 4) { phase_gemm<3>(P, lds, G, blockIdx.x); phase_gates_ab(P, G); } \
    else if ((k) == 5) phase_mix1a(P, lds, G); \
    else if ((k) == 6) phase_mix1b(P, lds, G); \
    else phase_gemm<4>(P, lds, G, blockIdx.x); } while (0)
#define STEP(k) do { if (IN(k)) { if ((k) == 5 && DUP_PHASE >= 5000 && DUP_PHASE < 5016) { for (int it_ = blockIdx.x; it_ < BATCH * H_D * NCH; it_ += G) dn1_item<(DUP_PHASE >= 5000 ? DUP_PHASE - 5000 : 0)>(P, lds, it_); xcd_barrier(bar); } RUN(k); if (DUP_PHASE == (k)) { xcd_barrier(bar); RUN(k); } \
        if ((k) == 2 && DUP_PHASE == 20) { xcd_barrier(bar); if (blockIdx.x >= 128) phase_mix0(P, lds, G); } \
        if ((k) == 2 && DUP_PHASE == 21) { xcd_barrier(bar); if (blockIdx.x < 128) phase_mix0(P, lds, G); } \
        if ((k) == 2 && DUP_PHASE >= 2000 && DUP_PHASE < 2128) { xcd_barrier(bar); if (blockIdx.x >= 128) { const int wa_ = blockIdx.x - 128; for (int k_ = 3; k_ >= 0; --k_) attn2_item<(DUP_PHASE >= 2000 ? DUP_PHASE - 2000 : 0)>(P, lds, (wa_ >> 2) * 16 + 4 * k_ + (wa_ & 3), WS_XB); } } \
        if ((k) == 2 && DUP_PHASE >= 1000 && DUP_PHASE < 1128) { xcd_barrier(bar); if (blockIdx.x < 128) mlstm_item<(DUP_PHASE >= 1000 ? DUP_PHASE - 1000 : 0)>(P, lds, blockIdx.x, WS_XB); } \
        if ((k) == 6 && DUP_PHASE >= 3000 && DUP_PHASE < 3032) { xcd_barrier(bar); if (blockIdx.x < 64) dn2_item<(DUP_PHASE >= 3000 ? DUP_PHASE - 3000 : 0)>(P, lds, blockIdx.x, 420 * MiB); } \
        if ((k) == 6 && DUP_PHASE >= 4000 && DUP_PHASE < 4032) { xcd_barrier(bar); rglru_item<(DUP_PHASE >= 4000 ? DUP_PHASE - 4000 : 0)>(P, lds, blockIdx.x, 420 * MiB); } \
        if ((k) == 5 && DUP_PHASE == 50) { xcd_barrier(bar); for (int it_ = blockIdx.x; it_ < BATCH * N_BLK_C * 4; it_ += G) rglru_item<0>(P, lds, it_); } \
        if ((k) == 5 && DUP_PHASE == 51) { xcd_barrier(bar); phase_mix1a(P, lds, G); } \
        } SEAM(k); } while (0)
    STEP(0); STEP(1); STEP(2); STEP(3); STEP(4); STEP(5); STEP(6); STEP(7);
#undef STEP
#undef RUN
#undef IN
#undef SEAM
}
extern "C" void kernel_launch(void* const* d_in, const int* in_sizes, int n_in, void* d_out, int out_size, void* d_ws, size_t ws_size, hipStream_t stream) {
    static int grid = 0;
    if (grid == 0) {
        if (n_in != 20 || in_sizes[0] != M_TOK * D_MODEL || out_size != M_TOK * D_MODEL || ws_size < WS_END) {
            fprintf(stderr, "kernel_launch: unexpected shapes: n_in %d in0 %d out %d ws %zu (need %zu)\n", n_in, n_in > 0 ? in_sizes[0] : -1, out_size, ws_size, (size_t)WS_END); grid = -1; return; }
        int dev = 0, cus = 0, per_cu = 0;
        if (hipGetDevice(&dev) != hipSuccess || hipDeviceGetAttribute(&cus, hipDeviceAttributeMultiprocessorCount, dev) != hipSuccess) { grid = -1; return; }
        if (hipFuncSetAttribute((const void*)fwd_mega, hipFuncAttributeMaxDynamicSharedMemorySize, LDS_BYTES) != hipSuccess) { fprintf(stderr, "kernel_launch: hipFuncSetAttribute failed\n"); grid = -1; return; }
        if (hipOccupancyMaxActiveBlocksPerMultiprocessor(&per_cu, (const void*)fwd_mega, NWAVES * 64, LDS_BYTES) != hipSuccess || per_cu < 1) { fprintf(stderr, "kernel_launch: occupancy query says %d blocks per CU\n", per_cu); per_cu = 1; }
        (void)hipGetLastError();
        grid = cus;
    }
    if (grid < 0) return;
    if (hipMemsetAsync((char*)d_ws + WS_CTL, 0, CTL_ZERO_BYTES, stream) != hipSuccess) { fprintf(stderr, "kernel_launch: memset failed\n"); return; }
    Args a{};
    for (int i = 0; i < 20; ++i) a.P.in[i] = (const float*)d_in[i];
    a.P.out = (float*)d_out; a.P.ws = (unsigned char*)d_ws; a.ph_lo = 0; a.ph_hi = N_PHASES;
    hipLaunchKernelGGL(fwd_mega, dim3(grid), dim3(NWAVES * 64), LDS_BYTES, stream, a);
    const hipError_t le = hipPeekAtLastError();
    if (le != hipSuccess) fprintf(stderr, "kernel_launch: launch failed: %s\n", hipGetErrorName(le));
}
```

```cpp
#include <hip/hip_runtime.h>
#include <cstdio>
#include <cstdint>
#include <cmath>
#include <type_traits>

constexpr int D_MODEL = 2048, BATCH = 8, SEQ = 2048, M_TOK = BATCH * SEQ;
constexpr int CHUNK = 64, NCH = SEQ / CHUNK;
constexpr float EPS = 1e-6f;
constexpr int HD_A = 128, W_A = 1024, H_A = 8, LOOKBACK = 8, BAND = (LOOKBACK + 1) * CHUNK, REL_MAX = 256, NREL = 2 * REL_MAX + 1;
constexpr int H_B = 4, W_B = 1024, HD_B = 256;
constexpr int W_C = 1024, N_BLK_C = 8, BLK_C = 128;
constexpr int HD_D = 128, W_D = 1024, H_D = 8;
constexpr int EV_IN = 9224, EV_N = 9216;
constexpr int OD_IN = 6160, OD_N = 6144;
constexpr int EC_QA = 0, EC_KA = 1024, EC_VA = 2048, EC_ZA = 3072, EC_QB = 4096, EC_KB = 5120, EC_VB = 6144, EC_OB = 7168, EC_ZB = 8192;
constexpr int OC_XC = 0, OC_ZC = 1024, OC_QD = 2048, OC_KD = 3072, OC_VD = 4096, OC_ZD = 5120;

constexpr size_t MiB = 1u << 20;
constexpr size_t WS_CTL = 0, CTL_ZERO_BYTES = 1 * MiB;
constexpr size_t WS_R0 = 1 * MiB;
constexpr size_t WS_SS1 = WS_R0 + 64 * 1024;
constexpr size_t WS_GIF = WS_SS1 + 64 * 1024;
constexpr size_t WS_AB = WS_GIF + 512 * 1024;
constexpr size_t WS_W1T = 4 * MiB;
constexpr size_t WS_W2T = 40 * MiB;
constexpr size_t WS_W3T = 48 * MiB;
constexpr size_t WS_W4T = 73 * MiB;
constexpr size_t WS_XB = 81 * MiB;
constexpr size_t WS_Y = 145 * MiB;
constexpr size_t WS_PROJ = 209 * MiB;
constexpr size_t WS_END = 497 * MiB;
constexpr size_t WS_FREE1 = 401 * MiB;

typedef unsigned short bf16_t;
__device__ __forceinline__ float bf2f(unsigned short v) { return __builtin_bit_cast(float, (unsigned)v << 16); }
__device__ __forceinline__ unsigned f2bf(float f) { unsigned u = __builtin_bit_cast(unsigned, f); return (u + 0x7fffu + ((u >> 16) & 1u)) >> 16; }
typedef float f32x2_t_ __attribute__((ext_vector_type(2))); typedef __bf16 bf16x2_t_ __attribute__((ext_vector_type(2)));
__device__ __forceinline__ unsigned pk2(float lo, float hi) { const f32x2_t_ v = {lo, hi}; return __builtin_bit_cast(unsigned, __builtin_convertvector(v, bf16x2_t_)); }
__device__ __forceinline__ float sigmoidf_(float x) { return 1.f / (1.f + expf(-x)); }
__device__ __forceinline__ float siluf_(float x) { return x / (1.f + expf(-x)); }
__device__ __forceinline__ float softplusf_(float x) { return fmaxf(x, 0.f) + log1pf(expf(-fabsf(x))); }
__device__ __forceinline__ float logsigmoidf_(float x) { return -softplusf_(-x); }

namespace pg8 {
#define PG8_LAS __attribute__((address_space(3)))
typedef unsigned short bf16_t;
typedef short bf16x8 __attribute__((ext_vector_type(8)));
typedef float f32x4 __attribute__((ext_vector_type(4)));
typedef unsigned u32x4 __attribute__((ext_vector_type(4)));
constexpr int BM = 256, BK = 64, HALF = 128, HTB = HALF * BK * 2  , STAGE_BYTES = 8 * HTB, NXCD = 8, WGM = 4;

__host__ __device__ __forceinline__ int lds_byte(int r, int c) { const int st = (r >> 4) * 2 + (c >> 5), rr = r & 15, cc = c & 31, ob = rr * 64 + cc * 2; return st * 1024 + (ob ^ (((ob >> 9) & 1) << 5)); }
__host__ __device__ __forceinline__ void stage_rc(int b, int& R, int& C) { const int st = b / 1024, sb = b % 1024, swz = sb ^ (((sb >> 9) & 1) << 5); R = (st >> 1) * 16 + swz / 64; C = (st & 1) * 32 + (swz % 64) / 2; }
__host__ __device__ __forceinline__ int perm32(int rho) { const int n = rho >> 4, i = rho & 15; return 8 * (i >> 2) + 4 * n + (i & 3); }

struct Unit { int pm, pn; };
struct Gemm { const bf16_t* A; const bf16_t* Bt; int M, N, K; };

struct StaticOrder {
    int nM, nN, nwg, G, c;
    __host__ __device__ void init(int M, int N, int G_, int c_) { nM = M / BM; nN = N / BM; nwg = nM * nN; G = G_; c = c_; }
    __host__ __device__ bool next(int i, Unit& u) const {
        const long L = (long)i * G + c; if (L >= nwg) return false;
        int wgid = (int)L; { const int q = nwg / NXCD, r = nwg % NXCD, xcd = wgid % NXCD, off = wgid / NXCD; wgid = (xcd < r ? xcd * (q + 1) : r * (q + 1) + (xcd - r) * q) + off; }
        const int nig = WGM * nN, gid = wgid / nig, fm = gid * WGM, gsz = (nM - fm) < WGM ? (nM - fm) : WGM;
        u.pm = fm + ((wgid % nig) % gsz); u.pn = (wgid % nig) / gsz; return true;
    }
    __device__ __forceinline__ void a_ready(const Unit&) const {}
    __device__ __forceinline__ void done(const Unit&) const {}
};

__device__ __forceinline__ unsigned cvt_pk_bf16(float lo, float hi) { unsigned r; asm volatile("v_cvt_pk_bf16_f32 %0, %1, %2" : "=v"(r) : "v"(lo), "v"(hi)); return r; }
struct EpiProj {
    static constexpr bool PERM = true, AFTER_DRAIN = false;
    bf16_t* O; int ldc; const float* rowv; int mode;
    __device__ __forceinline__ void operator()(const f32x4 (&acc)[2][2][4][2], const Unit& u, int wr, int wc, int fr, int fq) const {
        const int row0 = u.pm * BM + wr * 64 + fr; const int col0 = u.pn * BM + wc * 32 + 8 * fq;
#pragma unroll
        for (int ai = 0; ai < 2; ++ai)
#pragma unroll
            for (int m = 0; m < 4; ++m) { const int row = row0 + ai * HALF + m * 16; float sc = rowv[row]; if (mode) sc = 1.0f / sqrtf(sc * (1.0f / 2048.0f) + 1e-6f);
                bf16_t* rowp = O + (size_t)row * ldc + col0;
#pragma unroll
                for (int bj = 0; bj < 2; ++bj) { const f32x4 v0 = acc[ai][bj][m][0] * sc, v1 = acc[ai][bj][m][1] * sc;
                    u32x4 w; w.x = cvt_pk_bf16(v0[0], v0[1]); w.y = cvt_pk_bf16(v0[2], v0[3]); w.z = cvt_pk_bf16(v1[0], v1[1]); w.w = cvt_pk_bf16(v1[2], v1[3]);
                    *(u32x4*)(rowp + bj * HALF) = w; } }
    }
};
struct EpiRes {
    static constexpr bool PERM = false, AFTER_DRAIN = false;
    const float* base; float* out; bf16_t* xb; float* sumsq; int ldc;
    __device__ __forceinline__ void operator()(const f32x4 (&acc)[2][2][4][2], const Unit& u, int wr, int wc, int fr, int fq) const {
        typedef unsigned u32x2v __attribute__((ext_vector_type(2)));
        const int col0 = u.pn * BM + wc * 32 + 4 * fq;
#pragma unroll
        for (int ai = 0; ai < 2; ++ai)
#pragma unroll
            for (int m = 0; m < 4; ++m) { const int row = u.pm * BM + ai * HALF + wr * 64 + m * 16 + fr; const size_t off = (size_t)row * ldc + col0; float ss = 0.f;
#pragma unroll
                for (int bj = 0; bj < 2; ++bj)
#pragma unroll
                    for (int n = 0; n < 2; ++n) { const f32x4 o = *(const f32x4*)(base + off + bj * HALF + n * 16) + acc[ai][bj][m][n];
                        *(f32x4*)(out + off + bj * HALF + n * 16) = o;
                        if (xb) { u32x2v w; w.x = cvt_pk_bf16(o[0], o[1]); w.y = cvt_pk_bf16(o[2], o[3]); *(u32x2v*)(xb + off + bj * HALF + n * 16) = w; }
                        ss += (o[0] * o[0] + o[1] * o[1]) + (o[2] * o[2] + o[3] * o[3]); }
                if (sumsq) { ss += __shfl_xor(ss, 16); ss += __shfl_xor(ss, 32); if (fq == 0) atomicAdd(sumsq + row, ss); } }
    }
};

template <class Epi, class Sched, bool ALIGN_EPI = false, bool SP2 = false>
__device__ __forceinline__ void gemm_phase(PG8_LAS unsigned char* lds, const Gemm g, const Sched& S, const Epi& E) {
    const int tid = threadIdx.x, wid = __builtin_amdgcn_readfirstlane(tid >> 6), lane = tid & 63, wr = wid >> 2, wc = wid & 3, fr = lane & 15, fq = lane >> 4;
    const int K = g.K, nt = K / BK;
    unsigned voffA[2], voffB[2];
#pragma unroll
    for (int i = 0; i < 2; ++i) { int R, C; stage_rc(tid * 16 + i * 8192, R, C); const int Rb = Epi::PERM ? ((R & ~31) + perm32(R & 31)) : R;
        voffA[i] = (unsigned)(R * K + C) * 2u; voffB[i] = (unsigned)(Rb * K + C) * 2u; }
    const size_t kstep = (size_t)(BK * 2);
    const size_t hstep = (size_t)HALF * K * 2;
    const size_t tstep = 2 * hstep;
    const unsigned ldsw = (unsigned)wid * 1024u;
    const int aoff = lds_byte(wr * 64 + fr, fq * 8), boff = lds_byte(wc * 32 + fr, fq * 8);
#define PG8_SA(b, h) (((b) * 2 + (h)) * HTB)
#define PG8_SB(b, h) ((4 + (b) * 2 + (h)) * HTB)
#define PG8_STAGE(bufoff, gbase, voff) do { _Pragma("unroll") for (int _i = 0; _i < 2; ++_i) \
        __builtin_amdgcn_global_load_lds((const unsigned*)((const char*)(gbase) + (voff)[_i]), (PG8_LAS unsigned*)(lds + (bufoff) + ldsw + _i * 8192), 16, 0, 0); } while (0)
#define PG8_LDA(dst, b, h) do { _Pragma("unroll") for (int m = 0; m < 4; ++m) _Pragma("unroll") for (int k = 0; k < 2; ++k) dst[m][k] = *(const PG8_LAS bf16x8*)(lds + PG8_SA(b, h) + aoff + m * 2048 + k * 1024); } while (0)
#define PG8_LDB(dst, b, h) do { _Pragma("unroll") for (int n = 0; n < 2; ++n) _Pragma("unroll") for (int k = 0; k < 2; ++k) dst[n][k] = *(const PG8_LAS bf16x8*)(lds + PG8_SB(b, h) + boff + n * 2048 + k * 1024); } while (0)
#define PG8_MMA(ai, bj, At, Bt) do { __builtin_amdgcn_s_setprio(1); _Pragma("unroll") for (int m = 0; m < 4; ++m) _Pragma("unroll") for (int n = 0; n < 2; ++n) _Pragma("unroll") for (int k = 0; k < 2; ++k) \
        acc[ai][bj][m][n] = __builtin_amdgcn_mfma_f32_16x16x32_bf16(Bt[n][k], At[m][k], acc[ai][bj][m][n], 0, 0, 0); __builtin_amdgcn_s_setprio(0); } while (0)
#define PG8_WAIT_V(n) asm volatile("s_waitcnt vmcnt(" #n ")" ::: "memory")
#define PG8_WAIT_L(n) asm volatile("s_waitcnt lgkmcnt(" #n ")" ::: "memory")
#define PG8_BAR __builtin_amdgcn_s_barrier()
#define PG8_SCHED __builtin_amdgcn_sched_barrier(0)
    Unit cur, nxt; int ui = 0;
    if (!S.next(0, cur)) return;
    f32x4 acc[2][2][4][2];
#pragma unroll
    for (int a = 0; a < 2; ++a)
#pragma unroll
        for (int b = 0; b < 2; ++b)
#pragma unroll
            for (int m = 0; m < 4; ++m)
#pragma unroll
                for (int n = 0; n < 2; ++n) acc[a][b][m][n] = (f32x4){0.f, 0.f, 0.f, 0.f};
    bf16x8 At[4][2], B0[2][2], B1[2][2];
    const char* cA = (const char*)g.A + (size_t)cur.pm * tstep; const char* cB = (const char*)g.Bt + (size_t)cur.pn * tstep;
    S.a_ready(cur);
    if constexpr (SP2) {
        PG8_STAGE(PG8_SB(0, 0), cB, voffB); PG8_STAGE(PG8_SB(0, 1), cB + hstep, voffB); PG8_STAGE(PG8_SA(0, 0), cA, voffA); PG8_STAGE(PG8_SA(0, 1), cA + hstep, voffA);
        if (wr == 1) PG8_BAR;
        PG8_WAIT_V(2); PG8_BAR;
        PG8_STAGE(PG8_SB(1, 0), cB + kstep, voffB); PG8_STAGE(PG8_SA(1, 0), cA + kstep, voffA); PG8_STAGE(PG8_SB(1, 1), cB + hstep + kstep, voffB);
        PG8_WAIT_V(6); PG8_BAR;
    } else {
        PG8_STAGE(PG8_SB(0, 0), cB, voffB); PG8_STAGE(PG8_SA(0, 0), cA, voffA); PG8_STAGE(PG8_SB(0, 1), cB + hstep, voffB); PG8_STAGE(PG8_SA(0, 1), cA + hstep, voffA);
        if (wr == 1) PG8_BAR;
        PG8_WAIT_V(4); PG8_BAR;
        PG8_STAGE(PG8_SB(1, 0), cB + kstep, voffB); PG8_STAGE(PG8_SA(1, 0), cA + kstep, voffA); PG8_STAGE(PG8_SB(1, 1), cB + hstep + kstep, voffB);
        PG8_WAIT_V(6); PG8_BAR;
    }
    for (;;) {
        const bool has_next = S.next(ui + 1, nxt);
        const char* nA = has_next ? (const char*)g.A + (size_t)nxt.pm * tstep : cA; const char* nB = has_next ? (const char*)g.Bt + (size_t)nxt.pn * tstep : cB;
        for (int t = 0; t < nt; t += 2) {
            const bool last = (t == nt - 2);
            const char* a1 = cA + (size_t)(t + 1) * kstep;
            const char* a2 = last ? nA : cA + (size_t)(t + 2) * kstep; const char* b2 = last ? nB : cB + (size_t)(t + 2) * kstep;
            const char* a3 = a2 + kstep; const char* b3 = b2 + kstep;
            if (last && has_next) S.a_ready(nxt);
            if constexpr (SP2) {
            PG8_LDB(B0, 0, 0); PG8_LDB(B1, 0, 1); PG8_SCHED; PG8_LDA(At, 0, 0); PG8_STAGE(PG8_SA(1, 1), a1 + hstep, voffA);
            PG8_WAIT_V(8); PG8_WAIT_L(0); PG8_BAR; PG8_MMA(0, 0, At, B0); PG8_MMA(0, 1, At, B1); PG8_BAR; PG8_SCHED;
            PG8_LDA(At, 0, 1); PG8_STAGE(PG8_SB(0, 0), b2, voffB); PG8_STAGE(PG8_SB(0, 1), b2 + hstep, voffB); PG8_STAGE(PG8_SA(0, 0), a2, voffA);
            PG8_WAIT_V(8); PG8_WAIT_L(0); PG8_BAR; PG8_MMA(1, 0, At, B0); PG8_MMA(1, 1, At, B1); PG8_BAR; PG8_SCHED;
            PG8_LDB(B0, 1, 0); PG8_LDB(B1, 1, 1); PG8_SCHED; PG8_LDA(At, 1, 0); PG8_STAGE(PG8_SA(0, 1), a2 + hstep, voffA);
            PG8_WAIT_V(8); PG8_WAIT_L(0); PG8_BAR; PG8_MMA(0, 0, At, B0); PG8_MMA(0, 1, At, B1); PG8_BAR; PG8_SCHED;
            PG8_LDA(At, 1, 1); PG8_STAGE(PG8_SB(1, 0), b3, voffB); PG8_STAGE(PG8_SB(1, 1), b3 + hstep, voffB); PG8_STAGE(PG8_SA(1, 0), a3, voffA);
            PG8_WAIT_V(8); PG8_WAIT_L(0); PG8_BAR; PG8_MMA(1, 0, At, B0); PG8_MMA(1, 1, At, B1); PG8_BAR; PG8_SCHED;
            } else {
            PG8_LDB(B0, 0, 0); PG8_SCHED; PG8_LDA(At, 0, 0); PG8_STAGE(PG8_SA(1, 1), a1 + hstep, voffA);
            PG8_WAIT_L(8); PG8_BAR; PG8_WAIT_L(0); PG8_MMA(0, 0, At, B0); PG8_BAR; PG8_SCHED;
            PG8_LDB(B1, 0, 1); PG8_STAGE(PG8_SB(0, 0), b2, voffB);
            PG8_BAR; PG8_WAIT_L(0); PG8_MMA(0, 1, At, B1); PG8_BAR;
            PG8_LDA(At, 0, 1); PG8_STAGE(PG8_SA(0, 0), a2, voffA);
            PG8_BAR; PG8_WAIT_L(0); PG8_MMA(1, 0, At, B0); PG8_BAR; PG8_SCHED;
            PG8_STAGE(PG8_SB(0, 1), b2 + hstep, voffB);
            PG8_WAIT_V(6); PG8_BAR; PG8_MMA(1, 1, At, B1); PG8_BAR;
            PG8_LDB(B0, 1, 0); PG8_SCHED; PG8_LDA(At, 1, 0); PG8_STAGE(PG8_SA(0, 1), a2 + hstep, voffA);
            PG8_WAIT_L(8); PG8_BAR; PG8_WAIT_L(0); PG8_MMA(0, 0, At, B0); PG8_BAR; PG8_SCHED;
            PG8_LDB(B1, 1, 1); PG8_STAGE(PG8_SB(1, 0), b3, voffB);
            PG8_BAR; PG8_WAIT_L(0); PG8_MMA(0, 1, At, B1); PG8_BAR;
            PG8_LDA(At, 1, 1); PG8_STAGE(PG8_SA(1, 0), a3, voffA);
            PG8_BAR; PG8_WAIT_L(0); PG8_MMA(1, 0, At, B0); PG8_BAR; PG8_SCHED;
            PG8_STAGE(PG8_SB(1, 1), b3 + hstep, voffB);
            PG8_WAIT_V(6); PG8_BAR; PG8_MMA(1, 1, At, B1); PG8_BAR;
            }
        }
        if constexpr (ALIGN_EPI) { if (wr == 0) PG8_BAR; }
        if constexpr (!Epi::AFTER_DRAIN) { E(acc, cur, wr, wc, fr, fq); S.done(cur); }
        if (!has_next) break;
#pragma unroll
        for (int a = 0; a < 2; ++a)
#pragma unroll
            for (int b = 0; b < 2; ++b)
#pragma unroll
                for (int m = 0; m < 4; ++m)
#pragma unroll
                    for (int n = 0; n < 2; ++n) acc[a][b][m][n] = (f32x4){0.f, 0.f, 0.f, 0.f};
        cur = nxt; cA = nA; cB = nB; ++ui;
        if constexpr (ALIGN_EPI) { if (wr == 1) PG8_BAR; }
    }
    PG8_WAIT_V(0);
    if constexpr (!ALIGN_EPI) { if (wr == 0) PG8_BAR; }
    PG8_BAR;
    if constexpr (Epi::AFTER_DRAIN) { E.fused(acc, cur, wr, wc, fr, fq, lds, wid, lane); S.done(cur); }
#undef PG8_SA
#undef PG8_SB
#undef PG8_STAGE
#undef PG8_LDA
#undef PG8_LDB
#undef PG8_MMA
#undef PG8_WAIT_V
#undef PG8_WAIT_L
#undef PG8_BAR
#undef PG8_SCHED
}
}
#define GAS __attribute__((address_space(1)))
#define LAS __attribute__((address_space(3)))
typedef unsigned v4u __attribute__((ext_vector_type(4)));
typedef float f32x4 __attribute__((ext_vector_type(4)));
#define LDS_WAIT() asm volatile("s_waitcnt lgkmcnt(0)" ::: "memory")
constexpr int NWAVES = 8;
constexpr int GEMM_LDS = 131072;

struct Ptrs {
    const float* in[20]; float* out; unsigned char* ws;
};
#define IN_X 0
#define IN_EV_NORM 1
#define IN_EV_WIN 2
#define IN_EV_IFB 3
#define IN_EV_QNG 4
#define IN_EV_KNG 5
#define IN_EV_REL 6
#define IN_EV_WOUT 7
#define IN_OD_NORM 8
#define IN_OD_WIN 9
#define IN_OD_CCW 10
#define IN_OD_CCB 11
#define IN_OD_GW 12
#define IN_OD_GB 13
#define IN_OD_LAM 14
#define IN_OD_CDW 15
#define IN_OD_ALOG 16
#define IN_OD_DTB 17
#define IN_OD_ONORM 18
#define IN_OD_WOUT 19

__device__ __forceinline__ float frsq_(float x) { return __builtin_amdgcn_rsqf(x); }
__device__ __forceinline__ float wave_sum(float v) {
#pragma unroll
    for (int o = 1; o < 64; o <<= 1) v += __shfl_xor(v, o);
    return v;
}
struct TrItem { const float* W; const float* gain; bf16_t* WT; int ldw, nblk, item; };
__device__ __forceinline__ void p0_tr_load(const TrItem& t, float (&r)[32], int lane) {
    const int kb = t.item / t.nblk, nb = t.item % t.nblk, k0 = 64 * kb, n0 = 32 * nb;
#pragma unroll
    for (int i = 0; i < 32; ++i) { const int kk = 2 * i + (lane >> 5); r[i] = t.W[(size_t)(k0 + kk) * t.ldw + n0 + (lane & 31)]; }
}
__device__ __forceinline__ void p0_tr_store(const TrItem& t, const float (&r)[32], LAS float* scr, int lane) {
    const int kb = t.item / t.nblk, nb = t.item % t.nblk, k0 = 64 * kb, n0 = 32 * nb; constexpr int K = D_MODEL;
#pragma unroll
    for (int i = 0; i < 32; ++i) { const int kk = 2 * i + (lane >> 5); const float g = t.gain ? t.gain[k0 + kk] : 1.0f; scr[kk * 33 + (lane & 31)] = g * r[i]; }
    LDS_WAIT(); asm volatile("" ::: "memory");
    const int c = lane & 7;
#pragma unroll
    for (int j = 0; j < 4; ++j) { const int n = (lane >> 3) + 8 * j; const LAS float* s = scr + (8 * c) * 33 + n;
        v4u o; o.x = pk2(s[0 * 33], s[1 * 33]); o.y = pk2(s[2 * 33], s[3 * 33]); o.z = pk2(s[4 * 33], s[5 * 33]); o.w = pk2(s[6 * 33], s[7 * 33]);
        *(GAS v4u*)(t.WT + (size_t)(n0 + n) * K + k0 + 8 * c) = o; }
    LDS_WAIT(); asm volatile("" ::: "memory");
}
__device__ __forceinline__ void p0_transposes(const Ptrs& P, LAS float* scr, int lane, int gw, int NGW, int it0, int it1) {
    unsigned char* ws = P.ws;
    bf16_t* W1T = (bf16_t*)(ws + WS_W1T); bf16_t* W2T = (bf16_t*)(ws + WS_W2T); bf16_t* W3T = (bf16_t*)(ws + WS_W3T); bf16_t* W4T = (bf16_t*)(ws + WS_W4T);
    constexpr int I1 = (D_MODEL / 64) * (EV_N / 32), I2 = (D_MODEL / 64) * (D_MODEL / 32), I3 = (D_MODEL / 64) * (OD_N / 32);
    auto mk = [&](int it) { TrItem t; int r = it;
        if (r < I1) { t = TrItem{P.in[IN_EV_WIN], P.in[IN_EV_NORM], W1T, EV_IN, EV_N / 32, r}; return t; } r -= I1;
        if (r < I2) { t = TrItem{P.in[IN_EV_WOUT], nullptr, W2T, D_MODEL, D_MODEL / 32, r}; return t; } r -= I2;
        if (r < I3) { t = TrItem{P.in[IN_OD_WIN], P.in[IN_OD_NORM], W3T, OD_IN, OD_N / 32, r}; return t; } r -= I3;
        t = TrItem{P.in[IN_OD_WOUT], nullptr, W4T, D_MODEL, D_MODEL / 32, r}; return t; };
    float ra[32], rb[32]; int it = it0 + gw;
    if (it < it1) { TrItem ta = mk(it); p0_tr_load(ta, ra, lane);
        for (;;) { const int itb = it + NGW; TrItem tb = ta; const bool hb = itb < it1; if (hb) { tb = mk(itb); p0_tr_load(tb, rb, lane); }
            p0_tr_store(ta, ra, scr, lane); if (!hb) break;
            const int itc = itb + NGW; const bool hc = itc < it1; if (hc) { ta = mk(itc); p0_tr_load(ta, ra, lane); }
            p0_tr_store(tb, rb, scr, lane); if (!hc) break; it = itc; } }
}
constexpr int TR_I1 = (D_MODEL / 64) * (EV_N / 32), TR_ALL = TR_I1 + 2 * (D_MODEL / 64) * (D_MODEL / 32) + (D_MODEL / 64) * (OD_N / 32), TR_I4 = TR_ALL - (D_MODEL / 64) * (D_MODEL / 32);
__device__ __forceinline__ void late_weights(const Ptrs& P, LAS unsigned char* lds, int wave, int lane, int gw, int NGW) {
    p0_transposes(P, (LAS float*)(lds + wave * 16384), lane, gw, NGW, TR_I1, TR_I4);
    bf16_t* W3T = (bf16_t*)(P.ws + WS_W3T); const int gt = gw * 64 + lane, NT = NGW * 64;
    for (int e = gt; e < 16 * D_MODEL; e += NT) { const int j = e / D_MODEL, k = e % D_MODEL; W3T[(size_t)(OD_N + j) * D_MODEL + k] = (bf16_t)f2bf(P.in[IN_OD_NORM][k] * P.in[IN_OD_WIN][(size_t)k * OD_IN + OD_N + j]); }
}
__device__ __forceinline__ void last_weight(const Ptrs& P, LAS unsigned char* lds, int wave, int lane, int gw, int NGW) { p0_transposes(P, (LAS float*)(lds + wave * 16384), lane, gw, NGW, TR_I4, TR_ALL); }
template <int PART = 3> __device__ __forceinline__ void phase_prologue(const Ptrs& P, LAS unsigned char* lds, int wave, int lane, int gw, int NGW) {
    unsigned char* ws = P.ws;
    bf16_t* W1T = (bf16_t*)(ws + WS_W1T); bf16_t* W2T = (bf16_t*)(ws + WS_W2T); bf16_t* W3T = (bf16_t*)(ws + WS_W3T); bf16_t* W4T = (bf16_t*)(ws + WS_W4T);
    bf16_t* XB = (bf16_t*)(ws + WS_XB); float* R0 = (float*)(ws + WS_R0); float* SS1 = (float*)(ws + WS_SS1); float* GIF = (float*)(ws + WS_GIF);
    LAS float* scr = (LAS float*)(lds + wave * 16384);
    if constexpr (PART & 1) p0_transposes(P, scr, lane, gw, NGW, 0, TR_I1);
    if constexpr (!(PART & 2)) return;
    { const int gt = gw * 64 + lane, NT = NGW * 64;
      for (int e = gt; e < M_TOK; e += NT) SS1[e] = 0.f; }
    __syncthreads();
    LAS float* G8 = (LAS float*)lds;
#pragma unroll 8
    for (int e = threadIdx.x; e < D_MODEL * 8; e += NWAVES * 64) { const int k = e >> 3, j = e & 7; G8[j * D_MODEL + k] = P.in[IN_EV_NORM][k] * P.in[IN_EV_WIN][(size_t)k * EV_IN + EV_N + j]; }
    __syncthreads();
    const float* X = P.in[IN_X];
    f32x4 vnx[8];
    if (gw < M_TOK) { const GAS f32x4* xr0 = (const GAS f32x4*)(X + (size_t)gw * D_MODEL) + lane;
#pragma unroll
        for (int j = 0; j < 8; ++j) vnx[j] = xr0[64 * j]; }
    for (int m = gw; m < M_TOK; m += NGW) {
        float s = 0.f;
        GAS unsigned long long* o8 = (GAS unsigned long long*)(XB + (size_t)m * D_MODEL) + lane;
        f32x4 v[8];
#pragma unroll
        for (int j = 0; j < 8; ++j) v[j] = vnx[j];
        if (m + NGW < M_TOK) { const GAS f32x4* xr1 = (const GAS f32x4*)(X + (size_t)(m + NGW) * D_MODEL) + lane;
#pragma unroll
            for (int j = 0; j < 8; ++j) vnx[j] = xr1[64 * j]; }
#pragma unroll
        for (int j = 0; j < 8; ++j) { s += (v[j].x * v[j].x + v[j].y * v[j].y) + (v[j].z * v[j].z + v[j].w * v[j].w);
            o8[64 * j] = (unsigned long long)pk2(v[j].x, v[j].y) | ((unsigned long long)pk2(v[j].z, v[j].w) << 32); }
        const float r0 = frsq_(wave_sum(s) * (1.0f / D_MODEL) + EPS);
        float g[8];
#pragma unroll
        for (int i = 0; i < 8; ++i) g[i] = 0.f;
#pragma unroll
        for (int j = 0; j < 8; ++j) {
#pragma unroll
            for (int i = 0; i < 8; ++i) { const f32x4 gv = *(const LAS f32x4*)(G8 + i * D_MODEL + 4 * lane + 256 * j); g[i] += (v[j][0] * gv[0] + v[j][1] * gv[1]) + (v[j][2] * gv[2] + v[j][3] * gv[3]); }
            asm volatile("" : "+v"(g[0]), "+v"(g[1]), "+v"(g[2]), "+v"(g[3]), "+v"(g[4]), "+v"(g[5]), "+v"(g[6]), "+v"(g[7]) :: "memory");
        }
#pragma unroll
        for (int i = 0; i < 8; ++i) g[i] = wave_sum(g[i]);
        if (lane == 0) R0[m] = r0;
        if (lane < 8) { float gv = g[0];
#pragma unroll
            for (int i = 1; i < 8; ++i) gv = (lane == i) ? g[i] : gv;
            GIF[(size_t)m * 8 + lane] = r0 * gv + P.in[IN_EV_IFB][lane]; }
    }
}

#define XB_TMO      128
#define XB_XCNT(j)  (256  + 64 * (j))
#define XB_XSUB(j)  (1280 + 64 * (j))
#define XB_XGEN(j)  (2304 + 64 * (j))
#define XB_TOP      3328
#define XB_TOPGEN   3392
#define XCD_BAR_WORDS 3456
#define XB_SPIN_CAP (1u << 18)

__device__ __forceinline__ unsigned xb_ld(unsigned* p)              { return __hip_atomic_load(p, __ATOMIC_RELAXED, __HIP_MEMORY_SCOPE_AGENT); }
__device__ __forceinline__ unsigned xb_add(unsigned* p, unsigned v) { return __hip_atomic_fetch_add(p, v, __ATOMIC_RELAXED, __HIP_MEMORY_SCOPE_AGENT); }
__device__ __forceinline__ unsigned xb_xcc_id() { return (unsigned)__builtin_amdgcn_s_getreg((3 << 11) | 20) & 0xFu; }
#define XB_SPIN(cond, bar) do { unsigned _sp = 0; while (cond) { __builtin_amdgcn_s_sleep(1); \
    if ((++_sp & 255u) == 0u) { if (xb_ld(&(bar)[XB_TMO])) break; if (_sp > XB_SPIN_CAP) { atomicAdd(&(bar)[XB_TMO], 1u); break; } } } } while (0)

struct XcdBarrier {
    unsigned* bar; unsigned x;
    volatile LAS unsigned* st;
};

__device__ __forceinline__ XcdBarrier xcd_barrier_post(unsigned* bar, volatile LAS unsigned* st) {
    XcdBarrier b; b.bar = bar; b.x = xb_xcc_id(); b.st = st;
    if (threadIdx.x == 0) (void)xb_add(&bar[XB_XCNT(b.x)], 1u);
    return b;
}
__device__ __forceinline__ void xcd_barrier_complete(unsigned* bar, unsigned x, unsigned& nloc, unsigned& nx) {
    const unsigned G = gridDim.x * gridDim.y * gridDim.z;
    unsigned sum, cnt, mine, sp = 0u;
    for (;;) {
        sum = 0u; cnt = 0u; mine = 0u;
#pragma unroll
        for (unsigned j = 0; j < 16; ++j) { const unsigned c = xb_ld(&bar[XB_XCNT(j)]); sum += c; cnt += (c > 0u) ? 1u : 0u; mine = (j == x) ? c : mine; }
        if (sum == G) break;
        __builtin_amdgcn_s_sleep(1);
        if ((++sp & 255u) == 0u) { if (xb_ld(&bar[XB_TMO])) break; if (sp > XB_SPIN_CAP) { atomicAdd(&bar[XB_TMO], 1u); break; } }
    }
    nloc = mine > 0u ? mine : 1u; nx = cnt > 0u ? cnt : 1u;
}

__device__ __forceinline__ void xcd_barrier(const XcdBarrier& b) {
    asm volatile("s_waitcnt vmcnt(0)" ::: "memory");
    __syncthreads();
    if (threadIdx.x == 0) {
        unsigned* bar = b.bar;
        __builtin_amdgcn_s_waitcnt(0);
        unsigned nloc = b.st[0], nx = b.st[1];
        if (nloc == 0u) { xcd_barrier_complete(bar, b.x, nloc, nx); b.st[0] = nloc; b.st[1] = nx; }
        const unsigned old = xb_add(&bar[XB_XSUB(b.x)], 1u);
        const unsigned gen = old / nloc;
        if (old + 1u == (gen + 1u) * nloc) {
            __builtin_amdgcn_fence(__ATOMIC_RELEASE, "agent");
            asm volatile("s_waitcnt vmcnt(0)" ::: "memory");
            const unsigned og = xb_add(&bar[XB_TOP], 1u);
            const unsigned tg = og / nx;
            if (og + 1u == (tg + 1u) * nx) xb_add(&bar[XB_TOPGEN], 1u);
            else XB_SPIN(xb_ld(&bar[XB_TOPGEN]) == tg, bar);
            __builtin_amdgcn_fence(__ATOMIC_ACQUIRE, "agent");
            xb_add(&bar[XB_XGEN(b.x)], 1u);
            asm volatile("s_waitcnt vmcnt(0)" ::: "memory");
        } else {
            XB_SPIN(xb_ld(&bar[XB_XGEN(b.x)]) == gen, bar);
            __builtin_amdgcn_fence(__ATOMIC_ACQUIRE, "agent");
            asm volatile("s_waitcnt vmcnt(0)" ::: "memory");
        }
    }
    __syncthreads();
}
__device__ __forceinline__ void ld8bf(const bf16_t* p, float (&v)[8]) {
    const v4u w = *(const v4u*)p;
    v[0] = __builtin_bit_cast(float, w.x << 16); v[1] = __builtin_bit_cast(float, w.x & 0xffff0000u);
    v[2] = __builtin_bit_cast(float, w.y << 16); v[3] = __builtin_bit_cast(float, w.y & 0xffff0000u);
    v[4] = __builtin_bit_cast(float, w.z << 16); v[5] = __builtin_bit_cast(float, w.z & 0xffff0000u);
    v[6] = __builtin_bit_cast(float, w.w << 16); v[7] = __builtin_bit_cast(float, w.w & 0xffff0000u);
}
template <int WHICH> __device__ __forceinline__ void phase_gemm(const Ptrs& P, LAS unsigned char* lds, int G, int c) {
    unsigned char* ws = P.ws;
    bf16_t* W1T = (bf16_t*)(ws + WS_W1T); bf16_t* W2T = (bf16_t*)(ws + WS_W2T); bf16_t* W3T = (bf16_t*)(ws + WS_W3T); bf16_t* W4T = (bf16_t*)(ws + WS_W4T);
    bf16_t* XB = (bf16_t*)(ws + WS_XB); bf16_t* YB = (bf16_t*)(ws + WS_Y); bf16_t* PROJ = (bf16_t*)(ws + WS_PROJ);
    float* R0 = (float*)(ws + WS_R0); float* SS1 = (float*)(ws + WS_SS1);
    if constexpr (WHICH == 1) { pg8::Gemm g{XB, W1T, M_TOK, EV_N, D_MODEL}; pg8::EpiProj E{PROJ, EV_N, R0, 0}; pg8::StaticOrder S; S.init(g.M, g.N, G, c);
        pg8::gemm_phase<pg8::EpiProj, pg8::StaticOrder, true, true>(lds, g, S, E); }
    if constexpr (WHICH == 2) { pg8::Gemm g{YB, W2T, M_TOK, D_MODEL, D_MODEL}; pg8::EpiRes E{P.in[IN_X], P.out, XB, SS1, D_MODEL}; pg8::StaticOrder S; S.init(g.M, g.N, G, c);
        pg8::gemm_phase<pg8::EpiRes, pg8::StaticOrder, true, true>(lds, g, S, E); }
    if constexpr (WHICH == 3) { pg8::Gemm g{XB, W3T, M_TOK, OD_N, D_MODEL}; pg8::EpiProj E{PROJ, OD_N, SS1, 1}; pg8::StaticOrder S; S.init(g.M, g.N, G, c);
        pg8::gemm_phase<pg8::EpiProj, pg8::StaticOrder, true, true>(lds, g, S, E); }
    if constexpr (WHICH == 4) { pg8::Gemm g{YB, W4T, M_TOK, D_MODEL, D_MODEL}; pg8::EpiRes E{P.out, P.out, nullptr, nullptr, D_MODEL}; pg8::StaticOrder S; S.init(g.M, g.N, G, c);
        pg8::gemm_phase<pg8::EpiRes, pg8::StaticOrder, true, true>(lds, g, S, E); }
}
typedef short bf16x8 __attribute__((ext_vector_type(8)));
typedef short bf16x4 __attribute__((ext_vector_type(4)));
typedef short v4i16_t __attribute__((ext_vector_type(4)));
#define MFMA16(a, b, c) __builtin_amdgcn_mfma_f32_16x16x32_bf16((a), (b), (c), 0, 0, 0)
__device__ __forceinline__ v4i16_t lds_tr(LAS const unsigned char* p) { return __builtin_amdgcn_ds_read_tr16_b64_v4i16((LAS v4i16_t*)p); }
__device__ __forceinline__ bf16x8 frag_row(LAS const unsigned char* base, int RS, int r0, int k0, int lane) { return *(LAS const bf16x8*)(base + (r0 + (lane & 15)) * RS + (k0 + 8 * (lane >> 4)) * 2); }
__device__ __forceinline__ bf16x8 frag_row_perm(LAS const unsigned char* base, int RS, int r0, int k0, int lane) {
    LAS const unsigned char* p = base + (r0 + (lane & 15)) * RS + (k0 + 4 * (lane >> 4)) * 2;
    const bf16x4 a = *(LAS const bf16x4*)p, b = *(LAS const bf16x4*)(p + 32); return (bf16x8){a[0], a[1], a[2], a[3], b[0], b[1], b[2], b[3]}; }
__device__ __forceinline__ bf16x8 frag_tr(LAS const unsigned char* base, int RS, int k0, int c0, int lane) {
    const int g = lane >> 4, q = (lane & 15) >> 2, p = lane & 3; LAS const unsigned char* a = base + (k0 + 8 * g + q) * RS + (c0 + 4 * p) * 2;
    const v4i16_t lo = lds_tr(a), hi = lds_tr(a + 4 * RS); return (bf16x8){lo[0], lo[1], lo[2], lo[3], hi[0], hi[1], hi[2], hi[3]}; }
__device__ __forceinline__ bf16x8 frag_tr_perm(LAS const unsigned char* base, int RS, int k0, int c0, int lane) {
    const int g = lane >> 4, q = (lane & 15) >> 2, p = lane & 3; LAS const unsigned char* a = base + (k0 + 4 * g + q) * RS + (c0 + 4 * p) * 2;
    const v4i16_t lo = lds_tr(a), hi = lds_tr(a + 16 * RS); return (bf16x8){lo[0], lo[1], lo[2], lo[3], hi[0], hi[1], hi[2], hi[3]}; }
__device__ __forceinline__ bf16x8 acc_pair_frag(const f32x4& lo, const f32x4& hi) {
    const unsigned a = pk2(lo[0], lo[1]), b = pk2(lo[2], lo[3]), c = pk2(hi[0], hi[1]), d = pk2(hi[2], hi[3]);
    typedef unsigned u32x4_ __attribute__((ext_vector_type(4))); const u32x4_ w = {a, b, c, d}; return __builtin_bit_cast(bf16x8, w); }
__device__ __forceinline__ float fexp2(float x) { return __builtin_amdgcn_exp2f(x); }
constexpr float LOG2E = 1.4426950408889634f;
__device__ __forceinline__ float fexp(float x) { return __builtin_amdgcn_exp2f(x * LOG2E); }
__device__ __forceinline__ float frcp(float x) { return __builtin_amdgcn_rcpf(x); }
__device__ __forceinline__ float frsq(float x) { return __builtin_amdgcn_rsqf(x); }
__device__ __forceinline__ float fsqrt(float x) { return __builtin_amdgcn_sqrtf(x); }
__device__ __forceinline__ float fsigmoid(float x) { return __builtin_amdgcn_rcpf(1.0f + __builtin_amdgcn_exp2f(-x * LOG2E)); }
__device__ __forceinline__ float fsilu(float x) { return x * fsigmoid(x); }
__device__ __forceinline__ void phase_gates_ab(const Ptrs& P, int G) {
    unsigned char* ws = P.ws; const bf16_t* __restrict__ XB = (const bf16_t*)(ws + WS_XB); const bf16_t* __restrict__ W3T = (const bf16_t*)(ws + WS_W3T); const float* __restrict__ SS1 = (const float*)(ws + WS_SS1); float* __restrict__ AB = (float*)(ws + WS_AB);
    const int tid = threadIdx.x, lane = tid & 63, wave = tid >> 6, g = lane >> 4, l15 = lane & 15;
    for (int mt = blockIdx.x * NWAVES + wave; mt < M_TOK / 16; mt += G * NWAVES) {
        const bf16_t* ap = XB + (size_t)(mt * 16 + l15) * D_MODEL + 8 * g; const bf16_t* bp = W3T + (size_t)(OD_N + l15) * D_MODEL + 8 * g;
        f32x4 acc = (f32x4){0.f, 0.f, 0.f, 0.f};
#pragma unroll 1
        for (int kb = 0; kb < D_MODEL / 32; kb += 16) { bf16x8 af[16], bfr[16];
#pragma unroll
            for (int i = 0; i < 16; ++i) { af[i] = *(const bf16x8*)(ap + 32 * (kb + i)); bfr[i] = *(const bf16x8*)(bp + 32 * (kb + i)); }
#pragma unroll
            for (int i = 0; i < 16; ++i) acc = MFMA16(af[i], bfr[i], acc); }
#pragma unroll
        for (int r = 0; r < 4; ++r) { const int row = mt * 16 + 4 * g + r; AB[(size_t)row * 16 + l15] = acc[r] * frsq(SS1[row] * (1.0f / D_MODEL) + EPS); } }
}
#ifdef SKELETON
__device__ __forceinline__ void phase_mix0(const Ptrs& P, LAS unsigned char* lds, int G) {
    v4u* Y = (v4u*)(P.ws + WS_Y); const v4u z = {0u, 0u, 0u, 0u};
    for (size_t i = (size_t)blockIdx.x * 512 + threadIdx.x; i < (size_t)M_TOK * D_MODEL / 8; i += (size_t)G * 512) Y[i] = z;
}
__device__ __forceinline__ void phase_mix1a(const Ptrs& P, LAS unsigned char* lds, int G) { phase_mix0(P, lds, G); }
__device__ __forceinline__ void phase_mix1b(const Ptrs& P, LAS unsigned char* lds, int G) { }
#endif
constexpr int AT_RSK = 272, AT_RSV = 288, AT_KB = 64 * AT_RSK, AT_VB = 64 * AT_RSV;
constexpr int AT_OFF_K = 0, AT_OFF_V = 2 * AT_KB, AT_OFF_TBL = AT_OFF_V + 2 * AT_VB, AT_LDS = AT_OFF_TBL + 2064;
static_assert(AT_LDS <= 163328, "attention LDS");
template <int SKIP = 0> __device__ __forceinline__ void attn_item(const Ptrs& P, LAS unsigned char* lds, int item, size_t yoff = WS_Y) {
    const bf16_t* __restrict__ PROJ = (const bf16_t*)(P.ws + WS_PROJ); bf16_t* __restrict__ Y = (bf16_t*)(P.ws + yoff);
    const float* __restrict__ qn_g = P.in[IN_EV_QNG]; const float* __restrict__ kn_g = P.in[IN_EV_KNG];
    const int tid = threadIdx.x, lane = tid & 63, wave = tid >> 6, g = lane >> 4, l15 = lane & 15;
    const int cp = item & 15, h = (item >> 4) & 7, b = item >> 7;
    const int c = 2 * cp + (wave >> 2), qt = wave & 3;
    LAS float* tbl = (LAS float*)(lds + AT_OFF_TBL);
    for (int i = tid; i < NREL; i += 512) tbl[i] = P.in[IN_EV_REL][h * NREL + i] * LOG2E;
    bf16x8 qf[4];
    { const bf16_t* qp = PROJ + (size_t)(b * SEQ + c * 64 + qt * 16 + l15) * EV_N + EC_QA + h * 128 + 8 * g;
      float qv[4][8]; float ss = 0.f;
#pragma unroll
      for (int ks = 0; ks < 4; ++ks) { ld8bf(qp + 32 * ks, qv[ks]);
#pragma unroll
          for (int i = 0; i < 8; ++i) ss += qv[ks][i] * qv[ks][i]; }
      ss += __shfl_xor(ss, 16); ss += __shfl_xor(ss, 32);
      const float rs = frsq(ss * (1.0f / 128.0f) + EPS) * (0.08838834764831845f * LOG2E);
#pragma unroll
      for (int ks = 0; ks < 4; ++ks) { const float* gp = qn_g + 32 * ks + 8 * g; typedef unsigned u32x4_ __attribute__((ext_vector_type(4)));
          const u32x4_ w = {pk2(qv[ks][0] * rs * gp[0], qv[ks][1] * rs * gp[1]), pk2(qv[ks][2] * rs * gp[2], qv[ks][3] * rs * gp[3]),
                            pk2(qv[ks][4] * rs * gp[4], qv[ks][5] * rs * gp[5]), pk2(qv[ks][6] * rs * gp[6], qv[ks][7] * rs * gp[7])};
          qf[ks] = __builtin_bit_cast(bf16x8, w); } }
    f32x4 o[8];
#pragma unroll
    for (int i = 0; i < 8; ++i) o[i] = (f32x4){0.f, 0.f, 0.f, 0.f};
    float mrun = -1.0e30f, lrun = 0.f;
    const int kt_lo = (2 * cp - LOOKBACK) < 0 ? 0 : (2 * cp - LOOKBACK), kt_hi = 2 * cp + 1;
    v4u kreg[2], vreg[2];
    const int srow0 = tid >> 4, sch = tid & 15;
    float kg[8];
#pragma unroll
    for (int i = 0; i < 8; ++i) kg[i] = kn_g[sch * 8 + i];
#define AT_LOAD(kt) do { _Pragma("unroll") for (int i_ = 0; i_ < 2; ++i_) { const bf16_t* rp_ = PROJ + (size_t)(b * SEQ + (kt) * 64 + srow0 + 32 * i_) * EV_N + h * 128 + sch * 8; \
        kreg[i_] = *(const v4u*)(rp_ + EC_KA); vreg[i_] = *(const v4u*)(rp_ + EC_VA); } } while (0)
#define AT_STORE(buf) do { _Pragma("unroll") for (int i_ = 0; i_ < 2; ++i_) { const int row_ = srow0 + 32 * i_; \
        float kv_[8]; kv_[0] = __builtin_bit_cast(float, kreg[i_].x << 16); kv_[1] = __builtin_bit_cast(float, kreg[i_].x & 0xffff0000u); kv_[2] = __builtin_bit_cast(float, kreg[i_].y << 16); kv_[3] = __builtin_bit_cast(float, kreg[i_].y & 0xffff0000u); \
        kv_[4] = __builtin_bit_cast(float, kreg[i_].z << 16); kv_[5] = __builtin_bit_cast(float, kreg[i_].z & 0xffff0000u); kv_[6] = __builtin_bit_cast(float, kreg[i_].w << 16); kv_[7] = __builtin_bit_cast(float, kreg[i_].w & 0xffff0000u); \
        float ss_ = 0.f; _Pragma("unroll") for (int e_ = 0; e_ < 8; ++e_) ss_ += kv_[e_] * kv_[e_]; \
        ss_ += __shfl_xor(ss_, 1); ss_ += __shfl_xor(ss_, 2); ss_ += __shfl_xor(ss_, 4); ss_ += __shfl_xor(ss_, 8); \
        const float rs_ = frsq(ss_ * (1.0f / 128.0f) + EPS); \
        v4u w_; w_.x = pk2(kv_[0] * rs_ * kg[0], kv_[1] * rs_ * kg[1]); w_.y = pk2(kv_[2] * rs_ * kg[2], kv_[3] * rs_ * kg[3]); w_.z = pk2(kv_[4] * rs_ * kg[4], kv_[5] * rs_ * kg[5]); w_.w = pk2(kv_[6] * rs_ * kg[6], kv_[7] * rs_ * kg[7]); \
        *(LAS v4u*)(lds + AT_OFF_K + (buf) * AT_KB + row_ * AT_RSK + sch * 16) = w_; \
        *(LAS v4u*)(lds + AT_OFF_V + (buf) * AT_VB + row_ * AT_RSV + sch * 16) = vreg[i_]; } } while (0)
    AT_LOAD(kt_lo); AT_STORE(0);
    __syncthreads();
    const int qi = qt * 16 + l15;
    for (int kt = kt_lo, it = 0; kt <= kt_hi; ++kt, ++it) {
        const int buf = it & 1;
        if (kt < kt_hi) AT_LOAD(kt + 1);
        const int to = kt - (c - LOOKBACK);
        if (to >= 0 && to <= LOOKBACK) {
            LAS const unsigned char* Kb = lds + AT_OFF_K + buf * AT_KB; LAS const unsigned char* Vb = lds + AT_OFF_V + buf * AT_VB;
            f32x4 s[4];
#pragma unroll
            for (int nt = 0; nt < 4; ++nt) { s[nt] = (f32x4){0.f, 0.f, 0.f, 0.f};
#pragma unroll
                for (int ks = 0; ks < ((SKIP & 16) ? 0 : 4); ++ks) s[nt] = MFMA16(frag_row(Kb, AT_RSK, 16 * nt, 32 * ks, lane), qf[ks], s[nt]); }
            if constexpr (!(SKIP & 2)) { const int relb = LOOKBACK * CHUNK - 64 * to + qi - 4 * g;
#pragma unroll
              for (int nt = 0; nt < 4; ++nt)
#pragma unroll
                  for (int r = 0; r < 4; ++r) { int rel = relb - 16 * nt - r; rel = rel > REL_MAX ? REL_MAX : rel; s[nt][r] += tbl[rel + REL_MAX]; } }
            float tmax = fmaxf(fmaxf(s[0][0], s[0][1]), fmaxf(s[0][2], s[0][3]));
#pragma unroll
            for (int nt = 1; nt < 4; ++nt) tmax = fmaxf(tmax, fmaxf(fmaxf(s[nt][0], s[nt][1]), fmaxf(s[nt][2], s[nt][3])));
            tmax = fmaxf(tmax, __shfl_xor(tmax, 16)); tmax = fmaxf(tmax, __shfl_xor(tmax, 32));
            const float mnew = fmaxf(mrun, tmax), alpha = fexp2(mrun - mnew);
            float rsum = 0.f;
#pragma unroll
            for (int nt = 0; nt < 4; ++nt)
#pragma unroll
                for (int r = 0; r < 4; ++r) { s[nt][r] = (SKIP & 4) ? (s[nt][r] - mnew) : fexp2(s[nt][r] - mnew); rsum += s[nt][r]; }
            rsum += __shfl_xor(rsum, 16); rsum += __shfl_xor(rsum, 32);
            lrun = lrun * alpha + rsum; mrun = mnew;
            const bf16x8 pf0 = acc_pair_frag(s[0], s[1]), pf1 = acc_pair_frag(s[2], s[3]);
            float al[4];
#pragma unroll
            for (int r = 0; r < 4; ++r) al[r] = __shfl(alpha, 4 * g + r);
#pragma unroll
            for (int dt = 0; dt < ((SKIP & 8) ? 0 : 8); ++dt) { o[dt][0] *= al[0]; o[dt][1] *= al[1]; o[dt][2] *= al[2]; o[dt][3] *= al[3];
                o[dt] = MFMA16(pf0, frag_tr_perm(Vb, AT_RSV, 0, 16 * dt, lane), o[dt]);
                o[dt] = MFMA16(pf1, frag_tr_perm(Vb, AT_RSV, 32, 16 * dt, lane), o[dt]); }
        }
        if (kt < kt_hi) AT_STORE(buf ^ 1);
        __syncthreads();
    }
#undef AT_LOAD
#undef AT_STORE
    float li[4];
#pragma unroll
    for (int r = 0; r < 4; ++r) li[r] = frcp(__shfl(lrun, 4 * g + r));
#pragma unroll
    for (int r = 0; r < 4; ++r) { const size_t tok = (size_t)b * SEQ + c * 64 + qt * 16 + 4 * g + r; const bf16_t* zp = PROJ + tok * EV_N + EC_ZA + h * 128 + l15; bf16_t* yp = Y + tok * D_MODEL + h * 128 + l15;
#pragma unroll
        for (int dt = 0; dt < 8; ++dt) yp[16 * dt] = (bf16_t)f2bf(o[dt][r] * li[r] * fsilu(bf2f(zp[16 * dt]))); }
}
constexpr int A2_KB = 64 * AT_RSK, A2_VB = 64 * AT_RSV, A2_BUF = 2 * A2_KB + 2 * A2_VB;
constexpr int A2_OFF_TBL = 2 * A2_BUF, A2_LDS = A2_OFF_TBL + 2 * 2064;
static_assert(A2_LDS <= 163328, "attention (2-head) LDS");
template <int SKIP = 0> __device__ __forceinline__ void attn2_item(const Ptrs& P, LAS unsigned char* lds, int item, size_t yoff = WS_Y) {
    const bf16_t* __restrict__ PROJ = (const bf16_t*)(P.ws + WS_PROJ); bf16_t* __restrict__ Y = (bf16_t*)(P.ws + yoff);
    const float* __restrict__ qn_g = P.in[IN_EV_QNG]; const float* __restrict__ kn_g = P.in[IN_EV_KNG];
    const int tid = threadIdx.x, lane = tid & 63, wave = tid >> 6, g = lane >> 4, l15 = lane & 15;
    const int cp = item & 15, hp = (item >> 4) & 3, b = item >> 6;
    const int hs = wave >> 2, h = 2 * hp + hs, c = 2 * cp + ((wave >> 1) & 1), q0 = 32 * (wave & 1);
    LAS float* tbl = (LAS float*)(lds + A2_OFF_TBL);
    for (int i = tid; i < 2 * NREL; i += 512) { const int hh = i / NREL, r = i - hh * NREL; tbl[hh * 516 + r] = P.in[IN_EV_REL][(2 * hp + hh) * NREL + r] * LOG2E; }
    bf16x8 qf[2][4];
#pragma unroll
    for (int q = 0; q < 2; ++q) { const bf16_t* qp = PROJ + (size_t)(b * SEQ + c * 64 + q0 + 16 * q + l15) * EV_N + EC_QA + h * 128 + 8 * g;
        float qv[4][8]; float ss = 0.f;
#pragma unroll
        for (int ks = 0; ks < 4; ++ks) { ld8bf(qp + 32 * ks, qv[ks]);
#pragma unroll
            for (int i = 0; i < 8; ++i) ss += qv[ks][i] * qv[ks][i]; }
        ss += __shfl_xor(ss, 16); ss += __shfl_xor(ss, 32);
        const float rs = frsq(ss * (1.0f / 128.0f) + EPS) * (0.08838834764831845f * LOG2E);
#pragma unroll
        for (int ks = 0; ks < 4; ++ks) { const float* gp = qn_g + 32 * ks + 8 * g; typedef unsigned u32x4_ __attribute__((ext_vector_type(4)));
            const u32x4_ w = {pk2(qv[ks][0] * rs * gp[0], qv[ks][1] * rs * gp[1]), pk2(qv[ks][2] * rs * gp[2], qv[ks][3] * rs * gp[3]),
                              pk2(qv[ks][4] * rs * gp[4], qv[ks][5] * rs * gp[5]), pk2(qv[ks][6] * rs * gp[6], qv[ks][7] * rs * gp[7])};
            qf[q][ks] = __builtin_bit_cast(bf16x8, w); } }
    f32x4 o[2][8];
#pragma unroll
    for (int q = 0; q < 2; ++q)
#pragma unroll
        for (int i = 0; i < 8; ++i) o[q][i] = (f32x4){0.f, 0.f, 0.f, 0.f};
    float mrun[2] = {-1.0e30f, -1.0e30f}, lrun[2] = {0.f, 0.f};
    const int kt_lo = (2 * cp - LOOKBACK) < 0 ? 0 : (2 * cp - LOOKBACK), kt_hi = 2 * cp + 1;
    v4u kreg[2][2], vreg[2][2];
    const int srow0 = tid >> 4, sch = tid & 15;
#define A2_LOAD(kt) do { _Pragma("unroll") for (int hh_ = 0; hh_ < 2; ++hh_) _Pragma("unroll") for (int i_ = 0; i_ < 2; ++i_) { \
        const bf16_t* rp_ = PROJ + (size_t)(b * SEQ + (kt) * 64 + srow0 + 32 * i_) * EV_N + (2 * hp + hh_) * 128 + sch * 8; kreg[hh_][i_] = *(const v4u*)(rp_ + EC_KA); vreg[hh_][i_] = *(const v4u*)(rp_ + EC_VA); } } while (0)
#define A2_STORE(buf) do { _Pragma("unroll") for (int hh_ = 0; hh_ < 2; ++hh_) _Pragma("unroll") for (int i_ = 0; i_ < 2; ++i_) { const int row_ = srow0 + 32 * i_; const v4u kr_ = kreg[hh_][i_]; \
        float kv_[8]; kv_[0] = __builtin_bit_cast(float, kr_.x << 16); kv_[1] = __builtin_bit_cast(float, kr_.x & 0xffff0000u); kv_[2] = __builtin_bit_cast(float, kr_.y << 16); kv_[3] = __builtin_bit_cast(float, kr_.y & 0xffff0000u); \
        kv_[4] = __builtin_bit_cast(float, kr_.z << 16); kv_[5] = __builtin_bit_cast(float, kr_.z & 0xffff0000u); kv_[6] = __builtin_bit_cast(float, kr_.w << 16); kv_[7] = __builtin_bit_cast(float, kr_.w & 0xffff0000u); \
        float ss_ = 0.f; _Pragma("unroll") for (int e_ = 0; e_ < 8; ++e_) ss_ += kv_[e_] * kv_[e_]; \
        ss_ += __shfl_xor(ss_, 1); ss_ += __shfl_xor(ss_, 2); ss_ += __shfl_xor(ss_, 4); ss_ += __shfl_xor(ss_, 8); \
        const float rs_ = frsq(ss_ * (1.0f / 128.0f) + EPS); const f32x4 kga_ = *(const f32x4*)(kn_g + sch * 8), kgb_ = *(const f32x4*)(kn_g + sch * 8 + 4); const float kg[8] = {kga_[0], kga_[1], kga_[2], kga_[3], kgb_[0], kgb_[1], kgb_[2], kgb_[3]}; \
        v4u w_; w_.x = pk2(kv_[0] * rs_ * kg[0], kv_[1] * rs_ * kg[1]); w_.y = pk2(kv_[2] * rs_ * kg[2], kv_[3] * rs_ * kg[3]); w_.z = pk2(kv_[4] * rs_ * kg[4], kv_[5] * rs_ * kg[5]); w_.w = pk2(kv_[6] * rs_ * kg[6], kv_[7] * rs_ * kg[7]); \
        *(LAS v4u*)(lds + (buf) * A2_BUF + hh_ * A2_KB + row_ * AT_RSK + sch * 16) = w_; \
        *(LAS v4u*)(lds + (buf) * A2_BUF + 2 * A2_KB + hh_ * A2_VB + row_ * AT_RSV + sch * 16) = vreg[hh_][i_]; } } while (0)
    A2_LOAD(kt_lo); A2_STORE(0);
    __syncthreads();
    LAS const float* tb = tbl + hs * 516;
    for (int kt = kt_lo, it = 0; kt <= kt_hi; ++kt, ++it) {
        const int buf = it & 1;
        if (kt < kt_hi) A2_LOAD(kt + 1);
        const int to = kt - (c - LOOKBACK);
        if (to >= 0 && to <= LOOKBACK) {
            LAS const unsigned char* Kb = lds + buf * A2_BUF + hs * A2_KB; LAS const unsigned char* Vb = lds + buf * A2_BUF + 2 * A2_KB + hs * A2_VB;
            f32x4 s[2][4];
#pragma unroll
            for (int nt = 0; nt < 4; ++nt) { s[0][nt] = (f32x4){0.f, 0.f, 0.f, 0.f}; s[1][nt] = s[0][nt];
#pragma unroll
                for (int ks = 0; ks < 4; ++ks) { const bf16x8 kf = frag_row(Kb, AT_RSK, 16 * nt, 32 * ks, lane); s[0][nt] = MFMA16(kf, qf[0][ks], s[0][nt]); s[1][nt] = MFMA16(kf, qf[1][ks], s[1][nt]); }
                if (nt & 1) __builtin_amdgcn_sched_barrier(0); }
            bf16x8 pf[2][2]; float al[2][4];
#pragma unroll
            for (int q = 0; q < 2; ++q) {
                const int relb = LOOKBACK * CHUNK - 64 * to + (q0 + 16 * q + l15) - 4 * g;
                if (to <= 3) { const float cb = tb[2 * REL_MAX];
#pragma unroll
                    for (int nt = 0; nt < 4; ++nt) s[q][nt] += cb; }
                else if (to >= 5) { const LAS float* tp = tb + relb + REL_MAX;
#pragma unroll
                    for (int nt = 0; nt < 4; ++nt)
#pragma unroll
                        for (int r = 0; r < 4; ++r) s[q][nt][r] += tp[-(16 * nt + r)]; }
                else {
#pragma unroll
                    for (int nt = 0; nt < 4; ++nt)
#pragma unroll
                        for (int r = 0; r < 4; ++r) { int rel = relb - 16 * nt - r; rel = rel > REL_MAX ? REL_MAX : rel; s[q][nt][r] += tb[rel + REL_MAX]; } }
                float tmax = fmaxf(fmaxf(s[q][0][0], s[q][0][1]), fmaxf(s[q][0][2], s[q][0][3]));
#pragma unroll
                for (int nt = 1; nt < 4; ++nt) tmax = fmaxf(tmax, fmaxf(fmaxf(s[q][nt][0], s[q][nt][1]), fmaxf(s[q][nt][2], s[q][nt][3])));
                tmax = fmaxf(tmax, __shfl_xor(tmax, 16)); tmax = fmaxf(tmax, __shfl_xor(tmax, 32));
                const float mnew = fmaxf(mrun[q], tmax), alpha = fexp2(mrun[q] - mnew);
                float rsum = 0.f;
#pragma unroll
                for (int nt = 0; nt < 4; ++nt)
#pragma unroll
                    for (int r = 0; r < 4; ++r) { s[q][nt][r] = fexp2(s[q][nt][r] - mnew); rsum += s[q][nt][r]; }
                rsum += __shfl_xor(rsum, 16); rsum += __shfl_xor(rsum, 32);
                lrun[q] = lrun[q] * alpha + rsum; mrun[q] = mnew;
                pf[q][0] = acc_pair_frag(s[q][0], s[q][1]); pf[q][1] = acc_pair_frag(s[q][2], s[q][3]);
#pragma unroll
                for (int r = 0; r < 4; ++r) al[q][r] = __shfl(alpha, 4 * g + r); }
#pragma unroll
            for (int dt = 0; dt < 8; ++dt) { const bf16x8 v0 = frag_tr_perm(Vb, AT_RSV, 0, 16 * dt, lane), v1 = frag_tr_perm(Vb, AT_RSV, 32, 16 * dt, lane);
#pragma unroll
                for (int q = 0; q < 2; ++q) { o[q][dt][0] *= al[q][0]; o[q][dt][1] *= al[q][1]; o[q][dt][2] *= al[q][2]; o[q][dt][3] *= al[q][3];
                    o[q][dt] = MFMA16(pf[q][0], v0, o[q][dt]); o[q][dt] = MFMA16(pf[q][1], v1, o[q][dt]); }
                if (dt & 1) __builtin_amdgcn_sched_barrier(0); }
        }
        if (kt < kt_hi) A2_STORE(buf ^ 1);
        __syncthreads();
    }
#undef A2_LOAD
#undef A2_STORE
#pragma unroll
    for (int q = 0; q < 2; ++q) { float li[4];
#pragma unroll
        for (int r = 0; r < 4; ++r) li[r] = frcp(__shfl(lrun[q], 4 * g + r));
#pragma unroll
        for (int r = 0; r < 4; ++r) { const size_t tok = (size_t)b * SEQ + c * 64 + q0 + 16 * q + 4 * g + r; const bf16_t* zp = PROJ + tok * EV_N + EC_ZA + h * 128 + l15; bf16_t* yp = Y + tok * D_MODEL + h * 128 + l15;
#pragma unroll
            for (int dt = 0; dt < 8; ++dt) yp[16 * dt] = (bf16_t)f2bf(o[q][dt][r] * li[r] * fsilu(bf2f(zp[16 * dt]))); } }
}
constexpr int ML_RSQ = 528, ML_RSK = 544, ML_RSV = 160, ML_RSP = 144, ML_RSH = 144;
constexpr int ML_OFF_Q = 0, ML_OFF_K = ML_OFF_Q + 64 * ML_RSQ, ML_OFF_V = ML_OFF_K + 64 * ML_RSK, ML_OFF_P = ML_OFF_V + 64 * ML_RSV, ML_OFF_H = ML_OFF_P + 64 * ML_RSP, ML_OFF_S = ML_OFF_H + 64 * ML_RSH;
constexpr int ML_BC = 0, ML_AA = 2048, ML_PM = 4096, ML_MCH = 6144  , ML_BL = 6184  , ML_PL = 6216  ;
constexpr int ML_E1 = 6248, ML_E2 = ML_E1 + 64, ML_WI = ML_E2 + 64, ML_EMT = ML_WI + 64, ML_WS = ML_EMT + 64, ML_RS = ML_WS + 64, ML_QN = ML_RS + 64, ML_NV = ML_QN + 64, ML_NP = ML_NV + 256, ML_WC = ML_NP + 512, ML_LDS = ML_OFF_S + (ML_WC + 4) * 4;
static_assert(ML_LDS <= 163328, "mLSTM LDS");
template <int SKIP = 0> __device__ __forceinline__ void mlstm_item(const Ptrs& P, LAS unsigned char* lds, int item, size_t yoff = WS_Y) {
    const bf16_t* __restrict__ PROJ = (const bf16_t*)(P.ws + WS_PROJ); bf16_t* __restrict__ Y = (bf16_t*)(P.ws + yoff); const float* __restrict__ GIF = (const float*)(P.ws + WS_GIF);
    const int tid = threadIdx.x, lane = tid & 63, wave = tid >> 6, g = lane >> 4, l15 = lane & 15;
    const int quarter = item & 3, h = (item >> 2) & 3, b = item >> 4;
    LAS float* sc = (LAS float*)(lds + ML_OFF_S);
    LAS const unsigned char* Qt = lds + ML_OFF_Q; LAS const unsigned char* Kt = lds + ML_OFF_K; LAS const unsigned char* Vt = lds + ML_OFF_V; LAS const unsigned char* Ps = lds + ML_OFF_P;
    const size_t tok0 = (size_t)b * SEQ;
    f32x4 cacc[16];
#pragma unroll
    for (int i = 0; i < 16; ++i) cacc[i] = (f32x4){0.f, 0.f, 0.f, 0.f};
    if (tid < 256) sc[ML_NV + tid] = 0.f;
    for (int e = tid; e < 64 * ML_RSP / 8; e += 512) *(LAS unsigned long long*)(lds + ML_OFF_P + e * 8) = 0ull;
    float gli[4], gfp[4];
#pragma unroll
    for (int i = 0; i < 4; ++i) { const size_t tok = tok0 + (wave * 4 + i) * 64 + lane; gli[i] = GIF[tok * 8 + h]; gfp[i] = GIF[tok * 8 + 4 + h]; }
#pragma unroll
    for (int i = 0; i < 4; ++i) { const int c = wave * 4 + i;
        const float li = gli[i], lf = logsigmoidf_(gfp[i]);
        float bc = lf;
#pragma unroll
        for (int o = 1; o < 64; o <<= 1) { const float t_ = __shfl_up(bc, o); if (lane >= o) bc += t_; }
        const float as = li - bc; float pm = as;
#pragma unroll
        for (int o = 1; o < 64; o <<= 1) { const float t_ = __shfl_up(pm, o); if (lane >= o) pm = fmaxf(pm, t_); }
        sc[ML_BC + c * 64 + lane] = bc; sc[ML_AA + c * 64 + lane] = as; sc[ML_PM + c * 64 + lane] = pm;
        if (lane == 63) { sc[ML_BL + c] = bc; sc[ML_PL + c] = pm; } }
    __syncthreads();
    if (tid == 0) { float m = 0.f; sc[ML_MCH] = 0.f;
        for (int c = 0; c < NCH; ++c) { m = sc[ML_BL + c] + fmaxf(m, sc[ML_PL + c]); sc[ML_MCH + c + 1] = m; } }
    v4u qreg[4], kreg[4], vreg, oreg, zreg;
    const int ot = tid >> 3, oc = (tid & 7) * 8, ocol = h * 256 + quarter * 64 + oc;
#define ML_LOAD(n) do { _Pragma("unroll") for (int i_ = 0; i_ < 4; ++i_) { const int id_ = tid + 512 * i_, row_ = id_ >> 5, ch_ = id_ & 31; const bf16_t* rp_ = PROJ + (tok0 + (n) * 64 + row_) * EV_N + h * 256 + ch_ * 8; \
            qreg[i_] = *(const v4u*)(rp_ + EC_QB); kreg[i_] = *(const v4u*)(rp_ + EC_KB); } \
        vreg = *(const v4u*)(PROJ + (tok0 + (n) * 64 + (tid >> 3)) * EV_N + EC_VB + h * 256 + quarter * 64 + (tid & 7) * 8); } while (0)
#define ML_LOAD_OZ(n) do { const bf16_t* rp_ = PROJ + (tok0 + (n) * 64 + ot) * EV_N + ocol; oreg = *(const v4u*)(rp_ + EC_OB); zreg = *(const v4u*)(rp_ + EC_ZB); } while (0)
#define ML_STORE() do { _Pragma("unroll") for (int i_ = 0; i_ < 4; ++i_) { const int id_ = tid + 512 * i_, row_ = id_ >> 5, ch_ = id_ & 31; \
            *(LAS v4u*)(lds + ML_OFF_Q + row_ * ML_RSQ + ch_ * 16) = qreg[i_]; *(LAS v4u*)(lds + ML_OFF_K + row_ * ML_RSK + ch_ * 16) = kreg[i_]; } \
        *(LAS v4u*)(lds + ML_OFF_V + (tid >> 3) * ML_RSV + (tid & 7) * 16) = vreg; } while (0)
    ML_LOAD(0);
    __syncthreads();
    for (int n = 0; n < NCH; ++n) {
        if constexpr (!(SKIP & 64)) ML_STORE();
        const float m0 = sc[ML_MCH + n], m1 = sc[ML_MCH + n + 1], blast = sc[ML_BL + n];
        if (tid < 64) { const float bc = sc[ML_BC + n * 64 + tid], as = sc[ML_AA + n * 64 + tid], mx = fmaxf(m0, sc[ML_PM + n * 64 + tid]);
            sc[ML_E1 + tid] = -mx * LOG2E; sc[ML_E2 + tid] = as * LOG2E; sc[ML_WI + tid] = fexp(m0 - mx); sc[ML_EMT + tid] = fexp(-bc - mx); sc[ML_WS + tid] = fexp(as + blast - m1); sc[ML_RS + tid] = 0.f;
            if (tid == 0) sc[ML_WC] = fexp(blast + m0 - m1); }
        __syncthreads();
        if constexpr (!(SKIP & 64)) { if (n + 1 < NCH) ML_LOAD(n + 1); }
        f32x4 nu[4]; bf16x8 vf[2];
        if (wave >= 4) {
#pragma unroll 1
            for (int q = wave - 4; q < ((SKIP & 2) ? 0 : 10); q += 4) { const int tt = (q >= 6) ? 3 : (q >= 3) ? 2 : (q >= 1) ? 1 : 0; const int st = q - (tt * (tt + 1)) / 2;
                const int t = 16 * tt + l15; const float e1 = sc[ML_E1 + t];
                f32x4 s_ = (f32x4){0.f, 0.f, 0.f, 0.f};
#pragma unroll
                for (int ks = 0; ks < 8; ++ks) s_ = MFMA16(frag_row(Kt, ML_RSK, 16 * st, 32 * ks, lane), frag_row(Qt, ML_RSQ, 16 * tt, 32 * ks, lane), s_);
                float pv_[4]; float rs = 0.f;
#pragma unroll
                for (int r = 0; r < 4; ++r) { const int sidx = 16 * st + 4 * g + r; const float p = (sidx <= t) ? fexp2(e1 + sc[ML_E2 + sidx]) * s_[r] * 0.0625f : 0.f; pv_[r] = p; rs += p; }
                rs += __shfl_xor(rs, 16); rs += __shfl_xor(rs, 32);
                if (g == 0) atomicAdd((float*)(sc + ML_RS + t), rs);
                *(LAS unsigned long long*)(lds + ML_OFF_P + t * ML_RSP + (16 * st + 4 * g) * 2) = (unsigned long long)pk2(pv_[0], pv_[1]) | ((unsigned long long)pk2(pv_[2], pv_[3]) << 32); }
        } else {
#pragma unroll
            for (int tt = 0; tt < 4; ++tt) nu[tt] = (f32x4){0.f, 0.f, 0.f, 0.f};
#pragma unroll
            for (int j = 0; j < ((SKIP & 4) ? 0 : 8); ++j) { const bf16x8 cf = acc_pair_frag(cacc[2 * j], cacc[2 * j + 1]);
#pragma unroll
                for (int tt = 0; tt < 4; ++tt) nu[tt] = MFMA16(frag_row_perm(Qt, ML_RSQ, 16 * tt, 32 * j, lane), cf, nu[tt]);
                if (j & 1) __builtin_amdgcn_sched_barrier(0); }
            if constexpr (!(SKIP & 32)) { f32x4 qna = (f32x4){0.f, 0.f, 0.f, 0.f}; const LAS float* nvc = sc + ((n & 1) ? ML_NP : ML_NV);
#pragma unroll
              for (int j = 0; j < 8; ++j) { const f32x4 n0_ = *(LAS const f32x4*)(nvc + 32 * j + 4 * g), n1_ = *(LAS const f32x4*)(nvc + 32 * j + 16 + 4 * g);
                  qna = MFMA16(frag_row_perm(Qt, ML_RSQ, 16 * wave, 32 * j, lane), acc_pair_frag(n0_, n1_), qna); }
              if (l15 == 0) *(LAS f32x4*)(sc + ML_QN + 16 * wave + 4 * g) = qna * 0.0625f; }
            __builtin_amdgcn_sched_barrier(0);
#pragma unroll
            for (int tt = 0; tt < 4; ++tt) { const f32x4 wi = *(LAS const f32x4*)(sc + ML_WI + 16 * tt + 4 * g); nu[tt] *= wi * 0.0625f; }
            __builtin_amdgcn_sched_barrier(0);
#pragma unroll
            for (int ks = 0; ks < 2; ++ks) vf[ks] = frag_tr_perm(Vt, ML_RSV, 32 * ks, 16 * wave, lane);
            const float wc = sc[ML_WC];
            bf16x8 vw[2];
#pragma unroll
            for (int ks = 0; ks < 2; ++ks) { typedef unsigned u32x4_ __attribute__((ext_vector_type(4))); const u32x4_ w = __builtin_bit_cast(u32x4_, vf[ks]);
                const f32x4 wa = *(LAS const f32x4*)(sc + ML_WS + 32 * ks + 4 * g), wb = *(LAS const f32x4*)(sc + ML_WS + 32 * ks + 16 + 4 * g);
                const u32x4_ o = {pk2(__builtin_bit_cast(float, w.x << 16) * wa[0], __builtin_bit_cast(float, w.x & 0xffff0000u) * wa[1]), pk2(__builtin_bit_cast(float, w.y << 16) * wa[2], __builtin_bit_cast(float, w.y & 0xffff0000u) * wa[3]),
                                  pk2(__builtin_bit_cast(float, w.z << 16) * wb[0], __builtin_bit_cast(float, w.z & 0xffff0000u) * wb[1]), pk2(__builtin_bit_cast(float, w.w << 16) * wb[2], __builtin_bit_cast(float, w.w & 0xffff0000u) * wb[3])};
                vw[ks] = __builtin_bit_cast(bf16x8, o); }
#pragma unroll
            for (int kt = 0; kt < ((SKIP & 8) ? 0 : 16); ++kt) { cacc[kt] *= wc;
                cacc[kt] = MFMA16(frag_tr_perm(Kt, ML_RSK, 0, 16 * kt, lane), vw[0], cacc[kt]);
                cacc[kt] = MFMA16(frag_tr_perm(Kt, ML_RSK, 32, 16 * kt, lane), vw[1], cacc[kt]);
                if ((kt & 3) == 3) __builtin_amdgcn_sched_barrier(0); }
#pragma unroll
            for (int kt = 0; kt < 16; ++kt) asm volatile("" : "+v"(cacc[kt]));
            if constexpr (!(SKIP & 32)) { bf16x8 wsf[2];
#pragma unroll
              for (int ks = 0; ks < 2; ++ks) { const f32x4 w0_ = *(LAS const f32x4*)(sc + ML_WS + 32 * ks + 4 * g), w1_ = *(LAS const f32x4*)(sc + ML_WS + 32 * ks + 16 + 4 * g); wsf[ks] = acc_pair_frag(w0_, w1_); }
              const LAS float* nvo = sc + ((n & 1) ? ML_NP : ML_NV); LAS float* nvn = sc + ((n & 1) ? ML_NV : ML_NP);
#pragma unroll
              for (int i = 0; i < 4; ++i) { const int kt = 4 * wave + i; f32x4 na = (f32x4){0.f, 0.f, 0.f, 0.f};
                  na = MFMA16(frag_tr_perm(Kt, ML_RSK, 0, 16 * kt, lane), wsf[0], na); na = MFMA16(frag_tr_perm(Kt, ML_RSK, 32, 16 * kt, lane), wsf[1], na);
                  if (l15 == 0) *(LAS f32x4*)(nvn + 16 * kt + 4 * g) = *(LAS const f32x4*)(nvo + 16 * kt + 4 * g) * wc + na; } }
        }
        __syncthreads();
        if constexpr (!(SKIP & 1)) ML_LOAD_OZ(n);
        if (wave < 4) {
#pragma unroll
            for (int ks = 0; ks < ((SKIP & 16) ? 0 : 2); ++ks) {
#pragma unroll
                for (int tt = 0; tt < 4; ++tt) nu[tt] = MFMA16(frag_row_perm(Ps, ML_RSP, 16 * tt, 32 * ks, lane), vf[ks], nu[tt]); }
#pragma unroll
            for (int tt = 0; tt < 4; ++tt)
#pragma unroll
                for (int r = 0; r < 4; ++r) *(LAS unsigned short*)(lds + ML_OFF_H + (16 * tt + 4 * g + r) * ML_RSH + (16 * wave + l15) * 2) = (unsigned short)(pk2(nu[tt][r], 0.f) & 0xffffu);
            __builtin_amdgcn_sched_barrier(0);
        }
        __syncthreads();
        if constexpr (!(SKIP & 1)) { const float den = sc[ML_WI + ot] * sc[ML_QN + ot] + sc[ML_RS + ot]; const float inv = frcp(fmaxf(fabsf(den), sc[ML_EMT + ot]));
          const v4u hw = *(LAS const v4u*)(lds + ML_OFF_H + ot * ML_RSH + oc * 2); const v4u ow = oreg, zw = zreg;
#define ML_Y(hx, ox, zx, lo) (fsigmoid(__builtin_bit_cast(float, (lo) ? ((ox) << 16) : ((ox) & 0xffff0000u))) * (__builtin_bit_cast(float, (lo) ? ((hx) << 16) : ((hx) & 0xffff0000u)) * inv) * fsilu(__builtin_bit_cast(float, (lo) ? ((zx) << 16) : ((zx) & 0xffff0000u))))
          v4u yw; yw.x = pk2(ML_Y(hw.x, ow.x, zw.x, 1), ML_Y(hw.x, ow.x, zw.x, 0)); yw.y = pk2(ML_Y(hw.y, ow.y, zw.y, 1), ML_Y(hw.y, ow.y, zw.y, 0));
          yw.z = pk2(ML_Y(hw.z, ow.z, zw.z, 1), ML_Y(hw.z, ow.z, zw.z, 0)); yw.w = pk2(ML_Y(hw.w, ow.w, zw.w, 1), ML_Y(hw.w, ow.w, zw.w, 0));
#undef ML_Y
          *(v4u*)(Y + (tok0 + n * 64 + ot) * D_MODEL + W_A + ocol) = yw; }
    }
#undef ML_LOAD
#undef ML_LOAD_OZ
#undef ML_STORE
    __syncthreads();
}
constexpr int RG_RSG = 160, RG_RSX = 272, RG_RSF = 33 * 4;
constexpr int RG_OFF_G = 0, RG_OFF_X = RG_OFF_G + 128 * RG_RSG, RG_OFF_XF = RG_OFF_X + 64 * RG_RSX, RG_OFF_A = RG_OFF_XF + 64 * RG_RSF, RG_OFF_I = RG_OFF_A + 64 * RG_RSF, RG_OFF_H = RG_OFF_I + 64 * RG_RSF, RG_LDS = RG_OFF_H + 64 * RG_RSF;
static_assert(RG_LDS <= 163328, "RG-LRU LDS");
template <int SKIP = 0> __device__ __forceinline__ void rglru_item(const Ptrs& P, LAS unsigned char* lds, int item, size_t yoff = WS_Y) {
    const bf16_t* __restrict__ PROJ = (const bf16_t*)(P.ws + WS_PROJ); bf16_t* __restrict__ Y = (bf16_t*)(P.ws + yoff);
    const float* __restrict__ ccw = P.in[IN_OD_CCW]; const float* __restrict__ ccb = P.in[IN_OD_CCB]; const float* __restrict__ gw = P.in[IN_OD_GW]; const float* __restrict__ gb = P.in[IN_OD_GB]; const float* __restrict__ lam = P.in[IN_OD_LAM];
    const int tid = threadIdx.x, lane = tid & 63, wave = tid >> 6, g = lane >> 4, l15 = lane & 15;
    const int cq = item & 3, blk = (item >> 2) & 7, b = item >> 5;
    const size_t tok0 = (size_t)b * SEQ;
#pragma unroll
    for (int e = tid; e < 128 * 64; e += 512) { const int k = e >> 6, c = e & 63; const int d = (c < 32) ? (cq * 32 + c) : (128 + cq * 32 + c - 32);
        *(LAS unsigned short*)(lds + RG_OFF_G + k * RG_RSG + c * 2) = (unsigned short)f2bf(gw[((size_t)blk * 128 + k) * 256 + d]); }
    const int c8 = tid & 15, tq = tid >> 4, ch0 = blk * 128 + 8 * c8;
    float cw[4][8], cb[8];
#pragma unroll
    for (int i = 0; i < 8; ++i) { cb[i] = ccb[ch0 + i];
#pragma unroll
        for (int j = 0; j < 4; ++j) cw[j][i] = ccw[j * W_C + ch0 + i]; }
    const int chl = 16 * (wave & 1) + l15, cgl = blk * 128 + cq * 32 + chl;
    const float gbr = gb[cgl], gbi = gb[W_C + cgl], sp = softplusf_(-lam[cgl]);
    float hcar = 0.f;
    v4u xin[2][4]; unsigned long long zin = 0ull;
    const int ot = tid >> 3, oc4 = tid & 7, cgo = blk * 128 + cq * 32 + 4 * oc4;
#define RG_LOAD(n) do { _Pragma("unroll") for (int u_ = 0; u_ < 2; ++u_) { const int s_ = (n) * 64 + tq + 32 * u_; \
            _Pragma("unroll") for (int j_ = 0; j_ < 4; ++j_) { const bool ok_ = (s_ - 3 + j_ >= 0); const v4u x_ = *(const v4u*)(PROJ + (tok0 + (ok_ ? s_ - 3 + j_ : 0)) * OD_N + OC_XC + ch0); \
                xin[u_][j_].x = ok_ ? x_.x : 0u; xin[u_][j_].y = ok_ ? x_.y : 0u; xin[u_][j_].z = ok_ ? x_.z : 0u; xin[u_][j_].w = ok_ ? x_.w : 0u; } } \
        zin = *(const unsigned long long*)(PROJ + (tok0 + (n) * 64 + ot) * OD_N + OC_ZC + cgo); } while (0)
    RG_LOAD(0);
    __syncthreads();
    for (int n = 0; n < NCH; ++n) {
        const unsigned long long zw = zin;
#pragma unroll
        for (int u = 0; u < ((SKIP & 1) ? 0 : 2); ++u) { const int t = tq + 32 * u; float xv[8];
#pragma unroll
            for (int i = 0; i < 8; ++i) xv[i] = cb[i];
#pragma unroll
            for (int j = 0; j < 4; ++j) { const v4u w_ = xin[u][j];
                xv[0] += cw[j][0] * __builtin_bit_cast(float, w_.x << 16); xv[1] += cw[j][1] * __builtin_bit_cast(float, w_.x & 0xffff0000u); xv[2] += cw[j][2] * __builtin_bit_cast(float, w_.y << 16); xv[3] += cw[j][3] * __builtin_bit_cast(float, w_.y & 0xffff0000u);
                xv[4] += cw[j][4] * __builtin_bit_cast(float, w_.z << 16); xv[5] += cw[j][5] * __builtin_bit_cast(float, w_.z & 0xffff0000u); xv[6] += cw[j][6] * __builtin_bit_cast(float, w_.w << 16); xv[7] += cw[j][7] * __builtin_bit_cast(float, w_.w & 0xffff0000u); }
            v4u w; w.x = pk2(xv[0], xv[1]); w.y = pk2(xv[2], xv[3]); w.z = pk2(xv[4], xv[5]); w.w = pk2(xv[6], xv[7]);
            *(LAS v4u*)(lds + RG_OFF_X + t * RG_RSX + c8 * 16) = w;
            if ((c8 >> 2) == cq) { LAS float* xf = (LAS float*)(lds + RG_OFF_XF + t * RG_RSF) + 8 * (c8 & 3);
#pragma unroll
                for (int i = 0; i < 8; ++i) xf[i] = xv[i]; } }
        if (n + 1 < NCH) RG_LOAD(n + 1);
        __syncthreads();
        { const int tt = wave >> 1, cp = wave & 1; f32x4 ar = (f32x4){0.f, 0.f, 0.f, 0.f}, ai = ar;
#pragma unroll
          for (int ks = 0; ks < ((SKIP & 2) ? 0 : 4); ++ks) { const bf16x8 xa = frag_row(lds + RG_OFF_X, RG_RSX, 16 * tt, 32 * ks, lane);
              ar = MFMA16(xa, frag_tr(lds + RG_OFF_G, RG_RSG, 32 * ks, 16 * cp, lane), ar);
              ai = MFMA16(xa, frag_tr(lds + RG_OFF_G, RG_RSG, 32 * ks, 32 + 16 * cp, lane), ai); }
#pragma unroll
          for (int r = 0; r < ((SKIP & 4) ? 0 : 4); ++r) { const int t = 16 * tt + 4 * g + r;
              const float rr = fsigmoid(ar[r] + gbr), ig = fsigmoid(ai[r] + gbi); const float la = -8.0f * rr * sp;
              const float xc = *((LAS const float*)(lds + RG_OFF_XF + t * RG_RSF) + chl);
              *((LAS float*)(lds + RG_OFF_A + t * RG_RSF) + chl) = fexp(la);
              *((LAS float*)(lds + RG_OFF_I + t * RG_RSF) + chl) = fsqrt(1.0f - fexp(2.0f * la)) * (ig * xc); } }
        __syncthreads();
        if ((SKIP & 8) == 0 && tid < 32) { float h = hcar;
#pragma unroll 8
            for (int t = 0; t < 64; ++t) { h = *((LAS const float*)(lds + RG_OFF_A + t * RG_RSF) + tid) * h + *((LAS const float*)(lds + RG_OFF_I + t * RG_RSF) + tid);
                *((LAS float*)(lds + RG_OFF_H + t * RG_RSF) + tid) = h; }
            hcar = h; }
        __syncthreads();
        if constexpr (!(SKIP & 16)) { const size_t tok = tok0 + n * 64 + ot;
          const LAS float* hp = (LAS const float*)(lds + RG_OFF_H + ot * RG_RSF) + 4 * oc4;
          const float z0 = __builtin_bit_cast(float, (unsigned)(zw & 0xffffull) << 16), z1 = __builtin_bit_cast(float, (unsigned)(zw >> 16 & 0xffffull) << 16), z2 = __builtin_bit_cast(float, (unsigned)(zw >> 32 & 0xffffull) << 16), z3 = __builtin_bit_cast(float, (unsigned)(zw >> 48) << 16);
          *(unsigned long long*)(Y + tok * D_MODEL + cgo) = (unsigned long long)pk2(hp[0] * fsilu(z0), hp[1] * fsilu(z1)) | ((unsigned long long)pk2(hp[2] * fsilu(z2), hp[3] * fsilu(z3)) << 32); }
    }
#undef RG_LOAD
    __syncthreads();
}
constexpr size_t WS_DQ2 = 4 * MiB, WS_DK2 = 36 * MiB;
constexpr size_t WS_DWT = WS_XB, WS_DUT = WS_XB + 32 * MiB;
constexpr size_t WS_DQK = WS_FREE1, WS_DDEC = WS_FREE1 + 16 * MiB;
constexpr float DN_SCALE = 0.08838834764831845f;
template <int T> struct SolveRows {
    static __device__ __forceinline__ void run(float (&col)[32], LAS const unsigned char* Ab, int j) {
        SolveRows<T - 1>::run(col, Ab, j);
        float v = (T == j) ? 1.f : 0.f;
#pragma unroll
        for (int s4 = 0; s4 < (T + 3) / 4; ++s4) { const f32x4 a = *(LAS const f32x4*)(Ab + T * 272 + 16 * s4);
#pragma unroll
            for (int e = 0; e < 4; ++e) { if (4 * s4 + e < T) v -= a[e] * col[4 * s4 + e]; } }
        asm volatile("" : "+v"(v) :: "memory"); col[T] = v;
    }
};
template <> struct SolveRows<-1> { static __device__ __forceinline__ void run(float (&)[32], LAS const unsigned char*, int) {} };
constexpr int D1_RSQ = 272, D1_RSK = 288, D1_RSV = 288, D1_RSA = 272, D1_RST = 160;
constexpr int D1_OFF_Q = 0, D1_OFF_K = D1_OFF_Q + 64 * D1_RSQ, D1_OFF_V = D1_OFF_K + 64 * D1_RSK, D1_OFF_A = D1_OFF_V + 64 * D1_RSV, D1_OFF_T = D1_OFF_A + 64 * D1_RSA, D1_OFF_S = D1_OFF_T + 64 * D1_RST, D1_LDS = D1_OFF_S + 512;
static_assert(D1_LDS <= 163328, "D1 LDS");
template <int SKIP = 0> __device__ __forceinline__ void dn1_item(const Ptrs& P, LAS unsigned char* lds, int item) {
    const bf16_t* __restrict__ PROJ = (const bf16_t*)(P.ws + WS_PROJ); const float* __restrict__ AB = (const float*)(P.ws + WS_AB); const float* __restrict__ cdw = P.in[IN_OD_CDW];
    bf16_t* __restrict__ Q2 = (bf16_t*)(P.ws + WS_DQ2); bf16_t* __restrict__ K2 = (bf16_t*)(P.ws + WS_DK2);
    bf16_t* __restrict__ WTg = (bf16_t*)(P.ws + WS_DWT) + (size_t)item * 8192; bf16_t* __restrict__ UTg = (bf16_t*)(P.ws + WS_DUT) + (size_t)item * 8192;
    bf16_t* __restrict__ QKg = (bf16_t*)(P.ws + WS_DQK) + (size_t)item * 4096; float* __restrict__ DECg = (float*)(P.ws + WS_DDEC) + (size_t)item * 64;
    int tid_ = threadIdx.x; asm volatile("" : "+v"(tid_));
    const int tid = tid_, lane = tid & 63, wave = tid >> 6, g = lane >> 4, l15 = lane & 15;
    const int n = item & 31, h = (item >> 5) & 7, b = item >> 8;
    const size_t tok0 = (size_t)b * SEQ + n * 64;
    LAS float* beta_s = (LAS float*)(lds + D1_OFF_S); LAS float* dec_s = beta_s + 64;
    const float ab_a = AB[(tok0 + lane) * 16 + h], ab_b = AB[(tok0 + lane) * 16 + 8 + h], alog_ = P.in[IN_OD_ALOG][h], dtb_ = P.in[IN_OD_DTB][h];
    asm volatile("" ::: "memory");
    if constexpr (!(SKIP & 1)) { const int t = tid >> 3, d16 = tid & 7, s = n * 64 + t; float qk_[2][16]; float ssq[2] = {0.f, 0.f};
#pragma unroll
      for (int pp = 0; pp < 3; ++pp) { const int p = (pp + 2) % 3;
#pragma unroll
          for (int hf = 0; hf < 2; ++hf) { const int col = p * W_D + h * 128 + 16 * d16 + 8 * hf; float a[8];
              v4u xw[4];
#pragma unroll
              for (int j = 0; j < 4; ++j) { const bool ok = (s - 3 + j >= 0); xw[j] = *(const v4u*)(PROJ + (ok ? tok0 + t - 3 + j : tok0) * OD_N + OC_QD + col); }
#pragma unroll
              for (int i = 0; i < 8; ++i) a[i] = 0.f;
#pragma unroll
              for (int j = 0; j < 4; ++j) { const float m_ = (s - 3 + j >= 0) ? 1.0f : 0.0f; const f32x4 w0 = *(const f32x4*)(cdw + j * 3 * W_D + col) * m_, w1 = *(const f32x4*)(cdw + j * 3 * W_D + col + 4) * m_; const v4u x_ = xw[j];
                  a[0] += w0[0] * __builtin_bit_cast(float, x_.x << 16); a[1] += w0[1] * __builtin_bit_cast(float, x_.x & 0xffff0000u); a[2] += w0[2] * __builtin_bit_cast(float, x_.y << 16); a[3] += w0[3] * __builtin_bit_cast(float, x_.y & 0xffff0000u);
                  a[4] += w1[0] * __builtin_bit_cast(float, x_.z << 16); a[5] += w1[1] * __builtin_bit_cast(float, x_.z & 0xffff0000u); a[6] += w1[2] * __builtin_bit_cast(float, x_.w << 16); a[7] += w1[3] * __builtin_bit_cast(float, x_.w & 0xffff0000u); }
#pragma unroll
              for (int i = 0; i < 8; ++i) a[i] = fsilu(a[i]);
              if (p < 2) {
#pragma unroll
                  for (int i = 0; i < 8; ++i) { qk_[p][8 * hf + i] = a[i]; ssq[p] += a[i] * a[i]; } }
              else { v4u w; w.x = pk2(a[0], a[1]); w.y = pk2(a[2], a[3]); w.z = pk2(a[4], a[5]); w.w = pk2(a[6], a[7]);
                  *(LAS v4u*)(lds + D1_OFF_V + t * D1_RSV + (16 * d16 + 8 * hf) * 2) = w; }
              asm volatile("" ::: "memory"); } }
#pragma unroll
      for (int p = 0; p < 2; ++p) { float ss = ssq[p]; ss += __shfl_xor(ss, 1); ss += __shfl_xor(ss, 2); ss += __shfl_xor(ss, 4); const float rs = frsq(ss + EPS);
#pragma unroll
          for (int hf = 0; hf < 2; ++hf) { v4u w; w.x = pk2(qk_[p][8 * hf + 0] * rs, qk_[p][8 * hf + 1] * rs); w.y = pk2(qk_[p][8 * hf + 2] * rs, qk_[p][8 * hf + 3] * rs);
              w.z = pk2(qk_[p][8 * hf + 4] * rs, qk_[p][8 * hf + 5] * rs); w.w = pk2(qk_[p][8 * hf + 6] * rs, qk_[p][8 * hf + 7] * rs);
              const int dd = 16 * d16 + 8 * hf;
              if (p == 0) { *(LAS v4u*)(lds + D1_OFF_Q + t * D1_RSQ + dd * 2) = w; *(v4u*)(Q2 + (tok0 + t) * W_D + h * 128 + dd) = w; }
              else { *(LAS v4u*)(lds + D1_OFF_K + t * D1_RSK + dd * 2) = w; *(v4u*)(K2 + (tok0 + t) * W_D + h * 128 + dd) = w; } } } }
    if (wave == 0) {
        const float beta = fsigmoid(ab_b); float dc = -fexp(alog_) * softplusf_(ab_a + dtb_);
#pragma unroll
        for (int o = 1; o < 64; o <<= 1) { const float t_ = __shfl_up(dc, o); if (lane >= o) dc += t_; }
        beta_s[lane] = beta; dec_s[lane] = dc; DECg[lane] = dc; }
    __syncthreads();
    { const int tt = wave >> 1, t = 16 * tt + l15; const float dt_ = dec_s[t], bt = beta_s[t];
#pragma unroll
      for (int u = 0; u < 2; ++u) { const int st = 2 * (wave & 1) + u; unsigned long long qw = 0ull;
          if (st <= tt && !(SKIP & 2)) { f32x4 kk = (f32x4){0.f, 0.f, 0.f, 0.f}, qk = kk;
#pragma unroll
              for (int ks = 0; ks < 4; ++ks) { const bf16x8 a = frag_row(lds + D1_OFF_K, D1_RSK, 16 * st, 32 * ks, lane);
                  kk = MFMA16(a, frag_row(lds + D1_OFF_K, D1_RSK, 16 * tt, 32 * ks, lane), kk); qk = MFMA16(a, frag_row(lds + D1_OFF_Q, D1_RSQ, 16 * tt, 32 * ks, lane), qk); }
              f32x4 am; float qv[4];
#pragma unroll
              for (int r = 0; r < 4; ++r) { const int s = 16 * st + 4 * g + r; const float gam = (s <= t) ? fexp(dt_ - dec_s[s]) : 0.f; am[r] = (s < t) ? bt * kk[r] * gam : 0.f; qv[r] = qk[r] * gam * DN_SCALE; }
              *(LAS f32x4*)(lds + D1_OFF_A + t * D1_RSA + (16 * st + 4 * g) * 4) = am;
              qw = (unsigned long long)pk2(qv[0], qv[1]) | ((unsigned long long)pk2(qv[2], qv[3]) << 32); }
          *(unsigned long long*)(QKg + t * 64 + 16 * st + 4 * g) = qw; } }
    __syncthreads();
    if (wave == 0 && !(SKIP & 4)) { const int hb = lane >> 5, j = lane & 31; float col[32];
        LAS const unsigned char* Ab = lds + D1_OFF_A + (32 * hb) * D1_RSA + (32 * hb) * 4;
        SolveRows<31>::run(col, Ab, j);
        LAS unsigned char* trow = lds + D1_OFF_T + (32 * hb + j) * D1_RST;
#pragma unroll
        for (int c = 0; c < 4; ++c) { v4u w; w.x = pk2(col[8 * c], col[8 * c + 1]); w.y = pk2(col[8 * c + 2], col[8 * c + 3]); w.z = pk2(col[8 * c + 4], col[8 * c + 5]); w.w = pk2(col[8 * c + 6], col[8 * c + 7]);
            *(LAS v4u*)(trow + (32 * hb) * 2 + 16 * c) = w;
            if (hb) *(LAS v4u*)(trow + 16 * c) = (v4u){0u, 0u, 0u, 0u}; }
        bf16x8 af[2], bfr[2];
#pragma unroll
        for (int ti = 0; ti < 2; ++ti) { LAS const unsigned char* ap = lds + D1_OFF_A + (32 + 16 * ti + l15) * D1_RSA + (8 * g) * 4; const f32x4 a0 = *(LAS const f32x4*)ap, a1 = *(LAS const f32x4*)(ap + 16);
            typedef unsigned u32x4_ __attribute__((ext_vector_type(4))); const u32x4_ w = {pk2(a0[0], a0[1]), pk2(a0[2], a0[3]), pk2(a1[0], a1[1]), pk2(a1[2], a1[3])}; af[ti] = __builtin_bit_cast(bf16x8, w); }
#pragma unroll
        for (int nj = 0; nj < 2; ++nj) bfr[nj] = frag_row(lds + D1_OFF_T, D1_RST, 16 * nj, 0, lane);
        f32x4 X[2][2];
#pragma unroll
        for (int ti = 0; ti < 2; ++ti)
#pragma unroll
            for (int nj = 0; nj < 2; ++nj) X[ti][nj] = MFMA16(af[ti], bfr[nj], ((f32x4){0.f, 0.f, 0.f, 0.f}));
        LAS const unsigned char* T11b = lds + D1_OFF_T + 32 * D1_RST + 64;
#pragma unroll
        for (int nj = 0; nj < 2; ++nj) { const bf16x8 xb = acc_pair_frag(X[0][nj], X[1][nj]);
#pragma unroll
            for (int ti = 0; ti < 2; ++ti) { const f32x4 r_ = MFMA16(frag_tr_perm(T11b, D1_RST, 0, 16 * ti, lane), xb, ((f32x4){0.f, 0.f, 0.f, 0.f}));
                *(LAS unsigned long long*)(lds + D1_OFF_T + (16 * nj + l15) * D1_RST + (32 + 16 * ti + 4 * g) * 2) = (unsigned long long)pk2(-r_[0], -r_[1]) | ((unsigned long long)pk2(-r_[2], -r_[3]) << 32); } }
    }
    __syncthreads();
    if constexpr (!(SKIP & 8)) { bf16x8 bv[2], bk[2];
#pragma unroll
      for (int ks = 0; ks < 2; ++ks) { typedef unsigned u32x4_ __attribute__((ext_vector_type(4)));
          const u32x4_ wv = __builtin_bit_cast(u32x4_, frag_tr(lds + D1_OFF_V, D1_RSV, 32 * ks, 16 * wave, lane)), wk = __builtin_bit_cast(u32x4_, frag_tr(lds + D1_OFF_K, D1_RSK, 32 * ks, 16 * wave, lane));
          float fb[8], fk[8];
#pragma unroll
          for (int i = 0; i < 8; ++i) { const int s = 32 * ks + 8 * g + i; fb[i] = beta_s[s]; fk[i] = fb[i] * fexp(dec_s[s]); }
#define SC2(w_, f0, f1) pk2(__builtin_bit_cast(float, (w_) << 16) * (f0), __builtin_bit_cast(float, (w_) & 0xffff0000u) * (f1))
          const u32x4_ ov = {SC2(wv.x, fb[0], fb[1]), SC2(wv.y, fb[2], fb[3]), SC2(wv.z, fb[4], fb[5]), SC2(wv.w, fb[6], fb[7])};
          const u32x4_ ok = {SC2(wk.x, fk[0], fk[1]), SC2(wk.y, fk[2], fk[3]), SC2(wk.z, fk[4], fk[5]), SC2(wk.w, fk[6], fk[7])};
#undef SC2
          bv[ks] = __builtin_bit_cast(bf16x8, ov); bk[ks] = __builtin_bit_cast(bf16x8, ok); }
#pragma unroll
      for (int tt = 0; tt < 4; ++tt) { f32x4 u = (f32x4){0.f, 0.f, 0.f, 0.f}, wv = u;
#pragma unroll
          for (int ks = 0; ks < 2; ++ks) { const bf16x8 at = frag_tr(lds + D1_OFF_T, D1_RST, 32 * ks, 16 * tt, lane); u = MFMA16(at, bv[ks], u); wv = MFMA16(at, bk[ks], wv); }
          const size_t o_ = (size_t)(16 * wave + l15) * 64 + 16 * tt + 4 * g;
          *(unsigned long long*)(UTg + o_) = (unsigned long long)pk2(u[0], u[1]) | ((unsigned long long)pk2(u[2], u[3]) << 32);
          *(unsigned long long*)(WTg + o_) = (unsigned long long)pk2(wv[0], wv[1]) | ((unsigned long long)pk2(wv[2], wv[3]) << 32); } }
    __syncthreads();
}
constexpr int D2_RSW = 144, D2_RSQ = 272, D2_RSK = 288, D2_RSP = 144, D2_RSO = 528;
constexpr int D2_OFF_W = 0, D2_OFF_Q = D2_OFF_W + 128 * D2_RSW, D2_OFF_K = D2_OFF_Q + 64 * D2_RSQ, D2_OFF_P = D2_OFF_K + 64 * D2_RSK, D2_OFF_O = D2_OFF_P + 64 * D2_RSP, D2_OFF_D = D2_OFF_O + 64 * D2_RSO, D2_LDS = D2_OFF_D + 1024;
static_assert(D2_LDS <= 163328, "D2 LDS");
template <int SKIP = 0> __device__ __forceinline__ void dn2_item(const Ptrs& P, LAS unsigned char* lds, int item, size_t yoff = WS_Y) {
    const bf16_t* __restrict__ PROJ = (const bf16_t*)(P.ws + WS_PROJ); bf16_t* __restrict__ Y = (bf16_t*)(P.ws + yoff);
    const bf16_t* __restrict__ Q2 = (const bf16_t*)(P.ws + WS_DQ2); const bf16_t* __restrict__ K2 = (const bf16_t*)(P.ws + WS_DK2);
    const int tid = threadIdx.x, lane = tid & 63, wave = tid >> 6, g = lane >> 4, l15 = lane & 15;
    const int h = item & 7, b = item >> 3;
    const size_t tok0 = (size_t)b * SEQ; const int it0 = item * 32;
    const bf16_t* __restrict__ WTg = (const bf16_t*)(P.ws + WS_DWT) + (size_t)it0 * 8192; const bf16_t* __restrict__ UTg = (const bf16_t*)(P.ws + WS_DUT) + (size_t)it0 * 8192;
    const bf16_t* __restrict__ QKg = (const bf16_t*)(P.ws + WS_DQK) + (size_t)it0 * 4096; const float* __restrict__ DECg = (const float*)(P.ws + WS_DDEC) + (size_t)it0 * 64;
    LAS float* ed_s = (LAS float*)(lds + D2_OFF_D); LAS float* ek_s = ed_s + 64; LAS float* edl_s = ed_s + 128;
    f32x4 sacc[8];
#pragma unroll
    for (int i = 0; i < 8; ++i) sacc[i] = (f32x4){0.f, 0.f, 0.f, 0.f};
    const int ot = tid >> 3, oc = (tid & 7) * 16;
    float og[16];
#pragma unroll
    for (int i = 0; i < 16; ++i) og[i] = P.in[IN_OD_ONORM][oc + i];
    v4u wreg[2], qreg[2], kreg[2], preg, zreg[2]; unsigned long long ureg[4]; float dreg = 0.f, dlreg = 0.f;
#define D2_LOAD(n) do { _Pragma("unroll") for (int i_ = 0; i_ < 2; ++i_) { const int id_ = tid + 512 * i_; wreg[i_] = *(const v4u*)(WTg + (size_t)(n) * 8192 + id_ * 8); \
            const int row_ = id_ >> 4, ch_ = id_ & 15; const size_t o2_ = (tok0 + (n) * 64 + row_) * W_D + h * 128 + ch_ * 8; qreg[i_] = *(const v4u*)(Q2 + o2_); kreg[i_] = *(const v4u*)(K2 + o2_); } \
        preg = *(const v4u*)(QKg + (size_t)(n) * 4096 + tid * 8); \
        _Pragma("unroll") for (int tt_ = 0; tt_ < 4; ++tt_) ureg[tt_] = *(const unsigned long long*)(UTg + (size_t)(n) * 8192 + (16 * wave + l15) * 64 + 16 * tt_ + 4 * g); \
        if (tid < 64) { dreg = DECg[(n) * 64 + tid]; dlreg = DECg[(n) * 64 + 63]; } } while (0)
#define D2_LOAD_Z(n) do { const bf16_t* zp_ = PROJ + (tok0 + (n) * 64 + ot) * OD_N + OC_ZD + h * 128 + oc; zreg[0] = *(const v4u*)zp_; zreg[1] = *(const v4u*)(zp_ + 8); } while (0)
#define D2_STORE() do { _Pragma("unroll") for (int i_ = 0; i_ < 2; ++i_) { const int id_ = tid + 512 * i_; *(LAS v4u*)(lds + D2_OFF_W + (id_ >> 3) * D2_RSW + (id_ & 7) * 16) = wreg[i_]; \
            const int row_ = id_ >> 4, ch_ = id_ & 15; *(LAS v4u*)(lds + D2_OFF_Q + row_ * D2_RSQ + ch_ * 16) = qreg[i_]; *(LAS v4u*)(lds + D2_OFF_K + row_ * D2_RSK + ch_ * 16) = kreg[i_]; } \
        *(LAS v4u*)(lds + D2_OFF_P + (tid >> 3) * D2_RSP + (tid & 7) * 16) = preg; \
        if (tid < 64) { ed_s[tid] = fexp(dreg) * DN_SCALE; ek_s[tid] = fexp(dlreg - dreg); if (tid == 0) edl_s[0] = fexp(dlreg); } } while (0)
    D2_LOAD(0);
    for (int n = 0; n < NCH; ++n) {
        if constexpr (!(SKIP & 16)) D2_STORE();
        f32x4 un[4];
#pragma unroll
        for (int tt = 0; tt < 4; ++tt) { un[tt][0] = __builtin_bit_cast(float, (unsigned)(ureg[tt] & 0xffffull) << 16); un[tt][1] = __builtin_bit_cast(float, (unsigned)(ureg[tt] >> 16 & 0xffffull) << 16);
            un[tt][2] = __builtin_bit_cast(float, (unsigned)(ureg[tt] >> 32 & 0xffffull) << 16); un[tt][3] = __builtin_bit_cast(float, (unsigned)(ureg[tt] >> 48) << 16); }
        __syncthreads();
        if constexpr (!(SKIP & 16)) { if (n + 1 < NCH) D2_LOAD(n + 1); }
        bf16x8 sf[4];
#pragma unroll
        for (int j = 0; j < 4; ++j) sf[j] = acc_pair_frag(sacc[2 * j], sacc[2 * j + 1]);
        f32x4 vn[4], o[4];
#pragma unroll
        for (int tt = 0; tt < 4; ++tt) { f32x4 ws_ = (f32x4){0.f, 0.f, 0.f, 0.f}, qs_ = ws_;
#pragma unroll
            for (int j = 0; j < ((SKIP & 2) ? 0 : 4); ++j) { ws_ = MFMA16(frag_tr_perm(lds + D2_OFF_W, D2_RSW, 32 * j, 16 * tt, lane), sf[j], ws_); qs_ = MFMA16(frag_row_perm(lds + D2_OFF_Q, D2_RSQ, 16 * tt, 32 * j, lane), sf[j], qs_); }
            vn[tt] = un[tt] - ws_; o[tt] = qs_ * *(LAS const f32x4*)(ed_s + 16 * tt + 4 * g); }
        __builtin_amdgcn_sched_barrier(0);
        bf16x8 vf[2], vsf[2];
#pragma unroll
        for (int ks = 0; ks < 2; ++ks) { vf[ks] = acc_pair_frag(vn[2 * ks], vn[2 * ks + 1]);
            const f32x4 a_ = vn[2 * ks] * *(LAS const f32x4*)(ek_s + 32 * ks + 4 * g), b_ = vn[2 * ks + 1] * *(LAS const f32x4*)(ek_s + 32 * ks + 16 + 4 * g);
            vsf[ks] = acc_pair_frag(a_, b_); }
#pragma unroll
        for (int tt = 0; tt < 4; ++tt)
#pragma unroll
            for (int ks = 0; ks < ((SKIP & 4) ? 0 : 2); ++ks) o[tt] = MFMA16(frag_row_perm(lds + D2_OFF_P, D2_RSP, 16 * tt, 32 * ks, lane), vf[ks], o[tt]);
#pragma unroll
        for (int tt = 0; tt < 4; ++tt)
#pragma unroll
            for (int r = 0; r < 4; ++r) *(LAS float*)(lds + D2_OFF_O + (16 * tt + 4 * g + r) * D2_RSO + (16 * wave + l15) * 4) = o[tt][r];
        __builtin_amdgcn_sched_barrier(0);
        if constexpr (!(SKIP & 1)) D2_LOAD_Z(n);
        { const float edl = edl_s[0];
#pragma unroll
          for (int kt = 0; kt < ((SKIP & 8) ? 0 : 8); ++kt) { sacc[kt] *= edl;
#pragma unroll
              for (int ks = 0; ks < 2; ++ks) sacc[kt] = MFMA16(frag_tr_perm(lds + D2_OFF_K, D2_RSK, 32 * ks, 16 * kt, lane), vsf[ks], sacc[kt]);
              if ((kt & 3) == 3) __builtin_amdgcn_sched_barrier(0); }
#pragma unroll
          for (int kt = 0; kt < 8; ++kt) asm volatile("" : "+v"(sacc[kt])); }
        __syncthreads();
        if constexpr (!(SKIP & 1)) { f32x4 ov[4]; float ss = 0.f;
#pragma unroll
          for (int c = 0; c < 4; ++c) { ov[c] = *(LAS const f32x4*)(lds + D2_OFF_O + ot * D2_RSO + (oc + 4 * c) * 4); ss += (ov[c][0] * ov[c][0] + ov[c][1] * ov[c][1]) + (ov[c][2] * ov[c][2] + ov[c][3] * ov[c][3]); }
          ss += __shfl_xor(ss, 1); ss += __shfl_xor(ss, 2); ss += __shfl_xor(ss, 4);
          const float rs = frsq(ss * (1.0f / 128.0f) + EPS);
          bf16_t* yp = Y + (tok0 + n * 64 + ot) * D_MODEL + W_C + h * 128 + oc;
#pragma unroll
          for (int c = 0; c < 2; ++c) { const v4u zw = zreg[c]; const f32x4 a = ov[2 * c], b_ = ov[2 * c + 1];
#define D2_Y(ov_, gi, zx, lo) ((ov_) * rs * og[gi] * fsilu(__builtin_bit_cast(float, (lo) ? ((zx) << 16) : ((zx) & 0xffff0000u))))
              v4u yw; yw.x = pk2(D2_Y(a[0], 8 * c + 0, zw.x, 1), D2_Y(a[1], 8 * c + 1, zw.x, 0)); yw.y = pk2(D2_Y(a[2], 8 * c + 2, zw.y, 1), D2_Y(a[3], 8 * c + 3, zw.y, 0));
              yw.z = pk2(D2_Y(b_[0], 8 * c + 4, zw.z, 1), D2_Y(b_[1], 8 * c + 5, zw.z, 0)); yw.w = pk2(D2_Y(b_[2], 8 * c + 6, zw.w, 1), D2_Y(b_[3], 8 * c + 7, zw.w, 0));
#undef D2_Y
              *(v4u*)(yp + 8 * c) = yw; } }
    }
#undef D2_LOAD
#undef D2_LOAD_Z
#undef D2_STORE
    __syncthreads();
}
__device__ __forceinline__ void phase_mix0(const Ptrs& P, LAS unsigned char* lds, int G) {
    const int w = blockIdx.x;
    constexpr int NML = BATCH * H_B * 4;
    if (w < NML) mlstm_item(P, lds, w);
    else if (G - NML == 128) {
        const int wa = w - NML, bhp = wa >> 2, k0 = wa & 3;
        for (int k = 3; k >= 0; --k) attn2_item(P, lds, bhp * 16 + 4 * k + k0); }
    else { for (int item = w - NML; item < BATCH * H_A * (NCH / 2); item += G - NML) attn_item(P, lds, item); }
    { const int wave = threadIdx.x >> 6, lane = threadIdx.x & 63; late_weights(P, lds, wave, lane, w * NWAVES + wave, G * NWAVES); }
}
__device__ __forceinline__ void phase_mix1a(const Ptrs& P, LAS unsigned char* lds, int G) {
    const int w = blockIdx.x; constexpr int ND1 = BATCH * H_D * NCH, NRG = BATCH * N_BLK_C * 4;
    if (G == 256) {
        if (w < 64) rglru_item<0>(P, lds, 192 + w);
        else { const int wd = w - 64; const int cnt = wd < 128 ? 11 : 10, first = wd < 128 ? wd * 11 : 1408 + (wd - 128) * 10;
            for (int i = 0; i < cnt; ++i) dn1_item(P, lds, first + i); }
    } else {
        for (int it = 192 + w; it < NRG; it += G) rglru_item<0>(P, lds, it);
        for (int it = w; it < ND1; it += G) dn1_item(P, lds, it); }
}
__device__ __forceinline__ void phase_mix1b(const Ptrs& P, LAS unsigned char* lds, int G) {
    constexpr int ND2 = BATCH * H_D;
    if ((int)blockIdx.x < ND2) dn2_item(P, lds, blockIdx.x);
    else { for (int it = blockIdx.x - ND2; it < 192; it += G - ND2) rglru_item<0>(P, lds, it);
        const int wave = threadIdx.x >> 6, lane = threadIdx.x & 63; last_weight(P, lds, wave, lane, (blockIdx.x - ND2) * NWAVES + wave, (G - ND2) * NWAVES); }
}
typedef GAS unsigned gu32;
#define RLX_AGENT __ATOMIC_RELAXED, __HIP_MEMORY_SCOPE_AGENT
constexpr int CW_BAR = 4096;
static_assert((CW_BAR + XCD_BAR_WORDS) * 4 <= (int)CTL_ZERO_BYTES, "CTL words inside the memset region");
constexpr int LDS_BYTES = 163840;
constexpr int RING_OFF = 0, RING_BYTES = LDS_BYTES - 512;
constexpr int LDSCTL_OFF = RING_BYTES, MISC_OFF = LDSCTL_OFF + 320;

struct Args { Ptrs P; int ph_lo, ph_hi; };
constexpr int N_PHASES = 8;

__global__ void __launch_bounds__(NWAVES * 64, 2) fwd_mega(Args args) {
    extern __shared__ __attribute__((aligned(16))) unsigned char lds_raw[];
    LAS unsigned char* lds = (LAS unsigned char*)lds_raw;
    volatile LAS unsigned* MISC = (volatile LAS unsigned*)(lds + MISC_OFF);
    const int tid = threadIdx.x, lane = tid & 63, wave = __builtin_amdgcn_readfirstlane(tid >> 6);
    const int G = gridDim.x;
    for (int u = tid; u < (LDS_BYTES - LDSCTL_OFF) / 4; u += NWAVES * 64) ((LAS unsigned*)(lds + LDSCTL_OFF))[u] = 0u;
    __syncthreads();
    const Ptrs& P = args.P;
    gu32* ctl = (gu32*)(P.ws + WS_CTL);
    const int lo = args.ph_lo, hi = args.ph_hi;
    XcdBarrier bar; bar.bar = (unsigned*)(ctl + CW_BAR); bar.x = 0; bar.st = nullptr;
    if (hi - lo > 1) bar = xcd_barrier_post((unsigned*)(ctl + CW_BAR), MISC + 8);
#define IN(k) (lo <= (k) && (k) < hi)
#define SEAM(k) do { if (IN(k) && IN((k) + 1)) xcd_barrier(bar); } while (0)
#ifndef DUP_PHASE
#define DUP_PHASE -1
#endif
#define RUN(k) do { \
    if ((k) == 0) phase_prologue<3>(P, lds, wave, lane, blockIdx.x * NWAVES + wave, G * NWAVES); \
    else if ((k) == 1) phase_gemm<1>(P, lds, G, blockIdx.x); \
    else if ((k) == 2) phase_mix0(P, lds, G); \
    else if ((k) == 3) phase_gemm<2>(P, lds, G, blockIdx.x); \
    else if ((k) == 4) { phase_gemm<3>(P, lds, G, blockIdx.x); phase_gates_ab(P, G); } \
    else if ((k) == 5) phase_mix1a(P, lds, G); \
    else if ((k) == 6) phase_mix1b(P, lds, G); \
    else phase_gemm<4>(P, lds, G, blockIdx.x); } while (0)
#define STEP(k) do { if (IN(k)) { if ((k) == 0 && DUP_PHASE >= 6001 && DUP_PHASE <= 6002) { phase_prologue<(DUP_PHASE >= 6001 && DUP_PHASE <= 6002 ? DUP_PHASE - 6000 : 3)>(P, lds, wave, lane, blockIdx.x * NWAVES + wave, G * NWAVES); xcd_barrier(bar); } if ((k) == 5 && DUP_PHASE >= 5000 && DUP_PHASE < 5016) { for (int it_ = blockIdx.x; it_ < BATCH * H_D * NCH; it_ += G) dn1_item<(DUP_PHASE >= 5000 ? DUP_PHASE - 5000 : 0)>(P, lds, it_); xcd_barrier(bar); } RUN(k); if (DUP_PHASE == (k)) { xcd_barrier(bar); RUN(k); } \
        if ((k) == 2 && DUP_PHASE == 20) { xcd_barrier(bar); if (blockIdx.x >= 128) phase_mix0(P, lds, G); } \
        if ((k) == 2 && DUP_PHASE == 21) { xcd_barrier(bar); if (blockIdx.x < 128) phase_mix0(P, lds, G); } \
        if ((k) == 2 && DUP_PHASE >= 2000 && DUP_PHASE < 2128) { xcd_barrier(bar); if (blockIdx.x >= 128) { const int wa_ = blockIdx.x - 128; for (int k_ = 3; k_ >= 0; --k_) attn2_item<(DUP_PHASE >= 2000 ? DUP_PHASE - 2000 : 0)>(P, lds, (wa_ >> 2) * 16 + 4 * k_ + (wa_ & 3), WS_XB); } } \
        if ((k) == 2 && DUP_PHASE >= 1000 && DUP_PHASE < 1128) { xcd_barrier(bar); if (blockIdx.x < 128) mlstm_item<(DUP_PHASE >= 1000 ? DUP_PHASE - 1000 : 0)>(P, lds, blockIdx.x, WS_XB); } \
        if ((k) == 6 && DUP_PHASE >= 3000 && DUP_PHASE < 3032) { xcd_barrier(bar); if (blockIdx.x < 64) dn2_item<(DUP_PHASE >= 3000 ? DUP_PHASE - 3000 : 0)>(P, lds, blockIdx.x, 420 * MiB); } \
        if ((k) == 6 && DUP_PHASE >= 4000 && DUP_PHASE < 4032) { xcd_barrier(bar); rglru_item<(DUP_PHASE >= 4000 ? DUP_PHASE - 4000 : 0)>(P, lds, blockIdx.x, 420 * MiB); } \
        if ((k) == 5 && DUP_PHASE == 50) { xcd_barrier(bar); for (int it_ = blockIdx.x; it_ < BATCH * N_BLK_C * 4; it_ += G) rglru_item<0>(P, lds, it_); } \
        if ((k) == 5 && DUP_PHASE == 51) { xcd_barrier(bar); phase_mix1a(P, lds, G); } \
        } SEAM(k); } while (0)
    STEP(0); STEP(1); STEP(2); STEP(3); STEP(4); STEP(5); STEP(6); STEP(7);
#undef STEP
#undef RUN
#undef IN
#undef SEAM
}
extern "C" void kernel_launch(void* const* d_in, const int* in_sizes, int n_in, void* d_out, int out_size, void* d_ws, size_t ws_size, hipStream_t stream) {
    static int grid = 0;
    if (grid == 0) {
        if (n_in != 20 || in_sizes[0] != M_TOK * D_MODEL || out_size != M_TOK * D_MODEL || ws_size < WS_END) {
            fprintf(stderr, "kernel_launch: unexpected shapes: n_in %d in0 %d out %d ws %zu (need %zu)\n", n_in, n_in > 0 ? in_sizes[0] : -1, out_size, ws_size, (size_t)WS_END); grid = -1; return; }
        int dev = 0, cus = 0, per_cu = 0;
        if (hipGetDevice(&dev) != hipSuccess || hipDeviceGetAttribute(&cus, hipDeviceAttributeMultiprocessorCount, dev) != hipSuccess) { grid = -1; return; }
        if (hipFuncSetAttribute((const void*)fwd_mega, hipFuncAttributeMaxDynamicSharedMemorySize, LDS_BYTES) != hipSuccess) { fprintf(stderr, "kernel_launch: hipFuncSetAttribute failed\n"); grid = -1; return; }
        if (hipOccupancyMaxActiveBlocksPerMultiprocessor(&per_cu, (const void*)fwd_mega, NWAVES * 64, LDS_BYTES) != hipSuccess || per_cu < 1) { fprintf(stderr, "kernel_launch: occupancy query says %d blocks per CU\n", per_cu); per_cu = 1; }
        (void)hipGetLastError();
        grid = cus;
    }
    if (grid < 0) return;
    if (hipMemsetAsync((char*)d_ws + WS_CTL, 0, CTL_ZERO_BYTES, stream) != hipSuccess) { fprintf(stderr, "kernel_launch: memset failed\n"); return; }
    Args a{};
    for (int i = 0; i < 20; ++i) a.P.in[i] = (const float*)d_in[i];
    a.P.out = (float*)d_out; a.P.ws = (unsigned char*)d_ws; a.ph_lo = 0; a.ph_hi = N_PHASES;
    hipLaunchKernelGGL(fwd_mega, dim3(grid), dim3(NWAVES * 64), LDS_BYTES, stream, a);
    const hipError_t le = hipPeekAtLastError();
    if (le != hipSuccess) fprintf(stderr, "kernel_launch: launch failed: %s\n", hipGetErrorName(le));
}
```

```cpp
#include <hip/hip_runtime.h>
#include <cstdio>
#include <cstdint>
#include <cmath>
#include <type_traits>

constexpr int D_MODEL = 2048, BATCH = 8, SEQ = 2048, M_TOK = BATCH * SEQ;
constexpr int CHUNK = 64, NCH = SEQ / CHUNK;
constexpr float EPS = 1e-6f;
constexpr int HD_A = 128, W_A = 1024, H_A = 8, LOOKBACK = 8, BAND = (LOOKBACK + 1) * CHUNK, REL_MAX = 256, NREL = 2 * REL_MAX + 1;
constexpr int H_B = 4, W_B = 1024, HD_B = 256;
constexpr int W_C = 1024, N_BLK_C = 8, BLK_C = 128;
constexpr int HD_D = 128, W_D = 1024, H_D = 8;
constexpr int EV_IN = 9224, EV_N = 9216;
constexpr int OD_IN = 6160, OD_N = 6144;
constexpr int EC_QA = 0, EC_KA = 1024, EC_VA = 2048, EC_ZA = 3072, EC_QB = 4096, EC_KB = 5120, EC_VB = 6144, EC_OB = 7168, EC_ZB = 8192;
constexpr int OC_XC = 0, OC_ZC = 1024, OC_QD = 2048, OC_KD = 3072, OC_VD = 4096, OC_ZD = 5120;

constexpr size_t MiB = 1u << 20;
constexpr size_t WS_CTL = 0, CTL_ZERO_BYTES = 1 * MiB;
constexpr size_t WS_R0 = 1 * MiB;
constexpr size_t WS_SS1 = WS_R0 + 64 * 1024;
constexpr size_t WS_GIF = WS_SS1 + 64 * 1024;
constexpr size_t WS_AB = WS_GIF + 512 * 1024;
constexpr size_t WS_W1T = 4 * MiB;
constexpr size_t WS_W2T = 40 * MiB;
constexpr size_t WS_W3T = 48 * MiB;
constexpr size_t WS_W4T = 73 * MiB;
constexpr size_t WS_XB = 81 * MiB;
constexpr size_t WS_Y = 145 * MiB;
constexpr size_t WS_PROJ = 209 * MiB;
constexpr size_t WS_END = 497 * MiB;
constexpr size_t WS_FREE1 = 401 * MiB;

typedef unsigned short bf16_t;
__device__ __forceinline__ float bf2f(unsigned short v) { return __builtin_bit_cast(float, (unsigned)v << 16); }
__device__ __forceinline__ unsigned f2bf(float f) { unsigned u = __builtin_bit_cast(unsigned, f); return (u + 0x7fffu + ((u >> 16) & 1u)) >> 16; }
typedef float f32x2_t_ __attribute__((ext_vector_type(2))); typedef __bf16 bf16x2_t_ __attribute__((ext_vector_type(2)));
__device__ __forceinline__ unsigned pk2(float lo, float hi) { const f32x2_t_ v = {lo, hi}; return __builtin_bit_cast(unsigned, __builtin_convertvector(v, bf16x2_t_)); }
__device__ __forceinline__ float sigmoidf_(float x) { return 1.f / (1.f + expf(-x)); }
__device__ __forceinline__ float siluf_(float x) { return x / (1.f + expf(-x)); }
__device__ __forceinline__ float softplusf_(float x) { return fmaxf(x, 0.f) + log1pf(expf(-fabsf(x))); }
__device__ __forceinline__ float logsigmoidf_(float x) { return -softplusf_(-x); }

namespace pg8 {
#define PG8_LAS __attribute__((address_space(3)))
typedef unsigned short bf16_t;
typedef short bf16x8 __attribute__((ext_vector_type(8)));
typedef float f32x4 __attribute__((ext_vector_type(4)));
typedef unsigned u32x4 __attribute__((ext_vector_type(4)));
constexpr int BM = 256, BK = 64, HALF = 128, HTB = HALF * BK * 2  , STAGE_BYTES = 8 * HTB, NXCD = 8, WGM = 4;

__host__ __device__ __forceinline__ int lds_byte(int r, int c) { const int st = (r >> 4) * 2 + (c >> 5), rr = r & 15, cc = c & 31, ob = rr * 64 + cc * 2; return st * 1024 + (ob ^ (((ob >> 9) & 1) << 5)); }
__host__ __device__ __forceinline__ void stage_rc(int b, int& R, int& C) { const int st = b / 1024, sb = b % 1024, swz = sb ^ (((sb >> 9) & 1) << 5); R = (st >> 1) * 16 + swz / 64; C = (st & 1) * 32 + (swz % 64) / 2; }
__host__ __device__ __forceinline__ int perm32(int rho) { const int n = rho >> 4, i = rho & 15; return 8 * (i >> 2) + 4 * n + (i & 3); }

struct Unit { int pm, pn; };
struct Gemm { const bf16_t* A; const bf16_t* Bt; int M, N, K; };

struct StaticOrder {
    int nM, nN, nwg, G, c;
    __host__ __device__ void init(int M, int N, int G_, int c_) { nM = M / BM; nN = N / BM; nwg = nM * nN; G = G_; c = c_; }
    __host__ __device__ bool next(int i, Unit& u) const {
        const long L = (long)i * G + c; if (L >= nwg) return false;
        int wgid = (int)L; { const int q = nwg / NXCD, r = nwg % NXCD, xcd = wgid % NXCD, off = wgid / NXCD; wgid = (xcd < r ? xcd * (q + 1) : r * (q + 1) + (xcd - r) * q) + off; }
        const int nig = WGM * nN, gid = wgid / nig, fm = gid * WGM, gsz = (nM - fm) < WGM ? (nM - fm) : WGM;
        u.pm = fm + ((wgid % nig) % gsz); u.pn = (wgid % nig) / gsz; return true;
    }
    __device__ __forceinline__ void a_ready(const Unit&) const {}
    __device__ __forceinline__ void done(const Unit&) const {}
};

__device__ __forceinline__ unsigned cvt_pk_bf16(float lo, float hi) { unsigned r; asm volatile("v_cvt_pk_bf16_f32 %0, %1, %2" : "=v"(r) : "v"(lo), "v"(hi)); return r; }
struct EpiProj {
    static constexpr bool PERM = true, AFTER_DRAIN = false;
    bf16_t* O; int ldc; const float* rowv; int mode;
    __device__ __forceinline__ void operator()(const f32x4 (&acc)[2][2][4][2], const Unit& u, int wr, int wc, int fr, int fq) const {
        const int row0 = u.pm * BM + wr * 64 + fr; const int col0 = u.pn * BM + wc * 32 + 8 * fq;
#pragma unroll
        for (int ai = 0; ai < 2; ++ai)
#pragma unroll
            for (int m = 0; m < 4; ++m) { const int row = row0 + ai * HALF + m * 16; float sc = rowv[row]; if (mode) sc = 1.0f / sqrtf(sc * (1.0f / 2048.0f) + 1e-6f);
                bf16_t* rowp = O + (size_t)row * ldc + col0;
#pragma unroll
                for (int bj = 0; bj < 2; ++bj) { const f32x4 v0 = acc[ai][bj][m][0] * sc, v1 = acc[ai][bj][m][1] * sc;
                    u32x4 w; w.x = cvt_pk_bf16(v0[0], v0[1]); w.y = cvt_pk_bf16(v0[2], v0[3]); w.z = cvt_pk_bf16(v1[0], v1[1]); w.w = cvt_pk_bf16(v1[2], v1[3]);
                    *(u32x4*)(rowp + bj * HALF) = w; } }
    }
};
struct EpiRes {
    static constexpr bool PERM = false, AFTER_DRAIN = false;
    const float* base; const bf16_t* base16; float* out; bf16_t* xb; float* sumsq; int ldc;
    __device__ __forceinline__ void operator()(const f32x4 (&acc)[2][2][4][2], const Unit& u, int wr, int wc, int fr, int fq) const {
        typedef unsigned u32x2v __attribute__((ext_vector_type(2)));
        const int col0 = u.pn * BM + wc * 32 + 4 * fq;
#pragma unroll
        for (int ai = 0; ai < 2; ++ai)
#pragma unroll
            for (int m = 0; m < 4; ++m) { const int row = u.pm * BM + ai * HALF + wr * 64 + m * 16 + fr; const size_t off = (size_t)row * ldc + col0; float ss = 0.f;
#pragma unroll
                for (int bj = 0; bj < 2; ++bj)
#pragma unroll
                    for (int n = 0; n < 2; ++n) { f32x4 bs;
                        if (base16) { const u32x2v w_ = *(const u32x2v*)(base16 + off + bj * HALF + n * 16); bs = (f32x4){__builtin_bit_cast(float, w_.x << 16), __builtin_bit_cast(float, w_.x & 0xffff0000u), __builtin_bit_cast(float, w_.y << 16), __builtin_bit_cast(float, w_.y & 0xffff0000u)}; }
                        else bs = *(const f32x4*)(base + off + bj * HALF + n * 16);
                        const f32x4 o = bs + acc[ai][bj][m][n];
                        if (out) *(f32x4*)(out + off + bj * HALF + n * 16) = o;
                        if (xb) { u32x2v w; w.x = cvt_pk_bf16(o[0], o[1]); w.y = cvt_pk_bf16(o[2], o[3]); *(u32x2v*)(xb + off + bj * HALF + n * 16) = w; }
                        ss += (o[0] * o[0] + o[1] * o[1]) + (o[2] * o[2] + o[3] * o[3]); }
                if (sumsq) { ss += __shfl_xor(ss, 16); ss += __shfl_xor(ss, 32); if (fq == 0) atomicAdd(sumsq + row, ss); } }
    }
};

template <class Epi, class Sched, bool ALIGN_EPI = false, bool SP2 = false>
__device__ __forceinline__ void gemm_phase(PG8_LAS unsigned char* lds, const Gemm g, const Sched& S, const Epi& E) {
    const int tid = threadIdx.x, wid = __builtin_amdgcn_readfirstlane(tid >> 6), lane = tid & 63, wr = wid >> 2, wc = wid & 3, fr = lane & 15, fq = lane >> 4;
    const int K = g.K, nt = K / BK;
    unsigned voffA[2], voffB[2];
#pragma unroll
    for (int i = 0; i < 2; ++i) { int R, C; stage_rc(tid * 16 + i * 8192, R, C); const int Rb = Epi::PERM ? ((R & ~31) + perm32(R & 31)) : R;
        voffA[i] = (unsigned)(R * K + C) * 2u; voffB[i] = (unsigned)(Rb * K + C) * 2u; }
    const size_t kstep = (size_t)(BK * 2);
    const size_t hstep = (size_t)HALF * K * 2;
    const size_t tstep = 2 * hstep;
    const unsigned ldsw = (unsigned)wid * 1024u;
    const int aoff = lds_byte(wr * 64 + fr, fq * 8), boff = lds_byte(wc * 32 + fr, fq * 8);
#define PG8_SA(b, h) (((b) * 2 + (h)) * HTB)
#define PG8_SB(b, h) ((4 + (b) * 2 + (h)) * HTB)
#define PG8_STAGE(bufoff, gbase, voff) do { _Pragma("unroll") for (int _i = 0; _i < 2; ++_i) \
        __builtin_amdgcn_global_load_lds((const unsigned*)((const char*)(gbase) + (voff)[_i]), (PG8_LAS unsigned*)(lds + (bufoff) + ldsw + _i * 8192), 16, 0, 0); } while (0)
#define PG8_LDA(dst, b, h) do { _Pragma("unroll") for (int m = 0; m < 4; ++m) _Pragma("unroll") for (int k = 0; k < 2; ++k) dst[m][k] = *(const PG8_LAS bf16x8*)(lds + PG8_SA(b, h) + aoff + m * 2048 + k * 1024); } while (0)
#define PG8_LDB(dst, b, h) do { _Pragma("unroll") for (int n = 0; n < 2; ++n) _Pragma("unroll") for (int k = 0; k < 2; ++k) dst[n][k] = *(const PG8_LAS bf16x8*)(lds + PG8_SB(b, h) + boff + n * 2048 + k * 1024); } while (0)
#define PG8_MMA(ai, bj, At, Bt) do { __builtin_amdgcn_s_setprio(1); _Pragma("unroll") for (int m = 0; m < 4; ++m) _Pragma("unroll") for (int n = 0; n < 2; ++n) _Pragma("unroll") for (int k = 0; k < 2; ++k) \
        acc[ai][bj][m][n] = __builtin_amdgcn_mfma_f32_16x16x32_bf16(Bt[n][k], At[m][k], acc[ai][bj][m][n], 0, 0, 0); __builtin_amdgcn_s_setprio(0); } while (0)
#define PG8_WAIT_V(n) asm volatile("s_waitcnt vmcnt(" #n ")" ::: "memory")
#define PG8_WAIT_L(n) asm volatile("s_waitcnt lgkmcnt(" #n ")" ::: "memory")
#define PG8_BAR __builtin_amdgcn_s_barrier()
#define PG8_SCHED __builtin_amdgcn_sched_barrier(0)
    Unit cur, nxt; int ui = 0;
    if (!S.next(0, cur)) return;
    f32x4 acc[2][2][4][2];
#pragma unroll
    for (int a = 0; a < 2; ++a)
#pragma unroll
        for (int b = 0; b < 2; ++b)
#pragma unroll
            for (int m = 0; m < 4; ++m)
#pragma unroll
                for (int n = 0; n < 2; ++n) acc[a][b][m][n] = (f32x4){0.f, 0.f, 0.f, 0.f};
    bf16x8 At[4][2], B0[2][2], B1[2][2];
    const char* cA = (const char*)g.A + (size_t)cur.pm * tstep; const char* cB = (const char*)g.Bt + (size_t)cur.pn * tstep;
    S.a_ready(cur);
    if constexpr (SP2) {
        PG8_STAGE(PG8_SB(0, 0), cB, voffB); PG8_STAGE(PG8_SB(0, 1), cB + hstep, voffB); PG8_STAGE(PG8_SA(0, 0), cA, voffA); PG8_STAGE(PG8_SA(0, 1), cA + hstep, voffA);
        if (wr == 1) PG8_BAR;
        PG8_WAIT_V(2); PG8_BAR;
        PG8_STAGE(PG8_SB(1, 0), cB + kstep, voffB); PG8_STAGE(PG8_SA(1, 0), cA + kstep, voffA); PG8_STAGE(PG8_SB(1, 1), cB + hstep + kstep, voffB);
        PG8_WAIT_V(6); PG8_BAR;
    } else {
        PG8_STAGE(PG8_SB(0, 0), cB, voffB); PG8_STAGE(PG8_SA(0, 0), cA, voffA); PG8_STAGE(PG8_SB(0, 1), cB + hstep, voffB); PG8_STAGE(PG8_SA(0, 1), cA + hstep, voffA);
        if (wr == 1) PG8_BAR;
        PG8_WAIT_V(4); PG8_BAR;
        PG8_STAGE(PG8_SB(1, 0), cB + kstep, voffB); PG8_STAGE(PG8_SA(1, 0), cA + kstep, voffA); PG8_STAGE(PG8_SB(1, 1), cB + hstep + kstep, voffB);
        PG8_WAIT_V(6); PG8_BAR;
    }
    for (;;) {
        const bool has_next = S.next(ui + 1, nxt);
        const char* nA = has_next ? (const char*)g.A + (size_t)nxt.pm * tstep : cA; const char* nB = has_next ? (const char*)g.Bt + (size_t)nxt.pn * tstep : cB;
        for (int t = 0; t < nt; t += 2) {
            const bool last = (t == nt - 2);
            const char* a1 = cA + (size_t)(t + 1) * kstep;
            const char* a2 = last ? nA : cA + (size_t)(t + 2) * kstep; const char* b2 = last ? nB : cB + (size_t)(t + 2) * kstep;
            const char* a3 = a2 + kstep; const char* b3 = b2 + kstep;
            if (last && has_next) S.a_ready(nxt);
            if constexpr (SP2) {
            PG8_LDB(B0, 0, 0); PG8_LDB(B1, 0, 1); PG8_SCHED; PG8_LDA(At, 0, 0); PG8_STAGE(PG8_SA(1, 1), a1 + hstep, voffA);
            PG8_WAIT_V(8); PG8_WAIT_L(0); PG8_BAR; PG8_MMA(0, 0, At, B0); PG8_MMA(0, 1, At, B1); PG8_BAR; PG8_SCHED;
            PG8_LDA(At, 0, 1); PG8_STAGE(PG8_SB(0, 0), b2, voffB); PG8_STAGE(PG8_SB(0, 1), b2 + hstep, voffB); PG8_STAGE(PG8_SA(0, 0), a2, voffA);
            PG8_WAIT_V(8); PG8_WAIT_L(0); PG8_BAR; PG8_MMA(1, 0, At, B0); PG8_MMA(1, 1, At, B1); PG8_BAR; PG8_SCHED;
            PG8_LDB(B0, 1, 0); PG8_LDB(B1, 1, 1); PG8_SCHED; PG8_LDA(At, 1, 0); PG8_STAGE(PG8_SA(0, 1), a2 + hstep, voffA);
            PG8_WAIT_V(8); PG8_WAIT_L(0); PG8_BAR; PG8_MMA(0, 0, At, B0); PG8_MMA(0, 1, At, B1); PG8_BAR; PG8_SCHED;
            PG8_LDA(At, 1, 1); PG8_STAGE(PG8_SB(1, 0), b3, voffB); PG8_STAGE(PG8_SB(1, 1), b3 + hstep, voffB); PG8_STAGE(PG8_SA(1, 0), a3, voffA);
            PG8_WAIT_V(8); PG8_WAIT_L(0); PG8_BAR; PG8_MMA(1, 0, At, B0); PG8_MMA(1, 1, At, B1); PG8_BAR; PG8_SCHED;
            } else {
            PG8_LDB(B0, 0, 0); PG8_SCHED; PG8_LDA(At, 0, 0); PG8_STAGE(PG8_SA(1, 1), a1 + hstep, voffA);
            PG8_WAIT_L(8); PG8_BAR; PG8_WAIT_L(0); PG8_MMA(0, 0, At, B0); PG8_BAR; PG8_SCHED;
            PG8_LDB(B1, 0, 1); PG8_STAGE(PG8_SB(0, 0), b2, voffB);
            PG8_BAR; PG8_WAIT_L(0); PG8_MMA(0, 1, At, B1); PG8_BAR;
            PG8_LDA(At, 0, 1); PG8_STAGE(PG8_SA(0, 0), a2, voffA);
            PG8_BAR; PG8_WAIT_L(0); PG8_MMA(1, 0, At, B0); PG8_BAR; PG8_SCHED;
            PG8_STAGE(PG8_SB(0, 1), b2 + hstep, voffB);
            PG8_WAIT_V(6); PG8_BAR; PG8_MMA(1, 1, At, B1); PG8_BAR;
            PG8_LDB(B0, 1, 0); PG8_SCHED; PG8_LDA(At, 1, 0); PG8_STAGE(PG8_SA(0, 1), a2 + hstep, voffA);
            PG8_WAIT_L(8); PG8_BAR; PG8_WAIT_L(0); PG8_MMA(0, 0, At, B0); PG8_BAR; PG8_SCHED;
            PG8_LDB(B1, 1, 1); PG8_STAGE(PG8_SB(1, 0), b3, voffB);
            PG8_BAR; PG8_WAIT_L(0); PG8_MMA(0, 1, At, B1); PG8_BAR;
            PG8_LDA(At, 1, 1); PG8_STAGE(PG8_SA(1, 0), a3, voffA);
            PG8_BAR; PG8_WAIT_L(0); PG8_MMA(1, 0, At, B0); PG8_BAR; PG8_SCHED;
            PG8_STAGE(PG8_SB(1, 1), b3 + hstep, voffB);
            PG8_WAIT_V(6); PG8_BAR; PG8_MMA(1, 1, At, B1); PG8_BAR;
            }
        }
        if constexpr (ALIGN_EPI) { if (wr == 0) PG8_BAR; }
        if constexpr (!Epi::AFTER_DRAIN) { E(acc, cur, wr, wc, fr, fq); S.done(cur); }
        if (!has_next) break;
#pragma unroll
        for (int a = 0; a < 2; ++a)
#pragma unroll
            for (int b = 0; b < 2; ++b)
#pragma unroll
                for (int m = 0; m < 4; ++m)
#pragma unroll
                    for (int n = 0; n < 2; ++n) acc[a][b][m][n] = (f32x4){0.f, 0.f, 0.f, 0.f};
        cur = nxt; cA = nA; cB = nB; ++ui;
        if constexpr (ALIGN_EPI) { if (wr == 1) PG8_BAR; }
    }
    PG8_WAIT_V(0);
    if constexpr (!ALIGN_EPI) { if (wr == 0) PG8_BAR; }
    PG8_BAR;
    if constexpr (Epi::AFTER_DRAIN) { E.fused(acc, cur, wr, wc, fr, fq, lds, wid, lane); S.done(cur); }
#undef PG8_SA
#undef PG8_SB
#undef PG8_STAGE
#undef PG8_LDA
#undef PG8_LDB
#undef PG8_MMA
#undef PG8_WAIT_V
#undef PG8_WAIT_L
#undef PG8_BAR
#undef PG8_SCHED
}
}
#define GAS __attribute__((address_space(1)))
#define LAS __attribute__((address_space(3)))
typedef unsigned v4u __attribute__((ext_vector_type(4)));
typedef float f32x4 __attribute__((ext_vector_type(4)));
#define LDS_WAIT() asm volatile("s_waitcnt lgkmcnt(0)" ::: "memory")
constexpr int NWAVES = 8;
constexpr int GEMM_LDS = 131072;

struct Ptrs {
    const float* in[20]; float* out; unsigned char* ws;
};
#define IN_X 0
#define IN_EV_NORM 1
#define IN_EV_WIN 2
#define IN_EV_IFB 3
#define IN_EV_QNG 4
#define IN_EV_KNG 5
#define IN_EV_REL 6
#define IN_EV_WOUT 7
#define IN_OD_NORM 8
#define IN_OD_WIN 9
#define IN_OD_CCW 10
#define IN_OD_CCB 11
#define IN_OD_GW 12
#define IN_OD_GB 13
#define IN_OD_LAM 14
#define IN_OD_CDW 15
#define IN_OD_ALOG 16
#define IN_OD_DTB 17
#define IN_OD_ONORM 18
#define IN_OD_WOUT 19

__device__ __forceinline__ float frsq_(float x) { return __builtin_amdgcn_rsqf(x); }
__device__ __forceinline__ float wave_sum(float v) {
#pragma unroll
    for (int o = 1; o < 64; o <<= 1) v += __shfl_xor(v, o);
    return v;
}
struct TrItem { const float* W; const float* gain; bf16_t* WT; int ldw, nblk, item; };
__device__ __forceinline__ void p0_tr_load(const TrItem& t, float (&r)[32], int lane) {
    const int kb = t.item / t.nblk, nb = t.item % t.nblk, k0 = 64 * kb, n0 = 32 * nb;
#pragma unroll
    for (int i = 0; i < 32; ++i) { const int kk = 2 * i + (lane >> 5); r[i] = t.W[(size_t)(k0 + kk) * t.ldw + n0 + (lane & 31)]; }
}
__device__ __forceinline__ void p0_tr_store(const TrItem& t, const float (&r)[32], LAS float* scr, int lane) {
    const int kb = t.item / t.nblk, nb = t.item % t.nblk, k0 = 64 * kb, n0 = 32 * nb; constexpr int K = D_MODEL;
#pragma unroll
    for (int i = 0; i < 32; ++i) { const int kk = 2 * i + (lane >> 5); const float g = t.gain ? t.gain[k0 + kk] : 1.0f; scr[kk * 33 + (lane & 31)] = g * r[i]; }
    LDS_WAIT(); asm volatile("" ::: "memory");
    const int c = lane & 7;
#pragma unroll
    for (int j = 0; j < 4; ++j) { const int n = (lane >> 3) + 8 * j; const LAS float* s = scr + (8 * c) * 33 + n;
        v4u o; o.x = pk2(s[0 * 33], s[1 * 33]); o.y = pk2(s[2 * 33], s[3 * 33]); o.z = pk2(s[4 * 33], s[5 * 33]); o.w = pk2(s[6 * 33], s[7 * 33]);
        *(GAS v4u*)(t.WT + (size_t)(n0 + n) * K + k0 + 8 * c) = o; }
    LDS_WAIT(); asm volatile("" ::: "memory");
}
__device__ __forceinline__ void p0_transposes(const Ptrs& P, LAS float* scr, int lane, int gw, int NGW, int it0, int it1) {
    unsigned char* ws = P.ws;
    bf16_t* W1T = (bf16_t*)(ws + WS_W1T); bf16_t* W2T = (bf16_t*)(ws + WS_W2T); bf16_t* W3T = (bf16_t*)(ws + WS_W3T); bf16_t* W4T = (bf16_t*)(ws + WS_W4T);
    constexpr int I1 = (D_MODEL / 64) * (EV_N / 32), I2 = (D_MODEL / 64) * (D_MODEL / 32), I3 = (D_MODEL / 64) * (OD_N / 32);
    auto mk = [&](int it) { TrItem t; int r = it;
        if (r < I1) { t = TrItem{P.in[IN_EV_WIN], P.in[IN_EV_NORM], W1T, EV_IN, EV_N / 32, r}; return t; } r -= I1;
        if (r < I2) { t = TrItem{P.in[IN_EV_WOUT], nullptr, W2T, D_MODEL, D_MODEL / 32, r}; return t; } r -= I2;
        if (r < I3) { t = TrItem{P.in[IN_OD_WIN], P.in[IN_OD_NORM], W3T, OD_IN, OD_N / 32, r}; return t; } r -= I3;
        t = TrItem{P.in[IN_OD_WOUT], nullptr, W4T, D_MODEL, D_MODEL / 32, r}; return t; };
    float ra[32], rb[32]; int it = it0 + gw;
    if (it < it1) { TrItem ta = mk(it); p0_tr_load(ta, ra, lane);
        for (;;) { const int itb = it + NGW; TrItem tb = ta; const bool hb = itb < it1; if (hb) { tb = mk(itb); p0_tr_load(tb, rb, lane); }
            p0_tr_store(ta, ra, scr, lane); if (!hb) break;
            const int itc = itb + NGW; const bool hc = itc < it1; if (hc) { ta = mk(itc); p0_tr_load(ta, ra, lane); }
            p0_tr_store(tb, rb, scr, lane); if (!hc) break; it = itc; } }
}
constexpr int TR_I1 = (D_MODEL / 64) * (EV_N / 32), TR_ALL = TR_I1 + 2 * (D_MODEL / 64) * (D_MODEL / 32) + (D_MODEL / 64) * (OD_N / 32), TR_I4 = TR_ALL - (D_MODEL / 64) * (D_MODEL / 32);
__device__ __forceinline__ void late_weights(const Ptrs& P, LAS unsigned char* lds, int wave, int lane, int gw, int NGW) {
    p0_transposes(P, (LAS float*)(lds + wave * 16384), lane, gw, NGW, TR_I1, TR_I4);
    bf16_t* W3T = (bf16_t*)(P.ws + WS_W3T); const int gt = gw * 64 + lane, NT = NGW * 64;
    for (int e = gt; e < 16 * D_MODEL; e += NT) { const int j = e / D_MODEL, k = e % D_MODEL; W3T[(size_t)(OD_N + j) * D_MODEL + k] = (bf16_t)f2bf(P.in[IN_OD_NORM][k] * P.in[IN_OD_WIN][(size_t)k * OD_IN + OD_N + j]); }
}
__device__ __forceinline__ void last_weight(const Ptrs& P, LAS unsigned char* lds, int wave, int lane, int gw, int NGW) { p0_transposes(P, (LAS float*)(lds + wave * 16384), lane, gw, NGW, TR_I4, TR_ALL); }
template <int PART = 3> __device__ __forceinline__ void phase_prologue(const Ptrs& P, LAS unsigned char* lds, int wave, int lane, int gw, int NGW) {
    unsigned char* ws = P.ws;
    bf16_t* W1T = (bf16_t*)(ws + WS_W1T); bf16_t* W2T = (bf16_t*)(ws + WS_W2T); bf16_t* W3T = (bf16_t*)(ws + WS_W3T); bf16_t* W4T = (bf16_t*)(ws + WS_W4T);
    bf16_t* XB = (bf16_t*)(ws + WS_XB); float* R0 = (float*)(ws + WS_R0); float* SS1 = (float*)(ws + WS_SS1); float* GIF = (float*)(ws + WS_GIF);
    LAS float* scr = (LAS float*)(lds + wave * 16384);
    if constexpr (PART & 1) p0_transposes(P, scr, lane, gw, NGW, 0, TR_I1);
    if constexpr (!(PART & 2)) return;
    { const int gt = gw * 64 + lane, NT = NGW * 64;
      for (int e = gt; e < M_TOK; e += NT) SS1[e] = 0.f; }
    __syncthreads();
    LAS float* G8 = (LAS float*)lds;
#pragma unroll 8
    for (int e = threadIdx.x; e < D_MODEL * 8; e += NWAVES * 64) { const int k = e >> 3, j = e & 7; G8[j * D_MODEL + k] = P.in[IN_EV_NORM][k] * P.in[IN_EV_WIN][(size_t)k * EV_IN + EV_N + j]; }
    __syncthreads();
    const float* X = P.in[IN_X];
    f32x4 vnx[8];
    if (gw < M_TOK) { const GAS f32x4* xr0 = (const GAS f32x4*)(X + (size_t)gw * D_MODEL) + lane;
#pragma unroll
        for (int j = 0; j < 8; ++j) vnx[j] = xr0[64 * j]; }
    for (int m = gw; m < M_TOK; m += NGW) {
        float s = 0.f;
        GAS unsigned long long* o8 = (GAS unsigned long long*)(XB + (size_t)m * D_MODEL) + lane;
        f32x4 v[8];
#pragma unroll
        for (int j = 0; j < 8; ++j) v[j] = vnx[j];
        if (m + NGW < M_TOK) { const GAS f32x4* xr1 = (const GAS f32x4*)(X + (size_t)(m + NGW) * D_MODEL) + lane;
#pragma unroll
            for (int j = 0; j < 8; ++j) vnx[j] = xr1[64 * j]; }
#pragma unroll
        for (int j = 0; j < 8; ++j) { s += (v[j].x * v[j].x + v[j].y * v[j].y) + (v[j].z * v[j].z + v[j].w * v[j].w);
            o8[64 * j] = (unsigned long long)pk2(v[j].x, v[j].y) | ((unsigned long long)pk2(v[j].z, v[j].w) << 32); }
        const float r0 = frsq_(wave_sum(s) * (1.0f / D_MODEL) + EPS);
        float g[8];
#pragma unroll
        for (int i = 0; i < 8; ++i) g[i] = 0.f;
#pragma unroll
        for (int j = 0; j < 8; ++j) {
#pragma unroll
            for (int i = 0; i < 8; ++i) { const f32x4 gv = *(const LAS f32x4*)(G8 + i * D_MODEL + 4 * lane + 256 * j); g[i] += (v[j][0] * gv[0] + v[j][1] * gv[1]) + (v[j][2] * gv[2] + v[j][3] * gv[3]); }
            asm volatile("" : "+v"(g[0]), "+v"(g[1]), "+v"(g[2]), "+v"(g[3]), "+v"(g[4]), "+v"(g[5]), "+v"(g[6]), "+v"(g[7]) :: "memory");
        }
#pragma unroll
        for (int i = 0; i < 8; ++i) g[i] = wave_sum(g[i]);
        if (lane == 0) R0[m] = r0;
        if (lane < 8) { float gv = g[0];
#pragma unroll
            for (int i = 1; i < 8; ++i) gv = (lane == i) ? g[i] : gv;
            GIF[(size_t)m * 8 + lane] = r0 * gv + P.in[IN_EV_IFB][lane]; }
    }
}

#define XB_TMO      128
#define XB_XCNT(j)  (256  + 64 * (j))
#define XB_XSUB(j)  (1280 + 64 * (j))
#define XB_XGEN(j)  (2304 + 64 * (j))
#define XB_TOP      3328
#define XB_TOPGEN   3392
#define XCD_BAR_WORDS 3456
#define XB_SPIN_CAP (1u << 18)

__device__ __forceinline__ unsigned xb_ld(unsigned* p)              { return __hip_atomic_load(p, __ATOMIC_RELAXED, __HIP_MEMORY_SCOPE_AGENT); }
__device__ __forceinline__ unsigned xb_add(unsigned* p, unsigned v) { return __hip_atomic_fetch_add(p, v, __ATOMIC_RELAXED, __HIP_MEMORY_SCOPE_AGENT); }
__device__ __forceinline__ unsigned xb_xcc_id() { return (unsigned)__builtin_amdgcn_s_getreg((3 << 11) | 20) & 0xFu; }
#define XB_SPIN(cond, bar) do { unsigned _sp = 0; while (cond) { __builtin_amdgcn_s_sleep(1); \
    if ((++_sp & 255u) == 0u) { if (xb_ld(&(bar)[XB_TMO])) break; if (_sp > XB_SPIN_CAP) { atomicAdd(&(bar)[XB_TMO], 1u); break; } } } } while (0)

struct XcdBarrier {
    unsigned* bar; unsigned x;
    volatile LAS unsigned* st;
};

__device__ __forceinline__ XcdBarrier xcd_barrier_post(unsigned* bar, volatile LAS unsigned* st) {
    XcdBarrier b; b.bar = bar; b.x = xb_xcc_id(); b.st = st;
    if (threadIdx.x == 0) (void)xb_add(&bar[XB_XCNT(b.x)], 1u);
    return b;
}
__device__ __forceinline__ void xcd_barrier_complete(unsigned* bar, unsigned x, unsigned& nloc, unsigned& nx) {
    const unsigned G = gridDim.x * gridDim.y * gridDim.z;
    unsigned sum, cnt, mine, sp = 0u;
    for (;;) {
        sum = 0u; cnt = 0u; mine = 0u;
#pragma unroll
        for (unsigned j = 0; j < 16; ++j) { const unsigned c = xb_ld(&bar[XB_XCNT(j)]); sum += c; cnt += (c > 0u) ? 1u : 0u; mine = (j == x) ? c : mine; }
        if (sum == G) break;
        __builtin_amdgcn_s_sleep(1);
        if ((++sp & 255u) == 0u) { if (xb_ld(&bar[XB_TMO])) break; if (sp > XB_SPIN_CAP) { atomicAdd(&bar[XB_TMO], 1u); break; } }
    }
    nloc = mine > 0u ? mine : 1u; nx = cnt > 0u ? cnt : 1u;
}

__device__ __forceinline__ void xcd_barrier(const XcdBarrier& b) {
    asm volatile("s_waitcnt vmcnt(0)" ::: "memory");
    __syncthreads();
    if (threadIdx.x == 0) {
        unsigned* bar = b.bar;
        __builtin_amdgcn_s_waitcnt(0);
        unsigned nloc = b.st[0], nx = b.st[1];
        if (nloc == 0u) { xcd_barrier_complete(bar, b.x, nloc, nx); b.st[0] = nloc; b.st[1] = nx; }
        const unsigned old = xb_add(&bar[XB_XSUB(b.x)], 1u);
        const unsigned gen = old / nloc;
        if (old + 1u == (gen + 1u) * nloc) {
            __builtin_amdgcn_fence(__ATOMIC_RELEASE, "agent");
            asm volatile("s_waitcnt vmcnt(0)" ::: "memory");
            const unsigned og = xb_add(&bar[XB_TOP], 1u);
            const unsigned tg = og / nx;
            if (og + 1u == (tg + 1u) * nx) xb_add(&bar[XB_TOPGEN], 1u);
            else XB_SPIN(xb_ld(&bar[XB_TOPGEN]) == tg, bar);
            __builtin_amdgcn_fence(__ATOMIC_ACQUIRE, "agent");
            xb_add(&bar[XB_XGEN(b.x)], 1u);
            asm volatile("s_waitcnt vmcnt(0)" ::: "memory");
        } else {
            XB_SPIN(xb_ld(&bar[XB_XGEN(b.x)]) == gen, bar);
            __builtin_amdgcn_fence(__ATOMIC_ACQUIRE, "agent");
            asm volatile("s_waitcnt vmcnt(0)" ::: "memory");
        }
    }
    __syncthreads();
}
__device__ __forceinline__ void ld8bf(const bf16_t* p, float (&v)[8]) {
    const v4u w = *(const v4u*)p;
    v[0] = __builtin_bit_cast(float, w.x << 16); v[1] = __builtin_bit_cast(float, w.x & 0xffff0000u);
    v[2] = __builtin_bit_cast(float, w.y << 16); v[3] = __builtin_bit_cast(float, w.y & 0xffff0000u);
    v[4] = __builtin_bit_cast(float, w.z << 16); v[5] = __builtin_bit_cast(float, w.z & 0xffff0000u);
    v[6] = __builtin_bit_cast(float, w.w << 16); v[7] = __builtin_bit_cast(float, w.w & 0xffff0000u);
}
template <int WHICH> __device__ __forceinline__ void phase_gemm(const Ptrs& P, LAS unsigned char* lds, int G, int c) {
    unsigned char* ws = P.ws;
    bf16_t* W1T = (bf16_t*)(ws + WS_W1T); bf16_t* W2T = (bf16_t*)(ws + WS_W2T); bf16_t* W3T = (bf16_t*)(ws + WS_W3T); bf16_t* W4T = (bf16_t*)(ws + WS_W4T);
    bf16_t* XB = (bf16_t*)(ws + WS_XB); bf16_t* YB = (bf16_t*)(ws + WS_Y); bf16_t* PROJ = (bf16_t*)(ws + WS_PROJ);
    float* R0 = (float*)(ws + WS_R0); float* SS1 = (float*)(ws + WS_SS1);
    if constexpr (WHICH == 1) { pg8::Gemm g{XB, W1T, M_TOK, EV_N, D_MODEL}; pg8::EpiProj E{PROJ, EV_N, R0, 0}; pg8::StaticOrder S; S.init(g.M, g.N, G, c);
        pg8::gemm_phase<pg8::EpiProj, pg8::StaticOrder, true, true>(lds, g, S, E); }
    if constexpr (WHICH == 2) { pg8::Gemm g{YB, W2T, M_TOK, D_MODEL, D_MODEL}; pg8::EpiRes E{P.in[IN_X], nullptr, nullptr, XB, SS1, D_MODEL};     pg8::StaticOrder S; S.init(g.M, g.N, G, c);
        pg8::gemm_phase<pg8::EpiRes, pg8::StaticOrder, true, true>(lds, g, S, E); }
    if constexpr (WHICH == 3) { pg8::Gemm g{XB, W3T, M_TOK, OD_N, D_MODEL}; pg8::EpiProj E{PROJ, OD_N, SS1, 1}; pg8::StaticOrder S; S.init(g.M, g.N, G, c);
        pg8::gemm_phase<pg8::EpiProj, pg8::StaticOrder, true, true>(lds, g, S, E); }
    if constexpr (WHICH == 4) { pg8::Gemm g{YB, W4T, M_TOK, D_MODEL, D_MODEL}; pg8::EpiRes E{nullptr, XB, P.out, nullptr, nullptr, D_MODEL}; pg8::StaticOrder S; S.init(g.M, g.N, G, c);
        pg8::gemm_phase<pg8::EpiRes, pg8::StaticOrder, true, true>(lds, g, S, E); }
}
typedef short bf16x8 __attribute__((ext_vector_type(8)));
typedef short bf16x4 __attribute__((ext_vector_type(4)));
typedef short v4i16_t __attribute__((ext_vector_type(4)));
#define MFMA16(a, b, c) __builtin_amdgcn_mfma_f32_16x16x32_bf16((a), (b), (c), 0, 0, 0)
__device__ __forceinline__ v4i16_t lds_tr(LAS const unsigned char* p) { return __builtin_amdgcn_ds_read_tr16_b64_v4i16((LAS v4i16_t*)p); }
__device__ __forceinline__ bf16x8 frag_row(LAS const unsigned char* base, int RS, int r0, int k0, int lane) { return *(LAS const bf16x8*)(base + (r0 + (lane & 15)) * RS + (k0 + 8 * (lane >> 4)) * 2); }
__device__ __forceinline__ bf16x8 frag_row_perm(LAS const unsigned char* base, int RS, int r0, int k0, int lane) {
    LAS const unsigned char* p = base + (r0 + (lane & 15)) * RS + (k0 + 4 * (lane >> 4)) * 2;
    const bf16x4 a = *(LAS const bf16x4*)p, b = *(LAS const bf16x4*)(p + 32); return (bf16x8){a[0], a[1], a[2], a[3], b[0], b[1], b[2], b[3]}; }
__device__ __forceinline__ bf16x8 frag_tr(LAS const unsigned char* base, int RS, int k0, int c0, int lane) {
    const int g = lane >> 4, q = (lane & 15) >> 2, p = lane & 3; LAS const unsigned char* a = base + (k0 + 8 * g + q) * RS + (c0 + 4 * p) * 2;
    const v4i16_t lo = lds_tr(a), hi = lds_tr(a + 4 * RS); return (bf16x8){lo[0], lo[1], lo[2], lo[3], hi[0], hi[1], hi[2], hi[3]}; }
__device__ __forceinline__ bf16x8 frag_tr_perm(LAS const unsigned char* base, int RS, int k0, int c0, int lane) {
    const int g = lane >> 4, q = (lane & 15) >> 2, p = lane & 3; LAS const unsigned char* a = base + (k0 + 4 * g + q) * RS + (c0 + 4 * p) * 2;
    const v4i16_t lo = lds_tr(a), hi = lds_tr(a + 16 * RS); return (bf16x8){lo[0], lo[1], lo[2], lo[3], hi[0], hi[1], hi[2], hi[3]}; }
__device__ __forceinline__ bf16x8 acc_pair_frag(const f32x4& lo, const f32x4& hi) {
    const unsigned a = pk2(lo[0], lo[1]), b = pk2(lo[2], lo[3]), c = pk2(hi[0], hi[1]), d = pk2(hi[2], hi[3]);
    typedef unsigned u32x4_ __attribute__((ext_vector_type(4))); const u32x4_ w = {a, b, c, d}; return __builtin_bit_cast(bf16x8, w); }
__device__ __forceinline__ float fexp2(float x) { return __builtin_amdgcn_exp2f(x); }
constexpr float LOG2E = 1.4426950408889634f;
__device__ __forceinline__ float fexp(float x) { return __builtin_amdgcn_exp2f(x * LOG2E); }
__device__ __forceinline__ float frcp(float x) { return __builtin_amdgcn_rcpf(x); }
__device__ __forceinline__ float frsq(float x) { return __builtin_amdgcn_rsqf(x); }
__device__ __forceinline__ float fsqrt(float x) { return __builtin_amdgcn_sqrtf(x); }
__device__ __forceinline__ float fsigmoid(float x) { return __builtin_amdgcn_rcpf(1.0f + __builtin_amdgcn_exp2f(-x * LOG2E)); }
__device__ __forceinline__ float fsilu(float x) { return x * fsigmoid(x); }
__device__ __forceinline__ void phase_gates_ab(const Ptrs& P, int G) {
    unsigned char* ws = P.ws; const bf16_t* __restrict__ XB = (const bf16_t*)(ws + WS_XB); const bf16_t* __restrict__ W3T = (const bf16_t*)(ws + WS_W3T); const float* __restrict__ SS1 = (const float*)(ws + WS_SS1); float* __restrict__ AB = (float*)(ws + WS_AB);
    const int tid = threadIdx.x, lane = tid & 63, wave = tid >> 6, g = lane >> 4, l15 = lane & 15;
    for (int mt = blockIdx.x * NWAVES + wave; mt < M_TOK / 16; mt += G * NWAVES) {
        const bf16_t* ap = XB + (size_t)(mt * 16 + l15) * D_MODEL + 8 * g; const bf16_t* bp = W3T + (size_t)(OD_N + l15) * D_MODEL + 8 * g;
        f32x4 acc = (f32x4){0.f, 0.f, 0.f, 0.f};
#pragma unroll 1
        for (int kb = 0; kb < D_MODEL / 32; kb += 16) { bf16x8 af[16], bfr[16];
#pragma unroll
            for (int i = 0; i < 16; ++i) { af[i] = *(const bf16x8*)(ap + 32 * (kb + i)); bfr[i] = *(const bf16x8*)(bp + 32 * (kb + i)); }
#pragma unroll
            for (int i = 0; i < 16; ++i) acc = MFMA16(af[i], bfr[i], acc); }
#pragma unroll
        for (int r = 0; r < 4; ++r) { const int row = mt * 16 + 4 * g + r; AB[(size_t)row * 16 + l15] = acc[r] * frsq(SS1[row] * (1.0f / D_MODEL) + EPS); } }
}
#ifdef SKELETON
__device__ __forceinline__ void phase_mix0(const Ptrs& P, LAS unsigned char* lds, int G) {
    v4u* Y = (v4u*)(P.ws + WS_Y); const v4u z = {0u, 0u, 0u, 0u};
    for (size_t i = (size_t)blockIdx.x * 512 + threadIdx.x; i < (size_t)M_TOK * D_MODEL / 8; i += (size_t)G * 512) Y[i] = z;
}
__device__ __forceinline__ void phase_mix1a(const Ptrs& P, LAS unsigned char* lds, int G) { phase_mix0(P, lds, G); }
__device__ __forceinline__ void phase_mix1b(const Ptrs& P, LAS unsigned char* lds, int G) { }
#endif
constexpr int AT_RSK = 272, AT_RSV = 288, AT_KB = 64 * AT_RSK, AT_VB = 64 * AT_RSV;
constexpr int AT_OFF_K = 0, AT_OFF_V = 2 * AT_KB, AT_OFF_TBL = AT_OFF_V + 2 * AT_VB, AT_LDS = AT_OFF_TBL + 2064;
static_assert(AT_LDS <= 163328, "attention LDS");
template <int SKIP = 0> __device__ __forceinline__ void attn_item(const Ptrs& P, LAS unsigned char* lds, int item, size_t yoff = WS_Y) {
    const bf16_t* __restrict__ PROJ = (const bf16_t*)(P.ws + WS_PROJ); bf16_t* __restrict__ Y = (bf16_t*)(P.ws + yoff);
    const float* __restrict__ qn_g = P.in[IN_EV_QNG]; const float* __restrict__ kn_g = P.in[IN_EV_KNG];
    const int tid = threadIdx.x, lane = tid & 63, wave = tid >> 6, g = lane >> 4, l15 = lane & 15;
    const int cp = item & 15, h = (item >> 4) & 7, b = item >> 7;
    const int c = 2 * cp + (wave >> 2), qt = wave & 3;
    LAS float* tbl = (LAS float*)(lds + AT_OFF_TBL);
    for (int i = tid; i < NREL; i += 512) tbl[i] = P.in[IN_EV_REL][h * NREL + i] * LOG2E;
    bf16x8 qf[4];
    { const bf16_t* qp = PROJ + (size_t)(b * SEQ + c * 64 + qt * 16 + l15) * EV_N + EC_QA + h * 128 + 8 * g;
      float qv[4][8]; float ss = 0.f;
#pragma unroll
      for (int ks = 0; ks < 4; ++ks) { ld8bf(qp + 32 * ks, qv[ks]);
#pragma unroll
          for (int i = 0; i < 8; ++i) ss += qv[ks][i] * qv[ks][i]; }
      ss += __shfl_xor(ss, 16); ss += __shfl_xor(ss, 32);
      const float rs = frsq(ss * (1.0f / 128.0f) + EPS) * (0.08838834764831845f * LOG2E);
#pragma unroll
      for (int ks = 0; ks < 4; ++ks) { const float* gp = qn_g + 32 * ks + 8 * g; typedef unsigned u32x4_ __attribute__((ext_vector_type(4)));
          const u32x4_ w = {pk2(qv[ks][0] * rs * gp[0], qv[ks][1] * rs * gp[1]), pk2(qv[ks][2] * rs * gp[2], qv[ks][3] * rs * gp[3]),
                            pk2(qv[ks][4] * rs * gp[4], qv[ks][5] * rs * gp[5]), pk2(qv[ks][6] * rs * gp[6], qv[ks][7] * rs * gp[7])};
          qf[ks] = __builtin_bit_cast(bf16x8, w); } }
    f32x4 o[8];
#pragma unroll
    for (int i = 0; i < 8; ++i) o[i] = (f32x4){0.f, 0.f, 0.f, 0.f};
    float mrun = -1.0e30f, lrun = 0.f;
    const int kt_lo = (2 * cp - LOOKBACK) < 0 ? 0 : (2 * cp - LOOKBACK), kt_hi = 2 * cp + 1;
    v4u kreg[2], vreg[2];
    const int srow0 = tid >> 4, sch = tid & 15;
    float kg[8];
#pragma unroll
    for (int i = 0; i < 8; ++i) kg[i] = kn_g[sch * 8 + i];
#define AT_LOAD(kt) do { _Pragma("unroll") for (int i_ = 0; i_ < 2; ++i_) { const bf16_t* rp_ = PROJ + (size_t)(b * SEQ + (kt) * 64 + srow0 + 32 * i_) * EV_N + h * 128 + sch * 8; \
        kreg[i_] = *(const v4u*)(rp_ + EC_KA); vreg[i_] = *(const v4u*)(rp_ + EC_VA); } } while (0)
#define AT_STORE(buf) do { _Pragma("unroll") for (int i_ = 0; i_ < 2; ++i_) { const int row_ = srow0 + 32 * i_; \
        float kv_[8]; kv_[0] = __builtin_bit_cast(float, kreg[i_].x << 16); kv_[1] = __builtin_bit_cast(float, kreg[i_].x & 0xffff0000u); kv_[2] = __builtin_bit_cast(float, kreg[i_].y << 16); kv_[3] = __builtin_bit_cast(float, kreg[i_].y & 0xffff0000u); \
        kv_[4] = __builtin_bit_cast(float, kreg[i_].z << 16); kv_[5] = __builtin_bit_cast(float, kreg[i_].z & 0xffff0000u); kv_[6] = __builtin_bit_cast(float, kreg[i_].w << 16); kv_[7] = __builtin_bit_cast(float, kreg[i_].w & 0xffff0000u); \
        float ss_ = 0.f; _Pragma("unroll") for (int e_ = 0; e_ < 8; ++e_) ss_ += kv_[e_] * kv_[e_]; \
        ss_ += __shfl_xor(ss_, 1); ss_ += __shfl_xor(ss_, 2); ss_ += __shfl_xor(ss_, 4); ss_ += __shfl_xor(ss_, 8); \
        const float rs_ = frsq(ss_ * (1.0f / 128.0f) + EPS); \
        v4u w_; w_.x = pk2(kv_[0] * rs_ * kg[0], kv_[1] * rs_ * kg[1]); w_.y = pk2(kv_[2] * rs_ * kg[2], kv_[3] * rs_ * kg[3]); w_.z = pk2(kv_[4] * rs_ * kg[4], kv_[5] * rs_ * kg[5]); w_.w = pk2(kv_[6] * rs_ * kg[6], kv_[7] * rs_ * kg[7]); \
        *(LAS v4u*)(lds + AT_OFF_K + (buf) * AT_KB + row_ * AT_RSK + sch * 16) = w_; \
        *(LAS v4u*)(lds + AT_OFF_V + (buf) * AT_VB + row_ * AT_RSV + sch * 16) = vreg[i_]; } } while (0)
    AT_LOAD(kt_lo); AT_STORE(0);
    __syncthreads();
    const int qi = qt * 16 + l15;
    for (int kt = kt_lo, it = 0; kt <= kt_hi; ++kt, ++it) {
        const int buf = it & 1;
        if (kt < kt_hi) AT_LOAD(kt + 1);
        const int to = kt - (c - LOOKBACK);
        if (to >= 0 && to <= LOOKBACK) {
            LAS const unsigned char* Kb = lds + AT_OFF_K + buf * AT_KB; LAS const unsigned char* Vb = lds + AT_OFF_V + buf * AT_VB;
            f32x4 s[4];
#pragma unroll
            for (int nt = 0; nt < 4; ++nt) { s[nt] = (f32x4){0.f, 0.f, 0.f, 0.f};
#pragma unroll
                for (int ks = 0; ks < ((SKIP & 16) ? 0 : 4); ++ks) s[nt] = MFMA16(frag_row(Kb, AT_RSK, 16 * nt, 32 * ks, lane), qf[ks], s[nt]); }
            if constexpr (!(SKIP & 2)) { const int relb = LOOKBACK * CHUNK - 64 * to + qi - 4 * g;
#pragma unroll
              for (int nt = 0; nt < 4; ++nt)
#pragma unroll
                  for (int r = 0; r < 4; ++r) { int rel = relb - 16 * nt - r; rel = rel > REL_MAX ? REL_MAX : rel; s[nt][r] += tbl[rel + REL_MAX]; } }
            float tmax = fmaxf(fmaxf(s[0][0], s[0][1]), fmaxf(s[0][2], s[0][3]));
#pragma unroll
            for (int nt = 1; nt < 4; ++nt) tmax = fmaxf(tmax, fmaxf(fmaxf(s[nt][0], s[nt][1]), fmaxf(s[nt][2], s[nt][3])));
            tmax = fmaxf(tmax, __shfl_xor(tmax, 16)); tmax = fmaxf(tmax, __shfl_xor(tmax, 32));
            const float mnew = fmaxf(mrun, tmax), alpha = fexp2(mrun - mnew);
            float rsum = 0.f;
#pragma unroll
            for (int nt = 0; nt < 4; ++nt)
#pragma unroll
                for (int r = 0; r < 4; ++r) { s[nt][r] = (SKIP & 4) ? (s[nt][r] - mnew) : fexp2(s[nt][r] - mnew); rsum += s[nt][r]; }
            rsum += __shfl_xor(rsum, 16); rsum += __shfl_xor(rsum, 32);
            lrun = lrun * alpha + rsum; mrun = mnew;
            const bf16x8 pf0 = acc_pair_frag(s[0], s[1]), pf1 = acc_pair_frag(s[2], s[3]);
            float al[4];
#pragma unroll
            for (int r = 0; r < 4; ++r) al[r] = __shfl(alpha, 4 * g + r);
#pragma unroll
            for (int dt = 0; dt < ((SKIP & 8) ? 0 : 8); ++dt) { o[dt][0] *= al[0]; o[dt][1] *= al[1]; o[dt][2] *= al[2]; o[dt][3] *= al[3];
                o[dt] = MFMA16(pf0, frag_tr_perm(Vb, AT_RSV, 0, 16 * dt, lane), o[dt]);
                o[dt] = MFMA16(pf1, frag_tr_perm(Vb, AT_RSV, 32, 16 * dt, lane), o[dt]); }
        }
        if (kt < kt_hi) AT_STORE(buf ^ 1);
        __syncthreads();
    }
#undef AT_LOAD
#undef AT_STORE
    float li[4];
#pragma unroll
    for (int r = 0; r < 4; ++r) li[r] = frcp(__shfl(lrun, 4 * g + r));
#pragma unroll
    for (int r = 0; r < 4; ++r) { const size_t tok = (size_t)b * SEQ + c * 64 + qt * 16 + 4 * g + r; const bf16_t* zp = PROJ + tok * EV_N + EC_ZA + h * 128 + l15; bf16_t* yp = Y + tok * D_MODEL + h * 128 + l15;
#pragma unroll
        for (int dt = 0; dt < 8; ++dt) yp[16 * dt] = (bf16_t)f2bf(o[dt][r] * li[r] * fsilu(bf2f(zp[16 * dt]))); }
}
constexpr int A2_KB = 64 * AT_RSK, A2_VB = 64 * AT_RSV, A2_BUF = 2 * A2_KB + 2 * A2_VB;
constexpr int A2_OFF_TBL = 2 * A2_BUF, A2_LDS = A2_OFF_TBL + 2 * 2064;
static_assert(A2_LDS <= 163328, "attention (2-head) LDS");
template <int SKIP = 0> __device__ __forceinline__ void attn2_item(const Ptrs& P, LAS unsigned char* lds, int item, size_t yoff = WS_Y) {
    const bf16_t* __restrict__ PROJ = (const bf16_t*)(P.ws + WS_PROJ); bf16_t* __restrict__ Y = (bf16_t*)(P.ws + yoff);
    const float* __restrict__ qn_g = P.in[IN_EV_QNG]; const float* __restrict__ kn_g = P.in[IN_EV_KNG];
    const int tid = threadIdx.x, lane = tid & 63, wave = tid >> 6, g = lane >> 4, l15 = lane & 15;
    const int cp = item & 15, hp = (item >> 4) & 3, b = item >> 6;
    const int hs = wave >> 2, h = 2 * hp + hs, c = 2 * cp + ((wave >> 1) & 1), q0 = 32 * (wave & 1);
    LAS float* tbl = (LAS float*)(lds + A2_OFF_TBL);
    for (int i = tid; i < 2 * NREL; i += 512) { const int hh = i / NREL, r = i - hh * NREL; tbl[hh * 516 + r] = P.in[IN_EV_REL][(2 * hp + hh) * NREL + r] * LOG2E; }
    bf16x8 qf[2][4];
#pragma unroll
    for (int q = 0; q < 2; ++q) { const bf16_t* qp = PROJ + (size_t)(b * SEQ + c * 64 + q0 + 16 * q + l15) * EV_N + EC_QA + h * 128 + 8 * g;
        float qv[4][8]; float ss = 0.f;
#pragma unroll
        for (int ks = 0; ks < 4; ++ks) { ld8bf(qp + 32 * ks, qv[ks]);
#pragma unroll
            for (int i = 0; i < 8; ++i) ss += qv[ks][i] * qv[ks][i]; }
        ss += __shfl_xor(ss, 16); ss += __shfl_xor(ss, 32);
        const float rs = frsq(ss * (1.0f / 128.0f) + EPS) * (0.08838834764831845f * LOG2E);
#pragma unroll
        for (int ks = 0; ks < 4; ++ks) { const float* gp = qn_g + 32 * ks + 8 * g; typedef unsigned u32x4_ __attribute__((ext_vector_type(4)));
            const u32x4_ w = {pk2(qv[ks][0] * rs * gp[0], qv[ks][1] * rs * gp[1]), pk2(qv[ks][2] * rs * gp[2], qv[ks][3] * rs * gp[3]),
                              pk2(qv[ks][4] * rs * gp[4], qv[ks][5] * rs * gp[5]), pk2(qv[ks][6] * rs * gp[6], qv[ks][7] * rs * gp[7])};
            qf[q][ks] = __builtin_bit_cast(bf16x8, w); } }
    f32x4 o[2][8];
#pragma unroll
    for (int q = 0; q < 2; ++q)
#pragma unroll
        for (int i = 0; i < 8; ++i) o[q][i] = (f32x4){0.f, 0.f, 0.f, 0.f};
    float mrun[2] = {-1.0e30f, -1.0e30f}, lrun[2] = {0.f, 0.f};
    const int kt_lo = (2 * cp - LOOKBACK) < 0 ? 0 : (2 * cp - LOOKBACK), kt_hi = 2 * cp + 1;
    v4u kreg[2][2], vreg[2][2];
    const int srow0 = tid >> 4, sch = tid & 15;
#define A2_LOAD(kt) do { _Pragma("unroll") for (int hh_ = 0; hh_ < 2; ++hh_) _Pragma("unroll") for (int i_ = 0; i_ < 2; ++i_) { \
        const bf16_t* rp_ = PROJ + (size_t)(b * SEQ + (kt) * 64 + srow0 + 32 * i_) * EV_N + (2 * hp + hh_) * 128 + sch * 8; kreg[hh_][i_] = *(const v4u*)(rp_ + EC_KA); vreg[hh_][i_] = *(const v4u*)(rp_ + EC_VA); } } while (0)
#define A2_STORE(buf) do { _Pragma("unroll") for (int hh_ = 0; hh_ < 2; ++hh_) _Pragma("unroll") for (int i_ = 0; i_ < 2; ++i_) { const int row_ = srow0 + 32 * i_; const v4u kr_ = kreg[hh_][i_]; \
        float kv_[8]; kv_[0] = __builtin_bit_cast(float, kr_.x << 16); kv_[1] = __builtin_bit_cast(float, kr_.x & 0xffff0000u); kv_[2] = __builtin_bit_cast(float, kr_.y << 16); kv_[3] = __builtin_bit_cast(float, kr_.y & 0xffff0000u); \
        kv_[4] = __builtin_bit_cast(float, kr_.z << 16); kv_[5] = __builtin_bit_cast(float, kr_.z & 0xffff0000u); kv_[6] = __builtin_bit_cast(float, kr_.w << 16); kv_[7] = __builtin_bit_cast(float, kr_.w & 0xffff0000u); \
        float ss_ = 0.f; _Pragma("unroll") for (int e_ = 0; e_ < 8; ++e_) ss_ += kv_[e_] * kv_[e_]; \
        ss_ += __shfl_xor(ss_, 1); ss_ += __shfl_xor(ss_, 2); ss_ += __shfl_xor(ss_, 4); ss_ += __shfl_xor(ss_, 8); \
        const float rs_ = frsq(ss_ * (1.0f / 128.0f) + EPS); const f32x4 kga_ = *(const f32x4*)(kn_g + sch * 8), kgb_ = *(const f32x4*)(kn_g + sch * 8 + 4); const float kg[8] = {kga_[0], kga_[1], kga_[2], kga_[3], kgb_[0], kgb_[1], kgb_[2], kgb_[3]}; \
        v4u w_; w_.x = pk2(kv_[0] * rs_ * kg[0], kv_[1] * rs_ * kg[1]); w_.y = pk2(kv_[2] * rs_ * kg[2], kv_[3] * rs_ * kg[3]); w_.z = pk2(kv_[4] * rs_ * kg[4], kv_[5] * rs_ * kg[5]); w_.w = pk2(kv_[6] * rs_ * kg[6], kv_[7] * rs_ * kg[7]); \
        *(LAS v4u*)(lds + (buf) * A2_BUF + hh_ * A2_KB + row_ * AT_RSK + sch * 16) = w_; \
        *(LAS v4u*)(lds + (buf) * A2_BUF + 2 * A2_KB + hh_ * A2_VB + row_ * AT_RSV + sch * 16) = vreg[hh_][i_]; } } while (0)
    A2_LOAD(kt_lo); A2_STORE(0);
    __syncthreads();
    LAS const float* tb = tbl + hs * 516;
    for (int kt = kt_lo, it = 0; kt <= kt_hi; ++kt, ++it) {
        const int buf = it & 1;
        if (kt < kt_hi) A2_LOAD(kt + 1);
        const int to = kt - (c - LOOKBACK);
        if (to >= 0 && to <= LOOKBACK) {
            LAS const unsigned char* Kb = lds + buf * A2_BUF + hs * A2_KB; LAS const unsigned char* Vb = lds + buf * A2_BUF + 2 * A2_KB + hs * A2_VB;
            f32x4 s[2][4];
#pragma unroll
            for (int nt = 0; nt < 4; ++nt) { s[0][nt] = (f32x4){0.f, 0.f, 0.f, 0.f}; s[1][nt] = s[0][nt];
#pragma unroll
                for (int ks = 0; ks < 4; ++ks) { const bf16x8 kf = frag_row(Kb, AT_RSK, 16 * nt, 32 * ks, lane); s[0][nt] = MFMA16(kf, qf[0][ks], s[0][nt]); s[1][nt] = MFMA16(kf, qf[1][ks], s[1][nt]); }
                if (nt & 1) __builtin_amdgcn_sched_barrier(0); }
            bf16x8 pf[2][2]; float al[2][4];
#pragma unroll
            for (int q = 0; q < 2; ++q) {
                const int relb = LOOKBACK * CHUNK - 64 * to + (q0 + 16 * q + l15) - 4 * g;
                if (to <= 3) { const float cb = tb[2 * REL_MAX];
#pragma unroll
                    for (int nt = 0; nt < 4; ++nt) s[q][nt] += cb; }
                else if (to >= 5) { const LAS float* tp = tb + relb + REL_MAX;
#pragma unroll
                    for (int nt = 0; nt < 4; ++nt)
#pragma unroll
                        for (int r = 0; r < 4; ++r) s[q][nt][r] += tp[-(16 * nt + r)]; }
                else {
#pragma unroll
                    for (int nt = 0; nt < 4; ++nt)
#pragma unroll
                        for (int r = 0; r < 4; ++r) { int rel = relb - 16 * nt - r; rel = rel > REL_MAX ? REL_MAX : rel; s[q][nt][r] += tb[rel + REL_MAX]; } }
                float tmax = fmaxf(fmaxf(s[q][0][0], s[q][0][1]), fmaxf(s[q][0][2], s[q][0][3]));
#pragma unroll
                for (int nt = 1; nt < 4; ++nt) tmax = fmaxf(tmax, fmaxf(fmaxf(s[q][nt][0], s[q][nt][1]), fmaxf(s[q][nt][2], s[q][nt][3])));
                tmax = fmaxf(tmax, __shfl_xor(tmax, 16)); tmax = fmaxf(tmax, __shfl_xor(tmax, 32));
                const float mnew = fmaxf(mrun[q], tmax), alpha = fexp2(mrun[q] - mnew);
                float rsum = 0.f;
#pragma unroll
                for (int nt = 0; nt < 4; ++nt)
#pragma unroll
                    for (int r = 0; r < 4; ++r) { s[q][nt][r] = fexp2(s[q][nt][r] - mnew); rsum += s[q][nt][r]; }
                rsum += __shfl_xor(rsum, 16); rsum += __shfl_xor(rsum, 32);
                lrun[q] = lrun[q] * alpha + rsum; mrun[q] = mnew;
                pf[q][0] = acc_pair_frag(s[q][0], s[q][1]); pf[q][1] = acc_pair_frag(s[q][2], s[q][3]);
#pragma unroll
                for (int r = 0; r < 4; ++r) al[q][r] = __shfl(alpha, 4 * g + r); }
#pragma unroll
            for (int dt = 0; dt < 8; ++dt) { const bf16x8 v0 = frag_tr_perm(Vb, AT_RSV, 0, 16 * dt, lane), v1 = frag_tr_perm(Vb, AT_RSV, 32, 16 * dt, lane);
#pragma unroll
                for (int q = 0; q < 2; ++q) { o[q][dt][0] *= al[q][0]; o[q][dt][1] *= al[q][1]; o[q][dt][2] *= al[q][2]; o[q][dt][3] *= al[q][3];
                    o[q][dt] = MFMA16(pf[q][0], v0, o[q][dt]); o[q][dt] = MFMA16(pf[q][1], v1, o[q][dt]); }
                if (dt & 1) __builtin_amdgcn_sched_barrier(0); }
        }
        if (kt < kt_hi) A2_STORE(buf ^ 1);
        __syncthreads();
    }
#undef A2_LOAD
#undef A2_STORE
#pragma unroll
    for (int q = 0; q < 2; ++q) { float li[4];
#pragma unroll
        for (int r = 0; r < 4; ++r) li[r] = frcp(__shfl(lrun[q], 4 * g + r));
#pragma unroll
        for (int r = 0; r < 4; ++r) { const size_t tok = (size_t)b * SEQ + c * 64 + q0 + 16 * q + 4 * g + r; const bf16_t* zp = PROJ + tok * EV_N + EC_ZA + h * 128 + l15; bf16_t* yp = Y + tok * D_MODEL + h * 128 + l15;
#pragma unroll
            for (int dt = 0; dt < 8; ++dt) yp[16 * dt] = (bf16_t)f2bf(o[q][dt][r] * li[r] * fsilu(bf2f(zp[16 * dt]))); } }
}
constexpr int ML_RSQ = 528, ML_RSK = 544, ML_RSV = 160, ML_RSP = 144, ML_RSH = 144;
constexpr int ML_OFF_Q = 0, ML_OFF_K = ML_OFF_Q + 64 * ML_RSQ, ML_OFF_V = ML_OFF_K + 64 * ML_RSK, ML_OFF_P = ML_OFF_V + 64 * ML_RSV, ML_OFF_H = ML_OFF_P + 64 * ML_RSP, ML_OFF_S = ML_OFF_H + 64 * ML_RSH;
constexpr int ML_BC = 0, ML_AA = 2048, ML_PM = 4096, ML_MCH = 6144  , ML_BL = 6184  , ML_PL = 6216  ;
constexpr int ML_E1 = 6248, ML_E2 = ML_E1 + 64, ML_WI = ML_E2 + 64, ML_EMT = ML_WI + 64, ML_WS = ML_EMT + 64, ML_RS = ML_WS + 64, ML_QN = ML_RS + 64, ML_NV = ML_QN + 64, ML_NP = ML_NV + 256, ML_WC = ML_NP + 512, ML_LDS = ML_OFF_S + (ML_WC + 4) * 4;
static_assert(ML_LDS <= 163328, "mLSTM LDS");
template <int SKIP = 0> __device__ __forceinline__ void mlstm_item(const Ptrs& P, LAS unsigned char* lds, int item, size_t yoff = WS_Y) {
    const bf16_t* __restrict__ PROJ = (const bf16_t*)(P.ws + WS_PROJ); bf16_t* __restrict__ Y = (bf16_t*)(P.ws + yoff); const float* __restrict__ GIF = (const float*)(P.ws + WS_GIF);
    const int tid = threadIdx.x, lane = tid & 63, wave = tid >> 6, g = lane >> 4, l15 = lane & 15;
    const int quarter = item & 3, h = (item >> 2) & 3, b = item >> 4;
    LAS float* sc = (LAS float*)(lds + ML_OFF_S);
    LAS const unsigned char* Qt = lds + ML_OFF_Q; LAS const unsigned char* Kt = lds + ML_OFF_K; LAS const unsigned char* Vt = lds + ML_OFF_V; LAS const unsigned char* Ps = lds + ML_OFF_P;
    const size_t tok0 = (size_t)b * SEQ;
    f32x4 cacc[16];
#pragma unroll
    for (int i = 0; i < 16; ++i) cacc[i] = (f32x4){0.f, 0.f, 0.f, 0.f};
    if (tid < 256) sc[ML_NV + tid] = 0.f;
    for (int e = tid; e < 64 * ML_RSP / 8; e += 512) *(LAS unsigned long long*)(lds + ML_OFF_P + e * 8) = 0ull;
    float gli[4], gfp[4];
#pragma unroll
    for (int i = 0; i < 4; ++i) { const size_t tok = tok0 + (wave * 4 + i) * 64 + lane; gli[i] = GIF[tok * 8 + h]; gfp[i] = GIF[tok * 8 + 4 + h]; }
#pragma unroll
    for (int i = 0; i < 4; ++i) { const int c = wave * 4 + i;
        const float li = gli[i], lf = logsigmoidf_(gfp[i]);
        float bc = lf;
#pragma unroll
        for (int o = 1; o < 64; o <<= 1) { const float t_ = __shfl_up(bc, o); if (lane >= o) bc += t_; }
        const float as = li - bc; float pm = as;
#pragma unroll
        for (int o = 1; o < 64; o <<= 1) { const float t_ = __shfl_up(pm, o); if (lane >= o) pm = fmaxf(pm, t_); }
        sc[ML_BC + c * 64 + lane] = bc; sc[ML_AA + c * 64 + lane] = as; sc[ML_PM + c * 64 + lane] = pm;
        if (lane == 63) { sc[ML_BL + c] = bc; sc[ML_PL + c] = pm; } }
    __syncthreads();
    if (tid == 0) { float m = 0.f; sc[ML_MCH] = 0.f;
        for (int c = 0; c < NCH; ++c) { m = sc[ML_BL + c] + fmaxf(m, sc[ML_PL + c]); sc[ML_MCH + c + 1] = m; } }
    v4u qreg[4], kreg[4], vreg, oreg, zreg;
    const int ot = tid >> 3, oc = (tid & 7) * 8, ocol = h * 256 + quarter * 64 + oc;
#define ML_LOAD(n) do { _Pragma("unroll") for (int i_ = 0; i_ < 4; ++i_) { const int id_ = tid + 512 * i_, row_ = id_ >> 5, ch_ = id_ & 31; const bf16_t* rp_ = PROJ + (tok0 + (n) * 64 + row_) * EV_N + h * 256 + ch_ * 8; \
            qreg[i_] = *(const v4u*)(rp_ + EC_QB); kreg[i_] = *(const v4u*)(rp_ + EC_KB); } \
        vreg = *(const v4u*)(PROJ + (tok0 + (n) * 64 + (tid >> 3)) * EV_N + EC_VB + h * 256 + quarter * 64 + (tid & 7) * 8); } while (0)
#define ML_LOAD_OZ(n) do { const bf16_t* rp_ = PROJ + (tok0 + (n) * 64 + ot) * EV_N + ocol; oreg = *(const v4u*)(rp_ + EC_OB); zreg = *(const v4u*)(rp_ + EC_ZB); } while (0)
#define ML_STORE() do { _Pragma("unroll") for (int i_ = 0; i_ < 4; ++i_) { const int id_ = tid + 512 * i_, row_ = id_ >> 5, ch_ = id_ & 31; \
            *(LAS v4u*)(lds + ML_OFF_Q + row_ * ML_RSQ + ch_ * 16) = qreg[i_]; *(LAS v4u*)(lds + ML_OFF_K + row_ * ML_RSK + ch_ * 16) = kreg[i_]; } \
        *(LAS v4u*)(lds + ML_OFF_V + (tid >> 3) * ML_RSV + (tid & 7) * 16) = vreg; } while (0)
    ML_LOAD(0);
    __syncthreads();
    for (int n = 0; n < NCH; ++n) {
        if constexpr (!(SKIP & 64)) ML_STORE();
        const float m0 = sc[ML_MCH + n], m1 = sc[ML_MCH + n + 1], blast = sc[ML_BL + n];
        if (tid < 64) { const float bc = sc[ML_BC + n * 64 + tid], as = sc[ML_AA + n * 64 + tid], mx = fmaxf(m0, sc[ML_PM + n * 64 + tid]);
            sc[ML_E1 + tid] = -mx * LOG2E; sc[ML_E2 + tid] = as * LOG2E; sc[ML_WI + tid] = fexp(m0 - mx); sc[ML_EMT + tid] = fexp(-bc - mx); sc[ML_WS + tid] = fexp(as + blast - m1); sc[ML_RS + tid] = 0.f;
            if (tid == 0) sc[ML_WC] = fexp(blast + m0 - m1); }
        __syncthreads();
        if constexpr (!(SKIP & 64)) { if (n + 1 < NCH) ML_LOAD(n + 1); }
        f32x4 nu[4]; bf16x8 vf[2];
        if (wave >= 4) {
#pragma unroll 1
            for (int q = wave - 4; q < ((SKIP & 2) ? 0 : 10); q += 4) { const int tt = (q >= 6) ? 3 : (q >= 3) ? 2 : (q >= 1) ? 1 : 0; const int st = q - (tt * (tt + 1)) / 2;
                const int t = 16 * tt + l15; const float e1 = sc[ML_E1 + t];
                f32x4 s_ = (f32x4){0.f, 0.f, 0.f, 0.f};
#pragma unroll
                for (int ks = 0; ks < 8; ++ks) s_ = MFMA16(frag_row(Kt, ML_RSK, 16 * st, 32 * ks, lane), frag_row(Qt, ML_RSQ, 16 * tt, 32 * ks, lane), s_);
                float pv_[4]; float rs = 0.f;
#pragma unroll
                for (int r = 0; r < 4; ++r) { const int sidx = 16 * st + 4 * g + r; const float p = (sidx <= t) ? fexp2(e1 + sc[ML_E2 + sidx]) * s_[r] * 0.0625f : 0.f; pv_[r] = p; rs += p; }
                rs += __shfl_xor(rs, 16); rs += __shfl_xor(rs, 32);
                if (g == 0) atomicAdd((float*)(sc + ML_RS + t), rs);
                *(LAS unsigned long long*)(lds + ML_OFF_P + t * ML_RSP + (16 * st + 4 * g) * 2) = (unsigned long long)pk2(pv_[0], pv_[1]) | ((unsigned long long)pk2(pv_[2], pv_[3]) << 32); }
        } else {
#pragma unroll
            for (int tt = 0; tt < 4; ++tt) nu[tt] = (f32x4){0.f, 0.f, 0.f, 0.f};
#pragma unroll
            for (int j = 0; j < ((SKIP & 4) ? 0 : 8); ++j) { const bf16x8 cf = acc_pair_frag(cacc[2 * j], cacc[2 * j + 1]);
#pragma unroll
                for (int tt = 0; tt < 4; ++tt) nu[tt] = MFMA16(frag_row_perm(Qt, ML_RSQ, 16 * tt, 32 * j, lane), cf, nu[tt]);
                if (j & 1) __builtin_amdgcn_sched_barrier(0); }
            if constexpr (!(SKIP & 32)) { f32x4 qna = (f32x4){0.f, 0.f, 0.f, 0.f}; const LAS float* nvc = sc + ((n & 1) ? ML_NP : ML_NV);
#pragma unroll
              for (int j = 0; j < 8; ++j) { const f32x4 n0_ = *(LAS const f32x4*)(nvc + 32 * j + 4 * g), n1_ = *(LAS const f32x4*)(nvc + 32 * j + 16 + 4 * g);
                  qna = MFMA16(frag_row_perm(Qt, ML_RSQ, 16 * wave, 32 * j, lane), acc_pair_frag(n0_, n1_), qna); }
              if (l15 == 0) *(LAS f32x4*)(sc + ML_QN + 16 * wave + 4 * g) = qna * 0.0625f; }
            __builtin_amdgcn_sched_barrier(0);
#pragma unroll
            for (int tt = 0; tt < 4; ++tt) { const f32x4 wi = *(LAS const f32x4*)(sc + ML_WI + 16 * tt + 4 * g); nu[tt] *= wi * 0.0625f; }
            __builtin_amdgcn_sched_barrier(0);
#pragma unroll
            for (int ks = 0; ks < 2; ++ks) vf[ks] = frag_tr_perm(Vt, ML_RSV, 32 * ks, 16 * wave, lane);
            const float wc = sc[ML_WC];
            bf16x8 vw[2];
#pragma unroll
            for (int ks = 0; ks < 2; ++ks) { typedef unsigned u32x4_ __attribute__((ext_vector_type(4))); const u32x4_ w = __builtin_bit_cast(u32x4_, vf[ks]);
                const f32x4 wa = *(LAS const f32x4*)(sc + ML_WS + 32 * ks + 4 * g), wb = *(LAS const f32x4*)(sc + ML_WS + 32 * ks + 16 + 4 * g);
                const u32x4_ o = {pk2(__builtin_bit_cast(float, w.x << 16) * wa[0], __builtin_bit_cast(float, w.x & 0xffff0000u) * wa[1]), pk2(__builtin_bit_cast(float, w.y << 16) * wa[2], __builtin_bit_cast(float, w.y & 0xffff0000u) * wa[3]),
                                  pk2(__builtin_bit_cast(float, w.z << 16) * wb[0], __builtin_bit_cast(float, w.z & 0xffff0000u) * wb[1]), pk2(__builtin_bit_cast(float, w.w << 16) * wb[2], __builtin_bit_cast(float, w.w & 0xffff0000u) * wb[3])};
                vw[ks] = __builtin_bit_cast(bf16x8, o); }
#pragma unroll
            for (int kt = 0; kt < ((SKIP & 8) ? 0 : 16); ++kt) { cacc[kt] *= wc;
                cacc[kt] = MFMA16(frag_tr_perm(Kt, ML_RSK, 0, 16 * kt, lane), vw[0], cacc[kt]);
                cacc[kt] = MFMA16(frag_tr_perm(Kt, ML_RSK, 32, 16 * kt, lane), vw[1], cacc[kt]);
                if ((kt & 3) == 3) __builtin_amdgcn_sched_barrier(0); }
#pragma unroll
            for (int kt = 0; kt < 16; ++kt) asm volatile("" : "+v"(cacc[kt]));
            if constexpr (!(SKIP & 32)) { bf16x8 wsf[2];
#pragma unroll
              for (int ks = 0; ks < 2; ++ks) { const f32x4 w0_ = *(LAS const f32x4*)(sc + ML_WS + 32 * ks + 4 * g), w1_ = *(LAS const f32x4*)(sc + ML_WS + 32 * ks + 16 + 4 * g); wsf[ks] = acc_pair_frag(w0_, w1_); }
              const LAS float* nvo = sc + ((n & 1) ? ML_NP : ML_NV); LAS float* nvn = sc + ((n & 1) ? ML_NV : ML_NP);
#pragma unroll
              for (int i = 0; i < 4; ++i) { const int kt = 4 * wave + i; f32x4 na = (f32x4){0.f, 0.f, 0.f, 0.f};
                  na = MFMA16(frag_tr_perm(Kt, ML_RSK, 0, 16 * kt, lane), wsf[0], na); na = MFMA16(frag_tr_perm(Kt, ML_RSK, 32, 16 * kt, lane), wsf[1], na);
                  if (l15 == 0) *(LAS f32x4*)(nvn + 16 * kt + 4 * g) = *(LAS const f32x4*)(nvo + 16 * kt + 4 * g) * wc + na; } }
        }
        __syncthreads();
        if constexpr (!(SKIP & 1)) ML_LOAD_OZ(n);
        if (wave < 4) {
#pragma unroll
            for (int ks = 0; ks < ((SKIP & 16) ? 0 : 2); ++ks) {
#pragma unroll
                for (int tt = 0; tt < 4; ++tt) nu[tt] = MFMA16(frag_row_perm(Ps, ML_RSP, 16 * tt, 32 * ks, lane), vf[ks], nu[tt]); }
#pragma unroll
            for (int tt = 0; tt < 4; ++tt)
#pragma unroll
                for (int r = 0; r < 4; ++r) *(LAS unsigned short*)(lds + ML_OFF_H + (16 * tt + 4 * g + r) * ML_RSH + (16 * wave + l15) * 2) = (unsigned short)(pk2(nu[tt][r], 0.f) & 0xffffu);
            __builtin_amdgcn_sched_barrier(0);
        }
        __syncthreads();
        if constexpr (!(SKIP & 1)) { const float den = sc[ML_WI + ot] * sc[ML_QN + ot] + sc[ML_RS + ot]; const float inv = frcp(fmaxf(fabsf(den), sc[ML_EMT + ot]));
          const v4u hw = *(LAS const v4u*)(lds + ML_OFF_H + ot * ML_RSH + oc * 2); const v4u ow = oreg, zw = zreg;
#define ML_Y(hx, ox, zx, lo) (fsigmoid(__builtin_bit_cast(float, (lo) ? ((ox) << 16) : ((ox) & 0xffff0000u))) * (__builtin_bit_cast(float, (lo) ? ((hx) << 16) : ((hx) & 0xffff0000u)) * inv) * fsilu(__builtin_bit_cast(float, (lo) ? ((zx) << 16) : ((zx) & 0xffff0000u))))
          v4u yw; yw.x = pk2(ML_Y(hw.x, ow.x, zw.x, 1), ML_Y(hw.x, ow.x, zw.x, 0)); yw.y = pk2(ML_Y(hw.y, ow.y, zw.y, 1), ML_Y(hw.y, ow.y, zw.y, 0));
          yw.z = pk2(ML_Y(hw.z, ow.z, zw.z, 1), ML_Y(hw.z, ow.z, zw.z, 0)); yw.w = pk2(ML_Y(hw.w, ow.w, zw.w, 1), ML_Y(hw.w, ow.w, zw.w, 0));
#undef ML_Y
          *(v4u*)(Y + (tok0 + n * 64 + ot) * D_MODEL + W_A + ocol) = yw; }
    }
#undef ML_LOAD
#undef ML_LOAD_OZ
#undef ML_STORE
    __syncthreads();
}
constexpr int RG_RSG = 160, RG_RSX = 272, RG_RSF = 33 * 4;
constexpr int RG_OFF_G = 0, RG_OFF_X = RG_OFF_G + 128 * RG_RSG, RG_OFF_XF = RG_OFF_X + 64 * RG_RSX, RG_OFF_A = RG_OFF_XF + 64 * RG_RSF, RG_OFF_I = RG_OFF_A + 64 * RG_RSF, RG_OFF_H = RG_OFF_I + 64 * RG_RSF, RG_LDS = RG_OFF_H + 64 * RG_RSF;
static_assert(RG_LDS <= 163328, "RG-LRU LDS");
template <int SKIP = 0> __device__ __forceinline__ void rglru_item(const Ptrs& P, LAS unsigned char* lds, int item, size_t yoff = WS_Y) {
    const bf16_t* __restrict__ PROJ = (const bf16_t*)(P.ws + WS_PROJ); bf16_t* __restrict__ Y = (bf16_t*)(P.ws + yoff);
    const float* __restrict__ ccw = P.in[IN_OD_CCW]; const float* __restrict__ ccb = P.in[IN_OD_CCB]; const float* __restrict__ gw = P.in[IN_OD_GW]; const float* __restrict__ gb = P.in[IN_OD_GB]; const float* __restrict__ lam = P.in[IN_OD_LAM];
    const int tid = threadIdx.x, lane = tid & 63, wave = tid >> 6, g = lane >> 4, l15 = lane & 15;
    const int cq = item & 3, blk = (item >> 2) & 7, b = item >> 5;
    const size_t tok0 = (size_t)b * SEQ;
#pragma unroll
    for (int e = tid; e < 128 * 64; e += 512) { const int k = e >> 6, c = e & 63; const int d = (c < 32) ? (cq * 32 + c) : (128 + cq * 32 + c - 32);
        *(LAS unsigned short*)(lds + RG_OFF_G + k * RG_RSG + c * 2) = (unsigned short)f2bf(gw[((size_t)blk * 128 + k) * 256 + d]); }
    const int c8 = tid & 15, tq = tid >> 4, ch0 = blk * 128 + 8 * c8;
    float cw[4][8], cb[8];
#pragma unroll
    for (int i = 0; i < 8; ++i) { cb[i] = ccb[ch0 + i];
#pragma unroll
        for (int j = 0; j < 4; ++j) cw[j][i] = ccw[j * W_C + ch0 + i]; }
    const int chl = 16 * (wave & 1) + l15, cgl = blk * 128 + cq * 32 + chl;
    const float gbr = gb[cgl], gbi = gb[W_C + cgl], sp = softplusf_(-lam[cgl]);
    float hcar = 0.f;
    v4u xin[2][4]; unsigned long long zin = 0ull;
    const int ot = tid >> 3, oc4 = tid & 7, cgo = blk * 128 + cq * 32 + 4 * oc4;
#define RG_LOAD(n) do { _Pragma("unroll") for (int u_ = 0; u_ < 2; ++u_) { const int s_ = (n) * 64 + tq + 32 * u_; \
            _Pragma("unroll") for (int j_ = 0; j_ < 4; ++j_) { const bool ok_ = (s_ - 3 + j_ >= 0); const v4u x_ = *(const v4u*)(PROJ + (tok0 + (ok_ ? s_ - 3 + j_ : 0)) * OD_N + OC_XC + ch0); \
                xin[u_][j_].x = ok_ ? x_.x : 0u; xin[u_][j_].y = ok_ ? x_.y : 0u; xin[u_][j_].z = ok_ ? x_.z : 0u; xin[u_][j_].w = ok_ ? x_.w : 0u; } } \
        zin = *(const unsigned long long*)(PROJ + (tok0 + (n) * 64 + ot) * OD_N + OC_ZC + cgo); } while (0)
    RG_LOAD(0);
    __syncthreads();
    for (int n = 0; n < NCH; ++n) {
        const unsigned long long zw = zin;
#pragma unroll
        for (int u = 0; u < ((SKIP & 1) ? 0 : 2); ++u) { const int t = tq + 32 * u; float xv[8];
#pragma unroll
            for (int i = 0; i < 8; ++i) xv[i] = cb[i];
#pragma unroll
            for (int j = 0; j < 4; ++j) { const v4u w_ = xin[u][j];
                xv[0] += cw[j][0] * __builtin_bit_cast(float, w_.x << 16); xv[1] += cw[j][1] * __builtin_bit_cast(float, w_.x & 0xffff0000u); xv[2] += cw[j][2] * __builtin_bit_cast(float, w_.y << 16); xv[3] += cw[j][3] * __builtin_bit_cast(float, w_.y & 0xffff0000u);
                xv[4] += cw[j][4] * __builtin_bit_cast(float, w_.z << 16); xv[5] += cw[j][5] * __builtin_bit_cast(float, w_.z & 0xffff0000u); xv[6] += cw[j][6] * __builtin_bit_cast(float, w_.w << 16); xv[7] += cw[j][7] * __builtin_bit_cast(float, w_.w & 0xffff0000u); }
            v4u w; w.x = pk2(xv[0], xv[1]); w.y = pk2(xv[2], xv[3]); w.z = pk2(xv[4], xv[5]); w.w = pk2(xv[6], xv[7]);
            *(LAS v4u*)(lds + RG_OFF_X + t * RG_RSX + c8 * 16) = w;
            if ((c8 >> 2) == cq) { LAS float* xf = (LAS float*)(lds + RG_OFF_XF + t * RG_RSF) + 8 * (c8 & 3);
#pragma unroll
                for (int i = 0; i < 8; ++i) xf[i] = xv[i]; } }
        if (n + 1 < NCH) RG_LOAD(n + 1);
        __syncthreads();
        { const int tt = wave >> 1, cp = wave & 1; f32x4 ar = (f32x4){0.f, 0.f, 0.f, 0.f}, ai = ar;
#pragma unroll
          for (int ks = 0; ks < ((SKIP & 2) ? 0 : 4); ++ks) { const bf16x8 xa = frag_row(lds + RG_OFF_X, RG_RSX, 16 * tt, 32 * ks, lane);
              ar = MFMA16(xa, frag_tr(lds + RG_OFF_G, RG_RSG, 32 * ks, 16 * cp, lane), ar);
              ai = MFMA16(xa, frag_tr(lds + RG_OFF_G, RG_RSG, 32 * ks, 32 + 16 * cp, lane), ai); }
#pragma unroll
          for (int r = 0; r < ((SKIP & 4) ? 0 : 4); ++r) { const int t = 16 * tt + 4 * g + r;
              const float rr = fsigmoid(ar[r] + gbr), ig = fsigmoid(ai[r] + gbi); const float la = -8.0f * rr * sp;
              const float xc = *((LAS const float*)(lds + RG_OFF_XF + t * RG_RSF) + chl);
              *((LAS float*)(lds + RG_OFF_A + t * RG_RSF) + chl) = fexp(la);
              *((LAS float*)(lds + RG_OFF_I + t * RG_RSF) + chl) = fsqrt(1.0f - fexp(2.0f * la)) * (ig * xc); } }
        __syncthreads();
        if ((SKIP & 8) == 0 && tid < 32) { float h = hcar;
#pragma unroll 8
            for (int t = 0; t < 64; ++t) { h = *((LAS const float*)(lds + RG_OFF_A + t * RG_RSF) + tid) * h + *((LAS const float*)(lds + RG_OFF_I + t * RG_RSF) + tid);
                *((LAS float*)(lds + RG_OFF_H + t * RG_RSF) + tid) = h; }
            hcar = h; }
        __syncthreads();
        if constexpr (!(SKIP & 16)) { const size_t tok = tok0 + n * 64 + ot;
          const LAS float* hp = (LAS const float*)(lds + RG_OFF_H + ot * RG_RSF) + 4 * oc4;
          const float z0 = __builtin_bit_cast(float, (unsigned)(zw & 0xffffull) << 16), z1 = __builtin_bit_cast(float, (unsigned)(zw >> 16 & 0xffffull) << 16), z2 = __builtin_bit_cast(float, (unsigned)(zw >> 32 & 0xffffull) << 16), z3 = __builtin_bit_cast(float, (unsigned)(zw >> 48) << 16);
          *(unsigned long long*)(Y + tok * D_MODEL + cgo) = (unsigned long long)pk2(hp[0] * fsilu(z0), hp[1] * fsilu(z1)) | ((unsigned long long)pk2(hp[2] * fsilu(z2), hp[3] * fsilu(z3)) << 32); }
    }
#undef RG_LOAD
    __syncthreads();
}
constexpr size_t WS_DQ2 = 4 * MiB, WS_DK2 = 36 * MiB;
constexpr size_t OUT_DWT = 0, OUT_DUT = 32 * MiB;
constexpr size_t WS_DQK = WS_FREE1, WS_DDEC = WS_FREE1 + 16 * MiB;
constexpr float DN_SCALE = 0.08838834764831845f;
template <int T> struct SolveRows {
    static __device__ __forceinline__ void run(float (&col)[32], LAS const unsigned char* Ab, int j) {
        SolveRows<T - 1>::run(col, Ab, j);
        float v = (T == j) ? 1.f : 0.f;
#pragma unroll
        for (int s4 = 0; s4 < (T + 3) / 4; ++s4) { const f32x4 a = *(LAS const f32x4*)(Ab + T * 272 + 16 * s4);
#pragma unroll
            for (int e = 0; e < 4; ++e) { if (4 * s4 + e < T) v -= a[e] * col[4 * s4 + e]; } }
        asm volatile("" : "+v"(v) :: "memory"); col[T] = v;
    }
};
template <> struct SolveRows<-1> { static __device__ __forceinline__ void run(float (&)[32], LAS const unsigned char*, int) {} };
constexpr int D1_RSQ = 272, D1_RSK = 288, D1_RSV = 288, D1_RSA = 272, D1_RST = 160;
constexpr int D1_OFF_Q = 0, D1_OFF_K = D1_OFF_Q + 64 * D1_RSQ, D1_OFF_V = D1_OFF_K + 64 * D1_RSK, D1_OFF_A = D1_OFF_V + 64 * D1_RSV, D1_OFF_T = D1_OFF_A + 64 * D1_RSA, D1_OFF_S = D1_OFF_T + 64 * D1_RST, D1_LDS = D1_OFF_S + 512;
static_assert(D1_LDS <= 163328, "D1 LDS");
template <int SKIP = 0> __device__ __forceinline__ void dn1_item(const Ptrs& P, LAS unsigned char* lds, int item) {
    const bf16_t* __restrict__ PROJ = (const bf16_t*)(P.ws + WS_PROJ); const float* __restrict__ AB = (const float*)(P.ws + WS_AB); const float* __restrict__ cdw = P.in[IN_OD_CDW];
    bf16_t* __restrict__ Q2 = (bf16_t*)(P.ws + WS_DQ2); bf16_t* __restrict__ K2 = (bf16_t*)(P.ws + WS_DK2);
    bf16_t* __restrict__ WTg = (bf16_t*)((unsigned char*)P.out + OUT_DWT) + (size_t)item * 8192; bf16_t* __restrict__ UTg = (bf16_t*)((unsigned char*)P.out + OUT_DUT) + (size_t)item * 8192;
    bf16_t* __restrict__ QKg = (bf16_t*)(P.ws + WS_DQK) + (size_t)item * 4096; float* __restrict__ DECg = (float*)(P.ws + WS_DDEC) + (size_t)item * 64;
    int tid_ = threadIdx.x; asm volatile("" : "+v"(tid_));
    const int tid = tid_, lane = tid & 63, wave = tid >> 6, g = lane >> 4, l15 = lane & 15;
    const int n = item & 31, h = (item >> 5) & 7, b = item >> 8;
    const size_t tok0 = (size_t)b * SEQ + n * 64;
    LAS float* beta_s = (LAS float*)(lds + D1_OFF_S); LAS float* dec_s = beta_s + 64;
    const float ab_a = AB[(tok0 + lane) * 16 + h], ab_b = AB[(tok0 + lane) * 16 + 8 + h], alog_ = P.in[IN_OD_ALOG][h], dtb_ = P.in[IN_OD_DTB][h];
    asm volatile("" ::: "memory");
    if constexpr (!(SKIP & 1)) { const int t = tid >> 3, d16 = tid & 7, s = n * 64 + t; float qk_[2][16]; float ssq[2] = {0.f, 0.f};
#pragma unroll
      for (int pp = 0; pp < 3; ++pp) { const int p = (pp + 2) % 3;
#pragma unroll
          for (int hf = 0; hf < 2; ++hf) { const int col = p * W_D + h * 128 + 16 * d16 + 8 * hf; float a[8];
              v4u xw[4];
#pragma unroll
              for (int j = 0; j < 4; ++j) { const bool ok = (s - 3 + j >= 0); xw[j] = *(const v4u*)(PROJ + (ok ? tok0 + t - 3 + j : tok0) * OD_N + OC_QD + col); }
#pragma unroll
              for (int i = 0; i < 8; ++i) a[i] = 0.f;
#pragma unroll
              for (int j = 0; j < 4; ++j) { const float m_ = (s - 3 + j >= 0) ? 1.0f : 0.0f; const f32x4 w0 = *(const f32x4*)(cdw + j * 3 * W_D + col) * m_, w1 = *(const f32x4*)(cdw + j * 3 * W_D + col + 4) * m_; const v4u x_ = xw[j];
                  a[0] += w0[0] * __builtin_bit_cast(float, x_.x << 16); a[1] += w0[1] * __builtin_bit_cast(float, x_.x & 0xffff0000u); a[2] += w0[2] * __builtin_bit_cast(float, x_.y << 16); a[3] += w0[3] * __builtin_bit_cast(float, x_.y & 0xffff0000u);
                  a[4] += w1[0] * __builtin_bit_cast(float, x_.z << 16); a[5] += w1[1] * __builtin_bit_cast(float, x_.z & 0xffff0000u); a[6] += w1[2] * __builtin_bit_cast(float, x_.w << 16); a[7] += w1[3] * __builtin_bit_cast(float, x_.w & 0xffff0000u); }
#pragma unroll
              for (int i = 0; i < 8; ++i) a[i] = fsilu(a[i]);
              if (p < 2) {
#pragma unroll
                  for (int i = 0; i < 8; ++i) { qk_[p][8 * hf + i] = a[i]; ssq[p] += a[i] * a[i]; } }
              else { v4u w; w.x = pk2(a[0], a[1]); w.y = pk2(a[2], a[3]); w.z = pk2(a[4], a[5]); w.w = pk2(a[6], a[7]);
                  *(LAS v4u*)(lds + D1_OFF_V + t * D1_RSV + (16 * d16 + 8 * hf) * 2) = w; }
              asm volatile("" ::: "memory"); } }
#pragma unroll
      for (int p = 0; p < 2; ++p) { float ss = ssq[p]; ss += __shfl_xor(ss, 1); ss += __shfl_xor(ss, 2); ss += __shfl_xor(ss, 4); const float rs = frsq(ss + EPS);
#pragma unroll
          for (int hf = 0; hf < 2; ++hf) { v4u w; w.x = pk2(qk_[p][8 * hf + 0] * rs, qk_[p][8 * hf + 1] * rs); w.y = pk2(qk_[p][8 * hf + 2] * rs, qk_[p][8 * hf + 3] * rs);
              w.z = pk2(qk_[p][8 * hf + 4] * rs, qk_[p][8 * hf + 5] * rs); w.w = pk2(qk_[p][8 * hf + 6] * rs, qk_[p][8 * hf + 7] * rs);
              const int dd = 16 * d16 + 8 * hf;
              if (p == 0) { *(LAS v4u*)(lds + D1_OFF_Q + t * D1_RSQ + dd * 2) = w; *(v4u*)(Q2 + (tok0 + t) * W_D + h * 128 + dd) = w; }
              else { *(LAS v4u*)(lds + D1_OFF_K + t * D1_RSK + dd * 2) = w; *(v4u*)(K2 + (tok0 + t) * W_D + h * 128 + dd) = w; } } } }
    if (wave == 0) {
        const float beta = fsigmoid(ab_b); float dc = -fexp(alog_) * softplusf_(ab_a + dtb_);
#pragma unroll
        for (int o = 1; o < 64; o <<= 1) { const float t_ = __shfl_up(dc, o); if (lane >= o) dc += t_; }
        beta_s[lane] = beta; dec_s[lane] = dc; DECg[lane] = dc; }
    __syncthreads();
    { const int tt = wave >> 1, t = 16 * tt + l15; const float dt_ = dec_s[t], bt = beta_s[t];
#pragma unroll
      for (int u = 0; u < 2; ++u) { const int st = 2 * (wave & 1) + u; unsigned long long qw = 0ull;
          if (st <= tt && !(SKIP & 2)) { f32x4 kk = (f32x4){0.f, 0.f, 0.f, 0.f}, qk = kk;
#pragma unroll
              for (int ks = 0; ks < 4; ++ks) { const bf16x8 a = frag_row(lds + D1_OFF_K, D1_RSK, 16 * st, 32 * ks, lane);
                  kk = MFMA16(a, frag_row(lds + D1_OFF_K, D1_RSK, 16 * tt, 32 * ks, lane), kk); qk = MFMA16(a, frag_row(lds + D1_OFF_Q, D1_RSQ, 16 * tt, 32 * ks, lane), qk); }
              f32x4 am; float qv[4];
#pragma unroll
              for (int r = 0; r < 4; ++r) { const int s = 16 * st + 4 * g + r; const float gam = (s <= t) ? fexp(dt_ - dec_s[s]) : 0.f; am[r] = (s < t) ? bt * kk[r] * gam : 0.f; qv[r] = qk[r] * gam * DN_SCALE; }
              *(LAS f32x4*)(lds + D1_OFF_A + t * D1_RSA + (16 * st + 4 * g) * 4) = am;
              qw = (unsigned long long)pk2(qv[0], qv[1]) | ((unsigned long long)pk2(qv[2], qv[3]) << 32); }
          *(unsigned long long*)(QKg + t * 64 + 16 * st + 4 * g) = qw; } }
    __syncthreads();
    if (wave == 0 && !(SKIP & 4)) { const int hb = lane >> 5, j = lane & 31; float col[32];
        LAS const unsigned char* Ab = lds + D1_OFF_A + (32 * hb) * D1_RSA + (32 * hb) * 4;
        SolveRows<31>::run(col, Ab, j);
        LAS unsigned char* trow = lds + D1_OFF_T + (32 * hb + j) * D1_RST;
#pragma unroll
        for (int c = 0; c < 4; ++c) { v4u w; w.x = pk2(col[8 * c], col[8 * c + 1]); w.y = pk2(col[8 * c + 2], col[8 * c + 3]); w.z = pk2(col[8 * c + 4], col[8 * c + 5]); w.w = pk2(col[8 * c + 6], col[8 * c + 7]);
            *(LAS v4u*)(trow + (32 * hb) * 2 + 16 * c) = w;
            if (hb) *(LAS v4u*)(trow + 16 * c) = (v4u){0u, 0u, 0u, 0u}; }
        bf16x8 af[2], bfr[2];
#pragma unroll
        for (int ti = 0; ti < 2; ++ti) { LAS const unsigned char* ap = lds + D1_OFF_A + (32 + 16 * ti + l15) * D1_RSA + (8 * g) * 4; const f32x4 a0 = *(LAS const f32x4*)ap, a1 = *(LAS const f32x4*)(ap + 16);
            typedef unsigned u32x4_ __attribute__((ext_vector_type(4))); const u32x4_ w = {pk2(a0[0], a0[1]), pk2(a0[2], a0[3]), pk2(a1[0], a1[1]), pk2(a1[2], a1[3])}; af[ti] = __builtin_bit_cast(bf16x8, w); }
#pragma unroll
        for (int nj = 0; nj < 2; ++nj) bfr[nj] = frag_row(lds + D1_OFF_T, D1_RST, 16 * nj, 0, lane);
        f32x4 X[2][2];
#pragma unroll
        for (int ti = 0; ti < 2; ++ti)
#pragma unroll
            for (int nj = 0; nj < 2; ++nj) X[ti][nj] = MFMA16(af[ti], bfr[nj], ((f32x4){0.f, 0.f, 0.f, 0.f}));
        LAS const unsigned char* T11b = lds + D1_OFF_T + 32 * D1_RST + 64;
#pragma unroll
        for (int nj = 0; nj < 2; ++nj) { const bf16x8 xb = acc_pair_frag(X[0][nj], X[1][nj]);
#pragma unroll
            for (int ti = 0; ti < 2; ++ti) { const f32x4 r_ = MFMA16(frag_tr_perm(T11b, D1_RST, 0, 16 * ti, lane), xb, ((f32x4){0.f, 0.f, 0.f, 0.f}));
                *(LAS unsigned long long*)(lds + D1_OFF_T + (16 * nj + l15) * D1_RST + (32 + 16 * ti + 4 * g) * 2) = (unsigned long long)pk2(-r_[0], -r_[1]) | ((unsigned long long)pk2(-r_[2], -r_[3]) << 32); } }
    }
    __syncthreads();
    if constexpr (!(SKIP & 8)) { bf16x8 bv[2], bk[2];
#pragma unroll
      for (int ks = 0; ks < 2; ++ks) { typedef unsigned u32x4_ __attribute__((ext_vector_type(4)));
          const u32x4_ wv = __builtin_bit_cast(u32x4_, frag_tr(lds + D1_OFF_V, D1_RSV, 32 * ks, 16 * wave, lane)), wk = __builtin_bit_cast(u32x4_, frag_tr(lds + D1_OFF_K, D1_RSK, 32 * ks, 16 * wave, lane));
          float fb[8], fk[8];
#pragma unroll
          for (int i = 0; i < 8; ++i) { const int s = 32 * ks + 8 * g + i; fb[i] = beta_s[s]; fk[i] = fb[i] * fexp(dec_s[s]); }
#define SC2(w_, f0, f1) pk2(__builtin_bit_cast(float, (w_) << 16) * (f0), __builtin_bit_cast(float, (w_) & 0xffff0000u) * (f1))
          const u32x4_ ov = {SC2(wv.x, fb[0], fb[1]), SC2(wv.y, fb[2], fb[3]), SC2(wv.z, fb[4], fb[5]), SC2(wv.w, fb[6], fb[7])};
          const u32x4_ ok = {SC2(wk.x, fk[0], fk[1]), SC2(wk.y, fk[2], fk[3]), SC2(wk.z, fk[4], fk[5]), SC2(wk.w, fk[6], fk[7])};
#undef SC2
          bv[ks] = __builtin_bit_cast(bf16x8, ov); bk[ks] = __builtin_bit_cast(bf16x8, ok); }
#pragma unroll
      for (int tt = 0; tt < 4; ++tt) { f32x4 u = (f32x4){0.f, 0.f, 0.f, 0.f}, wv = u;
#pragma unroll
          for (int ks = 0; ks < 2; ++ks) { const bf16x8 at = frag_tr(lds + D1_OFF_T, D1_RST, 32 * ks, 16 * tt, lane); u = MFMA16(at, bv[ks], u); wv = MFMA16(at, bk[ks], wv); }
          const size_t o_ = (size_t)(16 * wave + l15) * 64 + 16 * tt + 4 * g;
          *(unsigned long long*)(UTg + o_) = (unsigned long long)pk2(u[0], u[1]) | ((unsigned long long)pk2(u[2], u[3]) << 32);
          *(unsigned long long*)(WTg + o_) = (unsigned long long)pk2(wv[0], wv[1]) | ((unsigned long long)pk2(wv[2], wv[3]) << 32); } }
    __syncthreads();
}
constexpr int D2_RSW = 144, D2_RSQ = 272, D2_RSK = 288, D2_RSP = 144, D2_RSO = 528;
constexpr int D2_OFF_W = 0, D2_OFF_Q = D2_OFF_W + 128 * D2_RSW, D2_OFF_K = D2_OFF_Q + 64 * D2_RSQ, D2_OFF_P = D2_OFF_K + 64 * D2_RSK, D2_OFF_O = D2_OFF_P + 64 * D2_RSP, D2_OFF_D = D2_OFF_O + 64 * D2_RSO, D2_LDS = D2_OFF_D + 1024;
static_assert(D2_LDS <= 163328, "D2 LDS");
template <int SKIP = 0> __device__ __forceinline__ void dn2_item(const Ptrs& P, LAS unsigned char* lds, int item, size_t yoff = WS_Y) {
    const bf16_t* __restrict__ PROJ = (const bf16_t*)(P.ws + WS_PROJ); bf16_t* __restrict__ Y = (bf16_t*)(P.ws + yoff);
    const bf16_t* __restrict__ Q2 = (const bf16_t*)(P.ws + WS_DQ2); const bf16_t* __restrict__ K2 = (const bf16_t*)(P.ws + WS_DK2);
    const int tid = threadIdx.x, lane = tid & 63, wave = tid >> 6, g = lane >> 4, l15 = lane & 15;
    const int h = item & 7, b = item >> 3;
    const size_t tok0 = (size_t)b * SEQ; const int it0 = item * 32;
    const bf16_t* __restrict__ WTg = (const bf16_t*)((const unsigned char*)P.out + OUT_DWT) + (size_t)it0 * 8192; const bf16_t* __restrict__ UTg = (const bf16_t*)((const unsigned char*)P.out + OUT_DUT) + (size_t)it0 * 8192;
    const bf16_t* __restrict__ QKg = (const bf16_t*)(P.ws + WS_DQK) + (size_t)it0 * 4096; const float* __restrict__ DECg = (const float*)(P.ws + WS_DDEC) + (size_t)it0 * 64;
    LAS float* ed_s = (LAS float*)(lds + D2_OFF_D); LAS float* ek_s = ed_s + 64; LAS float* edl_s = ed_s + 128;
    f32x4 sacc[8];
#pragma unroll
    for (int i = 0; i < 8; ++i) sacc[i] = (f32x4){0.f, 0.f, 0.f, 0.f};
    const int ot = tid >> 3, oc = (tid & 7) * 16;
    float og[16];
#pragma unroll
    for (int i = 0; i < 16; ++i) og[i] = P.in[IN_OD_ONORM][oc + i];
    v4u wreg[2], qreg[2], kreg[2], preg, zreg[2]; unsigned long long ureg[4]; float dreg = 0.f, dlreg = 0.f;
#define D2_LOAD(n) do { _Pragma("unroll") for (int i_ = 0; i_ < 2; ++i_) { const int id_ = tid + 512 * i_; wreg[i_] = *(const v4u*)(WTg + (size_t)(n) * 8192 + id_ * 8); \
            const int row_ = id_ >> 4, ch_ = id_ & 15; const size_t o2_ = (tok0 + (n) * 64 + row_) * W_D + h * 128 + ch_ * 8; qreg[i_] = *(const v4u*)(Q2 + o2_); kreg[i_] = *(const v4u*)(K2 + o2_); } \
        preg = *(const v4u*)(QKg + (size_t)(n) * 4096 + tid * 8); \
        _Pragma("unroll") for (int tt_ = 0; tt_ < 4; ++tt_) ureg[tt_] = *(const unsigned long long*)(UTg + (size_t)(n) * 8192 + (16 * wave + l15) * 64 + 16 * tt_ + 4 * g); \
        if (tid < 64) { dreg = DECg[(n) * 64 + tid]; dlreg = DECg[(n) * 64 + 63]; } } while (0)
#define D2_LOAD_Z(n) do { const bf16_t* zp_ = PROJ + (tok0 + (n) * 64 + ot) * OD_N + OC_ZD + h * 128 + oc; zreg[0] = *(const v4u*)zp_; zreg[1] = *(const v4u*)(zp_ + 8); } while (0)
#define D2_STORE() do { _Pragma("unroll") for (int i_ = 0; i_ < 2; ++i_) { const int id_ = tid + 512 * i_; *(LAS v4u*)(lds + D2_OFF_W + (id_ >> 3) * D2_RSW + (id_ & 7) * 16) = wreg[i_]; \
            const int row_ = id_ >> 4, ch_ = id_ & 15; *(LAS v4u*)(lds + D2_OFF_Q + row_ * D2_RSQ + ch_ * 16) = qreg[i_]; *(LAS v4u*)(lds + D2_OFF_K + row_ * D2_RSK + ch_ * 16) = kreg[i_]; } \
        *(LAS v4u*)(lds + D2_OFF_P + (tid >> 3) * D2_RSP + (tid & 7) * 16) = preg; \
        if (tid < 64) { ed_s[tid] = fexp(dreg) * DN_SCALE; ek_s[tid] = fexp(dlreg - dreg); if (tid == 0) edl_s[0] = fexp(dlreg); } } while (0)
    D2_LOAD(0);
    for (int n = 0; n < NCH; ++n) {
        if constexpr (!(SKIP & 16)) D2_STORE();
        f32x4 un[4];
#pragma unroll
        for (int tt = 0; tt < 4; ++tt) { un[tt][0] = __builtin_bit_cast(float, (unsigned)(ureg[tt] & 0xffffull) << 16); un[tt][1] = __builtin_bit_cast(float, (unsigned)(ureg[tt] >> 16 & 0xffffull) << 16);
            un[tt][2] = __builtin_bit_cast(float, (unsigned)(ureg[tt] >> 32 & 0xffffull) << 16); un[tt][3] = __builtin_bit_cast(float, (unsigned)(ureg[tt] >> 48) << 16); }
        __syncthreads();
        if constexpr (!(SKIP & 16)) { if (n + 1 < NCH) D2_LOAD(n + 1); }
        bf16x8 sf[4];
#pragma unroll
        for (int j = 0; j < 4; ++j) sf[j] = acc_pair_frag(sacc[2 * j], sacc[2 * j + 1]);
        f32x4 vn[4], o[4];
#pragma unroll
        for (int tt = 0; tt < 4; ++tt) { f32x4 ws_ = (f32x4){0.f, 0.f, 0.f, 0.f}, qs_ = ws_;
#pragma unroll
            for (int j = 0; j < ((SKIP & 2) ? 0 : 4); ++j) { ws_ = MFMA16(frag_tr_perm(lds + D2_OFF_W, D2_RSW, 32 * j, 16 * tt, lane), sf[j], ws_); qs_ = MFMA16(frag_row_perm(lds + D2_OFF_Q, D2_RSQ, 16 * tt, 32 * j, lane), sf[j], qs_); }
            vn[tt] = un[tt] - ws_; o[tt] = qs_ * *(LAS const f32x4*)(ed_s + 16 * tt + 4 * g); }
        __builtin_amdgcn_sched_barrier(0);
        bf16x8 vf[2], vsf[2];
#pragma unroll
        for (int ks = 0; ks < 2; ++ks) { vf[ks] = acc_pair_frag(vn[2 * ks], vn[2 * ks + 1]);
            const f32x4 a_ = vn[2 * ks] * *(LAS const f32x4*)(ek_s + 32 * ks + 4 * g), b_ = vn[2 * ks + 1] * *(LAS const f32x4*)(ek_s + 32 * ks + 16 + 4 * g);
            vsf[ks] = acc_pair_frag(a_, b_); }
#pragma unroll
        for (int tt = 0; tt < 4; ++tt)
#pragma unroll
            for (int ks = 0; ks < ((SKIP & 4) ? 0 : 2); ++ks) o[tt] = MFMA16(frag_row_perm(lds + D2_OFF_P, D2_RSP, 16 * tt, 32 * ks, lane), vf[ks], o[tt]);
#pragma unroll
        for (int tt = 0; tt < 4; ++tt)
#pragma unroll
            for (int r = 0; r < 4; ++r) *(LAS float*)(lds + D2_OFF_O + (16 * tt + 4 * g + r) * D2_RSO + (16 * wave + l15) * 4) = o[tt][r];
        __builtin_amdgcn_sched_barrier(0);
        if constexpr (!(SKIP & 1)) D2_LOAD_Z(n);
        { const float edl = edl_s[0];
#pragma unroll
          for (int kt = 0; kt < ((SKIP & 8) ? 0 : 8); ++kt) { sacc[kt] *= edl;
#pragma unroll
              for (int ks = 0; ks < 2; ++ks) sacc[kt] = MFMA16(frag_tr_perm(lds + D2_OFF_K, D2_RSK, 32 * ks, 16 * kt, lane), vsf[ks], sacc[kt]);
              if ((kt & 3) == 3) __builtin_amdgcn_sched_barrier(0); }
#pragma unroll
          for (int kt = 0; kt < 8; ++kt) asm volatile("" : "+v"(sacc[kt])); }
        __syncthreads();
        if constexpr (!(SKIP & 1)) { f32x4 ov[4]; float ss = 0.f;
#pragma unroll
          for (int c = 0; c < 4; ++c) { ov[c] = *(LAS const f32x4*)(lds + D2_OFF_O + ot * D2_RSO + (oc + 4 * c) * 4); ss += (ov[c][0] * ov[c][0] + ov[c][1] * ov[c][1]) + (ov[c][2] * ov[c][2] + ov[c][3] * ov[c][3]); }
          ss += __shfl_xor(ss, 1); ss += __shfl_xor(ss, 2); ss += __shfl_xor(ss, 4);
          const float rs = frsq(ss * (1.0f / 128.0f) + EPS);
          bf16_t* yp = Y + (tok0 + n * 64 + ot) * D_MODEL + W_C + h * 128 + oc;
#pragma unroll
          for (int c = 0; c < 2; ++c) { const v4u zw = zreg[c]; const f32x4 a = ov[2 * c], b_ = ov[2 * c + 1];
#define D2_Y(ov_, gi, zx, lo) ((ov_) * rs * og[gi] * fsilu(__builtin_bit_cast(float, (lo) ? ((zx) << 16) : ((zx) & 0xffff0000u))))
              v4u yw; yw.x = pk2(D2_Y(a[0], 8 * c + 0, zw.x, 1), D2_Y(a[1], 8 * c + 1, zw.x, 0)); yw.y = pk2(D2_Y(a[2], 8 * c + 2, zw.y, 1), D2_Y(a[3], 8 * c + 3, zw.y, 0));
              yw.z = pk2(D2_Y(b_[0], 8 * c + 4, zw.z, 1), D2_Y(b_[1], 8 * c + 5, zw.z, 0)); yw.w = pk2(D2_Y(b_[2], 8 * c + 6, zw.w, 1), D2_Y(b_[3], 8 * c + 7, zw.w, 0));
#undef D2_Y
              *(v4u*)(yp + 8 * c) = yw; } }
    }
#undef D2_LOAD
#undef D2_LOAD_Z
#undef D2_STORE
    __syncthreads();
}
__device__ __forceinline__ void phase_mix0(const Ptrs& P, LAS unsigned char* lds, int G) {
    const int w = blockIdx.x;
    constexpr int NML = BATCH * H_B * 4;
    if (w < NML) mlstm_item(P, lds, w);
    else if (G - NML == 128) {
        const int wa = w - NML, bhp = wa >> 2, k0 = wa & 3;
        for (int k = 3; k >= 0; --k) attn2_item(P, lds, bhp * 16 + 4 * k + k0); }
    else { for (int item = w - NML; item < BATCH * H_A * (NCH / 2); item += G - NML) attn_item(P, lds, item); }
    if (w < NML) { const int wave = threadIdx.x >> 6, lane = threadIdx.x & 63; late_weights(P, lds, wave, lane, w * NWAVES + wave, NML * NWAVES); }
}
__device__ __forceinline__ void phase_mix1a(const Ptrs& P, LAS unsigned char* lds, int G) {
    const int w = blockIdx.x; constexpr int ND1 = BATCH * H_D * NCH, NRG = BATCH * N_BLK_C * 4;
    if (G == 256) {
        if (w < 64) { rglru_item<0>(P, lds, 192 + w); dn1_item(P, lds, 2 * w); dn1_item(P, lds, 2 * w + 1); }
        else { const int first = 128 + (w - 64) * 10; for (int i = 0; i < 10; ++i) dn1_item(P, lds, first + i); }
    } else {
        for (int it = 192 + w; it < NRG; it += G) rglru_item<0>(P, lds, it);
        for (int it = w; it < ND1; it += G) dn1_item(P, lds, it); }
}
__device__ __forceinline__ void phase_mix1b(const Ptrs& P, LAS unsigned char* lds, int G) {
    constexpr int ND2 = BATCH * H_D;
    if ((int)blockIdx.x < ND2) dn2_item(P, lds, blockIdx.x);
    else { for (int it = blockIdx.x - ND2; it < 192; it += G - ND2) rglru_item<0>(P, lds, it);
        const int wave = threadIdx.x >> 6, lane = threadIdx.x & 63; last_weight(P, lds, wave, lane, (blockIdx.x - ND2) * NWAVES + wave, (G - ND2) * NWAVES); }
}
typedef GAS unsigned gu32;
#define RLX_AGENT __ATOMIC_RELAXED, __HIP_MEMORY_SCOPE_AGENT
constexpr int CW_BAR = 4096;
static_assert((CW_BAR + XCD_BAR_WORDS) * 4 <= (int)CTL_ZERO_BYTES, "CTL words inside the memset region");
constexpr int LDS_BYTES = 163840;
constexpr int RING_OFF = 0, RING_BYTES = LDS_BYTES - 512;
constexpr int LDSCTL_OFF = RING_BYTES, MISC_OFF = LDSCTL_OFF + 320;

struct Args { Ptrs P; int ph_lo, ph_hi; };
constexpr int N_PHASES = 8;

__global__ void __launch_bounds__(NWAVES * 64, 2) fwd_mega(Args args) {
    extern __shared__ __attribute__((aligned(16))) unsigned char lds_raw[];
    LAS unsigned char* lds = (LAS unsigned char*)lds_raw;
    volatile LAS unsigned* MISC = (volatile LAS unsigned*)(lds + MISC_OFF);
    const int tid = threadIdx.x, lane = tid & 63, wave = __builtin_amdgcn_readfirstlane(tid >> 6);
    const int G = gridDim.x;
    for (int u = tid; u < (LDS_BYTES - LDSCTL_OFF) / 4; u += NWAVES * 64) ((LAS unsigned*)(lds + LDSCTL_OFF))[u] = 0u;
    __syncthreads();
    const Ptrs& P = args.P;
    gu32* ctl = (gu32*)(P.ws + WS_CTL);
    const int lo = args.ph_lo, hi = args.ph_hi;
    XcdBarrier bar; bar.bar = (unsigned*)(ctl + CW_BAR); bar.x = 0; bar.st = nullptr;
    if (hi - lo > 1) bar = xcd_barrier_post((unsigned*)(ctl + CW_BAR), MISC + 8);
#define IN(k) (lo <= (k) && (k) < hi)
#define SEAM(k) do { if (IN(k) && IN((k) + 1)) xcd_barrier(bar); } while (0)
#ifndef DUP_PHASE
#define DUP_PHASE -1
#endif
#define RUN(k) do { \
    if ((k) == 0) phase_prologue<3>(P, lds, wave, lane, blockIdx.x * NWAVES + wave, G * NWAVES); \
    else if ((k) == 1) phase_gemm<1>(P, lds, G, blockIdx.x); \
    else if ((k) == 2) phase_mix0(P, lds, G); \
    else if ((k) == 3) phase_gemm<2>(P, lds, G, blockIdx.x); \
    else if ((k) == 4) { phase_gemm<3>(P, lds, G, blockIdx.x); phase_gates_ab(P, G); } \
    else if ((k) == 5) phase_mix1a(P, lds, G); \
    else if ((k) == 6) phase_mix1b(P, lds, G); \
    else phase_gemm<4>(P, lds, G, blockIdx.x); } while (0)
#define STEP(k) do { if (IN(k)) { if ((k) == 0 && DUP_PHASE >= 6001 && DUP_PHASE <= 6002) { phase_prologue<(DUP_PHASE >= 6001 && DUP_PHASE <= 6002 ? DUP_PHASE - 6000 : 3)>(P, lds, wave, lane, blockIdx.x * NWAVES + wave, G * NWAVES); xcd_barrier(bar); } if ((k) == 5 && DUP_PHASE >= 5000 && DUP_PHASE < 5016) { for (int it_ = blockIdx.x; it_ < BATCH * H_D * NCH; it_ += G) dn1_item<(DUP_PHASE >= 5000 ? DUP_PHASE - 5000 : 0)>(P, lds, it_); xcd_barrier(bar); } RUN(k); if (DUP_PHASE == (k)) { xcd_barrier(bar); RUN(k); } \
        if ((k) == 2 && DUP_PHASE == 20) { xcd_barrier(bar); if (blockIdx.x >= 128) phase_mix0(P, lds, G); } \
        if ((k) == 2 && DUP_PHASE == 21) { xcd_barrier(bar); if (blockIdx.x < 128) phase_mix0(P, lds, G); } \
        if ((k) == 2 && DUP_PHASE >= 2000 && DUP_PHASE < 2128) { xcd_barrier(bar); if (blockIdx.x >= 128) { const int wa_ = blockIdx.x - 128; for (int k_ = 3; k_ >= 0; --k_) attn2_item<(DUP_PHASE >= 2000 ? DUP_PHASE - 2000 : 0)>(P, lds, (wa_ >> 2) * 16 + 4 * k_ + (wa_ & 3), WS_XB); } } \
        if ((k) == 2 && DUP_PHASE >= 1000 && DUP_PHASE < 1128) { xcd_barrier(bar); if (blockIdx.x < 128) mlstm_item<(DUP_PHASE >= 1000 ? DUP_PHASE - 1000 : 0)>(P, lds, blockIdx.x, WS_XB); } \
        if ((k) == 6 && DUP_PHASE >= 3000 && DUP_PHASE < 3032) { xcd_barrier(bar); if (blockIdx.x < 64) dn2_item<(DUP_PHASE >= 3000 ? DUP_PHASE - 3000 : 0)>(P, lds, blockIdx.x, 420 * MiB); } \
        if ((k) == 6 && DUP_PHASE >= 4000 && DUP_PHASE < 4032) { xcd_barrier(bar); rglru_item<(DUP_PHASE >= 4000 ? DUP_PHASE - 4000 : 0)>(P, lds, blockIdx.x, 420 * MiB); } \
        if ((k) == 5 && DUP_PHASE == 50) { xcd_barrier(bar); for (int it_ = blockIdx.x; it_ < BATCH * N_BLK_C * 4; it_ += G) rglru_item<0>(P, lds, it_); } \
        if ((k) == 5 && DUP_PHASE == 51) { xcd_barrier(bar); phase_mix1a(P, lds, G); } \
        } SEAM(k); } while (0)
    STEP(0); STEP(1); STEP(2); STEP(3); STEP(4); STEP(5); STEP(6); STEP(7);
#undef STEP
#undef RUN
#undef IN
#undef SEAM
}
extern "C" void kernel_launch(void* const* d_in, const int* in_sizes, int n_in, void* d_out, int out_size, void* d_ws, size_t ws_size, hipStream_t stream) {
    static int grid = 0;
    if (grid == 0) {
        if (n_in != 20 || in_sizes[0] != M_TOK * D_MODEL || out_size != M_TOK * D_MODEL || ws_size < WS_END) {
            fprintf(stderr, "kernel_launch: unexpected shapes: n_in %d in0 %d out %d ws %zu (need %zu)\n", n_in, n_in > 0 ? in_sizes[0] : -1, out_size, ws_size, (size_t)WS_END); grid = -1; return; }
        int dev = 0, cus = 0, per_cu = 0;
        if (hipGetDevice(&dev) != hipSuccess || hipDeviceGetAttribute(&cus, hipDeviceAttributeMultiprocessorCount, dev) != hipSuccess) { grid = -1; return; }
        if (hipFuncSetAttribute((const void*)fwd_mega, hipFuncAttributeMaxDynamicSharedMemorySize, LDS_BYTES) != hipSuccess) { fprintf(stderr, "kernel_launch: hipFuncSetAttribute failed\n"); grid = -1; return; }
        if (hipOccupancyMaxActiveBlocksPerMultiprocessor(&per_cu, (const void*)fwd_mega, NWAVES * 64, LDS_BYTES) != hipSuccess || per_cu < 1) { fprintf(stderr, "kernel_launch: occupancy query says %d blocks per CU\n", per_cu); per_cu = 1; }
        (void)hipGetLastError();
        grid = cus;
    }
    if (grid < 0) return;
    if (hipMemsetAsync((char*)d_ws + WS_CTL, 0, CTL_ZERO_BYTES, stream) != hipSuccess) { fprintf(stderr, "kernel_launch: memset failed\n"); return; }
    Args a{};
    for (int i = 0; i < 20; ++i) a.P.in[i] = (const float*)d_in[i];
    a.P.out = (float*)d_out; a.P.ws = (unsigned char*)d_ws; a.ph_lo = 0; a.ph_hi = N_PHASES;
    hipLaunchKernelGGL(fwd_mega, dim3(grid), dim3(NWAVES * 64), LDS_BYTES, stream, a);
    const hipError_t le = hipPeekAtLastError();
    if (le != hipSuccess) fprintf(stderr, "kernel_launch: launch failed: %s\n", hipGetErrorName(le));
}
```

```cpp
#include <hip/hip_runtime.h>
#include <cstdio>
#include <cstdint>
#include <cmath>
#include <type_traits>

constexpr int D_MODEL = 2048, BATCH = 8, SEQ = 2048, M_TOK = BATCH * SEQ;
constexpr int CHUNK = 64, NCH = SEQ / CHUNK;
constexpr float EPS = 1e-6f;
constexpr int HD_A = 128, W_A = 1024, H_A = 8, LOOKBACK = 8, BAND = (LOOKBACK + 1) * CHUNK, REL_MAX = 256, NREL = 2 * REL_MAX + 1;
constexpr int H_B = 4, W_B = 1024, HD_B = 256;
constexpr int W_C = 1024, N_BLK_C = 8, BLK_C = 128;
constexpr int HD_D = 128, W_D = 1024, H_D = 8;
constexpr int EV_IN = 9224, EV_N = 9216;
constexpr int OD_IN = 6160, OD_N = 6144;
constexpr int EC_QA = 0, EC_KA = 1024, EC_VA = 2048, EC_ZA = 3072, EC_QB = 4096, EC_KB = 5120, EC_VB = 6144, EC_OB = 7168, EC_ZB = 8192;
constexpr int OC_XC = 0, OC_ZC = 1024, OC_QD = 2048, OC_KD = 3072, OC_VD = 4096, OC_ZD = 5120;

constexpr size_t MiB = 1u << 20;
constexpr size_t WS_CTL = 0, CTL_ZERO_BYTES = 1 * MiB;
constexpr size_t WS_R0 = 1 * MiB;
constexpr size_t WS_SS1 = WS_R0 + 64 * 1024;
constexpr size_t WS_GIF = WS_SS1 + 64 * 1024;
constexpr size_t WS_AB = WS_GIF + 512 * 1024;
constexpr size_t WS_W1T = 4 * MiB;
constexpr size_t WS_W2T = 40 * MiB;
constexpr size_t WS_W3T = 48 * MiB;
constexpr size_t WS_W4T = 73 * MiB;
constexpr size_t WS_XB = 81 * MiB;
constexpr size_t WS_Y = 145 * MiB;
constexpr size_t WS_PROJ = 209 * MiB;
constexpr size_t WS_END = 497 * MiB;
constexpr size_t WS_FREE1 = 401 * MiB;

typedef unsigned short bf16_t;
__device__ __forceinline__ float bf2f(unsigned short v) { return __builtin_bit_cast(float, (unsigned)v << 16); }
__device__ __forceinline__ unsigned f2bf(float f) { unsigned u = __builtin_bit_cast(unsigned, f); return (u + 0x7fffu + ((u >> 16) & 1u)) >> 16; }
typedef float f32x2_t_ __attribute__((ext_vector_type(2))); typedef __bf16 bf16x2_t_ __attribute__((ext_vector_type(2)));
__device__ __forceinline__ unsigned pk2(float lo, float hi) { const f32x2_t_ v = {lo, hi}; return __builtin_bit_cast(unsigned, __builtin_convertvector(v, bf16x2_t_)); }
__device__ __forceinline__ float sigmoidf_(float x) { return 1.f / (1.f + expf(-x)); }
__device__ __forceinline__ float siluf_(float x) { return x / (1.f + expf(-x)); }
__device__ __forceinline__ float softplusf_(float x) { return fmaxf(x, 0.f) + log1pf(expf(-fabsf(x))); }
__device__ __forceinline__ float logsigmoidf_(float x) { return -softplusf_(-x); }

namespace pg8 {
#define PG8_LAS __attribute__((address_space(3)))
typedef unsigned short bf16_t;
typedef short bf16x8 __attribute__((ext_vector_type(8)));
typedef float f32x4 __attribute__((ext_vector_type(4)));
typedef unsigned u32x4 __attribute__((ext_vector_type(4)));
constexpr int BM = 256, BK = 64, HALF = 128, HTB = HALF * BK * 2  , STAGE_BYTES = 8 * HTB, NXCD = 8, WGM = 4;

__host__ __device__ __forceinline__ int lds_byte(int r, int c) { const int st = (r >> 4) * 2 + (c >> 5), rr = r & 15, cc = c & 31, ob = rr * 64 + cc * 2; return st * 1024 + (ob ^ (((ob >> 9) & 1) << 5)); }
__host__ __device__ __forceinline__ void stage_rc(int b, int& R, int& C) { const int st = b / 1024, sb = b % 1024, swz = sb ^ (((sb >> 9) & 1) << 5); R = (st >> 1) * 16 + swz / 64; C = (st & 1) * 32 + (swz % 64) / 2; }
__host__ __device__ __forceinline__ int perm32(int rho) { const int n = rho >> 4, i = rho & 15; return 8 * (i >> 2) + 4 * n + (i & 3); }

struct Unit { int pm, pn; };
struct Gemm { const bf16_t* A; const bf16_t* Bt; int M, N, K; };

struct StaticOrder {
    int nM, nN, nwg, G, c;
    __host__ __device__ void init(int M, int N, int G_, int c_) { nM = M / BM; nN = N / BM; nwg = nM * nN; G = G_; c = c_; }
    __host__ __device__ bool next(int i, Unit& u) const {
        const long L = (long)i * G + c; if (L >= nwg) return false;
        int wgid = (int)L; { const int q = nwg / NXCD, r = nwg % NXCD, xcd = wgid % NXCD, off = wgid / NXCD; wgid = (xcd < r ? xcd * (q + 1) : r * (q + 1) + (xcd - r) * q) + off; }
        const int nig = WGM * nN, gid = wgid / nig, fm = gid * WGM, gsz = (nM - fm) < WGM ? (nM - fm) : WGM;
        u.pm = fm + ((wgid % nig) % gsz); u.pn = (wgid % nig) / gsz; return true;
    }
    __device__ __forceinline__ void a_ready(const Unit&) const {}
    __device__ __forceinline__ void done(const Unit&) const {}
};

__device__ __forceinline__ unsigned cvt_pk_bf16(float lo, float hi) { unsigned r; asm volatile("v_cvt_pk_bf16_f32 %0, %1, %2" : "=v"(r) : "v"(lo), "v"(hi)); return r; }
struct EpiProj {
    static constexpr bool PERM = true, AFTER_DRAIN = false;
    bf16_t* O; int ldc; const float* rowv; int mode;
    __device__ __forceinline__ void operator()(const f32x4 (&acc)[2][2][4][2], const Unit& u, int wr, int wc, int fr, int fq) const {
        const int row0 = u.pm * BM + wr * 64 + fr; const int col0 = u.pn * BM + wc * 32 + 8 * fq;
#pragma unroll
        for (int ai = 0; ai < 2; ++ai)
#pragma unroll
            for (int m = 0; m < 4; ++m) { const int row = row0 + ai * HALF + m * 16; float sc = rowv[row]; if (mode) sc = 1.0f / sqrtf(sc * (1.0f / 2048.0f) + 1e-6f);
                bf16_t* rowp = O + (size_t)row * ldc + col0;
#pragma unroll
                for (int bj = 0; bj < 2; ++bj) { const f32x4 v0 = acc[ai][bj][m][0] * sc, v1 = acc[ai][bj][m][1] * sc;
                    u32x4 w; w.x = cvt_pk_bf16(v0[0], v0[1]); w.y = cvt_pk_bf16(v0[2], v0[3]); w.z = cvt_pk_bf16(v1[0], v1[1]); w.w = cvt_pk_bf16(v1[2], v1[3]);
                    *(u32x4*)(rowp + bj * HALF) = w; } }
    }
};
struct EpiRes {
    static constexpr bool PERM = false, AFTER_DRAIN = false;
    const float* base; const bf16_t* base16; float* out; bf16_t* xb; float* sumsq; int ldc;
    __device__ __forceinline__ void operator()(const f32x4 (&acc)[2][2][4][2], const Unit& u, int wr, int wc, int fr, int fq) const {
        typedef unsigned u32x2v __attribute__((ext_vector_type(2)));
        const int col0 = u.pn * BM + wc * 32 + 4 * fq;
#pragma unroll
        for (int ai = 0; ai < 2; ++ai)
#pragma unroll
            for (int m = 0; m < 4; ++m) { const int row = u.pm * BM + ai * HALF + wr * 64 + m * 16 + fr; const size_t off = (size_t)row * ldc + col0; float ss = 0.f;
#pragma unroll
                for (int bj = 0; bj < 2; ++bj)
#pragma unroll
                    for (int n = 0; n < 2; ++n) { f32x4 bs;
                        if (base16) { const u32x2v w_ = *(const u32x2v*)(base16 + off + bj * HALF + n * 16); bs = (f32x4){__builtin_bit_cast(float, w_.x << 16), __builtin_bit_cast(float, w_.x & 0xffff0000u), __builtin_bit_cast(float, w_.y << 16), __builtin_bit_cast(float, w_.y & 0xffff0000u)}; }
                        else bs = *(const f32x4*)(base + off + bj * HALF + n * 16);
                        const f32x4 o = bs + acc[ai][bj][m][n];
                        if (out) *(f32x4*)(out + off + bj * HALF + n * 16) = o;
                        if (xb) { u32x2v w; w.x = cvt_pk_bf16(o[0], o[1]); w.y = cvt_pk_bf16(o[2], o[3]); *(u32x2v*)(xb + off + bj * HALF + n * 16) = w; }
                        ss += (o[0] * o[0] + o[1] * o[1]) + (o[2] * o[2] + o[3] * o[3]); }
                if (sumsq) { ss += __shfl_xor(ss, 16); ss += __shfl_xor(ss, 32); if (fq == 0) atomicAdd(sumsq + row, ss); } }
    }
};

template <class Epi, class Sched, bool ALIGN_EPI = false, bool SP2 = false>
__device__ __forceinline__ void gemm_phase(PG8_LAS unsigned char* lds, const Gemm g, const Sched& S, const Epi& E) {
    const int tid = threadIdx.x, wid = __builtin_amdgcn_readfirstlane(tid >> 6), lane = tid & 63, wr = wid >> 2, wc = wid & 3, fr = lane & 15, fq = lane >> 4;
    const int K = g.K, nt = K / BK;
    unsigned voffA[2], voffB[2];
#pragma unroll
    for (int i = 0; i < 2; ++i) { int R, C; stage_rc(tid * 16 + i * 8192, R, C); const int Rb = Epi::PERM ? ((R & ~31) + perm32(R & 31)) : R;
        voffA[i] = (unsigned)(R * K + C) * 2u; voffB[i] = (unsigned)(Rb * K + C) * 2u; }
    const size_t kstep = (size_t)(BK * 2);
    const size_t hstep = (size_t)HALF * K * 2;
    const size_t tstep = 2 * hstep;
    const unsigned ldsw = (unsigned)wid * 1024u;
    const int aoff = lds_byte(wr * 64 + fr, fq * 8), boff = lds_byte(wc * 32 + fr, fq * 8);
#define PG8_SA(b, h) (((b) * 2 + (h)) * HTB)
#define PG8_SB(b, h) ((4 + (b) * 2 + (h)) * HTB)
#define PG8_STAGE(bufoff, gbase, voff) do { _Pragma("unroll") for (int _i = 0; _i < 2; ++_i) \
        __builtin_amdgcn_global_load_lds((const unsigned*)((const char*)(gbase) + (voff)[_i]), (PG8_LAS unsigned*)(lds + (bufoff) + ldsw + _i * 8192), 16, 0, 0); } while (0)
#define PG8_LDA(dst, b, h) do { _Pragma("unroll") for (int m = 0; m < 4; ++m) _Pragma("unroll") for (int k = 0; k < 2; ++k) dst[m][k] = *(const PG8_LAS bf16x8*)(lds + PG8_SA(b, h) + aoff + m * 2048 + k * 1024); } while (0)
#define PG8_LDB(dst, b, h) do { _Pragma("unroll") for (int n = 0; n < 2; ++n) _Pragma("unroll") for (int k = 0; k < 2; ++k) dst[n][k] = *(const PG8_LAS bf16x8*)(lds + PG8_SB(b, h) + boff + n * 2048 + k * 1024); } while (0)
#define PG8_MMA(ai, bj, At, Bt) do { __builtin_amdgcn_s_setprio(1); _Pragma("unroll") for (int m = 0; m < 4; ++m) _Pragma("unroll") for (int n = 0; n < 2; ++n) _Pragma("unroll") for (int k = 0; k < 2; ++k) \
        acc[ai][bj][m][n] = __builtin_amdgcn_mfma_f32_16x16x32_bf16(Bt[n][k], At[m][k], acc[ai][bj][m][n], 0, 0, 0); __builtin_amdgcn_s_setprio(0); } while (0)
#define PG8_WAIT_V(n) asm volatile("s_waitcnt vmcnt(" #n ")" ::: "memory")
#define PG8_WAIT_L(n) asm volatile("s_waitcnt lgkmcnt(" #n ")" ::: "memory")
#define PG8_BAR __builtin_amdgcn_s_barrier()
#define PG8_SCHED __builtin_amdgcn_sched_barrier(0)
    Unit cur, nxt; int ui = 0;
    if (!S.next(0, cur)) return;
    f32x4 acc[2][2][4][2];
#pragma unroll
    for (int a = 0; a < 2; ++a)
#pragma unroll
        for (int b = 0; b < 2; ++b)
#pragma unroll
            for (int m = 0; m < 4; ++m)
#pragma unroll
                for (int n = 0; n < 2; ++n) acc[a][b][m][n] = (f32x4){0.f, 0.f, 0.f, 0.f};
    bf16x8 At[4][2], B0[2][2], B1[2][2];
    const char* cA = (const char*)g.A + (size_t)cur.pm * tstep; const char* cB = (const char*)g.Bt + (size_t)cur.pn * tstep;
    S.a_ready(cur);
    if constexpr (SP2) {
        PG8_STAGE(PG8_SB(0, 0), cB, voffB); PG8_STAGE(PG8_SB(0, 1), cB + hstep, voffB); PG8_STAGE(PG8_SA(0, 0), cA, voffA); PG8_STAGE(PG8_SA(0, 1), cA + hstep, voffA);
        if (wr == 1) PG8_BAR;
        PG8_WAIT_V(2); PG8_BAR;
        PG8_STAGE(PG8_SB(1, 0), cB + kstep, voffB); PG8_STAGE(PG8_SA(1, 0), cA + kstep, voffA); PG8_STAGE(PG8_SB(1, 1), cB + hstep + kstep, voffB);
        PG8_WAIT_V(6); PG8_BAR;
    } else {
        PG8_STAGE(PG8_SB(0, 0), cB, voffB); PG8_STAGE(PG8_SA(0, 0), cA, voffA); PG8_STAGE(PG8_SB(0, 1), cB + hstep, voffB); PG8_STAGE(PG8_SA(0, 1), cA + hstep, voffA);
        if (wr == 1) PG8_BAR;
        PG8_WAIT_V(4); PG8_BAR;
        PG8_STAGE(PG8_SB(1, 0), cB + kstep, voffB); PG8_STAGE(PG8_SA(1, 0), cA + kstep, voffA); PG8_STAGE(PG8_SB(1, 1), cB + hstep + kstep, voffB);
        PG8_WAIT_V(6); PG8_BAR;
    }
    for (;;) {
        const bool has_next = S.next(ui + 1, nxt);
        const char* nA = has_next ? (const char*)g.A + (size_t)nxt.pm * tstep : cA; const char* nB = has_next ? (const char*)g.Bt + (size_t)nxt.pn * tstep : cB;
        for (int t = 0; t < nt; t += 2) {
            const bool last = (t == nt - 2);
            const char* a1 = cA + (size_t)(t + 1) * kstep;
            const char* a2 = last ? nA : cA + (size_t)(t + 2) * kstep; const char* b2 = last ? nB : cB + (size_t)(t + 2) * kstep;
            const char* a3 = a2 + kstep; const char* b3 = b2 + kstep;
            if (last && has_next) S.a_ready(nxt);
            if constexpr (SP2) {
            PG8_LDB(B0, 0, 0); PG8_LDB(B1, 0, 1); PG8_SCHED; PG8_LDA(At, 0, 0); PG8_STAGE(PG8_SA(1, 1), a1 + hstep, voffA);
            PG8_WAIT_V(8); PG8_WAIT_L(0); PG8_BAR; PG8_MMA(0, 0, At, B0); PG8_MMA(0, 1, At, B1); PG8_BAR; PG8_SCHED;
            PG8_LDA(At, 0, 1); PG8_STAGE(PG8_SB(0, 0), b2, voffB); PG8_STAGE(PG8_SB(0, 1), b2 + hstep, voffB); PG8_STAGE(PG8_SA(0, 0), a2, voffA);
            PG8_WAIT_V(8); PG8_WAIT_L(0); PG8_BAR; PG8_MMA(1, 0, At, B0); PG8_MMA(1, 1, At, B1); PG8_BAR; PG8_SCHED;
            PG8_LDB(B0, 1, 0); PG8_LDB(B1, 1, 1); PG8_SCHED; PG8_LDA(At, 1, 0); PG8_STAGE(PG8_SA(0, 1), a2 + hstep, voffA);
            PG8_WAIT_V(8); PG8_WAIT_L(0); PG8_BAR; PG8_MMA(0, 0, At, B0); PG8_MMA(0, 1, At, B1); PG8_BAR; PG8_SCHED;
            PG8_LDA(At, 1, 1); PG8_STAGE(PG8_SB(1, 0), b3, voffB); PG8_STAGE(PG8_SB(1, 1), b3 + hstep, voffB); PG8_STAGE(PG8_SA(1, 0), a3, voffA);
            PG8_WAIT_V(8); PG8_WAIT_L(0); PG8_BAR; PG8_MMA(1, 0, At, B0); PG8_MMA(1, 1, At, B1); PG8_BAR; PG8_SCHED;
            } else {
            PG8_LDB(B0, 0, 0); PG8_SCHED; PG8_LDA(At, 0, 0); PG8_STAGE(PG8_SA(1, 1), a1 + hstep, voffA);
            PG8_WAIT_L(8); PG8_BAR; PG8_WAIT_L(0); PG8_MMA(0, 0, At, B0); PG8_BAR; PG8_SCHED;
            PG8_LDB(B1, 0, 1); PG8_STAGE(PG8_SB(0, 0), b2, voffB);
            PG8_BAR; PG8_WAIT_L(0); PG8_MMA(0, 1, At, B1); PG8_BAR;
            PG8_LDA(At, 0, 1); PG8_STAGE(PG8_SA(0, 0), a2, voffA);
            PG8_BAR; PG8_WAIT_L(0); PG8_MMA(1, 0, At, B0); PG8_BAR; PG8_SCHED;
            PG8_STAGE(PG8_SB(0, 1), b2 + hstep, voffB);
            PG8_WAIT_V(6); PG8_BAR; PG8_MMA(1, 1, At, B1); PG8_BAR;
            PG8_LDB(B0, 1, 0); PG8_SCHED; PG8_LDA(At, 1, 0); PG8_STAGE(PG8_SA(0, 1), a2 + hstep, voffA);
            PG8_WAIT_L(8); PG8_BAR; PG8_WAIT_L(0); PG8_MMA(0, 0, At, B0); PG8_BAR; PG8_SCHED;
            PG8_LDB(B1, 1, 1); PG8_STAGE(PG8_SB(1, 0), b3, voffB);
            PG8_BAR; PG8_WAIT_L(0); PG8_MMA(0, 1, At, B1); PG8_BAR;
            PG8_LDA(At, 1, 1); PG8_STAGE(PG8_SA(1, 0), a3, voffA);
            PG8_BAR; PG8_WAIT_L(0); PG8_MMA(1, 0, At, B0); PG8_BAR; PG8_SCHED;
            PG8_STAGE(PG8_SB(1, 1), b3 + hstep, voffB);
            PG8_WAIT_V(6); PG8_BAR; PG8_MMA(1, 1, At, B1); PG8_BAR;
            }
        }
        if constexpr (ALIGN_EPI) { if (wr == 0) PG8_BAR; }
        if constexpr (!Epi::AFTER_DRAIN) { E(acc, cur, wr, wc, fr, fq); S.done(cur); }
        if (!has_next) break;
#pragma unroll
        for (int a = 0; a < 2; ++a)
#pragma unroll
            for (int b = 0; b < 2; ++b)
#pragma unroll
                for (int m = 0; m < 4; ++m)
#pragma unroll
                    for (int n = 0; n < 2; ++n) acc[a][b][m][n] = (f32x4){0.f, 0.f, 0.f, 0.f};
        cur = nxt; cA = nA; cB = nB; ++ui;
        if constexpr (ALIGN_EPI) { if (wr == 1) PG8_BAR; }
    }
    PG8_WAIT_V(0);
    if constexpr (!ALIGN_EPI) { if (wr == 0) PG8_BAR; }
    PG8_BAR;
    if constexpr (Epi::AFTER_DRAIN) { E.fused(acc, cur, wr, wc, fr, fq, lds, wid, lane); S.done(cur); }
#undef PG8_SA
#undef PG8_SB
#undef PG8_STAGE
#undef PG8_LDA
#undef PG8_LDB
#undef PG8_MMA
#undef PG8_WAIT_V
#undef PG8_WAIT_L
#undef PG8_BAR
#undef PG8_SCHED
}
}
#define GAS __attribute__((address_space(1)))
#define LAS __attribute__((address_space(3)))
typedef unsigned v4u __attribute__((ext_vector_type(4)));
typedef float f32x4 __attribute__((ext_vector_type(4)));
#define LDS_WAIT() asm volatile("s_waitcnt lgkmcnt(0)" ::: "memory")
constexpr int NWAVES = 8;
constexpr int GEMM_LDS = 131072;

struct Ptrs {
    const float* in[20]; float* out; unsigned char* ws;
};
#define IN_X 0
#define IN_EV_NORM 1
#define IN_EV_WIN 2
#define IN_EV_IFB 3
#define IN_EV_QNG 4
#define IN_EV_KNG 5
#define IN_EV_REL 6
#define IN_EV_WOUT 7
#define IN_OD_NORM 8
#define IN_OD_WIN 9
#define IN_OD_CCW 10
#define IN_OD_CCB 11
#define IN_OD_GW 12
#define IN_OD_GB 13
#define IN_OD_LAM 14
#define IN_OD_CDW 15
#define IN_OD_ALOG 16
#define IN_OD_DTB 17
#define IN_OD_ONORM 18
#define IN_OD_WOUT 19

__device__ __forceinline__ float frsq_(float x) { return __builtin_amdgcn_rsqf(x); }
__device__ __forceinline__ float wave_sum(float v) {
#pragma unroll
    for (int o = 1; o < 64; o <<= 1) v += __shfl_xor(v, o);
    return v;
}
struct TrItem { const float* W; const float* gain; bf16_t* WT; int ldw, nblk, item; };
__device__ __forceinline__ void p0_tr_load(const TrItem& t, float (&r)[32], int lane) {
    const int kb = t.item / t.nblk, nb = t.item % t.nblk, k0 = 64 * kb, n0 = 32 * nb;
#pragma unroll
    for (int i = 0; i < 32; ++i) { const int kk = 2 * i + (lane >> 5); r[i] = t.W[(size_t)(k0 + kk) * t.ldw + n0 + (lane & 31)]; }
}
__device__ __forceinline__ void p0_tr_store(const TrItem& t, const float (&r)[32], LAS float* scr, int lane) {
    const int kb = t.item / t.nblk, nb = t.item % t.nblk, k0 = 64 * kb, n0 = 32 * nb; constexpr int K = D_MODEL;
#pragma unroll
    for (int i = 0; i < 32; ++i) { const int kk = 2 * i + (lane >> 5); const float g = t.gain ? t.gain[k0 + kk] : 1.0f; scr[kk * 33 + (lane & 31)] = g * r[i]; }
    LDS_WAIT(); asm volatile("" ::: "memory");
    const int c = lane & 7;
#pragma unroll
    for (int j = 0; j < 4; ++j) { const int n = (lane >> 3) + 8 * j; const LAS float* s = scr + (8 * c) * 33 + n;
        v4u o; o.x = pk2(s[0 * 33], s[1 * 33]); o.y = pk2(s[2 * 33], s[3 * 33]); o.z = pk2(s[4 * 33], s[5 * 33]); o.w = pk2(s[6 * 33], s[7 * 33]);
        *(GAS v4u*)(t.WT + (size_t)(n0 + n) * K + k0 + 8 * c) = o; }
    LDS_WAIT(); asm volatile("" ::: "memory");
}
__device__ __forceinline__ void p0_transposes(const Ptrs& P, LAS float* scr, int lane, int gw, int NGW, int it0, int it1) {
    unsigned char* ws = P.ws;
    bf16_t* W1T = (bf16_t*)(ws + WS_W1T); bf16_t* W2T = (bf16_t*)(ws + WS_W2T); bf16_t* W3T = (bf16_t*)(ws + WS_W3T); bf16_t* W4T = (bf16_t*)(ws + WS_W4T);
    constexpr int I1 = (D_MODEL / 64) * (EV_N / 32), I2 = (D_MODEL / 64) * (D_MODEL / 32), I3 = (D_MODEL / 64) * (OD_N / 32);
    auto mk = [&](int it) { TrItem t; int r = it;
        if (r < I1) { t = TrItem{P.in[IN_EV_WIN], P.in[IN_EV_NORM], W1T, EV_IN, EV_N / 32, r}; return t; } r -= I1;
        if (r < I2) { t = TrItem{P.in[IN_EV_WOUT], nullptr, W2T, D_MODEL, D_MODEL / 32, r}; return t; } r -= I2;
        if (r < I3) { t = TrItem{P.in[IN_OD_WIN], P.in[IN_OD_NORM], W3T, OD_IN, OD_N / 32, r}; return t; } r -= I3;
        t = TrItem{P.in[IN_OD_WOUT], nullptr, W4T, D_MODEL, D_MODEL / 32, r}; return t; };
    float ra[32], rb[32]; int it = it0 + gw;
    if (it < it1) { TrItem ta = mk(it); p0_tr_load(ta, ra, lane);
        for (;;) { const int itb = it + NGW; TrItem tb = ta; const bool hb = itb < it1; if (hb) { tb = mk(itb); p0_tr_load(tb, rb, lane); }
            p0_tr_store(ta, ra, scr, lane); if (!hb) break;
            const int itc = itb + NGW; const bool hc = itc < it1; if (hc) { ta = mk(itc); p0_tr_load(ta, ra, lane); }
            p0_tr_store(tb, rb, scr, lane); if (!hc) break; it = itc; } }
}
constexpr int TR_I1 = (D_MODEL / 64) * (EV_N / 32), TR_ALL = TR_I1 + 2 * (D_MODEL / 64) * (D_MODEL / 32) + (D_MODEL / 64) * (OD_N / 32), TR_I4 = TR_ALL - (D_MODEL / 64) * (D_MODEL / 32);
__device__ __forceinline__ void late_weights(const Ptrs& P, LAS unsigned char* lds, int wave, int lane, int gw, int NGW) {
    p0_transposes(P, (LAS float*)(lds + wave * 16384), lane, gw, NGW, TR_I1, TR_I4);
    bf16_t* W3T = (bf16_t*)(P.ws + WS_W3T); const int gt = gw * 64 + lane, NT = NGW * 64;
    for (int e = gt; e < 16 * D_MODEL; e += NT) { const int j = e / D_MODEL, k = e % D_MODEL; W3T[(size_t)(OD_N + j) * D_MODEL + k] = (bf16_t)f2bf(P.in[IN_OD_NORM][k] * P.in[IN_OD_WIN][(size_t)k * OD_IN + OD_N + j]); }
}
__device__ __forceinline__ void last_weight(const Ptrs& P, LAS unsigned char* lds, int wave, int lane, int gw, int NGW) { p0_transposes(P, (LAS float*)(lds + wave * 16384), lane, gw, NGW, TR_I4, TR_ALL); }
template <int PART = 3> __device__ __forceinline__ void phase_prologue(const Ptrs& P, LAS unsigned char* lds, int wave, int lane, int gw, int NGW) {
    unsigned char* ws = P.ws;
    bf16_t* W1T = (bf16_t*)(ws + WS_W1T); bf16_t* W2T = (bf16_t*)(ws + WS_W2T); bf16_t* W3T = (bf16_t*)(ws + WS_W3T); bf16_t* W4T = (bf16_t*)(ws + WS_W4T);
    bf16_t* XB = (bf16_t*)(ws + WS_XB); float* R0 = (float*)(ws + WS_R0); float* SS1 = (float*)(ws + WS_SS1); float* GIF = (float*)(ws + WS_GIF);
    LAS float* scr = (LAS float*)(lds + wave * 16384);
    if constexpr (PART & 1) p0_transposes(P, scr, lane, gw, NGW, 0, TR_I1);
    if constexpr (!(PART & 2)) return;
    { const int gt = gw * 64 + lane, NT = NGW * 64;
      for (int e = gt; e < M_TOK; e += NT) SS1[e] = 0.f; }
    __syncthreads();
    LAS float* G8 = (LAS float*)lds;
#pragma unroll 8
    for (int e = threadIdx.x; e < D_MODEL * 8; e += NWAVES * 64) { const int k = e >> 3, j = e & 7; G8[j * D_MODEL + k] = P.in[IN_EV_NORM][k] * P.in[IN_EV_WIN][(size_t)k * EV_IN + EV_N + j]; }
    __syncthreads();
    const float* X = P.in[IN_X];
    f32x4 vnx[8];
    if (gw < M_TOK) { const GAS f32x4* xr0 = (const GAS f32x4*)(X + (size_t)gw * D_MODEL) + lane;
#pragma unroll
        for (int j = 0; j < 8; ++j) vnx[j] = xr0[64 * j]; }
    for (int m = gw; m < M_TOK; m += NGW) {
        float s = 0.f;
        GAS unsigned long long* o8 = (GAS unsigned long long*)(XB + (size_t)m * D_MODEL) + lane;
        f32x4 v[8];
#pragma unroll
        for (int j = 0; j < 8; ++j) v[j] = vnx[j];
        if (m + NGW < M_TOK) { const GAS f32x4* xr1 = (const GAS f32x4*)(X + (size_t)(m + NGW) * D_MODEL) + lane;
#pragma unroll
            for (int j = 0; j < 8; ++j) vnx[j] = xr1[64 * j]; }
#pragma unroll
        for (int j = 0; j < 8; ++j) { s += (v[j].x * v[j].x + v[j].y * v[j].y) + (v[j].z * v[j].z + v[j].w * v[j].w);
            o8[64 * j] = (unsigned long long)pk2(v[j].x, v[j].y) | ((unsigned long long)pk2(v[j].z, v[j].w) << 32); }
        const float r0 = frsq_(wave_sum(s) * (1.0f / D_MODEL) + EPS);
        float g[8];
#pragma unroll
        for (int i = 0; i < 8; ++i) g[i] = 0.f;
#pragma unroll
        for (int j = 0; j < 8; ++j) {
#pragma unroll
            for (int i = 0; i < 8; ++i) { const f32x4 gv = *(const LAS f32x4*)(G8 + i * D_MODEL + 4 * lane + 256 * j); g[i] += (v[j][0] * gv[0] + v[j][1] * gv[1]) + (v[j][2] * gv[2] + v[j][3] * gv[3]); }
            asm volatile("" : "+v"(g[0]), "+v"(g[1]), "+v"(g[2]), "+v"(g[3]), "+v"(g[4]), "+v"(g[5]), "+v"(g[6]), "+v"(g[7]) :: "memory");
        }
#pragma unroll
        for (int i = 0; i < 8; ++i) g[i] = wave_sum(g[i]);
        if (lane == 0) R0[m] = r0;
        if (lane < 8) { float gv = g[0];
#pragma unroll
            for (int i = 1; i < 8; ++i) gv = (lane == i) ? g[i] : gv;
            GIF[(size_t)m * 8 + lane] = r0 * gv + P.in[IN_EV_IFB][lane]; }
    }
}

#define XB_TMO      128
#define XB_XCNT(j)  (256  + 64 * (j))
#define XB_XSUB(j)  (1280 + 64 * (j))
#define XB_XGEN(j)  (2304 + 64 * (j))
#define XB_TOP      3328
#define XB_TOPGEN   3392
#define XCD_BAR_WORDS 3456
#define XB_SPIN_CAP (1u << 18)

__device__ __forceinline__ unsigned xb_ld(unsigned* p)              { return __hip_atomic_load(p, __ATOMIC_RELAXED, __HIP_MEMORY_SCOPE_AGENT); }
__device__ __forceinline__ unsigned xb_add(unsigned* p, unsigned v) { return __hip_atomic_fetch_add(p, v, __ATOMIC_RELAXED, __HIP_MEMORY_SCOPE_AGENT); }
__device__ __forceinline__ unsigned xb_xcc_id() { return (unsigned)__builtin_amdgcn_s_getreg((3 << 11) | 20) & 0xFu; }
#define XB_SPIN(cond, bar) do { unsigned _sp = 0; while (cond) { __builtin_amdgcn_s_sleep(1); \
    if ((++_sp & 255u) == 0u) { if (xb_ld(&(bar)[XB_TMO])) break; if (_sp > XB_SPIN_CAP) { atomicAdd(&(bar)[XB_TMO], 1u); break; } } } } while (0)

struct XcdBarrier {
    unsigned* bar; unsigned x;
    volatile LAS unsigned* st;
};

__device__ __forceinline__ XcdBarrier xcd_barrier_post(unsigned* bar, volatile LAS unsigned* st) {
    XcdBarrier b; b.bar = bar; b.x = xb_xcc_id(); b.st = st;
    if (threadIdx.x == 0) (void)xb_add(&bar[XB_XCNT(b.x)], 1u);
    return b;
}
__device__ __forceinline__ void xcd_barrier_complete(unsigned* bar, unsigned x, unsigned& nloc, unsigned& nx) {
    const unsigned G = gridDim.x * gridDim.y * gridDim.z;
    unsigned sum, cnt, mine, sp = 0u;
    for (;;) {
        sum = 0u; cnt = 0u; mine = 0u;
#pragma unroll
        for (unsigned j = 0; j < 16; ++j) { const unsigned c = xb_ld(&bar[XB_XCNT(j)]); sum += c; cnt += (c > 0u) ? 1u : 0u; mine = (j == x) ? c : mine; }
        if (sum == G) break;
        __builtin_amdgcn_s_sleep(1);
        if ((++sp & 255u) == 0u) { if (xb_ld(&bar[XB_TMO])) break; if (sp > XB_SPIN_CAP) { atomicAdd(&bar[XB_TMO], 1u); break; } }
    }
    nloc = mine > 0u ? mine : 1u; nx = cnt > 0u ? cnt : 1u;
}

__device__ __forceinline__ void xcd_barrier(const XcdBarrier& b) {
    asm volatile("s_waitcnt vmcnt(0)" ::: "memory");
    __syncthreads();
    if (threadIdx.x == 0) {
        unsigned* bar = b.bar;
        __builtin_amdgcn_s_waitcnt(0);
        unsigned nloc = b.st[0], nx = b.st[1];
        if (nloc == 0u) { xcd_barrier_complete(bar, b.x, nloc, nx); b.st[0] = nloc; b.st[1] = nx; }
        const unsigned old = xb_add(&bar[XB_XSUB(b.x)], 1u);
        const unsigned gen = old / nloc;
        if (old + 1u == (gen + 1u) * nloc) {
            __builtin_amdgcn_fence(__ATOMIC_RELEASE, "agent");
            asm volatile("s_waitcnt vmcnt(0)" ::: "memory");
            const unsigned og = xb_add(&bar[XB_TOP], 1u);
            const unsigned tg = og / nx;
            if (og + 1u == (tg + 1u) * nx) xb_add(&bar[XB_TOPGEN], 1u);
            else XB_SPIN(xb_ld(&bar[XB_TOPGEN]) == tg, bar);
            __builtin_amdgcn_fence(__ATOMIC_ACQUIRE, "agent");
            xb_add(&bar[XB_XGEN(b.x)], 1u);
            asm volatile("s_waitcnt vmcnt(0)" ::: "memory");
        } else {
            XB_SPIN(xb_ld(&bar[XB_XGEN(b.x)]) == gen, bar);
            __builtin_amdgcn_fence(__ATOMIC_ACQUIRE, "agent");
            asm volatile("s_waitcnt vmcnt(0)" ::: "memory");
        }
    }
    __syncthreads();
}
__device__ __forceinline__ void ld8bf(const bf16_t* p, float (&v)[8]) {
    const v4u w = *(const v4u*)p;
    v[0] = __builtin_bit_cast(float, w.x << 16); v[1] = __builtin_bit_cast(float, w.x & 0xffff0000u);
    v[2] = __builtin_bit_cast(float, w.y << 16); v[3] = __builtin_bit_cast(float, w.y & 0xffff0000u);
    v[4] = __builtin_bit_cast(float, w.z << 16); v[5] = __builtin_bit_cast(float, w.z & 0xffff0000u);
    v[6] = __builtin_bit_cast(float, w.w << 16); v[7] = __builtin_bit_cast(float, w.w & 0xffff0000u);
}
template <int WHICH> __device__ __forceinline__ void phase_gemm(const Ptrs& P, LAS unsigned char* lds, int G, int c) {
    unsigned char* ws = P.ws;
    bf16_t* W1T = (bf16_t*)(ws + WS_W1T); bf16_t* W2T = (bf16_t*)(ws + WS_W2T); bf16_t* W3T = (bf16_t*)(ws + WS_W3T); bf16_t* W4T = (bf16_t*)(ws + WS_W4T);
    bf16_t* XB = (bf16_t*)(ws + WS_XB); bf16_t* YB = (bf16_t*)(ws + WS_Y); bf16_t* PROJ = (bf16_t*)(ws + WS_PROJ);
    float* R0 = (float*)(ws + WS_R0); float* SS1 = (float*)(ws + WS_SS1);
    if constexpr (WHICH == 1) { pg8::Gemm g{XB, W1T, M_TOK, EV_N, D_MODEL}; pg8::EpiProj E{PROJ, EV_N, R0, 0}; pg8::StaticOrder S; S.init(g.M, g.N, G, c);
        pg8::gemm_phase<pg8::EpiProj, pg8::StaticOrder, true, true>(lds, g, S, E); }
    if constexpr (WHICH == 2) { pg8::Gemm g{YB, W2T, M_TOK, D_MODEL, D_MODEL}; pg8::EpiRes E{nullptr, XB, nullptr, XB, SS1, D_MODEL};     pg8::StaticOrder S; S.init(g.M, g.N, G, c);
        pg8::gemm_phase<pg8::EpiRes, pg8::StaticOrder, true, true>(lds, g, S, E); }
    if constexpr (WHICH == 3) { pg8::Gemm g{XB, W3T, M_TOK, OD_N, D_MODEL}; pg8::EpiProj E{PROJ, OD_N, SS1, 1}; pg8::StaticOrder S; S.init(g.M, g.N, G, c);
        pg8::gemm_phase<pg8::EpiProj, pg8::StaticOrder, true, true>(lds, g, S, E); }
    if constexpr (WHICH == 4) { pg8::Gemm g{YB, W4T, M_TOK, D_MODEL, D_MODEL}; pg8::EpiRes E{nullptr, XB, P.out, nullptr, nullptr, D_MODEL}; pg8::StaticOrder S; S.init(g.M, g.N, G, c);
        pg8::gemm_phase<pg8::EpiRes, pg8::StaticOrder, true, true>(lds, g, S, E); }
}
typedef short bf16x8 __attribute__((ext_vector_type(8)));
typedef short bf16x4 __attribute__((ext_vector_type(4)));
typedef short v4i16_t __attribute__((ext_vector_type(4)));
#define MFMA16(a, b, c) __builtin_amdgcn_mfma_f32_16x16x32_bf16((a), (b), (c), 0, 0, 0)
__device__ __forceinline__ v4i16_t lds_tr(LAS const unsigned char* p) { return __builtin_amdgcn_ds_read_tr16_b64_v4i16((LAS v4i16_t*)p); }
__device__ __forceinline__ bf16x8 frag_row(LAS const unsigned char* base, int RS, int r0, int k0, int lane) { return *(LAS const bf16x8*)(base + (r0 + (lane & 15)) * RS + (k0 + 8 * (lane >> 4)) * 2); }
__device__ __forceinline__ bf16x8 frag_row_perm(LAS const unsigned char* base, int RS, int r0, int k0, int lane) {
    LAS const unsigned char* p = base + (r0 + (lane & 15)) * RS + (k0 + 4 * (lane >> 4)) * 2;
    const bf16x4 a = *(LAS const bf16x4*)p, b = *(LAS const bf16x4*)(p + 32); return (bf16x8){a[0], a[1], a[2], a[3], b[0], b[1], b[2], b[3]}; }
__device__ __forceinline__ bf16x8 frag_tr(LAS const unsigned char* base, int RS, int k0, int c0, int lane) {
    const int g = lane >> 4, q = (lane & 15) >> 2, p = lane & 3; LAS const unsigned char* a = base + (k0 + 8 * g + q) * RS + (c0 + 4 * p) * 2;
    const v4i16_t lo = lds_tr(a), hi = lds_tr(a + 4 * RS); return (bf16x8){lo[0], lo[1], lo[2], lo[3], hi[0], hi[1], hi[2], hi[3]}; }
__device__ __forceinline__ bf16x8 frag_tr_perm(LAS const unsigned char* base, int RS, int k0, int c0, int lane) {
    const int g = lane >> 4, q = (lane & 15) >> 2, p = lane & 3; LAS const unsigned char* a = base + (k0 + 4 * g + q) * RS + (c0 + 4 * p) * 2;
    const v4i16_t lo = lds_tr(a), hi = lds_tr(a + 16 * RS); return (bf16x8){lo[0], lo[1], lo[2], lo[3], hi[0], hi[1], hi[2], hi[3]}; }
__device__ __forceinline__ bf16x8 acc_pair_frag(const f32x4& lo, const f32x4& hi) {
    const unsigned a = pk2(lo[0], lo[1]), b = pk2(lo[2], lo[3]), c = pk2(hi[0], hi[1]), d = pk2(hi[2], hi[3]);
    typedef unsigned u32x4_ __attribute__((ext_vector_type(4))); const u32x4_ w = {a, b, c, d}; return __builtin_bit_cast(bf16x8, w); }
__device__ __forceinline__ float fexp2(float x) { return __builtin_amdgcn_exp2f(x); }
constexpr float LOG2E = 1.4426950408889634f;
__device__ __forceinline__ float fexp(float x) { return __builtin_amdgcn_exp2f(x * LOG2E); }
__device__ __forceinline__ float frcp(float x) { return __builtin_amdgcn_rcpf(x); }
__device__ __forceinline__ float frsq(float x) { return __builtin_amdgcn_rsqf(x); }
__device__ __forceinline__ float fsqrt(float x) { return __builtin_amdgcn_sqrtf(x); }
__device__ __forceinline__ float fsigmoid(float x) { return __builtin_amdgcn_rcpf(1.0f + __builtin_amdgcn_exp2f(-x * LOG2E)); }
__device__ __forceinline__ float fsilu(float x) { return x * fsigmoid(x); }
__device__ __forceinline__ void phase_gates_ab(const Ptrs& P, int G) {
    unsigned char* ws = P.ws; const bf16_t* __restrict__ XB = (const bf16_t*)(ws + WS_XB); const bf16_t* __restrict__ W3T = (const bf16_t*)(ws + WS_W3T); const float* __restrict__ SS1 = (const float*)(ws + WS_SS1); float* __restrict__ AB = (float*)(ws + WS_AB);
    const int tid = threadIdx.x, lane = tid & 63, wave = tid >> 6, g = lane >> 4, l15 = lane & 15;
    for (int mt = blockIdx.x * NWAVES + wave; mt < M_TOK / 16; mt += G * NWAVES) {
        const bf16_t* ap = XB + (size_t)(mt * 16 + l15) * D_MODEL + 8 * g; const bf16_t* bp = W3T + (size_t)(OD_N + l15) * D_MODEL + 8 * g;
        f32x4 acc = (f32x4){0.f, 0.f, 0.f, 0.f};
#pragma unroll 1
        for (int kb = 0; kb < D_MODEL / 32; kb += 16) { bf16x8 af[16], bfr[16];
#pragma unroll
            for (int i = 0; i < 16; ++i) { af[i] = *(const bf16x8*)(ap + 32 * (kb + i)); bfr[i] = *(const bf16x8*)(bp + 32 * (kb + i)); }
#pragma unroll
            for (int i = 0; i < 16; ++i) acc = MFMA16(af[i], bfr[i], acc); }
#pragma unroll
        for (int r = 0; r < 4; ++r) { const int row = mt * 16 + 4 * g + r; AB[(size_t)row * 16 + l15] = acc[r] * frsq(SS1[row] * (1.0f / D_MODEL) + EPS); } }
}
#ifdef SKELETON
__device__ __forceinline__ void phase_mix0(const Ptrs& P, LAS unsigned char* lds, int G) {
    v4u* Y = (v4u*)(P.ws + WS_Y); const v4u z = {0u, 0u, 0u, 0u};
    for (size_t i = (size_t)blockIdx.x * 512 + threadIdx.x; i < (size_t)M_TOK * D_MODEL / 8; i += (size_t)G * 512) Y[i] = z;
}
__device__ __forceinline__ void phase_mix1a(const Ptrs& P, LAS unsigned char* lds, int G) { phase_mix0(P, lds, G); }
__device__ __forceinline__ void phase_mix1b(const Ptrs& P, LAS unsigned char* lds, int G) { }
#endif
constexpr int AT_RSK = 272, AT_RSV = 288, AT_KB = 64 * AT_RSK, AT_VB = 64 * AT_RSV;
constexpr int AT_OFF_K = 0, AT_OFF_V = 2 * AT_KB, AT_OFF_TBL = AT_OFF_V + 2 * AT_VB, AT_LDS = AT_OFF_TBL + 2064;
static_assert(AT_LDS <= 163328, "attention LDS");
template <int SKIP = 0> __device__ __forceinline__ void attn_item(const Ptrs& P, LAS unsigned char* lds, int item, size_t yoff = WS_Y) {
    const bf16_t* __restrict__ PROJ = (const bf16_t*)(P.ws + WS_PROJ); bf16_t* __restrict__ Y = (bf16_t*)(P.ws + yoff);
    const float* __restrict__ qn_g = P.in[IN_EV_QNG]; const float* __restrict__ kn_g = P.in[IN_EV_KNG];
    const int tid = threadIdx.x, lane = tid & 63, wave = tid >> 6, g = lane >> 4, l15 = lane & 15;
    const int cp = item & 15, h = (item >> 4) & 7, b = item >> 7;
    const int c = 2 * cp + (wave >> 2), qt = wave & 3;
    LAS float* tbl = (LAS float*)(lds + AT_OFF_TBL);
    for (int i = tid; i < NREL; i += 512) tbl[i] = P.in[IN_EV_REL][h * NREL + i] * LOG2E;
    bf16x8 qf[4];
    { const bf16_t* qp = PROJ + (size_t)(b * SEQ + c * 64 + qt * 16 + l15) * EV_N + EC_QA + h * 128 + 8 * g;
      float qv[4][8]; float ss = 0.f;
#pragma unroll
      for (int ks = 0; ks < 4; ++ks) { ld8bf(qp + 32 * ks, qv[ks]);
#pragma unroll
          for (int i = 0; i < 8; ++i) ss += qv[ks][i] * qv[ks][i]; }
      ss += __shfl_xor(ss, 16); ss += __shfl_xor(ss, 32);
      const float rs = frsq(ss * (1.0f / 128.0f) + EPS) * (0.08838834764831845f * LOG2E);
#pragma unroll
      for (int ks = 0; ks < 4; ++ks) { const float* gp = qn_g + 32 * ks + 8 * g; typedef unsigned u32x4_ __attribute__((ext_vector_type(4)));
          const u32x4_ w = {pk2(qv[ks][0] * rs * gp[0], qv[ks][1] * rs * gp[1]), pk2(qv[ks][2] * rs * gp[2], qv[ks][3] * rs * gp[3]),
                            pk2(qv[ks][4] * rs * gp[4], qv[ks][5] * rs * gp[5]), pk2(qv[ks][6] * rs * gp[6], qv[ks][7] * rs * gp[7])};
          qf[ks] = __builtin_bit_cast(bf16x8, w); } }
    f32x4 o[8];
#pragma unroll
    for (int i = 0; i < 8; ++i) o[i] = (f32x4){0.f, 0.f, 0.f, 0.f};
    float mrun = -1.0e30f, lrun = 0.f;
    const int kt_lo = (2 * cp - LOOKBACK) < 0 ? 0 : (2 * cp - LOOKBACK), kt_hi = 2 * cp + 1;
    v4u kreg[2], vreg[2];
    const int srow0 = tid >> 4, sch = tid & 15;
    float kg[8];
#pragma unroll
    for (int i = 0; i < 8; ++i) kg[i] = kn_g[sch * 8 + i];
#define AT_LOAD(kt) do { _Pragma("unroll") for (int i_ = 0; i_ < 2; ++i_) { const bf16_t* rp_ = PROJ + (size_t)(b * SEQ + (kt) * 64 + srow0 + 32 * i_) * EV_N + h * 128 + sch * 8; \
        kreg[i_] = *(const v4u*)(rp_ + EC_KA); vreg[i_] = *(const v4u*)(rp_ + EC_VA); } } while (0)
#define AT_STORE(buf) do { _Pragma("unroll") for (int i_ = 0; i_ < 2; ++i_) { const int row_ = srow0 + 32 * i_; \
        float kv_[8]; kv_[0] = __builtin_bit_cast(float, kreg[i_].x << 16); kv_[1] = __builtin_bit_cast(float, kreg[i_].x & 0xffff0000u); kv_[2] = __builtin_bit_cast(float, kreg[i_].y << 16); kv_[3] = __builtin_bit_cast(float, kreg[i_].y & 0xffff0000u); \
        kv_[4] = __builtin_bit_cast(float, kreg[i_].z << 16); kv_[5] = __builtin_bit_cast(float, kreg[i_].z & 0xffff0000u); kv_[6] = __builtin_bit_cast(float, kreg[i_].w << 16); kv_[7] = __builtin_bit_cast(float, kreg[i_].w & 0xffff0000u); \
        float ss_ = 0.f; _Pragma("unroll") for (int e_ = 0; e_ < 8; ++e_) ss_ += kv_[e_] * kv_[e_]; \
        ss_ += __shfl_xor(ss_, 1); ss_ += __shfl_xor(ss_, 2); ss_ += __shfl_xor(ss_, 4); ss_ += __shfl_xor(ss_, 8); \
        const float rs_ = frsq(ss_ * (1.0f / 128.0f) + EPS); \
        v4u w_; w_.x = pk2(kv_[0] * rs_ * kg[0], kv_[1] * rs_ * kg[1]); w_.y = pk2(kv_[2] * rs_ * kg[2], kv_[3] * rs_ * kg[3]); w_.z = pk2(kv_[4] * rs_ * kg[4], kv_[5] * rs_ * kg[5]); w_.w = pk2(kv_[6] * rs_ * kg[6], kv_[7] * rs_ * kg[7]); \
        *(LAS v4u*)(lds + AT_OFF_K + (buf) * AT_KB + row_ * AT_RSK + sch * 16) = w_; \
        *(LAS v4u*)(lds + AT_OFF_V + (buf) * AT_VB + row_ * AT_RSV + sch * 16) = vreg[i_]; } } while (0)
    AT_LOAD(kt_lo); AT_STORE(0);
    __syncthreads();
    const int qi = qt * 16 + l15;
    for (int kt = kt_lo, it = 0; kt <= kt_hi; ++kt, ++it) {
        const int buf = it & 1;
        if (kt < kt_hi) AT_LOAD(kt + 1);
        const int to = kt - (c - LOOKBACK);
        if (to >= 0 && to <= LOOKBACK) {
            LAS const unsigned char* Kb = lds + AT_OFF_K + buf * AT_KB; LAS const unsigned char* Vb = lds + AT_OFF_V + buf * AT_VB;
            f32x4 s[4];
#pragma unroll
            for (int nt = 0; nt < 4; ++nt) { s[nt] = (f32x4){0.f, 0.f, 0.f, 0.f};
#pragma unroll
                for (int ks = 0; ks < ((SKIP & 16) ? 0 : 4); ++ks) s[nt] = MFMA16(frag_row(Kb, AT_RSK, 16 * nt, 32 * ks, lane), qf[ks], s[nt]); }
            if constexpr (!(SKIP & 2)) { const int relb = LOOKBACK * CHUNK - 64 * to + qi - 4 * g;
#pragma unroll
              for (int nt = 0; nt < 4; ++nt)
#pragma unroll
                  for (int r = 0; r < 4; ++r) { int rel = relb - 16 * nt - r; rel = rel > REL_MAX ? REL_MAX : rel; s[nt][r] += tbl[rel + REL_MAX]; } }
            float tmax = fmaxf(fmaxf(s[0][0], s[0][1]), fmaxf(s[0][2], s[0][3]));
#pragma unroll
            for (int nt = 1; nt < 4; ++nt) tmax = fmaxf(tmax, fmaxf(fmaxf(s[nt][0], s[nt][1]), fmaxf(s[nt][2], s[nt][3])));
            tmax = fmaxf(tmax, __shfl_xor(tmax, 16)); tmax = fmaxf(tmax, __shfl_xor(tmax, 32));
            const float mnew = fmaxf(mrun, tmax), alpha = fexp2(mrun - mnew);
            float rsum = 0.f;
#pragma unroll
            for (int nt = 0; nt < 4; ++nt)
#pragma unroll
                for (int r = 0; r < 4; ++r) { s[nt][r] = (SKIP & 4) ? (s[nt][r] - mnew) : fexp2(s[nt][r] - mnew); rsum += s[nt][r]; }
            rsum += __shfl_xor(rsum, 16); rsum += __shfl_xor(rsum, 32);
            lrun = lrun * alpha + rsum; mrun = mnew;
            const bf16x8 pf0 = acc_pair_frag(s[0], s[1]), pf1 = acc_pair_frag(s[2], s[3]);
            float al[4];
#pragma unroll
            for (int r = 0; r < 4; ++r) al[r] = __shfl(alpha, 4 * g + r);
#pragma unroll
            for (int dt = 0; dt < ((SKIP & 8) ? 0 : 8); ++dt) { o[dt][0] *= al[0]; o[dt][1] *= al[1]; o[dt][2] *= al[2]; o[dt][3] *= al[3];
                o[dt] = MFMA16(pf0, frag_tr_perm(Vb, AT_RSV, 0, 16 * dt, lane), o[dt]);
                o[dt] = MFMA16(pf1, frag_tr_perm(Vb, AT_RSV, 32, 16 * dt, lane), o[dt]); }
        }
        if (kt < kt_hi) AT_STORE(buf ^ 1);
        __syncthreads();
    }
#undef AT_LOAD
#undef AT_STORE
    float li[4];
#pragma unroll
    for (int r = 0; r < 4; ++r) li[r] = frcp(__shfl(lrun, 4 * g + r));
#pragma unroll
    for (int r = 0; r < 4; ++r) { const size_t tok = (size_t)b * SEQ + c * 64 + qt * 16 + 4 * g + r; const bf16_t* zp = PROJ + tok * EV_N + EC_ZA + h * 128 + l15; bf16_t* yp = Y + tok * D_MODEL + h * 128 + l15;
#pragma unroll
        for (int dt = 0; dt < 8; ++dt) yp[16 * dt] = (bf16_t)f2bf(o[dt][r] * li[r] * fsilu(bf2f(zp[16 * dt]))); }
}
constexpr int A2_KB = 64 * AT_RSK, A2_VB = 64 * AT_RSV, A2_BUF = 2 * A2_KB + 2 * A2_VB;
constexpr int A2_OFF_TBL = 2 * A2_BUF, A2_LDS = A2_OFF_TBL + 2 * 2064;
static_assert(A2_LDS <= 163328, "attention (2-head) LDS");
template <int SKIP = 0> __device__ __forceinline__ void attn2_item(const Ptrs& P, LAS unsigned char* lds, int item, size_t yoff = WS_Y) {
    const bf16_t* __restrict__ PROJ = (const bf16_t*)(P.ws + WS_PROJ); bf16_t* __restrict__ Y = (bf16_t*)(P.ws + yoff);
    const float* __restrict__ qn_g = P.in[IN_EV_QNG]; const float* __restrict__ kn_g = P.in[IN_EV_KNG];
    const int tid = threadIdx.x, lane = tid & 63, wave = tid >> 6, g = lane >> 4, l15 = lane & 15;
    const int cp = item & 15, hp = (item >> 4) & 3, b = item >> 6;
    const int hs = wave >> 2, h = 2 * hp + hs, c = 2 * cp + ((wave >> 1) & 1), q0 = 32 * (wave & 1);
    LAS float* tbl = (LAS float*)(lds + A2_OFF_TBL);
    for (int i = tid; i < 2 * NREL; i += 512) { const int hh = i / NREL, r = i - hh * NREL; tbl[hh * 516 + r] = P.in[IN_EV_REL][(2 * hp + hh) * NREL + r] * LOG2E; }
    bf16x8 qf[2][4];
#pragma unroll
    for (int q = 0; q < 2; ++q) { const bf16_t* qp = PROJ + (size_t)(b * SEQ + c * 64 + q0 + 16 * q + l15) * EV_N + EC_QA + h * 128 + 8 * g;
        float qv[4][8]; float ss = 0.f;
#pragma unroll
        for (int ks = 0; ks < 4; ++ks) { ld8bf(qp + 32 * ks, qv[ks]);
#pragma unroll
            for (int i = 0; i < 8; ++i) ss += qv[ks][i] * qv[ks][i]; }
        ss += __shfl_xor(ss, 16); ss += __shfl_xor(ss, 32);
        const float rs = frsq(ss * (1.0f / 128.0f) + EPS) * (0.08838834764831845f * LOG2E);
#pragma unroll
        for (int ks = 0; ks < 4; ++ks) { const float* gp = qn_g + 32 * ks + 8 * g; typedef unsigned u32x4_ __attribute__((ext_vector_type(4)));
            const u32x4_ w = {pk2(qv[ks][0] * rs * gp[0], qv[ks][1] * rs * gp[1]), pk2(qv[ks][2] * rs * gp[2], qv[ks][3] * rs * gp[3]),
                              pk2(qv[ks][4] * rs * gp[4], qv[ks][5] * rs * gp[5]), pk2(qv[ks][6] * rs * gp[6], qv[ks][7] * rs * gp[7])};
            qf[q][ks] = __builtin_bit_cast(bf16x8, w); } }
    f32x4 o[2][8];
#pragma unroll
    for (int q = 0; q < 2; ++q)
#pragma unroll
        for (int i = 0; i < 8; ++i) o[q][i] = (f32x4){0.f, 0.f, 0.f, 0.f};
    float mrun[2] = {-1.0e30f, -1.0e30f}, lrun[2] = {0.f, 0.f};
    const int kt_lo = (2 * cp - LOOKBACK) < 0 ? 0 : (2 * cp - LOOKBACK), kt_hi = 2 * cp + 1;
    v4u kreg[2][2], vreg[2][2];
    const int srow0 = tid >> 4, sch = tid & 15;
#define A2_LOAD(kt) do { _Pragma("unroll") for (int hh_ = 0; hh_ < 2; ++hh_) _Pragma("unroll") for (int i_ = 0; i_ < 2; ++i_) { \
        const bf16_t* rp_ = PROJ + (size_t)(b * SEQ + (kt) * 64 + srow0 + 32 * i_) * EV_N + (2 * hp + hh_) * 128 + sch * 8; kreg[hh_][i_] = *(const v4u*)(rp_ + EC_KA); vreg[hh_][i_] = *(const v4u*)(rp_ + EC_VA); } } while (0)
#define A2_STORE(buf) do { _Pragma("unroll") for (int hh_ = 0; hh_ < 2; ++hh_) _Pragma("unroll") for (int i_ = 0; i_ < 2; ++i_) { const int row_ = srow0 + 32 * i_; const v4u kr_ = kreg[hh_][i_]; \
        float kv_[8]; kv_[0] = __builtin_bit_cast(float, kr_.x << 16); kv_[1] = __builtin_bit_cast(float, kr_.x & 0xffff0000u); kv_[2] = __builtin_bit_cast(float, kr_.y << 16); kv_[3] = __builtin_bit_cast(float, kr_.y & 0xffff0000u); \
        kv_[4] = __builtin_bit_cast(float, kr_.z << 16); kv_[5] = __builtin_bit_cast(float, kr_.z & 0xffff0000u); kv_[6] = __builtin_bit_cast(float, kr_.w << 16); kv_[7] = __builtin_bit_cast(float, kr_.w & 0xffff0000u); \
        float ss_ = 0.f; _Pragma("unroll") for (int e_ = 0; e_ < 8; ++e_) ss_ += kv_[e_] * kv_[e_]; \
        ss_ += __shfl_xor(ss_, 1); ss_ += __shfl_xor(ss_, 2); ss_ += __shfl_xor(ss_, 4); ss_ += __shfl_xor(ss_, 8); \
        const float rs_ = frsq(ss_ * (1.0f / 128.0f) + EPS); const f32x4 kga_ = *(const f32x4*)(kn_g + sch * 8), kgb_ = *(const f32x4*)(kn_g + sch * 8 + 4); const float kg[8] = {kga_[0], kga_[1], kga_[2], kga_[3], kgb_[0], kgb_[1], kgb_[2], kgb_[3]}; \
        v4u w_; w_.x = pk2(kv_[0] * rs_ * kg[0], kv_[1] * rs_ * kg[1]); w_.y = pk2(kv_[2] * rs_ * kg[2], kv_[3] * rs_ * kg[3]); w_.z = pk2(kv_[4] * rs_ * kg[4], kv_[5] * rs_ * kg[5]); w_.w = pk2(kv_[6] * rs_ * kg[6], kv_[7] * rs_ * kg[7]); \
        *(LAS v4u*)(lds + (buf) * A2_BUF + hh_ * A2_KB + row_ * AT_RSK + sch * 16) = w_; \
        *(LAS v4u*)(lds + (buf) * A2_BUF + 2 * A2_KB + hh_ * A2_VB + row_ * AT_RSV + sch * 16) = vreg[hh_][i_]; } } while (0)
    A2_LOAD(kt_lo); A2_STORE(0);
    __syncthreads();
    LAS const float* tb = tbl + hs * 516;
    for (int kt = kt_lo, it = 0; kt <= kt_hi; ++kt, ++it) {
        const int buf = it & 1;
        if (kt < kt_hi) A2_LOAD(kt + 1);
        const int to = kt - (c - LOOKBACK);
        if (to >= 0 && to <= LOOKBACK) {
            LAS const unsigned char* Kb = lds + buf * A2_BUF + hs * A2_KB; LAS const unsigned char* Vb = lds + buf * A2_BUF + 2 * A2_KB + hs * A2_VB;
            f32x4 s[2][4];
#pragma unroll
            for (int nt = 0; nt < 4; ++nt) { s[0][nt] = (f32x4){0.f, 0.f, 0.f, 0.f}; s[1][nt] = s[0][nt];
#pragma unroll
                for (int ks = 0; ks < 4; ++ks) { const bf16x8 kf = frag_row(Kb, AT_RSK, 16 * nt, 32 * ks, lane); s[0][nt] = MFMA16(kf, qf[0][ks], s[0][nt]); s[1][nt] = MFMA16(kf, qf[1][ks], s[1][nt]); }
                if (nt & 1) __builtin_amdgcn_sched_barrier(0); }
            bf16x8 pf[2][2]; float al[2][4];
#pragma unroll
            for (int q = 0; q < 2; ++q) {
                const int relb = LOOKBACK * CHUNK - 64 * to + (q0 + 16 * q + l15) - 4 * g;
                if (to <= 3) { const float cb = tb[2 * REL_MAX];
#pragma unroll
                    for (int nt = 0; nt < 4; ++nt) s[q][nt] += cb; }
                else if (to >= 5) { const LAS float* tp = tb + relb + REL_MAX;
#pragma unroll
                    for (int nt = 0; nt < 4; ++nt)
#pragma unroll
                        for (int r = 0; r < 4; ++r) s[q][nt][r] += tp[-(16 * nt + r)]; }
                else {
#pragma unroll
                    for (int nt = 0; nt < 4; ++nt)
#pragma unroll
                        for (int r = 0; r < 4; ++r) { int rel = relb - 16 * nt - r; rel = rel > REL_MAX ? REL_MAX : rel; s[q][nt][r] += tb[rel + REL_MAX]; } }
                float tmax = fmaxf(fmaxf(s[q][0][0], s[q][0][1]), fmaxf(s[q][0][2], s[q][0][3]));
#pragma unroll
                for (int nt = 1; nt < 4; ++nt) tmax = fmaxf(tmax, fmaxf(fmaxf(s[q][nt][0], s[q][nt][1]), fmaxf(s[q][nt][2], s[q][nt][3])));
                tmax = fmaxf(tmax, __shfl_xor(tmax, 16)); tmax = fmaxf(tmax, __shfl_xor(tmax, 32));
                const float mnew = fmaxf(mrun[q], tmax), alpha = fexp2(mrun[q] - mnew);
                float rsum = 0.f;
#pragma unroll
                for (int nt = 0; nt < 4; ++nt)
#pragma unroll
                    for (int r = 0; r < 4; ++r) { s[q][nt][r] = fexp2(s[q][nt][r] - mnew); rsum += s[q][nt][r]; }
                rsum += __shfl_xor(rsum, 16); rsum += __shfl_xor(rsum, 32);
                lrun[q] = lrun[q] * alpha + rsum; mrun[q] = mnew;
                pf[q][0] = acc_pair_frag(s[q][0], s[q][1]); pf[q][1] = acc_pair_frag(s[q][2], s[q][3]);
#pragma unroll
                for (int r = 0; r < 4; ++r) al[q][r] = __shfl(alpha, 4 * g + r); }
#pragma unroll
            for (int dt = 0; dt < 8; ++dt) { const bf16x8 v0 = frag_tr_perm(Vb, AT_RSV, 0, 16 * dt, lane), v1 = frag_tr_perm(Vb, AT_RSV, 32, 16 * dt, lane);
#pragma unroll
                for (int q = 0; q < 2; ++q) { o[q][dt][0] *= al[q][0]; o[q][dt][1] *= al[q][1]; o[q][dt][2] *= al[q][2]; o[q][dt][3] *= al[q][3];
                    o[q][dt] = MFMA16(pf[q][0], v0, o[q][dt]); o[q][dt] = MFMA16(pf[q][1], v1, o[q][dt]); }
                if (dt & 1) __builtin_amdgcn_sched_barrier(0); }
        }
        if (kt < kt_hi) A2_STORE(buf ^ 1);
        __syncthreads();
    }
#undef A2_LOAD
#undef A2_STORE
#pragma unroll
    for (int q = 0; q < 2; ++q) { float li[4];
#pragma unroll
        for (int r = 0; r < 4; ++r) li[r] = frcp(__shfl(lrun[q], 4 * g + r));
#pragma unroll
        for (int r = 0; r < 4; ++r) { const size_t tok = (size_t)b * SEQ + c * 64 + q0 + 16 * q + 4 * g + r; const bf16_t* zp = PROJ + tok * EV_N + EC_ZA + h * 128 + l15; bf16_t* yp = Y + tok * D_MODEL + h * 128 + l15;
#pragma unroll
            for (int dt = 0; dt < 8; ++dt) yp[16 * dt] = (bf16_t)f2bf(o[q][dt][r] * li[r] * fsilu(bf2f(zp[16 * dt]))); } }
}
constexpr int ML_RSQ = 528, ML_RSK = 544, ML_RSV = 160, ML_RSP = 144, ML_RSH = 144;
constexpr int ML_OFF_Q = 0, ML_OFF_K = ML_OFF_Q + 64 * ML_RSQ, ML_OFF_V = ML_OFF_K + 64 * ML_RSK, ML_OFF_P = ML_OFF_V + 64 * ML_RSV, ML_OFF_H = ML_OFF_P + 64 * ML_RSP, ML_OFF_S = ML_OFF_H + 64 * ML_RSH;
constexpr int ML_BC = 0, ML_AA = 2048, ML_PM = 4096, ML_MCH = 6144  , ML_BL = 6184  , ML_PL = 6216  ;
constexpr int ML_E1 = 6248, ML_E2 = ML_E1 + 64, ML_WI = ML_E2 + 64, ML_EMT = ML_WI + 64, ML_WS = ML_EMT + 64, ML_RS = ML_WS + 64, ML_QN = ML_RS + 64, ML_NV = ML_QN + 64, ML_NP = ML_NV + 256, ML_WC = ML_NP + 512, ML_LDS = ML_OFF_S + (ML_WC + 4) * 4;
static_assert(ML_LDS <= 163328, "mLSTM LDS");
template <int SKIP = 0> __device__ __forceinline__ void mlstm_item(const Ptrs& P, LAS unsigned char* lds, int item, size_t yoff = WS_Y) {
    const bf16_t* __restrict__ PROJ = (const bf16_t*)(P.ws + WS_PROJ); bf16_t* __restrict__ Y = (bf16_t*)(P.ws + yoff); const float* __restrict__ GIF = (const float*)(P.ws + WS_GIF);
    const int tid = threadIdx.x, lane = tid & 63, wave = tid >> 6, g = lane >> 4, l15 = lane & 15;
    const int quarter = item & 3, h = (item >> 2) & 3, b = item >> 4;
    LAS float* sc = (LAS float*)(lds + ML_OFF_S);
    LAS const unsigned char* Qt = lds + ML_OFF_Q; LAS const unsigned char* Kt = lds + ML_OFF_K; LAS const unsigned char* Vt = lds + ML_OFF_V; LAS const unsigned char* Ps = lds + ML_OFF_P;
    const size_t tok0 = (size_t)b * SEQ;
    f32x4 cacc[16];
#pragma unroll
    for (int i = 0; i < 16; ++i) cacc[i] = (f32x4){0.f, 0.f, 0.f, 0.f};
    if (tid < 256) sc[ML_NV + tid] = 0.f;
    for (int e = tid; e < 64 * ML_RSP / 8; e += 512) *(LAS unsigned long long*)(lds + ML_OFF_P + e * 8) = 0ull;
    float gli[4], gfp[4];
#pragma unroll
    for (int i = 0; i < 4; ++i) { const size_t tok = tok0 + (wave * 4 + i) * 64 + lane; gli[i] = GIF[tok * 8 + h]; gfp[i] = GIF[tok * 8 + 4 + h]; }
#pragma unroll
    for (int i = 0; i < 4; ++i) { const int c = wave * 4 + i;
        const float li = gli[i], lf = logsigmoidf_(gfp[i]);
        float bc = lf;
#pragma unroll
        for (int o = 1; o < 64; o <<= 1) { const float t_ = __shfl_up(bc, o); if (lane >= o) bc += t_; }
        const float as = li - bc; float pm = as;
#pragma unroll
        for (int o = 1; o < 64; o <<= 1) { const float t_ = __shfl_up(pm, o); if (lane >= o) pm = fmaxf(pm, t_); }
        sc[ML_BC + c * 64 + lane] = bc; sc[ML_AA + c * 64 + lane] = as; sc[ML_PM + c * 64 + lane] = pm;
        if (lane == 63) { sc[ML_BL + c] = bc; sc[ML_PL + c] = pm; } }
    __syncthreads();
    if (tid == 0) { float m = 0.f; sc[ML_MCH] = 0.f;
        for (int c = 0; c < NCH; ++c) { m = sc[ML_BL + c] + fmaxf(m, sc[ML_PL + c]); sc[ML_MCH + c + 1] = m; } }
    v4u qreg[4], kreg[4], vreg, oreg, zreg;
    const int ot = tid >> 3, oc = (tid & 7) * 8, ocol = h * 256 + quarter * 64 + oc;
#define ML_LOAD(n) do { _Pragma("unroll") for (int i_ = 0; i_ < 4; ++i_) { const int id_ = tid + 512 * i_, row_ = id_ >> 5, ch_ = id_ & 31; const bf16_t* rp_ = PROJ + (tok0 + (n) * 64 + row_) * EV_N + h * 256 + ch_ * 8; \
            qreg[i_] = *(const v4u*)(rp_ + EC_QB); kreg[i_] = *(const v4u*)(rp_ + EC_KB); } \
        vreg = *(const v4u*)(PROJ + (tok0 + (n) * 64 + (tid >> 3)) * EV_N + EC_VB + h * 256 + quarter * 64 + (tid & 7) * 8); } while (0)
#define ML_LOAD_OZ(n) do { const bf16_t* rp_ = PROJ + (tok0 + (n) * 64 + ot) * EV_N + ocol; oreg = *(const v4u*)(rp_ + EC_OB); zreg = *(const v4u*)(rp_ + EC_ZB); } while (0)
#define ML_STORE() do { _Pragma("unroll") for (int i_ = 0; i_ < 4; ++i_) { const int id_ = tid + 512 * i_, row_ = id_ >> 5, ch_ = id_ & 31; \
            *(LAS v4u*)(lds + ML_OFF_Q + row_ * ML_RSQ + ch_ * 16) = qreg[i_]; *(LAS v4u*)(lds + ML_OFF_K + row_ * ML_RSK + ch_ * 16) = kreg[i_]; } \
        *(LAS v4u*)(lds + ML_OFF_V + (tid >> 3) * ML_RSV + (tid & 7) * 16) = vreg; } while (0)
    ML_LOAD(0);
    __syncthreads();
    for (int n = 0; n < NCH; ++n) {
        if constexpr (!(SKIP & 64)) ML_STORE();
        const float m0 = sc[ML_MCH + n], m1 = sc[ML_MCH + n + 1], blast = sc[ML_BL + n];
        if (tid < 64) { const float bc = sc[ML_BC + n * 64 + tid], as = sc[ML_AA + n * 64 + tid], mx = fmaxf(m0, sc[ML_PM + n * 64 + tid]);
            sc[ML_E1 + tid] = -mx * LOG2E; sc[ML_E2 + tid] = as * LOG2E; sc[ML_WI + tid] = fexp(m0 - mx); sc[ML_EMT + tid] = fexp(-bc - mx); sc[ML_WS + tid] = fexp(as + blast - m1); sc[ML_RS + tid] = 0.f;
            if (tid == 0) sc[ML_WC] = fexp(blast + m0 - m1); }
        __syncthreads();
        if constexpr (!(SKIP & 64)) { if (n + 1 < NCH) ML_LOAD(n + 1); }
        f32x4 nu[4]; bf16x8 vf[2];
        if (wave >= 4) {
#pragma unroll 1
            for (int q = wave - 4; q < ((SKIP & 2) ? 0 : 10); q += 4) { const int tt = (q >= 6) ? 3 : (q >= 3) ? 2 : (q >= 1) ? 1 : 0; const int st = q - (tt * (tt + 1)) / 2;
                const int t = 16 * tt + l15; const float e1 = sc[ML_E1 + t];
                f32x4 s_ = (f32x4){0.f, 0.f, 0.f, 0.f};
#pragma unroll
                for (int ks = 0; ks < 8; ++ks) s_ = MFMA16(frag_row(Kt, ML_RSK, 16 * st, 32 * ks, lane), frag_row(Qt, ML_RSQ, 16 * tt, 32 * ks, lane), s_);
                float pv_[4]; float rs = 0.f;
#pragma unroll
                for (int r = 0; r < 4; ++r) { const int sidx = 16 * st + 4 * g + r; const float p = (sidx <= t) ? fexp2(e1 + sc[ML_E2 + sidx]) * s_[r] * 0.0625f : 0.f; pv_[r] = p; rs += p; }
                rs += __shfl_xor(rs, 16); rs += __shfl_xor(rs, 32);
                if (g == 0) atomicAdd((float*)(sc + ML_RS + t), rs);
                *(LAS unsigned long long*)(lds + ML_OFF_P + t * ML_RSP + (16 * st + 4 * g) * 2) = (unsigned long long)pk2(pv_[0], pv_[1]) | ((unsigned long long)pk2(pv_[2], pv_[3]) << 32); }
        } else {
#pragma unroll
            for (int tt = 0; tt < 4; ++tt) nu[tt] = (f32x4){0.f, 0.f, 0.f, 0.f};
#pragma unroll
            for (int j = 0; j < ((SKIP & 4) ? 0 : 8); ++j) { const bf16x8 cf = acc_pair_frag(cacc[2 * j], cacc[2 * j + 1]);
#pragma unroll
                for (int tt = 0; tt < 4; ++tt) nu[tt] = MFMA16(frag_row_perm(Qt, ML_RSQ, 16 * tt, 32 * j, lane), cf, nu[tt]);
                if (j & 1) __builtin_amdgcn_sched_barrier(0); }
            if constexpr (!(SKIP & 32)) { f32x4 qna = (f32x4){0.f, 0.f, 0.f, 0.f}; const LAS float* nvc = sc + ((n & 1) ? ML_NP : ML_NV);
#pragma unroll
              for (int j = 0; j < 8; ++j) { const f32x4 n0_ = *(LAS const f32x4*)(nvc + 32 * j + 4 * g), n1_ = *(LAS const f32x4*)(nvc + 32 * j + 16 + 4 * g);
                  qna = MFMA16(frag_row_perm(Qt, ML_RSQ, 16 * wave, 32 * j, lane), acc_pair_frag(n0_, n1_), qna); }
              if (l15 == 0) *(LAS f32x4*)(sc + ML_QN + 16 * wave + 4 * g) = qna * 0.0625f; }
            __builtin_amdgcn_sched_barrier(0);
#pragma unroll
            for (int tt = 0; tt < 4; ++tt) { const f32x4 wi = *(LAS const f32x4*)(sc + ML_WI + 16 * tt + 4 * g); nu[tt] *= wi * 0.0625f; }
            __builtin_amdgcn_sched_barrier(0);
#pragma unroll
            for (int ks = 0; ks < 2; ++ks) vf[ks] = frag_tr_perm(Vt, ML_RSV, 32 * ks, 16 * wave, lane);
            const float wc = sc[ML_WC];
            bf16x8 vw[2];
#pragma unroll
            for (int ks = 0; ks < 2; ++ks) { typedef unsigned u32x4_ __attribute__((ext_vector_type(4))); const u32x4_ w = __builtin_bit_cast(u32x4_, vf[ks]);
                const f32x4 wa = *(LAS const f32x4*)(sc + ML_WS + 32 * ks + 4 * g), wb = *(LAS const f32x4*)(sc + ML_WS + 32 * ks + 16 + 4 * g);
                const u32x4_ o = {pk2(__builtin_bit_cast(float, w.x << 16) * wa[0], __builtin_bit_cast(float, w.x & 0xffff0000u) * wa[1]), pk2(__builtin_bit_cast(float, w.y << 16) * wa[2], __builtin_bit_cast(float, w.y & 0xffff0000u) * wa[3]),
                                  pk2(__builtin_bit_cast(float, w.z << 16) * wb[0], __builtin_bit_cast(float, w.z & 0xffff0000u) * wb[1]), pk2(__builtin_bit_cast(float, w.w << 16) * wb[2], __builtin_bit_cast(float, w.w & 0xffff0000u) * wb[3])};
                vw[ks] = __builtin_bit_cast(bf16x8, o); }
#pragma unroll
            for (int kt = 0; kt < ((SKIP & 8) ? 0 : 16); ++kt) { cacc[kt] *= wc;
                cacc[kt] = MFMA16(frag_tr_perm(Kt, ML_RSK, 0, 16 * kt, lane), vw[0], cacc[kt]);
                cacc[kt] = MFMA16(frag_tr_perm(Kt, ML_RSK, 32, 16 * kt, lane), vw[1], cacc[kt]);
                if ((kt & 3) == 3) __builtin_amdgcn_sched_barrier(0); }
#pragma unroll
            for (int kt = 0; kt < 16; ++kt) asm volatile("" : "+v"(cacc[kt]));
            if constexpr (!(SKIP & 32)) { bf16x8 wsf[2];
#pragma unroll
              for (int ks = 0; ks < 2; ++ks) { const f32x4 w0_ = *(LAS const f32x4*)(sc + ML_WS + 32 * ks + 4 * g), w1_ = *(LAS const f32x4*)(sc + ML_WS + 32 * ks + 16 + 4 * g); wsf[ks] = acc_pair_frag(w0_, w1_); }
              const LAS float* nvo = sc + ((n & 1) ? ML_NP : ML_NV); LAS float* nvn = sc + ((n & 1) ? ML_NV : ML_NP);
#pragma unroll
              for (int i = 0; i < 4; ++i) { const int kt = 4 * wave + i; f32x4 na = (f32x4){0.f, 0.f, 0.f, 0.f};
                  na = MFMA16(frag_tr_perm(Kt, ML_RSK, 0, 16 * kt, lane), wsf[0], na); na = MFMA16(frag_tr_perm(Kt, ML_RSK, 32, 16 * kt, lane), wsf[1], na);
                  if (l15 == 0) *(LAS f32x4*)(nvn + 16 * kt + 4 * g) = *(LAS const f32x4*)(nvo + 16 * kt + 4 * g) * wc + na; } }
        }
        __syncthreads();
        if constexpr (!(SKIP & 1)) ML_LOAD_OZ(n);
        if (wave < 4) {
#pragma unroll
            for (int ks = 0; ks < ((SKIP & 16) ? 0 : 2); ++ks) {
#pragma unroll
                for (int tt = 0; tt < 4; ++tt) nu[tt] = MFMA16(frag_row_perm(Ps, ML_RSP, 16 * tt, 32 * ks, lane), vf[ks], nu[tt]); }
#pragma unroll
            for (int tt = 0; tt < 4; ++tt)
#pragma unroll
                for (int r = 0; r < 4; ++r) *(LAS unsigned short*)(lds + ML_OFF_H + (16 * tt + 4 * g + r) * ML_RSH + (16 * wave + l15) * 2) = (unsigned short)(pk2(nu[tt][r], 0.f) & 0xffffu);
            __builtin_amdgcn_sched_barrier(0);
        }
        __syncthreads();
        if constexpr (!(SKIP & 1)) { const float den = sc[ML_WI + ot] * sc[ML_QN + ot] + sc[ML_RS + ot]; const float inv = frcp(fmaxf(fabsf(den), sc[ML_EMT + ot]));
          const v4u hw = *(LAS const v4u*)(lds + ML_OFF_H + ot * ML_RSH + oc * 2); const v4u ow = oreg, zw = zreg;
#define ML_Y(hx, ox, zx, lo) (fsigmoid(__builtin_bit_cast(float, (lo) ? ((ox) << 16) : ((ox) & 0xffff0000u))) * (__builtin_bit_cast(float, (lo) ? ((hx) << 16) : ((hx) & 0xffff0000u)) * inv) * fsilu(__builtin_bit_cast(float, (lo) ? ((zx) << 16) : ((zx) & 0xffff0000u))))
          v4u yw; yw.x = pk2(ML_Y(hw.x, ow.x, zw.x, 1), ML_Y(hw.x, ow.x, zw.x, 0)); yw.y = pk2(ML_Y(hw.y, ow.y, zw.y, 1), ML_Y(hw.y, ow.y, zw.y, 0));
          yw.z = pk2(ML_Y(hw.z, ow.z, zw.z, 1), ML_Y(hw.z, ow.z, zw.z, 0)); yw.w = pk2(ML_Y(hw.w, ow.w, zw.w, 1), ML_Y(hw.w, ow.w, zw.w, 0));
#undef ML_Y
          *(v4u*)(Y + (tok0 + n * 64 + ot) * D_MODEL + W_A + ocol) = yw; }
    }
#undef ML_LOAD
#undef ML_LOAD_OZ
#undef ML_STORE
    __syncthreads();
}
constexpr int RG_RSG = 160, RG_RSX = 272, RG_RSF = 33 * 4;
constexpr int RG_OFF_G = 0, RG_OFF_X = RG_OFF_G + 128 * RG_RSG, RG_OFF_XF = RG_OFF_X + 64 * RG_RSX, RG_OFF_A = RG_OFF_XF + 64 * RG_RSF, RG_OFF_I = RG_OFF_A + 64 * RG_RSF, RG_OFF_H = RG_OFF_I + 64 * RG_RSF, RG_LDS = RG_OFF_H + 64 * RG_RSF;
static_assert(RG_LDS <= 163328, "RG-LRU LDS");
template <int SKIP = 0> __device__ __forceinline__ void rglru_item(const Ptrs& P, LAS unsigned char* lds, int item, size_t yoff = WS_Y) {
    const bf16_t* __restrict__ PROJ = (const bf16_t*)(P.ws + WS_PROJ); bf16_t* __restrict__ Y = (bf16_t*)(P.ws + yoff);
    const float* __restrict__ ccw = P.in[IN_OD_CCW]; const float* __restrict__ ccb = P.in[IN_OD_CCB]; const float* __restrict__ gw = P.in[IN_OD_GW]; const float* __restrict__ gb = P.in[IN_OD_GB]; const float* __restrict__ lam = P.in[IN_OD_LAM];
    const int tid = threadIdx.x, lane = tid & 63, wave = tid >> 6, g = lane >> 4, l15 = lane & 15;
    const int cq = item & 3, blk = (item >> 2) & 7, b = item >> 5;
    const size_t tok0 = (size_t)b * SEQ;
#pragma unroll
    for (int e = tid; e < 128 * 64; e += 512) { const int k = e >> 6, c = e & 63; const int d = (c < 32) ? (cq * 32 + c) : (128 + cq * 32 + c - 32);
        *(LAS unsigned short*)(lds + RG_OFF_G + k * RG_RSG + c * 2) = (unsigned short)f2bf(gw[((size_t)blk * 128 + k) * 256 + d]); }
    const int c8 = tid & 15, tq = tid >> 4, ch0 = blk * 128 + 8 * c8;
    float cw[4][8], cb[8];
#pragma unroll
    for (int i = 0; i < 8; ++i) { cb[i] = ccb[ch0 + i];
#pragma unroll
        for (int j = 0; j < 4; ++j) cw[j][i] = ccw[j * W_C + ch0 + i]; }
    const int chl = 16 * (wave & 1) + l15, cgl = blk * 128 + cq * 32 + chl;
    const float gbr = gb[cgl], gbi = gb[W_C + cgl], sp = softplusf_(-lam[cgl]);
    float hcar = 0.f;
    v4u xin[2][4]; unsigned long long zin = 0ull;
    const int ot = tid >> 3, oc4 = tid & 7, cgo = blk * 128 + cq * 32 + 4 * oc4;
#define RG_LOAD(n) do { _Pragma("unroll") for (int u_ = 0; u_ < 2; ++u_) { const int s_ = (n) * 64 + tq + 32 * u_; \
            _Pragma("unroll") for (int j_ = 0; j_ < 4; ++j_) { const bool ok_ = (s_ - 3 + j_ >= 0); const v4u x_ = *(const v4u*)(PROJ + (tok0 + (ok_ ? s_ - 3 + j_ : 0)) * OD_N + OC_XC + ch0); \
                xin[u_][j_].x = ok_ ? x_.x : 0u; xin[u_][j_].y = ok_ ? x_.y : 0u; xin[u_][j_].z = ok_ ? x_.z : 0u; xin[u_][j_].w = ok_ ? x_.w : 0u; } } \
        zin = *(const unsigned long long*)(PROJ + (tok0 + (n) * 64 + ot) * OD_N + OC_ZC + cgo); } while (0)
    RG_LOAD(0);
    __syncthreads();
    for (int n = 0; n < NCH; ++n) {
        const unsigned long long zw = zin;
#pragma unroll
        for (int u = 0; u < ((SKIP & 1) ? 0 : 2); ++u) { const int t = tq + 32 * u; float xv[8];
#pragma unroll
            for (int i = 0; i < 8; ++i) xv[i] = cb[i];
#pragma unroll
            for (int j = 0; j < 4; ++j) { const v4u w_ = xin[u][j];
                xv[0] += cw[j][0] * __builtin_bit_cast(float, w_.x << 16); xv[1] += cw[j][1] * __builtin_bit_cast(float, w_.x & 0xffff0000u); xv[2] += cw[j][2] * __builtin_bit_cast(float, w_.y << 16); xv[3] += cw[j][3] * __builtin_bit_cast(float, w_.y & 0xffff0000u);
                xv[4] += cw[j][4] * __builtin_bit_cast(float, w_.z << 16); xv[5] += cw[j][5] * __builtin_bit_cast(float, w_.z & 0xffff0000u); xv[6] += cw[j][6] * __builtin_bit_cast(float, w_.w << 16); xv[7] += cw[j][7] * __builtin_bit_cast(float, w_.w & 0xffff0000u); }
            v4u w; w.x = pk2(xv[0], xv[1]); w.y = pk2(xv[2], xv[3]); w.z = pk2(xv[4], xv[5]); w.w = pk2(xv[6], xv[7]);
            *(LAS v4u*)(lds + RG_OFF_X + t * RG_RSX + c8 * 16) = w;
            if ((c8 >> 2) == cq) { LAS float* xf = (LAS float*)(lds + RG_OFF_XF + t * RG_RSF) + 8 * (c8 & 3);
#pragma unroll
                for (int i = 0; i < 8; ++i) xf[i] = xv[i]; } }
        if (n + 1 < NCH) RG_LOAD(n + 1);
        __syncthreads();
        { const int tt = wave >> 1, cp = wave & 1; f32x4 ar = (f32x4){0.f, 0.f, 0.f, 0.f}, ai = ar;
#pragma unroll
          for (int ks = 0; ks < ((SKIP & 2) ? 0 : 4); ++ks) { const bf16x8 xa = frag_row(lds + RG_OFF_X, RG_RSX, 16 * tt, 32 * ks, lane);
              ar = MFMA16(xa, frag_tr(lds + RG_OFF_G, RG_RSG, 32 * ks, 16 * cp, lane), ar);
              ai = MFMA16(xa, frag_tr(lds + RG_OFF_G, RG_RSG, 32 * ks, 32 + 16 * cp, lane), ai); }
#pragma unroll
          for (int r = 0; r < ((SKIP & 4) ? 0 : 4); ++r) { const int t = 16 * tt + 4 * g + r;
              const float rr = fsigmoid(ar[r] + gbr), ig = fsigmoid(ai[r] + gbi); const float la = -8.0f * rr * sp;
              const float xc = *((LAS const float*)(lds + RG_OFF_XF + t * RG_RSF) + chl);
              *((LAS float*)(lds + RG_OFF_A + t * RG_RSF) + chl) = fexp(la);
              *((LAS float*)(lds + RG_OFF_I + t * RG_RSF) + chl) = fsqrt(1.0f - fexp(2.0f * la)) * (ig * xc); } }
        __syncthreads();
        if ((SKIP & 8) == 0 && tid < 32) { float h = hcar;
#pragma unroll 8
            for (int t = 0; t < 64; ++t) { h = *((LAS const float*)(lds + RG_OFF_A + t * RG_RSF) + tid) * h + *((LAS const float*)(lds + RG_OFF_I + t * RG_RSF) + tid);
                *((LAS float*)(lds + RG_OFF_H + t * RG_RSF) + tid) = h; }
            hcar = h; }
        __syncthreads();
        if constexpr (!(SKIP & 16)) { const size_t tok = tok0 + n * 64 + ot;
          const LAS float* hp = (LAS const float*)(lds + RG_OFF_H + ot * RG_RSF) + 4 * oc4;
          const float z0 = __builtin_bit_cast(float, (unsigned)(zw & 0xffffull) << 16), z1 = __builtin_bit_cast(float, (unsigned)(zw >> 16 & 0xffffull) << 16), z2 = __builtin_bit_cast(float, (unsigned)(zw >> 32 & 0xffffull) << 16), z3 = __builtin_bit_cast(float, (unsigned)(zw >> 48) << 16);
          *(unsigned long long*)(Y + tok * D_MODEL + cgo) = (unsigned long long)pk2(hp[0] * fsilu(z0), hp[1] * fsilu(z1)) | ((unsigned long long)pk2(hp[2] * fsilu(z2), hp[3] * fsilu(z3)) << 32); }
    }
#undef RG_LOAD
    __syncthreads();
}
constexpr size_t WS_DQ2 = 4 * MiB, WS_DK2 = 36 * MiB;
constexpr size_t OUT_DWT = 0, OUT_DUT = 32 * MiB;
constexpr size_t WS_DQK = WS_FREE1, WS_DDEC = WS_FREE1 + 16 * MiB;
constexpr float DN_SCALE = 0.08838834764831845f;
template <int T> struct SolveRows {
    static __device__ __forceinline__ void run(float (&col)[32], LAS const unsigned char* Ab, int j) {
        SolveRows<T - 1>::run(col, Ab, j);
        float v = (T == j) ? 1.f : 0.f;
#pragma unroll
        for (int s4 = 0; s4 < (T + 3) / 4; ++s4) { const f32x4 a = *(LAS const f32x4*)(Ab + T * 272 + 16 * s4);
#pragma unroll
            for (int e = 0; e < 4; ++e) { if (4 * s4 + e < T) v -= a[e] * col[4 * s4 + e]; } }
        asm volatile("" : "+v"(v) :: "memory"); col[T] = v;
    }
};
template <> struct SolveRows<-1> { static __device__ __forceinline__ void run(float (&)[32], LAS const unsigned char*, int) {} };
constexpr int D1_RSQ = 272, D1_RSK = 288, D1_RSV = 288, D1_RSA = 272, D1_RST = 160;
constexpr int D1_OFF_Q = 0, D1_OFF_K = D1_OFF_Q + 64 * D1_RSQ, D1_OFF_V = D1_OFF_K + 64 * D1_RSK, D1_OFF_A = D1_OFF_V + 64 * D1_RSV, D1_OFF_T = D1_OFF_A + 64 * D1_RSA, D1_OFF_S = D1_OFF_T + 64 * D1_RST, D1_LDS = D1_OFF_S + 512;
static_assert(D1_LDS <= 163328, "D1 LDS");
template <int SKIP = 0> __device__ __forceinline__ void dn1_item(const Ptrs& P, LAS unsigned char* lds, int item) {
    const bf16_t* __restrict__ PROJ = (const bf16_t*)(P.ws + WS_PROJ); const float* __restrict__ AB = (const float*)(P.ws + WS_AB); const float* __restrict__ cdw = P.in[IN_OD_CDW];
    bf16_t* __restrict__ Q2 = (bf16_t*)(P.ws + WS_DQ2); bf16_t* __restrict__ K2 = (bf16_t*)(P.ws + WS_DK2);
    bf16_t* __restrict__ WTg = (bf16_t*)((unsigned char*)P.out + OUT_DWT) + (size_t)item * 8192; bf16_t* __restrict__ UTg = (bf16_t*)((unsigned char*)P.out + OUT_DUT) + (size_t)item * 8192;
    bf16_t* __restrict__ QKg = (bf16_t*)(P.ws + WS_DQK) + (size_t)item * 4096; float* __restrict__ DECg = (float*)(P.ws + WS_DDEC) + (size_t)item * 64;
    int tid_ = threadIdx.x; asm volatile("" : "+v"(tid_));
    const int tid = tid_, lane = tid & 63, wave = tid >> 6, g = lane >> 4, l15 = lane & 15;
    const int n = item & 31, h = (item >> 5) & 7, b = item >> 8;
    const size_t tok0 = (size_t)b * SEQ + n * 64;
    LAS float* beta_s = (LAS float*)(lds + D1_OFF_S); LAS float* dec_s = beta_s + 64;
    const float ab_a = AB[(tok0 + lane) * 16 + h], ab_b = AB[(tok0 + lane) * 16 + 8 + h], alog_ = P.in[IN_OD_ALOG][h], dtb_ = P.in[IN_OD_DTB][h];
    asm volatile("" ::: "memory");
    if constexpr (!(SKIP & 1)) { const int t = tid >> 3, d16 = tid & 7, s = n * 64 + t; float qk_[2][16]; float ssq[2] = {0.f, 0.f};
#pragma unroll
      for (int pp = 0; pp < 3; ++pp) { const int p = (pp + 2) % 3;
#pragma unroll
          for (int hf = 0; hf < 2; ++hf) { const int col = p * W_D + h * 128 + 16 * d16 + 8 * hf; float a[8];
              v4u xw[4];
#pragma unroll
              for (int j = 0; j < 4; ++j) { const bool ok = (s - 3 + j >= 0); xw[j] = *(const v4u*)(PROJ + (ok ? tok0 + t - 3 + j : tok0) * OD_N + OC_QD + col); }
#pragma unroll
              for (int i = 0; i < 8; ++i) a[i] = 0.f;
#pragma unroll
              for (int j = 0; j < 4; ++j) { const float m_ = (s - 3 + j >= 0) ? 1.0f : 0.0f; const f32x4 w0 = *(const f32x4*)(cdw + j * 3 * W_D + col) * m_, w1 = *(const f32x4*)(cdw + j * 3 * W_D + col + 4) * m_; const v4u x_ = xw[j];
                  a[0] += w0[0] * __builtin_bit_cast(float, x_.x << 16); a[1] += w0[1] * __builtin_bit_cast(float, x_.x & 0xffff0000u); a[2] += w0[2] * __builtin_bit_cast(float, x_.y << 16); a[3] += w0[3] * __builtin_bit_cast(float, x_.y & 0xffff0000u);
                  a[4] += w1[0] * __builtin_bit_cast(float, x_.z << 16); a[5] += w1[1] * __builtin_bit_cast(float, x_.z & 0xffff0000u); a[6] += w1[2] * __builtin_bit_cast(float, x_.w << 16); a[7] += w1[3] * __builtin_bit_cast(float, x_.w & 0xffff0000u); }
#pragma unroll
              for (int i = 0; i < 8; ++i) a[i] = fsilu(a[i]);
              if (p < 2) {
#pragma unroll
                  for (int i = 0; i < 8; ++i) { qk_[p][8 * hf + i] = a[i]; ssq[p] += a[i] * a[i]; } }
              else { v4u w; w.x = pk2(a[0], a[1]); w.y = pk2(a[2], a[3]); w.z = pk2(a[4], a[5]); w.w = pk2(a[6], a[7]);
                  *(LAS v4u*)(lds + D1_OFF_V + t * D1_RSV + (16 * d16 + 8 * hf) * 2) = w; }
              asm volatile("" ::: "memory"); } }
#pragma unroll
      for (int p = 0; p < 2; ++p) { float ss = ssq[p]; ss += __shfl_xor(ss, 1); ss += __shfl_xor(ss, 2); ss += __shfl_xor(ss, 4); const float rs = frsq(ss + EPS);
#pragma unroll
          for (int hf = 0; hf < 2; ++hf) { v4u w; w.x = pk2(qk_[p][8 * hf + 0] * rs, qk_[p][8 * hf + 1] * rs); w.y = pk2(qk_[p][8 * hf + 2] * rs, qk_[p][8 * hf + 3] * rs);
              w.z = pk2(qk_[p][8 * hf + 4] * rs, qk_[p][8 * hf + 5] * rs); w.w = pk2(qk_[p][8 * hf + 6] * rs, qk_[p][8 * hf + 7] * rs);
              const int dd = 16 * d16 + 8 * hf;
              if (p == 0) { *(LAS v4u*)(lds + D1_OFF_Q + t * D1_RSQ + dd * 2) = w; *(v4u*)(Q2 + (tok0 + t) * W_D + h * 128 + dd) = w; }
              else { *(LAS v4u*)(lds + D1_OFF_K + t * D1_RSK + dd * 2) = w; *(v4u*)(K2 + (tok0 + t) * W_D + h * 128 + dd) = w; } } } }
    if (wave == 0) {
        const float beta = fsigmoid(ab_b); float dc = -fexp(alog_) * softplusf_(ab_a + dtb_);
#pragma unroll
        for (int o = 1; o < 64; o <<= 1) { const float t_ = __shfl_up(dc, o); if (lane >= o) dc += t_; }
        beta_s[lane] = beta; dec_s[lane] = dc; DECg[lane] = dc; }
    __syncthreads();
    { const int tt = wave >> 1, t = 16 * tt + l15; const float dt_ = dec_s[t], bt = beta_s[t];
#pragma unroll
      for (int u = 0; u < 2; ++u) { const int st = 2 * (wave & 1) + u; unsigned long long qw = 0ull;
          if (st <= tt && !(SKIP & 2)) { f32x4 kk = (f32x4){0.f, 0.f, 0.f, 0.f}, qk = kk;
#pragma unroll
              for (int ks = 0; ks < 4; ++ks) { const bf16x8 a = frag_row(lds + D1_OFF_K, D1_RSK, 16 * st, 32 * ks, lane);
                  kk = MFMA16(a, frag_row(lds + D1_OFF_K, D1_RSK, 16 * tt, 32 * ks, lane), kk); qk = MFMA16(a, frag_row(lds + D1_OFF_Q, D1_RSQ, 16 * tt, 32 * ks, lane), qk); }
              f32x4 am; float qv[4];
#pragma unroll
              for (int r = 0; r < 4; ++r) { const int s = 16 * st + 4 * g + r; const float gam = (s <= t) ? fexp(dt_ - dec_s[s]) : 0.f; am[r] = (s < t) ? bt * kk[r] * gam : 0.f; qv[r] = qk[r] * gam * DN_SCALE; }
              *(LAS f32x4*)(lds + D1_OFF_A + t * D1_RSA + (16 * st + 4 * g) * 4) = am;
              qw = (unsigned long long)pk2(qv[0], qv[1]) | ((unsigned long long)pk2(qv[2], qv[3]) << 32); }
          *(unsigned long long*)(QKg + t * 64 + 16 * st + 4 * g) = qw; } }
    __syncthreads();
    if (wave == 0 && !(SKIP & 4)) { const int hb = lane >> 5, j = lane & 31; float col[32];
        LAS const unsigned char* Ab = lds + D1_OFF_A + (32 * hb) * D1_RSA + (32 * hb) * 4;
        SolveRows<31>::run(col, Ab, j);
        LAS unsigned char* trow = lds + D1_OFF_T + (32 * hb + j) * D1_RST;
#pragma unroll
        for (int c = 0; c < 4; ++c) { v4u w; w.x = pk2(col[8 * c], col[8 * c + 1]); w.y = pk2(col[8 * c + 2], col[8 * c + 3]); w.z = pk2(col[8 * c + 4], col[8 * c + 5]); w.w = pk2(col[8 * c + 6], col[8 * c + 7]);
            *(LAS v4u*)(trow + (32 * hb) * 2 + 16 * c) = w;
            if (hb) *(LAS v4u*)(trow + 16 * c) = (v4u){0u, 0u, 0u, 0u}; }
        bf16x8 af[2], bfr[2];
#pragma unroll
        for (int ti = 0; ti < 2; ++ti) { LAS const unsigned char* ap = lds + D1_OFF_A + (32 + 16 * ti + l15) * D1_RSA + (8 * g) * 4; const f32x4 a0 = *(LAS const f32x4*)ap, a1 = *(LAS const f32x4*)(ap + 16);
            typedef unsigned u32x4_ __attribute__((ext_vector_type(4))); const u32x4_ w = {pk2(a0[0], a0[1]), pk2(a0[2], a0[3]), pk2(a1[0], a1[1]), pk2(a1[2], a1[3])}; af[ti] = __builtin_bit_cast(bf16x8, w); }
#pragma unroll
        for (int nj = 0; nj < 2; ++nj) bfr[nj] = frag_row(lds + D1_OFF_T, D1_RST, 16 * nj, 0, lane);
        f32x4 X[2][2];
#pragma unroll
        for (int ti = 0; ti < 2; ++ti)
#pragma unroll
            for (int nj = 0; nj < 2; ++nj) X[ti][nj] = MFMA16(af[ti], bfr[nj], ((f32x4){0.f, 0.f, 0.f, 0.f}));
        LAS const unsigned char* T11b = lds + D1_OFF_T + 32 * D1_RST + 64;
#pragma unroll
        for (int nj = 0; nj < 2; ++nj) { const bf16x8 xb = acc_pair_frag(X[0][nj], X[1][nj]);
#pragma unroll
            for (int ti = 0; ti < 2; ++ti) { const f32x4 r_ = MFMA16(frag_tr_perm(T11b, D1_RST, 0, 16 * ti, lane), xb, ((f32x4){0.f, 0.f, 0.f, 0.f}));
                *(LAS unsigned long long*)(lds + D1_OFF_T + (16 * nj + l15) * D1_RST + (32 + 16 * ti + 4 * g) * 2) = (unsigned long long)pk2(-r_[0], -r_[1]) | ((unsigned long long)pk2(-r_[2], -r_[3]) << 32); } }
    }
    __syncthreads();
    if constexpr (!(SKIP & 8)) { bf16x8 bv[2], bk[2];
#pragma unroll
      for (int ks = 0; ks < 2; ++ks) { typedef unsigned u32x4_ __attribute__((ext_vector_type(4)));
          const u32x4_ wv = __builtin_bit_cast(u32x4_, frag_tr(lds + D1_OFF_V, D1_RSV, 32 * ks, 16 * wave, lane)), wk = __builtin_bit_cast(u32x4_, frag_tr(lds + D1_OFF_K, D1_RSK, 32 * ks, 16 * wave, lane));
          float fb[8], fk[8];
#pragma unroll
          for (int i = 0; i < 8; ++i) { const int s = 32 * ks + 8 * g + i; fb[i] = beta_s[s]; fk[i] = fb[i] * fexp(dec_s[s]); }
#define SC2(w_, f0, f1) pk2(__builtin_bit_cast(float, (w_) << 16) * (f0), __builtin_bit_cast(float, (w_) & 0xffff0000u) * (f1))
          const u32x4_ ov = {SC2(wv.x, fb[0], fb[1]), SC2(wv.y, fb[2], fb[3]), SC2(wv.z, fb[4], fb[5]), SC2(wv.w, fb[6], fb[7])};
          const u32x4_ ok = {SC2(wk.x, fk[0], fk[1]), SC2(wk.y, fk[2], fk[3]), SC2(wk.z, fk[4], fk[5]), SC2(wk.w, fk[6], fk[7])};
#undef SC2
          bv[ks] = __builtin_bit_cast(bf16x8, ov); bk[ks] = __builtin_bit_cast(bf16x8, ok); }
#pragma unroll
      for (int tt = 0; tt < 4; ++tt) { f32x4 u = (f32x4){0.f, 0.f, 0.f, 0.f}, wv = u;
#pragma unroll
          for (int ks = 0; ks < 2; ++ks) { const bf16x8 at = frag_tr(lds + D1_OFF_T, D1_RST, 32 * ks, 16 * tt, lane); u = MFMA16(at, bv[ks], u); wv = MFMA16(at, bk[ks], wv); }
          const size_t o_ = (size_t)(16 * wave + l15) * 64 + 16 * tt + 4 * g;
          *(unsigned long long*)(UTg + o_) = (unsigned long long)pk2(u[0], u[1]) | ((unsigned long long)pk2(u[2], u[3]) << 32);
          *(unsigned long long*)(WTg + o_) = (unsigned long long)pk2(wv[0], wv[1]) | ((unsigned long long)pk2(wv[2], wv[3]) << 32); } }
    __syncthreads();
}
constexpr int D2_RSW = 144, D2_RSQ = 272, D2_RSK = 288, D2_RSP = 144, D2_RSO = 528;
constexpr int D2_OFF_W = 0, D2_OFF_Q = D2_OFF_W + 128 * D2_RSW, D2_OFF_K = D2_OFF_Q + 64 * D2_RSQ, D2_OFF_P = D2_OFF_K + 64 * D2_RSK, D2_OFF_O = D2_OFF_P + 64 * D2_RSP, D2_OFF_D = D2_OFF_O + 64 * D2_RSO, D2_LDS = D2_OFF_D + 1024;
static_assert(D2_LDS <= 163328, "D2 LDS");
template <int SKIP = 0> __device__ __forceinline__ void dn2_item(const Ptrs& P, LAS unsigned char* lds, int item, size_t yoff = WS_Y) {
    const bf16_t* __restrict__ PROJ = (const bf16_t*)(P.ws + WS_PROJ); bf16_t* __restrict__ Y = (bf16_t*)(P.ws + yoff);
    const bf16_t* __restrict__ Q2 = (const bf16_t*)(P.ws + WS_DQ2); const bf16_t* __restrict__ K2 = (const bf16_t*)(P.ws + WS_DK2);
    const int tid = threadIdx.x, lane = tid & 63, wave = tid >> 6, g = lane >> 4, l15 = lane & 15;
    const int h = item & 7, b = item >> 3;
    const size_t tok0 = (size_t)b * SEQ; const int it0 = item * 32;
    const bf16_t* __restrict__ WTg = (const bf16_t*)((const unsigned char*)P.out + OUT_DWT) + (size_t)it0 * 8192; const bf16_t* __restrict__ UTg = (const bf16_t*)((const unsigned char*)P.out + OUT_DUT) + (size_t)it0 * 8192;
    const bf16_t* __restrict__ QKg = (const bf16_t*)(P.ws + WS_DQK) + (size_t)it0 * 4096; const float* __restrict__ DECg = (const float*)(P.ws + WS_DDEC) + (size_t)it0 * 64;
    LAS float* ed_s = (LAS float*)(lds + D2_OFF_D); LAS float* ek_s = ed_s + 64; LAS float* edl_s = ed_s + 128;
    f32x4 sacc[8];
#pragma unroll
    for (int i = 0; i < 8; ++i) sacc[i] = (f32x4){0.f, 0.f, 0.f, 0.f};
    const int ot = tid >> 3, oc = (tid & 7) * 16;
    float og[16];
#pragma unroll
    for (int i = 0; i < 16; ++i) og[i] = P.in[IN_OD_ONORM][oc + i];
    v4u wreg[2], qreg[2], kreg[2], preg, zreg[2]; unsigned long long ureg[4]; float dreg = 0.f, dlreg = 0.f;
#define D2_LOAD(n) do { _Pragma("unroll") for (int i_ = 0; i_ < 2; ++i_) { const int id_ = tid + 512 * i_; wreg[i_] = *(const v4u*)(WTg + (size_t)(n) * 8192 + id_ * 8); \
            const int row_ = id_ >> 4, ch_ = id_ & 15; const size_t o2_ = (tok0 + (n) * 64 + row_) * W_D + h * 128 + ch_ * 8; qreg[i_] = *(const v4u*)(Q2 + o2_); kreg[i_] = *(const v4u*)(K2 + o2_); } \
        preg = *(const v4u*)(QKg + (size_t)(n) * 4096 + tid * 8); \
        _Pragma("unroll") for (int tt_ = 0; tt_ < 4; ++tt_) ureg[tt_] = *(const unsigned long long*)(UTg + (size_t)(n) * 8192 + (16 * wave + l15) * 64 + 16 * tt_ + 4 * g); \
        if (tid < 64) { dreg = DECg[(n) * 64 + tid]; dlreg = DECg[(n) * 64 + 63]; } } while (0)
#define D2_LOAD_Z(n) do { const bf16_t* zp_ = PROJ + (tok0 + (n) * 64 + ot) * OD_N + OC_ZD + h * 128 + oc; zreg[0] = *(const v4u*)zp_; zreg[1] = *(const v4u*)(zp_ + 8); } while (0)
#define D2_STORE() do { _Pragma("unroll") for (int i_ = 0; i_ < 2; ++i_) { const int id_ = tid + 512 * i_; *(LAS v4u*)(lds + D2_OFF_W + (id_ >> 3) * D2_RSW + (id_ & 7) * 16) = wreg[i_]; \
            const int row_ = id_ >> 4, ch_ = id_ & 15; *(LAS v4u*)(lds + D2_OFF_Q + row_ * D2_RSQ + ch_ * 16) = qreg[i_]; *(LAS v4u*)(lds + D2_OFF_K + row_ * D2_RSK + ch_ * 16) = kreg[i_]; } \
        *(LAS v4u*)(lds + D2_OFF_P + (tid >> 3) * D2_RSP + (tid & 7) * 16) = preg; \
        if (tid < 64) { ed_s[tid] = fexp(dreg) * DN_SCALE; ek_s[tid] = fexp(dlreg - dreg); if (tid == 0) edl_s[0] = fexp(dlreg); } } while (0)
    D2_LOAD(0);
    for (int n = 0; n < NCH; ++n) {
        if constexpr (!(SKIP & 16)) D2_STORE();
        f32x4 un[4];
#pragma unroll
        for (int tt = 0; tt < 4; ++tt) { un[tt][0] = __builtin_bit_cast(float, (unsigned)(ureg[tt] & 0xffffull) << 16); un[tt][1] = __builtin_bit_cast(float, (unsigned)(ureg[tt] >> 16 & 0xffffull) << 16);
            un[tt][2] = __builtin_bit_cast(float, (unsigned)(ureg[tt] >> 32 & 0xffffull) << 16); un[tt][3] = __builtin_bit_cast(float, (unsigned)(ureg[tt] >> 48) << 16); }
        __syncthreads();
        if constexpr (!(SKIP & 16)) { if (n + 1 < NCH) D2_LOAD(n + 1); }
        bf16x8 sf[4];
#pragma unroll
        for (int j = 0; j < 4; ++j) sf[j] = acc_pair_frag(sacc[2 * j], sacc[2 * j + 1]);
        f32x4 vn[4], o[4];
#pragma unroll
        for (int tt = 0; tt < 4; ++tt) { f32x4 ws_ = (f32x4){0.f, 0.f, 0.f, 0.f}, qs_ = ws_;
#pragma unroll
            for (int j = 0; j < ((SKIP & 2) ? 0 : 4); ++j) { ws_ = MFMA16(frag_tr_perm(lds + D2_OFF_W, D2_RSW, 32 * j, 16 * tt, lane), sf[j], ws_); qs_ = MFMA16(frag_row_perm(lds + D2_OFF_Q, D2_RSQ, 16 * tt, 32 * j, lane), sf[j], qs_); }
            vn[tt] = un[tt] - ws_; o[tt] = qs_ * *(LAS const f32x4*)(ed_s + 16 * tt + 4 * g); }
        __builtin_amdgcn_sched_barrier(0);
        bf16x8 vf[2], vsf[2];
#pragma unroll
        for (int ks = 0; ks < 2; ++ks) { vf[ks] = acc_pair_frag(vn[2 * ks], vn[2 * ks + 1]);
            const f32x4 a_ = vn[2 * ks] * *(LAS const f32x4*)(ek_s + 32 * ks + 4 * g), b_ = vn[2 * ks + 1] * *(LAS const f32x4*)(ek_s + 32 * ks + 16 + 4 * g);
            vsf[ks] = acc_pair_frag(a_, b_); }
#pragma unroll
        for (int tt = 0; tt < 4; ++tt)
#pragma unroll
            for (int ks = 0; ks < ((SKIP & 4) ? 0 : 2); ++ks) o[tt] = MFMA16(frag_row_perm(lds + D2_OFF_P, D2_RSP, 16 * tt, 32 * ks, lane), vf[ks], o[tt]);
#pragma unroll
        for (int tt = 0; tt < 4; ++tt)
#pragma unroll
            for (int r = 0; r < 4; ++r) *(LAS float*)(lds + D2_OFF_O + (16 * tt + 4 * g + r) * D2_RSO + (16 * wave + l15) * 4) = o[tt][r];
        __builtin_amdgcn_sched_barrier(0);
        if constexpr (!(SKIP & 1)) D2_LOAD_Z(n);
        { const float edl = edl_s[0];
#pragma unroll
          for (int kt = 0; kt < ((SKIP & 8) ? 0 : 8); ++kt) { sacc[kt] *= edl;
#pragma unroll
              for (int ks = 0; ks < 2; ++ks) sacc[kt] = MFMA16(frag_tr_perm(lds + D2_OFF_K, D2_RSK, 32 * ks, 16 * kt, lane), vsf[ks], sacc[kt]);
              if ((kt & 3) == 3) __builtin_amdgcn_sched_barrier(0); }
#pragma unroll
          for (int kt = 0; kt < 8; ++kt) asm volatile("" : "+v"(sacc[kt])); }
        __syncthreads();
        if constexpr (!(SKIP & 1)) { f32x4 ov[4]; float ss = 0.f;
#pragma unroll
          for (int c = 0; c < 4; ++c) { ov[c] = *(LAS const f32x4*)(lds + D2_OFF_O + ot * D2_RSO + (oc + 4 * c) * 4); ss += (ov[c][0] * ov[c][0] + ov[c][1] * ov[c][1]) + (ov[c][2] * ov[c][2] + ov[c][3] * ov[c][3]); }
          ss += __shfl_xor(ss, 1); ss += __shfl_xor(ss, 2); ss += __shfl_xor(ss, 4);
          const float rs = frsq(ss * (1.0f / 128.0f) + EPS);
          bf16_t* yp = Y + (tok0 + n * 64 + ot) * D_MODEL + W_C + h * 128 + oc;
#pragma unroll
          for (int c = 0; c < 2; ++c) { const v4u zw = zreg[c]; const f32x4 a = ov[2 * c], b_ = ov[2 * c + 1];
#define D2_Y(ov_, gi, zx, lo) ((ov_) * rs * og[gi] * fsilu(__builtin_bit_cast(float, (lo) ? ((zx) << 16) : ((zx) & 0xffff0000u))))
              v4u yw; yw.x = pk2(D2_Y(a[0], 8 * c + 0, zw.x, 1), D2_Y(a[1], 8 * c + 1, zw.x, 0)); yw.y = pk2(D2_Y(a[2], 8 * c + 2, zw.y, 1), D2_Y(a[3], 8 * c + 3, zw.y, 0));
              yw.z = pk2(D2_Y(b_[0], 8 * c + 4, zw.z, 1), D2_Y(b_[1], 8 * c + 5, zw.z, 0)); yw.w = pk2(D2_Y(b_[2], 8 * c + 6, zw.w, 1), D2_Y(b_[3], 8 * c + 7, zw.w, 0));
#undef D2_Y
              *(v4u*)(yp + 8 * c) = yw; } }
    }
#undef D2_LOAD
#undef D2_LOAD_Z
#undef D2_STORE
    __syncthreads();
}
__device__ __forceinline__ void phase_mix0(const Ptrs& P, LAS unsigned char* lds, int G) {
    const int w = blockIdx.x;
    constexpr int NML = BATCH * H_B * 4;
    if (w < NML) mlstm_item(P, lds, w);
    else if (G - NML == 128) {
        const int wa = w - NML, bhp = wa >> 2, k0 = wa & 3;
        for (int k = 3; k >= 0; --k) attn2_item(P, lds, bhp * 16 + 4 * k + k0); }
    else { for (int item = w - NML; item < BATCH * H_A * (NCH / 2); item += G - NML) attn_item(P, lds, item); }
    if (w < NML) { const int wave = threadIdx.x >> 6, lane = threadIdx.x & 63; late_weights(P, lds, wave, lane, w * NWAVES + wave, NML * NWAVES); }
}
__device__ __forceinline__ void phase_mix1a(const Ptrs& P, LAS unsigned char* lds, int G) {
    const int w = blockIdx.x; constexpr int ND1 = BATCH * H_D * NCH, NRG = BATCH * N_BLK_C * 4;
    if (G == 256) {
        if (w < 64) { rglru_item<0>(P, lds, 192 + w); dn1_item(P, lds, 2 * w); dn1_item(P, lds, 2 * w + 1); }
        else { const int first = 128 + (w - 64) * 10; for (int i = 0; i < 10; ++i) dn1_item(P, lds, first + i); }
    } else {
        for (int it = 192 + w; it < NRG; it += G) rglru_item<0>(P, lds, it);
        for (int it = w; it < ND1; it += G) dn1_item(P, lds, it); }
}
__device__ __forceinline__ void phase_mix1b(const Ptrs& P, LAS unsigned char* lds, int G) {
    constexpr int ND2 = BATCH * H_D;
    if ((int)blockIdx.x < ND2) dn2_item(P, lds, blockIdx.x);
    else { for (int it = blockIdx.x - ND2; it < 192; it += G - ND2) rglru_item<0>(P, lds, it);
        const int wave = threadIdx.x >> 6, lane = threadIdx.x & 63; last_weight(P, lds, wave, lane, (blockIdx.x - ND2) * NWAVES + wave, (G - ND2) * NWAVES); }
}
typedef GAS unsigned gu32;
#define RLX_AGENT __ATOMIC_RELAXED, __HIP_MEMORY_SCOPE_AGENT
constexpr int CW_BAR = 4096;
static_assert((CW_BAR + XCD_BAR_WORDS) * 4 <= (int)CTL_ZERO_BYTES, "CTL words inside the memset region");
constexpr int LDS_BYTES = 163840;
constexpr int RING_OFF = 0, RING_BYTES = LDS_BYTES - 512;
constexpr int LDSCTL_OFF = RING_BYTES, MISC_OFF = LDSCTL_OFF + 320;

struct Args { Ptrs P; int ph_lo, ph_hi; };
constexpr int N_PHASES = 8;

__global__ void __launch_bounds__(NWAVES * 64, 2) fwd_mega(Args args) {
    extern __shared__ __attribute__((aligned(16))) unsigned char lds_raw[];
    LAS unsigned char* lds = (LAS unsigned char*)lds_raw;
    volatile LAS unsigned* MISC = (volatile LAS unsigned*)(lds + MISC_OFF);
    const int tid = threadIdx.x, lane = tid & 63, wave = __builtin_amdgcn_readfirstlane(tid >> 6);
    const int G = gridDim.x;
    for (int u = tid; u < (LDS_BYTES - LDSCTL_OFF) / 4; u += NWAVES * 64) ((LAS unsigned*)(lds + LDSCTL_OFF))[u] = 0u;
    __syncthreads();
    const Ptrs& P = args.P;
    gu32* ctl = (gu32*)(P.ws + WS_CTL);
    const int lo = args.ph_lo, hi = args.ph_hi;
    XcdBarrier bar; bar.bar = (unsigned*)(ctl + CW_BAR); bar.x = 0; bar.st = nullptr;
    if (hi - lo > 1) bar = xcd_barrier_post((unsigned*)(ctl + CW_BAR), MISC + 8);
#define IN(k) (lo <= (k) && (k) < hi)
#define SEAM(k) do { if (IN(k) && IN((k) + 1)) xcd_barrier(bar); } while (0)
#ifndef DUP_PHASE
#define DUP_PHASE -1
#endif
#define RUN(k) do { \
    if ((k) == 0) phase_prologue<3>(P, lds, wave, lane, blockIdx.x * NWAVES + wave, G * NWAVES); \
    else if ((k) == 1) phase_gemm<1>(P, lds, G, blockIdx.x); \
    else if ((k) == 2) phase_mix0(P, lds, G); \
    else if ((k) == 3) phase_gemm<2>(P, lds, G, blockIdx.x); \
    else if ((k) == 4) { phase_gemm<3>(P, lds, G, blockIdx.x); phase_gates_ab(P, G); } \
    else if ((k) == 5) phase_mix1a(P, lds, G); \
    else if ((k) == 6) phase_mix1b(P, lds, G); \
    else phase_gemm<4>(P, lds, G, blockIdx.x); } while (0)
#define STEP(k) do { if (IN(k)) { if ((k) == 0 && DUP_PHASE >= 6001 && DUP_PHASE <= 6002) { phase_prologue<(DUP_PHASE >= 6001 && DUP_PHASE <= 6002 ? DUP_PHASE - 6000 : 3)>(P, lds, wave, lane, blockIdx.x * NWAVES + wave, G * NWAVES); xcd_barrier(bar); } if ((k) == 5 && DUP_PHASE >= 5000 && DUP_PHASE < 5016) { for (int it_ = blockIdx.x; it_ < BATCH * H_D * NCH; it_ += G) dn1_item<(DUP_PHASE >= 5000 ? DUP_PHASE - 5000 : 0)>(P, lds, it_); xcd_barrier(bar); } RUN(k); if (DUP_PHASE == (k)) { xcd_barrier(bar); RUN(k); } \
        if ((k) == 2 && DUP_PHASE == 20) { xcd_barrier(bar); if (blockIdx.x >= 128) phase_mix0(P, lds, G); } \
        if ((k) == 2 && DUP_PHASE == 21) { xcd_barrier(bar); if (blockIdx.x < 128) phase_mix0(P, lds, G); } \
        if ((k) == 2 && DUP_PHASE >= 2000 && DUP_PHASE < 2128) { xcd_barrier(bar); if (blockIdx.x >= 128) { const int wa_ = blockIdx.x - 128; for (int k_ = 3; k_ >= 0; --k_) attn2_item<(DUP_PHASE >= 2000 ? DUP_PHASE - 2000 : 0)>(P, lds, (wa_ >> 2) * 16 + 4 * k_ + (wa_ & 3), WS_XB); } } \
        if ((k) == 2 && DUP_PHASE >= 1000 && DUP_PHASE < 1128) { xcd_barrier(bar); if (blockIdx.x < 128) mlstm_item<(DUP_PHASE >= 1000 ? DUP_PHASE - 1000 : 0)>(P, lds, blockIdx.x, WS_XB); } \
        if ((k) == 6 && DUP_PHASE >= 3000 && DUP_PHASE < 3032) { xcd_barrier(bar); if (blockIdx.x < 64) dn2_item<(DUP_PHASE >= 3000 ? DUP_PHASE - 3000 : 0)>(P, lds, blockIdx.x, 420 * MiB); } \
        if ((k) == 6 && DUP_PHASE >= 4000 && DUP_PHASE < 4032) { xcd_barrier(bar); rglru_item<(DUP_PHASE >= 4000 ? DUP_PHASE - 4000 : 0)>(P, lds, blockIdx.x, 420 * MiB); } \
        if ((k) == 5 && DUP_PHASE == 50) { xcd_barrier(bar); for (int it_ = blockIdx.x; it_ < BATCH * N_BLK_C * 4; it_ += G) rglru_item<0>(P, lds, it_); } \
        if ((k) == 5 && DUP_PHASE == 51) { xcd_barrier(bar); phase_mix1a(P, lds, G); } \
        } SEAM(k); } while (0)
    STEP(0); STEP(1); STEP(2); STEP(3); STEP(4); STEP(5); STEP(6); STEP(7);
#undef STEP
#undef RUN
#undef IN
#undef SEAM
}
extern "C" void kernel_launch(void* const* d_in, const int* in_sizes, int n_in, void* d_out, int out_size, void* d_ws, size_t ws_size, hipStream_t stream) {
    static int grid = 0;
    if (grid == 0) {
        if (n_in != 20 || in_sizes[0] != M_TOK * D_MODEL || out_size != M_TOK * D_MODEL || ws_size < WS_END) {
            fprintf(stderr, "kernel_launch: unexpected shapes: n_in %d in0 %d out %d ws %zu (need %zu)\n", n_in, n_in > 0 ? in_sizes[0] : -1, out_size, ws_size, (size_t)WS_END); grid = -1; return; }
        int dev = 0, cus = 0, per_cu = 0;
        if (hipGetDevice(&dev) != hipSuccess || hipDeviceGetAttribute(&cus, hipDeviceAttributeMultiprocessorCount, dev) != hipSuccess) { grid = -1; return; }
        if (hipFuncSetAttribute((const void*)fwd_mega, hipFuncAttributeMaxDynamicSharedMemorySize, LDS_BYTES) != hipSuccess) { fprintf(stderr, "kernel_launch: hipFuncSetAttribute failed\n"); grid = -1; return; }
        if (hipOccupancyMaxActiveBlocksPerMultiprocessor(&per_cu, (const void*)fwd_mega, NWAVES * 64, LDS_BYTES) != hipSuccess || per_cu < 1) { fprintf(stderr, "kernel_launch: occupancy query says %d blocks per CU\n", per_cu); per_cu = 1; }
        (void)hipGetLastError();
        grid = cus;
    }
    if (grid < 0) return;
    if (hipMemsetAsync((char*)d_ws + WS_CTL, 0, CTL_ZERO_BYTES, stream) != hipSuccess) { fprintf(stderr, "kernel_launch: memset failed\n"); return; }
    Args a{};
    for (int i = 0; i < 20; ++i) a.P.in[i] = (const float*)d_in[i];
    a.P.out = (float*)d_out; a.P.ws = (unsigned char*)d_ws; a.ph_lo = 0; a.ph_hi = N_PHASES;
    hipLaunchKernelGGL(fwd_mega, dim3(grid), dim3(NWAVES * 64), LDS_BYTES, stream, a);
    const hipError_t le = hipPeekAtLastError();
    if (le != hipSuccess) fprintf(stderr, "kernel_launch: launch failed: %s\n", hipGetErrorName(le));
}
```

```cpp
#include <hip/hip_runtime.h>
#include <cstdio>
#include <cstdint>
#include <cmath>
#include <type_traits>

constexpr int D_MODEL = 2048, BATCH = 8, SEQ = 2048, M_TOK = BATCH * SEQ;
constexpr int CHUNK = 64, NCH = SEQ / CHUNK;
constexpr float EPS = 1e-6f;
constexpr int HD_A = 128, W_A = 1024, H_A = 8, LOOKBACK = 8, BAND = (LOOKBACK + 1) * CHUNK, REL_MAX = 256, NREL = 2 * REL_MAX + 1;
constexpr int H_B = 4, W_B = 1024, HD_B = 256;
constexpr int W_C = 1024, N_BLK_C = 8, BLK_C = 128;
constexpr int HD_D = 128, W_D = 1024, H_D = 8;
constexpr int EV_IN = 9224, EV_N = 9216;
constexpr int OD_IN = 6160, OD_N = 6144;
constexpr int EC_QA = 0, EC_KA = 1024, EC_VA = 2048, EC_ZA = 3072, EC_QB = 4096, EC_KB = 5120, EC_VB = 6144, EC_OB = 7168, EC_ZB = 8192;
constexpr int OC_XC = 0, OC_ZC = 1024, OC_QD = 2048, OC_KD = 3072, OC_VD = 4096, OC_ZD = 5120;

constexpr size_t MiB = 1u << 20;
constexpr size_t WS_CTL = 0, CTL_ZERO_BYTES = 1 * MiB;
constexpr size_t WS_R0 = 1 * MiB;
constexpr size_t WS_SS1 = WS_R0 + 64 * 1024;
constexpr size_t WS_GIF = WS_SS1 + 64 * 1024;
constexpr size_t WS_AB = WS_GIF + 512 * 1024;
constexpr size_t WS_W1T = 4 * MiB;
constexpr size_t WS_W2T = 40 * MiB;
constexpr size_t WS_W3T = 48 * MiB;
constexpr size_t WS_W4T = 73 * MiB;
constexpr size_t WS_XB = 81 * MiB;
constexpr size_t WS_Y = 145 * MiB;
constexpr size_t WS_PROJ = 209 * MiB;
constexpr size_t WS_END = 497 * MiB;
constexpr size_t WS_FREE1 = 401 * MiB;

typedef unsigned short bf16_t;
__device__ __forceinline__ float bf2f(unsigned short v) { return __builtin_bit_cast(float, (unsigned)v << 16); }
__device__ __forceinline__ unsigned f2bf(float f) { unsigned u = __builtin_bit_cast(unsigned, f); return (u + 0x7fffu + ((u >> 16) & 1u)) >> 16; }
typedef float f32x2_t_ __attribute__((ext_vector_type(2))); typedef __bf16 bf16x2_t_ __attribute__((ext_vector_type(2)));
__device__ __forceinline__ unsigned pk2(float lo, float hi) { const f32x2_t_ v = {lo, hi}; return __builtin_bit_cast(unsigned, __builtin_convertvector(v, bf16x2_t_)); }
__device__ __forceinline__ float sigmoidf_(float x) { return 1.f / (1.f + expf(-x)); }
__device__ __forceinline__ float siluf_(float x) { return x / (1.f + expf(-x)); }
__device__ __forceinline__ float softplusf_(float x) { return fmaxf(x, 0.f) + log1pf(expf(-fabsf(x))); }
__device__ __forceinline__ float logsigmoidf_(float x) { return -softplusf_(-x); }

namespace pg8 {
#define PG8_LAS __attribute__((address_space(3)))
typedef unsigned short bf16_t;
typedef short bf16x8 __attribute__((ext_vector_type(8)));
typedef float f32x4 __attribute__((ext_vector_type(4)));
typedef unsigned u32x4 __attribute__((ext_vector_type(4)));
constexpr int BM = 256, BK = 64, HALF = 128, HTB = HALF * BK * 2  , STAGE_BYTES = 8 * HTB, NXCD = 8, WGM = 4;

__host__ __device__ __forceinline__ int lds_byte(int r, int c) { const int st = (r >> 4) * 2 + (c >> 5), rr = r & 15, cc = c & 31, ob = rr * 64 + cc * 2; return st * 1024 + (ob ^ (((ob >> 9) & 1) << 5)); }
__host__ __device__ __forceinline__ void stage_rc(int b, int& R, int& C) { const int st = b / 1024, sb = b % 1024, swz = sb ^ (((sb >> 9) & 1) << 5); R = (st >> 1) * 16 + swz / 64; C = (st & 1) * 32 + (swz % 64) / 2; }
__host__ __device__ __forceinline__ int perm32(int rho) { const int n = rho >> 4, i = rho & 15; return 8 * (i >> 2) + 4 * n + (i & 3); }

struct Unit { int pm, pn; };
struct Gemm { const bf16_t* A; const bf16_t* Bt; int M, N, K; };

struct StaticOrder {
    int nM, nN, nwg, G, c;
    __host__ __device__ void init(int M, int N, int G_, int c_) { nM = M / BM; nN = N / BM; nwg = nM * nN; G = G_; c = c_; }
    __host__ __device__ bool next(int i, Unit& u) const {
        const long L = (long)i * G + c; if (L >= nwg) return false;
        int wgid = (int)L; { const int q = nwg / NXCD, r = nwg % NXCD, xcd = wgid % NXCD, off = wgid / NXCD; wgid = (xcd < r ? xcd * (q + 1) : r * (q + 1) + (xcd - r) * q) + off; }
        const int nig = WGM * nN, gid = wgid / nig, fm = gid * WGM, gsz = (nM - fm) < WGM ? (nM - fm) : WGM;
        u.pm = fm + ((wgid % nig) % gsz); u.pn = (wgid % nig) / gsz; return true;
    }
    __device__ __forceinline__ void a_ready(const Unit&) const {}
    __device__ __forceinline__ void done(const Unit&) const {}
};

__device__ __forceinline__ unsigned cvt_pk_bf16(float lo, float hi) { unsigned r; asm volatile("v_cvt_pk_bf16_f32 %0, %1, %2" : "=v"(r) : "v"(lo), "v"(hi)); return r; }
struct EpiProj {
    static constexpr bool PERM = true, AFTER_DRAIN = false;
    bf16_t* O; int ldc; const float* rowv; int mode;
    __device__ __forceinline__ void operator()(const f32x4 (&acc)[2][2][4][2], const Unit& u, int wr, int wc, int fr, int fq) const {
        const int row0 = u.pm * BM + wr * 64 + fr; const int col0 = u.pn * BM + wc * 32 + 8 * fq;
#pragma unroll
        for (int ai = 0; ai < 2; ++ai)
#pragma unroll
            for (int m = 0; m < 4; ++m) { const int row = row0 + ai * HALF + m * 16; float sc = rowv[row]; if (mode) sc = 1.0f / sqrtf(sc * (1.0f / 2048.0f) + 1e-6f);
                bf16_t* rowp = O + (size_t)row * ldc + col0;
#pragma unroll
                for (int bj = 0; bj < 2; ++bj) { const f32x4 v0 = acc[ai][bj][m][0] * sc, v1 = acc[ai][bj][m][1] * sc;
                    u32x4 w; w.x = cvt_pk_bf16(v0[0], v0[1]); w.y = cvt_pk_bf16(v0[2], v0[3]); w.z = cvt_pk_bf16(v1[0], v1[1]); w.w = cvt_pk_bf16(v1[2], v1[3]);
                    *(u32x4*)(rowp + bj * HALF) = w; } }
    }
};
struct EpiRes {
    static constexpr bool PERM = false, AFTER_DRAIN = false;
    const float* base; const bf16_t* base16; float* out; bf16_t* xb; float* sumsq; int ldc;
    __device__ __forceinline__ void operator()(const f32x4 (&acc)[2][2][4][2], const Unit& u, int wr, int wc, int fr, int fq) const {
        typedef unsigned u32x2v __attribute__((ext_vector_type(2)));
        const int col0 = u.pn * BM + wc * 32 + 4 * fq;
#pragma unroll
        for (int ai = 0; ai < 2; ++ai)
#pragma unroll
            for (int m = 0; m < 4; ++m) { const int row = u.pm * BM + ai * HALF + wr * 64 + m * 16 + fr; const size_t off = (size_t)row * ldc + col0; float ss = 0.f;
#pragma unroll
                for (int bj = 0; bj < 2; ++bj)
#pragma unroll
                    for (int n = 0; n < 2; ++n) { f32x4 bs;
                        if (base16) { const u32x2v w_ = *(const u32x2v*)(base16 + off + bj * HALF + n * 16); bs = (f32x4){__builtin_bit_cast(float, w_.x << 16), __builtin_bit_cast(float, w_.x & 0xffff0000u), __builtin_bit_cast(float, w_.y << 16), __builtin_bit_cast(float, w_.y & 0xffff0000u)}; }
                        else bs = *(const f32x4*)(base + off + bj * HALF + n * 16);
                        const f32x4 o = bs + acc[ai][bj][m][n];
                        if (out) __builtin_nontemporal_store(o, (f32x4*)(out + off + bj * HALF + n * 16));
                        if (xb) { u32x2v w; w.x = cvt_pk_bf16(o[0], o[1]); w.y = cvt_pk_bf16(o[2], o[3]); *(u32x2v*)(xb + off + bj * HALF + n * 16) = w; }
                        ss += (o[0] * o[0] + o[1] * o[1]) + (o[2] * o[2] + o[3] * o[3]); }
                if (sumsq) { ss += __shfl_xor(ss, 16); ss += __shfl_xor(ss, 32); if (fq == 0) atomicAdd(sumsq + row, ss); } }
    }
};

template <class Epi, class Sched, bool ALIGN_EPI = false, bool SP2 = false>
__device__ __forceinline__ void gemm_phase(PG8_LAS unsigned char* lds, const Gemm g, const Sched& S, const Epi& E) {
    const int tid = threadIdx.x, wid = __builtin_amdgcn_readfirstlane(tid >> 6), lane = tid & 63, wr = wid >> 2, wc = wid & 3, fr = lane & 15, fq = lane >> 4;
    const int K = g.K, nt = K / BK;
    unsigned voffA[2], voffB[2];
#pragma unroll
    for (int i = 0; i < 2; ++i) { int R, C; stage_rc(tid * 16 + i * 8192, R, C); const int Rb = Epi::PERM ? ((R & ~31) + perm32(R & 31)) : R;
        voffA[i] = (unsigned)(R * K + C) * 2u; voffB[i] = (unsigned)(Rb * K + C) * 2u; }
    const size_t kstep = (size_t)(BK * 2);
    const size_t hstep = (size_t)HALF * K * 2;
    const size_t tstep = 2 * hstep;
    const unsigned ldsw = (unsigned)wid * 1024u;
    const int aoff = lds_byte(wr * 64 + fr, fq * 8), boff = lds_byte(wc * 32 + fr, fq * 8);
#define PG8_SA(b, h) (((b) * 2 + (h)) * HTB)
#define PG8_SB(b, h) ((4 + (b) * 2 + (h)) * HTB)
#define PG8_STAGE(bufoff, gbase, voff) do { _Pragma("unroll") for (int _i = 0; _i < 2; ++_i) \
        __builtin_amdgcn_global_load_lds((const unsigned*)((const char*)(gbase) + (voff)[_i]), (PG8_LAS unsigned*)(lds + (bufoff) + ldsw + _i * 8192), 16, 0, 0); } while (0)
#define PG8_LDA(dst, b, h) do { _Pragma("unroll") for (int m = 0; m < 4; ++m) _Pragma("unroll") for (int k = 0; k < 2; ++k) dst[m][k] = *(const PG8_LAS bf16x8*)(lds + PG8_SA(b, h) + aoff + m * 2048 + k * 1024); } while (0)
#define PG8_LDB(dst, b, h) do { _Pragma("unroll") for (int n = 0; n < 2; ++n) _Pragma("unroll") for (int k = 0; k < 2; ++k) dst[n][k] = *(const PG8_LAS bf16x8*)(lds + PG8_SB(b, h) + boff + n * 2048 + k * 1024); } while (0)
#define PG8_MMA(ai, bj, At, Bt) do { __builtin_amdgcn_s_setprio(1); _Pragma("unroll") for (int m = 0; m < 4; ++m) _Pragma("unroll") for (int n = 0; n < 2; ++n) _Pragma("unroll") for (int k = 0; k < 2; ++k) \
        acc[ai][bj][m][n] = __builtin_amdgcn_mfma_f32_16x16x32_bf16(Bt[n][k], At[m][k], acc[ai][bj][m][n], 0, 0, 0); __builtin_amdgcn_s_setprio(0); } while (0)
#define PG8_WAIT_V(n) asm volatile("s_waitcnt vmcnt(" #n ")" ::: "memory")
#define PG8_WAIT_L(n) asm volatile("s_waitcnt lgkmcnt(" #n ")" ::: "memory")
#define PG8_BAR __builtin_amdgcn_s_barrier()
#define PG8_SCHED __builtin_amdgcn_sched_barrier(0)
    Unit cur, nxt; int ui = 0;
    if (!S.next(0, cur)) return;
    f32x4 acc[2][2][4][2];
#pragma unroll
    for (int a = 0; a < 2; ++a)
#pragma unroll
        for (int b = 0; b < 2; ++b)
#pragma unroll
            for (int m = 0; m < 4; ++m)
#pragma unroll
                for (int n = 0; n < 2; ++n) acc[a][b][m][n] = (f32x4){0.f, 0.f, 0.f, 0.f};
    bf16x8 At[4][2], B0[2][2], B1[2][2];
    const char* cA = (const char*)g.A + (size_t)cur.pm * tstep; const char* cB = (const char*)g.Bt + (size_t)cur.pn * tstep;
    S.a_ready(cur);
    if constexpr (SP2) {
        PG8_STAGE(PG8_SB(0, 0), cB, voffB); PG8_STAGE(PG8_SB(0, 1), cB + hstep, voffB); PG8_STAGE(PG8_SA(0, 0), cA, voffA); PG8_STAGE(PG8_SA(0, 1), cA + hstep, voffA);
        if (wr == 1) PG8_BAR;
        PG8_WAIT_V(2); PG8_BAR;
        PG8_STAGE(PG8_SB(1, 0), cB + kstep, voffB); PG8_STAGE(PG8_SA(1, 0), cA + kstep, voffA); PG8_STAGE(PG8_SB(1, 1), cB + hstep + kstep, voffB);
        PG8_WAIT_V(6); PG8_BAR;
    } else {
        PG8_STAGE(PG8_SB(0, 0), cB, voffB); PG8_STAGE(PG8_SA(0, 0), cA, voffA); PG8_STAGE(PG8_SB(0, 1), cB + hstep, voffB); PG8_STAGE(PG8_SA(0, 1), cA + hstep, voffA);
        if (wr == 1) PG8_BAR;
        PG8_WAIT_V(4); PG8_BAR;
        PG8_STAGE(PG8_SB(1, 0), cB + kstep, voffB); PG8_STAGE(PG8_SA(1, 0), cA + kstep, voffA); PG8_STAGE(PG8_SB(1, 1), cB + hstep + kstep, voffB);
        PG8_WAIT_V(6); PG8_BAR;
    }
    for (;;) {
        const bool has_next = S.next(ui + 1, nxt);
        const char* nA = has_next ? (const char*)g.A + (size_t)nxt.pm * tstep : cA; const char* nB = has_next ? (const char*)g.Bt + (size_t)nxt.pn * tstep : cB;
        for (int t = 0; t < nt; t += 2) {
            const bool last = (t == nt - 2);
            const char* a1 = cA + (size_t)(t + 1) * kstep;
            const char* a2 = last ? nA : cA + (size_t)(t + 2) * kstep; const char* b2 = last ? nB : cB + (size_t)(t + 2) * kstep;
            const char* a3 = a2 + kstep; const char* b3 = b2 + kstep;
            if (last && has_next) S.a_ready(nxt);
            if constexpr (SP2) {
            PG8_LDB(B0, 0, 0); PG8_LDB(B1, 0, 1); PG8_SCHED; PG8_LDA(At, 0, 0); PG8_STAGE(PG8_SA(1, 1), a1 + hstep, voffA);
            PG8_WAIT_V(8); PG8_WAIT_L(0); PG8_BAR; PG8_MMA(0, 0, At, B0); PG8_MMA(0, 1, At, B1); PG8_BAR; PG8_SCHED;
            PG8_LDA(At, 0, 1); PG8_STAGE(PG8_SB(0, 0), b2, voffB); PG8_STAGE(PG8_SB(0, 1), b2 + hstep, voffB); PG8_STAGE(PG8_SA(0, 0), a2, voffA);
            PG8_WAIT_V(8); PG8_WAIT_L(0); PG8_BAR; PG8_MMA(1, 0, At, B0); PG8_MMA(1, 1, At, B1); PG8_BAR; PG8_SCHED;
            PG8_LDB(B0, 1, 0); PG8_LDB(B1, 1, 1); PG8_SCHED; PG8_LDA(At, 1, 0); PG8_STAGE(PG8_SA(0, 1), a2 + hstep, voffA);
            PG8_WAIT_V(8); PG8_WAIT_L(0); PG8_BAR; PG8_MMA(0, 0, At, B0); PG8_MMA(0, 1, At, B1); PG8_BAR; PG8_SCHED;
            PG8_LDA(At, 1, 1); PG8_STAGE(PG8_SB(1, 0), b3, voffB); PG8_STAGE(PG8_SB(1, 1), b3 + hstep, voffB); PG8_STAGE(PG8_SA(1, 0), a3, voffA);
            PG8_WAIT_V(8); PG8_WAIT_L(0); PG8_BAR; PG8_MMA(1, 0, At, B0); PG8_MMA(1, 1, At, B1); PG8_BAR; PG8_SCHED;
            } else {
            PG8_LDB(B0, 0, 0); PG8_SCHED; PG8_LDA(At, 0, 0); PG8_STAGE(PG8_SA(1, 1), a1 + hstep, voffA);
            PG8_WAIT_L(8); PG8_BAR; PG8_WAIT_L(0); PG8_MMA(0, 0, At, B0); PG8_BAR; PG8_SCHED;
            PG8_LDB(B1, 0, 1); PG8_STAGE(PG8_SB(0, 0), b2, voffB);
            PG8_BAR; PG8_WAIT_L(0); PG8_MMA(0, 1, At, B1); PG8_BAR;
            PG8_LDA(At, 0, 1); PG8_STAGE(PG8_SA(0, 0), a2, voffA);
            PG8_BAR; PG8_WAIT_L(0); PG8_MMA(1, 0, At, B0); PG8_BAR; PG8_SCHED;
            PG8_STAGE(PG8_SB(0, 1), b2 + hstep, voffB);
            PG8_WAIT_V(6); PG8_BAR; PG8_MMA(1, 1, At, B1); PG8_BAR;
            PG8_LDB(B0, 1, 0); PG8_SCHED; PG8_LDA(At, 1, 0); PG8_STAGE(PG8_SA(0, 1), a2 + hstep, voffA);
            PG8_WAIT_L(8); PG8_BAR; PG8_WAIT_L(0); PG8_MMA(0, 0, At, B0); PG8_BAR; PG8_SCHED;
            PG8_LDB(B1, 1, 1); PG8_STAGE(PG8_SB(1, 0), b3, voffB);
            PG8_BAR; PG8_WAIT_L(0); PG8_MMA(0, 1, At, B1); PG8_BAR;
            PG8_LDA(At, 1, 1); PG8_STAGE(PG8_SA(1, 0), a3, voffA);
            PG8_BAR; PG8_WAIT_L(0); PG8_MMA(1, 0, At, B0); PG8_BAR; PG8_SCHED;
            PG8_STAGE(PG8_SB(1, 1), b3 + hstep, voffB);
            PG8_WAIT_V(6); PG8_BAR; PG8_MMA(1, 1, At, B1); PG8_BAR;
            }
        }
        if constexpr (ALIGN_EPI) { if (wr == 0) PG8_BAR; }
        if constexpr (!Epi::AFTER_DRAIN) { E(acc, cur, wr, wc, fr, fq); S.done(cur); }
        if (!has_next) break;
#pragma unroll
        for (int a = 0; a < 2; ++a)
#pragma unroll
            for (int b = 0; b < 2; ++b)
#pragma unroll
                for (int m = 0; m < 4; ++m)
#pragma unroll
                    for (int n = 0; n < 2; ++n) acc[a][b][m][n] = (f32x4){0.f, 0.f, 0.f, 0.f};
        cur = nxt; cA = nA; cB = nB; ++ui;
        if constexpr (ALIGN_EPI) { if (wr == 1) PG8_BAR; }
    }
    PG8_WAIT_V(0);
    if constexpr (!ALIGN_EPI) { if (wr == 0) PG8_BAR; }
    PG8_BAR;
    if constexpr (Epi::AFTER_DRAIN) { E.fused(acc, cur, wr, wc, fr, fq, lds, wid, lane); S.done(cur); }
#undef PG8_SA
#undef PG8_SB
#undef PG8_STAGE
#undef PG8_LDA
#undef PG8_LDB
#undef PG8_MMA
#undef PG8_WAIT_V
#undef PG8_WAIT_L
#undef PG8_BAR
#undef PG8_SCHED
}
}
#define GAS __attribute__((address_space(1)))
#define LAS __attribute__((address_space(3)))
typedef unsigned v4u __attribute__((ext_vector_type(4)));
typedef float f32x4 __attribute__((ext_vector_type(4)));
#define LDS_WAIT() asm volatile("s_waitcnt lgkmcnt(0)" ::: "memory")
constexpr int NWAVES = 8;
constexpr int GEMM_LDS = 131072;

struct Ptrs {
    const float* in[20]; float* out; unsigned char* ws;
};
#define IN_X 0
#define IN_EV_NORM 1
#define IN_EV_WIN 2
#define IN_EV_IFB 3
#define IN_EV_QNG 4
#define IN_EV_KNG 5
#define IN_EV_REL 6
#define IN_EV_WOUT 7
#define IN_OD_NORM 8
#define IN_OD_WIN 9
#define IN_OD_CCW 10
#define IN_OD_CCB 11
#define IN_OD_GW 12
#define IN_OD_GB 13
#define IN_OD_LAM 14
#define IN_OD_CDW 15
#define IN_OD_ALOG 16
#define IN_OD_DTB 17
#define IN_OD_ONORM 18
#define IN_OD_WOUT 19

__device__ __forceinline__ float frsq_(float x) { return __builtin_amdgcn_rsqf(x); }
__device__ __forceinline__ float wave_sum(float v) {
#pragma unroll
    for (int o = 1; o < 64; o <<= 1) v += __shfl_xor(v, o);
    return v;
}
struct TrItem { const float* W; const float* gain; bf16_t* WT; int ldw, nblk, item; };
__device__ __forceinline__ void p0_tr_load(const TrItem& t, float (&r)[32], int lane) {
    const int kb = t.item / t.nblk, nb = t.item % t.nblk, k0 = 64 * kb, n0 = 32 * nb;
#pragma unroll
    for (int i = 0; i < 32; ++i) { const int kk = 2 * i + (lane >> 5); r[i] = __builtin_nontemporal_load(t.W + (size_t)(k0 + kk) * t.ldw + n0 + (lane & 31)); }
}
__device__ __forceinline__ void p0_tr_store(const TrItem& t, const float (&r)[32], LAS float* scr, int lane) {
    const int kb = t.item / t.nblk, nb = t.item % t.nblk, k0 = 64 * kb, n0 = 32 * nb; constexpr int K = D_MODEL;
#pragma unroll
    for (int i = 0; i < 32; ++i) { const int kk = 2 * i + (lane >> 5); const float g = t.gain ? t.gain[k0 + kk] : 1.0f; scr[kk * 33 + (lane & 31)] = g * r[i]; }
    LDS_WAIT(); asm volatile("" ::: "memory");
    const int c = lane & 7;
#pragma unroll
    for (int j = 0; j < 4; ++j) { const int n = (lane >> 3) + 8 * j; const LAS float* s = scr + (8 * c) * 33 + n;
        v4u o; o.x = pk2(s[0 * 33], s[1 * 33]); o.y = pk2(s[2 * 33], s[3 * 33]); o.z = pk2(s[4 * 33], s[5 * 33]); o.w = pk2(s[6 * 33], s[7 * 33]);
        *(GAS v4u*)(t.WT + (size_t)(n0 + n) * K + k0 + 8 * c) = o; }
    LDS_WAIT(); asm volatile("" ::: "memory");
}
__device__ __forceinline__ void p0_transposes(const Ptrs& P, LAS float* scr, int lane, int gw, int NGW, int it0, int it1) {
    unsigned char* ws = P.ws;
    bf16_t* W1T = (bf16_t*)(ws + WS_W1T); bf16_t* W2T = (bf16_t*)(ws + WS_W2T); bf16_t* W3T = (bf16_t*)(ws + WS_W3T); bf16_t* W4T = (bf16_t*)(ws + WS_W4T);
    constexpr int I1 = (D_MODEL / 64) * (EV_N / 32), I2 = (D_MODEL / 64) * (D_MODEL / 32), I3 = (D_MODEL / 64) * (OD_N / 32);
    auto mk = [&](int it) { TrItem t; int r = it;
        if (r < I1) { t = TrItem{P.in[IN_EV_WIN], P.in[IN_EV_NORM], W1T, EV_IN, EV_N / 32, r}; return t; } r -= I1;
        if (r < I2) { t = TrItem{P.in[IN_EV_WOUT], nullptr, W2T, D_MODEL, D_MODEL / 32, r}; return t; } r -= I2;
        if (r < I3) { t = TrItem{P.in[IN_OD_WIN], P.in[IN_OD_NORM], W3T, OD_IN, OD_N / 32, r}; return t; } r -= I3;
        t = TrItem{P.in[IN_OD_WOUT], nullptr, W4T, D_MODEL, D_MODEL / 32, r}; return t; };
    float ra[32], rb[32]; int it = it0 + gw;
    if (it < it1) { TrItem ta = mk(it); p0_tr_load(ta, ra, lane);
        for (;;) { const int itb = it + NGW; TrItem tb = ta; const bool hb = itb < it1; if (hb) { tb = mk(itb); p0_tr_load(tb, rb, lane); }
            p0_tr_store(ta, ra, scr, lane); if (!hb) break;
            const int itc = itb + NGW; const bool hc = itc < it1; if (hc) { ta = mk(itc); p0_tr_load(ta, ra, lane); }
            p0_tr_store(tb, rb, scr, lane); if (!hc) break; it = itc; } }
}
constexpr int TR_I1 = (D_MODEL / 64) * (EV_N / 32), TR_ALL = TR_I1 + 2 * (D_MODEL / 64) * (D_MODEL / 32) + (D_MODEL / 64) * (OD_N / 32), TR_I4 = TR_ALL - (D_MODEL / 64) * (D_MODEL / 32);
constexpr int TR_MID = TR_I1 + ((TR_I4 - TR_I1) / 4) * 3;
__device__ __forceinline__ void late_weights(const Ptrs& P, LAS unsigned char* lds, int wave, int lane, int gw, int NGW, int part) {
    if (part == 1) { p0_transposes(P, (LAS float*)(lds + wave * 16384), lane, gw, NGW, TR_MID, TR_I4); return; }
    p0_transposes(P, (LAS float*)(lds + wave * 16384), lane, gw, NGW, TR_I1, part == 0 ? TR_MID : TR_I4);
    bf16_t* W3T = (bf16_t*)(P.ws + WS_W3T); const int gt = gw * 64 + lane, NT = NGW * 64;
    for (int e = gt; e < 16 * D_MODEL; e += NT) { const int j = e / D_MODEL, k = e % D_MODEL; W3T[(size_t)(OD_N + j) * D_MODEL + k] = (bf16_t)f2bf(P.in[IN_OD_NORM][k] * P.in[IN_OD_WIN][(size_t)k * OD_IN + OD_N + j]); }
}
__device__ __forceinline__ void last_weight(const Ptrs& P, LAS unsigned char* lds, int wave, int lane, int gw, int NGW) { p0_transposes(P, (LAS float*)(lds + wave * 16384), lane, gw, NGW, TR_I4, TR_ALL); }
template <int PART = 3> __device__ __forceinline__ void phase_prologue(const Ptrs& P, LAS unsigned char* lds, int wave, int lane, int gw, int NGW) {
    unsigned char* ws = P.ws;
    bf16_t* W1T = (bf16_t*)(ws + WS_W1T); bf16_t* W2T = (bf16_t*)(ws + WS_W2T); bf16_t* W3T = (bf16_t*)(ws + WS_W3T); bf16_t* W4T = (bf16_t*)(ws + WS_W4T);
    bf16_t* XB = (bf16_t*)(ws + WS_XB); float* R0 = (float*)(ws + WS_R0); float* SS1 = (float*)(ws + WS_SS1); float* GIF = (float*)(ws + WS_GIF);
    LAS float* scr = (LAS float*)(lds + wave * 16384);
    if constexpr (PART & 1) p0_transposes(P, scr, lane, gw, NGW, 0, TR_I1);
    if constexpr (!(PART & 2)) return;
    { const int gt = gw * 64 + lane, NT = NGW * 64;
      for (int e = gt; e < M_TOK; e += NT) SS1[e] = 0.f; }
    __syncthreads();
    LAS float* G8 = (LAS float*)lds;
#pragma unroll 8
    for (int e = threadIdx.x; e < D_MODEL * 8; e += NWAVES * 64) { const int k = e >> 3, j = e & 7; G8[j * D_MODEL + k] = P.in[IN_EV_NORM][k] * P.in[IN_EV_WIN][(size_t)k * EV_IN + EV_N + j]; }
    __syncthreads();
    const float* X = P.in[IN_X];
    f32x4 vnx[8];
    if (gw < M_TOK) { const GAS f32x4* xr0 = (const GAS f32x4*)(X + (size_t)gw * D_MODEL) + lane;
#pragma unroll
        for (int j = 0; j < 8; ++j) vnx[j] = __builtin_nontemporal_load(xr0 + 64 * j); }
    for (int m = gw; m < M_TOK; m += NGW) {
        float s = 0.f;
        GAS unsigned long long* o8 = (GAS unsigned long long*)(XB + (size_t)m * D_MODEL) + lane;
        f32x4 v[8];
#pragma unroll
        for (int j = 0; j < 8; ++j) v[j] = vnx[j];
        if (m + NGW < M_TOK) { const GAS f32x4* xr1 = (const GAS f32x4*)(X + (size_t)(m + NGW) * D_MODEL) + lane;
#pragma unroll
            for (int j = 0; j < 8; ++j) vnx[j] = __builtin_nontemporal_load(xr1 + 64 * j); }
#pragma unroll
        for (int j = 0; j < 8; ++j) { s += (v[j].x * v[j].x + v[j].y * v[j].y) + (v[j].z * v[j].z + v[j].w * v[j].w);
            o8[64 * j] = (unsigned long long)pk2(v[j].x, v[j].y) | ((unsigned long long)pk2(v[j].z, v[j].w) << 32); }
        const float r0 = frsq_(wave_sum(s) * (1.0f / D_MODEL) + EPS);
        float g[8];
#pragma unroll
        for (int i = 0; i < 8; ++i) g[i] = 0.f;
#pragma unroll
        for (int j = 0; j < 8; ++j) {
#pragma unroll
            for (int i = 0; i < 8; ++i) { const f32x4 gv = *(const LAS f32x4*)(G8 + i * D_MODEL + 4 * lane + 256 * j); g[i] += (v[j][0] * gv[0] + v[j][1] * gv[1]) + (v[j][2] * gv[2] + v[j][3] * gv[3]); }
            asm volatile("" : "+v"(g[0]), "+v"(g[1]), "+v"(g[2]), "+v"(g[3]), "+v"(g[4]), "+v"(g[5]), "+v"(g[6]), "+v"(g[7]) :: "memory");
        }
#pragma unroll
        for (int i = 0; i < 8; ++i) g[i] = wave_sum(g[i]);
        if (lane == 0) R0[m] = r0;
        if (lane < 8) { float gv = g[0];
#pragma unroll
            for (int i = 1; i < 8; ++i) gv = (lane == i) ? g[i] : gv;
            GIF[(size_t)m * 8 + lane] = r0 * gv + P.in[IN_EV_IFB][lane]; }
    }
}

#define XB_TMO      128
#define XB_XCNT(j)  (256  + 64 * (j))
#define XB_XSUB(j)  (1280 + 64 * (j))
#define XB_XGEN(j)  (2304 + 64 * (j))
#define XB_TOP      3328
#define XB_TOPGEN   3392
#define XCD_BAR_WORDS 3456
#define XB_SPIN_CAP (1u << 18)

__device__ __forceinline__ unsigned xb_ld(unsigned* p)              { return __hip_atomic_load(p, __ATOMIC_RELAXED, __HIP_MEMORY_SCOPE_AGENT); }
__device__ __forceinline__ unsigned xb_add(unsigned* p, unsigned v) { return __hip_atomic_fetch_add(p, v, __ATOMIC_RELAXED, __HIP_MEMORY_SCOPE_AGENT); }
__device__ __forceinline__ unsigned xb_xcc_id() { return (unsigned)__builtin_amdgcn_s_getreg((3 << 11) | 20) & 0xFu; }
#define XB_SPIN(cond, bar) do { unsigned _sp = 0; while (cond) { __builtin_amdgcn_s_sleep(1); \
    if ((++_sp & 255u) == 0u) { if (xb_ld(&(bar)[XB_TMO])) break; if (_sp > XB_SPIN_CAP) { atomicAdd(&(bar)[XB_TMO], 1u); break; } } } } while (0)

struct XcdBarrier {
    unsigned* bar; unsigned x;
    volatile LAS unsigned* st;
};

__device__ __forceinline__ XcdBarrier xcd_barrier_post(unsigned* bar, volatile LAS unsigned* st) {
    XcdBarrier b; b.bar = bar; b.x = xb_xcc_id(); b.st = st;
    if (threadIdx.x == 0) (void)xb_add(&bar[XB_XCNT(b.x)], 1u);
    return b;
}
__device__ __forceinline__ void xcd_barrier_complete(unsigned* bar, unsigned x, unsigned& nloc, unsigned& nx) {
    const unsigned G = gridDim.x * gridDim.y * gridDim.z;
    unsigned sum, cnt, mine, sp = 0u;
    for (;;) {
        sum = 0u; cnt = 0u; mine = 0u;
#pragma unroll
        for (unsigned j = 0; j < 16; ++j) { const unsigned c = xb_ld(&bar[XB_XCNT(j)]); sum += c; cnt += (c > 0u) ? 1u : 0u; mine = (j == x) ? c : mine; }
        if (sum == G) break;
        __builtin_amdgcn_s_sleep(1);
        if ((++sp & 255u) == 0u) { if (xb_ld(&bar[XB_TMO])) break; if (sp > XB_SPIN_CAP) { atomicAdd(&bar[XB_TMO], 1u); break; } }
    }
    nloc = mine > 0u ? mine : 1u; nx = cnt > 0u ? cnt : 1u;
}

__device__ __forceinline__ void xcd_barrier(const XcdBarrier& b) {
    asm volatile("s_waitcnt vmcnt(0)" ::: "memory");
    __syncthreads();
    if (threadIdx.x == 0) {
        unsigned* bar = b.bar;
        __builtin_amdgcn_s_waitcnt(0);
        unsigned nloc = b.st[0], nx = b.st[1];
        if (nloc == 0u) { xcd_barrier_complete(bar, b.x, nloc, nx); b.st[0] = nloc; b.st[1] = nx; }
        const unsigned old = xb_add(&bar[XB_XSUB(b.x)], 1u);
        const unsigned gen = old / nloc;
        if (old + 1u == (gen + 1u) * nloc) {
            __builtin_amdgcn_fence(__ATOMIC_RELEASE, "agent");
            asm volatile("s_waitcnt vmcnt(0)" ::: "memory");
            const unsigned og = xb_add(&bar[XB_TOP], 1u);
            const unsigned tg = og / nx;
            if (og + 1u == (tg + 1u) * nx) xb_add(&bar[XB_TOPGEN], 1u);
            else XB_SPIN(xb_ld(&bar[XB_TOPGEN]) == tg, bar);
            __builtin_amdgcn_fence(__ATOMIC_ACQUIRE, "agent");
            xb_add(&bar[XB_XGEN(b.x)], 1u);
            asm volatile("s_waitcnt vmcnt(0)" ::: "memory");
        } else {
            XB_SPIN(xb_ld(&bar[XB_XGEN(b.x)]) == gen, bar);
            __builtin_amdgcn_fence(__ATOMIC_ACQUIRE, "agent");
            asm volatile("s_waitcnt vmcnt(0)" ::: "memory");
        }
    }
    __syncthreads();
}
__device__ __forceinline__ void ld8bf(const bf16_t* p, float (&v)[8]) {
    const v4u w = *(const v4u*)p;
    v[0] = __builtin_bit_cast(float, w.x << 16); v[1] = __builtin_bit_cast(float, w.x & 0xffff0000u);
    v[2] = __builtin_bit_cast(float, w.y << 16); v[3] = __builtin_bit_cast(float, w.y & 0xffff0000u);
    v[4] = __builtin_bit_cast(float, w.z << 16); v[5] = __builtin_bit_cast(float, w.z & 0xffff0000u);
    v[6] = __builtin_bit_cast(float, w.w << 16); v[7] = __builtin_bit_cast(float, w.w & 0xffff0000u);
}
template <int WHICH> __device__ __forceinline__ void phase_gemm(const Ptrs& P, LAS unsigned char* lds, int G, int c) {
    unsigned char* ws = P.ws;
    bf16_t* W1T = (bf16_t*)(ws + WS_W1T); bf16_t* W2T = (bf16_t*)(ws + WS_W2T); bf16_t* W3T = (bf16_t*)(ws + WS_W3T); bf16_t* W4T = (bf16_t*)(ws + WS_W4T);
    bf16_t* XB = (bf16_t*)(ws + WS_XB); bf16_t* YB = (bf16_t*)(ws + WS_Y); bf16_t* PROJ = (bf16_t*)(ws + WS_PROJ);
    float* R0 = (float*)(ws + WS_R0); float* SS1 = (float*)(ws + WS_SS1);
    if constexpr (WHICH == 1) { pg8::Gemm g{XB, W1T, M_TOK, EV_N, D_MODEL}; pg8::EpiProj E{PROJ, EV_N, R0, 0}; pg8::StaticOrder S; S.init(g.M, g.N, G, c);
        pg8::gemm_phase<pg8::EpiProj, pg8::StaticOrder, true, true>(lds, g, S, E); }
    if constexpr (WHICH == 2) { pg8::Gemm g{YB, W2T, M_TOK, D_MODEL, D_MODEL}; pg8::EpiRes E{nullptr, XB, nullptr, XB, SS1, D_MODEL};     pg8::StaticOrder S; S.init(g.M, g.N, G, c);
        pg8::gemm_phase<pg8::EpiRes, pg8::StaticOrder, true, true>(lds, g, S, E); }
    if constexpr (WHICH == 3) { pg8::Gemm g{XB, W3T, M_TOK, OD_N, D_MODEL}; pg8::EpiProj E{PROJ, OD_N, SS1, 1}; pg8::StaticOrder S; S.init(g.M, g.N, G, c);
        pg8::gemm_phase<pg8::EpiProj, pg8::StaticOrder, true, true>(lds, g, S, E); }
    if constexpr (WHICH == 4) { pg8::Gemm g{YB, W4T, M_TOK, D_MODEL, D_MODEL}; pg8::EpiRes E{nullptr, XB, P.out, nullptr, nullptr, D_MODEL}; pg8::StaticOrder S; S.init(g.M, g.N, G, c);
        pg8::gemm_phase<pg8::EpiRes, pg8::StaticOrder, true, true>(lds, g, S, E); }
}
typedef short bf16x8 __attribute__((ext_vector_type(8)));
typedef short bf16x4 __attribute__((ext_vector_type(4)));
typedef short v4i16_t __attribute__((ext_vector_type(4)));
#define MFMA16(a, b, c) __builtin_amdgcn_mfma_f32_16x16x32_bf16((a), (b), (c), 0, 0, 0)
__device__ __forceinline__ v4i16_t lds_tr(LAS const unsigned char* p) { return __builtin_amdgcn_ds_read_tr16_b64_v4i16((LAS v4i16_t*)p); }
__device__ __forceinline__ bf16x8 frag_row(LAS const unsigned char* base, int RS, int r0, int k0, int lane) { return *(LAS const bf16x8*)(base + (r0 + (lane & 15)) * RS + (k0 + 8 * (lane >> 4)) * 2); }
__device__ __forceinline__ bf16x8 frag_row_perm(LAS const unsigned char* base, int RS, int r0, int k0, int lane) {
    LAS const unsigned char* p = base + (r0 + (lane & 15)) * RS + (k0 + 4 * (lane >> 4)) * 2;
    const bf16x4 a = *(LAS const bf16x4*)p, b = *(LAS const bf16x4*)(p + 32); return (bf16x8){a[0], a[1], a[2], a[3], b[0], b[1], b[2], b[3]}; }
__device__ __forceinline__ bf16x8 frag_tr(LAS const unsigned char* base, int RS, int k0, int c0, int lane) {
    const int g = lane >> 4, q = (lane & 15) >> 2, p = lane & 3; LAS const unsigned char* a = base + (k0 + 8 * g + q) * RS + (c0 + 4 * p) * 2;
    const v4i16_t lo = lds_tr(a), hi = lds_tr(a + 4 * RS); return (bf16x8){lo[0], lo[1], lo[2], lo[3], hi[0], hi[1], hi[2], hi[3]}; }
__device__ __forceinline__ bf16x8 frag_tr_perm(LAS const unsigned char* base, int RS, int k0, int c0, int lane) {
    const int g = lane >> 4, q = (lane & 15) >> 2, p = lane & 3; LAS const unsigned char* a = base + (k0 + 4 * g + q) * RS + (c0 + 4 * p) * 2;
    const v4i16_t lo = lds_tr(a), hi = lds_tr(a + 16 * RS); return (bf16x8){lo[0], lo[1], lo[2], lo[3], hi[0], hi[1], hi[2], hi[3]}; }
__device__ __forceinline__ bf16x8 acc_pair_frag(const f32x4& lo, const f32x4& hi) {
    const unsigned a = pk2(lo[0], lo[1]), b = pk2(lo[2], lo[3]), c = pk2(hi[0], hi[1]), d = pk2(hi[2], hi[3]);
    typedef unsigned u32x4_ __attribute__((ext_vector_type(4))); const u32x4_ w = {a, b, c, d}; return __builtin_bit_cast(bf16x8, w); }
__device__ __forceinline__ float fexp2(float x) { return __builtin_amdgcn_exp2f(x); }
constexpr float LOG2E = 1.4426950408889634f;
__device__ __forceinline__ float fexp(float x) { return __builtin_amdgcn_exp2f(x * LOG2E); }
__device__ __forceinline__ float frcp(float x) { return __builtin_amdgcn_rcpf(x); }
__device__ __forceinline__ float frsq(float x) { return __builtin_amdgcn_rsqf(x); }
__device__ __forceinline__ float fsqrt(float x) { return __builtin_amdgcn_sqrtf(x); }
__device__ __forceinline__ float fsigmoid(float x) { return __builtin_amdgcn_rcpf(1.0f + __builtin_amdgcn_exp2f(-x * LOG2E)); }
__device__ __forceinline__ float fsilu(float x) { return x * fsigmoid(x); }
__device__ __forceinline__ void phase_gates_ab(const Ptrs& P, LAS unsigned char* lds, int G) {
    unsigned char* ws = P.ws; const bf16_t* __restrict__ XB = (const bf16_t*)(ws + WS_XB); const bf16_t* __restrict__ W3T = (const bf16_t*)(ws + WS_W3T); const float* __restrict__ SS1 = (const float*)(ws + WS_SS1); float* __restrict__ AB = (float*)(ws + WS_AB);
    const int tid = threadIdx.x, lane = tid & 63, wave = tid >> 6, g = lane >> 4, l15 = lane & 15, kh = wave >> 2, wq = wave & 3;
    for (int base = 0; base < M_TOK / 16; base += 4 * G) { const int mt = base + wq * G + (int)blockIdx.x; const bool act = mt < M_TOK / 16;
        f32x4 acc = (f32x4){0.f, 0.f, 0.f, 0.f};
        if (act) { const bf16_t* ap = XB + (size_t)(mt * 16 + l15) * D_MODEL + kh * (D_MODEL / 2) + 8 * g; const bf16_t* bp = W3T + (size_t)(OD_N + l15) * D_MODEL + kh * (D_MODEL / 2) + 8 * g;
#pragma unroll 1
            for (int kb = 0; kb < D_MODEL / 64; kb += 16) { bf16x8 af[16], bfr[16];
#pragma unroll
                for (int i = 0; i < 16; ++i) { af[i] = *(const bf16x8*)(ap + 32 * (kb + i)); bfr[i] = *(const bf16x8*)(bp + 32 * (kb + i)); }
#pragma unroll
                for (int i = 0; i < 16; ++i) acc = MFMA16(af[i], bfr[i], acc); } }
        if (kh == 1) *(LAS f32x4*)(lds + (wq * 64 + lane) * 16) = acc;
        __syncthreads();
        if (kh == 0 && act) { acc += *(LAS const f32x4*)(lds + (wq * 64 + lane) * 16);
#pragma unroll
            for (int r = 0; r < 4; ++r) { const int row = mt * 16 + 4 * g + r; AB[(size_t)row * 16 + l15] = acc[r] * frsq(SS1[row] * (1.0f / D_MODEL) + EPS); } }
        __syncthreads(); }
}
#ifdef SKELETON
__device__ __forceinline__ void phase_mix0(const Ptrs& P, LAS unsigned char* lds, int G) {
    v4u* Y = (v4u*)(P.ws + WS_Y); const v4u z = {0u, 0u, 0u, 0u};
    for (size_t i = (size_t)blockIdx.x * 512 + threadIdx.x; i < (size_t)M_TOK * D_MODEL / 8; i += (size_t)G * 512) Y[i] = z;
}
__device__ __forceinline__ void phase_mix1a(const Ptrs& P, LAS unsigned char* lds, int G) { phase_mix0(P, lds, G); }
__device__ __forceinline__ void phase_mix1b(const Ptrs& P, LAS unsigned char* lds, int G) { }
#endif
constexpr int AT_RSK = 272, AT_RSV = 288, AT_KB = 64 * AT_RSK, AT_VB = 64 * AT_RSV;
constexpr int AT_OFF_K = 0, AT_OFF_V = 2 * AT_KB, AT_OFF_TBL = AT_OFF_V + 2 * AT_VB, AT_LDS = AT_OFF_TBL + 2064;
static_assert(AT_LDS <= 163328, "attention LDS");
template <int SKIP = 0> __device__ __forceinline__ void attn_item(const Ptrs& P, LAS unsigned char* lds, int item, size_t yoff = WS_Y) {
    const bf16_t* __restrict__ PROJ = (const bf16_t*)(P.ws + WS_PROJ); bf16_t* __restrict__ Y = (bf16_t*)(P.ws + yoff);
    const float* __restrict__ qn_g = P.in[IN_EV_QNG]; const float* __restrict__ kn_g = P.in[IN_EV_KNG];
    const int tid = threadIdx.x, lane = tid & 63, wave = tid >> 6, g = lane >> 4, l15 = lane & 15;
    const int cp = item & 15, h = (item >> 4) & 7, b = item >> 7;
    const int c = 2 * cp + (wave >> 2), qt = wave & 3;
    LAS float* tbl = (LAS float*)(lds + AT_OFF_TBL);
    for (int i = tid; i < NREL; i += 512) tbl[i] = P.in[IN_EV_REL][h * NREL + i] * LOG2E;
    bf16x8 qf[4];
    { const bf16_t* qp = PROJ + (size_t)(b * SEQ + c * 64 + qt * 16 + l15) * EV_N + EC_QA + h * 128 + 8 * g;
      float qv[4][8]; float ss = 0.f;
#pragma unroll
      for (int ks = 0; ks < 4; ++ks) { ld8bf(qp + 32 * ks, qv[ks]);
#pragma unroll
          for (int i = 0; i < 8; ++i) ss += qv[ks][i] * qv[ks][i]; }
      ss += __shfl_xor(ss, 16); ss += __shfl_xor(ss, 32);
      const float rs = frsq(ss * (1.0f / 128.0f) + EPS) * (0.08838834764831845f * LOG2E);
#pragma unroll
      for (int ks = 0; ks < 4; ++ks) { const float* gp = qn_g + 32 * ks + 8 * g; typedef unsigned u32x4_ __attribute__((ext_vector_type(4)));
          const u32x4_ w = {pk2(qv[ks][0] * rs * gp[0], qv[ks][1] * rs * gp[1]), pk2(qv[ks][2] * rs * gp[2], qv[ks][3] * rs * gp[3]),
                            pk2(qv[ks][4] * rs * gp[4], qv[ks][5] * rs * gp[5]), pk2(qv[ks][6] * rs * gp[6], qv[ks][7] * rs * gp[7])};
          qf[ks] = __builtin_bit_cast(bf16x8, w); } }
    f32x4 o[8];
#pragma unroll
    for (int i = 0; i < 8; ++i) o[i] = (f32x4){0.f, 0.f, 0.f, 0.f};
    float mrun = -1.0e30f, lrun = 0.f;
    const int kt_lo = (2 * cp - LOOKBACK) < 0 ? 0 : (2 * cp - LOOKBACK), kt_hi = 2 * cp + 1;
    v4u kreg[2], vreg[2];
    const int srow0 = tid >> 4, sch = tid & 15;
    float kg[8];
#pragma unroll
    for (int i = 0; i < 8; ++i) kg[i] = kn_g[sch * 8 + i];
#define AT_LOAD(kt) do { _Pragma("unroll") for (int i_ = 0; i_ < 2; ++i_) { const bf16_t* rp_ = PROJ + (size_t)(b * SEQ + (kt) * 64 + srow0 + 32 * i_) * EV_N + h * 128 + sch * 8; \
        kreg[i_] = *(const v4u*)(rp_ + EC_KA); vreg[i_] = *(const v4u*)(rp_ + EC_VA); } } while (0)
#define AT_STORE(buf) do { _Pragma("unroll") for (int i_ = 0; i_ < 2; ++i_) { const int row_ = srow0 + 32 * i_; \
        float kv_[8]; kv_[0] = __builtin_bit_cast(float, kreg[i_].x << 16); kv_[1] = __builtin_bit_cast(float, kreg[i_].x & 0xffff0000u); kv_[2] = __builtin_bit_cast(float, kreg[i_].y << 16); kv_[3] = __builtin_bit_cast(float, kreg[i_].y & 0xffff0000u); \
        kv_[4] = __builtin_bit_cast(float, kreg[i_].z << 16); kv_[5] = __builtin_bit_cast(float, kreg[i_].z & 0xffff0000u); kv_[6] = __builtin_bit_cast(float, kreg[i_].w << 16); kv_[7] = __builtin_bit_cast(float, kreg[i_].w & 0xffff0000u); \
        float ss_ = 0.f; _Pragma("unroll") for (int e_ = 0; e_ < 8; ++e_) ss_ += kv_[e_] * kv_[e_]; \
        ss_ += __shfl_xor(ss_, 1); ss_ += __shfl_xor(ss_, 2); ss_ += __shfl_xor(ss_, 4); ss_ += __shfl_xor(ss_, 8); \
        const float rs_ = frsq(ss_ * (1.0f / 128.0f) + EPS); \
        v4u w_; w_.x = pk2(kv_[0] * rs_ * kg[0], kv_[1] * rs_ * kg[1]); w_.y = pk2(kv_[2] * rs_ * kg[2], kv_[3] * rs_ * kg[3]); w_.z = pk2(kv_[4] * rs_ * kg[4], kv_[5] * rs_ * kg[5]); w_.w = pk2(kv_[6] * rs_ * kg[6], kv_[7] * rs_ * kg[7]); \
        *(LAS v4u*)(lds + AT_OFF_K + (buf) * AT_KB + row_ * AT_RSK + sch * 16) = w_; \
        *(LAS v4u*)(lds + AT_OFF_V + (buf) * AT_VB + row_ * AT_RSV + sch * 16) = vreg[i_]; } } while (0)
    AT_LOAD(kt_lo); AT_STORE(0);
    __syncthreads();
    const int qi = qt * 16 + l15;
    for (int kt = kt_lo, it = 0; kt <= kt_hi; ++kt, ++it) {
        const int buf = it & 1;
        if (kt < kt_hi) AT_LOAD(kt + 1);
        const int to = kt - (c - LOOKBACK);
        if (to >= 0 && to <= LOOKBACK) {
            LAS const unsigned char* Kb = lds + AT_OFF_K + buf * AT_KB; LAS const unsigned char* Vb = lds + AT_OFF_V + buf * AT_VB;
            f32x4 s[4];
#pragma unroll
            for (int nt = 0; nt < 4; ++nt) { s[nt] = (f32x4){0.f, 0.f, 0.f, 0.f};
#pragma unroll
                for (int ks = 0; ks < ((SKIP & 16) ? 0 : 4); ++ks) s[nt] = MFMA16(frag_row(Kb, AT_RSK, 16 * nt, 32 * ks, lane), qf[ks], s[nt]); }
            if constexpr (!(SKIP & 2)) { const int relb = LOOKBACK * CHUNK - 64 * to + qi - 4 * g;
#pragma unroll
              for (int nt = 0; nt < 4; ++nt)
#pragma unroll
                  for (int r = 0; r < 4; ++r) { int rel = relb - 16 * nt - r; rel = rel > REL_MAX ? REL_MAX : rel; s[nt][r] += tbl[rel + REL_MAX]; } }
            float tmax = fmaxf(fmaxf(s[0][0], s[0][1]), fmaxf(s[0][2], s[0][3]));
#pragma unroll
            for (int nt = 1; nt < 4; ++nt) tmax = fmaxf(tmax, fmaxf(fmaxf(s[nt][0], s[nt][1]), fmaxf(s[nt][2], s[nt][3])));
            tmax = fmaxf(tmax, __shfl_xor(tmax, 16)); tmax = fmaxf(tmax, __shfl_xor(tmax, 32));
            const float mnew = fmaxf(mrun, tmax), alpha = fexp2(mrun - mnew);
            float rsum = 0.f;
#pragma unroll
            for (int nt = 0; nt < 4; ++nt)
#pragma unroll
                for (int r = 0; r < 4; ++r) { s[nt][r] = (SKIP & 4) ? (s[nt][r] - mnew) : fexp2(s[nt][r] - mnew); rsum += s[nt][r]; }
            rsum += __shfl_xor(rsum, 16); rsum += __shfl_xor(rsum, 32);
            lrun = lrun * alpha + rsum; mrun = mnew;
            const bf16x8 pf0 = acc_pair_frag(s[0], s[1]), pf1 = acc_pair_frag(s[2], s[3]);
            float al[4];
#pragma unroll
            for (int r = 0; r < 4; ++r) al[r] = __shfl(alpha, 4 * g + r);
#pragma unroll
            for (int dt = 0; dt < ((SKIP & 8) ? 0 : 8); ++dt) { o[dt][0] *= al[0]; o[dt][1] *= al[1]; o[dt][2] *= al[2]; o[dt][3] *= al[3];
                o[dt] = MFMA16(pf0, frag_tr_perm(Vb, AT_RSV, 0, 16 * dt, lane), o[dt]);
                o[dt] = MFMA16(pf1, frag_tr_perm(Vb, AT_RSV, 32, 16 * dt, lane), o[dt]); }
        }
        if (kt < kt_hi) AT_STORE(buf ^ 1);
        __syncthreads();
    }
#undef AT_LOAD
#undef AT_STORE
    float li[4];
#pragma unroll
    for (int r = 0; r < 4; ++r) li[r] = frcp(__shfl(lrun, 4 * g + r));
#pragma unroll
    for (int r = 0; r < 4; ++r) { const size_t tok = (size_t)b * SEQ + c * 64 + qt * 16 + 4 * g + r; const bf16_t* zp = PROJ + tok * EV_N + EC_ZA + h * 128 + l15; bf16_t* yp = Y + tok * D_MODEL + h * 128 + l15;
#pragma unroll
        for (int dt = 0; dt < 8; ++dt) yp[16 * dt] = (bf16_t)f2bf(o[dt][r] * li[r] * fsilu(bf2f(zp[16 * dt]))); }
}
constexpr int A2_KB = 64 * AT_RSK, A2_VB = 64 * AT_RSV, A2_BUF = 2 * A2_KB + 2 * A2_VB;
constexpr int A2_OFF_TBL = 2 * A2_BUF, A2_LDS = A2_OFF_TBL + 2 * 2064;
static_assert(A2_LDS <= 163328, "attention (2-head) LDS");
template <int SKIP = 0> __device__ __forceinline__ void attn2_item(const Ptrs& P, LAS unsigned char* lds, int item, size_t yoff = WS_Y) {
    const bf16_t* __restrict__ PROJ = (const bf16_t*)(P.ws + WS_PROJ); bf16_t* __restrict__ Y = (yoff == ~(size_t)0) ? (bf16_t*)P.out : (bf16_t*)(P.ws + yoff);
    const float* __restrict__ qn_g = P.in[IN_EV_QNG]; const float* __restrict__ kn_g = P.in[IN_EV_KNG];
    const int tid = threadIdx.x, lane = tid & 63, wave = tid >> 6, g = lane >> 4, l15 = lane & 15;
    const int cp = item & 15, hp = (item >> 4) & 3, b = item >> 6;
    const int hs = wave >> 2, h = 2 * hp + hs, c = 2 * cp + ((wave >> 1) & 1), q0 = 32 * (wave & 1);
    LAS float* tbl = (LAS float*)(lds + A2_OFF_TBL);
    for (int i = tid; i < 2 * NREL; i += 512) { const int hh = i / NREL, r = i - hh * NREL; tbl[hh * 516 + r] = P.in[IN_EV_REL][(2 * hp + hh) * NREL + r] * LOG2E; }
    bf16x8 qf[2][4];
#pragma unroll
    for (int q = 0; q < 2; ++q) { const bf16_t* qp = PROJ + (size_t)(b * SEQ + c * 64 + q0 + 16 * q + l15) * EV_N + EC_QA + h * 128 + 8 * g;
        float qv[4][8]; float ss = 0.f;
#pragma unroll
        for (int ks = 0; ks < 4; ++ks) { ld8bf(qp + 32 * ks, qv[ks]);
#pragma unroll
            for (int i = 0; i < 8; ++i) ss += qv[ks][i] * qv[ks][i]; }
        ss += __shfl_xor(ss, 16); ss += __shfl_xor(ss, 32);
        const float rs = frsq(ss * (1.0f / 128.0f) + EPS) * (0.08838834764831845f * LOG2E);
#pragma unroll
        for (int ks = 0; ks < 4; ++ks) { const float* gp = qn_g + 32 * ks + 8 * g; typedef unsigned u32x4_ __attribute__((ext_vector_type(4)));
            const u32x4_ w = {pk2(qv[ks][0] * rs * gp[0], qv[ks][1] * rs * gp[1]), pk2(qv[ks][2] * rs * gp[2], qv[ks][3] * rs * gp[3]),
                              pk2(qv[ks][4] * rs * gp[4], qv[ks][5] * rs * gp[5]), pk2(qv[ks][6] * rs * gp[6], qv[ks][7] * rs * gp[7])};
            qf[q][ks] = __builtin_bit_cast(bf16x8, w); } }
    f32x4 o[2][8];
#pragma unroll
    for (int q = 0; q < 2; ++q)
#pragma unroll
        for (int i = 0; i < 8; ++i) o[q][i] = (f32x4){0.f, 0.f, 0.f, 0.f};
    float mrun[2] = {-1.0e30f, -1.0e30f}, lrun[2] = {0.f, 0.f};
    const int kt_lo = (2 * cp - LOOKBACK) < 0 ? 0 : (2 * cp - LOOKBACK), kt_hi = 2 * cp + 1;
    v4u kreg[2][2], vreg[2][2];
    const int srow0 = tid >> 4, sch = tid & 15;
#define A2_LOAD(kt) do { _Pragma("unroll") for (int hh_ = 0; hh_ < 2; ++hh_) _Pragma("unroll") for (int i_ = 0; i_ < 2; ++i_) { \
        const bf16_t* rp_ = PROJ + (size_t)(b * SEQ + (kt) * 64 + srow0 + 32 * i_) * EV_N + (2 * hp + hh_) * 128 + sch * 8; kreg[hh_][i_] = *(const v4u*)(rp_ + EC_KA); vreg[hh_][i_] = *(const v4u*)(rp_ + EC_VA); } } while (0)
#define A2_STORE(buf) do { _Pragma("unroll") for (int hh_ = 0; hh_ < 2; ++hh_) _Pragma("unroll") for (int i_ = 0; i_ < 2; ++i_) { const int row_ = srow0 + 32 * i_; const v4u kr_ = kreg[hh_][i_]; \
        float kv_[8]; kv_[0] = __builtin_bit_cast(float, kr_.x << 16); kv_[1] = __builtin_bit_cast(float, kr_.x & 0xffff0000u); kv_[2] = __builtin_bit_cast(float, kr_.y << 16); kv_[3] = __builtin_bit_cast(float, kr_.y & 0xffff0000u); \
        kv_[4] = __builtin_bit_cast(float, kr_.z << 16); kv_[5] = __builtin_bit_cast(float, kr_.z & 0xffff0000u); kv_[6] = __builtin_bit_cast(float, kr_.w << 16); kv_[7] = __builtin_bit_cast(float, kr_.w & 0xffff0000u); \
        float ss_ = 0.f; _Pragma("unroll") for (int e_ = 0; e_ < 8; ++e_) ss_ += kv_[e_] * kv_[e_]; \
        ss_ += __shfl_xor(ss_, 1); ss_ += __shfl_xor(ss_, 2); ss_ += __shfl_xor(ss_, 4); ss_ += __shfl_xor(ss_, 8); \
        const float rs_ = frsq(ss_ * (1.0f / 128.0f) + EPS); const f32x4 kga_ = *(const f32x4*)(kn_g + sch * 8), kgb_ = *(const f32x4*)(kn_g + sch * 8 + 4); const float kg[8] = {kga_[0], kga_[1], kga_[2], kga_[3], kgb_[0], kgb_[1], kgb_[2], kgb_[3]}; \
        v4u w_; w_.x = pk2(kv_[0] * rs_ * kg[0], kv_[1] * rs_ * kg[1]); w_.y = pk2(kv_[2] * rs_ * kg[2], kv_[3] * rs_ * kg[3]); w_.z = pk2(kv_[4] * rs_ * kg[4], kv_[5] * rs_ * kg[5]); w_.w = pk2(kv_[6] * rs_ * kg[6], kv_[7] * rs_ * kg[7]); \
        *(LAS v4u*)(lds + (buf) * A2_BUF + hh_ * A2_KB + row_ * AT_RSK + sch * 16) = w_; \
        *(LAS v4u*)(lds + (buf) * A2_BUF + 2 * A2_KB + hh_ * A2_VB + row_ * AT_RSV + sch * 16) = vreg[hh_][i_]; } } while (0)
    A2_LOAD(kt_lo); A2_STORE(0);
    __syncthreads();
    LAS const float* tb = tbl + hs * 516;
    for (int kt = kt_lo, it = 0; kt <= kt_hi; ++kt, ++it) {
        const int buf = it & 1;
        if (kt < kt_hi) A2_LOAD(kt + 1);
        const int to = kt - (c - LOOKBACK);
        if (to >= 0 && to <= LOOKBACK) {
            LAS const unsigned char* Kb = lds + buf * A2_BUF + hs * A2_KB; LAS const unsigned char* Vb = lds + buf * A2_BUF + 2 * A2_KB + hs * A2_VB;
            f32x4 s[2][4];
#pragma unroll
            for (int nt = 0; nt < 4; ++nt) { s[0][nt] = (f32x4){0.f, 0.f, 0.f, 0.f}; s[1][nt] = s[0][nt];
#pragma unroll
                for (int ks = 0; ks < 4; ++ks) { const bf16x8 kf = frag_row(Kb, AT_RSK, 16 * nt, 32 * ks, lane); s[0][nt] = MFMA16(kf, qf[0][ks], s[0][nt]); s[1][nt] = MFMA16(kf, qf[1][ks], s[1][nt]); }
                if (nt & 1) __builtin_amdgcn_sched_barrier(0); }
            bf16x8 pf[2][2]; float al[2][4]; bool updany = false;
#pragma unroll
            for (int q = 0; q < 2; ++q) {
                const int relb = LOOKBACK * CHUNK - 64 * to + (q0 + 16 * q + l15) - 4 * g;
                if (to <= 3) { const float cb = tb[2 * REL_MAX];
#pragma unroll
                    for (int nt = 0; nt < 4; ++nt) s[q][nt] += cb; }
                else if (to >= 5) { const LAS float* tp = tb + relb + REL_MAX;
#pragma unroll
                    for (int nt = 0; nt < 4; ++nt)
#pragma unroll
                        for (int r = 0; r < 4; ++r) s[q][nt][r] += tp[-(16 * nt + r)]; }
                else {
#pragma unroll
                    for (int nt = 0; nt < 4; ++nt)
#pragma unroll
                        for (int r = 0; r < 4; ++r) { int rel = relb - 16 * nt - r; rel = rel > REL_MAX ? REL_MAX : rel; s[q][nt][r] += tb[rel + REL_MAX]; } }
                float tmax = fmaxf(fmaxf(s[q][0][0], s[q][0][1]), fmaxf(s[q][0][2], s[q][0][3]));
#pragma unroll
                for (int nt = 1; nt < 4; ++nt) tmax = fmaxf(tmax, fmaxf(fmaxf(s[q][nt][0], s[q][nt][1]), fmaxf(s[q][nt][2], s[q][nt][3])));
                tmax = fmaxf(tmax, __shfl_xor(tmax, 16)); tmax = fmaxf(tmax, __shfl_xor(tmax, 32));
                const bool upd = tmax > mrun[q] + 8.0f;
                updany |= upd;
                const float mnew = upd ? tmax : mrun[q], alpha = upd ? fexp2(mrun[q] - mnew) : 1.0f;
                float rsum = 0.f;
#pragma unroll
                for (int nt = 0; nt < 4; ++nt)
#pragma unroll
                    for (int r = 0; r < 4; ++r) { s[q][nt][r] = fexp2(s[q][nt][r] - mnew); rsum += s[q][nt][r]; }
                rsum += __shfl_xor(rsum, 16); rsum += __shfl_xor(rsum, 32);
                lrun[q] = lrun[q] * alpha + rsum; mrun[q] = mnew;
                pf[q][0] = acc_pair_frag(s[q][0], s[q][1]); pf[q][1] = acc_pair_frag(s[q][2], s[q][3]);
#pragma unroll
                for (int r = 0; r < 4; ++r) al[q][r] = __shfl(alpha, 4 * g + r); }
            const bool need = __builtin_amdgcn_ballot_w64(updany) != 0ull;
#pragma unroll
            for (int dt = 0; dt < 8; ++dt) { const bf16x8 v0 = frag_tr_perm(Vb, AT_RSV, 0, 16 * dt, lane), v1 = frag_tr_perm(Vb, AT_RSV, 32, 16 * dt, lane);
#pragma unroll
                for (int q = 0; q < 2; ++q) { if (need) { o[q][dt][0] *= al[q][0]; o[q][dt][1] *= al[q][1]; o[q][dt][2] *= al[q][2]; o[q][dt][3] *= al[q][3]; }
                    o[q][dt] = MFMA16(pf[q][0], v0, o[q][dt]); o[q][dt] = MFMA16(pf[q][1], v1, o[q][dt]); }
                if (dt & 1) __builtin_amdgcn_sched_barrier(0); }
        }
        if (kt < kt_hi) A2_STORE(buf ^ 1);
        __syncthreads();
    }
#undef A2_LOAD
#undef A2_STORE
    { const int er = lane >> 1, eh = lane & 1; const size_t tok = (size_t)b * SEQ + c * 64 + q0 + er;
      const bf16_t* zp = PROJ + tok * EV_N + EC_ZA + h * 128 + 64 * eh; bf16_t* yp = Y + tok * D_MODEL + h * 128 + 64 * eh;
      v4u zw[8];
#pragma unroll
      for (int i = 0; i < 8; ++i) zw[i] = *(const v4u*)(zp + 8 * i);
      LAS unsigned char* ep = lds + wave * (32 * 272);
#pragma unroll
      for (int q = 0; q < 2; ++q) { float li[4];
#pragma unroll
          for (int r = 0; r < 4; ++r) li[r] = frcp(__shfl(lrun[q], 4 * g + r));
#pragma unroll
          for (int r = 0; r < 4; ++r)
#pragma unroll
              for (int dt = 0; dt < 8; ++dt) *(LAS unsigned short*)(ep + (16 * q + 4 * g + r) * 272 + (16 * dt + l15) * 2) = (unsigned short)(pk2(o[q][dt][r] * li[r], 0.f) & 0xffffu); }
      LDS_WAIT(); asm volatile("" ::: "memory");
#pragma unroll
      for (int i = 0; i < 8; ++i) { const v4u ow = *(LAS const v4u*)(ep + er * 272 + eh * 128 + 16 * i); const v4u z_ = zw[i];
#define A2_Y(ox, zx, lo) (__builtin_bit_cast(float, (lo) ? ((ox) << 16) : ((ox) & 0xffff0000u)) * fsilu(__builtin_bit_cast(float, (lo) ? ((zx) << 16) : ((zx) & 0xffff0000u))))
          v4u yw; yw.x = pk2(A2_Y(ow.x, z_.x, 1), A2_Y(ow.x, z_.x, 0)); yw.y = pk2(A2_Y(ow.y, z_.y, 1), A2_Y(ow.y, z_.y, 0)); yw.z = pk2(A2_Y(ow.z, z_.z, 1), A2_Y(ow.z, z_.z, 0)); yw.w = pk2(A2_Y(ow.w, z_.w, 1), A2_Y(ow.w, z_.w, 0));
#undef A2_Y
          *(v4u*)(yp + 8 * i) = yw; } }
    __syncthreads();
}
constexpr int ML_RSQ = 528, ML_RSK = 544, ML_RSV = 160, ML_RSP = 144, ML_RSH = 144;
constexpr int ML_OFF_Q = 0, ML_OFF_K = ML_OFF_Q + 64 * ML_RSQ, ML_OFF_V = ML_OFF_K + 64 * ML_RSK, ML_OFF_P = ML_OFF_V + 64 * ML_RSV, ML_OFF_H = ML_OFF_P + 64 * ML_RSP, ML_OFF_S = ML_OFF_H + 64 * ML_RSH;
constexpr int ML_BC = 0, ML_AA = 2048, ML_PM = 4096, ML_MCH = 6144  , ML_BL = 6184  , ML_PL = 6216  ;
constexpr int ML_E1 = 6248, ML_E2 = ML_E1 + 64, ML_WI = ML_E2 + 64, ML_EMT = ML_WI + 64, ML_WS = ML_EMT + 64, ML_RS = ML_WS + 64, ML_QN = ML_RS + 64, ML_NV = ML_QN + 64, ML_NP = ML_NV + 256, ML_WC = ML_NP + 512, ML_LDS = ML_OFF_S + (ML_WC + 4) * 4;
static_assert(ML_LDS <= 163328, "mLSTM LDS");
template <int SKIP = 0> __device__ __forceinline__ void mlstm_item(const Ptrs& P, LAS unsigned char* lds, int item, size_t yoff = WS_Y) {
    const bf16_t* __restrict__ PROJ = (const bf16_t*)(P.ws + WS_PROJ); bf16_t* __restrict__ Y = (yoff == ~(size_t)0) ? (bf16_t*)P.out : (bf16_t*)(P.ws + yoff);   const float* __restrict__ GIF = (const float*)(P.ws + WS_GIF);
    const int tid = threadIdx.x, lane = tid & 63, wave = tid >> 6, g = lane >> 4, l15 = lane & 15;
    const int quarter = item & 3, h = (item >> 2) & 3, b = item >> 4;
    LAS float* sc = (LAS float*)(lds + ML_OFF_S);
    LAS const unsigned char* Qt = lds + ML_OFF_Q; LAS const unsigned char* Kt = lds + ML_OFF_K; LAS const unsigned char* Vt = lds + ML_OFF_V; LAS const unsigned char* Ps = lds + ML_OFF_P;
    const size_t tok0 = (size_t)b * SEQ;
    f32x4 cacc[16];
#pragma unroll
    for (int i = 0; i < 16; ++i) cacc[i] = (f32x4){0.f, 0.f, 0.f, 0.f};
    if (tid < 256) sc[ML_NV + tid] = 0.f;
    for (int e = tid; e < 64 * ML_RSP / 8; e += 512) *(LAS unsigned long long*)(lds + ML_OFF_P + e * 8) = 0ull;
    float gli[4], gfp[4];
#pragma unroll
    for (int i = 0; i < 4; ++i) { const size_t tok = tok0 + (wave * 4 + i) * 64 + lane; gli[i] = GIF[tok * 8 + h]; gfp[i] = GIF[tok * 8 + 4 + h]; }
#pragma unroll
    for (int i = 0; i < 4; ++i) { const int c = wave * 4 + i;
        const float li = gli[i], lf = logsigmoidf_(gfp[i]);
        float bc = lf;
#pragma unroll
        for (int o = 1; o < 64; o <<= 1) { const float t_ = __shfl_up(bc, o); if (lane >= o) bc += t_; }
        const float as = li - bc; float pm = as;
#pragma unroll
        for (int o = 1; o < 64; o <<= 1) { const float t_ = __shfl_up(pm, o); if (lane >= o) pm = fmaxf(pm, t_); }
        sc[ML_BC + c * 64 + lane] = bc; sc[ML_AA + c * 64 + lane] = as; sc[ML_PM + c * 64 + lane] = pm;
        if (lane == 63) { sc[ML_BL + c] = bc; sc[ML_PL + c] = pm; } }
    __syncthreads();
    if (tid == 0) { float m = 0.f; sc[ML_MCH] = 0.f;
        for (int c = 0; c < NCH; ++c) { m = sc[ML_BL + c] + fmaxf(m, sc[ML_PL + c]); sc[ML_MCH + c + 1] = m; } }
    v4u qreg[4], kreg[4], vreg, oreg, zreg, onx, znx;
    const int ot = tid >> 3, oc = (tid & 7) * 8, ocol = h * 256 + quarter * 64 + oc;
#define ML_LOAD(n) do { _Pragma("unroll") for (int i_ = 0; i_ < 4; ++i_) { const int id_ = tid + 512 * i_, row_ = id_ >> 5, ch_ = id_ & 31; const bf16_t* rp_ = PROJ + (tok0 + (n) * 64 + row_) * EV_N + h * 256 + ch_ * 8; \
            qreg[i_] = *(const v4u*)(rp_ + EC_QB); kreg[i_] = *(const v4u*)(rp_ + EC_KB); } \
        vreg = *(const v4u*)(PROJ + (tok0 + (n) * 64 + (tid >> 3)) * EV_N + EC_VB + h * 256 + quarter * 64 + (tid & 7) * 8); \
        if (!(SKIP & 1)) { const bf16_t* rp2_ = PROJ + (tok0 + (n) * 64 + ot) * EV_N + ocol; onx = *(const v4u*)(rp2_ + EC_OB); znx = *(const v4u*)(rp2_ + EC_ZB); } } while (0)
#define ML_STORE() do { _Pragma("unroll") for (int i_ = 0; i_ < 4; ++i_) { const int id_ = tid + 512 * i_, row_ = id_ >> 5, ch_ = id_ & 31; \
            *(LAS v4u*)(lds + ML_OFF_Q + row_ * ML_RSQ + ch_ * 16) = qreg[i_]; *(LAS v4u*)(lds + ML_OFF_K + row_ * ML_RSK + ch_ * 16) = kreg[i_]; } \
        *(LAS v4u*)(lds + ML_OFF_V + (tid >> 3) * ML_RSV + (tid & 7) * 16) = vreg; } while (0)
    ML_LOAD(0);
    __syncthreads();
    for (int n = 0; n < NCH; ++n) {
        if constexpr (!(SKIP & 64)) ML_STORE();
        oreg = onx; zreg = znx;
        const float m0 = sc[ML_MCH + n], m1 = sc[ML_MCH + n + 1], blast = sc[ML_BL + n];
        if (tid < 64) { const float bc = sc[ML_BC + n * 64 + tid], as = sc[ML_AA + n * 64 + tid], mx = fmaxf(m0, sc[ML_PM + n * 64 + tid]);
            sc[ML_E1 + tid] = -mx * LOG2E; sc[ML_E2 + tid] = as * LOG2E; sc[ML_WI + tid] = fexp(m0 - mx); sc[ML_EMT + tid] = fexp(-bc - mx); sc[ML_WS + tid] = fexp(as + blast - m1); sc[ML_RS + tid] = 0.f;
            if (tid == 0) sc[ML_WC] = fexp(blast + m0 - m1); }
        __syncthreads();
        if constexpr (!(SKIP & 64)) { if (n + 1 < NCH) ML_LOAD(n + 1); }
        f32x4 nu[4]; bf16x8 vf[2];
        if (wave >= 4) {
#pragma unroll 1
            for (int q = wave - 4; q < ((SKIP & 2) ? 0 : 10); q += 4) { const int tt = (q >= 6) ? 3 : (q >= 3) ? 2 : (q >= 1) ? 1 : 0; const int st = q - (tt * (tt + 1)) / 2;
                const int t = 16 * tt + l15; const float e1 = sc[ML_E1 + t];
                f32x4 s_ = (f32x4){0.f, 0.f, 0.f, 0.f};
#pragma unroll
                for (int ks = 0; ks < 8; ++ks) s_ = MFMA16(frag_row(Kt, ML_RSK, 16 * st, 32 * ks, lane), frag_row(Qt, ML_RSQ, 16 * tt, 32 * ks, lane), s_);
                float pv_[4]; float rs = 0.f;
#pragma unroll
                for (int r = 0; r < 4; ++r) { const int sidx = 16 * st + 4 * g + r; const float p = (sidx <= t) ? fexp2(e1 + sc[ML_E2 + sidx]) * s_[r] * 0.0625f : 0.f; pv_[r] = p; rs += p; }
                rs += __shfl_xor(rs, 16); rs += __shfl_xor(rs, 32);
                if (g == 0) atomicAdd((float*)(sc + ML_RS + t), rs);
                *(LAS unsigned long long*)(lds + ML_OFF_P + t * ML_RSP + (16 * st + 4 * g) * 2) = (unsigned long long)pk2(pv_[0], pv_[1]) | ((unsigned long long)pk2(pv_[2], pv_[3]) << 32); }
        } else {
#pragma unroll
            for (int tt = 0; tt < 4; ++tt) nu[tt] = (f32x4){0.f, 0.f, 0.f, 0.f};
#pragma unroll
            for (int j = 0; j < ((SKIP & 4) ? 0 : 8); ++j) { const bf16x8 cf = acc_pair_frag(cacc[2 * j], cacc[2 * j + 1]);
#pragma unroll
                for (int tt = 0; tt < 4; ++tt) nu[tt] = MFMA16(frag_row_perm(Qt, ML_RSQ, 16 * tt, 32 * j, lane), cf, nu[tt]);
                if ((j & 3) == 3) __builtin_amdgcn_sched_barrier(0); }
            if constexpr (!(SKIP & 32)) { f32x4 qna = (f32x4){0.f, 0.f, 0.f, 0.f}; const LAS float* nvc = sc + ((n & 1) ? ML_NP : ML_NV);
#pragma unroll
              for (int j = 0; j < 8; ++j) { const f32x4 n0_ = *(LAS const f32x4*)(nvc + 32 * j + 4 * g), n1_ = *(LAS const f32x4*)(nvc + 32 * j + 16 + 4 * g);
                  qna = MFMA16(frag_row_perm(Qt, ML_RSQ, 16 * wave, 32 * j, lane), acc_pair_frag(n0_, n1_), qna); }
              if (l15 == 0) *(LAS f32x4*)(sc + ML_QN + 16 * wave + 4 * g) = qna * 0.0625f; }
            __builtin_amdgcn_sched_barrier(0);
#pragma unroll
            for (int tt = 0; tt < 4; ++tt) { const f32x4 wi = *(LAS const f32x4*)(sc + ML_WI + 16 * tt + 4 * g); nu[tt] *= wi * 0.0625f; }
            __builtin_amdgcn_sched_barrier(0);
#pragma unroll
            for (int ks = 0; ks < 2; ++ks) vf[ks] = frag_tr_perm(Vt, ML_RSV, 32 * ks, 16 * wave, lane);
            const float wc = sc[ML_WC];
            bf16x8 vw[2];
#pragma unroll
            for (int ks = 0; ks < 2; ++ks) { typedef unsigned u32x4_ __attribute__((ext_vector_type(4))); const u32x4_ w = __builtin_bit_cast(u32x4_, vf[ks]);
                const f32x4 wa = *(LAS const f32x4*)(sc + ML_WS + 32 * ks + 4 * g), wb = *(LAS const f32x4*)(sc + ML_WS + 32 * ks + 16 + 4 * g);
                const u32x4_ o = {pk2(__builtin_bit_cast(float, w.x << 16) * wa[0], __builtin_bit_cast(float, w.x & 0xffff0000u) * wa[1]), pk2(__builtin_bit_cast(float, w.y << 16) * wa[2], __builtin_bit_cast(float, w.y & 0xffff0000u) * wa[3]),
                                  pk2(__builtin_bit_cast(float, w.z << 16) * wb[0], __builtin_bit_cast(float, w.z & 0xffff0000u) * wb[1]), pk2(__builtin_bit_cast(float, w.w << 16) * wb[2], __builtin_bit_cast(float, w.w & 0xffff0000u) * wb[3])};
                vw[ks] = __builtin_bit_cast(bf16x8, o); }
#pragma unroll
            for (int kt = 0; kt < ((SKIP & 8) ? 0 : 16); ++kt) { cacc[kt] *= wc;
                cacc[kt] = MFMA16(frag_tr_perm(Kt, ML_RSK, 0, 16 * kt, lane), vw[0], cacc[kt]);
                cacc[kt] = MFMA16(frag_tr_perm(Kt, ML_RSK, 32, 16 * kt, lane), vw[1], cacc[kt]);
                if ((kt & 7) == 7) __builtin_amdgcn_sched_barrier(0); }
#pragma unroll
            for (int kt = 0; kt < 16; ++kt) asm volatile("" : "+v"(cacc[kt]));
            if constexpr (!(SKIP & 32)) { bf16x8 wsf[2];
#pragma unroll
              for (int ks = 0; ks < 2; ++ks) { const f32x4 w0_ = *(LAS const f32x4*)(sc + ML_WS + 32 * ks + 4 * g), w1_ = *(LAS const f32x4*)(sc + ML_WS + 32 * ks + 16 + 4 * g); wsf[ks] = acc_pair_frag(w0_, w1_); }
              const LAS float* nvo = sc + ((n & 1) ? ML_NP : ML_NV); LAS float* nvn = sc + ((n & 1) ? ML_NV : ML_NP);
#pragma unroll
              for (int i = 0; i < 4; ++i) { const int kt = 4 * wave + i; f32x4 na = (f32x4){0.f, 0.f, 0.f, 0.f};
                  na = MFMA16(frag_tr_perm(Kt, ML_RSK, 0, 16 * kt, lane), wsf[0], na); na = MFMA16(frag_tr_perm(Kt, ML_RSK, 32, 16 * kt, lane), wsf[1], na);
                  if (l15 == 0) *(LAS f32x4*)(nvn + 16 * kt + 4 * g) = *(LAS const f32x4*)(nvo + 16 * kt + 4 * g) * wc + na; } }
        }
        __syncthreads();
        if (wave < 4) {
#pragma unroll
            for (int ks = 0; ks < ((SKIP & 16) ? 0 : 2); ++ks) {
#pragma unroll
                for (int tt = 0; tt < 4; ++tt) nu[tt] = MFMA16(frag_row_perm(Ps, ML_RSP, 16 * tt, 32 * ks, lane), vf[ks], nu[tt]); }
#pragma unroll
            for (int tt = 0; tt < 4; ++tt)
#pragma unroll
                for (int r = 0; r < 4; ++r) *(LAS unsigned short*)(lds + ML_OFF_H + (16 * tt + 4 * g + r) * ML_RSH + (16 * wave + l15) * 2) = (unsigned short)(pk2(nu[tt][r], 0.f) & 0xffffu);
            __builtin_amdgcn_sched_barrier(0);
        }
        __syncthreads();
        if constexpr (!(SKIP & 1)) { const float den = sc[ML_WI + ot] * sc[ML_QN + ot] + sc[ML_RS + ot]; const float inv = frcp(fmaxf(fabsf(den), sc[ML_EMT + ot]));
          const v4u hw = *(LAS const v4u*)(lds + ML_OFF_H + ot * ML_RSH + oc * 2); const v4u ow = oreg, zw = zreg;
#define ML_Y(hx, ox, zx, lo) (fsigmoid(__builtin_bit_cast(float, (lo) ? ((ox) << 16) : ((ox) & 0xffff0000u))) * (__builtin_bit_cast(float, (lo) ? ((hx) << 16) : ((hx) & 0xffff0000u)) * inv) * fsilu(__builtin_bit_cast(float, (lo) ? ((zx) << 16) : ((zx) & 0xffff0000u))))
          v4u yw; yw.x = pk2(ML_Y(hw.x, ow.x, zw.x, 1), ML_Y(hw.x, ow.x, zw.x, 0)); yw.y = pk2(ML_Y(hw.y, ow.y, zw.y, 1), ML_Y(hw.y, ow.y, zw.y, 0));
          yw.z = pk2(ML_Y(hw.z, ow.z, zw.z, 1), ML_Y(hw.z, ow.z, zw.z, 0)); yw.w = pk2(ML_Y(hw.w, ow.w, zw.w, 1), ML_Y(hw.w, ow.w, zw.w, 0));
#undef ML_Y
          *(v4u*)(Y + (tok0 + n * 64 + ot) * D_MODEL + W_A + ocol) = yw; }
    }
#undef ML_LOAD
#undef ML_STORE
    __syncthreads();
}
constexpr int RG_RSG = 272, RG_RSX = 272, RG_RSF = 272;
constexpr int RG_OFF_G = 0, RG_OFF_X = RG_OFF_G + 128 * RG_RSG, RG_OFF_XF = RG_OFF_X + 64 * RG_RSX, RG_OFF_SEG = RG_OFF_XF + 64 * RG_RSF, RG_OFF_H = RG_OFF_SEG + 16 * 64 * 8, RG_LDS = RG_OFF_H + 64 * RG_RSF;
static_assert(RG_LDS <= 163328, "RG-LRU LDS");
template <int SKIP = 0> __device__ __forceinline__ void rglru_item(const Ptrs& P, LAS unsigned char* lds, int item, size_t yoff = WS_Y) {
    const bf16_t* __restrict__ PROJ = (const bf16_t*)(P.ws + WS_PROJ); bf16_t* __restrict__ Y = (bf16_t*)(P.ws + yoff);
    const float* __restrict__ ccw = P.in[IN_OD_CCW]; const float* __restrict__ ccb = P.in[IN_OD_CCB]; const float* __restrict__ gw = P.in[IN_OD_GW]; const float* __restrict__ gb = P.in[IN_OD_GB]; const float* __restrict__ lam = P.in[IN_OD_LAM];
    const int tid = threadIdx.x, lane = tid & 63, wave = tid >> 6, g = lane >> 4, l15 = lane & 15;
    const int hf = item & 1, blk = (item >> 1) & 7, b = item >> 4;
    const size_t tok0 = (size_t)b * SEQ;
#pragma unroll 4
    for (int e = tid; e < 128 * 128; e += 512) { const int k = e >> 7, c = e & 127; const int d = (c < 64) ? (hf * 64 + c) : (128 + hf * 64 + c - 64);
        *(LAS unsigned short*)(lds + RG_OFF_G + k * RG_RSG + c * 2) = (unsigned short)f2bf(gw[((size_t)blk * 128 + k) * 256 + d]); }
    const int c8 = tid & 15, tq = tid >> 4, ch0 = blk * 128 + 8 * c8;
    float cw[4][8], cb[8];
#pragma unroll
    for (int i = 0; i < 8; ++i) { cb[i] = ccb[ch0 + i];
#pragma unroll
        for (int j = 0; j < 4; ++j) cw[j][i] = ccw[j * W_C + ch0 + i]; }
    const int tt = wave >> 1, cp = wave & 1, seg = 4 * tt + g;
    float gbr[2], gbi[2], sp[2], hcar[2] = {0.f, 0.f};
#pragma unroll
    for (int j = 0; j < 2; ++j) { const int cgl = blk * 128 + hf * 64 + 32 * cp + 16 * j + l15; gbr[j] = gb[cgl]; gbi[j] = gb[W_C + cgl]; sp[j] = softplusf_(-lam[cgl]); }
    v4u xin[5], zin = {0u, 0u, 0u, 0u}, zold = zin;
    const int ot = tid >> 3, oc8 = tid & 7, cgo = blk * 128 + hf * 64 + 8 * oc8;
#define RG_LOAD(n) do { _Pragma("unroll") for (int j_ = 0; j_ < 5; ++j_) { const int s_ = (n) * 64 + 2 * tq - 3 + j_; xin[j_] = *(const v4u*)(PROJ + (tok0 + (s_ >= 0 ? s_ : 0)) * OD_N + OC_XC + ch0); } \
        zin = *(const v4u*)(PROJ + (tok0 + (n) * 64 + ot) * OD_N + OC_ZC + cgo); } while (0)
#define RG_Y(hx, zx, lo) ((hx) * fsilu(__builtin_bit_cast(float, (lo) ? ((zx) << 16) : ((zx) & 0xffff0000u))))
#define RG_OUT(n_, zw) do { const size_t tok = tok0 + (n_) * 64 + ot; const LAS float* hp = (LAS const float*)(lds + RG_OFF_H + ot * RG_RSF) + 8 * oc8; const f32x4 h0 = *(LAS const f32x4*)hp, h1 = *(LAS const f32x4*)(hp + 4); \
          v4u yw; yw.x = pk2(RG_Y(h0[0], (zw).x, 1), RG_Y(h0[1], (zw).x, 0)); yw.y = pk2(RG_Y(h0[2], (zw).y, 1), RG_Y(h0[3], (zw).y, 0)); yw.z = pk2(RG_Y(h1[0], (zw).z, 1), RG_Y(h1[1], (zw).z, 0)); yw.w = pk2(RG_Y(h1[2], (zw).w, 1), RG_Y(h1[3], (zw).w, 0)); \
          *(v4u*)(Y + tok * D_MODEL + cgo) = yw; } while (0)
    RG_LOAD(0);
    __syncthreads();
    for (int n = 0; n < NCH; ++n) {
        if constexpr (!(SKIP & 1)) { float xv[2][8];
#pragma unroll
            for (int rr = 0; rr < 2; ++rr)
#pragma unroll
                for (int i = 0; i < 8; ++i) xv[rr][i] = cb[i];
#pragma unroll
            for (int j = 0; j < 4; ++j)
#pragma unroll
                for (int rr = 0; rr < 2; ++rr) { v4u w_ = xin[j + rr]; if (n == 0 && 2 * tq - 3 + j + rr < 0) w_ = (v4u){0u, 0u, 0u, 0u};
                    xv[rr][0] += cw[j][0] * __builtin_bit_cast(float, w_.x << 16); xv[rr][1] += cw[j][1] * __builtin_bit_cast(float, w_.x & 0xffff0000u); xv[rr][2] += cw[j][2] * __builtin_bit_cast(float, w_.y << 16); xv[rr][3] += cw[j][3] * __builtin_bit_cast(float, w_.y & 0xffff0000u);
                    xv[rr][4] += cw[j][4] * __builtin_bit_cast(float, w_.z << 16); xv[rr][5] += cw[j][5] * __builtin_bit_cast(float, w_.z & 0xffff0000u); xv[rr][6] += cw[j][6] * __builtin_bit_cast(float, w_.w << 16); xv[rr][7] += cw[j][7] * __builtin_bit_cast(float, w_.w & 0xffff0000u); }
#pragma unroll
            for (int rr = 0; rr < 2; ++rr) { const int t = 2 * tq + rr;
                v4u w; w.x = pk2(xv[rr][0], xv[rr][1]); w.y = pk2(xv[rr][2], xv[rr][3]); w.z = pk2(xv[rr][4], xv[rr][5]); w.w = pk2(xv[rr][6], xv[rr][7]);
                *(LAS v4u*)(lds + RG_OFF_X + t * RG_RSX + c8 * 16) = w;
                if ((c8 >> 3) == hf) { LAS float* xf = (LAS float*)(lds + RG_OFF_XF + t * RG_RSF) + 8 * (c8 & 7);
                    *(LAS f32x4*)xf = (f32x4){xv[rr][0], xv[rr][1], xv[rr][2], xv[rr][3]}; *(LAS f32x4*)(xf + 4) = (f32x4){xv[rr][4], xv[rr][5], xv[rr][6], xv[rr][7]}; } } }
        const v4u znew = zin;
        if (n + 1 < NCH) RG_LOAD(n + 1);
        __syncthreads();
        if (n > 0 && !(SKIP & 16)) RG_OUT(n - 1, zold);
        zold = znew;
        float al[2][4], hl[2][4];
        { f32x4 ar[2], ai[2];
#pragma unroll
          for (int j = 0; j < 2; ++j) { ar[j] = (f32x4){0.f, 0.f, 0.f, 0.f}; ai[j] = ar[j]; }
#pragma unroll
          for (int ks = 0; ks < ((SKIP & 2) ? 0 : 4); ++ks) { const bf16x8 xa = frag_row(lds + RG_OFF_X, RG_RSX, 16 * tt, 32 * ks, lane);
#pragma unroll
              for (int j = 0; j < 2; ++j) { ar[j] = MFMA16(xa, frag_tr(lds + RG_OFF_G, RG_RSG, 32 * ks, 32 * cp + 16 * j, lane), ar[j]);
                  ai[j] = MFMA16(xa, frag_tr(lds + RG_OFF_G, RG_RSG, 32 * ks, 64 + 32 * cp + 16 * j, lane), ai[j]); } }
          typedef float f32x2_ __attribute__((ext_vector_type(2)));
#pragma unroll
          for (int j = 0; j < 2; ++j) { const int chl = 32 * cp + 16 * j + l15;
#pragma unroll
              for (int r = 0; r < 4; ++r) { const int t = 16 * tt + 4 * g + r;
                  const float rr = fsigmoid(ar[j][r] + gbr[j]), ig = fsigmoid(ai[j][r] + gbi[j]); const float a_ = fexp(-8.0f * rr * sp[j]);
                  const float xc = *((LAS const float*)(lds + RG_OFF_XF + t * RG_RSF) + chl);
                  const float b_ = fsqrt(1.0f - a_ * a_) * (ig * xc);
                  if (r == 0) { al[j][0] = a_; hl[j][0] = b_; } else { al[j][r] = a_ * al[j][r - 1]; hl[j][r] = a_ * hl[j][r - 1] + b_; } }
              *(LAS f32x2_*)(lds + RG_OFF_SEG + (seg * 64 + chl) * 8) = (f32x2_){al[j][3], hl[j][3]}; } }
        __syncthreads();
        { typedef float f32x2_ __attribute__((ext_vector_type(2)));
#pragma unroll
          for (int j = 0; j < 2; ++j) { const int chl = 32 * cp + 16 * j + l15; float carry = hcar[j], cin = 0.f;
#pragma unroll
              for (int s2 = 0; s2 < 16; ++s2) { const f32x2_ sb = *(LAS const f32x2_*)(lds + RG_OFF_SEG + (s2 * 64 + chl) * 8); cin = (s2 == seg) ? carry : cin; carry = sb.x * carry + sb.y; }
              hcar[j] = carry;
#pragma unroll
              for (int r = 0; r < 4; ++r) *((LAS float*)(lds + RG_OFF_H + (16 * tt + 4 * g + r) * RG_RSF) + chl) = hl[j][r] + al[j][r] * cin; } }
    }
    __syncthreads();
    if constexpr (!(SKIP & 16)) RG_OUT(NCH - 1, zold);
#undef RG_LOAD
#undef RG_OUT
#undef RG_Y
    __syncthreads();
}
constexpr size_t WS_DQ2 = 4 * MiB, WS_DK2 = 36 * MiB;
constexpr size_t OUT_DWT = 0, OUT_DUT = 32 * MiB;
constexpr size_t WS_DQK = WS_FREE1, WS_DDEC = WS_FREE1 + 16 * MiB;
constexpr float DN_SCALE = 0.08838834764831845f;
template <int T> struct SolveRows {
    static __device__ __forceinline__ void run(float (&col)[32], LAS const unsigned char* Ab, int j) {
        SolveRows<T - 1>::run(col, Ab, j);
        float v = (T == j) ? 1.f : 0.f, v1 = 0.f, v2 = 0.f, v3 = 0.f;
#pragma unroll
        for (int s4 = 0; s4 < (T + 3) / 4; ++s4) { const f32x4 a = *(LAS const f32x4*)(Ab + T * 272 + 16 * s4);
            if (4 * s4 + 0 < T) v -= a[0] * col[4 * s4 + 0]; if (4 * s4 + 1 < T) v1 -= a[1] * col[4 * s4 + 1]; if (4 * s4 + 2 < T) v2 -= a[2] * col[4 * s4 + 2]; if (4 * s4 + 3 < T) v3 -= a[3] * col[4 * s4 + 3]; }
        v = (v + v1) + (v2 + v3);
        asm volatile("" : "+v"(v) :: "memory"); col[T] = v;
    }
};
template <> struct SolveRows<-1> { static __device__ __forceinline__ void run(float (&)[32], LAS const unsigned char*, int) {} };
constexpr int D1_RSQ = 272, D1_RSK = 288, D1_RSV = 288, D1_RSA = 272, D1_RST = 160;
constexpr int D1_OFF_Q = 0, D1_OFF_K = D1_OFF_Q + 64 * D1_RSQ, D1_OFF_V = D1_OFF_K + 64 * D1_RSK, D1_OFF_A = D1_OFF_V + 64 * D1_RSV, D1_OFF_T = D1_OFF_A + 64 * D1_RSA, D1_OFF_S = D1_OFF_T + 64 * D1_RST, D1_OFF_AB = D1_OFF_S + 512, D1_OFF_W = D1_OFF_AB + 512, D1_OFF_R = D1_OFF_W + 6144 + 16, D1_LDS = D1_OFF_R + 68 * 768;
#define D1_BAR() do { asm volatile("s_waitcnt lgkmcnt(0)" ::: "memory"); __builtin_amdgcn_s_barrier(); asm volatile("" ::: "memory"); } while (0)
__device__ __forceinline__ void glds16_asm(const void* gsrc, unsigned lds_dst) { unsigned keep;
    asm volatile("s_mov_b32 %0, m0\n\ts_mov_b32 m0, %2\n\ts_nop 0\n\tglobal_load_lds_dwordx4 %1, off\n\ts_mov_b32 m0, %0" : "=&s"(keep) : "v"(gsrc), "s"(lds_dst) : "memory"); }
__device__ __forceinline__ void glds4_asm(const void* gsrc, unsigned lds_dst) { unsigned keep;
    asm volatile("s_mov_b32 %0, m0\n\ts_mov_b32 m0, %2\n\ts_nop 0\n\tglobal_load_lds_dword %1, off\n\ts_mov_b32 m0, %0" : "=&s"(keep) : "v"(gsrc), "s"(lds_dst) : "memory"); }
__device__ __forceinline__ void dn1_stage(const Ptrs& P, LAS unsigned char* lds, int item, int wave, int lane) {
    const bf16_t* __restrict__ PROJ = (const bf16_t*)(P.ws + WS_PROJ); const float* __restrict__ AB = (const float*)(P.ws + WS_AB);
    const int n = item & 31, h = (item >> 5) & 7, b = item >> 8; const size_t tokb = (size_t)b * SEQ; const unsigned ldsb = __builtin_amdgcn_readfirstlane((unsigned)(size_t)lds);
    if (wave == 0) { const float* ga = AB + (tokb + n * 64 + lane) * 16 + h;
        glds4_asm(ga, ldsb + D1_OFF_AB); glds4_asm(ga + 8, ldsb + D1_OFF_AB + 256); }
    for (int i = wave; i < 51; i += 8) { const int u = 4 * i + (lane >> 4), r = u / 3, p = u - 3 * r; const int sq0 = n * 64 - 3 + r, sq = sq0 > SEQ - 1 ? SEQ - 1 : sq0;
        const bf16_t* gp = PROJ + (tokb + sq) * OD_N + OC_QD + p * W_D + h * 128 + (((lane & 15) ^ (r & 1)) * 8);
        if (sq0 < 0) gp = (const bf16_t*)(P.ws + WS_CTL + 512 * 1024) + (lane & 15) * 8;
        glds16_asm(gp, ldsb + D1_OFF_R + i * 1024); }
}
static_assert(D1_LDS <= 163328, "D1 LDS");
#define D1_ST8(ptr_, val_) do { if constexpr (WT) __hip_atomic_store((GAS unsigned long long*)(ptr_), (unsigned long long)(val_), __ATOMIC_RELAXED, __HIP_MEMORY_SCOPE_AGENT); else *(unsigned long long*)(ptr_) = (val_); } while (0)
template <int SKIP = 0, bool WT = false> __device__ __forceinline__ void dn1_item(const Ptrs& P, LAS unsigned char* lds, int item, int prev_item = -1, int next_item = -1) {
    const float* __restrict__ cdw = P.in[IN_OD_CDW];
    bf16_t* __restrict__ Q2 = (bf16_t*)(P.ws + WS_DQ2); bf16_t* __restrict__ K2 = (bf16_t*)(P.ws + WS_DK2);
    bf16_t* __restrict__ WTg = (bf16_t*)((unsigned char*)P.out + OUT_DWT) + (size_t)item * 8192; bf16_t* __restrict__ UTg = (bf16_t*)((unsigned char*)P.out + OUT_DUT) + (size_t)item * 8192;
    bf16_t* __restrict__ QKg = (bf16_t*)(P.ws + WS_DQK) + (size_t)item * 4096; float* __restrict__ DECg = (float*)(P.ws + WS_DDEC) + (size_t)item * 64;
    int tid_ = threadIdx.x; asm volatile("" : "+v"(tid_));
    const int tid = tid_, lane = tid & 63, wave = __builtin_amdgcn_readfirstlane(tid >> 6), g = lane >> 4, l15 = lane & 15;
    const int n = item & 31, h = (item >> 5) & 7, b = item >> 8;
    const size_t tok0 = (size_t)b * SEQ + n * 64;
    LAS float* beta_s = (LAS float*)(lds + D1_OFF_S); LAS float* dec_s = beta_s + 64;
    if (prev_item < 0) dn1_stage(P, lds, item, wave, lane);
    if (prev_item < 0 || (((prev_item ^ item) >> 5) & 7)) {
        for (int e = tid; e < 1536; e += 512) { const int col = e & 127; *((LAS float*)(lds + D1_OFF_W) + (e & ~127) + ((col >> 2) & 1) * 64 + (col >> 3) * 4 + (col & 3)) = cdw[(e >> 7) * W_D + h * 128 + col]; }
        if (tid < 2) *((LAS float*)(lds + D1_OFF_W) + 1536 + tid) = tid ? P.in[IN_OD_DTB][h] : P.in[IN_OD_ALOG][h]; }
    if (prev_item < 0 || (SKIP & 10)) asm volatile("s_waitcnt vmcnt(0)" ::: "memory"); else asm volatile("s_waitcnt vmcnt(8)" ::: "memory");
    D1_BAR();
    if constexpr (!(SKIP & 1)) { const int tp = tid >> 4, c16 = tid & 15, t0 = 2 * tp; float qk_[2][2][8]; float ssq[2][2] = {{0.f, 0.f}, {0.f, 0.f}};
#define LO_(w_) __builtin_bit_cast(float, (w_) << 16)
#define HI_(w_) __builtin_bit_cast(float, (w_) & 0xffff0000u)
#pragma unroll
      for (int pp = 0; pp < 3; ++pp) { const int p = (pp + 2) % 3;
          v4u xw[5]; float a[2][8];
#pragma unroll
          for (int j = 0; j < 5; ++j) xw[j] = *(LAS const v4u*)(lds + D1_OFF_R + (t0 + j) * 768 + p * 256 + ((c16 ^ (j & 1)) * 16));
#pragma unroll
          for (int rr = 0; rr < 2; ++rr)
#pragma unroll
              for (int i = 0; i < 8; ++i) a[rr][i] = 0.f;
#pragma unroll
          for (int j = 0; j < 4; ++j) { LAS const float* wl_ = (LAS const float*)(lds + D1_OFF_W) + (j * 3 + p) * 128 + c16 * 4; const f32x4 w0 = *(LAS const f32x4*)wl_, w1 = *(LAS const f32x4*)(wl_ + 64);
#pragma unroll
              for (int rr = 0; rr < 2; ++rr) { const v4u x_ = xw[j + rr];
                  a[rr][0] += w0[0] * LO_(x_.x); a[rr][1] += w0[1] * HI_(x_.x); a[rr][2] += w0[2] * LO_(x_.y); a[rr][3] += w0[3] * HI_(x_.y);
                  a[rr][4] += w1[0] * LO_(x_.z); a[rr][5] += w1[1] * HI_(x_.z); a[rr][6] += w1[2] * LO_(x_.w); a[rr][7] += w1[3] * HI_(x_.w); } }
#pragma unroll
          for (int rr = 0; rr < 2; ++rr) {
#pragma unroll
              for (int i = 0; i < 8; ++i) a[rr][i] = fsilu(a[rr][i]);
              if (p < 2) {
#pragma unroll
                  for (int i = 0; i < 8; ++i) { qk_[p][rr][i] = a[rr][i]; ssq[p][rr] += a[rr][i] * a[rr][i]; } }
              else { v4u w; w.x = pk2(a[rr][0], a[rr][1]); w.y = pk2(a[rr][2], a[rr][3]); w.z = pk2(a[rr][4], a[rr][5]); w.w = pk2(a[rr][6], a[rr][7]);
                  *(LAS v4u*)(lds + D1_OFF_V + (t0 + rr) * D1_RSV + c16 * 16) = w; } }
          asm volatile("" ::: "memory"); }
#undef LO_
#undef HI_
#pragma unroll
      for (int p = 0; p < 2; ++p)
#pragma unroll
          for (int rr = 0; rr < 2; ++rr) { float ss = ssq[p][rr]; ss += __shfl_xor(ss, 1); ss += __shfl_xor(ss, 2); ss += __shfl_xor(ss, 4); ss += __shfl_xor(ss, 8); const float rs = frsq(ss + EPS);
              v4u w; w.x = pk2(qk_[p][rr][0] * rs, qk_[p][rr][1] * rs); w.y = pk2(qk_[p][rr][2] * rs, qk_[p][rr][3] * rs); w.z = pk2(qk_[p][rr][4] * rs, qk_[p][rr][5] * rs); w.w = pk2(qk_[p][rr][6] * rs, qk_[p][rr][7] * rs);
              const int t = t0 + rr;
              const size_t go_ = (tok0 + t) * W_D + h * 128 + 8 * c16;
              if (p == 0) { *(LAS v4u*)(lds + D1_OFF_Q + t * D1_RSQ + c16 * 16) = w; if constexpr (WT) __builtin_amdgcn_raw_buffer_store_b128(w, __builtin_amdgcn_make_buffer_rsrc((void*)Q2, 0, 32 << 20, 0x00020000), (int)(go_ * 2), 0, 16); else *(v4u*)(Q2 + go_) = w; }
              else { *(LAS v4u*)(lds + D1_OFF_K + t * D1_RSK + c16 * 16) = w; if constexpr (WT) __builtin_amdgcn_raw_buffer_store_b128(w, __builtin_amdgcn_make_buffer_rsrc((void*)K2, 0, 32 << 20, 0x00020000), (int)(go_ * 2), 0, 16); else *(v4u*)(K2 + go_) = w; } } }
    if (wave == 0) { const float ab_a = *((LAS const float*)(lds + D1_OFF_AB) + lane), ab_b = *((LAS const float*)(lds + D1_OFF_AB + 256) + lane);
        const float alog_ = *((LAS const float*)(lds + D1_OFF_W) + 1536), dtb_ = *((LAS const float*)(lds + D1_OFF_W) + 1537);
        const float beta = fsigmoid(ab_b); float dc = -fexp(alog_) * softplusf_(ab_a + dtb_);
#pragma unroll
        for (int o = 1; o < 64; o <<= 1) { const float t_ = __shfl_up(dc, o); if (lane >= o) dc += t_; }
        beta_s[lane] = beta; dec_s[lane] = dc; if constexpr (WT) __hip_atomic_store((GAS unsigned*)(DECg + lane), __builtin_bit_cast(unsigned, dc), __ATOMIC_RELAXED, __HIP_MEMORY_SCOPE_AGENT); else DECg[lane] = dc; }
    D1_BAR();
    if (next_item >= 0 && !(SKIP & 32)) dn1_stage(P, lds, next_item, wave, lane);
    asm volatile("" ::: "memory");
    { const int tt = wave >> 1, t = 16 * tt + l15; const float dt_ = dec_s[t], bt = beta_s[t];
#pragma unroll
      for (int u = 0; u < 2; ++u) { const int st = 2 * (wave & 1) + u; unsigned long long qw = 0ull;
          if (st <= tt && !(SKIP & 2)) { f32x4 kk = (f32x4){0.f, 0.f, 0.f, 0.f}, qk = kk;
#pragma unroll
              for (int ks = 0; ks < 4; ++ks) { const bf16x8 a = frag_row(lds + D1_OFF_K, D1_RSK, 16 * st, 32 * ks, lane);
                  kk = MFMA16(a, frag_row(lds + D1_OFF_K, D1_RSK, 16 * tt, 32 * ks, lane), kk); qk = MFMA16(a, frag_row(lds + D1_OFF_Q, D1_RSQ, 16 * tt, 32 * ks, lane), qk); }
              f32x4 am; float qv[4];
#pragma unroll
              for (int r = 0; r < 4; ++r) { const int s = 16 * st + 4 * g + r; const float gam = (s <= t) ? fexp(dt_ - dec_s[s]) : 0.f; am[r] = (s < t) ? bt * kk[r] * gam : 0.f; qv[r] = qk[r] * gam * DN_SCALE; }
              *(LAS f32x4*)(lds + D1_OFF_A + t * D1_RSA + (16 * st + 4 * g) * 4) = am;
              qw = (unsigned long long)pk2(qv[0], qv[1]) | ((unsigned long long)pk2(qv[2], qv[3]) << 32); }
          D1_ST8(QKg + t * 64 + 16 * st + 4 * g, qw); } }
    D1_BAR();
    if (wave == 0 && !(SKIP & 4)) { const int hb = lane >> 5, j = lane & 31; float col[32];
        LAS const unsigned char* Ab = lds + D1_OFF_A + (32 * hb) * D1_RSA + (32 * hb) * 4;
        SolveRows<31>::run(col, Ab, j);
        LAS unsigned char* trow = lds + D1_OFF_T + (32 * hb + j) * D1_RST;
#pragma unroll
        for (int c = 0; c < 4; ++c) { v4u w; w.x = pk2(col[8 * c], col[8 * c + 1]); w.y = pk2(col[8 * c + 2], col[8 * c + 3]); w.z = pk2(col[8 * c + 4], col[8 * c + 5]); w.w = pk2(col[8 * c + 6], col[8 * c + 7]);
            *(LAS v4u*)(trow + (32 * hb) * 2 + 16 * c) = w;
            if (hb) *(LAS v4u*)(trow + 16 * c) = (v4u){0u, 0u, 0u, 0u}; }
        bf16x8 af[2], bfr[2];
#pragma unroll
        for (int ti = 0; ti < 2; ++ti) { LAS const unsigned char* ap = lds + D1_OFF_A + (32 + 16 * ti + l15) * D1_RSA + (8 * g) * 4; const f32x4 a0 = *(LAS const f32x4*)ap, a1 = *(LAS const f32x4*)(ap + 16);
            typedef unsigned u32x4_ __attribute__((ext_vector_type(4))); const u32x4_ w = {pk2(a0[0], a0[1]), pk2(a0[2], a0[3]), pk2(a1[0], a1[1]), pk2(a1[2], a1[3])}; af[ti] = __builtin_bit_cast(bf16x8, w); }
#pragma unroll
        for (int nj = 0; nj < 2; ++nj) bfr[nj] = frag_row(lds + D1_OFF_T, D1_RST, 16 * nj, 0, lane);
        f32x4 X[2][2];
#pragma unroll
        for (int ti = 0; ti < 2; ++ti)
#pragma unroll
            for (int nj = 0; nj < 2; ++nj) X[ti][nj] = MFMA16(af[ti], bfr[nj], ((f32x4){0.f, 0.f, 0.f, 0.f}));
        LAS const unsigned char* T11b = lds + D1_OFF_T + 32 * D1_RST + 64;
#pragma unroll
        for (int nj = 0; nj < 2; ++nj) { const bf16x8 xb = acc_pair_frag(X[0][nj], X[1][nj]);
#pragma unroll
            for (int ti = 0; ti < 2; ++ti) { const f32x4 r_ = MFMA16(frag_tr_perm(T11b, D1_RST, 0, 16 * ti, lane), xb, ((f32x4){0.f, 0.f, 0.f, 0.f}));
                *(LAS unsigned long long*)(lds + D1_OFF_T + (16 * nj + l15) * D1_RST + (32 + 16 * ti + 4 * g) * 2) = (unsigned long long)pk2(-r_[0], -r_[1]) | ((unsigned long long)pk2(-r_[2], -r_[3]) << 32); } }
    }
    D1_BAR();
    if constexpr (!(SKIP & 8)) { bf16x8 bv[2], bk[2];
#pragma unroll
      for (int ks = 0; ks < 2; ++ks) { typedef unsigned u32x4_ __attribute__((ext_vector_type(4)));
          const u32x4_ wv = __builtin_bit_cast(u32x4_, frag_tr(lds + D1_OFF_V, D1_RSV, 32 * ks, 16 * wave, lane)), wk = __builtin_bit_cast(u32x4_, frag_tr(lds + D1_OFF_K, D1_RSK, 32 * ks, 16 * wave, lane));
          float fb[8], fk[8];
#pragma unroll
          for (int i = 0; i < 8; ++i) { const int s = 32 * ks + 8 * g + i; fb[i] = beta_s[s]; fk[i] = fb[i] * fexp(dec_s[s]); }
#define SC2(w_, f0, f1) pk2(__builtin_bit_cast(float, (w_) << 16) * (f0), __builtin_bit_cast(float, (w_) & 0xffff0000u) * (f1))
          const u32x4_ ov = {SC2(wv.x, fb[0], fb[1]), SC2(wv.y, fb[2], fb[3]), SC2(wv.z, fb[4], fb[5]), SC2(wv.w, fb[6], fb[7])};
          const u32x4_ ok = {SC2(wk.x, fk[0], fk[1]), SC2(wk.y, fk[2], fk[3]), SC2(wk.z, fk[4], fk[5]), SC2(wk.w, fk[6], fk[7])};
#undef SC2
          bv[ks] = __builtin_bit_cast(bf16x8, ov); bk[ks] = __builtin_bit_cast(bf16x8, ok); }
#pragma unroll
      for (int tt = 0; tt < 4; ++tt) { f32x4 u = (f32x4){0.f, 0.f, 0.f, 0.f}, wv = u;
#pragma unroll
          for (int ks = 0; ks < 2; ++ks) { const bf16x8 at = frag_tr(lds + D1_OFF_T, D1_RST, 32 * ks, 16 * tt, lane); u = MFMA16(at, bv[ks], u); wv = MFMA16(at, bk[ks], wv); }
          const size_t o_ = (size_t)(16 * wave + l15) * 64 + 16 * tt + 4 * g;
          D1_ST8(UTg + o_, (unsigned long long)pk2(u[0], u[1]) | ((unsigned long long)pk2(u[2], u[3]) << 32));
          D1_ST8(WTg + o_, (unsigned long long)pk2(wv[0], wv[1]) | ((unsigned long long)pk2(wv[2], wv[3]) << 32)); } }
    D1_BAR();
}
constexpr int D2_RSW = 144, D2_RSQ = 272, D2_RSK = 288, D2_RSP = 144, D2_RSO = 528;
constexpr int D2_OFF_W = 0, D2_OFF_U = D2_OFF_W + 128 * D2_RSW, D2_OFF_Q = D2_OFF_U + 128 * D2_RSW, D2_OFF_P = D2_OFF_Q + 64 * D2_RSQ, D2_OFF_K = D2_OFF_P + 64 * D2_RSP, D2_KBUF = 64 * D2_RSK;
constexpr int D2_OFF_O = D2_OFF_K + 2 * D2_KBUF, D2_OFF_D = D2_OFF_O + 64 * D2_RSO, D2_LDS = D2_OFF_D + 2560;
static_assert(D2_LDS <= 163328, "D2 LDS");
constexpr int D2_LATE0 = 20;
__device__ __forceinline__ void dn2_wait_late(unsigned* late, int lane, unsigned target) {
    if (lane == 0) { unsigned sp = 0u; while (xb_ld(late) < target && ++sp < (1u << 21)) __builtin_amdgcn_s_sleep(1); }
    __builtin_amdgcn_fence(__ATOMIC_ACQUIRE, "agent"); asm volatile("s_waitcnt vmcnt(0)" ::: "memory"); }
template <int SKIP = 0> __device__ __forceinline__ void dn2_item(const Ptrs& P, LAS unsigned char* lds, int item, size_t yoff = WS_Y, unsigned* late = nullptr) {
    const bf16_t* __restrict__ PROJ = (const bf16_t*)(P.ws + WS_PROJ); bf16_t* __restrict__ Y = (bf16_t*)(P.ws + yoff);
    const bf16_t* __restrict__ Q2 = (const bf16_t*)(P.ws + WS_DQ2); const bf16_t* __restrict__ K2 = (const bf16_t*)(P.ws + WS_DK2);
    const int tid = threadIdx.x, lane = tid & 63, wave = __builtin_amdgcn_readfirstlane(tid >> 6), g = lane >> 4, l15 = lane & 15;
    const int h = item & 7, b = item >> 3;
    const size_t tok0 = (size_t)b * SEQ; const int it0 = item * 32;
    const bf16_t* __restrict__ WTg = (const bf16_t*)((const unsigned char*)P.out + OUT_DWT) + (size_t)it0 * 8192; const bf16_t* __restrict__ UTg = (const bf16_t*)((const unsigned char*)P.out + OUT_DUT) + (size_t)it0 * 8192;
    const bf16_t* __restrict__ QKg = (const bf16_t*)(P.ws + WS_DQK) + (size_t)it0 * 4096; const float* __restrict__ DECg = (const float*)(P.ws + WS_DDEC) + (size_t)it0 * 64;
    if (wave < 4) {
        f32x4 sacc[2][8];
#pragma unroll
        for (int s2 = 0; s2 < 2; ++s2)
#pragma unroll
            for (int i = 0; i < 8; ++i) sacc[s2][i] = (f32x4){0.f, 0.f, 0.f, 0.f};
        for (int n = 0; n < NCH; ++n) {
            LAS const unsigned char* tb = lds; LAS const unsigned char* kb_ = lds + D2_OFF_K + (n & 1) * D2_KBUF; LAS const float* ed_s = (LAS const float*)(lds + D2_OFF_D + (n & 1) * 1024); LAS const float* ek_s = ed_s + 64;
            __syncthreads();
            bf16x8 sf[2][4];
#pragma unroll
            for (int s2 = 0; s2 < 2; ++s2)
#pragma unroll
                for (int j = 0; j < 4; ++j) sf[s2][j] = acc_pair_frag(sacc[s2][2 * j], sacc[s2][2 * j + 1]);
            f32x4 vn[2][4], o[2][4];
#pragma unroll
            for (int tt = 0; tt < 4; ++tt) { f32x4 ws_[2], qs_[2];
#pragma unroll
                for (int s2 = 0; s2 < 2; ++s2) { ws_[s2] = (f32x4){0.f, 0.f, 0.f, 0.f}; qs_[s2] = ws_[s2]; }
#pragma unroll
                for (int j = 0; j < ((SKIP & 2) ? 0 : 4); ++j) { const bf16x8 wa = frag_tr_perm(tb + D2_OFF_W, D2_RSW, 32 * j, 16 * tt, lane), qa = frag_row_perm(tb + D2_OFF_Q, D2_RSQ, 16 * tt, 32 * j, lane);
#pragma unroll
                    for (int s2 = 0; s2 < 2; ++s2) { ws_[s2] = MFMA16(wa, sf[s2][j], ws_[s2]); qs_[s2] = MFMA16(qa, sf[s2][j], qs_[s2]); } }
                const f32x4 edv = *(LAS const f32x4*)(ed_s + 16 * tt + 4 * g);
#pragma unroll
                for (int s2 = 0; s2 < 2; ++s2) { const unsigned long long uw = *(LAS const unsigned long long*)(lds + D2_OFF_U + (32 * wave + 16 * s2 + l15) * D2_RSW + (16 * tt + 4 * g) * 2);
                    const f32x4 un = {__builtin_bit_cast(float, (unsigned)(uw & 0xffffull) << 16), __builtin_bit_cast(float, (unsigned)(uw >> 16 & 0xffffull) << 16), __builtin_bit_cast(float, (unsigned)(uw >> 32 & 0xffffull) << 16), __builtin_bit_cast(float, (unsigned)(uw >> 48) << 16)};
                    vn[s2][tt] = un - ws_[s2]; o[s2][tt] = qs_[s2] * edv; }
                if (tt & 1) __builtin_amdgcn_sched_barrier(0); }
            bf16x8 vf[2][2], vsf[2][2];
#pragma unroll
            for (int ks = 0; ks < 2; ++ks) { const f32x4 e0 = *(LAS const f32x4*)(ek_s + 32 * ks + 4 * g), e1 = *(LAS const f32x4*)(ek_s + 32 * ks + 16 + 4 * g);
#pragma unroll
                for (int s2 = 0; s2 < 2; ++s2) { vf[s2][ks] = acc_pair_frag(vn[s2][2 * ks], vn[s2][2 * ks + 1]); vsf[s2][ks] = acc_pair_frag(vn[s2][2 * ks] * e0, vn[s2][2 * ks + 1] * e1); } }
#pragma unroll
            for (int tt = 0; tt < ((SKIP & 4) ? 0 : 4); ++tt)
#pragma unroll
                for (int ks = 0; ks < 2; ++ks) { const bf16x8 pa = frag_row_perm(tb + D2_OFF_P, D2_RSP, 16 * tt, 32 * ks, lane);
#pragma unroll
                    for (int s2 = 0; s2 < 2; ++s2) o[s2][tt] = MFMA16(pa, vf[s2][ks], o[s2][tt]); }
            __builtin_amdgcn_sched_barrier(0);
            __syncthreads();
#pragma unroll
            for (int s2 = 0; s2 < 2; ++s2)
#pragma unroll
                for (int tt = 0; tt < 4; ++tt)
#pragma unroll
                    for (int r = 0; r < 4; ++r) *(LAS float*)(lds + D2_OFF_O + (16 * tt + 4 * g + r) * D2_RSO + (32 * wave + 16 * s2 + l15) * 4) = o[s2][tt][r];
            __builtin_amdgcn_sched_barrier(0);
            { const float edl = ed_s[128];
#pragma unroll
              for (int kt = 0; kt < ((SKIP & 8) ? 0 : 8); ++kt) { bf16x8 ka[2];
#pragma unroll
                  for (int ks = 0; ks < 2; ++ks) ka[ks] = frag_tr_perm(kb_, D2_RSK, 32 * ks, 16 * kt, lane);
#pragma unroll
                  for (int s2 = 0; s2 < 2; ++s2) { sacc[s2][kt] *= edl;
#pragma unroll
                      for (int ks = 0; ks < 2; ++ks) sacc[s2][kt] = MFMA16(ka[ks], vsf[s2][ks], sacc[s2][kt]); }
                  if ((kt & 3) == 3) __builtin_amdgcn_sched_barrier(0); }
#pragma unroll
              for (int s2 = 0; s2 < 2; ++s2)
#pragma unroll
                  for (int kt = 0; kt < 8; ++kt) asm volatile("" : "+v"(sacc[s2][kt])); }
        }
        __syncthreads();
    } else {
        const int t2 = tid - 256, ot = t2 >> 2, oq = t2 & 3;
        LAS float* ogl = (LAS float*)(lds + D2_OFF_D + 2048);
        if (t2 < 128) { const int q_ = t2 >> 5, i_ = t2 & 31; ogl[t2] = P.in[IN_OD_ONORM][(i_ < 16 ? 16 * q_ : 48 + 16 * q_) + i_]; }
        v4u wreg[2][4], ureg[2][4], qreg[2][4], kreg[4], preg[2], zreg[4]; float dreg[2] = {0.f, 0.f}, dlreg[2] = {0.f, 0.f};
#define D2_LOADH(n, S) do { _Pragma("unroll") for (int i_ = 0; i_ < 4; ++i_) { const int id_ = t2 + 256 * i_; wreg[S][i_] = *(const v4u*)(WTg + (size_t)(n) * 8192 + id_ * 8); ureg[S][i_] = *(const v4u*)(UTg + (size_t)(n) * 8192 + id_ * 8); \
                const int row_ = id_ >> 4, ch_ = id_ & 15; const size_t o2_ = (tok0 + (n) * 64 + row_) * W_D + h * 128 + ch_ * 8; qreg[S][i_] = *(const v4u*)(Q2 + o2_); } \
            if (t2 < 64) { dreg[S] = DECg[(n) * 64 + t2]; dlreg[S] = DECg[(n) * 64 + 63]; } } while (0)
#define D2_LOADKP(n) do { _Pragma("unroll") for (int i_ = 0; i_ < 4; ++i_) { const int id_ = t2 + 256 * i_, row_ = id_ >> 4, ch_ = id_ & 15; kreg[i_] = *(const v4u*)(K2 + (tok0 + (n) * 64 + row_) * W_D + h * 128 + ch_ * 8); } \
            _Pragma("unroll") for (int i_ = 0; i_ < 2; ++i_) preg[i_] = *(const v4u*)(QKg + (size_t)(n) * 4096 + (t2 + 256 * i_) * 8); } while (0)
#define D2_STOREH(n, S) do { LAS unsigned char* tb_ = lds; LAS unsigned char* kb2_ = lds + D2_OFF_K + ((n) & 1) * D2_KBUF; LAS float* dd_ = (LAS float*)(lds + D2_OFF_D + ((n) & 1) * 1024); \
            _Pragma("unroll") for (int i_ = 0; i_ < 4; ++i_) { const int id_ = t2 + 256 * i_; *(LAS v4u*)(tb_ + D2_OFF_W + (id_ >> 3) * D2_RSW + (id_ & 7) * 16) = wreg[S][i_]; *(LAS v4u*)(tb_ + D2_OFF_U + (id_ >> 3) * D2_RSW + (id_ & 7) * 16) = ureg[S][i_]; \
                const int row_ = id_ >> 4, ch_ = id_ & 15; *(LAS v4u*)(tb_ + D2_OFF_Q + row_ * D2_RSQ + ch_ * 16) = qreg[S][i_]; *(LAS v4u*)(kb2_ + row_ * D2_RSK + ch_ * 16) = kreg[i_]; } \
            _Pragma("unroll") for (int i_ = 0; i_ < 2; ++i_) { const int id_ = t2 + 256 * i_; *(LAS v4u*)(tb_ + D2_OFF_P + (id_ >> 3) * D2_RSP + (id_ & 7) * 16) = preg[i_]; } \
            if (t2 < 64) { dd_[t2] = fexp(dreg[S]) * DN_SCALE; dd_[64 + t2] = fexp(dlreg[S] - dreg[S]); if (t2 == 0) dd_[128] = fexp(dlreg[S]); } } while (0)
#define D2_LOADZ(n) do { const bf16_t* zp_ = PROJ + (tok0 + (n) * 64 + ot) * OD_N + OC_ZD + h * 128 + 16 * oq; zreg[0] = *(const v4u*)zp_; zreg[1] = *(const v4u*)(zp_ + 8); zreg[2] = *(const v4u*)(zp_ + 64); zreg[3] = *(const v4u*)(zp_ + 72); } while (0)
#define D2_OV(c) (*(LAS const f32x4*)(lds + D2_OFF_O + ot * D2_RSO + (((c) < 4 ? 16 * oq : 48 + 16 * oq) + 4 * (c)) * 4))
#define D2_OUT(n_) do { float ss = 0.f; \
            _Pragma("unroll") for (int c = 0; c < 8; ++c) { const f32x4 ov_ = D2_OV(c); ss += (ov_[0] * ov_[0] + ov_[1] * ov_[1]) + (ov_[2] * ov_[2] + ov_[3] * ov_[3]); } \
            ss += __shfl_xor(ss, 1); ss += __shfl_xor(ss, 2); \
            const float rs = frsq(ss * (1.0f / 128.0f) + EPS); \
            bf16_t* yp = Y + (tok0 + (n_) * 64 + ot) * D_MODEL + W_C + h * 128 + 16 * oq; \
            _Pragma("unroll") for (int c = 0; c < 4; ++c) { const v4u zw = zreg[c]; const f32x4 a = D2_OV(2 * c), b_ = D2_OV(2 * c + 1);     float ogv[32]; { const f32x4 g0_ = *(LAS const f32x4*)(ogl + oq * 32 + 8 * c), g1_ = *(LAS const f32x4*)(ogl + oq * 32 + 8 * c + 4); ogv[8 * c] = g0_[0]; ogv[8 * c + 1] = g0_[1]; ogv[8 * c + 2] = g0_[2]; ogv[8 * c + 3] = g0_[3]; ogv[8 * c + 4] = g1_[0]; ogv[8 * c + 5] = g1_[1]; ogv[8 * c + 6] = g1_[2]; ogv[8 * c + 7] = g1_[3]; } \
                v4u yw; yw.x = pk2(D2_Y(a[0], 8 * c + 0, zw.x, 1), D2_Y(a[1], 8 * c + 1, zw.x, 0)); yw.y = pk2(D2_Y(a[2], 8 * c + 2, zw.y, 1), D2_Y(a[3], 8 * c + 3, zw.y, 0)); \
                yw.z = pk2(D2_Y(b_[0], 8 * c + 4, zw.z, 1), D2_Y(b_[1], 8 * c + 5, zw.z, 0)); yw.w = pk2(D2_Y(b_[2], 8 * c + 6, zw.w, 1), D2_Y(b_[3], 8 * c + 7, zw.w, 0)); \
                *(v4u*)(yp + (c < 2 ? 8 * c : 48 + 8 * c)) = yw; } } while (0)
#define D2_Y(ov_, gi, zx, lo) ((ov_) * rs * ogv[gi] * fsilu(__builtin_bit_cast(float, (lo) ? ((zx) << 16) : ((zx) & 0xffff0000u))))
        D2_LOADH(0, 0); D2_LOADKP(0); D2_STOREH(0, 0); D2_LOADH(1, 1); D2_LOADKP(1); D2_LOADH(2, 0);
        for (int n = 0; n < NCH; n += 2) {
            __syncthreads();
            if constexpr (!(SKIP & 1)) { if (n > 0) D2_OUT(n - 1); D2_LOADZ(n); }
            __syncthreads();
            if (n + 1 < NCH) D2_STOREH(n + 1, 1);
            if (n + 2 < NCH) D2_LOADKP(n + 2);
            if (n + 3 < NCH) D2_LOADH(n + 3, 1);
            __syncthreads();
            if constexpr (!(SKIP & 1)) { D2_OUT(n); D2_LOADZ(n + 1); }
            __syncthreads();
            if (n + 2 < NCH) D2_STOREH(n + 2, 0);
            if (n + 3 < NCH) D2_LOADKP(n + 3);
            if (late) { if (n + 4 == D2_LATE0) dn2_wait_late(late, lane, 1u);
                else if (n + 4 == D2_LATE0 + 4) dn2_wait_late(late + 16, lane, 1u);
                else if (n + 4 == D2_LATE0 + 6) dn2_wait_late(late + 32, lane, 1u);
                else if (n + 4 == D2_LATE0 + 8) dn2_wait_late(late + 48, lane, 2u); }
            if (n + 4 < NCH) D2_LOADH(n + 4, 0);
        }
        __syncthreads();
        if constexpr (!(SKIP & 1)) D2_OUT(NCH - 1);
#undef D2_Y
#undef D2_LOADH
#undef D2_STOREH
#undef D2_LOADKP
#undef D2_LOADZ
#undef D2_OUT
#undef D2_OV
    }
    __syncthreads();
}
__device__ __forceinline__ void phase_mix0(const Ptrs& P, LAS unsigned char* lds, int G) {
    const int w = blockIdx.x;
    constexpr int NML = BATCH * H_B * 4;
    const int xq = w & 7, qq = (w >> 3) & 15;
    if (w < NML) mlstm_item(P, lds, G == 256 ? (xq + 8 * (qq >> 2)) * 4 + (qq & 3) : w);
    else if (G - NML == 128) {
        const int bhp = xq + 8 * (qq >> 2), k0 = qq & 3;
        for (int k = 3; k >= 0; --k) attn2_item(P, lds, bhp * 16 + 4 * k + k0); }
    else { for (int item = w - NML; item < BATCH * H_A * (NCH / 2); item += G - NML) attn_item(P, lds, item); }
    { const int wave = threadIdx.x >> 6, lane = threadIdx.x & 63;
      if (G - NML == 128) late_weights(P, lds, wave, lane, (w & (NML - 1)) * NWAVES + wave, NML * NWAVES, w < NML ? 0 : 1);
      else if (w < NML) late_weights(P, lds, wave, lane, w * NWAVES + wave, NML * NWAVES, 2); }
}
__device__ __forceinline__ void phase_mix1a(const Ptrs& P, LAS unsigned char* lds, int G) {
    const int w = blockIdx.x; constexpr int ND1 = BATCH * H_D * NCH;
    if (G == 256) { const int first = (w >> 2) * 32 + (w & 3) * 5;
        for (int i = 0; i < 5; ++i) dn1_item(P, lds, first + i, i ? first + i - 1 : -1, i < 4 ? first + i + 1 : -1);
    } else { for (int it = w; it < ND1; it += G) dn1_item(P, lds, it, it >= G ? it - G : -1, it + G < ND1 ? it + G : -1); }
}
__device__ __forceinline__ void phase_mix1b(const Ptrs& P, LAS unsigned char* lds, int G) {
    constexpr int ND2 = BATCH * H_D, NRG = BATCH * N_BLK_C * 2;
    const int w = blockIdx.x, wave = threadIdx.x >> 6, lane = threadIdx.x & 63;
    unsigned* late = (unsigned*)(P.ws + WS_CTL);
    if (w < ND2) dn2_item(P, lds, w, WS_Y, G == 256 ? late + w * 64 : nullptr);
    else if (G == 256) {
#define PUBLISH(word, amount) do { asm volatile("s_waitcnt vmcnt(0)" ::: "memory"); __syncthreads();     \
            if (threadIdx.x == 0) (void)xb_add(late + (word), (amount)); } while (0)
        if (w >= 192) { const int bh = w - 192, first = bh * 32 + D2_LATE0;
            for (int i = 0; i < 8; ++i) { dn1_item<0, true>(P, lds, first + i, i ? first + i - 1 : -1, i < 7 ? first + i + 1 : -1);
                if (i == 3) PUBLISH(bh * 64, 1u); else if (i == 5) PUBLISH(bh * 64 + 16, 1u); else if (i == 7) PUBLISH(bh * 64 + 32, 1u); } }
        else { const int j = w - 64, bh = j >> 1, first = bh * 32 + D2_LATE0 + 8 + 2 * (j & 1);
            dn1_item<0, true>(P, lds, first, -1, first + 1); dn1_item<0, true>(P, lds, first + 1, first, -1); PUBLISH(bh * 64 + 48, 1u);
            rglru_item<0>(P, lds, (w & 7) * 16 + ((w - 64) >> 3)); }
#undef PUBLISH
        last_weight(P, lds, wave, lane, (w - ND2) * NWAVES + wave, (G - ND2) * NWAVES); }
    else { for (int it = w - ND2; it < NRG; it += G - ND2) rglru_item<0>(P, lds, it);
        last_weight(P, lds, wave, lane, (w - ND2) * NWAVES + wave, (G - ND2) * NWAVES); }
}
typedef GAS unsigned gu32;
#define RLX_AGENT __ATOMIC_RELAXED, __HIP_MEMORY_SCOPE_AGENT
constexpr int CW_BAR = 4096;
static_assert((CW_BAR + XCD_BAR_WORDS) * 4 <= (int)CTL_ZERO_BYTES, "CTL words inside the memset region");
constexpr int LDS_BYTES = 163840;
constexpr int RING_OFF = 0, RING_BYTES = LDS_BYTES - 512;
constexpr int LDSCTL_OFF = RING_BYTES, MISC_OFF = LDSCTL_OFF + 320;

struct Args { Ptrs P; int ph_lo, ph_hi; };
constexpr int N_PHASES = 8;

__global__ void __launch_bounds__(NWAVES * 64, 2) fwd_mega(Args args) {
    extern __shared__ __attribute__((aligned(16))) unsigned char lds_raw[];
    LAS unsigned char* lds = (LAS unsigned char*)lds_raw;
    volatile LAS unsigned* MISC = (volatile LAS unsigned*)(lds + MISC_OFF);
    const int tid = threadIdx.x, lane = tid & 63, wave = __builtin_amdgcn_readfirstlane(tid >> 6);
    const int G = gridDim.x;
    for (int u = tid; u < (LDS_BYTES - LDSCTL_OFF) / 4; u += NWAVES * 64) ((LAS unsigned*)(lds + LDSCTL_OFF))[u] = 0u;
    __syncthreads();
    const Ptrs& P = args.P;
    gu32* ctl = (gu32*)(P.ws + WS_CTL);
    const int lo = args.ph_lo, hi = args.ph_hi;
    XcdBarrier bar; bar.bar = (unsigned*)(ctl + CW_BAR); bar.x = 0; bar.st = nullptr;
    if (hi - lo > 1) bar = xcd_barrier_post((unsigned*)(ctl + CW_BAR), MISC + 8);
#define IN(k) (lo <= (k) && (k) < hi)
#define SEAM(k) do { if (IN(k) && IN((k) + 1)) xcd_barrier(bar); } while (0)
#ifndef DUP_PHASE
#define DUP_PHASE -1
#endif
#define RUN(k) do { \
    if ((k) == 0) phase_prologue<3>(P, lds, wave, lane, blockIdx.x * NWAVES + wave, G * NWAVES); \
    else if ((k) == 1) phase_gemm<1>(P, lds, G, blockIdx.x); \
    else if ((k) == 2) phase_mix0(P, lds, G); \
    else if ((k) == 3) phase_gemm<2>(P, lds, G, blockIdx.x); \
    else if ((k) == 4) { phase_gemm<3>(P, lds, G, blockIdx.x); phase_gates_ab(P, lds, G); } \
    else if ((k) == 5) phase_mix1a(P, lds, G); \
    else if ((k) == 6) phase_mix1b(P, lds, G); \
    else phase_gemm<4>(P, lds, G, blockIdx.x); } while (0)
#define STEP(k) do { if (IN(k)) { if ((k) == 3 && DUP_PHASE == 7000) { for (int b_ = 0; b_ < 10; ++b_) xcd_barrier(bar); } if ((k) == 0 && DUP_PHASE >= 6001 && DUP_PHASE <= 6002) { phase_prologue<(DUP_PHASE >= 6001 && DUP_PHASE <= 6002 ? DUP_PHASE - 6000 : 3)>(P, lds, wave, lane, blockIdx.x * NWAVES + wave, G * NWAVES); xcd_barrier(bar); } if ((k) == 5 && DUP_PHASE >= 5000 && DUP_PHASE < 5064) { for (int it_ = blockIdx.x; it_ < BATCH * H_D * NCH; it_ += G) dn1_item<(DUP_PHASE >= 5000 ? DUP_PHASE - 5000 : 0)>(P, lds, it_, it_ >= G ? it_ - G : -1, it_ + G < BATCH * H_D * NCH ? it_ + G : -1); xcd_barrier(bar); } RUN(k); if (DUP_PHASE == (k)) { xcd_barrier(bar); RUN(k); } \
        if ((k) == 2 && DUP_PHASE == 20) { xcd_barrier(bar); if (blockIdx.x >= 128) phase_mix0(P, lds, G); } \
        if ((k) == 2 && DUP_PHASE == 21) { xcd_barrier(bar); if (blockIdx.x < 128) phase_mix0(P, lds, G); } \
        if ((k) == 2 && DUP_PHASE >= 2000 && DUP_PHASE < 2128) { xcd_barrier(bar); if (blockIdx.x >= 128) { const int wa_ = blockIdx.x - 128; for (int k_ = 3; k_ >= 0; --k_) attn2_item<(DUP_PHASE >= 2000 ? DUP_PHASE - 2000 : 0)>(P, lds, (wa_ >> 2) * 16 + 4 * k_ + (wa_ & 3), ~(size_t)0); } } \
        if ((k) == 2 && DUP_PHASE >= 1000 && DUP_PHASE < 1128) { xcd_barrier(bar); if (blockIdx.x < 128) mlstm_item<(DUP_PHASE >= 1000 ? DUP_PHASE - 1000 : 0)>(P, lds, blockIdx.x, ~(size_t)0); } \
        if ((k) == 6 && DUP_PHASE >= 3000 && DUP_PHASE < 3032) { xcd_barrier(bar); if (blockIdx.x < 64) dn2_item<(DUP_PHASE >= 3000 ? DUP_PHASE - 3000 : 0)>(P, lds, blockIdx.x, 420 * MiB); } \
        if ((k) == 6 && DUP_PHASE >= 4000 && DUP_PHASE < 4032) { xcd_barrier(bar); rglru_item<(DUP_PHASE >= 4000 ? DUP_PHASE - 4000 : 0)>(P, lds, blockIdx.x & 127, 420 * MiB); } \
        if ((k) == 5 && DUP_PHASE == 50) { xcd_barrier(bar); for (int it_ = blockIdx.x; it_ < BATCH * N_BLK_C * 2; it_ += G) rglru_item<0>(P, lds, it_); } \
        if ((k) == 5 && DUP_PHASE == 51) { xcd_barrier(bar); phase_mix1a(P, lds, G); } \
        if ((k) == 6 && DUP_PHASE == 64) { xcd_barrier(bar); if (blockIdx.x < 64 || blockIdx.x >= 192) phase_mix1b(P, lds, G); } \
        if ((k) == 6 && DUP_PHASE == 65) { xcd_barrier(bar); if (blockIdx.x < 192) phase_mix1b(P, lds, G); } \
        if ((k) == 6 && DUP_PHASE == 66) { xcd_barrier(bar); if (blockIdx.x < 64) phase_mix1b(P, lds, G); } \
        if ((k) == 6 && DUP_PHASE == 61) { xcd_barrier(bar); if (blockIdx.x >= 64 && blockIdx.x < 192) phase_mix1b(P, lds, G); } \
        if ((k) == 6 && DUP_PHASE == 62) { xcd_barrier(bar); if (blockIdx.x >= 192) phase_mix1b(P, lds, G); } \
        if ((k) == 6 && DUP_PHASE == 63) { xcd_barrier(bar); if (blockIdx.x >= 64) phase_mix1b(P, lds, G); } \
        if ((k) == 5 && DUP_PHASE == 52) { xcd_barrier(bar); if (blockIdx.x >= 64) phase_mix1a(P, lds, G); } \
        } SEAM(k); } while (0)
    STEP(0); STEP(1); STEP(2); STEP(3); STEP(4); STEP(5); STEP(6); STEP(7);
#undef STEP
#undef RUN
#undef IN
#undef SEAM
}
extern "C" void kernel_launch(void* const* d_in, const int* in_sizes, int n_in, void* d_out, int out_size, void* d_ws, size_t ws_size, hipStream_t stream) {
    static int grid = 0;
    if (grid == 0) {
        if (n_in != 20 || in_sizes[0] != M_TOK * D_MODEL || out_size != M_TOK * D_MODEL || ws_size < WS_END) {
            fprintf(stderr, "kernel_launch: unexpected shapes: n_in %d in0 %d out %d ws %zu (need %zu)\n", n_in, n_in > 0 ? in_sizes[0] : -1, out_size, ws_size, (size_t)WS_END); grid = -1; return; }
        int dev = 0, cus = 0, per_cu = 0;
        if (hipGetDevice(&dev) != hipSuccess || hipDeviceGetAttribute(&cus, hipDeviceAttributeMultiprocessorCount, dev) != hipSuccess) { grid = -1; return; }
        if (hipFuncSetAttribute((const void*)fwd_mega, hipFuncAttributeMaxDynamicSharedMemorySize, LDS_BYTES) != hipSuccess) { fprintf(stderr, "kernel_launch: hipFuncSetAttribute failed\n"); grid = -1; return; }
        if (hipOccupancyMaxActiveBlocksPerMultiprocessor(&per_cu, (const void*)fwd_mega, NWAVES * 64, LDS_BYTES) != hipSuccess || per_cu < 1) { fprintf(stderr, "kernel_launch: occupancy query says %d blocks per CU\n", per_cu); per_cu = 1; }
        (void)hipGetLastError();
        grid = cus;
    }
    if (grid < 0) return;
    if (hipMemsetAsync((char*)d_ws + WS_CTL, 0, CTL_ZERO_BYTES, stream) != hipSuccess) { fprintf(stderr, "kernel_launch: memset failed\n"); return; }
    Args a{};
    for (int i = 0; i < 20; ++i) a.P.in[i] = (const float*)d_in[i];
    a.P.out = (float*)d_out; a.P.ws = (unsigned char*)d_ws; a.ph_lo = 0; a.ph_hi = N_PHASES;
    hipLaunchKernelGGL(fwd_mega, dim3(grid), dim3(NWAVES * 64), LDS_BYTES, stream, a);
    const hipError_t le = hipPeekAtLastError();
    if (le != hipSuccess) fprintf(stderr, "kernel_launch: launch failed: %s\n", hipGetErrorName(le));
}
```
